# Optimizing an MI355X kernel written in HIP

```python
import jax, jax.numpy as jnp
from jax import lax
import numpy as np

D_MODEL = 1024
BATCH = 16
SEQ = 256
DEPTH = 2
DEC_BATCH = 4
DEC_SEQ = 2048
PAST_LEN = 512

GRID_W = 64
HEAD_DIM = 64
H_A = 8
KVH_A = 2
H_B = 4
H_C = 4
WINDOW = 128
BLOCK = 128
NA_ROWS = 8
NA_COLS = 16
ROPE_BASE = 10000.0
N_EXPERTS = 16
CAPACITY_FACTOR = 2
D_FF = 1024
LN_EPS = 1e-6

kernel_name = "hybrid_diffusion_parallel_heads_step"

F32 = jnp.float32


def _split_sizes():
    qa, kva = H_A * HEAD_DIM, KVH_A * HEAD_DIM
    b, c = H_B * HEAD_DIM, H_C * HEAD_DIM
    return [qa, kva, kva, b, b, b, c, c, c, c]


def _layernorm(x, g, b):
    xf = x.astype(F32)
    mu = xf.mean(-1, keepdims=True)
    var = jnp.square(xf - mu).mean(-1, keepdims=True)
    return ((xf - mu) * lax.rsqrt(var + LN_EPS) * g.astype(F32) + b.astype(F32)).astype(x.dtype)


def _modulation(cond, w, b):
    m = jax.nn.silu(cond) @ w + b
    return [p[:, None, :] for p in jnp.split(m, 6, axis=-1)]


def _project(h, w_in):
    bsz, L = h.shape[:2]
    pts = np.cumsum(_split_sizes())[:-1].tolist()
    qa, ka, va, qb, kb, vb, qc, kc, vc, gc = jnp.split(h @ w_in, pts, axis=-1)
    hd = lambda t, n: t.reshape(bsz, L, n, HEAD_DIM)
    return (hd(qa, H_A), hd(ka, KVH_A), hd(va, KVH_A), hd(qb, H_B), hd(kb, H_B), hd(vb, H_B),
            hd(qc, H_C), hd(kc, H_C), hd(vc, H_C), gc)


def _axial_rope(x):
    L = x.shape[1]
    t = np.arange(L)
    row, col = t // GRID_W, t % GRID_W
    half = HEAD_DIM // 2
    inv = 1.0 / (ROPE_BASE ** (np.arange(0, half, 2) / half))

    def rot(xp, pos):
        ang = jnp.asarray(pos[:, None] * inv[None, :], F32)
        cos, sin = jnp.cos(ang)[None, :, None, :], jnp.sin(ang)[None, :, None, :]
        x1, x2 = jnp.split(xp.astype(F32), 2, axis=-1)
        return jnp.concatenate([x1 * cos - x2 * sin, x1 * sin + x2 * cos], -1)

    xr, xc = jnp.split(x, 2, axis=-1)
    return jnp.concatenate([rot(xr, row), rot(xc, col)], -1).astype(x.dtype)


def _to_blocks(x):
    bsz, L = x.shape[:2]
    return jnp.moveaxis(x.reshape(bsz, L // BLOCK, BLOCK, *x.shape[2:]), 1, 0)


def _from_blocks(x):
    x = jnp.moveaxis(x, 0, 1)
    return x.reshape(x.shape[0], -1, *x.shape[3:])


def _gqa_attn(q, k, v, mask=None, sink=None):
    bsz, Q, H, d = q.shape
    kvh = k.shape[2]
    g = H // kvh
    qg = q.reshape(bsz, Q, kvh, g, d)
    s = jnp.einsum('bqhgd,bkhd->bhgqk', qg, k).astype(F32) * (d ** -0.5)
    if mask is not None:
        s = jnp.where(mask, s, -jnp.inf)
    m = s.max(-1, keepdims=True)
    if sink is not None:
        sk = sink.astype(F32).reshape(kvh, g, 1, 1)
        m = jnp.maximum(m, sk)
    p = jnp.exp(s - m)
    den = p.sum(-1, keepdims=True)
    if sink is not None:
        den = den + jnp.exp(sk - m)
    o = jnp.einsum('bhgqk,bkhd->bqhgd', (p / den).astype(v.dtype), v)
    return o.reshape(bsz, Q, H, d)


def _ctx_attn(q, k, v, sink=None):
    out = lax.map(lambda qb: _gqa_attn(qb, k, v, None, sink), _to_blocks(q))
    return _from_blocks(out)


def _window_attn_latent(q, k, v, kc, vc, sink):
    bsz, L = q.shape[:2]
    nb = L // BLOCK
    Lc = kc.shape[1]

    def windows(t):
        tb = jnp.pad(t, [(0, 0), (BLOCK, BLOCK), (0, 0), (0, 0)]).reshape(bsz, nb + 2, BLOCK, *t.shape[2:])
        return jnp.moveaxis(jnp.concatenate([tb[:, :-2], tb[:, 1:-1], tb[:, 2:]], axis=2), 1, 0)

    qi = np.arange(nb)[:, None, None] * BLOCK + np.arange(BLOCK)[None, :, None]
    kj = np.arange(nb)[:, None, None] * BLOCK - BLOCK + np.arange(3 * BLOCK)[None, None, :]
    band = (np.abs(qi - kj) <= WINDOW) & (kj >= 0) & (kj < L)
    full = jnp.asarray(np.concatenate([band, np.ones((nb, BLOCK, Lc), bool)], -1))

    def blk(args):
        qb, kb, vb, mb = args
        return _gqa_attn(qb, jnp.concatenate([kb, kc], 1), jnp.concatenate([vb, vc], 1), mb, sink)

    out = lax.map(blk, (_to_blocks(q), windows(k), windows(v), full))
    return _from_blocks(out)


def _na_indices(L):
    rows = L // GRID_W
    kh, kw = min(NA_ROWS, rows), min(NA_COLS, GRID_W)
    t = np.arange(L)
    r, c = t // GRID_W, t % GRID_W
    rs = np.clip(r - kh // 2, 0, rows - kh)
    cs = np.clip(c - kw // 2, 0, GRID_W - kw)
    kr = rs[:, None, None] + np.arange(kh)[None, :, None]
    kc = cs[:, None, None] + np.arange(kw)[None, None, :]
    kr, kc = np.broadcast_arrays(kr, kc)
    idx = (kr * GRID_W + kc).reshape(L, kh * kw)
    dr = (kr - r[:, None, None]).reshape(L, -1) + NA_ROWS - 1
    dc = (kc - c[:, None, None]).reshape(L, -1) + NA_COLS - 1
    return idx, dr, dc


def _na_latent(q, k, v, kc, vc, rpb):
    bsz, L, H, d = q.shape
    nb = L // BLOCK
    idx, dr, dc = _na_indices(L)
    K = idx.shape[1]
    bias = jnp.moveaxis(rpb[:, dr, dc].reshape(H, nb, BLOCK, K), 1, 0)
    scale = d ** -0.5

    def blk(args):
        qb, ib, bb = args
        kn, vn = k[:, ib], v[:, ib]
        s_nb = jnp.einsum('bqhd,bqkhd->bhqk', qb, kn).astype(F32) * scale + bb.astype(F32)
        s_cx = jnp.einsum('bqhd,bkhd->bhqk', qb, kc).astype(F32) * scale
        p = jax.nn.softmax(jnp.concatenate([s_nb, s_cx], -1), axis=-1).astype(v.dtype)
        return (jnp.einsum('bhqk,bqkhd->bqhd', p[..., :K], vn)
                + jnp.einsum('bhqk,bkhd->bqhd', p[..., K:], vc))

    out = lax.map(blk, (_to_blocks(q), jnp.asarray(idx.reshape(nb, BLOCK, K), jnp.int32), bias))
    return _from_blocks(out)


def _retention_dir(q, k, v, log_gamma, s0):
    j = np.arange(BLOCK).astype(np.float32)
    rel = j[:, None] - j[None, :]
    lg = log_gamma.astype(F32)
    dmat = jnp.where(jnp.asarray(rel >= 0), jnp.exp(lg[:, None, None] * np.maximum(rel, 0.0)), 0.0)
    xi = jnp.exp(lg[None, :] * (j[:, None] + 1.0))
    zeta = jnp.exp(lg[None, :] * (BLOCK - 1.0 - j)[:, None])
    g_chunk = jnp.exp(lg * BLOCK)

    def step(S, args):
        qc, kc, vc = args
        inner = jnp.einsum('bhij,bjhe->bihe', jnp.einsum('bihd,bjhd->bhij', qc, kc) * dmat, vc)
        cross = jnp.einsum('bihd,bhde->bihe', qc, S) * xi[None, :, :, None]
        S = S * g_chunk[None, :, None, None] + jnp.einsum('bjhd,bjhe->bhde', kc * zeta[None, :, :, None], vc)
        return S, inner + cross

    S, out = lax.scan(step, s0.astype(F32), (_to_blocks(q), _to_blocks(k), _to_blocks(v)))
    return _from_blocks(out), S


def _retention(q, k, v, lg, s0_f, s0_b):
    qf, kf, vf = q.astype(F32), k.astype(F32) * (HEAD_DIM ** -0.5), v.astype(F32)
    of, sf = _retention_dir(qf, kf, vf, lg[0], s0_f)
    ob, sb = _retention_dir(qf[:, ::-1], kf[:, ::-1], vf[:, ::-1], lg[1], s0_b)
    return of + ob[:, ::-1], sf, sb


def _retention_out(o, g, gn_w):
    mu = o.mean(-1, keepdims=True)
    var = jnp.square(o - mu).mean(-1, keepdims=True)
    on = ((o - mu) * lax.rsqrt(var + LN_EPS)).reshape(*g.shape) * gn_w.astype(F32)
    return (jax.nn.silu(g.astype(F32)) * on).astype(g.dtype)


def _mixer_context(h, w_in, w_out, sink, lg, gn_w):
    bsz, L = h.shape[:2]
    qa, ka, va, qb, kb, vb, qc, kc, vc, gc = _project(h, w_in)
    oa = _ctx_attn(qa, ka, va, sink)
    ob = _ctx_attn(qb, kb, vb)
    z = jnp.zeros((bsz, H_C, HEAD_DIM, HEAD_DIM), F32)
    oc, sf, sb = _retention(qc, kc, vc, lg, z, z)
    cat = jnp.concatenate([oa.reshape(bsz, L, -1), ob.reshape(bsz, L, -1), _retention_out(oc, gc, gn_w)], -1)
    return cat @ w_out, (ka, va, kb, vb, jnp.stack([sf, sb], 1))


def _mixer_latent(h, cak, cav, cbk, cbv, cst, w_in, w_out, sink, rpb, lg, gn_w):
    bsz, L = h.shape[:2]
    qa, ka, va, qb, kb, vb, qc, kc, vc, gc = _project(h, w_in)
    oa = _window_attn_latent(_axial_rope(qa), _axial_rope(ka), va, cak, cav, sink)
    ob = _na_latent(qb, kb, vb, cbk, cbv, rpb)
    oc, _, _ = _retention(qc, kc, vc, lg, cst[:, 0], cst[:, 1])
    cat = jnp.concatenate([oa.reshape(bsz, L, -1), ob.reshape(bsz, L, -1), _retention_out(oc, gc, gn_w)], -1)
    return cat @ w_out


def _expert_choice(h, w_router, w_gate_up, w_down):
    n = h.shape[1]
    cap = CAPACITY_FACTOR * n // N_EXPERTS
    aff = jax.nn.softmax((h @ w_router).astype(F32), axis=-1)
    gate, idx = lax.top_k(jnp.swapaxes(aff, 1, 2), cap)

    def per_request(hb, ib, gb):
        xe = hb[ib]
        a, b = jnp.split(jnp.einsum('ecd,edf->ecf', xe, w_gate_up), 2, axis=-1)
        ye = jnp.einsum('ecf,efd->ecd', jax.nn.silu(a) * b, w_down) * gb[..., None].astype(hb.dtype)
        return jnp.zeros_like(hb).at[ib.reshape(-1)].add(ye.reshape(-1, hb.shape[-1]))

    return jax.vmap(per_request)(h, idx, gate)


def setup_inputs(seed: int = 0) -> dict:
    key = jax.random.key(seed)
    ks = jax.random.split(key, 26)
    beta = (8 * DEPTH) ** -0.25
    d_in = sum(_split_sizes())
    nrm = lambda k, shape, s=1.0: jax.random.normal(k, shape, F32) * s
    dec0 = jnp.asarray(np.log(-np.log(1.0 - 2.0 ** (-5.0 - np.arange(H_C)))), F32)
    return {
        "x_prompt": nrm(ks[0], (BATCH, SEQ, D_MODEL)),
        "x_sample": nrm(ks[1], (DEC_BATCH, DEC_SEQ, D_MODEL)),
        "cache_attn_a_k": nrm(ks[2], (DEC_BATCH, DEPTH, PAST_LEN, KVH_A, HEAD_DIM)),
        "cache_attn_a_v": nrm(ks[3], (DEC_BATCH, DEPTH, PAST_LEN, KVH_A, HEAD_DIM)),
        "cache_attn_b_k": nrm(ks[4], (DEC_BATCH, DEPTH, PAST_LEN, H_B, HEAD_DIM)),
        "cache_attn_b_v": nrm(ks[5], (DEC_BATCH, DEPTH, PAST_LEN, H_B, HEAD_DIM)),
        "state_ret": nrm(ks[6], (DEC_BATCH, DEPTH, 2, H_C, HEAD_DIM, HEAD_DIM)),
        "c": nrm(ks[7], (DEC_BATCH, D_MODEL)),
        "c_ctx": nrm(ks[8], (D_MODEL,)),
        "w_ada": nrm(ks[9], (DEPTH, D_MODEL, 6 * D_MODEL), 0.5 * D_MODEL ** -0.5),
        "b_ada": nrm(ks[10], (DEPTH, 6 * D_MODEL), 0.01),
        "w_in": nrm(ks[11], (DEPTH, D_MODEL, d_in), D_MODEL ** -0.5),
        "w_out": nrm(ks[12], (DEPTH, D_MODEL, D_MODEL), beta * D_MODEL ** -0.5),
        "attn_sink": nrm(ks[13], (DEPTH, H_A), 0.5),
        "na_rpb": nrm(ks[14], (DEPTH, H_B, 2 * NA_ROWS - 1, 2 * NA_COLS - 1), 0.5),
        "ret_decay": jnp.broadcast_to(dec0, (DEPTH, 2, H_C)) + nrm(ks[15], (DEPTH, 2, H_C), 0.05),
        "ret_gn": 1.0 + nrm(ks[16], (DEPTH, H_C * HEAD_DIM), 0.02),
        "ln1_g": 1.0 + nrm(ks[17], (DEPTH, D_MODEL), 0.02),
        "ln1_b": nrm(ks[18], (DEPTH, D_MODEL), 0.01),
        "ln2_g": 1.0 + nrm(ks[19], (DEPTH, D_MODEL), 0.02),
        "ln2_b": nrm(ks[20], (DEPTH, D_MODEL), 0.01),
        "w_router": nrm(ks[21], (DEPTH, D_MODEL, N_EXPERTS), D_MODEL ** -0.5),
        "w_gate_up": nrm(ks[22], (DEPTH, N_EXPERTS, D_MODEL, 2 * D_FF), D_MODEL ** -0.5),
        "w_down": nrm(ks[23], (DEPTH, N_EXPERTS, D_FF, D_MODEL), beta * D_FF ** -0.5),
    }


def reference(x_prompt, x_sample, cache_attn_a_k, cache_attn_a_v, cache_attn_b_k, cache_attn_b_v, state_ret,
              c, c_ctx, w_ada, b_ada, w_in, w_out, attn_sink, na_rpb, ret_decay, ret_gn,
              ln1_g, ln1_b, ln2_g, ln2_b, w_router, w_gate_up, w_down):
    alpha = (2 * DEPTH) ** 0.25

    x = x_prompt
    a_k, a_v, b_k, b_v, st = [], [], [], [], []
    for l in range(DEPTH):
        sh1, sc1, g1, sh2, sc2, g2 = _modulation(c_ctx[None, :], w_ada[l], b_ada[l])
        lg = -jnp.exp(ret_decay[l].astype(F32))
        mix, (ka, va, kb, vb, s_l) = _mixer_context(x * (1 + sc1) + sh1, w_in[l], w_out[l], attn_sink[l], lg, ret_gn[l])
        x = _layernorm(alpha * x + g1 * mix, ln1_g[l], ln1_b[l])
        ff = _expert_choice(x * (1 + sc2) + sh2, w_router[l], w_gate_up[l], w_down[l])
        x = _layernorm(alpha * x + g2 * ff, ln2_g[l], ln2_b[l])
        a_k.append(ka); a_v.append(va); b_k.append(kb); b_v.append(vb); st.append(s_l)
    y_prompt = x
    new_attn_a_k = jnp.stack(a_k, 1)
    new_attn_a_v = jnp.stack(a_v, 1)
    new_attn_b_k = jnp.stack(b_k, 1)
    new_attn_b_v = jnp.stack(b_v, 1)
    new_state_ret = jnp.stack(st, 1)

    x = x_sample
    for l in range(DEPTH):
        sh1, sc1, g1, sh2, sc2, g2 = _modulation(c, w_ada[l], b_ada[l])
        lg = -jnp.exp(ret_decay[l].astype(F32))
        mix = _mixer_latent(x * (1 + sc1) + sh1, cache_attn_a_k[:, l], cache_attn_a_v[:, l],
                            cache_attn_b_k[:, l], cache_attn_b_v[:, l], state_ret[:, l],
                            w_in[l], w_out[l], attn_sink[l], na_rpb[l], lg, ret_gn[l])
        x = _layernorm(alpha * x + g1 * mix, ln1_g[l], ln1_b[l])
        ff = _expert_choice(x * (1 + sc2) + sh2, w_router[l], w_gate_up[l], w_down[l])
        x = _layernorm(alpha * x + g2 * ff, ln2_g[l], ln2_b[l])
    y_sample = x

    return (y_prompt, y_sample, new_attn_a_k, new_attn_a_v, new_attn_b_k, new_attn_b_v, new_state_ret)
```

```cpp
#include <hip/hip_runtime.h>
#include <hip/hip_cooperative_groups.h>
#include <cstdio>
namespace cg = cooperative_groups;

#define DI __device__ __forceinline__
typedef short bf16x8 __attribute__((ext_vector_type(8)));
typedef float f32x16 __attribute__((ext_vector_type(16)));
typedef __bf16 bf2_t __attribute__((ext_vector_type(2)));
typedef float f2_t __attribute__((ext_vector_type(2)));
typedef unsigned short u16;
typedef unsigned u32x4 __attribute__((ext_vector_type(4)));

#define MFMA(a, b, c) __builtin_amdgcn_mfma_f32_32x32x16_bf16((a), (b), (c), 0, 0, 0)

constexpr int NTOK = 12288;
constexpr int NCTX = 4096;
constexpr int DM = 1024;
constexpr int DIN = 2560;
constexpr int LDT = 72;
constexpr int LDT2 = 136;
constexpr int NROWS_E = 1536;
constexpr float NEG = -1e30f;
constexpr float ALPHA = 1.41421356237f;

constexpr size_t OFF_AK = 12582912, OFF_AV = 13631488, OFF_BK = 14680064, OFF_BV = 16777216, OFF_ST = 18874368;

struct Params {
  const float *x_prompt, *x_sample, *cak, *cav, *cbk, *cbv, *state, *c, *c_ctx, *w_ada, *b_ada, *w_in, *w_out, *sink, *rpb,
      *decay, *gn, *ln1g, *ln1b, *ln2g, *ln2b, *w_router, *w_gu, *w_down;
  float* out;
  float *MOD, *ROPE, *X, *PRE, *KVS, *AFF, *SELGATE;
  int* SELTOK;
  u16 *QKV, *CAT, *H2, *ACT;
};

DI unsigned pack2(float a, float b) {
  f2_t v = {a, b};
  bf2_t r = __builtin_convertvector(v, bf2_t);
  return __builtin_bit_cast(unsigned, r);
}
DI int otid() { int x = threadIdx.x; asm volatile("" : "+v"(x)); return x; }
DI float bflo(unsigned u) { return __uint_as_float(u << 16); }
DI float bfhi(unsigned u) { return __uint_as_float(u & 0xffff0000u); }
DI int crow(int i, int h) { return (i & 3) + 8 * (i >> 2) + 4 * h; }
DI float silu(float x) { return x / (1.f + __expf(-x)); }
DI float wave_sum(float v) {
#pragma unroll
  for (int o = 32; o >= 1; o >>= 1) v += __shfl_xor(v, o);
  return v;
}
DI bf16x8 mk8(unsigned a, unsigned b, unsigned c, unsigned d) {
  uint4 u = {a, b, c, d};
  return __builtin_bit_cast(bf16x8, u);
}

template <int AMODE, class ARow, class BCol, class Epi>
DI void gemm_tile(char* smem, ARow arow, const float* sc, const float* sh, BCol bcol, int ldb, Epi epi) {
  u16* sA = (u16*)smem;
  u16* sB = sA + 128 * LDT;
  const int tid = otid(), lane = tid & 63, w = tid >> 6, r = lane & 31, h = lane >> 5;
  const int wm = w >> 1, wn = w & 1;
  f32x16 acc[2][2];
#pragma unroll
  for (int a = 0; a < 2; ++a)
#pragma unroll
    for (int b = 0; b < 2; ++b)
#pragma unroll
      for (int i = 0; i < 16; ++i) acc[a][b][i] = 0.f;

  const int a_r0 = (AMODE == 0) ? (tid >> 4) : (tid >> 3);
  const int a_c = (AMODE == 0) ? (tid & 15) * 4 : (tid & 7) * 8;
  const float* apf = nullptr;
  const u16* apb[4] = {nullptr, nullptr, nullptr, nullptr};
  if constexpr (AMODE == 0) {
    apf = (const float*)arow(a_r0) + a_c;
  } else {
#pragma unroll
    for (int i = 0; i < 4; ++i) apb[i] = (const u16*)arow(a_r0 + 32 * i) + a_c;
  }
  const int b_n = tid & 127, b_kg = tid >> 7;
  const float* bp = bcol(b_n) + (size_t)(b_kg * 32) * ldb;

  float4 af[8];
  u32x4 ab[4];
  float bfv[32];

#pragma unroll 1
  for (int kt = 0; kt <= 16; ++kt) {
    if (kt < 16) {
      const int k0 = kt * 64;
      if constexpr (AMODE == 0) {
#pragma unroll
        for (int i = 0; i < 8; ++i) af[i] = *(const float4*)(apf + (size_t)i * 16 * DM + k0);
      } else {
#pragma unroll
        for (int i = 0; i < 4; ++i) ab[i] = *(const u32x4*)(apb[i] + k0);
      }
#pragma unroll
      for (int j = 0; j < 32; ++j) bfv[j] = bp[(size_t)(k0 + j) * ldb];
    }
    if (kt > 0) {
#pragma unroll
      for (int ks = 0; ks < 4; ++ks) {
        bf16x8 fa[2], fb[2];
#pragma unroll
        for (int mt = 0; mt < 2; ++mt) fa[mt] = *(const bf16x8*)&sA[(wm * 64 + mt * 32 + r) * LDT + ks * 16 + 8 * h];
#pragma unroll
        for (int nt = 0; nt < 2; ++nt) fb[nt] = *(const bf16x8*)&sB[(wn * 64 + nt * 32 + r) * LDT + ks * 16 + 8 * h];
#pragma unroll
        for (int mt = 0; mt < 2; ++mt)
#pragma unroll
          for (int nt = 0; nt < 2; ++nt) acc[mt][nt] = MFMA(fa[mt], fb[nt], acc[mt][nt]);
      }
    }
    __syncthreads();
    if (kt < 16) {
      if constexpr (AMODE == 0) {
        const float4 s4 = *(const float4*)(sc + kt * 64 + a_c);
        const float4 h4 = *(const float4*)(sh + kt * 64 + a_c);
#pragma unroll
        for (int i = 0; i < 8; ++i) {
          const float4 x = af[i];
          uint2 pk;
          pk.x = pack2(x.x * (1.f + s4.x) + h4.x, x.y * (1.f + s4.y) + h4.y);
          pk.y = pack2(x.z * (1.f + s4.z) + h4.z, x.w * (1.f + s4.w) + h4.w);
          *(uint2*)&sA[(a_r0 + 16 * i) * LDT + a_c] = pk;
        }
      } else {
#pragma unroll
        for (int i = 0; i < 4; ++i) *(u32x4*)&sA[(a_r0 + 32 * i) * LDT + a_c] = ab[i];
      }
#pragma unroll
      for (int q = 0; q < 4; ++q) {
        uint4 pk;
        pk.x = pack2(bfv[8 * q + 0], bfv[8 * q + 1]);
        pk.y = pack2(bfv[8 * q + 2], bfv[8 * q + 3]);
        pk.z = pack2(bfv[8 * q + 4], bfv[8 * q + 5]);
        pk.w = pack2(bfv[8 * q + 6], bfv[8 * q + 7]);
        *(uint4*)&sB[b_n * LDT + b_kg * 32 + 8 * q] = pk;
      }
    }
    __syncthreads();
  }
  epi(acc, wm, wn, r, h);
}

DI void load4x4(const void* base, int stride, bool isf32, int rq, int c4, float v[4][4]) {
  if (isf32) {
#pragma unroll
    for (int i = 0; i < 4; ++i) {
      const float4 x = *(const float4*)((const float*)base + (size_t)(4 * rq + i) * stride + 4 * c4);
      v[i][0] = x.x; v[i][1] = x.y; v[i][2] = x.z; v[i][3] = x.w;
    }
  } else {
#pragma unroll
    for (int i = 0; i < 4; ++i) {
      const uint2 x = *(const uint2*)((const u16*)base + (size_t)(4 * rq + i) * stride + 4 * c4);
      v[i][0] = bflo(x.x); v[i][1] = bfhi(x.x); v[i][2] = bflo(x.y); v[i][3] = bfhi(x.y);
    }
  }
}
DI void store_n(u16* dst, int ld, int row0, int rq, int c4, const float v[4][4]) {
#pragma unroll
  for (int i = 0; i < 4; ++i) {
    uint2 pk = {pack2(v[i][0], v[i][1]), pack2(v[i][2], v[i][3])};
    *(uint2*)&dst[(row0 + 4 * rq + i) * ld + 4 * c4] = pk;
  }
}
DI void store_t(u16* dst, int ld, int col0, int rq, int c4, const float v[4][4], const float s[4]) {
#pragma unroll
  for (int j = 0; j < 4; ++j) {
    uint2 pk = {pack2(v[0][j] * s[0], v[1][j] * s[1]), pack2(v[2][j] * s[2], v[3][j] * s[3])};
    *(uint2*)&dst[(4 * c4 + j) * ld + col0 + 4 * rq] = pk;
  }
}

template <class TileSrc, class BiasF>
DI void attn_core(char* smem, const u16* qbase, int ntiles, TileSrc src, BiasF biasf, float m_init, bool has_sink, u16* obase) {
  u16* sK = (u16*)smem;
  u16* sVT = sK + 64 * LDT;
  const int tid = otid(), lane = tid & 63, w = tid >> 6, r = lane & 31, h = lane >> 5;
  const int rq = tid >> 4, c4 = tid & 15;
  const int ql = w * 32 + r;
  bf16x8 qf[4];
#pragma unroll
  for (int ks = 0; ks < 4; ++ks) qf[ks] = *(const bf16x8*)(qbase + (size_t)ql * DIN + ks * 16 + 8 * h);
  f32x16 O[2];
#pragma unroll
  for (int d = 0; d < 2; ++d)
#pragma unroll
    for (int i = 0; i < 16; ++i) O[d][i] = 0.f;
  float m = m_init, lsum = (has_sink && h == 0) ? 1.f : 0.f;
  const float one4[4] = {1.f, 1.f, 1.f, 1.f};

#pragma unroll 1
  for (int j = 0; j < ntiles; ++j) {
    const void *kp, *vp;
    int stride;
    bool isf32;
    if (!src(j, kp, vp, stride, isf32)) continue;
    __syncthreads();
    {
      float v[4][4];
      load4x4(kp, stride, isf32, rq, c4, v);
      store_n(sK, LDT, 0, rq, c4, v);
      load4x4(vp, stride, isf32, rq, c4, v);
      store_t(sVT, LDT, 0, rq, c4, v, one4);
    }
    __syncthreads();
    f32x16 S[2];
#pragma unroll
    for (int mt = 0; mt < 2; ++mt)
#pragma unroll
      for (int i = 0; i < 16; ++i) S[mt][i] = 0.f;
#pragma unroll
    for (int ks = 0; ks < 4; ++ks)
#pragma unroll
      for (int mt = 0; mt < 2; ++mt) {
        const bf16x8 kf = *(const bf16x8*)&sK[(mt * 32 + r) * LDT + ks * 16 + 8 * h];
        S[mt] = MFMA(kf, qf[ks], S[mt]);
      }
    float mx = NEG;
#pragma unroll
    for (int mt = 0; mt < 2; ++mt)
#pragma unroll
      for (int i = 0; i < 16; ++i) {
        const float s = S[mt][i] * 0.125f + biasf(j, mt * 32 + crow(i, h), ql);
        S[mt][i] = s;
        mx = fmaxf(mx, s);
      }
    mx = fmaxf(mx, __shfl_xor(mx, 32));
    const float mn = fmaxf(m, mx);
    const float alpha = __expf(m - mn);
    m = mn;
    float ps = 0.f;
#pragma unroll
    for (int mt = 0; mt < 2; ++mt)
#pragma unroll
      for (int i = 0; i < 16; ++i) {
        const float pv = __expf(S[mt][i] - mn);
        S[mt][i] = pv;
        ps += pv;
      }
    lsum = lsum * alpha + ps;
#pragma unroll
    for (int d = 0; d < 2; ++d)
#pragma unroll
      for (int i = 0; i < 16; ++i) O[d][i] *= alpha;
#pragma unroll
    for (int mt = 0; mt < 2; ++mt)
#pragma unroll
      for (int s = 0; s < 2; ++s) {
        const bf16x8 pf = mk8(pack2(S[mt][8 * s + 0], S[mt][8 * s + 1]), pack2(S[mt][8 * s + 2], S[mt][8 * s + 3]),
                              pack2(S[mt][8 * s + 4], S[mt][8 * s + 5]), pack2(S[mt][8 * s + 6], S[mt][8 * s + 7]));
#pragma unroll
        for (int d = 0; d < 2; ++d) {
          const u16* vrow = &sVT[(d * 32 + r) * LDT + mt * 32 + 16 * s + 4 * h];
          const uint2 lo = *(const uint2*)vrow;
          const uint2 hi = *(const uint2*)(vrow + 8);
          O[d] = MFMA(mk8(lo.x, lo.y, hi.x, hi.y), pf, O[d]);
        }
      }
  }
  const float l = lsum + __shfl_xor(lsum, 32);
  const float inv = 1.f / l;
#pragma unroll
  for (int d = 0; d < 2; ++d)
#pragma unroll
    for (int g = 0; g < 4; ++g) {
      uint2 pk = {pack2(O[d][4 * g + 0] * inv, O[d][4 * g + 1] * inv), pack2(O[d][4 * g + 2] * inv, O[d][4 * g + 3] * inv)};
      *(uint2*)(obase + (size_t)ql * DM + d * 32 + 8 * g + 4 * h) = pk;
    }
}

DI void phase0(const Params& p, char* smem) {
  const int tid = otid();
  if (blockIdx.x == 0) {
    for (int idx = tid; idx < 1024; idx += 256) {
      const int pos = idx >> 4, j = idx & 15;
      const double inv = 1.0 / pow(10000.0, (double)j / 16.0);
      const float ang = (float)((double)pos * inv);
      p.ROPE[idx] = cosf(ang);
      p.ROPE[1024 + idx] = sinf(ang);
    }
  }
  float* scond = (float*)smem;
  for (int item = blockIdx.x; item < 768; item += gridDim.x) {
    const int l = item / 384, ks = (item / 24) % 16, jb = item % 24;
    __syncthreads();
    for (int idx = tid; idx < 320; idx += 256) {
      const int c = idx / 64, k = ks * 64 + (idx & 63);
      const float v = (c == 0) ? p.c_ctx[k] : p.c[(c - 1) * DM + k];
      scond[idx] = silu(v);
    }
    __syncthreads();
    const int j = jb * 256 + tid;
    const float* wp = p.w_ada + ((size_t)l * DM + ks * 64) * 6144 + j;
    float a[5] = {0.f, 0.f, 0.f, 0.f, 0.f};
#pragma unroll 8
    for (int k = 0; k < 64; ++k) {
      const float wv = wp[(size_t)k * 6144];
#pragma unroll
      for (int c = 0; c < 5; ++c) a[c] += scond[c * 64 + k] * wv;
    }
    const float bias = (ks == 0) ? p.b_ada[l * 6144 + j] : 0.f;
#pragma unroll
    for (int c = 0; c < 5; ++c) unsafeAtomicAdd(&p.MOD[(l * 5 + c) * 6144 + j], a[c] + bias);
  }
}

DI int cond_of(int T) { return T < NCTX ? 0 : 1 + ((T - NCTX) >> 11); }

DI void phase1(const Params& p, char* smem, int l, const float* xc, const float* xl) {
  const float* W = p.w_in + (size_t)l * DM * DIN;
  for (int tile = blockIdx.x; tile < 96 * 20; tile += gridDim.x) {
    const int tm = tile / 20, tn = tile % 20;
    const int m0 = tm * 128, n0 = tn * 128;
    const bool lat = m0 >= NCTX;
    const float* xb = lat ? (xl + (size_t)(m0 - NCTX) * DM) : (xc + (size_t)m0 * DM);
    const float* mod = p.MOD + (size_t)(l * 5 + cond_of(m0)) * 6144;
    auto arow = [&](int r) { return xb + (size_t)r * DM; };
    auto bcol = [&](int n) { return W + n0 + n; };
    auto epi = [&](f32x16(&acc)[2][2], int wm, int wn, int r, int h) {
      const bool rope = lat && (n0 < 640);
#pragma unroll
      for (int mt = 0; mt < 2; ++mt)
#pragma unroll
        for (int nt = 0; nt < 2; ++nt) {
          const int n = n0 + wn * 64 + nt * 32 + r;
#pragma unroll
          for (int i = 0; i < 16; ++i) {
            const int T = m0 + wm * 64 + mt * 32 + crow(i, h);
            float v = acc[mt][nt][i];
            if (rope) {
              const int t = (T - NCTX) & 2047;
              const int pos = (nt == 0) ? (t >> 6) : (t & 63);
              const float cs = p.ROPE[pos * 16 + (r & 15)], sn = p.ROPE[1024 + pos * 16 + (r & 15)];
              const float o = __shfl_xor(v, 16);
              v = (r & 16) ? (o * sn + v * cs) : (v * cs - o * sn);
            }
            p.QKV[(size_t)T * DIN + n] = (u16)(pack2(v, 0.f) & 0xffffu);
            if (!lat) {
              const int b = T >> 8, t = T & 255;
              if (n0 == 512) p.out[OFF_AK + ((size_t)(b * 2 + l) * 256 + t) * 128 + (n - 512)] = v;
              else if (n0 == 640) p.out[OFF_AV + ((size_t)(b * 2 + l) * 256 + t) * 128 + (n - 640)] = v;
              else if (n0 == 1024 || n0 == 1152) p.out[OFF_BK + ((size_t)(b * 2 + l) * 256 + t) * 256 + (n - 1024)] = v;
              else if (n0 == 1280 || n0 == 1408) p.out[OFF_BV + ((size_t)(b * 2 + l) * 256 + t) * 256 + (n - 1280)] = v;
            }
          }
        }
    };
    gemm_tile<0>(smem, arow, mod + 1024, mod, bcol, DIN, epi);
  }
}

DI float ret_lg(const Params& p, int l, int dir, int head) { return -__expf(p.decay[(l * 2 + dir) * 4 + head]); }

DI size_t kvs_slot(int req, int head, int dir, int c) { return ((size_t)((req * 4 + head) * 2 + dir) * 16 + c) * 4096; }

DI void retkv_item(const Params& p, char* smem, int l, int req, int head, int c) {
  u16* sKTf = (u16*)smem;
  u16* sKTb = sKTf + 64 * LDT2;
  u16* sVT = sKTb + 64 * LDT2;
  const int tid = otid(), lane = tid & 63, w = tid >> 6, r = lane & 31, h = lane >> 5;
  const int rq = tid >> 4, c4 = tid & 15;
  const int T0 = (req < 16 ? req * 256 : NCTX + (req - 16) * 2048) + c * 128;
  const float lgf = ret_lg(p, l, 0, head), lgb = ret_lg(p, l, 1, head);
  const float one4[4] = {1.f, 1.f, 1.f, 1.f};
  __syncthreads();
#pragma unroll
  for (int half = 0; half < 2; ++half) {
    float v[4][4];
    float sf[4], sb[4];
#pragma unroll
    for (int i = 0; i < 4; ++i) {
      const int j = half * 64 + 4 * rq + i;
      sf[i] = 0.125f * __expf(lgf * (float)(127 - j));
      sb[i] = 0.125f * __expf(lgb * (float)j);
    }
    load4x4(p.QKV + (size_t)(T0 + half * 64) * DIN + 1792 + head * 64, DIN, false, rq, c4, v);
    store_t(sKTf, LDT2, half * 64, rq, c4, v, sf);
    store_t(sKTb, LDT2, half * 64, rq, c4, v, sb);
    load4x4(p.QKV + (size_t)(T0 + half * 64) * DIN + 2048 + head * 64, DIN, false, rq, c4, v);
    store_t(sVT, LDT2, half * 64, rq, c4, v, one4);
  }
  __syncthreads();
  const int dir = w >> 1, mt = w & 1;
  const u16* sKT = dir ? sKTb : sKTf;
  f32x16 acc[2];
#pragma unroll
  for (int nt = 0; nt < 2; ++nt)
#pragma unroll
    for (int i = 0; i < 16; ++i) acc[nt][i] = 0.f;
#pragma unroll
  for (int ks = 0; ks < 8; ++ks) {
    const bf16x8 fa = *(const bf16x8*)&sKT[(mt * 32 + r) * LDT2 + ks * 16 + 8 * h];
#pragma unroll
    for (int nt = 0; nt < 2; ++nt) {
      const bf16x8 fb = *(const bf16x8*)&sVT[(nt * 32 + r) * LDT2 + ks * 16 + 8 * h];
      acc[nt] = MFMA(fa, fb, acc[nt]);
    }
  }
  float* dst = p.KVS + kvs_slot(req, head, dir, c);
#pragma unroll
  for (int nt = 0; nt < 2; ++nt)
#pragma unroll
    for (int i = 0; i < 16; ++i) dst[(mt * 32 + crow(i, h)) * 64 + nt * 32 + r] = acc[nt][i];
}

DI void phase2(const Params& p, char* smem, int l) {
  const int tid = otid();
  for (int item = blockIdx.x; item < 1536; item += gridDim.x) {
    if (item < 512) {
      const int b = item >> 7, head = (item >> 4) & 7, qb = item & 15, kvh = head >> 2;
      const int T0 = NCTX + b * 2048 + qb * 128;
      const float* ck = p.cak + ((size_t)(b * 2 + l) * 512) * 128 + kvh * 64;
      const float* cv = p.cav + ((size_t)(b * 2 + l) * 512) * 128 + kvh * 64;
      auto src = [&](int j, const void*& kp, const void*& vp, int& stride, bool& isf32) -> bool {
        if (j < 8) {
          kp = ck + (size_t)j * 64 * 128; vp = cv + (size_t)j * 64 * 128; stride = 128; isf32 = true;
          return true;
        }
        const int jj = j - 8, kb = qb - 1 + (jj >> 1);
        if (kb < 0 || kb >= 16) return false;
        const int Tk = NCTX + b * 2048 + kb * 128 + (jj & 1) * 64;
        kp = p.QKV + (size_t)Tk * DIN + 512 + kvh * 64; vp = p.QKV + (size_t)Tk * DIN + 640 + kvh * 64; stride = DIN; isf32 = false;
        return true;
      };
      auto biasf = [&](int j, int key, int ql) -> float {
        if (j < 8) return 0.f;
        const int jj = j - 8;
        const int kj = (qb - 1 + (jj >> 1)) * 128 + (jj & 1) * 64 + key;
        const int qi = qb * 128 + ql;
        const int d = qi - kj;
        return (d <= 128 && d >= -128) ? 0.f : NEG;
      };
      attn_core(smem, p.QKV + (size_t)T0 * DIN + head * 64, 14, src, biasf, p.sink[l * 8 + head], true,
                p.CAT + (size_t)T0 * DM + head * 64);
    } else if (item < 768) {
      const int it = item - 512;
      const int b = it >> 6, head = (it >> 4) & 3, qb = it & 15;
      const int T0 = NCTX + b * 2048 + qb * 128;
      float* srpb = (float*)(smem + 2 * 64 * LDT * 2);
      __syncthreads();
      for (int idx = tid; idx < 465; idx += 256) srpb[idx] = p.rpb[(size_t)(l * 4 + head) * 465 + idx];
      const int r0 = 2 * qb;
      const int rmin = min(max(r0 - 4, 0), 24), rmax = min(max(r0 + 1 - 4, 0), 24) + 7;
      const float* ck = p.cbk + ((size_t)(b * 2 + l) * 512) * 256 + head * 64;
      const float* cv = p.cbv + ((size_t)(b * 2 + l) * 512) * 256 + head * 64;
      auto src = [&](int j, const void*& kp, const void*& vp, int& stride, bool& isf32) -> bool {
        if (j < 8) {
          kp = ck + (size_t)j * 64 * 256; vp = cv + (size_t)j * 64 * 256; stride = 256; isf32 = true;
          return true;
        }
        const int Tk = NCTX + b * 2048 + (rmin + j - 8) * 64;
        kp = p.QKV + (size_t)Tk * DIN + 1024 + head * 64; vp = p.QKV + (size_t)Tk * DIN + 1280 + head * 64; stride = DIN; isf32 = false;
        return true;
      };
      auto biasf = [&](int j, int key, int ql) -> float {
        if (j < 8) return 0.f;
        const int kr = rmin + j - 8, kc = key;
        const int qr = r0 + (ql >> 6), qc = ql & 63;
        const int rs = min(max(qr - 4, 0), 24), cs = min(max(qc - 8, 0), 48);
        const bool ok = (kr >= rs) && (kr < rs + 8) && (kc >= cs) && (kc < cs + 16);
        const int bi = ok ? ((kr - qr + 7) * 31 + (kc - qc + 15)) : 0;
        const float bv = srpb[bi];
        return ok ? bv : NEG;
      };
      attn_core(smem, p.QKV + (size_t)T0 * DIN + 768 + head * 64, 8 + (rmax - rmin + 1), src, biasf, NEG, false,
                p.CAT + (size_t)T0 * DM + 512 + head * 64);
    } else if (item < 1152) {
      const int it = item - 768;
      if (it < 256) retkv_item(p, smem, l, 16 + (it >> 6), (it >> 4) & 3, it & 15);
      else { const int i2 = it - 256; retkv_item(p, smem, l, i2 >> 3, (i2 >> 1) & 3, i2 & 1); }
    } else if (item < 1408) {
      const int it = item - 1152;
      const int b = it >> 4, head = (it >> 1) & 7, qh = it & 1, kvh = head >> 2;
      const int T0 = b * 256 + qh * 128;
      auto src = [&](int j, const void*& kp, const void*& vp, int& stride, bool& isf32) -> bool {
        const int Tk = b * 256 + j * 64;
        kp = p.QKV + (size_t)Tk * DIN + 512 + kvh * 64; vp = p.QKV + (size_t)Tk * DIN + 640 + kvh * 64; stride = DIN; isf32 = false;
        return true;
      };
      auto biasf = [&](int, int, int) -> float { return 0.f; };
      attn_core(smem, p.QKV + (size_t)T0 * DIN + head * 64, 4, src, biasf, p.sink[l * 8 + head], true,
                p.CAT + (size_t)T0 * DM + head * 64);
    } else {
      const int it = item - 1408;
      const int b = it >> 3, head = (it >> 1) & 3, qh = it & 1;
      const int T0 = b * 256 + qh * 128;
      auto src = [&](int j, const void*& kp, const void*& vp, int& stride, bool& isf32) -> bool {
        const int Tk = b * 256 + j * 64;
        kp = p.QKV + (size_t)Tk * DIN + 1024 + head * 64; vp = p.QKV + (size_t)Tk * DIN + 1280 + head * 64; stride = DIN; isf32 = false;
        return true;
      };
      auto biasf = [&](int, int, int) -> float { return 0.f; };
      attn_core(smem, p.QKV + (size_t)T0 * DIN + 768 + head * 64, 4, src, biasf, NEG, false,
                p.CAT + (size_t)T0 * DM + 512 + head * 64);
    }
  }
}

DI void phase2c(const Params& p, char* smem, int l) {
  u16* sK = (u16*)smem;
  u16* sVT = sK + 128 * LDT;
  u16* sSTf = sVT + 64 * LDT2;
  u16* sSTb = sSTf + 64 * LDT;
  const int tid = otid(), lane = tid & 63, w = tid >> 6, r = lane & 31, h = lane >> 5;
  const int rq = tid >> 4, c4 = tid & 15;
  const float one4[4] = {1.f, 1.f, 1.f, 1.f};
  for (int item = blockIdx.x; item < 384; item += gridDim.x) {
    int req, head, c, nc;
    if (item < 256) { req = 16 + (item >> 6); head = (item >> 4) & 3; c = item & 15; nc = 16; }
    else { const int i2 = item - 256; req = i2 >> 3; head = (i2 >> 1) & 3; c = i2 & 1; nc = 2; }
    const bool lat = req >= 16;
    const int T0 = (lat ? NCTX + (req - 16) * 2048 : req * 256) + c * 128;
    const float lgf = ret_lg(p, l, 0, head), lgb = ret_lg(p, l, 1, head);
    const float gf = __expf(lgf * 128.f), gb = __expf(lgb * 128.f);
    __syncthreads();
    {
      const int d = tid >> 2, e0 = (tid & 3) * 16;
#pragma unroll
      for (int dir = 0; dir < 2; ++dir) {
        float s[16];
#pragma unroll
        for (int q = 0; q < 16; ++q) s[q] = 0.f;
        const float g = dir ? gb : gf;
        if (lat) {
          const float* s0 = p.state + ((size_t)(((req - 16) * 2 + l) * 2 + dir) * 4 + head) * 4096 + d * 64 + e0;
#pragma unroll
          for (int q = 0; q < 16; q += 4) {
            const float4 x = *(const float4*)(s0 + q);
            s[q] = x.x; s[q + 1] = x.y; s[q + 2] = x.z; s[q + 3] = x.w;
          }
        }
        const int nsteps = dir ? (nc - 1 - c) : c;
        for (int st = 0; st < nsteps; ++st) {
          const int cc = dir ? (nc - 1 - st) : st;
          const float* kv = p.KVS + kvs_slot(req, head, dir, cc) + d * 64 + e0;
#pragma unroll
          for (int q = 0; q < 16; q += 4) {
            const float4 x = *(const float4*)(kv + q);
            s[q] = s[q] * g + x.x; s[q + 1] = s[q + 1] * g + x.y; s[q + 2] = s[q + 2] * g + x.z; s[q + 3] = s[q + 3] * g + x.w;
          }
        }
        u16* sST = dir ? sSTb : sSTf;
#pragma unroll
        for (int q = 0; q < 16; ++q) sST[(e0 + q) * LDT + d] = (u16)(pack2(s[q], 0.f) & 0xffffu);
        if (!lat && c == 0) {
          const float* k0 = p.KVS + kvs_slot(req, head, dir, 0) + d * 64 + e0;
          const float* k1 = p.KVS + kvs_slot(req, head, dir, 1) + d * 64 + e0;
          float* o = p.out + OFF_ST + ((size_t)((req * 2 + l) * 2 + dir) * 4 + head) * 4096 + d * 64 + e0;
#pragma unroll
          for (int q = 0; q < 16; ++q) o[q] = dir ? (gb * k1[q] + k0[q]) : (gf * k0[q] + k1[q]);
        }
      }
    }
#pragma unroll
    for (int half = 0; half < 2; ++half) {
      float v[4][4];
      load4x4(p.QKV + (size_t)(T0 + half * 64) * DIN + 1792 + head * 64, DIN, false, rq, c4, v);
      store_n(sK, LDT, half * 64, rq, c4, v);
      load4x4(p.QKV + (size_t)(T0 + half * 64) * DIN + 2048 + head * 64, DIN, false, rq, c4, v);
      store_t(sVT, LDT2, half * 64, rq, c4, v, one4);
    }
    __syncthreads();
    const int qi = w * 32 + r;
    const u16* qrow = p.QKV + (size_t)(T0 + qi) * DIN + 1536 + head * 64;
    uint4 qraw[4];
#pragma unroll
    for (int ks = 0; ks < 4; ++ks) qraw[ks] = *(const uint4*)(qrow + ks * 16 + 8 * h);
    f32x16 O[2];
#pragma unroll
    for (int d = 0; d < 2; ++d)
#pragma unroll
      for (int i = 0; i < 16; ++i) O[d][i] = 0.f;
#pragma unroll
    for (int jt = 0; jt < 4; ++jt) {
      f32x16 S;
#pragma unroll
      for (int i = 0; i < 16; ++i) S[i] = 0.f;
#pragma unroll
      for (int ks = 0; ks < 4; ++ks) {
        const bf16x8 kf = *(const bf16x8*)&sK[(jt * 32 + r) * LDT + ks * 16 + 8 * h];
        S = MFMA(kf, __builtin_bit_cast(bf16x8, qraw[ks]), S);
      }
#pragma unroll
      for (int i = 0; i < 16; ++i) {
        const int j = jt * 32 + crow(i, h);
        const int dlt = qi - j;
        const float wgt = (dlt > 0) ? __expf(lgf * (float)dlt) : ((dlt < 0) ? __expf(lgb * (float)(-dlt)) : 2.f);
        S[i] = S[i] * 0.125f * wgt;
      }
#pragma unroll
      for (int s = 0; s < 2; ++s) {
        const bf16x8 pf = mk8(pack2(S[8 * s + 0], S[8 * s + 1]), pack2(S[8 * s + 2], S[8 * s + 3]),
                              pack2(S[8 * s + 4], S[8 * s + 5]), pack2(S[8 * s + 6], S[8 * s + 7]));
#pragma unroll
        for (int d = 0; d < 2; ++d) {
          const u16* vrow = &sVT[(d * 32 + r) * LDT2 + jt * 32 + 16 * s + 4 * h];
          const uint2 lo = *(const uint2*)vrow;
          const uint2 hi = *(const uint2*)(vrow + 8);
          O[d] = MFMA(mk8(lo.x, lo.y, hi.x, hi.y), pf, O[d]);
        }
      }
    }
    {
      const float xf = __expf(lgf * (float)(qi + 1)), xb = __expf(lgb * (float)(128 - qi));
#pragma unroll
      for (int ks = 0; ks < 4; ++ks) {
        const uint4 q = qraw[ks];
        const bf16x8 qsf = mk8(pack2(bflo(q.x) * xf, bfhi(q.x) * xf), pack2(bflo(q.y) * xf, bfhi(q.y) * xf),
                               pack2(bflo(q.z) * xf, bfhi(q.z) * xf), pack2(bflo(q.w) * xf, bfhi(q.w) * xf));
        const bf16x8 qsb = mk8(pack2(bflo(q.x) * xb, bfhi(q.x) * xb), pack2(bflo(q.y) * xb, bfhi(q.y) * xb),
                               pack2(bflo(q.z) * xb, bfhi(q.z) * xb), pack2(bflo(q.w) * xb, bfhi(q.w) * xb));
#pragma unroll
        for (int d = 0; d < 2; ++d) {
          const bf16x8 sf = *(const bf16x8*)&sSTf[(d * 32 + r) * LDT + ks * 16 + 8 * h];
          const bf16x8 sb = *(const bf16x8*)&sSTb[(d * 32 + r) * LDT + ks * 16 + 8 * h];
          O[d] = MFMA(sf, qsf, O[d]);
          O[d] = MFMA(sb, qsb, O[d]);
        }
      }
    }
    float sum = 0.f;
#pragma unroll
    for (int d = 0; d < 2; ++d)
#pragma unroll
      for (int i = 0; i < 16; ++i) sum += O[d][i];
    sum += __shfl_xor(sum, 32);
    const float mu = sum * (1.f / 64.f);
    float vs = 0.f;
#pragma unroll
    for (int d = 0; d < 2; ++d)
#pragma unroll
      for (int i = 0; i < 16; ++i) { const float t = O[d][i] - mu; vs += t * t; }
    vs += __shfl_xor(vs, 32);
    const float rstd = rsqrtf(vs * (1.f / 64.f) + 1e-6f);
    const u16* grow = p.QKV + (size_t)(T0 + qi) * DIN + 2304 + head * 64;
    const float* gnw = p.gn + l * 256 + head * 64;
    u16* orow = p.CAT + (size_t)(T0 + qi) * DM + 768 + head * 64;
#pragma unroll
    for (int d = 0; d < 2; ++d)
#pragma unroll
      for (int g = 0; g < 4; ++g) {
        const int e = d * 32 + 8 * g + 4 * h;
        const uint2 gr = *(const uint2*)(grow + e);
        const float4 gw = *(const float4*)(gnw + e);
        const float o0 = silu(bflo(gr.x)) * (O[d][4 * g + 0] - mu) * rstd * gw.x;
        const float o1 = silu(bfhi(gr.x)) * (O[d][4 * g + 1] - mu) * rstd * gw.y;
        const float o2 = silu(bflo(gr.y)) * (O[d][4 * g + 2] - mu) * rstd * gw.z;
        const float o3 = silu(bfhi(gr.y)) * (O[d][4 * g + 3] - mu) * rstd * gw.w;
        uint2 pk = {pack2(o0, o1), pack2(o2, o3)};
        *(uint2*)(orow + e) = pk;
      }
  }
}

DI void phase3(const Params& p, char* smem, int l, const float* xc, const float* xl) {
  const float* W = p.w_out + (size_t)l * DM * DM;
  for (int tile = blockIdx.x; tile < 96 * 8; tile += gridDim.x) {
    const int tm = tile >> 3, tn = tile & 7;
    const int m0 = tm * 128, n0 = tn * 128;
    const bool lat = m0 >= NCTX;
    const float* xb = lat ? (xl + (size_t)(m0 - NCTX) * DM) : (xc + (size_t)m0 * DM);
    const float* g1 = p.MOD + (size_t)(l * 5 + cond_of(m0)) * 6144 + 2048;
    const u16* ab = p.CAT + (size_t)m0 * DM;
    auto arow = [&](int r) { return ab + (size_t)r * DM; };
    auto bcol = [&](int n) { return W + n0 + n; };
    auto epi = [&](f32x16(&acc)[2][2], int wm, int wn, int r, int h) {
#pragma unroll
      for (int mt = 0; mt < 2; ++mt)
#pragma unroll
        for (int nt = 0; nt < 2; ++nt) {
          const int n = n0 + wn * 64 + nt * 32 + r;
          const float g = g1[n];
#pragma unroll
          for (int i = 0; i < 16; ++i) {
            const int ml = wm * 64 + mt * 32 + crow(i, h);
            p.PRE[(size_t)(m0 + ml) * DM + n] = ALPHA * xb[(size_t)ml * DM + n] + g * acc[mt][nt][i];
          }
        }
    };
    gemm_tile<1>(smem, arow, nullptr, nullptr, bcol, DM, epi);
  }
}

DI void phase4(const Params& p, char* smem, int l) {
  float* swr = (float*)smem;
  const int tid = otid(), lane = tid & 63, w = tid >> 6;
  __syncthreads();
  for (int idx = tid; idx < 4096; idx += 256) {
    const float4 x = *(const float4*)(p.w_router + (size_t)l * DM * 16 + idx * 4);
    const int k = idx >> 2, e = (idx & 3) * 4;
    swr[(e + 0) * DM + k] = x.x; swr[(e + 1) * DM + k] = x.y; swr[(e + 2) * DM + k] = x.z; swr[(e + 3) * DM + k] = x.w;
  }
  __syncthreads();
  const float* lg = p.ln1g + l * DM;
  const float* lb = p.ln1b + l * DM;
  for (int T = blockIdx.x * 4 + w; T < NTOK; T += gridDim.x * 4) {
    const float* mod = p.MOD + (size_t)(l * 5 + cond_of(T)) * 6144;
    float4 x[4];
    float s = 0.f;
#pragma unroll
    for (int i = 0; i < 4; ++i) {
      x[i] = *(const float4*)(p.PRE + (size_t)T * DM + 256 * i + 4 * lane);
      s += x[i].x + x[i].y + x[i].z + x[i].w;
    }
    const float mu = wave_sum(s) * (1.f / 1024.f);
    float vs = 0.f;
#pragma unroll
    for (int i = 0; i < 4; ++i) {
      x[i].x -= mu; x[i].y -= mu; x[i].z -= mu; x[i].w -= mu;
      vs += x[i].x * x[i].x + x[i].y * x[i].y + x[i].z * x[i].z + x[i].w * x[i].w;
    }
    const float rstd = rsqrtf(wave_sum(vs) * (1.f / 1024.f) + 1e-6f);
#pragma unroll
    for (int i = 0; i < 4; ++i) {
      const int k = 256 * i + 4 * lane;
      const float4 g = *(const float4*)(lg + k), bb = *(const float4*)(lb + k);
      float4 y;
      y.x = x[i].x * rstd * g.x + bb.x; y.y = x[i].y * rstd * g.y + bb.y; y.z = x[i].z * rstd * g.z + bb.z; y.w = x[i].w * rstd * g.w + bb.w;
      *(float4*)(p.X + (size_t)T * DM + k) = y;
      const float4 sc = *(const float4*)(mod + 4096 + k), sh = *(const float4*)(mod + 3072 + k);
      float4 hh;
      hh.x = y.x * (1.f + sc.x) + sh.x; hh.y = y.y * (1.f + sc.y) + sh.y; hh.z = y.z * (1.f + sc.z) + sh.z; hh.w = y.w * (1.f + sc.w) + sh.w;
      uint2 pk = {pack2(hh.x, hh.y), pack2(hh.z, hh.w)};
      *(uint2*)(p.H2 + (size_t)T * DM + k) = pk;
      x[i] = hh;
      const float4 z = {0.f, 0.f, 0.f, 0.f};
      *(float4*)(p.PRE + (size_t)T * DM + k) = z;
    }
    float mine = NEG;
#pragma unroll 1
    for (int e = 0; e < 16; ++e) {
      float a = 0.f;
#pragma unroll
      for (int i = 0; i < 4; ++i) {
        const float4 wv = *(const float4*)(swr + e * DM + 256 * i + 4 * lane);
        a += x[i].x * wv.x + x[i].y * wv.y + x[i].z * wv.z + x[i].w * wv.w;
      }
      a = wave_sum(a);
      mine = (lane == e) ? a : mine;
    }
    float mx = mine;
#pragma unroll
    for (int o = 8; o >= 1; o >>= 1) mx = fmaxf(mx, __shfl_xor(mx, o));
    const float ex = __expf(mine - mx);
    float den = ex;
#pragma unroll
    for (int o = 8; o >= 1; o >>= 1) den += __shfl_xor(den, o);
    mine = ex / den;
    if (lane < 16) p.AFF[(size_t)T * 16 + lane] = mine;
  }
}

DI void phase5(const Params& p, char* smem) {
  float* sa = (float*)smem;
  const int tid = otid();
  for (int item = blockIdx.x; item < 768; item += gridDim.x) {
    int n, base, e, t, cap, rowbase;
    if (item < 512) {
      const int b = item >> 7; e = (item >> 3) & 15; const int seg = item & 7;
      n = 2048; base = NCTX + b * 2048; t = seg * 256 + tid; cap = 256; rowbase = 512 + b * 256;
    } else {
      const int it = item - 512; const int rq = it >> 4; e = it & 15;
      n = 256; base = rq * 256; t = tid; cap = 32; rowbase = rq * 32;
    }
    __syncthreads();
    for (int j = tid; j < n; j += 256) sa[j] = p.AFF[(size_t)(base + j) * 16 + e];
    __syncthreads();
    const float a = sa[t];
    int rank = 0;
    for (int j = 0; j < n; j += 4) {
      const float4 v = *(const float4*)(sa + j);
      rank += (v.x > a || (v.x == a && j < t)) ? 1 : 0;
      rank += (v.y > a || (v.y == a && j + 1 < t)) ? 1 : 0;
      rank += (v.z > a || (v.z == a && j + 2 < t)) ? 1 : 0;
      rank += (v.w > a || (v.w == a && j + 3 < t)) ? 1 : 0;
    }
    if (rank < cap) {
      p.SELTOK[e * NROWS_E + rowbase + rank] = base + t;
      p.SELGATE[e * NROWS_E + rowbase + rank] = a;
    }
  }
}

DI void phase6(const Params& p, char* smem, int l) {
  for (int tile = blockIdx.x; tile < 16 * 12 * 16; tile += gridDim.x) {
    const int e = tile / 192, rem = tile % 192, tn = rem / 12, tm = rem % 12;
    const int m0 = tm * 128, f0 = tn * 64;
    const float* W = p.w_gu + ((size_t)l * 16 + e) * DM * 2048;
    const int* tok = p.SELTOK + e * NROWS_E + m0;
    auto arow = [&](int r) { return p.H2 + (size_t)tok[r] * DM; };
    auto bcol = [&](int n) { return W + ((n >> 5) & 1) * 1024 + f0 + (n >> 6) * 32 + (n & 31); };
    u16* act = p.ACT + ((size_t)e * NROWS_E + m0) * DM;
    auto epi = [&](f32x16(&acc)[2][2], int wm, int wn, int r, int h) {
#pragma unroll
      for (int mt = 0; mt < 2; ++mt)
#pragma unroll
        for (int i = 0; i < 16; ++i) {
          const int ml = wm * 64 + mt * 32 + crow(i, h);
          const float v = silu(acc[mt][0][i]) * acc[mt][1][i];
          act[(size_t)ml * DM + f0 + wn * 32 + r] = (u16)(pack2(v, 0.f) & 0xffffu);
        }
    };
    gemm_tile<1>(smem, arow, nullptr, nullptr, bcol, 2048, epi);
  }
}

DI void phase7(const Params& p, char* smem, int l) {
  float* FF = p.PRE;
  for (int tile = blockIdx.x; tile < 16 * 12 * 8; tile += gridDim.x) {
    const int e = tile / 96, rem = tile % 96, tn = rem / 12, tm = rem % 12;
    const int m0 = tm * 128, n0 = tn * 128;
    const float* W = p.w_down + ((size_t)l * 16 + e) * DM * DM;
    const u16* ab = p.ACT + ((size_t)e * NROWS_E + m0) * DM;
    const int* tok = p.SELTOK + e * NROWS_E + m0;
    const float* gate = p.SELGATE + e * NROWS_E + m0;
    auto arow = [&](int r) { return ab + (size_t)r * DM; };
    auto bcol = [&](int n) { return W + n0 + n; };
    auto epi = [&](f32x16(&acc)[2][2], int wm, int wn, int r, int h) {
#pragma unroll
      for (int mt = 0; mt < 2; ++mt)
#pragma unroll
        for (int i = 0; i < 16; ++i) {
          const int ml = wm * 64 + mt * 32 + crow(i, h);
          const int T = tok[ml];
          const float g = gate[ml];
#pragma unroll
          for (int nt = 0; nt < 2; ++nt) unsafeAtomicAdd(&FF[(size_t)T * DM + n0 + wn * 64 + nt * 32 + r], g * acc[mt][nt][i]);
        }
    };
    gemm_tile<1>(smem, arow, nullptr, nullptr, bcol, DM, epi);
  }
}

DI void phase8(const Params& p, int l, float* dst) {
  const int tid = otid(), lane = tid & 63, w = tid >> 6;
  const float* lg = p.ln2g + l * DM;
  const float* lb = p.ln2b + l * DM;
  for (int T = blockIdx.x * 4 + w; T < NTOK; T += gridDim.x * 4) {
    const float* g2 = p.MOD + (size_t)(l * 5 + cond_of(T)) * 6144 + 5120;
    float4 x[4];
    float s = 0.f;
#pragma unroll
    for (int i = 0; i < 4; ++i) {
      const int k = 256 * i + 4 * lane;
      const float4 a = *(const float4*)(p.X + (size_t)T * DM + k);
      const float4 f = *(const float4*)(p.PRE + (size_t)T * DM + k);
      const float4 g = *(const float4*)(g2 + k);
      x[i].x = ALPHA * a.x + g.x * f.x; x[i].y = ALPHA * a.y + g.y * f.y; x[i].z = ALPHA * a.z + g.z * f.z; x[i].w = ALPHA * a.w + g.w * f.w;
      s += x[i].x + x[i].y + x[i].z + x[i].w;
    }
    const float mu = wave_sum(s) * (1.f / 1024.f);
    float vs = 0.f;
#pragma unroll
    for (int i = 0; i < 4; ++i) {
      x[i].x -= mu; x[i].y -= mu; x[i].z -= mu; x[i].w -= mu;
      vs += x[i].x * x[i].x + x[i].y * x[i].y + x[i].z * x[i].z + x[i].w * x[i].w;
    }
    const float rstd = rsqrtf(wave_sum(vs) * (1.f / 1024.f) + 1e-6f);
#pragma unroll
    for (int i = 0; i < 4; ++i) {
      const int k = 256 * i + 4 * lane;
      const float4 g = *(const float4*)(lg + k), bb = *(const float4*)(lb + k);
      float4 y;
      y.x = x[i].x * rstd * g.x + bb.x; y.y = x[i].y * rstd * g.y + bb.y; y.z = x[i].z * rstd * g.z + bb.z; y.w = x[i].w * rstd * g.w + bb.w;
      *(float4*)(dst + (size_t)T * DM + k) = y;
    }
  }
}

__global__ void __launch_bounds__(256, 1) mega(Params p) {
  __shared__ __attribute__((aligned(16))) char smem[65536];
  cg::grid_group grid = cg::this_grid();
  phase0(p, smem);
  grid.sync();
#pragma unroll 1
  for (int l = 0; l < 2; ++l) {
    const float* xc = (l == 0) ? p.x_prompt : p.X;
    const float* xl = (l == 0) ? p.x_sample : (p.X + (size_t)NCTX * DM);
    phase1(p, smem, l, xc, xl);
    grid.sync();
    phase2(p, smem, l);
    grid.sync();
    phase2c(p, smem, l);
    grid.sync();
    phase3(p, smem, l, xc, xl);
    grid.sync();
    phase4(p, smem, l);
    grid.sync();
    phase5(p, smem);
    grid.sync();
    phase6(p, smem, l);
    grid.sync();
    phase7(p, smem, l);
    grid.sync();
    phase8(p, l, (l == 1) ? p.out : p.X);
    grid.sync();
  }
}

extern "C" void kernel_launch(void* const* d_in, const int* in_sizes, int n_in, void* d_out, int out_size, void* d_ws,
                              size_t ws_size, hipStream_t stream) {
  static int grid_blocks = 0;
  if (!grid_blocks) {
    int dev = 0, cus = 0, per_cu = 0;
    hipGetDevice(&dev);
    hipDeviceGetAttribute(&cus, hipDeviceAttributeMultiprocessorCount, dev);
    hipOccupancyMaxActiveBlocksPerMultiprocessor(&per_cu, mega, 256, 0);
    if (per_cu > 1) per_cu = 1;
    if (per_cu < 1) per_cu = 1;
    grid_blocks = cus * per_cu;
  }
  Params p{};
  const float** pf = (const float**)&p;
  for (int i = 0; i < 24; ++i) pf[i] = (const float*)d_in[i];
  p.out = (float*)d_out;
  char* ws = (char*)d_ws;
  size_t off = 0;
  auto take = [&](size_t bytes) { char* q = ws + off; off += (bytes + 255) & ~(size_t)255; return q; };
  p.MOD = (float*)take(2 * 5 * 6144 * 4);
  p.ROPE = (float*)take(2048 * 4);
  p.X = (float*)take((size_t)NTOK * DM * 4);
  p.PRE = (float*)take((size_t)NTOK * DM * 4);
  p.KVS = (float*)take((size_t)20 * 4 * 2 * 16 * 4096 * 4);
  p.AFF = (float*)take((size_t)NTOK * 16 * 4);
  p.SELGATE = (float*)take((size_t)16 * NROWS_E * 4);
  p.SELTOK = (int*)take((size_t)16 * NROWS_E * 4);
  p.QKV = (u16*)take((size_t)NTOK * DIN * 2);
  p.CAT = (u16*)take((size_t)NTOK * DM * 2);
  p.H2 = (u16*)take((size_t)NTOK * DM * 2);
  p.ACT = (u16*)take((size_t)16 * NROWS_E * DM * 2);
  hipMemsetAsync(p.MOD, 0, 2 * 5 * 6144 * 4, stream);
  void* args[] = {&p};
  hipError_t e = hipLaunchCooperativeKernel((void*)mega, dim3(grid_blocks), dim3(256), args, 0, stream);
  if (e != hipSuccess) fprintf(stderr, "cooperative launch failed: %s (grid %d)\n", hipGetErrorString(e), grid_blocks);
}
```

```cpp
#include <hip/hip_runtime.h>
#include <hip/hip_cooperative_groups.h>
#include <cstdio>
namespace cg = cooperative_groups;

#define DI __device__ __forceinline__
typedef short bf16x8 __attribute__((ext_vector_type(8)));
typedef float f32x16 __attribute__((ext_vector_type(16)));
typedef __bf16 bf2_t __attribute__((ext_vector_type(2)));
typedef float f2_t __attribute__((ext_vector_type(2)));
typedef unsigned short u16;
typedef unsigned u32x4 __attribute__((ext_vector_type(4)));
typedef float f32x4 __attribute__((ext_vector_type(4)));
typedef float f32x2 __attribute__((ext_vector_type(2)));

#define MFMA(a, b, c) __builtin_amdgcn_mfma_f32_32x32x16_bf16((a), (b), (c), 0, 0, 0)

#define PROBE 4
constexpr int NTOK = 12288;
constexpr int NCTX = 4096;
constexpr int DM = 1024;
constexpr int DIN = 2560;
constexpr int LDT = 72;
constexpr int LDT2 = 136;
constexpr int NROWS_E = 1536;
constexpr float NEG = -1e30f;
constexpr float ALPHA = 1.41421356237f;

constexpr size_t OFF_AK = 12582912, OFF_AV = 13631488, OFF_BK = 14680064, OFF_BV = 16777216, OFF_ST = 18874368;

struct Params {
  const float *x_prompt, *x_sample, *cak, *cav, *cbk, *cbv, *state, *c, *c_ctx, *w_ada, *b_ada, *w_in, *w_out, *sink, *rpb,
      *decay, *gn, *ln1g, *ln1b, *ln2g, *ln2b, *w_router, *w_gu, *w_down;
  float* out;
  float *MOD, *ROPE, *X, *PRE, *KVS, *AFF, *SELGATE;
  int* SELTOK;
  u16 *QKV, *CAT, *H2, *ACT;
  float* YE;
  int* INV;
  unsigned* BAR;
  long never;
};

DI unsigned pack2(float a, float b) {
  f2_t v = {a, b};
  bf2_t r = __builtin_convertvector(v, bf2_t);
  return __builtin_bit_cast(unsigned, r);
}
DI int otid() { int x = threadIdx.x; asm volatile("" : "+v"(x)); return x; }
DI float bflo(unsigned u) { return __uint_as_float(u << 16); }
DI float bfhi(unsigned u) { return __uint_as_float(u & 0xffff0000u); }
DI int crow(int i, int h) { return (i & 3) + 8 * (i >> 2) + 4 * h; }
DI float silu(float x) { return x / (1.f + __expf(-x)); }
DI float wave_sum(float v) {
#pragma unroll
  for (int o = 32; o >= 1; o >>= 1) v += __shfl_xor(v, o);
  return v;
}
DI bf16x8 mk8(unsigned a, unsigned b, unsigned c, unsigned d) {
  uint4 u = {a, b, c, d};
  return __builtin_bit_cast(bf16x8, u);
}


#define XB_TMO 128
#define XB_XCNT(j) (256 + 64 * (j))
#define XB_XSUB(j) (1280 + 64 * (j))
#define XB_XGEN(j) (2304 + 64 * (j))
#define XB_TOP 3328
#define XB_TOPGEN 3392
#define XCD_BAR_WORDS 3456
#define XB_SPIN_CAP (1u << 20)
DI unsigned xb_ld(unsigned* p) { return __hip_atomic_load(p, __ATOMIC_RELAXED, __HIP_MEMORY_SCOPE_AGENT); }
DI unsigned xb_add(unsigned* p, unsigned v) { return __hip_atomic_fetch_add(p, v, __ATOMIC_RELAXED, __HIP_MEMORY_SCOPE_AGENT); }
DI unsigned xb_xcc_id() { return (unsigned)__builtin_amdgcn_s_getreg((3 << 11) | 20) & 0xFu; }
#define XB_SPIN(cond, bar)                                                            \
  do {                                                                                \
    unsigned _sp = 0;                                                                 \
    while (cond) {                                                                    \
      __builtin_amdgcn_s_sleep(1);                                                    \
      if ((++_sp & 255u) == 0u) {                                                     \
        if (xb_ld(&(bar)[XB_TMO])) break;                                             \
        if (_sp > XB_SPIN_CAP) { atomicAdd(&(bar)[XB_TMO], 1u); break; }              \
      }                                                                               \
    }                                                                                 \
  } while (0)
struct GBar { unsigned* bar; unsigned x, nloc, nx; };
DI void gbar_complete(unsigned* bar, unsigned x, unsigned& nloc, unsigned& nx) {
  const unsigned G = gridDim.x;
  unsigned sum, cnt, mine, sp = 0u;
  for (;;) {
    sum = 0u; cnt = 0u; mine = 0u;
#pragma unroll
    for (unsigned j = 0; j < 16; ++j) {
      const unsigned c = xb_ld(&bar[XB_XCNT(j)]);
      sum += c; cnt += (c > 0u) ? 1u : 0u; mine = (j == x) ? c : mine;
    }
    if (sum == G) break;
    __builtin_amdgcn_s_sleep(1);
    if ((++sp & 255u) == 0u) {
      if (xb_ld(&bar[XB_TMO])) break;
      if (sp > XB_SPIN_CAP) { atomicAdd(&bar[XB_TMO], 1u); break; }
    }
  }
  nloc = mine > 0u ? mine : 1u;
  nx = cnt > 0u ? cnt : 1u;
}
DI void gbar(GBar& b) {
  asm volatile("s_waitcnt vmcnt(0)" ::: "memory");
  __syncthreads();
  if (threadIdx.x == 0) {
    unsigned* bar = b.bar;
    __builtin_amdgcn_s_waitcnt(0);
    if (b.nloc == 0u) gbar_complete(bar, b.x, b.nloc, b.nx);
    const unsigned nloc = b.nloc, nx = b.nx;
    const unsigned old = xb_add(&bar[XB_XSUB(b.x)], 1u);
    const unsigned gen = old / nloc;
    if (old + 1u == (gen + 1u) * nloc) {
      __builtin_amdgcn_fence(__ATOMIC_RELEASE, "agent");
      asm volatile("s_waitcnt vmcnt(0)" ::: "memory");
      const unsigned og = xb_add(&bar[XB_TOP], 1u);
      const unsigned tg = og / nx;
      if (og + 1u == (tg + 1u) * nx) xb_add(&bar[XB_TOPGEN], 1u);
      else XB_SPIN(xb_ld(&bar[XB_TOPGEN]) == tg, bar);
      __builtin_amdgcn_fence(__ATOMIC_ACQUIRE, "agent");
      xb_add(&bar[XB_XGEN(b.x)], 1u);
      asm volatile("s_waitcnt vmcnt(0)" ::: "memory");
    } else {
      XB_SPIN(xb_ld(&bar[XB_XGEN(b.x)]) == gen, bar);
      __builtin_amdgcn_fence(__ATOMIC_ACQUIRE, "agent");
      asm volatile("s_waitcnt vmcnt(0)" ::: "memory");
    }
  }
  __syncthreads();
}

template <class ARow, class BCol, class Epi>
DI void gemm_tile(char* smem, ARow arow, BCol bcol4, int ldb, Epi epi) {
  u16* sA = (u16*)smem;
  u16* sB = sA + 128 * LDT;
  const int tid = otid(), lane = tid & 63, w = tid >> 6, r = lane & 31, h = lane >> 5;
  const int wm = w >> 1, wn = w & 1;
  f32x16 acc[2][2];
#pragma unroll
  for (int a = 0; a < 2; ++a)
#pragma unroll
    for (int b = 0; b < 2; ++b)
#pragma unroll
      for (int i = 0; i < 16; ++i) acc[a][b][i] = 0.f;

  const int a_r0 = tid >> 3, a_c = (tid & 7) * 8;
  const u16* apb0 = (const u16*)arow(a_r0) + a_c;
  const u16* apb1 = (const u16*)arow(a_r0 + 32) + a_c;
  const u16* apb2 = (const u16*)arow(a_r0 + 64) + a_c;
  const u16* apb3 = (const u16*)arow(a_r0 + 96) + a_c;
  const int b_n4 = tid & 31, b_kq = tid >> 5;
  const float* bp = bcol4(b_n4) + (size_t)(b_kq * 8) * ldb;

  u32x4 ab0, ab1, ab2, ab3;
  f32x4 bv[8];

#pragma unroll 1
  for (int kt = 0; kt <= 16; ++kt) {
    if (kt < 16) {
      const int k0 = kt * 64;
      ab0 = *(const u32x4*)(apb0 + k0);
      ab1 = *(const u32x4*)(apb1 + k0);
      ab2 = *(const u32x4*)(apb2 + k0);
      ab3 = *(const u32x4*)(apb3 + k0);
#pragma unroll
      for (int i = 0; i < 8; ++i) bv[i] = *(const f32x4*)(bp + (size_t)(k0 + i) * ldb);
    }
    if (kt > 0) {
#pragma unroll
      for (int ks = 0; ks < 4; ++ks) {
        bf16x8 fa[2], fb[2];
#pragma unroll
        for (int mt = 0; mt < 2; ++mt) fa[mt] = *(const bf16x8*)&sA[(wm * 64 + mt * 32 + r) * LDT + ks * 16 + 8 * h];
#pragma unroll
        for (int nt = 0; nt < 2; ++nt) fb[nt] = *(const bf16x8*)&sB[(wn * 64 + nt * 32 + r) * LDT + ks * 16 + 8 * h];
#pragma unroll
        for (int mt = 0; mt < 2; ++mt)
#pragma unroll
          for (int nt = 0; nt < 2; ++nt) acc[mt][nt] = MFMA(fa[mt], fb[nt], acc[mt][nt]);
      }
    }
    __syncthreads();
    if (kt < 16) {
      *(u32x4*)&sA[(a_r0)*LDT + a_c] = ab0;
      *(u32x4*)&sA[(a_r0 + 32) * LDT + a_c] = ab1;
      *(u32x4*)&sA[(a_r0 + 64) * LDT + a_c] = ab2;
      *(u32x4*)&sA[(a_r0 + 96) * LDT + a_c] = ab3;
#pragma unroll
      for (int j = 0; j < 4; ++j) {
        u32x4 pk;
        pk.x = pack2(bv[0][j], bv[1][j]);
        pk.y = pack2(bv[2][j], bv[3][j]);
        pk.z = pack2(bv[4][j], bv[5][j]);
        pk.w = pack2(bv[6][j], bv[7][j]);
        *(u32x4*)&sB[(j * 32 + b_n4) * LDT + b_kq * 8] = pk;
      }
    }
    __syncthreads();
  }
  epi(acc, wm, wn, r, h);
}

DI void load4x4(const void* base, int stride, bool isf32, int rq, int c4, float v[4][4]) {
  if (isf32) {
#pragma unroll
    for (int i = 0; i < 4; ++i) {
      const float4 x = *(const float4*)((const float*)base + (size_t)(4 * rq + i) * stride + 4 * c4);
      v[i][0] = x.x; v[i][1] = x.y; v[i][2] = x.z; v[i][3] = x.w;
    }
  } else {
#pragma unroll
    for (int i = 0; i < 4; ++i) {
      const uint2 x = *(const uint2*)((const u16*)base + (size_t)(4 * rq + i) * stride + 4 * c4);
      v[i][0] = bflo(x.x); v[i][1] = bfhi(x.x); v[i][2] = bflo(x.y); v[i][3] = bfhi(x.y);
    }
  }
}
DI void store_n(u16* dst, int ld, int row0, int rq, int c4, const float v[4][4]) {
#pragma unroll
  for (int i = 0; i < 4; ++i) {
    uint2 pk = {pack2(v[i][0], v[i][1]), pack2(v[i][2], v[i][3])};
    *(uint2*)&dst[(row0 + 4 * rq + i) * ld + 4 * c4] = pk;
  }
}
DI void store_t(u16* dst, int ld, int col0, int rq, int c4, const float v[4][4], const float s[4]) {
#pragma unroll
  for (int j = 0; j < 4; ++j) {
    uint2 pk = {pack2(v[0][j] * s[0], v[1][j] * s[1]), pack2(v[2][j] * s[2], v[3][j] * s[3])};
    *(uint2*)&dst[(4 * c4 + j) * ld + col0 + 4 * rq] = pk;
  }
}

template <class TileSrc, class BiasF>
DI void attn_core(char* smem, const u16* qbase, int ntiles, TileSrc src, BiasF biasf, float m_init, bool has_sink, u16* obase) {
  u16* sK = (u16*)smem;
  u16* sVT = sK + 64 * LDT;
  const int tid = otid(), lane = tid & 63, w = tid >> 6, r = lane & 31, h = lane >> 5;
  const int rq = tid >> 4, c4 = tid & 15;
  const int ql = w * 32 + r;
  bf16x8 qf[4];
#pragma unroll
  for (int ks = 0; ks < 4; ++ks) qf[ks] = *(const bf16x8*)(qbase + (size_t)ql * DIN + ks * 16 + 8 * h);
  f32x16 O[2];
#pragma unroll
  for (int d = 0; d < 2; ++d)
#pragma unroll
    for (int i = 0; i < 16; ++i) O[d][i] = 0.f;
  float m = m_init, lsum = (has_sink && h == 0) ? 1.f : 0.f;
  const float one4[4] = {1.f, 1.f, 1.f, 1.f};

#pragma unroll 1
  for (int j = 0; j < ntiles; ++j) {
    const void *kp, *vp;
    int stride;
    bool isf32;
    if (!src(j, kp, vp, stride, isf32)) continue;
    __syncthreads();
    {
      float v[4][4];
      load4x4(kp, stride, isf32, rq, c4, v);
      store_n(sK, LDT, 0, rq, c4, v);
      load4x4(vp, stride, isf32, rq, c4, v);
      store_t(sVT, LDT, 0, rq, c4, v, one4);
    }
    __syncthreads();
    f32x16 S[2];
#pragma unroll
    for (int mt = 0; mt < 2; ++mt)
#pragma unroll
      for (int i = 0; i < 16; ++i) S[mt][i] = 0.f;
#pragma unroll
    for (int ks = 0; ks < 4; ++ks)
#pragma unroll
      for (int mt = 0; mt < 2; ++mt) {
        const bf16x8 kf = *(const bf16x8*)&sK[(mt * 32 + r) * LDT + ks * 16 + 8 * h];
        S[mt] = MFMA(kf, qf[ks], S[mt]);
      }
    float mx = NEG;
#pragma unroll
    for (int mt = 0; mt < 2; ++mt)
#pragma unroll
      for (int i = 0; i < 16; ++i) {
        const float s = S[mt][i] * 0.125f + biasf(j, mt * 32 + crow(i, h), ql);
        S[mt][i] = s;
        mx = fmaxf(mx, s);
      }
    mx = fmaxf(mx, __shfl_xor(mx, 32));
    const float mn = fmaxf(m, mx);
    const float alpha = __expf(m - mn);
    m = mn;
    float ps = 0.f;
#pragma unroll
    for (int mt = 0; mt < 2; ++mt)
#pragma unroll
      for (int i = 0; i < 16; ++i) {
        const float pv = __expf(S[mt][i] - mn);
        S[mt][i] = pv;
        ps += pv;
      }
    lsum = lsum * alpha + ps;
#pragma unroll
    for (int d = 0; d < 2; ++d)
#pragma unroll
      for (int i = 0; i < 16; ++i) O[d][i] *= alpha;
#pragma unroll
    for (int mt = 0; mt < 2; ++mt)
#pragma unroll
      for (int s = 0; s < 2; ++s) {
        const bf16x8 pf = mk8(pack2(S[mt][8 * s + 0], S[mt][8 * s + 1]), pack2(S[mt][8 * s + 2], S[mt][8 * s + 3]),
                              pack2(S[mt][8 * s + 4], S[mt][8 * s + 5]), pack2(S[mt][8 * s + 6], S[mt][8 * s + 7]));
#pragma unroll
        for (int d = 0; d < 2; ++d) {
          const u16* vrow = &sVT[(d * 32 + r) * LDT + mt * 32 + 16 * s + 4 * h];
          const uint2 lo = *(const uint2*)vrow;
          const uint2 hi = *(const uint2*)(vrow + 8);
          O[d] = MFMA(mk8(lo.x, lo.y, hi.x, hi.y), pf, O[d]);
        }
      }
  }
  const float l = lsum + __shfl_xor(lsum, 32);
  const float inv = 1.f / l;
#pragma unroll
  for (int d = 0; d < 2; ++d)
#pragma unroll
    for (int g = 0; g < 4; ++g) {
      uint2 pk = {pack2(O[d][4 * g + 0] * inv, O[d][4 * g + 1] * inv), pack2(O[d][4 * g + 2] * inv, O[d][4 * g + 3] * inv)};
      *(uint2*)(obase + (size_t)ql * DM + d * 32 + 8 * g + 4 * h) = pk;
    }
}

DI void phase0(const Params& p, char* smem) {
  const int tid = otid();
  if (blockIdx.x == 0) {
    for (int idx = tid; idx < 1024; idx += 256) {
      const int pos = idx >> 4, j = idx & 15;
      const double inv = 1.0 / pow(10000.0, (double)j / 16.0);
      const float ang = (float)((double)pos * inv);
      p.ROPE[idx] = cosf(ang);
      p.ROPE[1024 + idx] = sinf(ang);
    }
  }
  float* scond = (float*)smem;
  for (int item = blockIdx.x; item < 768; item += gridDim.x) {
    const int l = item / 384, ks = (item / 24) % 16, jb = item % 24;
    __syncthreads();
    for (int idx = tid; idx < 320; idx += 256) {
      const int c = idx / 64, k = ks * 64 + (idx & 63);
      const float v = (c == 0) ? p.c_ctx[k] : p.c[(c - 1) * DM + k];
      scond[idx] = silu(v);
    }
    __syncthreads();
    const int j = jb * 256 + tid;
    const float* wp = p.w_ada + ((size_t)l * DM + ks * 64) * 6144 + j;
    float a[5] = {0.f, 0.f, 0.f, 0.f, 0.f};
#pragma unroll 8
    for (int k = 0; k < 64; ++k) {
      const float wv = wp[(size_t)k * 6144];
#pragma unroll
      for (int c = 0; c < 5; ++c) a[c] += scond[c * 64 + k] * wv;
    }
    const float bias = (ks == 0) ? p.b_ada[l * 6144 + j] : 0.f;
#pragma unroll
    for (int c = 0; c < 5; ++c) unsafeAtomicAdd(&p.MOD[(l * 5 + c) * 6144 + j], a[c] + bias);
  }
}

DI int cond_of(int T) { return T < NCTX ? 0 : 1 + ((T - NCTX) >> 11); }

DI void phase0b(const Params& p) {
  const int tid = otid(), lane = tid & 63, w = tid >> 6;
  for (int T = blockIdx.x * 4 + w; T < NTOK; T += gridDim.x * 4) {
    const float* mod = p.MOD + (size_t)cond_of(T) * 6144;
    const float* xr = (T < NCTX) ? (p.x_prompt + (size_t)T * DM) : (p.x_sample + (size_t)(T - NCTX) * DM);
#pragma unroll
    for (int i = 0; i < 4; ++i) {
      const int k = 256 * i + 4 * lane;
      const float4 x = *(const float4*)(xr + k);
      const float4 sc = *(const float4*)(mod + 1024 + k), sh = *(const float4*)(mod + k);
      uint2 pk = {pack2(x.x * (1.f + sc.x) + sh.x, x.y * (1.f + sc.y) + sh.y), pack2(x.z * (1.f + sc.z) + sh.z, x.w * (1.f + sc.w) + sh.w)};
      *(uint2*)(p.H2 + (size_t)T * DM + k) = pk;
    }
  }
}

DI void phase1(const Params& p, char* smem, int l) {
  const float* W = p.w_in + (size_t)l * DM * DIN;
  const int xcd = blockIdx.x & 7, nloc = gridDim.x >> 3;
  for (int s = blockIdx.x >> 3; s < 240; s += nloc) {
    const int tm = 12 * xcd + s % 12, tn = s / 12;
    const int m0 = tm * 128, n0 = tn * 128;
    const bool lat = m0 >= NCTX;
    const u16* ab = p.H2 + (size_t)m0 * DM;
    auto arow = [&](int r) { return ab + (size_t)r * DM; };
    auto bcol4 = [&](int n4) { return W + n0 + 4 * n4; };
    auto epi = [&](f32x16(&acc)[2][2], int wm, int wn, int r, int h) {
      const bool rope = lat && (n0 < 640);
      const int n = n0 + 4 * r + 2 * wn;
      const int q = (r >> 2) & 3;
#pragma unroll
      for (int mt = 0; mt < 2; ++mt)
#pragma unroll
        for (int i = 0; i < 16; ++i) {
          const int T = m0 + wm * 64 + mt * 32 + crow(i, h);
          float v0 = acc[mt][0][i], v1 = acc[mt][1][i];
          if (rope) {
            const int t = (T - NCTX) & 2047;
            const int pos = (q < 2) ? (t >> 6) : (t & 63);
            const int jf = 4 * (r & 3) + 2 * wn;
            const float2 cs = *(const float2*)(p.ROPE + pos * 16 + jf), sn = *(const float2*)(p.ROPE + 1024 + pos * 16 + jf);
            const float o0 = __shfl_xor(v0, 4), o1 = __shfl_xor(v1, 4);
            if (q & 1) { v0 = o0 * sn.x + v0 * cs.x; v1 = o1 * sn.y + v1 * cs.y; }
            else { v0 = v0 * cs.x - o0 * sn.x; v1 = v1 * cs.y - o1 * sn.y; }
          }
          *(unsigned*)(p.QKV + (size_t)T * DIN + n) = pack2(v0, v1);
          if (!lat) {
            const int b = T >> 8, t = T & 255;
            const float2 vv = {v0, v1};
            if (n0 == 512) *(float2*)(p.out + OFF_AK + ((size_t)(b * 2 + l) * 256 + t) * 128 + (n - 512)) = vv;
            else if (n0 == 640) *(float2*)(p.out + OFF_AV + ((size_t)(b * 2 + l) * 256 + t) * 128 + (n - 640)) = vv;
            else if (n0 == 1024 || n0 == 1152) *(float2*)(p.out + OFF_BK + ((size_t)(b * 2 + l) * 256 + t) * 256 + (n - 1024)) = vv;
            else if (n0 == 1280 || n0 == 1408) *(float2*)(p.out + OFF_BV + ((size_t)(b * 2 + l) * 256 + t) * 256 + (n - 1280)) = vv;
          }
        }
    };
    gemm_tile(smem, arow, bcol4, DIN, epi);
  }
}

DI float ret_lg(const Params& p, int l, int dir, int head) { return -__expf(p.decay[(l * 2 + dir) * 4 + head]); }

DI size_t kvs_slot(int req, int head, int dir, int c) { return ((size_t)((req * 4 + head) * 2 + dir) * 16 + c) * 4096; }

DI void retkv_item(const Params& p, char* smem, int l, int req, int head, int c) {
  u16* sKTf = (u16*)smem;
  u16* sKTb = sKTf + 64 * LDT2;
  u16* sVT = sKTb + 64 * LDT2;
  const int tid = otid(), lane = tid & 63, w = tid >> 6, r = lane & 31, h = lane >> 5;
  const int rq = tid >> 4, c4 = tid & 15;
  const int T0 = (req < 16 ? req * 256 : NCTX + (req - 16) * 2048) + c * 128;
  const float lgf = ret_lg(p, l, 0, head), lgb = ret_lg(p, l, 1, head);
  const float one4[4] = {1.f, 1.f, 1.f, 1.f};
  __syncthreads();
#pragma unroll
  for (int half = 0; half < 2; ++half) {
    float v[4][4];
    float sf[4], sb[4];
#pragma unroll
    for (int i = 0; i < 4; ++i) {
      const int j = half * 64 + 4 * rq + i;
      sf[i] = 0.125f * __expf(lgf * (float)(127 - j));
      sb[i] = 0.125f * __expf(lgb * (float)j);
    }
    load4x4(p.QKV + (size_t)(T0 + half * 64) * DIN + 1792 + head * 64, DIN, false, rq, c4, v);
    store_t(sKTf, LDT2, half * 64, rq, c4, v, sf);
    store_t(sKTb, LDT2, half * 64, rq, c4, v, sb);
    load4x4(p.QKV + (size_t)(T0 + half * 64) * DIN + 2048 + head * 64, DIN, false, rq, c4, v);
    store_t(sVT, LDT2, half * 64, rq, c4, v, one4);
  }
  __syncthreads();
  const int dir = w >> 1, mt = w & 1;
  const u16* sKT = dir ? sKTb : sKTf;
  f32x16 acc[2];
#pragma unroll
  for (int nt = 0; nt < 2; ++nt)
#pragma unroll
    for (int i = 0; i < 16; ++i) acc[nt][i] = 0.f;
#pragma unroll
  for (int ks = 0; ks < 8; ++ks) {
    const bf16x8 fa = *(const bf16x8*)&sKT[(mt * 32 + r) * LDT2 + ks * 16 + 8 * h];
#pragma unroll
    for (int nt = 0; nt < 2; ++nt) {
      const bf16x8 fb = *(const bf16x8*)&sVT[(nt * 32 + r) * LDT2 + ks * 16 + 8 * h];
      acc[nt] = MFMA(fa, fb, acc[nt]);
    }
  }
  float* dst = p.KVS + kvs_slot(req, head, dir, c);
#pragma unroll
  for (int nt = 0; nt < 2; ++nt)
#pragma unroll
    for (int i = 0; i < 16; ++i) dst[(mt * 32 + crow(i, h)) * 64 + nt * 32 + r] = acc[nt][i];
}

DI void phase2(const Params& p, char* smem, int l) {
  const int tid = otid();
  for (int item = blockIdx.x; item < 1536; item += gridDim.x) {
    if (item < 512) {
      const int b = item >> 7, head = (item >> 4) & 7, qb = item & 15, kvh = head >> 2;
      const int T0 = NCTX + b * 2048 + qb * 128;
      const float* ck = p.cak + ((size_t)(b * 2 + l) * 512) * 128 + kvh * 64;
      const float* cv = p.cav + ((size_t)(b * 2 + l) * 512) * 128 + kvh * 64;
      auto src = [&](int j, const void*& kp, const void*& vp, int& stride, bool& isf32) -> bool {
        if (j < 8) {
          kp = ck + (size_t)j * 64 * 128; vp = cv + (size_t)j * 64 * 128; stride = 128; isf32 = true;
          return true;
        }
        const int jj = j - 8, kb = qb - 1 + (jj >> 1);
        if (kb < 0 || kb >= 16) return false;
        const int Tk = NCTX + b * 2048 + kb * 128 + (jj & 1) * 64;
        kp = p.QKV + (size_t)Tk * DIN + 512 + kvh * 64; vp = p.QKV + (size_t)Tk * DIN + 640 + kvh * 64; stride = DIN; isf32 = false;
        return true;
      };
      auto biasf = [&](int j, int key, int ql) -> float {
        if (j < 8) return 0.f;
        const int jj = j - 8;
        const int kj = (qb - 1 + (jj >> 1)) * 128 + (jj & 1) * 64 + key;
        const int qi = qb * 128 + ql;
        const int d = qi - kj;
        return (d <= 128 && d >= -128) ? 0.f : NEG;
      };
      attn_core(smem, p.QKV + (size_t)T0 * DIN + head * 64, 14, src, biasf, p.sink[l * 8 + head], true,
                p.CAT + (size_t)T0 * DM + head * 64);
    } else if (item < 768) {
      const int it = item - 512;
      const int b = it >> 6, head = (it >> 4) & 3, qb = it & 15;
      const int T0 = NCTX + b * 2048 + qb * 128;
      float* srpb = (float*)(smem + 2 * 64 * LDT * 2);
      __syncthreads();
      for (int idx = tid; idx < 465; idx += 256) srpb[idx] = p.rpb[(size_t)(l * 4 + head) * 465 + idx];
      const int r0 = 2 * qb;
      const int rmin = min(max(r0 - 4, 0), 24), rmax = min(max(r0 + 1 - 4, 0), 24) + 7;
      const float* ck = p.cbk + ((size_t)(b * 2 + l) * 512) * 256 + head * 64;
      const float* cv = p.cbv + ((size_t)(b * 2 + l) * 512) * 256 + head * 64;
      auto src = [&](int j, const void*& kp, const void*& vp, int& stride, bool& isf32) -> bool {
        if (j < 8) {
          kp = ck + (size_t)j * 64 * 256; vp = cv + (size_t)j * 64 * 256; stride = 256; isf32 = true;
          return true;
        }
        const int Tk = NCTX + b * 2048 + (rmin + j - 8) * 64;
        kp = p.QKV + (size_t)Tk * DIN + 1024 + head * 64; vp = p.QKV + (size_t)Tk * DIN + 1280 + head * 64; stride = DIN; isf32 = false;
        return true;
      };
      auto biasf = [&](int j, int key, int ql) -> float {
        if (j < 8) return 0.f;
        const int kr = rmin + j - 8, kc = key;
        const int qr = r0 + (ql >> 6), qc = ql & 63;
        const int rs = min(max(qr - 4, 0), 24), cs = min(max(qc - 8, 0), 48);
        const bool ok = (kr >= rs) && (kr < rs + 8) && (kc >= cs) && (kc < cs + 16);
        const int bi = ok ? ((kr - qr + 7) * 31 + (kc - qc + 15)) : 0;
        const float bv = srpb[bi];
        return ok ? bv : NEG;
      };
      attn_core(smem, p.QKV + (size_t)T0 * DIN + 768 + head * 64, 8 + (rmax - rmin + 1), src, biasf, NEG, false,
                p.CAT + (size_t)T0 * DM + 512 + head * 64);
    } else if (item < 1152) {
      const int it = item - 768;
      if (it < 256) retkv_item(p, smem, l, 16 + (it >> 6), (it >> 4) & 3, it & 15);
      else { const int i2 = it - 256; retkv_item(p, smem, l, i2 >> 3, (i2 >> 1) & 3, i2 & 1); }
    } else if (item < 1408) {
      const int it = item - 1152;
      const int b = it >> 4, head = (it >> 1) & 7, qh = it & 1, kvh = head >> 2;
      const int T0 = b * 256 + qh * 128;
      auto src = [&](int j, const void*& kp, const void*& vp, int& stride, bool& isf32) -> bool {
        const int Tk = b * 256 + j * 64;
        kp = p.QKV + (size_t)Tk * DIN + 512 + kvh * 64; vp = p.QKV + (size_t)Tk * DIN + 640 + kvh * 64; stride = DIN; isf32 = false;
        return true;
      };
      auto biasf = [&](int, int, int) -> float { return 0.f; };
      attn_core(smem, p.QKV + (size_t)T0 * DIN + head * 64, 4, src, biasf, p.sink[l * 8 + head], true,
                p.CAT + (size_t)T0 * DM + head * 64);
    } else {
      const int it = item - 1408;
      const int b = it >> 3, head = (it >> 1) & 3, qh = it & 1;
      const int T0 = b * 256 + qh * 128;
      auto src = [&](int j, const void*& kp, const void*& vp, int& stride, bool& isf32) -> bool {
        const int Tk = b * 256 + j * 64;
        kp = p.QKV + (size_t)Tk * DIN + 1024 + head * 64; vp = p.QKV + (size_t)Tk * DIN + 1280 + head * 64; stride = DIN; isf32 = false;
        return true;
      };
      auto biasf = [&](int, int, int) -> float { return 0.f; };
      attn_core(smem, p.QKV + (size_t)T0 * DIN + 768 + head * 64, 4, src, biasf, NEG, false,
                p.CAT + (size_t)T0 * DM + 512 + head * 64);
    }
  }
}

DI void phase2c(const Params& p, char* smem, int l) {
  u16* sK = (u16*)smem;
  u16* sVT = sK + 128 * LDT;
  u16* sSTf = sVT + 64 * LDT2;
  u16* sSTb = sSTf + 64 * LDT;
  const int tid = otid(), lane = tid & 63, w = tid >> 6, r = lane & 31, h = lane >> 5;
  const int rq = tid >> 4, c4 = tid & 15;
  const float one4[4] = {1.f, 1.f, 1.f, 1.f};
  for (int item = blockIdx.x; item < 384; item += gridDim.x) {
    int req, head, c, nc;
    if (item < 256) { req = 16 + (item >> 6); head = (item >> 4) & 3; c = item & 15; nc = 16; }
    else { const int i2 = item - 256; req = i2 >> 3; head = (i2 >> 1) & 3; c = i2 & 1; nc = 2; }
    const bool lat = req >= 16;
    const int T0 = (lat ? NCTX + (req - 16) * 2048 : req * 256) + c * 128;
    const float lgf = ret_lg(p, l, 0, head), lgb = ret_lg(p, l, 1, head);
    const float gf = __expf(lgf * 128.f), gb = __expf(lgb * 128.f);
    __syncthreads();
    {
      const int d = tid >> 2, e0 = (tid & 3) * 16;
#pragma unroll
      for (int dir = 0; dir < 2; ++dir) {
        float s[16];
#pragma unroll
        for (int q = 0; q < 16; ++q) s[q] = 0.f;
        const float g = dir ? gb : gf;
        if (lat) {
          const float* s0 = p.state + ((size_t)(((req - 16) * 2 + l) * 2 + dir) * 4 + head) * 4096 + d * 64 + e0;
#pragma unroll
          for (int q = 0; q < 16; q += 4) {
            const float4 x = *(const float4*)(s0 + q);
            s[q] = x.x; s[q + 1] = x.y; s[q + 2] = x.z; s[q + 3] = x.w;
          }
        }
        const int nsteps = dir ? (nc - 1 - c) : c;
        for (int st = 0; st < nsteps; ++st) {
          const int cc = dir ? (nc - 1 - st) : st;
          const float* kv = p.KVS + kvs_slot(req, head, dir, cc) + d * 64 + e0;
#pragma unroll
          for (int q = 0; q < 16; q += 4) {
            const float4 x = *(const float4*)(kv + q);
            s[q] = s[q] * g + x.x; s[q + 1] = s[q + 1] * g + x.y; s[q + 2] = s[q + 2] * g + x.z; s[q + 3] = s[q + 3] * g + x.w;
          }
        }
        u16* sST = dir ? sSTb : sSTf;
#pragma unroll
        for (int q = 0; q < 16; ++q) sST[(e0 + q) * LDT + d] = (u16)(pack2(s[q], 0.f) & 0xffffu);
        if (!lat && c == 0) {
          const float* k0 = p.KVS + kvs_slot(req, head, dir, 0) + d * 64 + e0;
          const float* k1 = p.KVS + kvs_slot(req, head, dir, 1) + d * 64 + e0;
          float* o = p.out + OFF_ST + ((size_t)((req * 2 + l) * 2 + dir) * 4 + head) * 4096 + d * 64 + e0;
#pragma unroll
          for (int q = 0; q < 16; ++q) o[q] = dir ? (gb * k1[q] + k0[q]) : (gf * k0[q] + k1[q]);
        }
      }
    }
#pragma unroll
    for (int half = 0; half < 2; ++half) {
      float v[4][4];
      load4x4(p.QKV + (size_t)(T0 + half * 64) * DIN + 1792 + head * 64, DIN, false, rq, c4, v);
      store_n(sK, LDT, half * 64, rq, c4, v);
      load4x4(p.QKV + (size_t)(T0 + half * 64) * DIN + 2048 + head * 64, DIN, false, rq, c4, v);
      store_t(sVT, LDT2, half * 64, rq, c4, v, one4);
    }
    __syncthreads();
    const int qi = w * 32 + r;
    const u16* qrow = p.QKV + (size_t)(T0 + qi) * DIN + 1536 + head * 64;
    uint4 qraw[4];
#pragma unroll
    for (int ks = 0; ks < 4; ++ks) qraw[ks] = *(const uint4*)(qrow + ks * 16 + 8 * h);
    f32x16 O[2];
#pragma unroll
    for (int d = 0; d < 2; ++d)
#pragma unroll
      for (int i = 0; i < 16; ++i) O[d][i] = 0.f;
#pragma unroll 1
    for (int jt = 0; jt < 4; ++jt) {
      f32x16 S;
#pragma unroll
      for (int i = 0; i < 16; ++i) S[i] = 0.f;
#pragma unroll
      for (int ks = 0; ks < 4; ++ks) {
        const bf16x8 kf = *(const bf16x8*)&sK[(jt * 32 + r) * LDT + ks * 16 + 8 * h];
        S = MFMA(kf, __builtin_bit_cast(bf16x8, qraw[ks]), S);
      }
#pragma unroll
      for (int i = 0; i < 16; ++i) {
        const int j = jt * 32 + crow(i, h);
        const int dlt = qi - j;
        const float wgt = (dlt > 0) ? __expf(lgf * (float)dlt) : ((dlt < 0) ? __expf(lgb * (float)(-dlt)) : 2.f);
        S[i] = S[i] * 0.125f * wgt;
      }
#pragma unroll
      for (int s = 0; s < 2; ++s) {
        const bf16x8 pf = mk8(pack2(S[8 * s + 0], S[8 * s + 1]), pack2(S[8 * s + 2], S[8 * s + 3]),
                              pack2(S[8 * s + 4], S[8 * s + 5]), pack2(S[8 * s + 6], S[8 * s + 7]));
#pragma unroll
        for (int d = 0; d < 2; ++d) {
          const u16* vrow = &sVT[(d * 32 + r) * LDT2 + jt * 32 + 16 * s + 4 * h];
          const uint2 lo = *(const uint2*)vrow;
          const uint2 hi = *(const uint2*)(vrow + 8);
          O[d] = MFMA(mk8(lo.x, lo.y, hi.x, hi.y), pf, O[d]);
        }
      }
    }
    {
      const float xf = __expf(lgf * (float)(qi + 1)), xb = __expf(lgb * (float)(128 - qi));
#pragma unroll
      for (int ks = 0; ks < 4; ++ks) {
        const uint4 q = qraw[ks];
        const bf16x8 qsf = mk8(pack2(bflo(q.x) * xf, bfhi(q.x) * xf), pack2(bflo(q.y) * xf, bfhi(q.y) * xf),
                               pack2(bflo(q.z) * xf, bfhi(q.z) * xf), pack2(bflo(q.w) * xf, bfhi(q.w) * xf));
        const bf16x8 qsb = mk8(pack2(bflo(q.x) * xb, bfhi(q.x) * xb), pack2(bflo(q.y) * xb, bfhi(q.y) * xb),
                               pack2(bflo(q.z) * xb, bfhi(q.z) * xb), pack2(bflo(q.w) * xb, bfhi(q.w) * xb));
#pragma unroll
        for (int d = 0; d < 2; ++d) {
          const bf16x8 sf = *(const bf16x8*)&sSTf[(d * 32 + r) * LDT + ks * 16 + 8 * h];
          const bf16x8 sb = *(const bf16x8*)&sSTb[(d * 32 + r) * LDT + ks * 16 + 8 * h];
          O[d] = MFMA(sf, qsf, O[d]);
          O[d] = MFMA(sb, qsb, O[d]);
        }
      }
    }
    float sum = 0.f;
#pragma unroll
    for (int d = 0; d < 2; ++d)
#pragma unroll
      for (int i = 0; i < 16; ++i) sum += O[d][i];
    sum += __shfl_xor(sum, 32);
    const float mu = sum * (1.f / 64.f);
    float vs = 0.f;
#pragma unroll
    for (int d = 0; d < 2; ++d)
#pragma unroll
      for (int i = 0; i < 16; ++i) { const float t = O[d][i] - mu; vs += t * t; }
    vs += __shfl_xor(vs, 32);
    const float rstd = rsqrtf(vs * (1.f / 64.f) + 1e-6f);
    const u16* grow = p.QKV + (size_t)(T0 + qi) * DIN + 2304 + head * 64;
    const float* gnw = p.gn + l * 256 + head * 64;
    u16* orow = p.CAT + (size_t)(T0 + qi) * DM + 768 + head * 64;
#pragma unroll
    for (int d = 0; d < 2; ++d)
#pragma unroll
      for (int g = 0; g < 4; ++g) {
        const int e = d * 32 + 8 * g + 4 * h;
        const uint2 gr = *(const uint2*)(grow + e);
        const float4 gw = *(const float4*)(gnw + e);
        const float o0 = silu(bflo(gr.x)) * (O[d][4 * g + 0] - mu) * rstd * gw.x;
        const float o1 = silu(bfhi(gr.x)) * (O[d][4 * g + 1] - mu) * rstd * gw.y;
        const float o2 = silu(bflo(gr.y)) * (O[d][4 * g + 2] - mu) * rstd * gw.z;
        const float o3 = silu(bfhi(gr.y)) * (O[d][4 * g + 3] - mu) * rstd * gw.w;
        uint2 pk = {pack2(o0, o1), pack2(o2, o3)};
        *(uint2*)(orow + e) = pk;
      }
  }
}

DI void phase3(const Params& p, char* smem, int l, const float* xc, const float* xl) {
  const float* W = p.w_out + (size_t)l * DM * DM;
  const int xcd = blockIdx.x & 7, nloc = gridDim.x >> 3;
  for (int s = blockIdx.x >> 3; s < 96; s += nloc) {
    const int tm = 12 * xcd + s % 12, tn = s / 12;
    const int m0 = tm * 128, n0 = tn * 128;
    const bool lat = m0 >= NCTX;
    const float* xb = lat ? (xl + (size_t)(m0 - NCTX) * DM) : (xc + (size_t)m0 * DM);
    const float* g1 = p.MOD + (size_t)(l * 5 + cond_of(m0)) * 6144 + 2048;
    const u16* ab = p.CAT + (size_t)m0 * DM;
    auto arow = [&](int r) { return ab + (size_t)r * DM; };
    auto bcol4 = [&](int n4) { return W + n0 + 4 * n4; };
    auto epi = [&](f32x16(&acc)[2][2], int wm, int wn, int r, int h) {
      const int n = n0 + 4 * r + 2 * wn;
      const float2 g = *(const float2*)(g1 + n);
#pragma unroll
      for (int mt = 0; mt < 2; ++mt)
#pragma unroll
        for (int i = 0; i < 16; ++i) {
          const int ml = wm * 64 + mt * 32 + crow(i, h);
          const float2 xv = *(const float2*)(xb + (size_t)ml * DM + n);
          const float2 o = {ALPHA * xv.x + g.x * acc[mt][0][i], ALPHA * xv.y + g.y * acc[mt][1][i]};
          *(float2*)(p.PRE + (size_t)(m0 + ml) * DM + n) = o;
        }
    };
    gemm_tile(smem, arow, bcol4, DM, epi);
  }
}

DI void phase4(const Params& p, char* smem, int l) {
  float* swr = (float*)smem;
  const int tid = otid(), lane = tid & 63, w = tid >> 6;
  __syncthreads();
  for (int idx = tid; idx < 4096; idx += 256) {
    const float4 x = *(const float4*)(p.w_router + (size_t)l * DM * 16 + idx * 4);
    const int k = idx >> 2, e = (idx & 3) * 4;
    swr[(e + 0) * DM + k] = x.x; swr[(e + 1) * DM + k] = x.y; swr[(e + 2) * DM + k] = x.z; swr[(e + 3) * DM + k] = x.w;
  }
  __syncthreads();
  const float* lg = p.ln1g + l * DM;
  const float* lb = p.ln1b + l * DM;
  for (int T = blockIdx.x * 4 + w; T < NTOK; T += gridDim.x * 4) {
    const float* mod = p.MOD + (size_t)(l * 5 + cond_of(T)) * 6144;
    float4 x[4];
    float s = 0.f;
#pragma unroll
    for (int i = 0; i < 4; ++i) {
      x[i] = *(const float4*)(p.PRE + (size_t)T * DM + 256 * i + 4 * lane);
      s += x[i].x + x[i].y + x[i].z + x[i].w;
    }
    const float mu = wave_sum(s) * (1.f / 1024.f);
    float vs = 0.f;
#pragma unroll
    for (int i = 0; i < 4; ++i) {
      x[i].x -= mu; x[i].y -= mu; x[i].z -= mu; x[i].w -= mu;
      vs += x[i].x * x[i].x + x[i].y * x[i].y + x[i].z * x[i].z + x[i].w * x[i].w;
    }
    const float rstd = rsqrtf(wave_sum(vs) * (1.f / 1024.f) + 1e-6f);
#pragma unroll
    for (int i = 0; i < 4; ++i) {
      const int k = 256 * i + 4 * lane;
      const float4 g = *(const float4*)(lg + k), bb = *(const float4*)(lb + k);
      float4 y;
      y.x = x[i].x * rstd * g.x + bb.x; y.y = x[i].y * rstd * g.y + bb.y; y.z = x[i].z * rstd * g.z + bb.z; y.w = x[i].w * rstd * g.w + bb.w;
      *(float4*)(p.X + (size_t)T * DM + k) = y;
      const float4 sc = *(const float4*)(mod + 4096 + k), sh = *(const float4*)(mod + 3072 + k);
      float4 hh;
      hh.x = y.x * (1.f + sc.x) + sh.x; hh.y = y.y * (1.f + sc.y) + sh.y; hh.z = y.z * (1.f + sc.z) + sh.z; hh.w = y.w * (1.f + sc.w) + sh.w;
      uint2 pk = {pack2(hh.x, hh.y), pack2(hh.z, hh.w)};
      *(uint2*)(p.H2 + (size_t)T * DM + k) = pk;
      x[i] = hh;
    }
    float mine = NEG;
#pragma unroll 1
    for (int e = 0; e < 16; ++e) {
      float a = 0.f;
#pragma unroll
      for (int i = 0; i < 4; ++i) {
        const float4 wv = *(const float4*)(swr + e * DM + 256 * i + 4 * lane);
        a += x[i].x * wv.x + x[i].y * wv.y + x[i].z * wv.z + x[i].w * wv.w;
      }
      a = wave_sum(a);
      mine = (lane == e) ? a : mine;
    }
    float mx = mine;
#pragma unroll
    for (int o = 8; o >= 1; o >>= 1) mx = fmaxf(mx, __shfl_xor(mx, o));
    const float ex = __expf(mine - mx);
    float den = ex;
#pragma unroll
    for (int o = 8; o >= 1; o >>= 1) den += __shfl_xor(den, o);
    mine = ex / den;
    if (lane < 16) { p.AFF[(size_t)T * 16 + lane] = mine; p.INV[(size_t)T * 16 + lane] = -1; }
  }
}

DI void phase5(const Params& p, char* smem) {
  float* sa = (float*)smem;
  const int tid = otid();
  for (int item = blockIdx.x; item < 768; item += gridDim.x) {
    int n, base, e, t, cap, rowbase;
    if (item < 512) {
      const int b = item >> 7; e = (item >> 3) & 15; const int seg = item & 7;
      n = 2048; base = NCTX + b * 2048; t = seg * 256 + tid; cap = 256; rowbase = 512 + b * 256;
    } else {
      const int it = item - 512; const int rq = it >> 4; e = it & 15;
      n = 256; base = rq * 256; t = tid; cap = 32; rowbase = rq * 32;
    }
    __syncthreads();
    for (int j = tid; j < n; j += 256) sa[j] = p.AFF[(size_t)(base + j) * 16 + e];
    __syncthreads();
    const float a = sa[t];
    int rank = 0;
    for (int j = 0; j < n; j += 4) {
      const float4 v = *(const float4*)(sa + j);
      rank += (v.x > a || (v.x == a && j < t)) ? 1 : 0;
      rank += (v.y > a || (v.y == a && j + 1 < t)) ? 1 : 0;
      rank += (v.z > a || (v.z == a && j + 2 < t)) ? 1 : 0;
      rank += (v.w > a || (v.w == a && j + 3 < t)) ? 1 : 0;
    }
    if (rank < cap) {
      p.SELTOK[e * NROWS_E + rowbase + rank] = base + t;
      p.SELGATE[e * NROWS_E + rowbase + rank] = a;
      p.INV[(size_t)(base + t) * 16 + e] = e * NROWS_E + rowbase + rank;
    }
  }
}

DI void phase6(const Params& p, char* smem, int l) {
  const int xcd = blockIdx.x & 7, nloc = gridDim.x >> 3;
  for (int s = blockIdx.x >> 3; s < 384; s += nloc) {
    const int e = 2 * xcd + s / 192, rem = s % 192, tn = rem / 12, tm = rem % 12;
    const int m0 = tm * 128, f0 = tn * 64;
    const float* W = p.w_gu + ((size_t)l * 16 + e) * DM * 2048;
    const int* tok = p.SELTOK + e * NROWS_E + m0;
    auto arow = [&](int r) { return p.H2 + (size_t)tok[r] * DM; };
    auto bcol4 = [&](int n4) { return W + ((n4 >> 4) & 1) * 1024 + f0 + 4 * (n4 & 15); };
    u16* act = p.ACT + ((size_t)e * NROWS_E + m0) * DM;
    auto epi = [&](f32x16(&acc)[2][2], int wm, int wn, int r, int h) {
#pragma unroll
      for (int mt = 0; mt < 2; ++mt)
#pragma unroll
        for (int i = 0; i < 16; ++i) {
          const int ml = wm * 64 + mt * 32 + crow(i, h);
          const float a0 = acc[mt][0][i], a1 = acc[mt][1][i];
          const float u0 = __shfl_xor(a0, 16), u1 = __shfl_xor(a1, 16);
          if (r < 16) *(unsigned*)(act + (size_t)ml * DM + f0 + 4 * r + 2 * wn) = pack2(silu(a0) * u0, silu(a1) * u1);
        }
    };
    gemm_tile(smem, arow, bcol4, 2048, epi);
  }
}

DI void phase7(const Params& p, char* smem, int l, float* FF) {
  const int xcd = blockIdx.x & 7, nloc = gridDim.x >> 3;
  for (int s = blockIdx.x >> 3; s < 192; s += nloc) {
    const int e = 2 * xcd + s / 96, rem = s % 96, tn = rem / 12, tm = rem % 12;
    const int m0 = tm * 128, n0 = tn * 128;
    const float* W = p.w_down + ((size_t)l * 16 + e) * DM * DM;
    const u16* ab = p.ACT + ((size_t)e * NROWS_E + m0) * DM;
    const float* gate = p.SELGATE + e * NROWS_E + m0;
    auto arow = [&](int r) { return ab + (size_t)r * DM; };
    auto bcol4 = [&](int n4) { return W + n0 + 4 * n4; };
    auto epi = [&](f32x16(&acc)[2][2], int wm, int wn, int r, int h) {
#pragma unroll
      for (int mt = 0; mt < 2; ++mt)
#pragma unroll
        for (int i = 0; i < 16; ++i) {
          const int ml = wm * 64 + mt * 32 + crow(i, h);
          const float g = gate[ml];
          const float2 o = {g * acc[mt][0][i], g * acc[mt][1][i]};
          *(float2*)(FF + ((size_t)e * NROWS_E + m0 + ml) * DM + n0 + 4 * r + 2 * wn) = o;
        }
    };
    gemm_tile(smem, arow, bcol4, DM, epi);
  }
}

DI void phase8(const Params& p, int l, float* dst, bool write_h) {
  const int tid = otid(), lane = tid & 63, w = tid >> 6;
  const float* lg = p.ln2g + l * DM;
  const float* lb = p.ln2b + l * DM;
  for (int T = blockIdx.x * 4 + w; T < NTOK; T += gridDim.x * 4) {
    const float* g2 = p.MOD + (size_t)(l * 5 + cond_of(T)) * 6144 + 5120;
    const float* modn = p.MOD + (size_t)(5 + cond_of(T)) * 6144;
    float4 x[4], ff[4];
#pragma unroll
    for (int i = 0; i < 4; ++i) ff[i] = make_float4(0.f, 0.f, 0.f, 0.f);
    const int myinv = p.INV[(size_t)T * 16 + (lane & 15)];
#pragma unroll 1
    for (int e = 0; e < 16; ++e) {
      const int row = __shfl(myinv, e);
      if (row >= 0) {
#pragma unroll
        for (int i = 0; i < 4; ++i) {
          const float4 y = *(const float4*)(p.YE + (size_t)row * DM + 256 * i + 4 * lane);
          ff[i].x += y.x; ff[i].y += y.y; ff[i].z += y.z; ff[i].w += y.w;
        }
      }
    }
    float s = 0.f;
#pragma unroll
    for (int i = 0; i < 4; ++i) {
      const int k = 256 * i + 4 * lane;
      const float4 a = *(const float4*)(p.X + (size_t)T * DM + k);
      const float4 f = ff[i];
      const float4 g = *(const float4*)(g2 + k);
      x[i].x = ALPHA * a.x + g.x * f.x; x[i].y = ALPHA * a.y + g.y * f.y; x[i].z = ALPHA * a.z + g.z * f.z; x[i].w = ALPHA * a.w + g.w * f.w;
      s += x[i].x + x[i].y + x[i].z + x[i].w;
    }
    const float mu = wave_sum(s) * (1.f / 1024.f);
    float vs = 0.f;
#pragma unroll
    for (int i = 0; i < 4; ++i) {
      x[i].x -= mu; x[i].y -= mu; x[i].z -= mu; x[i].w -= mu;
      vs += x[i].x * x[i].x + x[i].y * x[i].y + x[i].z * x[i].z + x[i].w * x[i].w;
    }
    const float rstd = rsqrtf(wave_sum(vs) * (1.f / 1024.f) + 1e-6f);
#pragma unroll
    for (int i = 0; i < 4; ++i) {
      const int k = 256 * i + 4 * lane;
      const float4 g = *(const float4*)(lg + k), bb = *(const float4*)(lb + k);
      float4 y;
      y.x = x[i].x * rstd * g.x + bb.x; y.y = x[i].y * rstd * g.y + bb.y; y.z = x[i].z * rstd * g.z + bb.z; y.w = x[i].w * rstd * g.w + bb.w;
      *(float4*)(dst + (size_t)T * DM + k) = y;
      if (write_h) {
        const float4 sc = *(const float4*)(modn + 1024 + k), sh = *(const float4*)(modn + k);
        uint2 pk = {pack2(y.x * (1.f + sc.x) + sh.x, y.y * (1.f + sc.y) + sh.y), pack2(y.z * (1.f + sc.z) + sh.z, y.w * (1.f + sc.w) + sh.w)};
        *(uint2*)(p.H2 + (size_t)T * DM + k) = pk;
      }
    }
  }
}

__global__ void __launch_bounds__(256, 2) mega(Params p) {
  __shared__ __attribute__((aligned(16))) char smem[65536];
  cg::grid_group grid = cg::this_grid();
  if (p.never) grid.sync();
  GBar gb;
  gb.bar = p.BAR; gb.x = xb_xcc_id(); gb.nloc = 0u; gb.nx = 0u;
  if (threadIdx.x == 0) (void)xb_add(&p.BAR[XB_XCNT(gb.x)], 1u);
  phase0(p, smem);
  gbar(gb);
  phase0b(p);
  gbar(gb);
#pragma unroll 1
  for (int l = 0; l < 2; ++l) {
    const float* xc = (l == 0) ? p.x_prompt : p.X;
    const float* xl = (l == 0) ? p.x_sample : (p.X + (size_t)NCTX * DM);
    phase1(p, smem, l);
    gbar(gb);
    phase2(p, smem, l);
    gbar(gb);
    phase2c(p, smem, l);
    gbar(gb);
    phase3(p, smem, l, xc, xl);
    gbar(gb);
    phase4(p, smem, l);
    gbar(gb);
    phase5(p, smem);
    gbar(gb);
    phase6(p, smem, l);
    gbar(gb);
    phase7(p, smem, l, p.YE);
    gbar(gb);
    phase8(p, l, (l == 1) ? p.out : p.X, l == 0);
    if (l == 0) gbar(gb);
  }
}

extern "C" void kernel_launch(void* const* d_in, const int* in_sizes, int n_in, void* d_out, int out_size, void* d_ws,
                              size_t ws_size, hipStream_t stream) {
  static int grid_blocks = 0;
  if (!grid_blocks) {
    int dev = 0, cus = 0, per_cu = 0;
    hipGetDevice(&dev);
    hipDeviceGetAttribute(&cus, hipDeviceAttributeMultiprocessorCount, dev);
    hipOccupancyMaxActiveBlocksPerMultiprocessor(&per_cu, mega, 256, 0);
    if (per_cu > 2) per_cu = 2;
    if (per_cu < 1) per_cu = 1;
    grid_blocks = cus * per_cu;
  }
  Params p{};
  const float** pf = (const float**)&p;
  for (int i = 0; i < 24; ++i) pf[i] = (const float*)d_in[i];
  p.out = (float*)d_out;
  char* ws = (char*)d_ws;
  size_t off = 0;
  auto take = [&](size_t bytes) { char* q = ws + off; off += (bytes + 255) & ~(size_t)255; return q; };
  p.MOD = (float*)take(2 * 5 * 6144 * 4);
  p.BAR = (unsigned*)take(XCD_BAR_WORDS * 4);
  p.ROPE = (float*)take(2048 * 4);
  p.X = (float*)take((size_t)NTOK * DM * 4);
  p.PRE = (float*)take((size_t)NTOK * DM * 4);
  p.KVS = (float*)take((size_t)20 * 4 * 2 * 16 * 4096 * 4);
  p.AFF = (float*)take((size_t)NTOK * 16 * 4);
  p.SELGATE = (float*)take((size_t)16 * NROWS_E * 4);
  p.SELTOK = (int*)take((size_t)16 * NROWS_E * 4);
  p.QKV = (u16*)take((size_t)NTOK * DIN * 2);
  p.CAT = (u16*)take((size_t)NTOK * DM * 2);
  p.H2 = (u16*)take((size_t)NTOK * DM * 2);
  p.ACT = (u16*)take((size_t)16 * NROWS_E * DM * 2);
  p.YE = (float*)take((size_t)16 * NROWS_E * DM * 4);
  p.INV = (int*)take((size_t)NTOK * 16 * 4);
  p.never = 0;
  hipMemsetAsync(p.MOD, 0, (size_t)((char*)p.BAR - (char*)p.MOD) + XCD_BAR_WORDS * 4, stream);
  void* args[] = {&p};
  hipError_t e = hipLaunchCooperativeKernel((void*)mega, dim3(grid_blocks), dim3(256), args, 0, stream);
  if (e != hipSuccess) fprintf(stderr, "cooperative launch failed: %s (grid %d)\n", hipGetErrorString(e), grid_blocks);
}
```

```cpp
#include <hip/hip_runtime.h>
#include <hip/hip_cooperative_groups.h>
#include <cstdio>
namespace cg = cooperative_groups;

#define DI __device__ __forceinline__
typedef short bf16x8 __attribute__((ext_vector_type(8)));
typedef float f32x16 __attribute__((ext_vector_type(16)));
typedef __bf16 bf2_t __attribute__((ext_vector_type(2)));
typedef float f2_t __attribute__((ext_vector_type(2)));
typedef unsigned short u16;
typedef unsigned u32x4 __attribute__((ext_vector_type(4)));
typedef float f32x4 __attribute__((ext_vector_type(4)));
typedef float f32x2 __attribute__((ext_vector_type(2)));

#define MFMA(a, b, c) __builtin_amdgcn_mfma_f32_32x32x16_bf16((a), (b), (c), 0, 0, 0)

#define PROBE 0
constexpr int NTOK = 12288;
constexpr int NCTX = 4096;
constexpr int DM = 1024;
constexpr int DIN = 2560;
constexpr int LDT = 72;
constexpr int LDT2 = 136;
constexpr int NROWS_E = 1536;
constexpr float NEG = -1e30f;
constexpr float ALPHA = 1.41421356237f;

constexpr size_t OFF_AK = 12582912, OFF_AV = 13631488, OFF_BK = 14680064, OFF_BV = 16777216, OFF_ST = 18874368;

struct Params {
  const float *x_prompt, *x_sample, *cak, *cav, *cbk, *cbv, *state, *c, *c_ctx, *w_ada, *b_ada, *w_in, *w_out, *sink, *rpb,
      *decay, *gn, *ln1g, *ln1b, *ln2g, *ln2b, *w_router, *w_gu, *w_down;
  float* out;
  float *MOD, *ROPE, *X, *PRE, *KVS, *AFF, *SELGATE;
  int* SELTOK;
  u16 *QKV, *CAT, *H2, *ACT;
  u16* YE;
  int* INV;
  unsigned* BAR;
  long never;
};

DI unsigned pack2(float a, float b) {
  f2_t v = {a, b};
  bf2_t r = __builtin_convertvector(v, bf2_t);
  return __builtin_bit_cast(unsigned, r);
}
DI int otid() { int x = threadIdx.x; asm volatile("" : "+v"(x)); return x; }
DI float bflo(unsigned u) { return __uint_as_float(u << 16); }
DI float bfhi(unsigned u) { return __uint_as_float(u & 0xffff0000u); }
DI int crow(int i, int h) { return (i & 3) + 8 * (i >> 2) + 4 * h; }
DI float silu(float x) { return x / (1.f + __expf(-x)); }
DI float wave_sum(float v) {
#pragma unroll
  for (int o = 32; o >= 1; o >>= 1) v += __shfl_xor(v, o);
  return v;
}
DI bf16x8 mk8(unsigned a, unsigned b, unsigned c, unsigned d) {
  uint4 u = {a, b, c, d};
  return __builtin_bit_cast(bf16x8, u);
}


#define XB_TMO 128
#define XB_XCNT(j) (256 + 64 * (j))
#define XB_XSUB(j) (1280 + 64 * (j))
#define XB_XGEN(j) (2304 + 64 * (j))
#define XB_TOP 3328
#define XB_TOPGEN 3392
#define XCD_BAR_WORDS 3456
#define XB_SPIN_CAP (1u << 20)
DI unsigned xb_ld(unsigned* p) { return __hip_atomic_load(p, __ATOMIC_RELAXED, __HIP_MEMORY_SCOPE_AGENT); }
DI unsigned xb_add(unsigned* p, unsigned v) { return __hip_atomic_fetch_add(p, v, __ATOMIC_RELAXED, __HIP_MEMORY_SCOPE_AGENT); }
DI unsigned xb_xcc_id() { return (unsigned)__builtin_amdgcn_s_getreg((3 << 11) | 20) & 0xFu; }
#define XB_SPIN(cond, bar)                                                            \
  do {                                                                                \
    unsigned _sp = 0;                                                                 \
    while (cond) {                                                                    \
      __builtin_amdgcn_s_sleep(1);                                                    \
      if ((++_sp & 255u) == 0u) {                                                     \
        if (xb_ld(&(bar)[XB_TMO])) break;                                             \
        if (_sp > XB_SPIN_CAP) { atomicAdd(&(bar)[XB_TMO], 1u); break; }              \
      }                                                                               \
    }                                                                                 \
  } while (0)
struct GBar { unsigned* bar; unsigned x, nloc, nx; };
DI void gbar_complete(unsigned* bar, unsigned x, unsigned& nloc, unsigned& nx) {
  const unsigned G = gridDim.x;
  unsigned sum, cnt, mine, sp = 0u;
  for (;;) {
    sum = 0u; cnt = 0u; mine = 0u;
#pragma unroll
    for (unsigned j = 0; j < 16; ++j) {
      const unsigned c = xb_ld(&bar[XB_XCNT(j)]);
      sum += c; cnt += (c > 0u) ? 1u : 0u; mine = (j == x) ? c : mine;
    }
    if (sum == G) break;
    __builtin_amdgcn_s_sleep(1);
    if ((++sp & 255u) == 0u) {
      if (xb_ld(&bar[XB_TMO])) break;
      if (sp > XB_SPIN_CAP) { atomicAdd(&bar[XB_TMO], 1u); break; }
    }
  }
  nloc = mine > 0u ? mine : 1u;
  nx = cnt > 0u ? cnt : 1u;
}
DI void gbar(GBar& b) {
  asm volatile("s_waitcnt vmcnt(0)" ::: "memory");
  __syncthreads();
  if (threadIdx.x == 0) {
    unsigned* bar = b.bar;
    __builtin_amdgcn_s_waitcnt(0);
    if (b.nloc == 0u) gbar_complete(bar, b.x, b.nloc, b.nx);
    const unsigned nloc = b.nloc, nx = b.nx;
    const unsigned old = xb_add(&bar[XB_XSUB(b.x)], 1u);
    const unsigned gen = old / nloc;
    if (old + 1u == (gen + 1u) * nloc) {
      __builtin_amdgcn_fence(__ATOMIC_RELEASE, "agent");
      asm volatile("s_waitcnt vmcnt(0)" ::: "memory");
      const unsigned og = xb_add(&bar[XB_TOP], 1u);
      const unsigned tg = og / nx;
      if (og + 1u == (tg + 1u) * nx) xb_add(&bar[XB_TOPGEN], 1u);
      else XB_SPIN(xb_ld(&bar[XB_TOPGEN]) == tg, bar);
      __builtin_amdgcn_fence(__ATOMIC_ACQUIRE, "agent");
      xb_add(&bar[XB_XGEN(b.x)], 1u);
      asm volatile("s_waitcnt vmcnt(0)" ::: "memory");
    } else {
      XB_SPIN(xb_ld(&bar[XB_XGEN(b.x)]) == gen, bar);
      __builtin_amdgcn_fence(__ATOMIC_ACQUIRE, "agent");
      asm volatile("s_waitcnt vmcnt(0)" ::: "memory");
    }
  }
  __syncthreads();
}

template <class Setup, class Epi>
DI void gemm_phase(char* smem, int s0, int s_end, int s_step, Setup setup, int ldb, Epi epi) {
  if (s0 >= s_end) return;
  u16* sA = (u16*)smem;
  u16* sB = sA + 128 * LDT;
  const int tid = otid(), lane = tid & 63, w = tid >> 6, r = lane & 31, h = lane >> 5;
  const int a_r0 = tid >> 3, a_c = (tid & 7) * 8;
  const int b_n4 = tid & 31, b_kq = tid >> 5;
  const u16 *apb0, *apb1, *apb2, *apb3;
  const float* bp;
  setup(s0, a_r0, a_c, b_n4, b_kq, apb0, apb1, apb2, apb3, bp);

  u32x4 pa0, pa1, pa2, pa3;
  f32x4 pb[8];

#define G_LOAD(P0, P1, P2, P3, BP, KT)                                                   \
  {                                                                                      \
    const int k0_ = (KT) * 64;                                                           \
    pa0 = *(const u32x4*)(P0 + k0_);                                                     \
    pa1 = *(const u32x4*)(P1 + k0_);                                                     \
    pa2 = *(const u32x4*)(P2 + k0_);                                                     \
    pa3 = *(const u32x4*)(P3 + k0_);                                                     \
    _Pragma("unroll") for (int i_ = 0; i_ < 8; ++i_) pb[i_] = *(const f32x4*)(BP + (size_t)(k0_ + i_) * ldb); \
  }
#define G_STAGE()                                                                        \
  {                                                                                      \
    *(u32x4*)&sA[(a_r0)*LDT + a_c] = pa0;                                                \
    *(u32x4*)&sA[(a_r0 + 32) * LDT + a_c] = pa1;                                         \
    *(u32x4*)&sA[(a_r0 + 64) * LDT + a_c] = pa2;                                         \
    *(u32x4*)&sA[(a_r0 + 96) * LDT + a_c] = pa3;                                         \
    _Pragma("unroll") for (int j_ = 0; j_ < 4; ++j_) {                                   \
      u32x4 pk_;                                                                         \
      pk_.x = pack2(pb[0][j_], pb[1][j_]);                                               \
      pk_.y = pack2(pb[2][j_], pb[3][j_]);                                               \
      pk_.z = pack2(pb[4][j_], pb[5][j_]);                                               \
      pk_.w = pack2(pb[6][j_], pb[7][j_]);                                               \
      *(u32x4*)&sB[(j_ * 32 + b_n4) * LDT + b_kq * 8] = pk_;                             \
    }                                                                                    \
  }
  const u16* sAr = sA + (w * 32 + r) * LDT + 8 * h;
  const u16* sBr = sB + r * LDT + 8 * h;
#define G_FRAG(BUF, KS)                                                                  \
  {                                                                                      \
    fa[BUF] = *(const bf16x8*)(sAr + (KS) * 16);                                         \
    fb[BUF][0] = *(const bf16x8*)(sBr + (KS) * 16);                                      \
    fb[BUF][1] = *(const bf16x8*)(sBr + 32 * LDT + (KS) * 16);                           \
    fb[BUF][2] = *(const bf16x8*)(sBr + 64 * LDT + (KS) * 16);                           \
    fb[BUF][3] = *(const bf16x8*)(sBr + 96 * LDT + (KS) * 16);                           \
  }
#define G_MFMA(BUF)                                                                      \
  {                                                                                      \
    acc[0] = MFMA(fa[BUF], fb[BUF][0], acc[0]);                                          \
    acc[1] = MFMA(fa[BUF], fb[BUF][1], acc[1]);                                          \
    acc[2] = MFMA(fa[BUF], fb[BUF][2], acc[2]);                                          \
    acc[3] = MFMA(fa[BUF], fb[BUF][3], acc[3]);                                          \
  }
#define SB() __builtin_amdgcn_sched_barrier(0)
#define G_COMPUTE()                                                                      \
  {                                                                                      \
    bf16x8 fa[2], fb[2][4];                                                              \
    G_FRAG(0, 0);                                                                        \
    G_FRAG(1, 1);                                                                        \
    SB();                                                                                \
    G_MFMA(0);                                                                           \
    SB();                                                                                \
    G_FRAG(0, 2);                                                                        \
    SB();                                                                                \
    G_MFMA(1);                                                                           \
    SB();                                                                                \
    G_FRAG(1, 3);                                                                        \
    SB();                                                                                \
    G_MFMA(0);                                                                           \
    SB();                                                                                \
    G_MFMA(1);                                                                           \
    SB();                                                                                \
  }

  G_LOAD(apb0, apb1, apb2, apb3, bp, 0);
#pragma unroll 1
  for (int s = s0; s < s_end; s += s_step) {
    f32x16 acc[4];
#pragma unroll
    for (int a = 0; a < 4; ++a)
#pragma unroll
      for (int i = 0; i < 16; ++i) acc[a][i] = 0.f;
    const int sn = s + s_step;
    const bool has_next = sn < s_end;
    const u16 *n0 = apb0, *n1 = apb1, *n2 = apb2, *n3 = apb3;
    const float* nbp = bp;
    if (has_next) setup(sn, a_r0, a_c, b_n4, b_kq, n0, n1, n2, n3, nbp);
#pragma unroll 1
    for (int kt = 0; kt < 16; ++kt) {
      __syncthreads();
      G_STAGE();
      __syncthreads();
      int kn = kt + 1;
      if (kt == 15) { apb0 = n0; apb1 = n1; apb2 = n2; apb3 = n3; bp = nbp; kn = 0; }
      G_LOAD(apb0, apb1, apb2, apb3, bp, kn);
      G_COMPUTE();
    }
    epi(s, acc, w, r, h);
  }
#undef G_LOAD
#undef G_STAGE
#undef G_COMPUTE
#undef G_FRAG
#undef G_MFMA
}

DI void load4x4(const void* base, int stride, bool isf32, int rq, int c4, float v[4][4]) {
  if (isf32) {
#pragma unroll
    for (int i = 0; i < 4; ++i) {
      const float4 x = *(const float4*)((const float*)base + (size_t)(4 * rq + i) * stride + 4 * c4);
      v[i][0] = x.x; v[i][1] = x.y; v[i][2] = x.z; v[i][3] = x.w;
    }
  } else {
#pragma unroll
    for (int i = 0; i < 4; ++i) {
      const uint2 x = *(const uint2*)((const u16*)base + (size_t)(4 * rq + i) * stride + 4 * c4);
      v[i][0] = bflo(x.x); v[i][1] = bfhi(x.x); v[i][2] = bflo(x.y); v[i][3] = bfhi(x.y);
    }
  }
}
DI void store_n(u16* dst, int ld, int row0, int rq, int c4, const float v[4][4]) {
#pragma unroll
  for (int i = 0; i < 4; ++i) {
    uint2 pk = {pack2(v[i][0], v[i][1]), pack2(v[i][2], v[i][3])};
    *(uint2*)&dst[(row0 + 4 * rq + i) * ld + 4 * c4] = pk;
  }
}
DI void store_t(u16* dst, int ld, int col0, int rq, int c4, const float v[4][4], const float s[4]) {
#pragma unroll
  for (int j = 0; j < 4; ++j) {
    uint2 pk = {pack2(v[0][j] * s[0], v[1][j] * s[1]), pack2(v[2][j] * s[2], v[3][j] * s[3])};
    *(uint2*)&dst[(4 * c4 + j) * ld + col0 + 4 * rq] = pk;
  }
}

template <class TileSrc, class BiasF>
DI void attn_core(char* smem, const u16* qbase, int ntiles, TileSrc src, BiasF biasf, float m_init, bool has_sink, u16* obase) {
  u16* sK = (u16*)smem;
  u16* sVT = sK + 64 * LDT;
  const int tid = otid(), lane = tid & 63, w = tid >> 6, r = lane & 31, h = lane >> 5;
  const int rq = tid >> 4, c4 = tid & 15;
  const int ql = w * 32 + r;
  bf16x8 qf[4];
#pragma unroll
  for (int ks = 0; ks < 4; ++ks) qf[ks] = *(const bf16x8*)(qbase + (size_t)ql * DIN + ks * 16 + 8 * h);
  f32x16 O[2];
#pragma unroll
  for (int d = 0; d < 2; ++d)
#pragma unroll
    for (int i = 0; i < 16; ++i) O[d][i] = 0.f;
  float m = m_init, lsum = (has_sink && h == 0) ? 1.f : 0.f;
  const float one4[4] = {1.f, 1.f, 1.f, 1.f};

  u32x4 kraw[4], vraw[4];
#pragma unroll
  for (int i = 0; i < 4; ++i) { kraw[i] = (u32x4){0u, 0u, 0u, 0u}; vraw[i] = (u32x4){0u, 0u, 0u, 0u}; }
  bool cur_f32 = false, nxt_f32 = false;
  int j = 0;
  {
    const void *kp = nullptr, *vp = nullptr;
    int stride = 0;
    while (j < ntiles && !src(j, kp, vp, stride, nxt_f32)) ++j;
    if (j < ntiles) {
      if (nxt_f32) {
#pragma unroll
        for (int i = 0; i < 4; ++i) {
          kraw[i] = *(const u32x4*)((const float*)kp + (size_t)(4 * rq + i) * stride + 4 * c4);
          vraw[i] = *(const u32x4*)((const float*)vp + (size_t)(4 * rq + i) * stride + 4 * c4);
        }
      } else {
#pragma unroll
        for (int i = 0; i < 4; ++i) {
          const uint2 a = *(const uint2*)((const u16*)kp + (size_t)(4 * rq + i) * stride + 4 * c4);
          const uint2 c = *(const uint2*)((const u16*)vp + (size_t)(4 * rq + i) * stride + 4 * c4);
          kraw[i].x = a.x; kraw[i].y = a.y; vraw[i].x = c.x; vraw[i].y = c.y;
        }
      }
    }
  }
#pragma unroll 1
  while (j < ntiles) {
    cur_f32 = nxt_f32;
    __syncthreads();
    {
      float v[4][4];
#pragma unroll
      for (int i = 0; i < 4; ++i) {
        if (cur_f32) { v[i][0] = __uint_as_float(kraw[i].x); v[i][1] = __uint_as_float(kraw[i].y); v[i][2] = __uint_as_float(kraw[i].z); v[i][3] = __uint_as_float(kraw[i].w); }
        else { v[i][0] = bflo(kraw[i].x); v[i][1] = bfhi(kraw[i].x); v[i][2] = bflo(kraw[i].y); v[i][3] = bfhi(kraw[i].y); }
      }
      store_n(sK, LDT, 0, rq, c4, v);
#pragma unroll
      for (int i = 0; i < 4; ++i) {
        if (cur_f32) { v[i][0] = __uint_as_float(vraw[i].x); v[i][1] = __uint_as_float(vraw[i].y); v[i][2] = __uint_as_float(vraw[i].z); v[i][3] = __uint_as_float(vraw[i].w); }
        else { v[i][0] = bflo(vraw[i].x); v[i][1] = bfhi(vraw[i].x); v[i][2] = bflo(vraw[i].y); v[i][3] = bfhi(vraw[i].y); }
      }
      store_t(sVT, LDT, 0, rq, c4, v, one4);
    }
    __syncthreads();
    const int jc = j;
    {
      const void *kp = nullptr, *vp = nullptr;
      int stride = 0;
      ++j;
      while (j < ntiles && !src(j, kp, vp, stride, nxt_f32)) ++j;
      if (j < ntiles) {
        if (nxt_f32) {
#pragma unroll
          for (int i = 0; i < 4; ++i) {
            kraw[i] = *(const u32x4*)((const float*)kp + (size_t)(4 * rq + i) * stride + 4 * c4);
            vraw[i] = *(const u32x4*)((const float*)vp + (size_t)(4 * rq + i) * stride + 4 * c4);
          }
        } else {
#pragma unroll
          for (int i = 0; i < 4; ++i) {
            const uint2 a = *(const uint2*)((const u16*)kp + (size_t)(4 * rq + i) * stride + 4 * c4);
            const uint2 c = *(const uint2*)((const u16*)vp + (size_t)(4 * rq + i) * stride + 4 * c4);
            kraw[i].x = a.x; kraw[i].y = a.y; vraw[i].x = c.x; vraw[i].y = c.y;
          }
        }
      }
    }
    f32x16 S[2];
#pragma unroll
    for (int mt = 0; mt < 2; ++mt)
#pragma unroll
      for (int i = 0; i < 16; ++i) S[mt][i] = 0.f;
#pragma unroll
    for (int ks = 0; ks < 4; ++ks)
#pragma unroll
      for (int mt = 0; mt < 2; ++mt) {
        const bf16x8 kf = *(const bf16x8*)&sK[(mt * 32 + r) * LDT + ks * 16 + 8 * h];
        S[mt] = MFMA(kf, qf[ks], S[mt]);
      }
    float mx = NEG;
#pragma unroll
    for (int mt = 0; mt < 2; ++mt)
#pragma unroll
      for (int i = 0; i < 16; ++i) {
        const float s = S[mt][i] * 0.125f + biasf(jc, mt * 32 + crow(i, h), ql);
        S[mt][i] = s;
        mx = fmaxf(mx, s);
      }
    mx = fmaxf(mx, __shfl_xor(mx, 32));
    const float mn = fmaxf(m, mx);
    const float alpha = __expf(m - mn);
    m = mn;
    float ps = 0.f;
#pragma unroll
    for (int mt = 0; mt < 2; ++mt)
#pragma unroll
      for (int i = 0; i < 16; ++i) {
        const float pv = __expf(S[mt][i] - mn);
        S[mt][i] = pv;
        ps += pv;
      }
    lsum = lsum * alpha + ps;
#pragma unroll
    for (int d = 0; d < 2; ++d)
#pragma unroll
      for (int i = 0; i < 16; ++i) O[d][i] *= alpha;
#pragma unroll
    for (int mt = 0; mt < 2; ++mt)
#pragma unroll
      for (int s = 0; s < 2; ++s) {
        const bf16x8 pf = mk8(pack2(S[mt][8 * s + 0], S[mt][8 * s + 1]), pack2(S[mt][8 * s + 2], S[mt][8 * s + 3]),
                              pack2(S[mt][8 * s + 4], S[mt][8 * s + 5]), pack2(S[mt][8 * s + 6], S[mt][8 * s + 7]));
#pragma unroll
        for (int d = 0; d < 2; ++d) {
          const u16* vrow = &sVT[(d * 32 + r) * LDT + mt * 32 + 16 * s + 4 * h];
          const uint2 lo = *(const uint2*)vrow;
          const uint2 hi = *(const uint2*)(vrow + 8);
          O[d] = MFMA(mk8(lo.x, lo.y, hi.x, hi.y), pf, O[d]);
        }
      }
  }
  const float l = lsum + __shfl_xor(lsum, 32);
  const float inv = 1.f / l;
#pragma unroll
  for (int d = 0; d < 2; ++d)
#pragma unroll
    for (int g = 0; g < 4; ++g) {
      uint2 pk = {pack2(O[d][4 * g + 0] * inv, O[d][4 * g + 1] * inv), pack2(O[d][4 * g + 2] * inv, O[d][4 * g + 3] * inv)};
      *(uint2*)(obase + (size_t)ql * DM + d * 32 + 8 * g + 4 * h) = pk;
    }
}

DI void phase0(const Params& p, char* smem) {
  const int tid = otid();
  if (blockIdx.x == 0) {
    for (int idx = tid; idx < 1024; idx += 256) {
      const int pos = idx >> 4, j = idx & 15;
      const double inv = 1.0 / pow(10000.0, (double)j / 16.0);
      const float ang = (float)((double)pos * inv);
      p.ROPE[idx] = cosf(ang);
      p.ROPE[1024 + idx] = sinf(ang);
    }
  }
  float* scond = (float*)smem;
  for (int item = blockIdx.x; item < 768; item += gridDim.x) {
    const int l = item / 384, ks = (item / 24) % 16, jb = item % 24;
    __syncthreads();
    for (int idx = tid; idx < 320; idx += 256) {
      const int c = idx / 64, k = ks * 64 + (idx & 63);
      const float v = (c == 0) ? p.c_ctx[k] : p.c[(c - 1) * DM + k];
      scond[idx] = silu(v);
    }
    __syncthreads();
    const int j = jb * 256 + tid;
    const float* wp = p.w_ada + ((size_t)l * DM + ks * 64) * 6144 + j;
    float a[5] = {0.f, 0.f, 0.f, 0.f, 0.f};
#pragma unroll 8
    for (int k = 0; k < 64; ++k) {
      const float wv = wp[(size_t)k * 6144];
#pragma unroll
      for (int c = 0; c < 5; ++c) a[c] += scond[c * 64 + k] * wv;
    }
    const float bias = (ks == 0) ? p.b_ada[l * 6144 + j] : 0.f;
#pragma unroll
    for (int c = 0; c < 5; ++c) unsafeAtomicAdd(&p.MOD[(l * 5 + c) * 6144 + j], a[c] + bias);
  }
}

DI int cond_of(int T) { return T < NCTX ? 0 : 1 + ((T - NCTX) >> 11); }

DI void phase0b(const Params& p) {
  const int tid = otid(), lane = tid & 63, w = tid >> 6;
  for (int T = blockIdx.x * 4 + w; T < NTOK; T += gridDim.x * 4) {
    const float* mod = p.MOD + (size_t)cond_of(T) * 6144;
    const float* xr = (T < NCTX) ? (p.x_prompt + (size_t)T * DM) : (p.x_sample + (size_t)(T - NCTX) * DM);
#pragma unroll
    for (int i = 0; i < 4; ++i) {
      const int k = 256 * i + 4 * lane;
      const float4 x = *(const float4*)(xr + k);
      const float4 sc = *(const float4*)(mod + 1024 + k), sh = *(const float4*)(mod + k);
      uint2 pk = {pack2(x.x * (1.f + sc.x) + sh.x, x.y * (1.f + sc.y) + sh.y), pack2(x.z * (1.f + sc.z) + sh.z, x.w * (1.f + sc.w) + sh.w)};
      *(uint2*)(p.H2 + (size_t)T * DM + k) = pk;
    }
  }
}

DI void phase1(const Params& p, char* smem, int l) {
  const float* W = p.w_in + (size_t)l * DM * DIN;
  const int xcd = blockIdx.x & 7, nloc = gridDim.x >> 3;
  auto setup = [&](int s, int ar0, int ac, int n4, int kq, const u16*& q0, const u16*& q1, const u16*& q2, const u16*& q3, const float*& bp) {
    const int tm = 12 * xcd + s % 12, tn = s / 12;
    const u16* ab = p.H2 + ((size_t)tm * 128 + ar0) * DM + ac;
    q0 = ab; q1 = ab + 32 * DM; q2 = ab + 64 * DM; q3 = ab + 96 * DM;
    bp = W + tn * 128 + 4 * n4 + (size_t)(kq * 8) * DIN;
  };
  auto epi = [&](int s, f32x16(&acc)[4], int w, int r, int h) {
    int hq = h;
    asm volatile("" : "+v"(hq));
    const int tm = 12 * xcd + s % 12, tn = s / 12;
    const int m0 = tm * 128, n0 = tn * 128;
    const bool lat = m0 >= NCTX;
    const bool rope = lat && (n0 < 640);
    const int n = n0 + 4 * r;
    const int q = (r >> 2) & 3;
#pragma unroll
    for (int i = 0; i < 16; ++i) {
      const int T = m0 + w * 32 + crow(i, hq);
      float v0 = acc[0][i], v1 = acc[1][i], v2 = acc[2][i], v3 = acc[3][i];
      if (rope) {
        const int t = (T - NCTX) & 2047;
        const int pos = (q < 2) ? (t >> 6) : (t & 63);
        const int jf = 4 * (r & 3);
        const float4 cs = *(const float4*)(p.ROPE + pos * 16 + jf), sn = *(const float4*)(p.ROPE + 1024 + pos * 16 + jf);
        const float o0 = __shfl_xor(v0, 4), o1 = __shfl_xor(v1, 4), o2 = __shfl_xor(v2, 4), o3 = __shfl_xor(v3, 4);
        if (q & 1) { v0 = o0 * sn.x + v0 * cs.x; v1 = o1 * sn.y + v1 * cs.y; v2 = o2 * sn.z + v2 * cs.z; v3 = o3 * sn.w + v3 * cs.w; }
        else { v0 = v0 * cs.x - o0 * sn.x; v1 = v1 * cs.y - o1 * sn.y; v2 = v2 * cs.z - o2 * sn.z; v3 = v3 * cs.w - o3 * sn.w; }
      }
      uint2 pk = {pack2(v0, v1), pack2(v2, v3)};
      *(uint2*)(p.QKV + (size_t)T * DIN + n) = pk;
      if (!lat) {
        const int b = T >> 8, t = T & 255;
        const float4 vv = {v0, v1, v2, v3};
        if (n0 == 512) *(float4*)(p.out + OFF_AK + ((size_t)(b * 2 + l) * 256 + t) * 128 + (n - 512)) = vv;
        else if (n0 == 640) *(float4*)(p.out + OFF_AV + ((size_t)(b * 2 + l) * 256 + t) * 128 + (n - 640)) = vv;
        else if (n0 == 1024 || n0 == 1152) *(float4*)(p.out + OFF_BK + ((size_t)(b * 2 + l) * 256 + t) * 256 + (n - 1024)) = vv;
        else if (n0 == 1280 || n0 == 1408) *(float4*)(p.out + OFF_BV + ((size_t)(b * 2 + l) * 256 + t) * 256 + (n - 1280)) = vv;
      }
      if ((i & 3) == 3) __builtin_amdgcn_sched_barrier(0);
    }
  };
  gemm_phase(smem, blockIdx.x >> 3, 240, nloc, setup, DIN, epi);
}

DI float ret_lg(const Params& p, int l, int dir, int head) { return -__expf(p.decay[(l * 2 + dir) * 4 + head]); }

DI size_t kvs_slot(int req, int head, int dir, int c) { return ((size_t)((req * 4 + head) * 2 + dir) * 16 + c) * 4096; }

DI void retkv_item(const Params& p, char* smem, int l, int req, int head, int c) {
  u16* sKTf = (u16*)smem;
  u16* sKTb = sKTf + 64 * LDT2;
  u16* sVT = sKTb + 64 * LDT2;
  const int tid = otid(), lane = tid & 63, w = tid >> 6, r = lane & 31, h = lane >> 5;
  const int rq = tid >> 4, c4 = tid & 15;
  const int T0 = (req < 16 ? req * 256 : NCTX + (req - 16) * 2048) + c * 128;
  const float lgf = ret_lg(p, l, 0, head), lgb = ret_lg(p, l, 1, head);
  const float one4[4] = {1.f, 1.f, 1.f, 1.f};
  __syncthreads();
#pragma unroll
  for (int half = 0; half < 2; ++half) {
    float v[4][4];
    float sf[4], sb[4];
#pragma unroll
    for (int i = 0; i < 4; ++i) {
      const int j = half * 64 + 4 * rq + i;
      sf[i] = 0.125f * __expf(lgf * (float)(127 - j));
      sb[i] = 0.125f * __expf(lgb * (float)j);
    }
    load4x4(p.QKV + (size_t)(T0 + half * 64) * DIN + 1792 + head * 64, DIN, false, rq, c4, v);
    store_t(sKTf, LDT2, half * 64, rq, c4, v, sf);
    store_t(sKTb, LDT2, half * 64, rq, c4, v, sb);
    load4x4(p.QKV + (size_t)(T0 + half * 64) * DIN + 2048 + head * 64, DIN, false, rq, c4, v);
    store_t(sVT, LDT2, half * 64, rq, c4, v, one4);
  }
  __syncthreads();
  const int dir = w >> 1, mt = w & 1;
  const u16* sKT = dir ? sKTb : sKTf;
  f32x16 acc[2];
#pragma unroll
  for (int nt = 0; nt < 2; ++nt)
#pragma unroll
    for (int i = 0; i < 16; ++i) acc[nt][i] = 0.f;
#pragma unroll
  for (int ks = 0; ks < 8; ++ks) {
    const bf16x8 fa = *(const bf16x8*)&sKT[(mt * 32 + r) * LDT2 + ks * 16 + 8 * h];
#pragma unroll
    for (int nt = 0; nt < 2; ++nt) {
      const bf16x8 fb = *(const bf16x8*)&sVT[(nt * 32 + r) * LDT2 + ks * 16 + 8 * h];
      acc[nt] = MFMA(fa, fb, acc[nt]);
    }
  }
  float* dst = p.KVS + kvs_slot(req, head, dir, c);
#pragma unroll
  for (int nt = 0; nt < 2; ++nt)
#pragma unroll
    for (int i = 0; i < 16; ++i) dst[(mt * 32 + crow(i, h)) * 64 + nt * 32 + r] = acc[nt][i];
}

DI void phase2(const Params& p, char* smem, int l) {
  const int tid = otid();
  for (int item = blockIdx.x; item < 1536; item += gridDim.x) {
    if (item < 512) {
      const int b = item >> 7, head = (item >> 4) & 7, qb = item & 15, kvh = head >> 2;
      const int T0 = NCTX + b * 2048 + qb * 128;
      const float* ck = p.cak + ((size_t)(b * 2 + l) * 512) * 128 + kvh * 64;
      const float* cv = p.cav + ((size_t)(b * 2 + l) * 512) * 128 + kvh * 64;
      auto src = [&](int j, const void*& kp, const void*& vp, int& stride, bool& isf32) -> bool {
        if (j < 8) {
          kp = ck + (size_t)j * 64 * 128; vp = cv + (size_t)j * 64 * 128; stride = 128; isf32 = true;
          return true;
        }
        const int jj = j - 8, kb = qb - 1 + (jj >> 1);
        if (kb < 0 || kb >= 16) return false;
        const int Tk = NCTX + b * 2048 + kb * 128 + (jj & 1) * 64;
        kp = p.QKV + (size_t)Tk * DIN + 512 + kvh * 64; vp = p.QKV + (size_t)Tk * DIN + 640 + kvh * 64; stride = DIN; isf32 = false;
        return true;
      };
      auto biasf = [&](int j, int key, int ql) -> float {
        if (j < 8) return 0.f;
        const int jj = j - 8;
        const int kj = (qb - 1 + (jj >> 1)) * 128 + (jj & 1) * 64 + key;
        const int qi = qb * 128 + ql;
        const int d = qi - kj;
        return (d <= 128 && d >= -128) ? 0.f : NEG;
      };
      attn_core(smem, p.QKV + (size_t)T0 * DIN + head * 64, 14, src, biasf, p.sink[l * 8 + head], true,
                p.CAT + (size_t)T0 * DM + head * 64);
    } else if (item < 768) {
      const int it = item - 512;
      const int b = it >> 6, head = (it >> 4) & 3, qb = it & 15;
      const int T0 = NCTX + b * 2048 + qb * 128;
      float* srpb = (float*)(smem + 2 * 64 * LDT * 2);
      __syncthreads();
      for (int idx = tid; idx < 465; idx += 256) srpb[idx] = p.rpb[(size_t)(l * 4 + head) * 465 + idx];
      const int r0 = 2 * qb;
      const int rmin = min(max(r0 - 4, 0), 24), rmax = min(max(r0 + 1 - 4, 0), 24) + 7;
      const float* ck = p.cbk + ((size_t)(b * 2 + l) * 512) * 256 + head * 64;
      const float* cv = p.cbv + ((size_t)(b * 2 + l) * 512) * 256 + head * 64;
      auto src = [&](int j, const void*& kp, const void*& vp, int& stride, bool& isf32) -> bool {
        if (j < 8) {
          kp = ck + (size_t)j * 64 * 256; vp = cv + (size_t)j * 64 * 256; stride = 256; isf32 = true;
          return true;
        }
        const int Tk = NCTX + b * 2048 + (rmin + j - 8) * 64;
        kp = p.QKV + (size_t)Tk * DIN + 1024 + head * 64; vp = p.QKV + (size_t)Tk * DIN + 1280 + head * 64; stride = DIN; isf32 = false;
        return true;
      };
      auto biasf = [&](int j, int key, int ql) -> float {
        if (j < 8) return 0.f;
        const int kr = rmin + j - 8, kc = key;
        const int qr = r0 + (ql >> 6), qc = ql & 63;
        const int rs = min(max(qr - 4, 0), 24), cs = min(max(qc - 8, 0), 48);
        const bool ok = (kr >= rs) && (kr < rs + 8) && (kc >= cs) && (kc < cs + 16);
        const int bi = ok ? ((kr - qr + 7) * 31 + (kc - qc + 15)) : 0;
        const float bv = srpb[bi];
        return ok ? bv : NEG;
      };
      attn_core(smem, p.QKV + (size_t)T0 * DIN + 768 + head * 64, 8 + (rmax - rmin + 1), src, biasf, NEG, false,
                p.CAT + (size_t)T0 * DM + 512 + head * 64);
    } else if (item < 1152) {
      const int it = item - 768;
      if (it < 256) retkv_item(p, smem, l, 16 + (it >> 6), (it >> 4) & 3, it & 15);
      else { const int i2 = it - 256; retkv_item(p, smem, l, i2 >> 3, (i2 >> 1) & 3, i2 & 1); }
    } else if (item < 1408) {
      const int it = item - 1152;
      const int b = it >> 4, head = (it >> 1) & 7, qh = it & 1, kvh = head >> 2;
      const int T0 = b * 256 + qh * 128;
      auto src = [&](int j, const void*& kp, const void*& vp, int& stride, bool& isf32) -> bool {
        const int Tk = b * 256 + j * 64;
        kp = p.QKV + (size_t)Tk * DIN + 512 + kvh * 64; vp = p.QKV + (size_t)Tk * DIN + 640 + kvh * 64; stride = DIN; isf32 = false;
        return true;
      };
      auto biasf = [&](int, int, int) -> float { return 0.f; };
      attn_core(smem, p.QKV + (size_t)T0 * DIN + head * 64, 4, src, biasf, p.sink[l * 8 + head], true,
                p.CAT + (size_t)T0 * DM + head * 64);
    } else {
      const int it = item - 1408;
      const int b = it >> 3, head = (it >> 1) & 3, qh = it & 1;
      const int T0 = b * 256 + qh * 128;
      auto src = [&](int j, const void*& kp, const void*& vp, int& stride, bool& isf32) -> bool {
        const int Tk = b * 256 + j * 64;
        kp = p.QKV + (size_t)Tk * DIN + 1024 + head * 64; vp = p.QKV + (size_t)Tk * DIN + 1280 + head * 64; stride = DIN; isf32 = false;
        return true;
      };
      auto biasf = [&](int, int, int) -> float { return 0.f; };
      attn_core(smem, p.QKV + (size_t)T0 * DIN + 768 + head * 64, 4, src, biasf, NEG, false,
                p.CAT + (size_t)T0 * DM + 512 + head * 64);
    }
  }
}

DI void phase2c(const Params& p, char* smem, int l) {
  u16* sK = (u16*)smem;
  u16* sVT = sK + 128 * LDT;
  u16* sSTf = sVT + 64 * LDT2;
  u16* sSTb = sSTf + 64 * LDT;
  const int tid = otid(), lane = tid & 63, w = tid >> 6, r = lane & 31, h = lane >> 5;
  const int rq = tid >> 4, c4 = tid & 15;
  const float one4[4] = {1.f, 1.f, 1.f, 1.f};
  for (int item = blockIdx.x; item < 384; item += gridDim.x) {
    int req, head, c, nc;
    if (item < 256) { req = 16 + (item >> 6); head = (item >> 4) & 3; c = item & 15; nc = 16; }
    else { const int i2 = item - 256; req = i2 >> 3; head = (i2 >> 1) & 3; c = i2 & 1; nc = 2; }
    const bool lat = req >= 16;
    const int T0 = (lat ? NCTX + (req - 16) * 2048 : req * 256) + c * 128;
    const float lgf = ret_lg(p, l, 0, head), lgb = ret_lg(p, l, 1, head);
    const float gf = __expf(lgf * 128.f), gb = __expf(lgb * 128.f);
    __syncthreads();
    {
      const int d = tid >> 2, e0 = (tid & 3) * 16;
#pragma unroll
      for (int dir = 0; dir < 2; ++dir) {
        float s[16];
#pragma unroll
        for (int q = 0; q < 16; ++q) s[q] = 0.f;
        const float g = dir ? gb : gf;
        if (lat) {
          const float* s0 = p.state + ((size_t)(((req - 16) * 2 + l) * 2 + dir) * 4 + head) * 4096 + d * 64 + e0;
#pragma unroll
          for (int q = 0; q < 16; q += 4) {
            const float4 x = *(const float4*)(s0 + q);
            s[q] = x.x; s[q + 1] = x.y; s[q + 2] = x.z; s[q + 3] = x.w;
          }
        }
        const int nsteps = dir ? (nc - 1 - c) : c;
        for (int st = 0; st < nsteps; ++st) {
          const int cc = dir ? (nc - 1 - st) : st;
          const float* kv = p.KVS + kvs_slot(req, head, dir, cc) + d * 64 + e0;
#pragma unroll
          for (int q = 0; q < 16; q += 4) {
            const float4 x = *(const float4*)(kv + q);
            s[q] = s[q] * g + x.x; s[q + 1] = s[q + 1] * g + x.y; s[q + 2] = s[q + 2] * g + x.z; s[q + 3] = s[q + 3] * g + x.w;
          }
        }
        u16* sST = dir ? sSTb : sSTf;
#pragma unroll
        for (int q = 0; q < 16; ++q) sST[(e0 + q) * LDT + d] = (u16)(pack2(s[q], 0.f) & 0xffffu);
        if (!lat && c == 0) {
          const float* k0 = p.KVS + kvs_slot(req, head, dir, 0) + d * 64 + e0;
          const float* k1 = p.KVS + kvs_slot(req, head, dir, 1) + d * 64 + e0;
          float* o = p.out + OFF_ST + ((size_t)((req * 2 + l) * 2 + dir) * 4 + head) * 4096 + d * 64 + e0;
#pragma unroll
          for (int q = 0; q < 16; ++q) o[q] = dir ? (gb * k1[q] + k0[q]) : (gf * k0[q] + k1[q]);
        }
      }
    }
#pragma unroll
    for (int half = 0; half < 2; ++half) {
      float v[4][4];
      load4x4(p.QKV + (size_t)(T0 + half * 64) * DIN + 1792 + head * 64, DIN, false, rq, c4, v);
      store_n(sK, LDT, half * 64, rq, c4, v);
      load4x4(p.QKV + (size_t)(T0 + half * 64) * DIN + 2048 + head * 64, DIN, false, rq, c4, v);
      store_t(sVT, LDT2, half * 64, rq, c4, v, one4);
    }
    __syncthreads();
    const int qi = w * 32 + r;
    const u16* qrow = p.QKV + (size_t)(T0 + qi) * DIN + 1536 + head * 64;
    uint4 qraw[4];
#pragma unroll
    for (int ks = 0; ks < 4; ++ks) qraw[ks] = *(const uint4*)(qrow + ks * 16 + 8 * h);
    f32x16 O[2];
#pragma unroll
    for (int d = 0; d < 2; ++d)
#pragma unroll
      for (int i = 0; i < 16; ++i) O[d][i] = 0.f;
#pragma unroll 1
    for (int jt = 0; jt < 4; ++jt) {
      f32x16 S;
#pragma unroll
      for (int i = 0; i < 16; ++i) S[i] = 0.f;
#pragma unroll
      for (int ks = 0; ks < 4; ++ks) {
        const bf16x8 kf = *(const bf16x8*)&sK[(jt * 32 + r) * LDT + ks * 16 + 8 * h];
        S = MFMA(kf, __builtin_bit_cast(bf16x8, qraw[ks]), S);
      }
#pragma unroll
      for (int i = 0; i < 16; ++i) {
        const int j = jt * 32 + crow(i, h);
        const int dlt = qi - j;
        const float wgt = (dlt > 0) ? __expf(lgf * (float)dlt) : ((dlt < 0) ? __expf(lgb * (float)(-dlt)) : 2.f);
        S[i] = S[i] * 0.125f * wgt;
      }
#pragma unroll
      for (int s = 0; s < 2; ++s) {
        const bf16x8 pf = mk8(pack2(S[8 * s + 0], S[8 * s + 1]), pack2(S[8 * s + 2], S[8 * s + 3]),
                              pack2(S[8 * s + 4], S[8 * s + 5]), pack2(S[8 * s + 6], S[8 * s + 7]));
#pragma unroll
        for (int d = 0; d < 2; ++d) {
          const u16* vrow = &sVT[(d * 32 + r) * LDT2 + jt * 32 + 16 * s + 4 * h];
          const uint2 lo = *(const uint2*)vrow;
          const uint2 hi = *(const uint2*)(vrow + 8);
          O[d] = MFMA(mk8(lo.x, lo.y, hi.x, hi.y), pf, O[d]);
        }
      }
    }
    {
      const float xf = __expf(lgf * (float)(qi + 1)), xb = __expf(lgb * (float)(128 - qi));
#pragma unroll
      for (int ks = 0; ks < 4; ++ks) {
        const uint4 q = qraw[ks];
        const bf16x8 qsf = mk8(pack2(bflo(q.x) * xf, bfhi(q.x) * xf), pack2(bflo(q.y) * xf, bfhi(q.y) * xf),
                               pack2(bflo(q.z) * xf, bfhi(q.z) * xf), pack2(bflo(q.w) * xf, bfhi(q.w) * xf));
        const bf16x8 qsb = mk8(pack2(bflo(q.x) * xb, bfhi(q.x) * xb), pack2(bflo(q.y) * xb, bfhi(q.y) * xb),
                               pack2(bflo(q.z) * xb, bfhi(q.z) * xb), pack2(bflo(q.w) * xb, bfhi(q.w) * xb));
#pragma unroll
        for (int d = 0; d < 2; ++d) {
          const bf16x8 sf = *(const bf16x8*)&sSTf[(d * 32 + r) * LDT + ks * 16 + 8 * h];
          const bf16x8 sb = *(const bf16x8*)&sSTb[(d * 32 + r) * LDT + ks * 16 + 8 * h];
          O[d] = MFMA(sf, qsf, O[d]);
          O[d] = MFMA(sb, qsb, O[d]);
        }
      }
    }
    float sum = 0.f;
#pragma unroll
    for (int d = 0; d < 2; ++d)
#pragma unroll
      for (int i = 0; i < 16; ++i) sum += O[d][i];
    sum += __shfl_xor(sum, 32);
    const float mu = sum * (1.f / 64.f);
    float vs = 0.f;
#pragma unroll
    for (int d = 0; d < 2; ++d)
#pragma unroll
      for (int i = 0; i < 16; ++i) { const float t = O[d][i] - mu; vs += t * t; }
    vs += __shfl_xor(vs, 32);
    const float rstd = rsqrtf(vs * (1.f / 64.f) + 1e-6f);
    const u16* grow = p.QKV + (size_t)(T0 + qi) * DIN + 2304 + head * 64;
    const float* gnw = p.gn + l * 256 + head * 64;
    u16* orow = p.CAT + (size_t)(T0 + qi) * DM + 768 + head * 64;
#pragma unroll
    for (int d = 0; d < 2; ++d)
#pragma unroll
      for (int g = 0; g < 4; ++g) {
        const int e = d * 32 + 8 * g + 4 * h;
        const uint2 gr = *(const uint2*)(grow + e);
        const float4 gw = *(const float4*)(gnw + e);
        const float o0 = silu(bflo(gr.x)) * (O[d][4 * g + 0] - mu) * rstd * gw.x;
        const float o1 = silu(bfhi(gr.x)) * (O[d][4 * g + 1] - mu) * rstd * gw.y;
        const float o2 = silu(bflo(gr.y)) * (O[d][4 * g + 2] - mu) * rstd * gw.z;
        const float o3 = silu(bfhi(gr.y)) * (O[d][4 * g + 3] - mu) * rstd * gw.w;
        uint2 pk = {pack2(o0, o1), pack2(o2, o3)};
        *(uint2*)(orow + e) = pk;
      }
  }
}

DI void phase3(const Params& p, char* smem, int l, const float* xc, const float* xl) {
  const float* W = p.w_out + (size_t)l * DM * DM;
  const int xcd = blockIdx.x & 7, nloc = gridDim.x >> 3;
  auto setup = [&](int s, int ar0, int ac, int n4, int kq, const u16*& q0, const u16*& q1, const u16*& q2, const u16*& q3, const float*& bp) {
    const int tm = 12 * xcd + s % 12, tn = s / 12;
    const u16* ab = p.CAT + ((size_t)tm * 128 + ar0) * DM + ac;
    q0 = ab; q1 = ab + 32 * DM; q2 = ab + 64 * DM; q3 = ab + 96 * DM;
    bp = W + tn * 128 + 4 * n4 + (size_t)(kq * 8) * DM;
  };
  auto epi = [&](int s, f32x16(&acc)[4], int w, int r, int h) {
    int hq = h;
    asm volatile("" : "+v"(hq));
    const int tm = 12 * xcd + s % 12, tn = s / 12;
    const int m0 = tm * 128, n0 = tn * 128;
    const float* g1 = p.MOD + (size_t)(l * 5 + cond_of(m0)) * 6144 + 2048;
    const int n = n0 + 4 * r;
    const float4 g = *(const float4*)(g1 + n);
#pragma unroll
    for (int i = 0; i < 16; ++i) {
      const int ml = w * 32 + crow(i, hq);
      const float4 o = {g.x * acc[0][i], g.y * acc[1][i], g.z * acc[2][i], g.w * acc[3][i]};
      *(float4*)(p.PRE + (size_t)(m0 + ml) * DM + n) = o;
    }
  };
  gemm_phase(smem, blockIdx.x >> 3, 96, nloc, setup, DM, epi);
}

DI void phase4(const Params& p, char* smem, int l, const float* xc, const float* xl) {
  float* swr = (float*)smem;
  const int tid = otid(), lane = tid & 63, w = tid >> 6;
  __syncthreads();
  for (int idx = tid; idx < 4096; idx += 256) {
    const float4 x = *(const float4*)(p.w_router + (size_t)l * DM * 16 + idx * 4);
    const int k = idx >> 2, e = (idx & 3) * 4;
    swr[(e + 0) * DM + k] = x.x; swr[(e + 1) * DM + k] = x.y; swr[(e + 2) * DM + k] = x.z; swr[(e + 3) * DM + k] = x.w;
  }
  __syncthreads();
  const float* lg = p.ln1g + l * DM;
  const float* lb = p.ln1b + l * DM;
  for (int T = blockIdx.x * 4 + w; T < NTOK; T += gridDim.x * 4) {
    const float* mod = p.MOD + (size_t)(l * 5 + cond_of(T)) * 6144;
    const float* xrow = (T < NCTX) ? (xc + (size_t)T * DM) : (xl + (size_t)(T - NCTX) * DM);
    float4 x[4];
    float s = 0.f;
#pragma unroll
    for (int i = 0; i < 4; ++i) {
      const float4 pr = *(const float4*)(p.PRE + (size_t)T * DM + 256 * i + 4 * lane);
      const float4 xi = *(const float4*)(xrow + 256 * i + 4 * lane);
      x[i].x = ALPHA * xi.x + pr.x; x[i].y = ALPHA * xi.y + pr.y; x[i].z = ALPHA * xi.z + pr.z; x[i].w = ALPHA * xi.w + pr.w;
      s += x[i].x + x[i].y + x[i].z + x[i].w;
    }
    const float mu = wave_sum(s) * (1.f / 1024.f);
    float vs = 0.f;
#pragma unroll
    for (int i = 0; i < 4; ++i) {
      x[i].x -= mu; x[i].y -= mu; x[i].z -= mu; x[i].w -= mu;
      vs += x[i].x * x[i].x + x[i].y * x[i].y + x[i].z * x[i].z + x[i].w * x[i].w;
    }
    const float rstd = rsqrtf(wave_sum(vs) * (1.f / 1024.f) + 1e-6f);
#pragma unroll
    for (int i = 0; i < 4; ++i) {
      const int k = 256 * i + 4 * lane;
      const float4 g = *(const float4*)(lg + k), bb = *(const float4*)(lb + k);
      float4 y;
      y.x = x[i].x * rstd * g.x + bb.x; y.y = x[i].y * rstd * g.y + bb.y; y.z = x[i].z * rstd * g.z + bb.z; y.w = x[i].w * rstd * g.w + bb.w;
      *(float4*)(p.X + (size_t)T * DM + k) = y;
      const float4 sc = *(const float4*)(mod + 4096 + k), sh = *(const float4*)(mod + 3072 + k);
      float4 hh;
      hh.x = y.x * (1.f + sc.x) + sh.x; hh.y = y.y * (1.f + sc.y) + sh.y; hh.z = y.z * (1.f + sc.z) + sh.z; hh.w = y.w * (1.f + sc.w) + sh.w;
      uint2 pk = {pack2(hh.x, hh.y), pack2(hh.z, hh.w)};
      *(uint2*)(p.H2 + (size_t)T * DM + k) = pk;
      x[i] = hh;
    }
    float mine = NEG;
#pragma unroll 1
    for (int e = 0; e < 16; ++e) {
      float a = 0.f;
#pragma unroll
      for (int i = 0; i < 4; ++i) {
        const float4 wv = *(const float4*)(swr + e * DM + 256 * i + 4 * lane);
        a += x[i].x * wv.x + x[i].y * wv.y + x[i].z * wv.z + x[i].w * wv.w;
      }
      a = wave_sum(a);
      mine = (lane == e) ? a : mine;
    }
    float mx = mine;
#pragma unroll
    for (int o = 8; o >= 1; o >>= 1) mx = fmaxf(mx, __shfl_xor(mx, o));
    const float ex = __expf(mine - mx);
    float den = ex;
#pragma unroll
    for (int o = 8; o >= 1; o >>= 1) den += __shfl_xor(den, o);
    mine = ex / den;
    if (lane < 16) { p.AFF[(size_t)T * 16 + lane] = mine; p.INV[(size_t)T * 16 + lane] = -1; }
  }
}

DI void phase5(const Params& p, char* smem) {
  float* sa = (float*)smem;
  const int tid = otid();
  for (int item = blockIdx.x; item < 768; item += gridDim.x) {
    int n, base, e, t, cap, rowbase;
    if (item < 512) {
      const int b = item >> 7; e = (item >> 3) & 15; const int seg = item & 7;
      n = 2048; base = NCTX + b * 2048; t = seg * 256 + tid; cap = 256; rowbase = 512 + b * 256;
    } else {
      const int it = item - 512; const int rq = it >> 4; e = it & 15;
      n = 256; base = rq * 256; t = tid; cap = 32; rowbase = rq * 32;
    }
    __syncthreads();
    for (int j = tid; j < n; j += 256) sa[j] = p.AFF[(size_t)(base + j) * 16 + e];
    __syncthreads();
    const float a = sa[t];
    int rank = 0;
    for (int j = 0; j < n; j += 4) {
      const float4 v = *(const float4*)(sa + j);
      rank += (v.x > a || (v.x == a && j < t)) ? 1 : 0;
      rank += (v.y > a || (v.y == a && j + 1 < t)) ? 1 : 0;
      rank += (v.z > a || (v.z == a && j + 2 < t)) ? 1 : 0;
      rank += (v.w > a || (v.w == a && j + 3 < t)) ? 1 : 0;
    }
    if (rank < cap) {
      p.SELTOK[e * NROWS_E + rowbase + rank] = base + t;
      p.SELGATE[e * NROWS_E + rowbase + rank] = a;
      p.INV[(size_t)(base + t) * 16 + e] = e * NROWS_E + rowbase + rank;
    }
  }
}

DI void phase6(const Params& p, char* smem, int l) {
  const int xcd = blockIdx.x & 7, nloc = gridDim.x >> 3;
  auto setup = [&](int s, int ar0, int ac, int n4, int kq, const u16*& q0, const u16*& q1, const u16*& q2, const u16*& q3, const float*& bp) {
    const int e = 2 * xcd + s / 192, rem = s % 192, tn = rem / 12, tm = rem % 12;
    const int* tok = p.SELTOK + e * NROWS_E + tm * 128 + ar0;
    q0 = p.H2 + (size_t)tok[0] * DM + ac; q1 = p.H2 + (size_t)tok[32] * DM + ac;
    q2 = p.H2 + (size_t)tok[64] * DM + ac; q3 = p.H2 + (size_t)tok[96] * DM + ac;
    bp = p.w_gu + ((size_t)l * 16 + e) * DM * 2048 + ((n4 >> 4) & 1) * 1024 + tn * 64 + 4 * (n4 & 15) + (size_t)(kq * 8) * 2048;
  };
  auto epi = [&](int s, f32x16(&acc)[4], int w, int r, int h) {
    int hq = h;
    asm volatile("" : "+v"(hq));
    const int e = 2 * xcd + s / 192, rem = s % 192, tn = rem / 12, tm = rem % 12;
    const int m0 = tm * 128, f0 = tn * 64;
    u16* act = p.ACT + ((size_t)e * NROWS_E + m0) * DM;
#pragma unroll
    for (int i = 0; i < 16; ++i) {
      const int ml = w * 32 + crow(i, hq);
      const float a0 = acc[0][i], a1 = acc[1][i], a2 = acc[2][i], a3 = acc[3][i];
      const float u0 = __shfl_xor(a0, 16), u1 = __shfl_xor(a1, 16), u2 = __shfl_xor(a2, 16), u3 = __shfl_xor(a3, 16);
      if (r < 16) {
        uint2 pk = {pack2(silu(a0) * u0, silu(a1) * u1), pack2(silu(a2) * u2, silu(a3) * u3)};
        *(uint2*)(act + (size_t)ml * DM + f0 + 4 * r) = pk;
      }
      if ((i & 3) == 3) __builtin_amdgcn_sched_barrier(0);
    }
  };
  gemm_phase(smem, blockIdx.x >> 3, 384, nloc, setup, 2048, epi);
}

DI void phase7(const Params& p, char* smem, int l, u16* FF) {
  const int xcd = blockIdx.x & 7, nloc = gridDim.x >> 3;
  auto setup = [&](int s, int ar0, int ac, int n4, int kq, const u16*& q0, const u16*& q1, const u16*& q2, const u16*& q3, const float*& bp) {
    const int e = 2 * xcd + s / 96, rem = s % 96, tn = rem / 12, tm = rem % 12;
    const u16* ab = p.ACT + ((size_t)e * NROWS_E + tm * 128 + ar0) * DM + ac;
    q0 = ab; q1 = ab + 32 * DM; q2 = ab + 64 * DM; q3 = ab + 96 * DM;
    bp = p.w_down + ((size_t)l * 16 + e) * DM * DM + tn * 128 + 4 * n4 + (size_t)(kq * 8) * DM;
  };
  auto epi = [&](int s, f32x16(&acc)[4], int w, int r, int h) {
    int hq = h;
    asm volatile("" : "+v"(hq));
    const int e = 2 * xcd + s / 96, rem = s % 96, tn = rem / 12, tm = rem % 12;
    const int m0 = tm * 128, n0 = tn * 128;
    const float* gate = p.SELGATE + e * NROWS_E + m0;
#pragma unroll
    for (int i = 0; i < 16; ++i) {
      const int ml = w * 32 + crow(i, hq);
      const float g = gate[ml];
      uint2 pk = {pack2(g * acc[0][i], g * acc[1][i]), pack2(g * acc[2][i], g * acc[3][i])};
      *(uint2*)(FF + ((size_t)e * NROWS_E + m0 + ml) * DM + n0 + 4 * r) = pk;
      if ((i & 3) == 3) __builtin_amdgcn_sched_barrier(0);
    }
  };
  gemm_phase(smem, blockIdx.x >> 3, 192, nloc, setup, DM, epi);
}

DI void phase8(const Params& p, int l, float* dst, bool write_h) {
  const int tid = otid(), lane = tid & 63, w = tid >> 6;
  const float* lg = p.ln2g + l * DM;
  const float* lb = p.ln2b + l * DM;
  for (int T = blockIdx.x * 4 + w; T < NTOK; T += gridDim.x * 4) {
    const float* g2 = p.MOD + (size_t)(l * 5 + cond_of(T)) * 6144 + 5120;
    const float* modn = p.MOD + (size_t)(5 + cond_of(T)) * 6144;
    float4 x[4], ff[4];
#pragma unroll
    for (int i = 0; i < 4; ++i) ff[i] = make_float4(0.f, 0.f, 0.f, 0.f);
    const int myinv = p.INV[(size_t)T * 16 + (lane & 15)];
#pragma unroll 1
    for (int e = 0; e < 16; ++e) {
      const int row = __shfl(myinv, e);
      if (row >= 0) {
#pragma unroll
        for (int i = 0; i < 4; ++i) {
          const uint2 y = *(const uint2*)(p.YE + (size_t)row * DM + 256 * i + 4 * lane);
          ff[i].x += bflo(y.x); ff[i].y += bfhi(y.x); ff[i].z += bflo(y.y); ff[i].w += bfhi(y.y);
        }
      }
    }
    float s = 0.f;
#pragma unroll
    for (int i = 0; i < 4; ++i) {
      const int k = 256 * i + 4 * lane;
      const float4 a = *(const float4*)(p.X + (size_t)T * DM + k);
      const float4 f = ff[i];
      const float4 g = *(const float4*)(g2 + k);
      x[i].x = ALPHA * a.x + g.x * f.x; x[i].y = ALPHA * a.y + g.y * f.y; x[i].z = ALPHA * a.z + g.z * f.z; x[i].w = ALPHA * a.w + g.w * f.w;
      s += x[i].x + x[i].y + x[i].z + x[i].w;
    }
    const float mu = wave_sum(s) * (1.f / 1024.f);
    float vs = 0.f;
#pragma unroll
    for (int i = 0; i < 4; ++i) {
      x[i].x -= mu; x[i].y -= mu; x[i].z -= mu; x[i].w -= mu;
      vs += x[i].x * x[i].x + x[i].y * x[i].y + x[i].z * x[i].z + x[i].w * x[i].w;
    }
    const float rstd = rsqrtf(wave_sum(vs) * (1.f / 1024.f) + 1e-6f);
#pragma unroll
    for (int i = 0; i < 4; ++i) {
      const int k = 256 * i + 4 * lane;
      const float4 g = *(const float4*)(lg + k), bb = *(const float4*)(lb + k);
      float4 y;
      y.x = x[i].x * rstd * g.x + bb.x; y.y = x[i].y * rstd * g.y + bb.y; y.z = x[i].z * rstd * g.z + bb.z; y.w = x[i].w * rstd * g.w + bb.w;
      *(float4*)(dst + (size_t)T * DM + k) = y;
      if (write_h) {
        const float4 sc = *(const float4*)(modn + 1024 + k), sh = *(const float4*)(modn + k);
        uint2 pk = {pack2(y.x * (1.f + sc.x) + sh.x, y.y * (1.f + sc.y) + sh.y), pack2(y.z * (1.f + sc.z) + sh.z, y.w * (1.f + sc.w) + sh.w)};
        *(uint2*)(p.H2 + (size_t)T * DM + k) = pk;
      }
    }
  }
}

__global__ void __launch_bounds__(256, 2) mega(Params p) {
  __shared__ __attribute__((aligned(16))) char smem[65536];
  cg::grid_group grid = cg::this_grid();
  if (p.never) grid.sync();
  GBar gb;
  gb.bar = p.BAR; gb.x = xb_xcc_id(); gb.nloc = 0u; gb.nx = 0u;
  if (threadIdx.x == 0) (void)xb_add(&p.BAR[XB_XCNT(gb.x)], 1u);
  phase0(p, smem);
  gbar(gb);
  phase0b(p);
  gbar(gb);
#pragma unroll 1
  for (int l = 0; l < 2; ++l) {
    const float* xc = (l == 0) ? p.x_prompt : p.X;
    const float* xl = (l == 0) ? p.x_sample : (p.X + (size_t)NCTX * DM);
    phase1(p, smem, l);
    gbar(gb);
    if (PROBE == 1) { phase1(p, smem, l); gbar(gb); }
    phase2(p, smem, l);
    gbar(gb);
    if (PROBE == 3) { phase2(p, smem, l); gbar(gb); }
    phase2c(p, smem, l);
    gbar(gb);
    if (PROBE == 3) { phase2c(p, smem, l); gbar(gb); }
    phase3(p, smem, l, xc, xl);
    gbar(gb);
    if (PROBE == 1) { phase3(p, smem, l, xc, xl); gbar(gb); }
    phase4(p, smem, l, xc, xl);
    gbar(gb);
    phase5(p, smem);
    gbar(gb);
    if (PROBE == 4) { phase5(p, smem); gbar(gb); }
    phase6(p, smem, l);
    gbar(gb);
    if (PROBE == 1) { phase6(p, smem, l); gbar(gb); }
    phase7(p, smem, l, p.YE);
    gbar(gb);
    phase8(p, l, (l == 1) ? p.out : p.X, l == 0);
    if (l == 0) gbar(gb);
  }
}

extern "C" void kernel_launch(void* const* d_in, const int* in_sizes, int n_in, void* d_out, int out_size, void* d_ws,
                              size_t ws_size, hipStream_t stream) {
  static int grid_blocks = 0;
  if (!grid_blocks) {
    int dev = 0, cus = 0, per_cu = 0;
    hipGetDevice(&dev);
    hipDeviceGetAttribute(&cus, hipDeviceAttributeMultiprocessorCount, dev);
    hipOccupancyMaxActiveBlocksPerMultiprocessor(&per_cu, mega, 256, 0);
    if (per_cu > 2) per_cu = 2;
    if (per_cu < 1) per_cu = 1;
    grid_blocks = cus * per_cu;
  }
  Params p{};
  const float** pf = (const float**)&p;
  for (int i = 0; i < 24; ++i) pf[i] = (const float*)d_in[i];
  p.out = (float*)d_out;
  char* ws = (char*)d_ws;
  size_t off = 0;
  auto take = [&](size_t bytes) { char* q = ws + off; off += (bytes + 255) & ~(size_t)255; return q; };
  p.MOD = (float*)take(2 * 5 * 6144 * 4);
  p.BAR = (unsigned*)take(XCD_BAR_WORDS * 4);
  p.ROPE = (float*)take(2048 * 4);
  p.X = (float*)take((size_t)NTOK * DM * 4);
  p.PRE = (float*)take((size_t)NTOK * DM * 4);
  p.KVS = (float*)take((size_t)20 * 4 * 2 * 16 * 4096 * 4);
  p.AFF = (float*)take((size_t)NTOK * 16 * 4);
  p.SELGATE = (float*)take((size_t)16 * NROWS_E * 4);
  p.SELTOK = (int*)take((size_t)16 * NROWS_E * 4);
  p.QKV = (u16*)take((size_t)NTOK * DIN * 2);
  p.CAT = (u16*)take((size_t)NTOK * DM * 2);
  p.H2 = (u16*)take((size_t)NTOK * DM * 2);
  p.ACT = (u16*)take((size_t)16 * NROWS_E * DM * 2);
  p.YE = (u16*)take((size_t)16 * NROWS_E * DM * 2);
  p.INV = (int*)take((size_t)NTOK * 16 * 4);
  p.never = 0;
  hipMemsetAsync(p.MOD, 0, (size_t)((char*)p.BAR - (char*)p.MOD) + XCD_BAR_WORDS * 4, stream);
  void* args[] = {&p};
  hipError_t e = hipLaunchCooperativeKernel((void*)mega, dim3(grid_blocks), dim3(256), args, 0, stream);
  if (e != hipSuccess) fprintf(stderr, "cooperative launch failed: %s (grid %d)\n", hipGetErrorString(e), grid_blocks);
}
```

```cpp
#include <hip/hip_runtime.h>
#include <hip/hip_cooperative_groups.h>
#include <cstdio>
namespace cg = cooperative_groups;

#define DI __device__ __forceinline__
typedef short bf16x8 __attribute__((ext_vector_type(8)));
typedef float f32x16 __attribute__((ext_vector_type(16)));
typedef __bf16 bf2_t __attribute__((ext_vector_type(2)));
typedef float f2_t __attribute__((ext_vector_type(2)));
typedef unsigned short u16;
typedef unsigned u32x4 __attribute__((ext_vector_type(4)));
typedef float f32x4 __attribute__((ext_vector_type(4)));
typedef float f32x2 __attribute__((ext_vector_type(2)));

#define MFMA(a, b, c) __builtin_amdgcn_mfma_f32_32x32x16_bf16((a), (b), (c), 0, 0, 0)

#define PROBE 0
constexpr int NTOK = 12288;
constexpr int NCTX = 4096;
constexpr int DM = 1024;
constexpr int DIN = 2560;
constexpr int LDT = 72;
constexpr int LDT2 = 136;
constexpr int NROWS_E = 1536;
constexpr float NEG = -1e30f;
constexpr float ALPHA = 1.41421356237f;

constexpr size_t OFF_AK = 12582912, OFF_AV = 13631488, OFF_BK = 14680064, OFF_BV = 16777216, OFF_ST = 18874368;

struct Params {
  const float *x_prompt, *x_sample, *cak, *cav, *cbk, *cbv, *state, *c, *c_ctx, *w_ada, *b_ada, *w_in, *w_out, *sink, *rpb,
      *decay, *gn, *ln1g, *ln1b, *ln2g, *ln2b, *w_router, *w_gu, *w_down;
  float* out;
  float *MOD, *ROPE, *X, *PRE, *KVS, *AFF, *SELGATE;
  int* SELTOK;
  u16 *QKV, *CAT, *H2, *ACT;
  u16* YE;
  int* INV;
  unsigned* BAR;
  long never;
};

DI unsigned pack2(float a, float b) {
  f2_t v = {a, b};
  bf2_t r = __builtin_convertvector(v, bf2_t);
  return __builtin_bit_cast(unsigned, r);
}
DI int otid() { int x = threadIdx.x; asm volatile("" : "+v"(x)); return x; }
DI float bflo(unsigned u) { return __uint_as_float(u << 16); }
DI float bfhi(unsigned u) { return __uint_as_float(u & 0xffff0000u); }
DI int crow(int i, int h) { return (i & 3) + 8 * (i >> 2) + 4 * h; }
DI float silu(float x) { return x / (1.f + __expf(-x)); }
DI float wave_sum(float v) {
#pragma unroll
  for (int o = 32; o >= 1; o >>= 1) v += __shfl_xor(v, o);
  return v;
}
DI bf16x8 mk8(unsigned a, unsigned b, unsigned c, unsigned d) {
  uint4 u = {a, b, c, d};
  return __builtin_bit_cast(bf16x8, u);
}


#define XB_TMO 128
#define XB_XCNT(j) (256 + 64 * (j))
#define XB_XSUB(j) (1280 + 64 * (j))
#define XB_XGEN(j) (2304 + 64 * (j))
#define XB_TOP 3328
#define XB_TOPGEN 3392
#define XCD_BAR_WORDS 3456
#define XB_SPIN_CAP (1u << 20)
DI unsigned xb_ld(unsigned* p) { return __hip_atomic_load(p, __ATOMIC_RELAXED, __HIP_MEMORY_SCOPE_AGENT); }
DI unsigned xb_add(unsigned* p, unsigned v) { return __hip_atomic_fetch_add(p, v, __ATOMIC_RELAXED, __HIP_MEMORY_SCOPE_AGENT); }
DI unsigned xb_xcc_id() { return (unsigned)__builtin_amdgcn_s_getreg((3 << 11) | 20) & 0xFu; }
#define XB_SPIN(cond, bar)                                                            \
  do {                                                                                \
    unsigned _sp = 0;                                                                 \
    while (cond) {                                                                    \
      __builtin_amdgcn_s_sleep(1);                                                    \
      if ((++_sp & 255u) == 0u) {                                                     \
        if (xb_ld(&(bar)[XB_TMO])) break;                                             \
        if (_sp > XB_SPIN_CAP) { atomicAdd(&(bar)[XB_TMO], 1u); break; }              \
      }                                                                               \
    }                                                                                 \
  } while (0)
struct GBar { unsigned* bar; unsigned x, nloc, nx; };
DI void gbar_complete(unsigned* bar, unsigned x, unsigned& nloc, unsigned& nx) {
  const unsigned G = gridDim.x;
  unsigned sum, cnt, mine, sp = 0u;
  for (;;) {
    sum = 0u; cnt = 0u; mine = 0u;
#pragma unroll
    for (unsigned j = 0; j < 16; ++j) {
      const unsigned c = xb_ld(&bar[XB_XCNT(j)]);
      sum += c; cnt += (c > 0u) ? 1u : 0u; mine = (j == x) ? c : mine;
    }
    if (sum == G) break;
    __builtin_amdgcn_s_sleep(1);
    if ((++sp & 255u) == 0u) {
      if (xb_ld(&bar[XB_TMO])) break;
      if (sp > XB_SPIN_CAP) { atomicAdd(&bar[XB_TMO], 1u); break; }
    }
  }
  nloc = mine > 0u ? mine : 1u;
  nx = cnt > 0u ? cnt : 1u;
}
DI void gbar(GBar& b) {
  asm volatile("s_waitcnt vmcnt(0)" ::: "memory");
  __syncthreads();
  if (threadIdx.x == 0) {
    unsigned* bar = b.bar;
    __builtin_amdgcn_s_waitcnt(0);
    if (b.nloc == 0u) gbar_complete(bar, b.x, b.nloc, b.nx);
    const unsigned nloc = b.nloc, nx = b.nx;
    const unsigned old = xb_add(&bar[XB_XSUB(b.x)], 1u);
    const unsigned gen = old / nloc;
    if (old + 1u == (gen + 1u) * nloc) {
      __builtin_amdgcn_fence(__ATOMIC_RELEASE, "agent");
      asm volatile("s_waitcnt vmcnt(0)" ::: "memory");
      const unsigned og = xb_add(&bar[XB_TOP], 1u);
      const unsigned tg = og / nx;
      if (og + 1u == (tg + 1u) * nx) xb_add(&bar[XB_TOPGEN], 1u);
      else XB_SPIN(xb_ld(&bar[XB_TOPGEN]) == tg, bar);
      __builtin_amdgcn_fence(__ATOMIC_ACQUIRE, "agent");
      xb_add(&bar[XB_XGEN(b.x)], 1u);
      asm volatile("s_waitcnt vmcnt(0)" ::: "memory");
    } else {
      XB_SPIN(xb_ld(&bar[XB_XGEN(b.x)]) == gen, bar);
      __builtin_amdgcn_fence(__ATOMIC_ACQUIRE, "agent");
      asm volatile("s_waitcnt vmcnt(0)" ::: "memory");
    }
  }
  __syncthreads();
}

template <class Setup, class Epi>
DI void gemm_phase(char* smem, int s0, int s_end, int s_step, Setup setup, int ldb, Epi epi) {
  if (s0 >= s_end) return;
  u16* sA0 = (u16*)smem;
  u16* sB0 = sA0 + 128 * LDT;
  u16* sA1 = sB0 + 128 * LDT;
  u16* sB1 = sA1 + 128 * LDT;
  const int tid = otid(), lane = tid & 63, w = tid >> 6, r = lane & 31, h = lane >> 5;
  const int a_r0 = tid >> 3, a_c = (tid & 7) * 8;
  const int b_n4 = tid & 31, b_kq = tid >> 5;
  const u16 *apb0, *apb1, *apb2, *apb3;
  const float* bp;
  setup(s0, a_r0, a_c, b_n4, b_kq, apb0, apb1, apb2, apb3, bp);

  u32x4 pa0, pa1, pa2, pa3;
  f32x4 pb[8];

#define G_LOAD(KT)                                                                       \
  {                                                                                      \
    const int k0_ = (KT) * 64;                                                           \
    pa0 = *(const u32x4*)(apb0 + k0_);                                                   \
    pa1 = *(const u32x4*)(apb1 + k0_);                                                   \
    pa2 = *(const u32x4*)(apb2 + k0_);                                                   \
    pa3 = *(const u32x4*)(apb3 + k0_);                                                   \
    _Pragma("unroll") for (int i_ = 0; i_ < 8; ++i_) pb[i_] = *(const f32x4*)(bp + (size_t)(k0_ + i_) * ldb); \
  }
#define G_STAGE(SA, SBB)                                                                 \
  {                                                                                      \
    *(u32x4*)&SA[(a_r0)*LDT + a_c] = pa0;                                                \
    *(u32x4*)&SA[(a_r0 + 32) * LDT + a_c] = pa1;                                         \
    *(u32x4*)&SA[(a_r0 + 64) * LDT + a_c] = pa2;                                         \
    *(u32x4*)&SA[(a_r0 + 96) * LDT + a_c] = pa3;                                         \
    _Pragma("unroll") for (int j_ = 0; j_ < 4; ++j_) {                                   \
      u32x4 pk_;                                                                         \
      pk_.x = pack2(pb[0][j_], pb[1][j_]);                                               \
      pk_.y = pack2(pb[2][j_], pb[3][j_]);                                               \
      pk_.z = pack2(pb[4][j_], pb[5][j_]);                                               \
      pk_.w = pack2(pb[6][j_], pb[7][j_]);                                               \
      *(u32x4*)&SBB[(j_ * 32 + b_n4) * LDT + b_kq * 8] = pk_;                            \
    }                                                                                    \
  }
  const int aoff = (w * 32 + r) * LDT + 8 * h, boff = r * LDT + 8 * h;
#define G_FRAG(BUF, SA, SBB, KS)                                                         \
  {                                                                                      \
    fa[BUF] = *(const bf16x8*)(SA + aoff + (KS) * 16);                                   \
    fb[BUF][0] = *(const bf16x8*)(SBB + boff + (KS) * 16);                               \
    fb[BUF][1] = *(const bf16x8*)(SBB + boff + 32 * LDT + (KS) * 16);                    \
    fb[BUF][2] = *(const bf16x8*)(SBB + boff + 64 * LDT + (KS) * 16);                    \
    fb[BUF][3] = *(const bf16x8*)(SBB + boff + 96 * LDT + (KS) * 16);                    \
  }
#define G_MFMA(BUF)                                                                      \
  {                                                                                      \
    acc[0] = MFMA(fa[BUF], fb[BUF][0], acc[0]);                                          \
    acc[1] = MFMA(fa[BUF], fb[BUF][1], acc[1]);                                          \
    acc[2] = MFMA(fa[BUF], fb[BUF][2], acc[2]);                                          \
    acc[3] = MFMA(fa[BUF], fb[BUF][3], acc[3]);                                          \
  }
#define SB() __builtin_amdgcn_sched_barrier(0)
#define G_COMPUTE(SA, SBB)                                                               \
  {                                                                                      \
    bf16x8 fa[2], fb[2][4];                                                              \
    G_FRAG(0, SA, SBB, 0);                                                               \
    G_FRAG(1, SA, SBB, 1);                                                               \
    SB();                                                                                \
    G_MFMA(0);                                                                           \
    SB();                                                                                \
    G_FRAG(0, SA, SBB, 2);                                                               \
    SB();                                                                                \
    G_MFMA(1);                                                                           \
    SB();                                                                                \
    G_FRAG(1, SA, SBB, 3);                                                               \
    SB();                                                                                \
    G_MFMA(0);                                                                           \
    SB();                                                                                \
    G_MFMA(1);                                                                           \
    SB();                                                                                \
  }

  G_LOAD(0);
  __syncthreads();
#pragma unroll 1
  for (int s = s0; s < s_end; s += s_step) {
    f32x16 acc[4];
#pragma unroll
    for (int a = 0; a < 4; ++a)
#pragma unroll
      for (int i = 0; i < 16; ++i) acc[a][i] = 0.f;
    const int sn = s + s_step;
    const bool has_next = sn < s_end;
    const u16 *n0 = apb0, *n1 = apb1, *n2 = apb2, *n3 = apb3;
    const float* nbp = bp;
    if (has_next) setup(sn, a_r0, a_c, b_n4, b_kq, n0, n1, n2, n3, nbp);
#pragma unroll 1
    for (int kt = 0; kt < 16; kt += 2) {
      G_STAGE(sA0, sB0);
      __syncthreads();
      G_LOAD(kt + 1);
      G_COMPUTE(sA0, sB0);
      G_STAGE(sA1, sB1);
      __syncthreads();
      {
        int kn = kt + 2;
        if (kt == 14) { apb0 = n0; apb1 = n1; apb2 = n2; apb3 = n3; bp = nbp; kn = 0; }
        G_LOAD(kn);
      }
      G_COMPUTE(sA1, sB1);
    }
    epi(s, acc, w, r, h);
  }
  __syncthreads();
#undef G_LOAD
#undef G_STAGE
#undef G_COMPUTE
#undef G_FRAG
#undef G_MFMA
}

DI void load4x4(const void* base, int stride, bool isf32, int rq, int c4, float v[4][4]) {
  if (isf32) {
#pragma unroll
    for (int i = 0; i < 4; ++i) {
      const float4 x = *(const float4*)((const float*)base + (size_t)(4 * rq + i) * stride + 4 * c4);
      v[i][0] = x.x; v[i][1] = x.y; v[i][2] = x.z; v[i][3] = x.w;
    }
  } else {
#pragma unroll
    for (int i = 0; i < 4; ++i) {
      const uint2 x = *(const uint2*)((const u16*)base + (size_t)(4 * rq + i) * stride + 4 * c4);
      v[i][0] = bflo(x.x); v[i][1] = bfhi(x.x); v[i][2] = bflo(x.y); v[i][3] = bfhi(x.y);
    }
  }
}
DI void store_n(u16* dst, int ld, int row0, int rq, int c4, const float v[4][4]) {
#pragma unroll
  for (int i = 0; i < 4; ++i) {
    uint2 pk = {pack2(v[i][0], v[i][1]), pack2(v[i][2], v[i][3])};
    *(uint2*)&dst[(row0 + 4 * rq + i) * ld + 4 * c4] = pk;
  }
}
DI void store_t(u16* dst, int ld, int col0, int rq, int c4, const float v[4][4], const float s[4]) {
#pragma unroll
  for (int j = 0; j < 4; ++j) {
    uint2 pk = {pack2(v[0][j] * s[0], v[1][j] * s[1]), pack2(v[2][j] * s[2], v[3][j] * s[3])};
    *(uint2*)&dst[(4 * c4 + j) * ld + col0 + 4 * rq] = pk;
  }
}

template <class TileSrc, class BiasF, class TMode>
DI void attn_core(char* smem, const u16* qbase, int ntiles, TileSrc src, BiasF biasf, TMode tmode, float m_init, bool has_sink, u16* obase) {
  u16* sK = (u16*)smem;
  u16* sVT = sK + 64 * LDT;
  const int tid = otid(), lane = tid & 63, w = tid >> 6, r = lane & 31, h = lane >> 5;
  const int rq = tid >> 4, c4 = tid & 15;
  const int ql = w * 32 + r;
  bf16x8 qf[4];
#pragma unroll
  for (int ks = 0; ks < 4; ++ks) qf[ks] = *(const bf16x8*)(qbase + (size_t)ql * DIN + ks * 16 + 8 * h);
  f32x16 O[2];
#pragma unroll
  for (int d = 0; d < 2; ++d)
#pragma unroll
    for (int i = 0; i < 16; ++i) O[d][i] = 0.f;
  float m = m_init, lsum = (has_sink && h == 0) ? 1.f : 0.f;
  const float one4[4] = {1.f, 1.f, 1.f, 1.f};

  u32x4 kraw[4], vraw[4];
#pragma unroll
  for (int i = 0; i < 4; ++i) { kraw[i] = (u32x4){0u, 0u, 0u, 0u}; vraw[i] = (u32x4){0u, 0u, 0u, 0u}; }
  bool cur_f32 = false, nxt_f32 = false;
  int j = 0;
  {
    const void *kp = nullptr, *vp = nullptr;
    int stride = 0;
    while (j < ntiles && !src(j, kp, vp, stride, nxt_f32)) ++j;
    if (j < ntiles) {
      if (nxt_f32) {
#pragma unroll
        for (int i = 0; i < 4; ++i) {
          kraw[i] = *(const u32x4*)((const float*)kp + (size_t)(4 * rq + i) * stride + 4 * c4);
          vraw[i] = *(const u32x4*)((const float*)vp + (size_t)(4 * rq + i) * stride + 4 * c4);
        }
      } else {
#pragma unroll
        for (int i = 0; i < 4; ++i) {
          const uint2 a = *(const uint2*)((const u16*)kp + (size_t)(4 * rq + i) * stride + 4 * c4);
          const uint2 c = *(const uint2*)((const u16*)vp + (size_t)(4 * rq + i) * stride + 4 * c4);
          kraw[i].x = a.x; kraw[i].y = a.y; vraw[i].x = c.x; vraw[i].y = c.y;
        }
      }
    }
  }
#pragma unroll 1
  while (j < ntiles) {
    cur_f32 = nxt_f32;
    __syncthreads();
    {
      float v[4][4];
#pragma unroll
      for (int i = 0; i < 4; ++i) {
        if (cur_f32) { v[i][0] = __uint_as_float(kraw[i].x); v[i][1] = __uint_as_float(kraw[i].y); v[i][2] = __uint_as_float(kraw[i].z); v[i][3] = __uint_as_float(kraw[i].w); }
        else { v[i][0] = bflo(kraw[i].x); v[i][1] = bfhi(kraw[i].x); v[i][2] = bflo(kraw[i].y); v[i][3] = bfhi(kraw[i].y); }
      }
      store_n(sK, LDT, 0, rq, c4, v);
#pragma unroll
      for (int i = 0; i < 4; ++i) {
        if (cur_f32) { v[i][0] = __uint_as_float(vraw[i].x); v[i][1] = __uint_as_float(vraw[i].y); v[i][2] = __uint_as_float(vraw[i].z); v[i][3] = __uint_as_float(vraw[i].w); }
        else { v[i][0] = bflo(vraw[i].x); v[i][1] = bfhi(vraw[i].x); v[i][2] = bflo(vraw[i].y); v[i][3] = bfhi(vraw[i].y); }
      }
      store_t(sVT, LDT, 0, rq, c4, v, one4);
    }
    __syncthreads();
    const int jc = j;
    {
      const void *kp = nullptr, *vp = nullptr;
      int stride = 0;
      ++j;
      while (j < ntiles && !src(j, kp, vp, stride, nxt_f32)) ++j;
      if (j < ntiles) {
        if (nxt_f32) {
#pragma unroll
          for (int i = 0; i < 4; ++i) {
            kraw[i] = *(const u32x4*)((const float*)kp + (size_t)(4 * rq + i) * stride + 4 * c4);
            vraw[i] = *(const u32x4*)((const float*)vp + (size_t)(4 * rq + i) * stride + 4 * c4);
          }
        } else {
#pragma unroll
          for (int i = 0; i < 4; ++i) {
            const uint2 a = *(const uint2*)((const u16*)kp + (size_t)(4 * rq + i) * stride + 4 * c4);
            const uint2 c = *(const uint2*)((const u16*)vp + (size_t)(4 * rq + i) * stride + 4 * c4);
            kraw[i].x = a.x; kraw[i].y = a.y; vraw[i].x = c.x; vraw[i].y = c.y;
          }
        }
      }
    }
    const int mode = tmode(jc, w);
    if (mode != 2) {
      f32x16 S[2];
#pragma unroll
      for (int mt = 0; mt < 2; ++mt)
#pragma unroll
        for (int i = 0; i < 16; ++i) S[mt][i] = 0.f;
#pragma unroll
      for (int ks = 0; ks < 4; ++ks)
#pragma unroll
        for (int mt = 0; mt < 2; ++mt) {
          const bf16x8 kf = *(const bf16x8*)&sK[(mt * 32 + r) * LDT + ks * 16 + 8 * h];
          S[mt] = MFMA(kf, qf[ks], S[mt]);
        }
      const float C2 = 0.125f * 1.44269504f;
      float mx = NEG;
      if (mode == 1) {
#pragma unroll
        for (int mt = 0; mt < 2; ++mt)
#pragma unroll
          for (int i = 0; i < 16; ++i) {
            const float s = S[mt][i] * C2 + biasf(jc, mt * 32 + crow(i, h), ql);
            S[mt][i] = s;
            mx = fmaxf(mx, s);
          }
      } else {
#pragma unroll
        for (int mt = 0; mt < 2; ++mt)
#pragma unroll
          for (int i = 0; i < 16; ++i) {
            const float s = S[mt][i] * C2;
            S[mt][i] = s;
            mx = fmaxf(mx, s);
          }
      }
      mx = fmaxf(mx, __shfl_xor(mx, 32));
      const float mn = fmaxf(m, mx);
      if (__any(mn > m)) {
        const float alpha = __builtin_amdgcn_exp2f(m - mn);
        m = mn;
        lsum *= alpha;
#pragma unroll
        for (int d = 0; d < 2; ++d)
#pragma unroll
          for (int i = 0; i < 16; ++i) O[d][i] *= alpha;
      }
      float ps = 0.f;
#pragma unroll
      for (int mt = 0; mt < 2; ++mt)
#pragma unroll
        for (int i = 0; i < 16; ++i) {
          const float pv = __builtin_amdgcn_exp2f(S[mt][i] - m);
          S[mt][i] = pv;
          ps += pv;
        }
      lsum += ps;
#pragma unroll
      for (int mt = 0; mt < 2; ++mt)
#pragma unroll
        for (int s = 0; s < 2; ++s) {
          const bf16x8 pf = mk8(pack2(S[mt][8 * s + 0], S[mt][8 * s + 1]), pack2(S[mt][8 * s + 2], S[mt][8 * s + 3]),
                                pack2(S[mt][8 * s + 4], S[mt][8 * s + 5]), pack2(S[mt][8 * s + 6], S[mt][8 * s + 7]));
#pragma unroll
          for (int d = 0; d < 2; ++d) {
            const u16* vrow = &sVT[(d * 32 + r) * LDT + mt * 32 + 16 * s + 4 * h];
            const uint2 lo = *(const uint2*)vrow;
            const uint2 hi = *(const uint2*)(vrow + 8);
            O[d] = MFMA(mk8(lo.x, lo.y, hi.x, hi.y), pf, O[d]);
          }
        }
    }
  }
  const float l = lsum + __shfl_xor(lsum, 32);
  const float inv = 1.f / l;
#pragma unroll
  for (int d = 0; d < 2; ++d)
#pragma unroll
    for (int g = 0; g < 4; ++g) {
      uint2 pk = {pack2(O[d][4 * g + 0] * inv, O[d][4 * g + 1] * inv), pack2(O[d][4 * g + 2] * inv, O[d][4 * g + 3] * inv)};
      *(uint2*)(obase + (size_t)ql * DM + d * 32 + 8 * g + 4 * h) = pk;
    }
}

DI void phase0(const Params& p, char* smem) {
  const int tid = otid();
  if (blockIdx.x == 0) {
    for (int idx = tid; idx < 1024; idx += 256) {
      const int pos = idx >> 4, j = idx & 15;
      const double inv = 1.0 / pow(10000.0, (double)j / 16.0);
      const float ang = (float)((double)pos * inv);
      p.ROPE[idx] = cosf(ang);
      p.ROPE[1024 + idx] = sinf(ang);
    }
  }
  float* scond = (float*)smem;
  for (int item = blockIdx.x; item < 768; item += gridDim.x) {
    const int l = item / 384, ks = (item / 24) % 16, jb = item % 24;
    __syncthreads();
    for (int idx = tid; idx < 320; idx += 256) {
      const int c = idx / 64, k = ks * 64 + (idx & 63);
      const float v = (c == 0) ? p.c_ctx[k] : p.c[(c - 1) * DM + k];
      scond[idx] = silu(v);
    }
    __syncthreads();
    const int j = jb * 256 + tid;
    const float* wp = p.w_ada + ((size_t)l * DM + ks * 64) * 6144 + j;
    float a[5] = {0.f, 0.f, 0.f, 0.f, 0.f};
#pragma unroll 8
    for (int k = 0; k < 64; ++k) {
      const float wv = wp[(size_t)k * 6144];
#pragma unroll
      for (int c = 0; c < 5; ++c) a[c] += scond[c * 64 + k] * wv;
    }
    const float bias = (ks == 0) ? p.b_ada[l * 6144 + j] : 0.f;
#pragma unroll
    for (int c = 0; c < 5; ++c) unsafeAtomicAdd(&p.MOD[(l * 5 + c) * 6144 + j], a[c] + bias);
  }
}

DI int cond_of(int T) { return T < NCTX ? 0 : 1 + ((T - NCTX) >> 11); }

DI void phase0b(const Params& p) {
  const int tid = otid(), lane = tid & 63, w = tid >> 6;
  for (int T = blockIdx.x * 4 + w; T < NTOK; T += gridDim.x * 4) {
    const float* mod = p.MOD + (size_t)cond_of(T) * 6144;
    const float* xr = (T < NCTX) ? (p.x_prompt + (size_t)T * DM) : (p.x_sample + (size_t)(T - NCTX) * DM);
#pragma unroll
    for (int i = 0; i < 4; ++i) {
      const int k = 256 * i + 4 * lane;
      const float4 x = *(const float4*)(xr + k);
      const float4 sc = *(const float4*)(mod + 1024 + k), sh = *(const float4*)(mod + k);
      uint2 pk = {pack2(x.x * (1.f + sc.x) + sh.x, x.y * (1.f + sc.y) + sh.y), pack2(x.z * (1.f + sc.z) + sh.z, x.w * (1.f + sc.w) + sh.w)};
      *(uint2*)(p.H2 + (size_t)T * DM + k) = pk;
    }
  }
}

DI void phase1(const Params& p, char* smem, int l) {
  const float* W = p.w_in + (size_t)l * DM * DIN;
  const int xcd = blockIdx.x & 7, nloc = gridDim.x >> 3;
  auto setup = [&](int s, int ar0, int ac, int n4, int kq, const u16*& q0, const u16*& q1, const u16*& q2, const u16*& q3, const float*& bp) {
    const int tm = 12 * xcd + s % 12, tn = s / 12;
    const u16* ab = p.H2 + ((size_t)tm * 128 + ar0) * DM + ac;
    q0 = ab; q1 = ab + 32 * DM; q2 = ab + 64 * DM; q3 = ab + 96 * DM;
    bp = W + tn * 128 + 4 * n4 + (size_t)(kq * 8) * DIN;
  };
  auto epi = [&](int s, f32x16(&acc)[4], int w, int r, int h) {
    int hq = h;
    asm volatile("" : "+v"(hq));
    const int tm = 12 * xcd + s % 12, tn = s / 12;
    const int m0 = tm * 128, n0 = tn * 128;
    const bool lat = m0 >= NCTX;
    const bool rope = lat && (n0 < 640);
    const int n = n0 + 4 * r;
    const int q = (r >> 2) & 3;
#pragma unroll
    for (int i = 0; i < 16; ++i) {
      const int T = m0 + w * 32 + crow(i, hq);
      float v0 = acc[0][i], v1 = acc[1][i], v2 = acc[2][i], v3 = acc[3][i];
      if (rope) {
        const int t = (T - NCTX) & 2047;
        const int pos = (q < 2) ? (t >> 6) : (t & 63);
        const int jf = 4 * (r & 3);
        const float4 cs = *(const float4*)(p.ROPE + pos * 16 + jf), sn = *(const float4*)(p.ROPE + 1024 + pos * 16 + jf);
        const float o0 = __shfl_xor(v0, 4), o1 = __shfl_xor(v1, 4), o2 = __shfl_xor(v2, 4), o3 = __shfl_xor(v3, 4);
        if (q & 1) { v0 = o0 * sn.x + v0 * cs.x; v1 = o1 * sn.y + v1 * cs.y; v2 = o2 * sn.z + v2 * cs.z; v3 = o3 * sn.w + v3 * cs.w; }
        else { v0 = v0 * cs.x - o0 * sn.x; v1 = v1 * cs.y - o1 * sn.y; v2 = v2 * cs.z - o2 * sn.z; v3 = v3 * cs.w - o3 * sn.w; }
      }
      uint2 pk = {pack2(v0, v1), pack2(v2, v3)};
      *(uint2*)(p.QKV + (size_t)T * DIN + n) = pk;
      if (!lat) {
        const int b = T >> 8, t = T & 255;
        const float4 vv = {v0, v1, v2, v3};
        if (n0 == 512) *(float4*)(p.out + OFF_AK + ((size_t)(b * 2 + l) * 256 + t) * 128 + (n - 512)) = vv;
        else if (n0 == 640) *(float4*)(p.out + OFF_AV + ((size_t)(b * 2 + l) * 256 + t) * 128 + (n - 640)) = vv;
        else if (n0 == 1024 || n0 == 1152) *(float4*)(p.out + OFF_BK + ((size_t)(b * 2 + l) * 256 + t) * 256 + (n - 1024)) = vv;
        else if (n0 == 1280 || n0 == 1408) *(float4*)(p.out + OFF_BV + ((size_t)(b * 2 + l) * 256 + t) * 256 + (n - 1280)) = vv;
      }
      if ((i & 3) == 3) __builtin_amdgcn_sched_barrier(0);
    }
  };
  gemm_phase(smem, blockIdx.x >> 3, 240, nloc, setup, DIN, epi);
}

DI float ret_lg(const Params& p, int l, int dir, int head) { return -__expf(p.decay[(l * 2 + dir) * 4 + head]); }

DI size_t kvs_slot(int req, int head, int dir, int c) { return ((size_t)((req * 4 + head) * 2 + dir) * 16 + c) * 4096; }

DI void retkv_item(const Params& p, char* smem, int l, int req, int head, int c) {
  u16* sKTf = (u16*)smem;
  u16* sKTb = sKTf + 64 * LDT2;
  u16* sVT = sKTb + 64 * LDT2;
  const int tid = otid(), lane = tid & 63, w = tid >> 6, r = lane & 31, h = lane >> 5;
  const int rq = tid >> 4, c4 = tid & 15;
  const int T0 = (req < 16 ? req * 256 : NCTX + (req - 16) * 2048) + c * 128;
  const float lgf = ret_lg(p, l, 0, head), lgb = ret_lg(p, l, 1, head);
  const float one4[4] = {1.f, 1.f, 1.f, 1.f};
  __syncthreads();
#pragma unroll
  for (int half = 0; half < 2; ++half) {
    float v[4][4];
    float sf[4], sb[4];
#pragma unroll
    for (int i = 0; i < 4; ++i) {
      const int j = half * 64 + 4 * rq + i;
      sf[i] = 0.125f * __expf(lgf * (float)(127 - j));
      sb[i] = 0.125f * __expf(lgb * (float)j);
    }
    load4x4(p.QKV + (size_t)(T0 + half * 64) * DIN + 1792 + head * 64, DIN, false, rq, c4, v);
    store_t(sKTf, LDT2, half * 64, rq, c4, v, sf);
    store_t(sKTb, LDT2, half * 64, rq, c4, v, sb);
    load4x4(p.QKV + (size_t)(T0 + half * 64) * DIN + 2048 + head * 64, DIN, false, rq, c4, v);
    store_t(sVT, LDT2, half * 64, rq, c4, v, one4);
  }
  __syncthreads();
  const int dir = w >> 1, mt = w & 1;
  const u16* sKT = dir ? sKTb : sKTf;
  f32x16 acc[2];
#pragma unroll
  for (int nt = 0; nt < 2; ++nt)
#pragma unroll
    for (int i = 0; i < 16; ++i) acc[nt][i] = 0.f;
#pragma unroll
  for (int ks = 0; ks < 8; ++ks) {
    const bf16x8 fa = *(const bf16x8*)&sKT[(mt * 32 + r) * LDT2 + ks * 16 + 8 * h];
#pragma unroll
    for (int nt = 0; nt < 2; ++nt) {
      const bf16x8 fb = *(const bf16x8*)&sVT[(nt * 32 + r) * LDT2 + ks * 16 + 8 * h];
      acc[nt] = MFMA(fa, fb, acc[nt]);
    }
  }
  float* dst = p.KVS + kvs_slot(req, head, dir, c);
#pragma unroll
  for (int nt = 0; nt < 2; ++nt)
#pragma unroll
    for (int i = 0; i < 16; ++i) dst[(mt * 32 + crow(i, h)) * 64 + nt * 32 + r] = acc[nt][i];
}

DI void phase2(const Params& p, char* smem, int l) {
  const int tid = otid();
  for (int item = blockIdx.x; item < 1536; item += gridDim.x) {
    if (item < 512) {
      const int b = item >> 7, head = (item >> 4) & 7, qb = item & 15, kvh = head >> 2;
      const int T0 = NCTX + b * 2048 + qb * 128;
      const float* ck = p.cak + ((size_t)(b * 2 + l) * 512) * 128 + kvh * 64;
      const float* cv = p.cav + ((size_t)(b * 2 + l) * 512) * 128 + kvh * 64;
      auto src = [&](int j, const void*& kp, const void*& vp, int& stride, bool& isf32) -> bool {
        if (j < 8) {
          kp = ck + (size_t)j * 64 * 128; vp = cv + (size_t)j * 64 * 128; stride = 128; isf32 = true;
          return true;
        }
        const int jj = j - 8, kb = qb - 1 + (jj >> 1);
        if (kb < 0 || kb >= 16) return false;
        const int Tk = NCTX + b * 2048 + kb * 128 + (jj & 1) * 64;
        kp = p.QKV + (size_t)Tk * DIN + 512 + kvh * 64; vp = p.QKV + (size_t)Tk * DIN + 640 + kvh * 64; stride = DIN; isf32 = false;
        return true;
      };
      auto biasf = [&](int j, int key, int ql) -> float {
        if (j < 8) return 0.f;
        const int jj = j - 8;
        const int kj = (qb - 1 + (jj >> 1)) * 128 + (jj & 1) * 64 + key;
        const int qi = qb * 128 + ql;
        const int d = qi - kj;
        return (d <= 128 && d >= -128) ? 0.f : NEG;
      };
      auto tmode = [&](int j, int w) -> int {
        if (j < 8) return 0;
        const int jj = j - 8;
        const int k0 = (qb - 1 + (jj >> 1)) * 128 + (jj & 1) * 64, q0w = qb * 128 + w * 32;
        if (k0 - (q0w + 31) > 128 || q0w - (k0 + 63) > 128) return 2;
        if ((q0w + 31) - k0 <= 128 && (k0 + 63) - q0w <= 128) return 0;
        return 1;
      };
      attn_core(smem, p.QKV + (size_t)T0 * DIN + head * 64, 14, src, biasf, tmode, p.sink[l * 8 + head] * 1.44269504f, true,
                p.CAT + (size_t)T0 * DM + head * 64);
    } else if (item < 768) {
      const int it = item - 512;
      const int b = it >> 6, head = (it >> 4) & 3, qb = it & 15;
      const int T0 = NCTX + b * 2048 + qb * 128;
      float* srpb = (float*)(smem + 2 * 64 * LDT * 2);
      __syncthreads();
      for (int idx = tid; idx < 465; idx += 256) srpb[idx] = p.rpb[(size_t)(l * 4 + head) * 465 + idx] * 1.44269504f;
      const int r0 = 2 * qb;
      const int rmin = min(max(r0 - 4, 0), 24), rmax = min(max(r0 + 1 - 4, 0), 24) + 7;
      const float* ck = p.cbk + ((size_t)(b * 2 + l) * 512) * 256 + head * 64;
      const float* cv = p.cbv + ((size_t)(b * 2 + l) * 512) * 256 + head * 64;
      auto src = [&](int j, const void*& kp, const void*& vp, int& stride, bool& isf32) -> bool {
        if (j < 8) {
          kp = ck + (size_t)j * 64 * 256; vp = cv + (size_t)j * 64 * 256; stride = 256; isf32 = true;
          return true;
        }
        const int Tk = NCTX + b * 2048 + (rmin + j - 8) * 64;
        kp = p.QKV + (size_t)Tk * DIN + 1024 + head * 64; vp = p.QKV + (size_t)Tk * DIN + 1280 + head * 64; stride = DIN; isf32 = false;
        return true;
      };
      auto biasf = [&](int j, int key, int ql) -> float {
        if (j < 8) return 0.f;
        const int kr = rmin + j - 8, kc = key;
        const int qr = r0 + (ql >> 6), qc = ql & 63;
        const int rs = min(max(qr - 4, 0), 24), cs = min(max(qc - 8, 0), 48);
        const bool ok = (kr >= rs) && (kr < rs + 8) && (kc >= cs) && (kc < cs + 16);
        const int bi = ok ? ((kr - qr + 7) * 31 + (kc - qc + 15)) : 0;
        const float bv = srpb[bi];
        return ok ? bv : NEG;
      };
      auto tmode = [&](int j, int w) -> int {
        if (j < 8) return 0;
        const int kr = rmin + j - 8, qr = r0 + (w >> 1);
        const int rs = min(max(qr - 4, 0), 24);
        return (kr >= rs && kr < rs + 8) ? 1 : 2;
      };
      attn_core(smem, p.QKV + (size_t)T0 * DIN + 768 + head * 64, 8 + (rmax - rmin + 1), src, biasf, tmode, NEG, false,
                p.CAT + (size_t)T0 * DM + 512 + head * 64);
    } else if (item < 1152) {
      const int it = item - 768;
      if (it < 256) retkv_item(p, smem, l, 16 + (it >> 6), (it >> 4) & 3, it & 15);
      else { const int i2 = it - 256; retkv_item(p, smem, l, i2 >> 3, (i2 >> 1) & 3, i2 & 1); }
    } else if (item < 1408) {
      const int it = item - 1152;
      const int b = it >> 4, head = (it >> 1) & 7, qh = it & 1, kvh = head >> 2;
      const int T0 = b * 256 + qh * 128;
      auto src = [&](int j, const void*& kp, const void*& vp, int& stride, bool& isf32) -> bool {
        const int Tk = b * 256 + j * 64;
        kp = p.QKV + (size_t)Tk * DIN + 512 + kvh * 64; vp = p.QKV + (size_t)Tk * DIN + 640 + kvh * 64; stride = DIN; isf32 = false;
        return true;
      };
      auto biasf = [&](int, int, int) -> float { return 0.f; };
      auto tmode = [&](int, int) -> int { return 0; };
      attn_core(smem, p.QKV + (size_t)T0 * DIN + head * 64, 4, src, biasf, tmode, p.sink[l * 8 + head] * 1.44269504f, true,
                p.CAT + (size_t)T0 * DM + head * 64);
    } else {
      const int it = item - 1408;
      const int b = it >> 3, head = (it >> 1) & 3, qh = it & 1;
      const int T0 = b * 256 + qh * 128;
      auto src = [&](int j, const void*& kp, const void*& vp, int& stride, bool& isf32) -> bool {
        const int Tk = b * 256 + j * 64;
        kp = p.QKV + (size_t)Tk * DIN + 1024 + head * 64; vp = p.QKV + (size_t)Tk * DIN + 1280 + head * 64; stride = DIN; isf32 = false;
        return true;
      };
      auto biasf = [&](int, int, int) -> float { return 0.f; };
      auto tmode = [&](int, int) -> int { return 0; };
      attn_core(smem, p.QKV + (size_t)T0 * DIN + 768 + head * 64, 4, src, biasf, tmode, NEG, false,
                p.CAT + (size_t)T0 * DM + 512 + head * 64);
    }
  }
}

DI void phase2c(const Params& p, char* smem, int l) {
  u16* sK = (u16*)smem;
  u16* sVT = sK + 128 * LDT;
  u16* sSTf = sVT + 64 * LDT2;
  u16* sSTb = sSTf + 64 * LDT;
  const int tid = otid(), lane = tid & 63, w = tid >> 6, r = lane & 31, h = lane >> 5;
  const int rq = tid >> 4, c4 = tid & 15;
  const float one4[4] = {1.f, 1.f, 1.f, 1.f};
  for (int item = blockIdx.x; item < 384; item += gridDim.x) {
    int req, head, c, nc;
    if (item < 256) { req = 16 + (item >> 6); head = (item >> 4) & 3; c = item & 15; nc = 16; }
    else { const int i2 = item - 256; req = i2 >> 3; head = (i2 >> 1) & 3; c = i2 & 1; nc = 2; }
    const bool lat = req >= 16;
    const int T0 = (lat ? NCTX + (req - 16) * 2048 : req * 256) + c * 128;
    const float lgf = ret_lg(p, l, 0, head), lgb = ret_lg(p, l, 1, head);
    const float gf = __expf(lgf * 128.f), gb = __expf(lgb * 128.f);
    __syncthreads();
    {
      const int d = tid >> 2, e0 = (tid & 3) * 16;
#pragma unroll
      for (int dir = 0; dir < 2; ++dir) {
        float s[16];
#pragma unroll
        for (int q = 0; q < 16; ++q) s[q] = 0.f;
        const float g = dir ? gb : gf;
        if (lat) {
          const float* s0 = p.state + ((size_t)(((req - 16) * 2 + l) * 2 + dir) * 4 + head) * 4096 + d * 64 + e0;
#pragma unroll
          for (int q = 0; q < 16; q += 4) {
            const float4 x = *(const float4*)(s0 + q);
            s[q] = x.x; s[q + 1] = x.y; s[q + 2] = x.z; s[q + 3] = x.w;
          }
        }
        const int nsteps = dir ? (nc - 1 - c) : c;
        for (int st = 0; st < nsteps; ++st) {
          const int cc = dir ? (nc - 1 - st) : st;
          const float* kv = p.KVS + kvs_slot(req, head, dir, cc) + d * 64 + e0;
#pragma unroll
          for (int q = 0; q < 16; q += 4) {
            const float4 x = *(const float4*)(kv + q);
            s[q] = s[q] * g + x.x; s[q + 1] = s[q + 1] * g + x.y; s[q + 2] = s[q + 2] * g + x.z; s[q + 3] = s[q + 3] * g + x.w;
          }
        }
        u16* sST = dir ? sSTb : sSTf;
#pragma unroll
        for (int q = 0; q < 16; ++q) sST[(e0 + q) * LDT + d] = (u16)(pack2(s[q], 0.f) & 0xffffu);
        if (!lat && c == 0) {
          const float* k0 = p.KVS + kvs_slot(req, head, dir, 0) + d * 64 + e0;
          const float* k1 = p.KVS + kvs_slot(req, head, dir, 1) + d * 64 + e0;
          float* o = p.out + OFF_ST + ((size_t)((req * 2 + l) * 2 + dir) * 4 + head) * 4096 + d * 64 + e0;
#pragma unroll
          for (int q = 0; q < 16; ++q) o[q] = dir ? (gb * k1[q] + k0[q]) : (gf * k0[q] + k1[q]);
        }
      }
    }
#pragma unroll
    for (int half = 0; half < 2; ++half) {
      float v[4][4];
      load4x4(p.QKV + (size_t)(T0 + half * 64) * DIN + 1792 + head * 64, DIN, false, rq, c4, v);
      store_n(sK, LDT, half * 64, rq, c4, v);
      load4x4(p.QKV + (size_t)(T0 + half * 64) * DIN + 2048 + head * 64, DIN, false, rq, c4, v);
      store_t(sVT, LDT2, half * 64, rq, c4, v, one4);
    }
    __syncthreads();
    const int qi = w * 32 + r;
    const u16* qrow = p.QKV + (size_t)(T0 + qi) * DIN + 1536 + head * 64;
    uint4 qraw[4];
#pragma unroll
    for (int ks = 0; ks < 4; ++ks) qraw[ks] = *(const uint4*)(qrow + ks * 16 + 8 * h);
    f32x16 O[2];
#pragma unroll
    for (int d = 0; d < 2; ++d)
#pragma unroll
      for (int i = 0; i < 16; ++i) O[d][i] = 0.f;
#pragma unroll 1
    for (int jt = 0; jt < 4; ++jt) {
      f32x16 S;
#pragma unroll
      for (int i = 0; i < 16; ++i) S[i] = 0.f;
#pragma unroll
      for (int ks = 0; ks < 4; ++ks) {
        const bf16x8 kf = *(const bf16x8*)&sK[(jt * 32 + r) * LDT + ks * 16 + 8 * h];
        S = MFMA(kf, __builtin_bit_cast(bf16x8, qraw[ks]), S);
      }
#pragma unroll
      for (int i = 0; i < 16; ++i) {
        const int j = jt * 32 + crow(i, h);
        const int dlt = qi - j;
        const float wgt = (dlt > 0) ? __expf(lgf * (float)dlt) : ((dlt < 0) ? __expf(lgb * (float)(-dlt)) : 2.f);
        S[i] = S[i] * 0.125f * wgt;
      }
#pragma unroll
      for (int s = 0; s < 2; ++s) {
        const bf16x8 pf = mk8(pack2(S[8 * s + 0], S[8 * s + 1]), pack2(S[8 * s + 2], S[8 * s + 3]),
                              pack2(S[8 * s + 4], S[8 * s + 5]), pack2(S[8 * s + 6], S[8 * s + 7]));
#pragma unroll
        for (int d = 0; d < 2; ++d) {
          const u16* vrow = &sVT[(d * 32 + r) * LDT2 + jt * 32 + 16 * s + 4 * h];
          const uint2 lo = *(const uint2*)vrow;
          const uint2 hi = *(const uint2*)(vrow + 8);
          O[d] = MFMA(mk8(lo.x, lo.y, hi.x, hi.y), pf, O[d]);
        }
      }
    }
    {
      const float xf = __expf(lgf * (float)(qi + 1)), xb = __expf(lgb * (float)(128 - qi));
#pragma unroll
      for (int ks = 0; ks < 4; ++ks) {
        const uint4 q = qraw[ks];
        const bf16x8 qsf = mk8(pack2(bflo(q.x) * xf, bfhi(q.x) * xf), pack2(bflo(q.y) * xf, bfhi(q.y) * xf),
                               pack2(bflo(q.z) * xf, bfhi(q.z) * xf), pack2(bflo(q.w) * xf, bfhi(q.w) * xf));
        const bf16x8 qsb = mk8(pack2(bflo(q.x) * xb, bfhi(q.x) * xb), pack2(bflo(q.y) * xb, bfhi(q.y) * xb),
                               pack2(bflo(q.z) * xb, bfhi(q.z) * xb), pack2(bflo(q.w) * xb, bfhi(q.w) * xb));
#pragma unroll
        for (int d = 0; d < 2; ++d) {
          const bf16x8 sf = *(const bf16x8*)&sSTf[(d * 32 + r) * LDT + ks * 16 + 8 * h];
          const bf16x8 sb = *(const bf16x8*)&sSTb[(d * 32 + r) * LDT + ks * 16 + 8 * h];
          O[d] = MFMA(sf, qsf, O[d]);
          O[d] = MFMA(sb, qsb, O[d]);
        }
      }
    }
    float sum = 0.f;
#pragma unroll
    for (int d = 0; d < 2; ++d)
#pragma unroll
      for (int i = 0; i < 16; ++i) sum += O[d][i];
    sum += __shfl_xor(sum, 32);
    const float mu = sum * (1.f / 64.f);
    float vs = 0.f;
#pragma unroll
    for (int d = 0; d < 2; ++d)
#pragma unroll
      for (int i = 0; i < 16; ++i) { const float t = O[d][i] - mu; vs += t * t; }
    vs += __shfl_xor(vs, 32);
    const float rstd = rsqrtf(vs * (1.f / 64.f) + 1e-6f);
    const u16* grow = p.QKV + (size_t)(T0 + qi) * DIN + 2304 + head * 64;
    const float* gnw = p.gn + l * 256 + head * 64;
    u16* orow = p.CAT + (size_t)(T0 + qi) * DM + 768 + head * 64;
#pragma unroll
    for (int d = 0; d < 2; ++d)
#pragma unroll
      for (int g = 0; g < 4; ++g) {
        const int e = d * 32 + 8 * g + 4 * h;
        const uint2 gr = *(const uint2*)(grow + e);
        const float4 gw = *(const float4*)(gnw + e);
        const float o0 = silu(bflo(gr.x)) * (O[d][4 * g + 0] - mu) * rstd * gw.x;
        const float o1 = silu(bfhi(gr.x)) * (O[d][4 * g + 1] - mu) * rstd * gw.y;
        const float o2 = silu(bflo(gr.y)) * (O[d][4 * g + 2] - mu) * rstd * gw.z;
        const float o3 = silu(bfhi(gr.y)) * (O[d][4 * g + 3] - mu) * rstd * gw.w;
        uint2 pk = {pack2(o0, o1), pack2(o2, o3)};
        *(uint2*)(orow + e) = pk;
      }
  }
}

DI void phase3(const Params& p, char* smem, int l, const float* xc, const float* xl) {
  const float* W = p.w_out + (size_t)l * DM * DM;
  const int xcd = blockIdx.x & 7, nloc = gridDim.x >> 3;
  auto setup = [&](int s, int ar0, int ac, int n4, int kq, const u16*& q0, const u16*& q1, const u16*& q2, const u16*& q3, const float*& bp) {
    const int tm = 12 * xcd + s % 12, tn = s / 12;
    const u16* ab = p.CAT + ((size_t)tm * 128 + ar0) * DM + ac;
    q0 = ab; q1 = ab + 32 * DM; q2 = ab + 64 * DM; q3 = ab + 96 * DM;
    bp = W + tn * 128 + 4 * n4 + (size_t)(kq * 8) * DM;
  };
  auto epi = [&](int s, f32x16(&acc)[4], int w, int r, int h) {
    int hq = h;
    asm volatile("" : "+v"(hq));
    const int tm = 12 * xcd + s % 12, tn = s / 12;
    const int m0 = tm * 128, n0 = tn * 128;
    const float* g1 = p.MOD + (size_t)(l * 5 + cond_of(m0)) * 6144 + 2048;
    const int n = n0 + 4 * r;
    const float4 g = *(const float4*)(g1 + n);
#pragma unroll
    for (int i = 0; i < 16; ++i) {
      const int ml = w * 32 + crow(i, hq);
      const float4 o = {g.x * acc[0][i], g.y * acc[1][i], g.z * acc[2][i], g.w * acc[3][i]};
      *(float4*)(p.PRE + (size_t)(m0 + ml) * DM + n) = o;
    }
  };
  gemm_phase(smem, blockIdx.x >> 3, 96, nloc, setup, DM, epi);
}

DI void phase4(const Params& p, char* smem, int l, const float* xc, const float* xl) {
  float* swr = (float*)smem;
  const int tid = otid(), lane = tid & 63, w = tid >> 6;
  __syncthreads();
  for (int idx = tid; idx < 4096; idx += 256) {
    const float4 x = *(const float4*)(p.w_router + (size_t)l * DM * 16 + idx * 4);
    const int k = idx >> 2, e = (idx & 3) * 4;
    swr[(e + 0) * DM + k] = x.x; swr[(e + 1) * DM + k] = x.y; swr[(e + 2) * DM + k] = x.z; swr[(e + 3) * DM + k] = x.w;
  }
  __syncthreads();
  const float* lg = p.ln1g + l * DM;
  const float* lb = p.ln1b + l * DM;
  for (int T = blockIdx.x * 4 + w; T < NTOK; T += gridDim.x * 4) {
    const float* mod = p.MOD + (size_t)(l * 5 + cond_of(T)) * 6144;
    const float* xrow = (T < NCTX) ? (xc + (size_t)T * DM) : (xl + (size_t)(T - NCTX) * DM);
    float4 x[4];
    float s = 0.f;
#pragma unroll
    for (int i = 0; i < 4; ++i) {
      const float4 pr = *(const float4*)(p.PRE + (size_t)T * DM + 256 * i + 4 * lane);
      const float4 xi = *(const float4*)(xrow + 256 * i + 4 * lane);
      x[i].x = ALPHA * xi.x + pr.x; x[i].y = ALPHA * xi.y + pr.y; x[i].z = ALPHA * xi.z + pr.z; x[i].w = ALPHA * xi.w + pr.w;
      s += x[i].x + x[i].y + x[i].z + x[i].w;
    }
    const float mu = wave_sum(s) * (1.f / 1024.f);
    float vs = 0.f;
#pragma unroll
    for (int i = 0; i < 4; ++i) {
      x[i].x -= mu; x[i].y -= mu; x[i].z -= mu; x[i].w -= mu;
      vs += x[i].x * x[i].x + x[i].y * x[i].y + x[i].z * x[i].z + x[i].w * x[i].w;
    }
    const float rstd = rsqrtf(wave_sum(vs) * (1.f / 1024.f) + 1e-6f);
#pragma unroll
    for (int i = 0; i < 4; ++i) {
      const int k = 256 * i + 4 * lane;
      const float4 g = *(const float4*)(lg + k), bb = *(const float4*)(lb + k);
      float4 y;
      y.x = x[i].x * rstd * g.x + bb.x; y.y = x[i].y * rstd * g.y + bb.y; y.z = x[i].z * rstd * g.z + bb.z; y.w = x[i].w * rstd * g.w + bb.w;
      *(float4*)(p.X + (size_t)T * DM + k) = y;
      const float4 sc = *(const float4*)(mod + 4096 + k), sh = *(const float4*)(mod + 3072 + k);
      float4 hh;
      hh.x = y.x * (1.f + sc.x) + sh.x; hh.y = y.y * (1.f + sc.y) + sh.y; hh.z = y.z * (1.f + sc.z) + sh.z; hh.w = y.w * (1.f + sc.w) + sh.w;
      uint2 pk = {pack2(hh.x, hh.y), pack2(hh.z, hh.w)};
      *(uint2*)(p.H2 + (size_t)T * DM + k) = pk;
      x[i] = hh;
    }
    float a16[16];
#pragma unroll
    for (int e = 0; e < 16; ++e) {
      float a = 0.f;
#pragma unroll
      for (int i = 0; i < 4; ++i) {
        const float4 wv = *(const float4*)(swr + e * DM + 256 * i + 4 * lane);
        a += x[i].x * wv.x + x[i].y * wv.y + x[i].z * wv.z + x[i].w * wv.w;
      }
      a16[e] = a;
      if ((e & 3) == 3) __builtin_amdgcn_sched_barrier(0);
    }
    float a8[8], a4[4], a2[2], a1;
    {
      const bool hi = (lane & 32) != 0;
#pragma unroll
      for (int j = 0; j < 8; ++j) {
        const float snd = hi ? a16[j] : a16[8 + j];
        const float kp = hi ? a16[8 + j] : a16[j];
        a8[j] = kp + __shfl_xor(snd, 32);
      }
    }
    {
      const bool hi = (lane & 16) != 0;
#pragma unroll
      for (int j = 0; j < 4; ++j) {
        const float snd = hi ? a8[j] : a8[4 + j];
        const float kp = hi ? a8[4 + j] : a8[j];
        a4[j] = kp + __shfl_xor(snd, 16);
      }
    }
    {
      const bool hi = (lane & 8) != 0;
#pragma unroll
      for (int j = 0; j < 2; ++j) {
        const float snd = hi ? a4[j] : a4[2 + j];
        const float kp = hi ? a4[2 + j] : a4[j];
        a2[j] = kp + __shfl_xor(snd, 8);
      }
    }
    {
      const bool hi = (lane & 4) != 0;
      const float snd = hi ? a2[0] : a2[1];
      const float kp = hi ? a2[1] : a2[0];
      a1 = kp + __shfl_xor(snd, 4);
    }
    a1 += __shfl_xor(a1, 2);
    a1 += __shfl_xor(a1, 1);
    const int myexp = ((lane >> 5) & 1) * 8 + ((lane >> 4) & 1) * 4 + ((lane >> 3) & 1) * 2 + ((lane >> 2) & 1);
    float mx = a1;
#pragma unroll
    for (int o = 32; o >= 4; o >>= 1) mx = fmaxf(mx, __shfl_xor(mx, o));
    const float ex = __expf(a1 - mx);
    float den = ex;
#pragma unroll
    for (int o = 32; o >= 4; o >>= 1) den += __shfl_xor(den, o);
    if ((lane & 3) == 0) { p.AFF[(size_t)T * 16 + myexp] = ex / den; p.INV[(size_t)T * 16 + myexp] = -1; }
  }
}

DI unsigned block_incl_scan(unsigned v, unsigned* wsum, int lane, int w, unsigned& total) {
#pragma unroll
  for (int o = 1; o < 64; o <<= 1) {
    const unsigned t = __shfl_up(v, o);
    if (lane >= o) v += t;
  }
  __syncthreads();
  if (lane == 63) wsum[w] = v;
  __syncthreads();
  unsigned off = 0;
  total = 0;
#pragma unroll
  for (int i = 0; i < 4; ++i) {
    const unsigned s = wsum[i];
    if (i < w) off += s;
    total += s;
  }
  return v + off;
}

DI void phase5(const Params& p, char* smem) {
  unsigned* hist = (unsigned*)smem;
  unsigned* wsum = hist + 256;
  unsigned* bc = wsum + 4;
  const int tid = otid(), lane = tid & 63, w = tid >> 6;
  for (int item = blockIdx.x; item < 320; item += gridDim.x) {
    int n, base, e, cap, rowbase;
    if (item < 64) {
      const int b = item >> 4; e = item & 15;
      n = 2048; base = NCTX + b * 2048; cap = 256; rowbase = 512 + b * 256;
    } else {
      const int it = item - 64; const int rq = it >> 4; e = it & 15;
      n = 256; base = rq * 256; cap = 32; rowbase = rq * 32;
    }
    const int per = n >> 8;
    unsigned key[8];
#pragma unroll
    for (int q = 0; q < 8; ++q) key[q] = (q < per) ? __float_as_uint(p.AFF[(size_t)(base + tid * per + q) * 16 + e]) : 0u;
    unsigned prefix = 0u, mask = 0u;
    unsigned remaining = (unsigned)cap;
#pragma unroll 1
    for (int pass = 3; pass >= 0; --pass) {
      const int shift = pass * 8;
      __syncthreads();
      hist[tid] = 0u;
      __syncthreads();
#pragma unroll
      for (int q = 0; q < 8; ++q)
        if (q < per && (key[q] & mask) == prefix) atomicAdd(&hist[(key[q] >> shift) & 255u], 1u);
      __syncthreads();
      const unsigned hv = hist[tid];
      unsigned total;
      const unsigned incl = block_incl_scan(hv, wsum, lane, w, total);
      const unsigned above = total - incl;
      if (above < remaining && remaining <= above + hv) { bc[0] = (unsigned)tid; bc[1] = remaining - above; }
      __syncthreads();
      const unsigned bsel = bc[0];
      remaining = bc[1];
      prefix |= bsel << shift;
      mask |= 0xFFu << shift;
    }
    const unsigned thr = prefix;
    unsigned ceq = 0u;
#pragma unroll
    for (int q = 0; q < 8; ++q) ceq += (q < per && key[q] == thr) ? 1u : 0u;
    unsigned tot;
    unsigned eq_before = block_incl_scan(ceq, wsum, lane, w, tot) - ceq;
    unsigned selmask = 0u, nsel = 0u;
#pragma unroll
    for (int q = 0; q < 8; ++q) {
      if (q < per) {
        const bool eq = key[q] == thr;
        const bool sel = (key[q] > thr) || (eq && eq_before < remaining);
        eq_before += eq ? 1u : 0u;
        selmask |= sel ? (1u << q) : 0u;
        nsel += sel ? 1u : 0u;
      }
    }
    unsigned row = block_incl_scan(nsel, wsum, lane, w, tot) - nsel;
#pragma unroll
    for (int q = 0; q < 8; ++q) {
      if (q < per && ((selmask >> q) & 1u)) {
        const int tok = base + tid * per + q;
        const int rr = e * NROWS_E + rowbase + (int)row;
        p.SELTOK[rr] = tok;
        p.SELGATE[rr] = __uint_as_float(key[q]);
        p.INV[(size_t)tok * 16 + e] = rr;
        ++row;
      }
    }
  }
}

DI void phase6(const Params& p, char* smem, int l) {
  const int xcd = blockIdx.x & 7, nloc = gridDim.x >> 3;
  auto setup = [&](int s, int ar0, int ac, int n4, int kq, const u16*& q0, const u16*& q1, const u16*& q2, const u16*& q3, const float*& bp) {
    const int e = 2 * xcd + s / 192, rem = s % 192, tn = rem / 12, tm = rem % 12;
    const int* tok = p.SELTOK + e * NROWS_E + tm * 128 + ar0;
    q0 = p.H2 + (size_t)tok[0] * DM + ac; q1 = p.H2 + (size_t)tok[32] * DM + ac;
    q2 = p.H2 + (size_t)tok[64] * DM + ac; q3 = p.H2 + (size_t)tok[96] * DM + ac;
    bp = p.w_gu + ((size_t)l * 16 + e) * DM * 2048 + ((n4 >> 4) & 1) * 1024 + tn * 64 + 4 * (n4 & 15) + (size_t)(kq * 8) * 2048;
  };
  auto epi = [&](int s, f32x16(&acc)[4], int w, int r, int h) {
    int hq = h;
    asm volatile("" : "+v"(hq));
    const int e = 2 * xcd + s / 192, rem = s % 192, tn = rem / 12, tm = rem % 12;
    const int m0 = tm * 128, f0 = tn * 64;
    u16* act = p.ACT + ((size_t)e * NROWS_E + m0) * DM;
#pragma unroll
    for (int i = 0; i < 16; ++i) {
      const int ml = w * 32 + crow(i, hq);
      const float a0 = acc[0][i], a1 = acc[1][i], a2 = acc[2][i], a3 = acc[3][i];
      const float u0 = __shfl_xor(a0, 16), u1 = __shfl_xor(a1, 16), u2 = __shfl_xor(a2, 16), u3 = __shfl_xor(a3, 16);
      if (r < 16) {
        uint2 pk = {pack2(silu(a0) * u0, silu(a1) * u1), pack2(silu(a2) * u2, silu(a3) * u3)};
        *(uint2*)(act + (size_t)ml * DM + f0 + 4 * r) = pk;
      }
      if ((i & 3) == 3) __builtin_amdgcn_sched_barrier(0);
    }
  };
  gemm_phase(smem, blockIdx.x >> 3, 384, nloc, setup, 2048, epi);
}

DI void phase7(const Params& p, char* smem, int l, u16* FF) {
  const int xcd = blockIdx.x & 7, nloc = gridDim.x >> 3;
  auto setup = [&](int s, int ar0, int ac, int n4, int kq, const u16*& q0, const u16*& q1, const u16*& q2, const u16*& q3, const float*& bp) {
    const int e = 2 * xcd + s / 96, rem = s % 96, tn = rem / 12, tm = rem % 12;
    const u16* ab = p.ACT + ((size_t)e * NROWS_E + tm * 128 + ar0) * DM + ac;
    q0 = ab; q1 = ab + 32 * DM; q2 = ab + 64 * DM; q3 = ab + 96 * DM;
    bp = p.w_down + ((size_t)l * 16 + e) * DM * DM + tn * 128 + 4 * n4 + (size_t)(kq * 8) * DM;
  };
  auto epi = [&](int s, f32x16(&acc)[4], int w, int r, int h) {
    int hq = h;
    asm volatile("" : "+v"(hq));
    const int e = 2 * xcd + s / 96, rem = s % 96, tn = rem / 12, tm = rem % 12;
    const int m0 = tm * 128, n0 = tn * 128;
    const float* gate = p.SELGATE + e * NROWS_E + m0;
#pragma unroll
    for (int i = 0; i < 16; ++i) {
      const int ml = w * 32 + crow(i, hq);
      const float g = gate[ml];
      uint2 pk = {pack2(g * acc[0][i], g * acc[1][i]), pack2(g * acc[2][i], g * acc[3][i])};
      *(uint2*)(FF + ((size_t)e * NROWS_E + m0 + ml) * DM + n0 + 4 * r) = pk;
      if ((i & 3) == 3) __builtin_amdgcn_sched_barrier(0);
    }
  };
  gemm_phase(smem, blockIdx.x >> 3, 192, nloc, setup, DM, epi);
}

DI void phase8(const Params& p, int l, float* dst, bool write_h) {
  const int tid = otid(), lane = tid & 63, w = tid >> 6;
  const float* lg = p.ln2g + l * DM;
  const float* lb = p.ln2b + l * DM;
  for (int T = blockIdx.x * 4 + w; T < NTOK; T += gridDim.x * 4) {
    const float* g2 = p.MOD + (size_t)(l * 5 + cond_of(T)) * 6144 + 5120;
    const float* modn = p.MOD + (size_t)(5 + cond_of(T)) * 6144;
    float4 x[4], ff[4];
#pragma unroll
    for (int i = 0; i < 4; ++i) ff[i] = make_float4(0.f, 0.f, 0.f, 0.f);
    const int myinv = p.INV[(size_t)T * 16 + (lane & 15)];
#pragma unroll 1
    for (int e = 0; e < 16; ++e) {
      const int row = __shfl(myinv, e);
      if (row >= 0) {
#pragma unroll
        for (int i = 0; i < 4; ++i) {
          const uint2 y = *(const uint2*)(p.YE + (size_t)row * DM + 256 * i + 4 * lane);
          ff[i].x += bflo(y.x); ff[i].y += bfhi(y.x); ff[i].z += bflo(y.y); ff[i].w += bfhi(y.y);
        }
      }
    }
    float s = 0.f;
#pragma unroll
    for (int i = 0; i < 4; ++i) {
      const int k = 256 * i + 4 * lane;
      const float4 a = *(const float4*)(p.X + (size_t)T * DM + k);
      const float4 f = ff[i];
      const float4 g = *(const float4*)(g2 + k);
      x[i].x = ALPHA * a.x + g.x * f.x; x[i].y = ALPHA * a.y + g.y * f.y; x[i].z = ALPHA * a.z + g.z * f.z; x[i].w = ALPHA * a.w + g.w * f.w;
      s += x[i].x + x[i].y + x[i].z + x[i].w;
    }
    const float mu = wave_sum(s) * (1.f / 1024.f);
    float vs = 0.f;
#pragma unroll
    for (int i = 0; i < 4; ++i) {
      x[i].x -= mu; x[i].y -= mu; x[i].z -= mu; x[i].w -= mu;
      vs += x[i].x * x[i].x + x[i].y * x[i].y + x[i].z * x[i].z + x[i].w * x[i].w;
    }
    const float rstd = rsqrtf(wave_sum(vs) * (1.f / 1024.f) + 1e-6f);
#pragma unroll
    for (int i = 0; i < 4; ++i) {
      const int k = 256 * i + 4 * lane;
      const float4 g = *(const float4*)(lg + k), bb = *(const float4*)(lb + k);
      float4 y;
      y.x = x[i].x * rstd * g.x + bb.x; y.y = x[i].y * rstd * g.y + bb.y; y.z = x[i].z * rstd * g.z + bb.z; y.w = x[i].w * rstd * g.w + bb.w;
      *(float4*)(dst + (size_t)T * DM + k) = y;
      if (write_h) {
        const float4 sc = *(const float4*)(modn + 1024 + k), sh = *(const float4*)(modn + k);
        uint2 pk = {pack2(y.x * (1.f + sc.x) + sh.x, y.y * (1.f + sc.y) + sh.y), pack2(y.z * (1.f + sc.z) + sh.z, y.w * (1.f + sc.w) + sh.w)};
        *(uint2*)(p.H2 + (size_t)T * DM + k) = pk;
      }
    }
  }
}

constexpr int kDynLds = 73728;
__global__ void __launch_bounds__(256, 2) mega(Params p) {
  extern __shared__ __attribute__((aligned(16))) char smem[];
  cg::grid_group grid = cg::this_grid();
  if (p.never) grid.sync();
  GBar gb;
  gb.bar = p.BAR; gb.x = xb_xcc_id(); gb.nloc = 0u; gb.nx = 0u;
  if (threadIdx.x == 0) (void)xb_add(&p.BAR[XB_XCNT(gb.x)], 1u);
  phase0(p, smem);
  gbar(gb);
  phase0b(p);
  gbar(gb);
#pragma unroll 1
  for (int l = 0; l < 2; ++l) {
    const float* xc = (l == 0) ? p.x_prompt : p.X;
    const float* xl = (l == 0) ? p.x_sample : (p.X + (size_t)NCTX * DM);
    phase1(p, smem, l);
    gbar(gb);
    if (PROBE == 1) { phase1(p, smem, l); gbar(gb); }
    phase2(p, smem, l);
    gbar(gb);
    if (PROBE == 3) { phase2(p, smem, l); gbar(gb); }
    phase2c(p, smem, l);
    gbar(gb);
    if (PROBE == 3) { phase2c(p, smem, l); gbar(gb); }
    phase3(p, smem, l, xc, xl);
    gbar(gb);
    if (PROBE == 1) { phase3(p, smem, l, xc, xl); gbar(gb); }
    phase4(p, smem, l, xc, xl);
    gbar(gb);
    phase5(p, smem);
    gbar(gb);
    phase6(p, smem, l);
    gbar(gb);
    if (PROBE == 1) { phase6(p, smem, l); gbar(gb); }
    phase7(p, smem, l, p.YE);
    gbar(gb);
    phase8(p, l, (l == 1) ? p.out : p.X, l == 0);
    if (l == 0) gbar(gb);
  }
}

extern "C" void kernel_launch(void* const* d_in, const int* in_sizes, int n_in, void* d_out, int out_size, void* d_ws,
                              size_t ws_size, hipStream_t stream) {
  static int grid_blocks = 0;
  if (!grid_blocks) {
    int dev = 0, cus = 0, per_cu = 0;
    hipGetDevice(&dev);
    hipDeviceGetAttribute(&cus, hipDeviceAttributeMultiprocessorCount, dev);
    hipFuncSetAttribute((const void*)mega, hipFuncAttributeMaxDynamicSharedMemorySize, kDynLds);
    hipOccupancyMaxActiveBlocksPerMultiprocessor(&per_cu, mega, 256, kDynLds);
    if (per_cu > 2) per_cu = 2;
    if (per_cu < 1) per_cu = 1;
    grid_blocks = cus * per_cu;
  }
  Params p{};
  const float** pf = (const float**)&p;
  for (int i = 0; i < 24; ++i) pf[i] = (const float*)d_in[i];
  p.out = (float*)d_out;
  char* ws = (char*)d_ws;
  size_t off = 0;
  auto take = [&](size_t bytes) { char* q = ws + off; off += (bytes + 255) & ~(size_t)255; return q; };
  p.MOD = (float*)take(2 * 5 * 6144 * 4);
  p.BAR = (unsigned*)take(XCD_BAR_WORDS * 4);
  p.ROPE = (float*)take(2048 * 4);
  p.X = (float*)take((size_t)NTOK * DM * 4);
  p.PRE = (float*)take((size_t)NTOK * DM * 4);
  p.KVS = (float*)take((size_t)20 * 4 * 2 * 16 * 4096 * 4);
  p.AFF = (float*)take((size_t)NTOK * 16 * 4);
  p.SELGATE = (float*)take((size_t)16 * NROWS_E * 4);
  p.SELTOK = (int*)take((size_t)16 * NROWS_E * 4);
  p.QKV = (u16*)take((size_t)NTOK * DIN * 2);
  p.CAT = (u16*)take((size_t)NTOK * DM * 2);
  p.H2 = (u16*)take((size_t)NTOK * DM * 2);
  p.ACT = (u16*)take((size_t)16 * NROWS_E * DM * 2);
  p.YE = (u16*)take((size_t)16 * NROWS_E * DM * 2);
  p.INV = (int*)take((size_t)NTOK * 16 * 4);
  p.never = 0;
  hipMemsetAsync(p.MOD, 0, (size_t)((char*)p.BAR - (char*)p.MOD) + XCD_BAR_WORDS * 4, stream);
  void* args[] = {&p};
  hipError_t e = hipLaunchCooperativeKernel((void*)mega, dim3(grid_blocks), dim3(256), args, kDynLds, stream);
  if (e != hipSuccess) fprintf(stderr, "cooperative launch failed: %s (grid %d)\n", hipGetErrorString(e), grid_blocks);
}
```

```cpp
#include <hip/hip_runtime.h>
#include <hip/hip_cooperative_groups.h>
#include <cstdio>
namespace cg = cooperative_groups;

#define DI __device__ __forceinline__
typedef short bf16x8 __attribute__((ext_vector_type(8)));
typedef float f32x16 __attribute__((ext_vector_type(16)));
typedef __bf16 bf2_t __attribute__((ext_vector_type(2)));
typedef float f2_t __attribute__((ext_vector_type(2)));
typedef unsigned short u16;
typedef unsigned u32x4 __attribute__((ext_vector_type(4)));
typedef float f32x4 __attribute__((ext_vector_type(4)));
typedef float f32x2 __attribute__((ext_vector_type(2)));

#define MFMA(a, b, c) __builtin_amdgcn_mfma_f32_32x32x16_bf16((a), (b), (c), 0, 0, 0)

#define PROBE 0
constexpr int NTOK = 12288;
constexpr int NCTX = 4096;
constexpr int DM = 1024;
constexpr int DIN = 2560;
constexpr int LDT = 72;
constexpr int LDT2 = 136;
constexpr int NROWS_E = 1536;
constexpr float NEG = -1e30f;
constexpr float ALPHA = 1.41421356237f;

constexpr size_t OFF_AK = 12582912, OFF_AV = 13631488, OFF_BK = 14680064, OFF_BV = 16777216, OFF_ST = 18874368;

struct Params {
  const float *x_prompt, *x_sample, *cak, *cav, *cbk, *cbv, *state, *c, *c_ctx, *w_ada, *b_ada, *w_in, *w_out, *sink, *rpb,
      *decay, *gn, *ln1g, *ln1b, *ln2g, *ln2b, *w_router, *w_gu, *w_down;
  float* out;
  float *MOD, *ROPE, *X, *PRE, *KVS, *AFF, *SELGATE;
  int* SELTOK;
  u16 *QKV, *CAT, *H2, *ACT;
  u16* YE;
  int* INV;
  unsigned* BAR;
  long never;
};

DI unsigned pack2(float a, float b) {
  f2_t v = {a, b};
  bf2_t r = __builtin_convertvector(v, bf2_t);
  return __builtin_bit_cast(unsigned, r);
}
DI int otid() { int x = threadIdx.x; asm volatile("" : "+v"(x)); return x; }
DI float bflo(unsigned u) { return __uint_as_float(u << 16); }
DI float bfhi(unsigned u) { return __uint_as_float(u & 0xffff0000u); }
DI int crow(int i, int h) { return (i & 3) + 8 * (i >> 2) + 4 * h; }
DI float silu(float x) { return x / (1.f + __expf(-x)); }
DI float wave_sum(float v) {
#pragma unroll
  for (int o = 32; o >= 1; o >>= 1) v += __shfl_xor(v, o);
  return v;
}
DI bf16x8 mk8(unsigned a, unsigned b, unsigned c, unsigned d) {
  uint4 u = {a, b, c, d};
  return __builtin_bit_cast(bf16x8, u);
}


#define XB_TMO 128
#define XB_XCNT(j) (256 + 64 * (j))
#define XB_XSUB(j) (1280 + 64 * (j))
#define XB_XGEN(j) (2304 + 64 * (j))
#define XB_TOP 3328
#define XB_TOPGEN 3392
#define XCD_BAR_WORDS 3456
#define XB_SPIN_CAP (1u << 20)
DI unsigned xb_ld(unsigned* p) { return __hip_atomic_load(p, __ATOMIC_RELAXED, __HIP_MEMORY_SCOPE_AGENT); }
DI unsigned xb_add(unsigned* p, unsigned v) { return __hip_atomic_fetch_add(p, v, __ATOMIC_RELAXED, __HIP_MEMORY_SCOPE_AGENT); }
DI unsigned xb_xcc_id() { return (unsigned)__builtin_amdgcn_s_getreg((3 << 11) | 20) & 0xFu; }
#define XB_SPIN(cond, bar)                                                            \
  do {                                                                                \
    unsigned _sp = 0;                                                                 \
    while (cond) {                                                                    \
      __builtin_amdgcn_s_sleep(1);                                                    \
      if ((++_sp & 255u) == 0u) {                                                     \
        if (xb_ld(&(bar)[XB_TMO])) break;                                             \
        if (_sp > XB_SPIN_CAP) { atomicAdd(&(bar)[XB_TMO], 1u); break; }              \
      }                                                                               \
    }                                                                                 \
  } while (0)
struct GBar { unsigned* bar; unsigned x, nloc, nx; };
DI void gbar_complete(unsigned* bar, unsigned x, unsigned& nloc, unsigned& nx) {
  const unsigned G = gridDim.x;
  unsigned sum, cnt, mine, sp = 0u;
  for (;;) {
    sum = 0u; cnt = 0u; mine = 0u;
#pragma unroll
    for (unsigned j = 0; j < 16; ++j) {
      const unsigned c = xb_ld(&bar[XB_XCNT(j)]);
      sum += c; cnt += (c > 0u) ? 1u : 0u; mine = (j == x) ? c : mine;
    }
    if (sum == G) break;
    __builtin_amdgcn_s_sleep(1);
    if ((++sp & 255u) == 0u) {
      if (xb_ld(&bar[XB_TMO])) break;
      if (sp > XB_SPIN_CAP) { atomicAdd(&bar[XB_TMO], 1u); break; }
    }
  }
  nloc = mine > 0u ? mine : 1u;
  nx = cnt > 0u ? cnt : 1u;
}
DI void gbar(GBar& b) {
  asm volatile("s_waitcnt vmcnt(0)" ::: "memory");
  __syncthreads();
  if (threadIdx.x == 0) {
    unsigned* bar = b.bar;
    __builtin_amdgcn_s_waitcnt(0);
    if (b.nloc == 0u) gbar_complete(bar, b.x, b.nloc, b.nx);
    const unsigned nloc = b.nloc, nx = b.nx;
    const unsigned old = xb_add(&bar[XB_XSUB(b.x)], 1u);
    const unsigned gen = old / nloc;
    if (old + 1u == (gen + 1u) * nloc) {
      __builtin_amdgcn_fence(__ATOMIC_RELEASE, "agent");
      asm volatile("s_waitcnt vmcnt(0)" ::: "memory");
      const unsigned og = xb_add(&bar[XB_TOP], 1u);
      const unsigned tg = og / nx;
      if (og + 1u == (tg + 1u) * nx) xb_add(&bar[XB_TOPGEN], 1u);
      else XB_SPIN(xb_ld(&bar[XB_TOPGEN]) == tg, bar);
      __builtin_amdgcn_fence(__ATOMIC_ACQUIRE, "agent");
      xb_add(&bar[XB_XGEN(b.x)], 1u);
      asm volatile("s_waitcnt vmcnt(0)" ::: "memory");
    } else {
      XB_SPIN(xb_ld(&bar[XB_XGEN(b.x)]) == gen, bar);
      __builtin_amdgcn_fence(__ATOMIC_ACQUIRE, "agent");
      asm volatile("s_waitcnt vmcnt(0)" ::: "memory");
    }
  }
  __syncthreads();
}

template <class Setup, class Epi>
DI void gemm_phase128(char* smem, int s0, int s_end, int s_step, Setup setup, int ldb, Epi epi) {
  if (s0 >= s_end) return;
  u16* sA0 = (u16*)smem;
  u16* sB0 = sA0 + 128 * LDT;
  u16* sA1 = sB0 + 128 * LDT;
  u16* sB1 = sA1 + 128 * LDT;
  const int tid = otid(), lane = tid & 63, w = tid >> 6, r = lane & 31, h = lane >> 5;
  const int a_r0 = tid >> 3, a_c = (tid & 7) * 8;
  const int b_n4 = tid & 31, b_kq = tid >> 5;
  const u16 *apb0, *apb1, *apb2, *apb3;
  const float* bp;
  setup(s0, a_r0, a_c, b_n4, b_kq, apb0, apb1, apb2, apb3, bp);

  u32x4 pa0, pa1, pa2, pa3;
  f32x4 pb[8];

#define G_LOAD(KT)                                                                       \
  {                                                                                      \
    const int k0_ = (KT) * 64;                                                           \
    pa0 = *(const u32x4*)(apb0 + k0_);                                                   \
    pa1 = *(const u32x4*)(apb1 + k0_);                                                   \
    pa2 = *(const u32x4*)(apb2 + k0_);                                                   \
    pa3 = *(const u32x4*)(apb3 + k0_);                                                   \
    _Pragma("unroll") for (int i_ = 0; i_ < 8; ++i_) pb[i_] = *(const f32x4*)(bp + (size_t)(k0_ + i_) * ldb); \
  }
#define G_STAGE(SA, SBB)                                                                 \
  {                                                                                      \
    *(u32x4*)&SA[(a_r0)*LDT + a_c] = pa0;                                                \
    *(u32x4*)&SA[(a_r0 + 32) * LDT + a_c] = pa1;                                         \
    *(u32x4*)&SA[(a_r0 + 64) * LDT + a_c] = pa2;                                         \
    *(u32x4*)&SA[(a_r0 + 96) * LDT + a_c] = pa3;                                         \
    _Pragma("unroll") for (int j_ = 0; j_ < 4; ++j_) {                                   \
      u32x4 pk_;                                                                         \
      pk_.x = pack2(pb[0][j_], pb[1][j_]);                                               \
      pk_.y = pack2(pb[2][j_], pb[3][j_]);                                               \
      pk_.z = pack2(pb[4][j_], pb[5][j_]);                                               \
      pk_.w = pack2(pb[6][j_], pb[7][j_]);                                               \
      *(u32x4*)&SBB[(j_ * 32 + b_n4) * LDT + b_kq * 8] = pk_;                            \
    }                                                                                    \
  }
  const int aoff = (w * 32 + r) * LDT + 8 * h, boff = r * LDT + 8 * h;
#define G_FRAG(BUF, SA, SBB, KS)                                                         \
  {                                                                                      \
    fa[BUF] = *(const bf16x8*)(SA + aoff + (KS) * 16);                                   \
    fb[BUF][0] = *(const bf16x8*)(SBB + boff + (KS) * 16);                               \
    fb[BUF][1] = *(const bf16x8*)(SBB + boff + 32 * LDT + (KS) * 16);                    \
    fb[BUF][2] = *(const bf16x8*)(SBB + boff + 64 * LDT + (KS) * 16);                    \
    fb[BUF][3] = *(const bf16x8*)(SBB + boff + 96 * LDT + (KS) * 16);                    \
  }
#define G_MFMA(BUF)                                                                      \
  {                                                                                      \
    acc[0] = MFMA(fa[BUF], fb[BUF][0], acc[0]);                                          \
    acc[1] = MFMA(fa[BUF], fb[BUF][1], acc[1]);                                          \
    acc[2] = MFMA(fa[BUF], fb[BUF][2], acc[2]);                                          \
    acc[3] = MFMA(fa[BUF], fb[BUF][3], acc[3]);                                          \
  }
#define SB() __builtin_amdgcn_sched_barrier(0)
#define G_COMPUTE(SA, SBB)                                                               \
  {                                                                                      \
    bf16x8 fa[2], fb[2][4];                                                              \
    G_FRAG(0, SA, SBB, 0);                                                               \
    G_FRAG(1, SA, SBB, 1);                                                               \
    SB();                                                                                \
    G_MFMA(0);                                                                           \
    SB();                                                                                \
    G_FRAG(0, SA, SBB, 2);                                                               \
    SB();                                                                                \
    G_MFMA(1);                                                                           \
    SB();                                                                                \
    G_FRAG(1, SA, SBB, 3);                                                               \
    SB();                                                                                \
    G_MFMA(0);                                                                           \
    SB();                                                                                \
    G_MFMA(1);                                                                           \
    SB();                                                                                \
  }

  G_LOAD(0);
  __syncthreads();
#pragma unroll 1
  for (int s = s0; s < s_end; s += s_step) {
    f32x16 acc[4];
#pragma unroll
    for (int a = 0; a < 4; ++a)
#pragma unroll
      for (int i = 0; i < 16; ++i) acc[a][i] = 0.f;
    const int sn = s + s_step;
    const bool has_next = sn < s_end;
    const u16 *n0 = apb0, *n1 = apb1, *n2 = apb2, *n3 = apb3;
    const float* nbp = bp;
    if (has_next) setup(sn, a_r0, a_c, b_n4, b_kq, n0, n1, n2, n3, nbp);
#pragma unroll 1
    for (int kt = 0; kt < 16; kt += 2) {
      G_STAGE(sA0, sB0);
      __syncthreads();
      G_LOAD(kt + 1);
      G_COMPUTE(sA0, sB0);
      G_STAGE(sA1, sB1);
      __syncthreads();
      {
        int kn = kt + 2;
        if (kt == 14) { apb0 = n0; apb1 = n1; apb2 = n2; apb3 = n3; bp = nbp; kn = 0; }
        G_LOAD(kn);
      }
      G_COMPUTE(sA1, sB1);
    }
    epi(s, acc, w, r, h);
  }
  __syncthreads();
#undef G_LOAD
#undef G_STAGE
#undef G_COMPUTE
#undef G_FRAG
#undef G_MFMA
}
#undef SB

template <bool CONTIG, class Setup, class Epi>
DI void gemm_phase(char* smem, int s0, int s_end, int s_step, Setup setup, int ldb, Epi epi) {
  asm volatile("" : "+s"(s_end));
  if (s0 >= s_end) return;
  constexpr int LDK = 40;
  u16* sA0 = (u16*)smem;
  u16* sB0 = sA0 + 256 * LDK;
  u16* sA1 = sB0 + 128 * LDK;
  u16* sB1 = sA1 + 256 * LDK;
  const int tid = otid(), lane = tid & 63, w = tid >> 6, r = lane & 31, h = lane >> 5;
  const int a_r0 = tid >> 2, a_c = (tid & 3) * 8;
  const int b_n4 = tid & 31, b_kq = tid >> 5;
  const u16 *apb0, *apb1, *apb2, *apb3;
  const float* bp;
  setup(s0, a_r0, a_c, b_n4, b_kq, apb0, apb1, apb2, apb3, bp);

  u32x4 pa0, pa1, pa2, pa3;
  f32x4 pb[4];

#define G_LOAD(KT)                                                                       \
  {                                                                                      \
    const int k0_ = (KT) * 32;                                                           \
    pa0 = *(const u32x4*)(apb0 + k0_);                                                   \
    pa1 = *(const u32x4*)((CONTIG ? apb0 + 64 * DM : apb1) + k0_);                       \
    pa2 = *(const u32x4*)((CONTIG ? apb0 + 128 * DM : apb2) + k0_);                      \
    pa3 = *(const u32x4*)((CONTIG ? apb0 + 192 * DM : apb3) + k0_);                      \
    _Pragma("unroll") for (int i_ = 0; i_ < 4; ++i_) pb[i_] = *(const f32x4*)(bp + (size_t)(k0_ + i_) * ldb); \
  }
#define G_STAGE(SA, SBB)                                                                 \
  {                                                                                      \
    *(u32x4*)&SA[(a_r0)*LDK + a_c] = pa0;                                                \
    *(u32x4*)&SA[(a_r0 + 64) * LDK + a_c] = pa1;                                         \
    *(u32x4*)&SA[(a_r0 + 128) * LDK + a_c] = pa2;                                        \
    *(u32x4*)&SA[(a_r0 + 192) * LDK + a_c] = pa3;                                        \
    _Pragma("unroll") for (int j_ = 0; j_ < 4; ++j_) {                                   \
      uint2 pk_;                                                                         \
      pk_.x = pack2(pb[0][j_], pb[1][j_]);                                               \
      pk_.y = pack2(pb[2][j_], pb[3][j_]);                                               \
      *(uint2*)&SBB[(j_ * 32 + b_n4) * LDK + b_kq * 4] = pk_;                            \
    }                                                                                    \
  }
  const int aoff = (w * 64 + r) * LDK + 8 * h, boff = r * LDK + 8 * h;
#define G_FRAG(FA, FB, SA, SBB, KS)                                                      \
  {                                                                                      \
    FA[0] = *(const bf16x8*)(SA + aoff + (KS) * 16);                                     \
    FA[1] = *(const bf16x8*)(SA + aoff + 32 * LDK + (KS) * 16);                          \
    FB[0] = *(const bf16x8*)(SBB + boff + (KS) * 16);                                    \
    FB[1] = *(const bf16x8*)(SBB + boff + 32 * LDK + (KS) * 16);                         \
    FB[2] = *(const bf16x8*)(SBB + boff + 64 * LDK + (KS) * 16);                         \
    FB[3] = *(const bf16x8*)(SBB + boff + 96 * LDK + (KS) * 16);                         \
  }
#define G_MFMA(FA, FB)                                                                   \
  {                                                                                      \
    _Pragma("unroll") for (int mt_ = 0; mt_ < 2; ++mt_)                                  \
    _Pragma("unroll") for (int nt_ = 0; nt_ < 4; ++nt_) acc[mt_][nt_] = MFMA(FA[mt_], FB[nt_], acc[mt_][nt_]); \
  }
#define SB() __builtin_amdgcn_sched_barrier(0)
#define G_COMPUTE(SA, SBB)                                                               \
  {                                                                                      \
    bf16x8 fa0[2], fb0[4];                                                               \
    G_FRAG(fa0, fb0, SA, SBB, 0);                                                        \
    SB();                                                                                \
    G_MFMA(fa0, fb0);                                                                    \
    SB();                                                                                \
    G_FRAG(fa0, fb0, SA, SBB, 1);                                                        \
    SB();                                                                                \
    G_MFMA(fa0, fb0);                                                                    \
    SB();                                                                                \
  }

  G_LOAD(0);
  __syncthreads();
#pragma unroll 1
  for (int s = s0; s < s_end; s += s_step) {
    f32x16 acc[2][4];
#pragma unroll
    for (int a = 0; a < 2; ++a)
#pragma unroll
      for (int b = 0; b < 4; ++b)
#pragma unroll
        for (int i = 0; i < 16; ++i) acc[a][b][i] = 0.f;
    const int sn = s + s_step;
    const bool has_next = sn < s_end;
    const u16 *n0 = apb0, *n1 = apb1, *n2 = apb2, *n3 = apb3;
    const float* nbp = bp;
    if (has_next) setup(sn, a_r0, a_c, b_n4, b_kq, n0, n1, n2, n3, nbp);
#pragma unroll 1
    for (int kt = 0; kt < 32; kt += 2) {
      G_STAGE(sA0, sB0);
      __syncthreads();
      G_LOAD(kt + 1);
      G_COMPUTE(sA0, sB0);
      G_STAGE(sA1, sB1);
      __syncthreads();
      {
        int kn = kt + 2;
        if (kt == 30) { apb0 = n0; apb1 = n1; apb2 = n2; apb3 = n3; bp = nbp; kn = 0; }
        G_LOAD(kn);
      }
      G_COMPUTE(sA1, sB1);
    }
    epi(s, acc, w, r, h);
  }
  __syncthreads();
#undef G_LOAD
#undef G_STAGE
#undef G_COMPUTE
#undef G_FRAG
#undef G_MFMA
}

DI void load4x4(const void* base, int stride, bool isf32, int rq, int c4, float v[4][4]) {
  if (isf32) {
#pragma unroll
    for (int i = 0; i < 4; ++i) {
      const float4 x = *(const float4*)((const float*)base + (size_t)(4 * rq + i) * stride + 4 * c4);
      v[i][0] = x.x; v[i][1] = x.y; v[i][2] = x.z; v[i][3] = x.w;
    }
  } else {
#pragma unroll
    for (int i = 0; i < 4; ++i) {
      const uint2 x = *(const uint2*)((const u16*)base + (size_t)(4 * rq + i) * stride + 4 * c4);
      v[i][0] = bflo(x.x); v[i][1] = bfhi(x.x); v[i][2] = bflo(x.y); v[i][3] = bfhi(x.y);
    }
  }
}
DI void store_n(u16* dst, int ld, int row0, int rq, int c4, const float v[4][4]) {
#pragma unroll
  for (int i = 0; i < 4; ++i) {
    uint2 pk = {pack2(v[i][0], v[i][1]), pack2(v[i][2], v[i][3])};
    *(uint2*)&dst[(row0 + 4 * rq + i) * ld + 4 * c4] = pk;
  }
}
DI void store_t(u16* dst, int ld, int col0, int rq, int c4, const float v[4][4], const float s[4]) {
#pragma unroll
  for (int j = 0; j < 4; ++j) {
    uint2 pk = {pack2(v[0][j] * s[0], v[1][j] * s[1]), pack2(v[2][j] * s[2], v[3][j] * s[3])};
    *(uint2*)&dst[(4 * c4 + j) * ld + col0 + 4 * rq] = pk;
  }
}

template <class TileSrc, class BiasF, class TMode>
DI void attn_core(char* smem, const u16* qbase, int ntiles, TileSrc src, BiasF biasf, TMode tmode, float m_init, bool has_sink, u16* obase) {
  u16* sK = (u16*)smem;
  u16* sVT = sK + 64 * LDT;
  const int tid = otid(), lane = tid & 63, w = tid >> 6, r = lane & 31, h = lane >> 5;
  const int rq = tid >> 4, c4 = tid & 15;
  const int ql = w * 32 + r;
  bf16x8 qf[4];
#pragma unroll
  for (int ks = 0; ks < 4; ++ks) qf[ks] = *(const bf16x8*)(qbase + (size_t)ql * DIN + ks * 16 + 8 * h);
  f32x16 O[2];
#pragma unroll
  for (int d = 0; d < 2; ++d)
#pragma unroll
    for (int i = 0; i < 16; ++i) O[d][i] = 0.f;
  float m = m_init, lsum = (has_sink && h == 0) ? 1.f : 0.f;
  const float one4[4] = {1.f, 1.f, 1.f, 1.f};

  u32x4 kraw[4], vraw[4];
#pragma unroll
  for (int i = 0; i < 4; ++i) { kraw[i] = (u32x4){0u, 0u, 0u, 0u}; vraw[i] = (u32x4){0u, 0u, 0u, 0u}; }
  bool cur_f32 = false, nxt_f32 = false;
  int j = 0;
  {
    const void *kp = nullptr, *vp = nullptr;
    int stride = 0;
    while (j < ntiles && !src(j, kp, vp, stride, nxt_f32)) ++j;
    if (j < ntiles) {
      if (nxt_f32) {
#pragma unroll
        for (int i = 0; i < 4; ++i) {
          kraw[i] = *(const u32x4*)((const float*)kp + (size_t)(4 * rq + i) * stride + 4 * c4);
          vraw[i] = *(const u32x4*)((const float*)vp + (size_t)(4 * rq + i) * stride + 4 * c4);
        }
      } else {
#pragma unroll
        for (int i = 0; i < 4; ++i) {
          const uint2 a = *(const uint2*)((const u16*)kp + (size_t)(4 * rq + i) * stride + 4 * c4);
          const uint2 c = *(const uint2*)((const u16*)vp + (size_t)(4 * rq + i) * stride + 4 * c4);
          kraw[i].x = a.x; kraw[i].y = a.y; vraw[i].x = c.x; vraw[i].y = c.y;
        }
      }
    }
  }
#pragma unroll 1
  while (j < ntiles) {
    cur_f32 = nxt_f32;
    __syncthreads();
    {
      float v[4][4];
#pragma unroll
      for (int i = 0; i < 4; ++i) {
        if (cur_f32) { v[i][0] = __uint_as_float(kraw[i].x); v[i][1] = __uint_as_float(kraw[i].y); v[i][2] = __uint_as_float(kraw[i].z); v[i][3] = __uint_as_float(kraw[i].w); }
        else { v[i][0] = bflo(kraw[i].x); v[i][1] = bfhi(kraw[i].x); v[i][2] = bflo(kraw[i].y); v[i][3] = bfhi(kraw[i].y); }
      }
      store_n(sK, LDT, 0, rq, c4, v);
#pragma unroll
      for (int i = 0; i < 4; ++i) {
        if (cur_f32) { v[i][0] = __uint_as_float(vraw[i].x); v[i][1] = __uint_as_float(vraw[i].y); v[i][2] = __uint_as_float(vraw[i].z); v[i][3] = __uint_as_float(vraw[i].w); }
        else { v[i][0] = bflo(vraw[i].x); v[i][1] = bfhi(vraw[i].x); v[i][2] = bflo(vraw[i].y); v[i][3] = bfhi(vraw[i].y); }
      }
      store_t(sVT, LDT, 0, rq, c4, v, one4);
    }
    __syncthreads();
    const int jc = j;
    {
      const void *kp = nullptr, *vp = nullptr;
      int stride = 0;
      ++j;
      while (j < ntiles && !src(j, kp, vp, stride, nxt_f32)) ++j;
      if (j < ntiles) {
        if (nxt_f32) {
#pragma unroll
          for (int i = 0; i < 4; ++i) {
            kraw[i] = *(const u32x4*)((const float*)kp + (size_t)(4 * rq + i) * stride + 4 * c4);
            vraw[i] = *(const u32x4*)((const float*)vp + (size_t)(4 * rq + i) * stride + 4 * c4);
          }
        } else {
#pragma unroll
          for (int i = 0; i < 4; ++i) {
            const uint2 a = *(const uint2*)((const u16*)kp + (size_t)(4 * rq + i) * stride + 4 * c4);
            const uint2 c = *(const uint2*)((const u16*)vp + (size_t)(4 * rq + i) * stride + 4 * c4);
            kraw[i].x = a.x; kraw[i].y = a.y; vraw[i].x = c.x; vraw[i].y = c.y;
          }
        }
      }
    }
    const int mode = tmode(jc, w);
    if (mode != 2) {
      f32x16 S[2];
#pragma unroll
      for (int mt = 0; mt < 2; ++mt)
#pragma unroll
        for (int i = 0; i < 16; ++i) S[mt][i] = 0.f;
#pragma unroll
      for (int ks = 0; ks < 4; ++ks)
#pragma unroll
        for (int mt = 0; mt < 2; ++mt) {
          const bf16x8 kf = *(const bf16x8*)&sK[(mt * 32 + r) * LDT + ks * 16 + 8 * h];
          S[mt] = MFMA(kf, qf[ks], S[mt]);
        }
      const float C2 = 0.125f * 1.44269504f;
      float mx = NEG;
      if (mode == 1) {
#pragma unroll
        for (int mt = 0; mt < 2; ++mt)
#pragma unroll
          for (int i = 0; i < 16; ++i) {
            const float s = S[mt][i] * C2 + biasf(jc, mt * 32 + crow(i, h), ql);
            S[mt][i] = s;
            mx = fmaxf(mx, s);
          }
      } else {
#pragma unroll
        for (int mt = 0; mt < 2; ++mt)
#pragma unroll
          for (int i = 0; i < 16; ++i) {
            const float s = S[mt][i] * C2;
            S[mt][i] = s;
            mx = fmaxf(mx, s);
          }
      }
      mx = fmaxf(mx, __shfl_xor(mx, 32));
      const float mn = fmaxf(m, mx);
      if (__any(mn > m)) {
        const float alpha = __builtin_amdgcn_exp2f(m - mn);
        m = mn;
        lsum *= alpha;
#pragma unroll
        for (int d = 0; d < 2; ++d)
#pragma unroll
          for (int i = 0; i < 16; ++i) O[d][i] *= alpha;
      }
      float ps = 0.f;
#pragma unroll
      for (int mt = 0; mt < 2; ++mt)
#pragma unroll
        for (int i = 0; i < 16; ++i) {
          const float pv = __builtin_amdgcn_exp2f(S[mt][i] - m);
          S[mt][i] = pv;
          ps += pv;
        }
      lsum += ps;
#pragma unroll
      for (int mt = 0; mt < 2; ++mt)
#pragma unroll
        for (int s = 0; s < 2; ++s) {
          const bf16x8 pf = mk8(pack2(S[mt][8 * s + 0], S[mt][8 * s + 1]), pack2(S[mt][8 * s + 2], S[mt][8 * s + 3]),
                                pack2(S[mt][8 * s + 4], S[mt][8 * s + 5]), pack2(S[mt][8 * s + 6], S[mt][8 * s + 7]));
#pragma unroll
          for (int d = 0; d < 2; ++d) {
            const u16* vrow = &sVT[(d * 32 + r) * LDT + mt * 32 + 16 * s + 4 * h];
            const uint2 lo = *(const uint2*)vrow;
            const uint2 hi = *(const uint2*)(vrow + 8);
            O[d] = MFMA(mk8(lo.x, lo.y, hi.x, hi.y), pf, O[d]);
          }
        }
    }
  }
  const float l = lsum + __shfl_xor(lsum, 32);
  const float inv = 1.f / l;
#pragma unroll
  for (int d = 0; d < 2; ++d)
#pragma unroll
    for (int g = 0; g < 4; ++g) {
      uint2 pk = {pack2(O[d][4 * g + 0] * inv, O[d][4 * g + 1] * inv), pack2(O[d][4 * g + 2] * inv, O[d][4 * g + 3] * inv)};
      *(uint2*)(obase + (size_t)ql * DM + d * 32 + 8 * g + 4 * h) = pk;
    }
}

DI void phase0(const Params& p, char* smem) {
  const int tid = otid();
  if (blockIdx.x == 0) {
    for (int idx = tid; idx < 1024; idx += 256) {
      const int pos = idx >> 4, j = idx & 15;
      const double inv = 1.0 / pow(10000.0, (double)j / 16.0);
      const float ang = (float)((double)pos * inv);
      p.ROPE[idx] = cosf(ang);
      p.ROPE[1024 + idx] = sinf(ang);
    }
  }
  float* scond = (float*)smem;
  for (int item = blockIdx.x; item < 768; item += gridDim.x) {
    const int l = item / 384, ks = (item / 24) % 16, jb = item % 24;
    __syncthreads();
    for (int idx = tid; idx < 320; idx += 256) {
      const int c = idx / 64, k = ks * 64 + (idx & 63);
      const float v = (c == 0) ? p.c_ctx[k] : p.c[(c - 1) * DM + k];
      scond[idx] = silu(v);
    }
    __syncthreads();
    const int j = jb * 256 + tid;
    const float* wp = p.w_ada + ((size_t)l * DM + ks * 64) * 6144 + j;
    float a[5] = {0.f, 0.f, 0.f, 0.f, 0.f};
#pragma unroll 8
    for (int k = 0; k < 64; ++k) {
      const float wv = wp[(size_t)k * 6144];
#pragma unroll
      for (int c = 0; c < 5; ++c) a[c] += scond[c * 64 + k] * wv;
    }
    const float bias = (ks == 0) ? p.b_ada[l * 6144 + j] : 0.f;
#pragma unroll
    for (int c = 0; c < 5; ++c) unsafeAtomicAdd(&p.MOD[(l * 5 + c) * 6144 + j], a[c] + bias);
  }
}

DI int cond_of(int T) { return T < NCTX ? 0 : 1 + ((T - NCTX) >> 11); }

DI void phase0b(const Params& p) {
  const int tid = otid(), lane = tid & 63, w = tid >> 6;
  for (int T = blockIdx.x * 4 + w; T < NTOK; T += gridDim.x * 4) {
    const float* mod = p.MOD + (size_t)cond_of(T) * 6144;
    const float* xr = (T < NCTX) ? (p.x_prompt + (size_t)T * DM) : (p.x_sample + (size_t)(T - NCTX) * DM);
#pragma unroll
    for (int i = 0; i < 4; ++i) {
      const int k = 256 * i + 4 * lane;
      const float4 x = *(const float4*)(xr + k);
      const float4 sc = *(const float4*)(mod + 1024 + k), sh = *(const float4*)(mod + k);
      uint2 pk = {pack2(x.x * (1.f + sc.x) + sh.x, x.y * (1.f + sc.y) + sh.y), pack2(x.z * (1.f + sc.z) + sh.z, x.w * (1.f + sc.w) + sh.w)};
      *(uint2*)(p.H2 + (size_t)T * DM + k) = pk;
    }
  }
}

DI void phase1(const Params& p, char* smem, int l) {
  const float* W = p.w_in + (size_t)l * DM * DIN;
  const int xcd = blockIdx.x & 7, nloc = gridDim.x >> 3;
  auto setup = [&](int s, int ar0, int ac, int n4, int kq, const u16*& q0, const u16*& q1, const u16*& q2, const u16*& q3, const float*& bp) {
    const int tm = 6 * xcd + s % 6, tn = s / 6;
    const u16* ab = p.H2 + ((size_t)tm * 256 + ar0) * DM + ac;
    q0 = ab; q1 = ab + 64 * DM; q2 = ab + 128 * DM; q3 = ab + 192 * DM;
    bp = W + tn * 128 + 4 * n4 + (size_t)(kq * 4) * DIN;
  };
  auto epi = [&](int s, f32x16(&acc)[2][4], int w, int r, int h) {
    int hq = h;
    asm volatile("" : "+v"(hq));
    const int tm = 6 * xcd + s % 6, tn = s / 6;
    const int m0 = tm * 256, n0 = tn * 128;
    const bool lat = m0 >= NCTX;
    const bool rope = lat && (n0 < 640);
    const int n = n0 + 4 * r;
    const int q = (r >> 2) & 3;
#pragma unroll
    for (int mt = 0; mt < 2; ++mt)
#pragma unroll
    for (int i = 0; i < 16; ++i) {
      const int T = m0 + w * 64 + mt * 32 + crow(i, hq);
      float v0 = acc[mt][0][i], v1 = acc[mt][1][i], v2 = acc[mt][2][i], v3 = acc[mt][3][i];
      if (rope) {
        const int t = (T - NCTX) & 2047;
        const int pos = (q < 2) ? (t >> 6) : (t & 63);
        const int jf = 4 * (r & 3);
        const float4 cs = *(const float4*)(p.ROPE + pos * 16 + jf), sn = *(const float4*)(p.ROPE + 1024 + pos * 16 + jf);
        const float o0 = __shfl_xor(v0, 4), o1 = __shfl_xor(v1, 4), o2 = __shfl_xor(v2, 4), o3 = __shfl_xor(v3, 4);
        if (q & 1) { v0 = o0 * sn.x + v0 * cs.x; v1 = o1 * sn.y + v1 * cs.y; v2 = o2 * sn.z + v2 * cs.z; v3 = o3 * sn.w + v3 * cs.w; }
        else { v0 = v0 * cs.x - o0 * sn.x; v1 = v1 * cs.y - o1 * sn.y; v2 = v2 * cs.z - o2 * sn.z; v3 = v3 * cs.w - o3 * sn.w; }
      }
      uint2 pk = {pack2(v0, v1), pack2(v2, v3)};
      *(uint2*)(p.QKV + (size_t)T * DIN + n) = pk;
      if (!lat) {
        const int b = T >> 8, t = T & 255;
        const float4 vv = {v0, v1, v2, v3};
        if (n0 == 512) *(float4*)(p.out + OFF_AK + ((size_t)(b * 2 + l) * 256 + t) * 128 + (n - 512)) = vv;
        else if (n0 == 640) *(float4*)(p.out + OFF_AV + ((size_t)(b * 2 + l) * 256 + t) * 128 + (n - 640)) = vv;
        else if (n0 == 1024 || n0 == 1152) *(float4*)(p.out + OFF_BK + ((size_t)(b * 2 + l) * 256 + t) * 256 + (n - 1024)) = vv;
        else if (n0 == 1280 || n0 == 1408) *(float4*)(p.out + OFF_BV + ((size_t)(b * 2 + l) * 256 + t) * 256 + (n - 1280)) = vv;
      }
      if ((i & 3) == 3) __builtin_amdgcn_sched_barrier(0);
    }
  };
  gemm_phase<true>(smem, blockIdx.x >> 3, 120, nloc, setup, DIN, epi);
}

DI float ret_lg(const Params& p, int l, int dir, int head) { return -__expf(p.decay[(l * 2 + dir) * 4 + head]); }

DI size_t kvs_slot(int req, int head, int dir, int c) { return ((size_t)((req * 4 + head) * 2 + dir) * 16 + c) * 4096; }

DI void retkv_item(const Params& p, char* smem, int l, int req, int head, int c) {
  u16* sKTf = (u16*)smem;
  u16* sKTb = sKTf + 64 * LDT2;
  u16* sVT = sKTb + 64 * LDT2;
  const int tid = otid(), lane = tid & 63, w = tid >> 6, r = lane & 31, h = lane >> 5;
  const int rq = tid >> 4, c4 = tid & 15;
  const int T0 = (req < 16 ? req * 256 : NCTX + (req - 16) * 2048) + c * 128;
  const float lgf = ret_lg(p, l, 0, head), lgb = ret_lg(p, l, 1, head);
  const float one4[4] = {1.f, 1.f, 1.f, 1.f};
  __syncthreads();
#pragma unroll
  for (int half = 0; half < 2; ++half) {
    float v[4][4];
    float sf[4], sb[4];
#pragma unroll
    for (int i = 0; i < 4; ++i) {
      const int j = half * 64 + 4 * rq + i;
      sf[i] = 0.125f * __expf(lgf * (float)(127 - j));
      sb[i] = 0.125f * __expf(lgb * (float)j);
    }
    load4x4(p.QKV + (size_t)(T0 + half * 64) * DIN + 1792 + head * 64, DIN, false, rq, c4, v);
    store_t(sKTf, LDT2, half * 64, rq, c4, v, sf);
    store_t(sKTb, LDT2, half * 64, rq, c4, v, sb);
    load4x4(p.QKV + (size_t)(T0 + half * 64) * DIN + 2048 + head * 64, DIN, false, rq, c4, v);
    store_t(sVT, LDT2, half * 64, rq, c4, v, one4);
  }
  __syncthreads();
  const int dir = w >> 1, mt = w & 1;
  const u16* sKT = dir ? sKTb : sKTf;
  f32x16 acc[2];
#pragma unroll
  for (int nt = 0; nt < 2; ++nt)
#pragma unroll
    for (int i = 0; i < 16; ++i) acc[nt][i] = 0.f;
#pragma unroll
  for (int ks = 0; ks < 8; ++ks) {
    const bf16x8 fa = *(const bf16x8*)&sKT[(mt * 32 + r) * LDT2 + ks * 16 + 8 * h];
#pragma unroll
    for (int nt = 0; nt < 2; ++nt) {
      const bf16x8 fb = *(const bf16x8*)&sVT[(nt * 32 + r) * LDT2 + ks * 16 + 8 * h];
      acc[nt] = MFMA(fa, fb, acc[nt]);
    }
  }
  float* dst = p.KVS + kvs_slot(req, head, dir, c);
#pragma unroll
  for (int nt = 0; nt < 2; ++nt)
#pragma unroll
    for (int i = 0; i < 16; ++i) dst[(mt * 32 + crow(i, h)) * 64 + nt * 32 + r] = acc[nt][i];
}

DI void phase2(const Params& p, char* smem, int l) {
  const int tid = otid();
  for (int item = blockIdx.x; item < 1536; item += gridDim.x) {
    if (item < 512) {
      const int b = item >> 7, head = (item >> 4) & 7, qb = item & 15, kvh = head >> 2;
      const int T0 = NCTX + b * 2048 + qb * 128;
      const float* ck = p.cak + ((size_t)(b * 2 + l) * 512) * 128 + kvh * 64;
      const float* cv = p.cav + ((size_t)(b * 2 + l) * 512) * 128 + kvh * 64;
      auto src = [&](int j, const void*& kp, const void*& vp, int& stride, bool& isf32) -> bool {
        if (j < 8) {
          kp = ck + (size_t)j * 64 * 128; vp = cv + (size_t)j * 64 * 128; stride = 128; isf32 = true;
          return true;
        }
        const int jj = j - 8, kb = qb - 1 + (jj >> 1);
        if (kb < 0 || kb >= 16) return false;
        const int Tk = NCTX + b * 2048 + kb * 128 + (jj & 1) * 64;
        kp = p.QKV + (size_t)Tk * DIN + 512 + kvh * 64; vp = p.QKV + (size_t)Tk * DIN + 640 + kvh * 64; stride = DIN; isf32 = false;
        return true;
      };
      auto biasf = [&](int j, int key, int ql) -> float {
        if (j < 8) return 0.f;
        const int jj = j - 8;
        const int kj = (qb - 1 + (jj >> 1)) * 128 + (jj & 1) * 64 + key;
        const int qi = qb * 128 + ql;
        const int d = qi - kj;
        return (d <= 128 && d >= -128) ? 0.f : NEG;
      };
      auto tmode = [&](int j, int w) -> int {
        if (j < 8) return 0;
        const int jj = j - 8;
        const int k0 = (qb - 1 + (jj >> 1)) * 128 + (jj & 1) * 64, q0w = qb * 128 + w * 32;
        if (k0 - (q0w + 31) > 128 || q0w - (k0 + 63) > 128) return 2;
        if ((q0w + 31) - k0 <= 128 && (k0 + 63) - q0w <= 128) return 0;
        return 1;
      };
      attn_core(smem, p.QKV + (size_t)T0 * DIN + head * 64, 14, src, biasf, tmode, p.sink[l * 8 + head] * 1.44269504f, true,
                p.CAT + (size_t)T0 * DM + head * 64);
    } else if (item < 768) {
      const int it = item - 512;
      const int b = it >> 6, head = (it >> 4) & 3, qb = it & 15;
      const int T0 = NCTX + b * 2048 + qb * 128;
      float* srpb = (float*)(smem + 2 * 64 * LDT * 2);
      __syncthreads();
      for (int idx = tid; idx < 465; idx += 256) srpb[idx] = p.rpb[(size_t)(l * 4 + head) * 465 + idx] * 1.44269504f;
      const int r0 = 2 * qb;
      const int rmin = min(max(r0 - 4, 0), 24), rmax = min(max(r0 + 1 - 4, 0), 24) + 7;
      const float* ck = p.cbk + ((size_t)(b * 2 + l) * 512) * 256 + head * 64;
      const float* cv = p.cbv + ((size_t)(b * 2 + l) * 512) * 256 + head * 64;
      auto src = [&](int j, const void*& kp, const void*& vp, int& stride, bool& isf32) -> bool {
        if (j < 8) {
          kp = ck + (size_t)j * 64 * 256; vp = cv + (size_t)j * 64 * 256; stride = 256; isf32 = true;
          return true;
        }
        const int Tk = NCTX + b * 2048 + (rmin + j - 8) * 64;
        kp = p.QKV + (size_t)Tk * DIN + 1024 + head * 64; vp = p.QKV + (size_t)Tk * DIN + 1280 + head * 64; stride = DIN; isf32 = false;
        return true;
      };
      auto biasf = [&](int j, int key, int ql) -> float {
        if (j < 8) return 0.f;
        const int kr = rmin + j - 8, kc = key;
        const int qr = r0 + (ql >> 6), qc = ql & 63;
        const int rs = min(max(qr - 4, 0), 24), cs = min(max(qc - 8, 0), 48);
        const bool ok = (kr >= rs) && (kr < rs + 8) && (kc >= cs) && (kc < cs + 16);
        const int bi = ok ? ((kr - qr + 7) * 31 + (kc - qc + 15)) : 0;
        const float bv = srpb[bi];
        return ok ? bv : NEG;
      };
      auto tmode = [&](int j, int w) -> int {
        if (j < 8) return 0;
        const int kr = rmin + j - 8, qr = r0 + (w >> 1);
        const int rs = min(max(qr - 4, 0), 24);
        return (kr >= rs && kr < rs + 8) ? 1 : 2;
      };
      attn_core(smem, p.QKV + (size_t)T0 * DIN + 768 + head * 64, 8 + (rmax - rmin + 1), src, biasf, tmode, NEG, false,
                p.CAT + (size_t)T0 * DM + 512 + head * 64);
    } else if (item < 1152) {
      const int it = item - 768;
      if (it < 256) retkv_item(p, smem, l, 16 + (it >> 6), (it >> 4) & 3, it & 15);
      else { const int i2 = it - 256; retkv_item(p, smem, l, i2 >> 3, (i2 >> 1) & 3, i2 & 1); }
    } else if (item < 1408) {
      const int it = item - 1152;
      const int b = it >> 4, head = (it >> 1) & 7, qh = it & 1, kvh = head >> 2;
      const int T0 = b * 256 + qh * 128;
      auto src = [&](int j, const void*& kp, const void*& vp, int& stride, bool& isf32) -> bool {
        const int Tk = b * 256 + j * 64;
        kp = p.QKV + (size_t)Tk * DIN + 512 + kvh * 64; vp = p.QKV + (size_t)Tk * DIN + 640 + kvh * 64; stride = DIN; isf32 = false;
        return true;
      };
      auto biasf = [&](int, int, int) -> float { return 0.f; };
      auto tmode = [&](int, int) -> int { return 0; };
      attn_core(smem, p.QKV + (size_t)T0 * DIN + head * 64, 4, src, biasf, tmode, p.sink[l * 8 + head] * 1.44269504f, true,
                p.CAT + (size_t)T0 * DM + head * 64);
    } else {
      const int it = item - 1408;
      const int b = it >> 3, head = (it >> 1) & 3, qh = it & 1;
      const int T0 = b * 256 + qh * 128;
      auto src = [&](int j, const void*& kp, const void*& vp, int& stride, bool& isf32) -> bool {
        const int Tk = b * 256 + j * 64;
        kp = p.QKV + (size_t)Tk * DIN + 1024 + head * 64; vp = p.QKV + (size_t)Tk * DIN + 1280 + head * 64; stride = DIN; isf32 = false;
        return true;
      };
      auto biasf = [&](int, int, int) -> float { return 0.f; };
      auto tmode = [&](int, int) -> int { return 0; };
      attn_core(smem, p.QKV + (size_t)T0 * DIN + 768 + head * 64, 4, src, biasf, tmode, NEG, false,
                p.CAT + (size_t)T0 * DM + 512 + head * 64);
    }
  }
}

DI void phase2c(const Params& p, char* smem, int l) {
  u16* sK = (u16*)smem;
  u16* sVT = sK + 128 * LDT;
  u16* sSTf = sVT + 64 * LDT2;
  u16* sSTb = sSTf + 64 * LDT;
  const int tid = otid(), lane = tid & 63, w = tid >> 6, r = lane & 31, h = lane >> 5;
  const int rq = tid >> 4, c4 = tid & 15;
  const float one4[4] = {1.f, 1.f, 1.f, 1.f};
  for (int item = blockIdx.x; item < 384; item += gridDim.x) {
    int req, head, c, nc;
    if (item < 256) { req = 16 + (item >> 6); head = (item >> 4) & 3; c = item & 15; nc = 16; }
    else { const int i2 = item - 256; req = i2 >> 3; head = (i2 >> 1) & 3; c = i2 & 1; nc = 2; }
    const bool lat = req >= 16;
    const int T0 = (lat ? NCTX + (req - 16) * 2048 : req * 256) + c * 128;
    const float lgf = ret_lg(p, l, 0, head), lgb = ret_lg(p, l, 1, head);
    const float gf = __expf(lgf * 128.f), gb = __expf(lgb * 128.f);
    __syncthreads();
    {
      const int d = tid >> 2, e0 = (tid & 3) * 16;
#pragma unroll
      for (int dir = 0; dir < 2; ++dir) {
        float s[16];
#pragma unroll
        for (int q = 0; q < 16; ++q) s[q] = 0.f;
        const float g = dir ? gb : gf;
        if (lat) {
          const float* s0 = p.state + ((size_t)(((req - 16) * 2 + l) * 2 + dir) * 4 + head) * 4096 + d * 64 + e0;
#pragma unroll
          for (int q = 0; q < 16; q += 4) {
            const float4 x = *(const float4*)(s0 + q);
            s[q] = x.x; s[q + 1] = x.y; s[q + 2] = x.z; s[q + 3] = x.w;
          }
        }
        const int nsteps = dir ? (nc - 1 - c) : c;
        for (int st = 0; st < nsteps; ++st) {
          const int cc = dir ? (nc - 1 - st) : st;
          const float* kv = p.KVS + kvs_slot(req, head, dir, cc) + d * 64 + e0;
#pragma unroll
          for (int q = 0; q < 16; q += 4) {
            const float4 x = *(const float4*)(kv + q);
            s[q] = s[q] * g + x.x; s[q + 1] = s[q + 1] * g + x.y; s[q + 2] = s[q + 2] * g + x.z; s[q + 3] = s[q + 3] * g + x.w;
          }
        }
        u16* sST = dir ? sSTb : sSTf;
#pragma unroll
        for (int q = 0; q < 16; ++q) sST[(e0 + q) * LDT + d] = (u16)(pack2(s[q], 0.f) & 0xffffu);
        if (!lat && c == 0) {
          const float* k0 = p.KVS + kvs_slot(req, head, dir, 0) + d * 64 + e0;
          const float* k1 = p.KVS + kvs_slot(req, head, dir, 1) + d * 64 + e0;
          float* o = p.out + OFF_ST + ((size_t)((req * 2 + l) * 2 + dir) * 4 + head) * 4096 + d * 64 + e0;
#pragma unroll
          for (int q = 0; q < 16; ++q) o[q] = dir ? (gb * k1[q] + k0[q]) : (gf * k0[q] + k1[q]);
        }
      }
    }
#pragma unroll
    for (int half = 0; half < 2; ++half) {
      float v[4][4];
      load4x4(p.QKV + (size_t)(T0 + half * 64) * DIN + 1792 + head * 64, DIN, false, rq, c4, v);
      store_n(sK, LDT, half * 64, rq, c4, v);
      load4x4(p.QKV + (size_t)(T0 + half * 64) * DIN + 2048 + head * 64, DIN, false, rq, c4, v);
      store_t(sVT, LDT2, half * 64, rq, c4, v, one4);
    }
    __syncthreads();
    const int qi = w * 32 + r;
    const u16* qrow = p.QKV + (size_t)(T0 + qi) * DIN + 1536 + head * 64;
    uint4 qraw[4];
#pragma unroll
    for (int ks = 0; ks < 4; ++ks) qraw[ks] = *(const uint4*)(qrow + ks * 16 + 8 * h);
    f32x16 O[2];
#pragma unroll
    for (int d = 0; d < 2; ++d)
#pragma unroll
      for (int i = 0; i < 16; ++i) O[d][i] = 0.f;
#pragma unroll 1
    for (int jt = 0; jt < 4; ++jt) {
      f32x16 S;
#pragma unroll
      for (int i = 0; i < 16; ++i) S[i] = 0.f;
#pragma unroll
      for (int ks = 0; ks < 4; ++ks) {
        const bf16x8 kf = *(const bf16x8*)&sK[(jt * 32 + r) * LDT + ks * 16 + 8 * h];
        S = MFMA(kf, __builtin_bit_cast(bf16x8, qraw[ks]), S);
      }
#pragma unroll
      for (int i = 0; i < 16; ++i) {
        const int j = jt * 32 + crow(i, h);
        const int dlt = qi - j;
        const float wgt = (dlt > 0) ? __expf(lgf * (float)dlt) : ((dlt < 0) ? __expf(lgb * (float)(-dlt)) : 2.f);
        S[i] = S[i] * 0.125f * wgt;
      }
#pragma unroll
      for (int s = 0; s < 2; ++s) {
        const bf16x8 pf = mk8(pack2(S[8 * s + 0], S[8 * s + 1]), pack2(S[8 * s + 2], S[8 * s + 3]),
                              pack2(S[8 * s + 4], S[8 * s + 5]), pack2(S[8 * s + 6], S[8 * s + 7]));
#pragma unroll
        for (int d = 0; d < 2; ++d) {
          const u16* vrow = &sVT[(d * 32 + r) * LDT2 + jt * 32 + 16 * s + 4 * h];
          const uint2 lo = *(const uint2*)vrow;
          const uint2 hi = *(const uint2*)(vrow + 8);
          O[d] = MFMA(mk8(lo.x, lo.y, hi.x, hi.y), pf, O[d]);
        }
      }
    }
    {
      const float xf = __expf(lgf * (float)(qi + 1)), xb = __expf(lgb * (float)(128 - qi));
#pragma unroll
      for (int ks = 0; ks < 4; ++ks) {
        const uint4 q = qraw[ks];
        const bf16x8 qsf = mk8(pack2(bflo(q.x) * xf, bfhi(q.x) * xf), pack2(bflo(q.y) * xf, bfhi(q.y) * xf),
                               pack2(bflo(q.z) * xf, bfhi(q.z) * xf), pack2(bflo(q.w) * xf, bfhi(q.w) * xf));
        const bf16x8 qsb = mk8(pack2(bflo(q.x) * xb, bfhi(q.x) * xb), pack2(bflo(q.y) * xb, bfhi(q.y) * xb),
                               pack2(bflo(q.z) * xb, bfhi(q.z) * xb), pack2(bflo(q.w) * xb, bfhi(q.w) * xb));
#pragma unroll
        for (int d = 0; d < 2; ++d) {
          const bf16x8 sf = *(const bf16x8*)&sSTf[(d * 32 + r) * LDT + ks * 16 + 8 * h];
          const bf16x8 sb = *(const bf16x8*)&sSTb[(d * 32 + r) * LDT + ks * 16 + 8 * h];
          O[d] = MFMA(sf, qsf, O[d]);
          O[d] = MFMA(sb, qsb, O[d]);
        }
      }
    }
    float sum = 0.f;
#pragma unroll
    for (int d = 0; d < 2; ++d)
#pragma unroll
      for (int i = 0; i < 16; ++i) sum += O[d][i];
    sum += __shfl_xor(sum, 32);
    const float mu = sum * (1.f / 64.f);
    float vs = 0.f;
#pragma unroll
    for (int d = 0; d < 2; ++d)
#pragma unroll
      for (int i = 0; i < 16; ++i) { const float t = O[d][i] - mu; vs += t * t; }
    vs += __shfl_xor(vs, 32);
    const float rstd = rsqrtf(vs * (1.f / 64.f) + 1e-6f);
    const u16* grow = p.QKV + (size_t)(T0 + qi) * DIN + 2304 + head * 64;
    const float* gnw = p.gn + l * 256 + head * 64;
    u16* orow = p.CAT + (size_t)(T0 + qi) * DM + 768 + head * 64;
#pragma unroll
    for (int d = 0; d < 2; ++d)
#pragma unroll
      for (int g = 0; g < 4; ++g) {
        const int e = d * 32 + 8 * g + 4 * h;
        const uint2 gr = *(const uint2*)(grow + e);
        const float4 gw = *(const float4*)(gnw + e);
        const float o0 = silu(bflo(gr.x)) * (O[d][4 * g + 0] - mu) * rstd * gw.x;
        const float o1 = silu(bfhi(gr.x)) * (O[d][4 * g + 1] - mu) * rstd * gw.y;
        const float o2 = silu(bflo(gr.y)) * (O[d][4 * g + 2] - mu) * rstd * gw.z;
        const float o3 = silu(bfhi(gr.y)) * (O[d][4 * g + 3] - mu) * rstd * gw.w;
        uint2 pk = {pack2(o0, o1), pack2(o2, o3)};
        *(uint2*)(orow + e) = pk;
      }
  }
}

DI void phase3(const Params& p, char* smem, int l, const float* xc, const float* xl) {
  const float* W = p.w_out + (size_t)l * DM * DM;
  const int xcd = blockIdx.x & 7, nloc = gridDim.x >> 3;
  auto setup = [&](int s, int ar0, int ac, int n4, int kq, const u16*& q0, const u16*& q1, const u16*& q2, const u16*& q3, const float*& bp) {
    const int tm = 12 * xcd + s % 12, tn = s / 12;
    const u16* ab = p.CAT + ((size_t)tm * 128 + ar0) * DM + ac;
    q0 = ab; q1 = ab + 32 * DM; q2 = ab + 64 * DM; q3 = ab + 96 * DM;
    bp = W + tn * 128 + 4 * n4 + (size_t)(kq * 8) * DM;
  };
  auto epi = [&](int s, f32x16(&acc)[4], int w, int r, int h) {
    int hq = h;
    asm volatile("" : "+v"(hq));
    const int tm = 12 * xcd + s % 12, tn = s / 12;
    const int m0 = tm * 128, n0 = tn * 128;
    const float* g1 = p.MOD + (size_t)(l * 5 + cond_of(m0)) * 6144 + 2048;
    const int n = n0 + 4 * r;
    const float4 g = *(const float4*)(g1 + n);
#pragma unroll
    for (int i = 0; i < 16; ++i) {
      const int ml = w * 32 + crow(i, hq);
      const float4 o = {g.x * acc[0][i], g.y * acc[1][i], g.z * acc[2][i], g.w * acc[3][i]};
      *(float4*)(p.PRE + (size_t)(m0 + ml) * DM + n) = o;
    }
  };
  gemm_phase128(smem, blockIdx.x >> 3, 96, nloc, setup, DM, epi);
}

DI void phase4(const Params& p, char* smem, int l, const float* xc, const float* xl) {
  float* swr = (float*)smem;
  const int tid = otid(), lane = tid & 63, w = tid >> 6;
  __syncthreads();
  for (int idx = tid; idx < 4096; idx += 256) {
    const float4 x = *(const float4*)(p.w_router + (size_t)l * DM * 16 + idx * 4);
    const int k = idx >> 2, e = (idx & 3) * 4;
    swr[(e + 0) * DM + k] = x.x; swr[(e + 1) * DM + k] = x.y; swr[(e + 2) * DM + k] = x.z; swr[(e + 3) * DM + k] = x.w;
  }
  __syncthreads();
  const float* lg = p.ln1g + l * DM;
  const float* lb = p.ln1b + l * DM;
  for (int T = blockIdx.x * 4 + w; T < NTOK; T += gridDim.x * 4) {
    const float* mod = p.MOD + (size_t)(l * 5 + cond_of(T)) * 6144;
    const float* xrow = (T < NCTX) ? (xc + (size_t)T * DM) : (xl + (size_t)(T - NCTX) * DM);
    float4 x[4];
    float s = 0.f;
#pragma unroll
    for (int i = 0; i < 4; ++i) {
      const float4 pr = *(const float4*)(p.PRE + (size_t)T * DM + 256 * i + 4 * lane);
      const float4 xi = *(const float4*)(xrow + 256 * i + 4 * lane);
      x[i].x = ALPHA * xi.x + pr.x; x[i].y = ALPHA * xi.y + pr.y; x[i].z = ALPHA * xi.z + pr.z; x[i].w = ALPHA * xi.w + pr.w;
      s += x[i].x + x[i].y + x[i].z + x[i].w;
    }
    const float mu = wave_sum(s) * (1.f / 1024.f);
    float vs = 0.f;
#pragma unroll
    for (int i = 0; i < 4; ++i) {
      x[i].x -= mu; x[i].y -= mu; x[i].z -= mu; x[i].w -= mu;
      vs += x[i].x * x[i].x + x[i].y * x[i].y + x[i].z * x[i].z + x[i].w * x[i].w;
    }
    const float rstd = rsqrtf(wave_sum(vs) * (1.f / 1024.f) + 1e-6f);
#pragma unroll
    for (int i = 0; i < 4; ++i) {
      const int k = 256 * i + 4 * lane;
      const float4 g = *(const float4*)(lg + k), bb = *(const float4*)(lb + k);
      float4 y;
      y.x = x[i].x * rstd * g.x + bb.x; y.y = x[i].y * rstd * g.y + bb.y; y.z = x[i].z * rstd * g.z + bb.z; y.w = x[i].w * rstd * g.w + bb.w;
      *(float4*)(p.X + (size_t)T * DM + k) = y;
      const float4 sc = *(const float4*)(mod + 4096 + k), sh = *(const float4*)(mod + 3072 + k);
      float4 hh;
      hh.x = y.x * (1.f + sc.x) + sh.x; hh.y = y.y * (1.f + sc.y) + sh.y; hh.z = y.z * (1.f + sc.z) + sh.z; hh.w = y.w * (1.f + sc.w) + sh.w;
      uint2 pk = {pack2(hh.x, hh.y), pack2(hh.z, hh.w)};
      *(uint2*)(p.H2 + (size_t)T * DM + k) = pk;
      x[i] = hh;
    }
    float a16[16];
#pragma unroll
    for (int e = 0; e < 16; ++e) {
      float a = 0.f;
#pragma unroll
      for (int i = 0; i < 4; ++i) {
        const float4 wv = *(const float4*)(swr + e * DM + 256 * i + 4 * lane);
        a += x[i].x * wv.x + x[i].y * wv.y + x[i].z * wv.z + x[i].w * wv.w;
      }
      a16[e] = a;
      if ((e & 3) == 3) __builtin_amdgcn_sched_barrier(0);
    }
    float a8[8], a4[4], a2[2], a1;
    {
      const bool hi = (lane & 32) != 0;
#pragma unroll
      for (int j = 0; j < 8; ++j) {
        const float snd = hi ? a16[j] : a16[8 + j];
        const float kp = hi ? a16[8 + j] : a16[j];
        a8[j] = kp + __shfl_xor(snd, 32);
      }
    }
    {
      const bool hi = (lane & 16) != 0;
#pragma unroll
      for (int j = 0; j < 4; ++j) {
        const float snd = hi ? a8[j] : a8[4 + j];
        const float kp = hi ? a8[4 + j] : a8[j];
        a4[j] = kp + __shfl_xor(snd, 16);
      }
    }
    {
      const bool hi = (lane & 8) != 0;
#pragma unroll
      for (int j = 0; j < 2; ++j) {
        const float snd = hi ? a4[j] : a4[2 + j];
        const float kp = hi ? a4[2 + j] : a4[j];
        a2[j] = kp + __shfl_xor(snd, 8);
      }
    }
    {
      const bool hi = (lane & 4) != 0;
      const float snd = hi ? a2[0] : a2[1];
      const float kp = hi ? a2[1] : a2[0];
      a1 = kp + __shfl_xor(snd, 4);
    }
    a1 += __shfl_xor(a1, 2);
    a1 += __shfl_xor(a1, 1);
    const int myexp = ((lane >> 5) & 1) * 8 + ((lane >> 4) & 1) * 4 + ((lane >> 3) & 1) * 2 + ((lane >> 2) & 1);
    float mx = a1;
#pragma unroll
    for (int o = 32; o >= 4; o >>= 1) mx = fmaxf(mx, __shfl_xor(mx, o));
    const float ex = __expf(a1 - mx);
    float den = ex;
#pragma unroll
    for (int o = 32; o >= 4; o >>= 1) den += __shfl_xor(den, o);
    if ((lane & 3) == 0) { p.AFF[(size_t)T * 16 + myexp] = ex / den; p.INV[(size_t)T * 16 + myexp] = -1; }
  }
}

DI unsigned block_incl_scan(unsigned v, unsigned* wsum, int lane, int w, unsigned& total) {
#pragma unroll
  for (int o = 1; o < 64; o <<= 1) {
    const unsigned t = __shfl_up(v, o);
    if (lane >= o) v += t;
  }
  __syncthreads();
  if (lane == 63) wsum[w] = v;
  __syncthreads();
  unsigned off = 0;
  total = 0;
#pragma unroll
  for (int i = 0; i < 4; ++i) {
    const unsigned s = wsum[i];
    if (i < w) off += s;
    total += s;
  }
  return v + off;
}

DI void phase5(const Params& p, char* smem) {
  unsigned* hist = (unsigned*)smem;
  unsigned* wsum = hist + 256;
  unsigned* bc = wsum + 4;
  const int tid = otid(), lane = tid & 63, w = tid >> 6;
  for (int item = blockIdx.x; item < 320; item += gridDim.x) {
    int n, base, e, cap, rowbase;
    if (item < 64) {
      const int b = item >> 4; e = item & 15;
      n = 2048; base = NCTX + b * 2048; cap = 256; rowbase = 512 + b * 256;
    } else {
      const int it = item - 64; const int rq = it >> 4; e = it & 15;
      n = 256; base = rq * 256; cap = 32; rowbase = rq * 32;
    }
    const int per = n >> 8;
    unsigned key[8];
#pragma unroll
    for (int q = 0; q < 8; ++q) key[q] = (q < per) ? __float_as_uint(p.AFF[(size_t)(base + tid * per + q) * 16 + e]) : 0u;
    unsigned prefix = 0u, mask = 0u;
    unsigned remaining = (unsigned)cap;
#pragma unroll 1
    for (int pass = 3; pass >= 0; --pass) {
      const int shift = pass * 8;
      __syncthreads();
      hist[tid] = 0u;
      __syncthreads();
#pragma unroll
      for (int q = 0; q < 8; ++q)
        if (q < per && (key[q] & mask) == prefix) atomicAdd(&hist[(key[q] >> shift) & 255u], 1u);
      __syncthreads();
      const unsigned hv = hist[tid];
      unsigned total;
      const unsigned incl = block_incl_scan(hv, wsum, lane, w, total);
      const unsigned above = total - incl;
      if (above < remaining && remaining <= above + hv) { bc[0] = (unsigned)tid; bc[1] = remaining - above; }
      __syncthreads();
      const unsigned bsel = bc[0];
      remaining = bc[1];
      prefix |= bsel << shift;
      mask |= 0xFFu << shift;
    }
    const unsigned thr = prefix;
    unsigned ceq = 0u;
#pragma unroll
    for (int q = 0; q < 8; ++q) ceq += (q < per && key[q] == thr) ? 1u : 0u;
    unsigned tot;
    unsigned eq_before = block_incl_scan(ceq, wsum, lane, w, tot) - ceq;
    unsigned selmask = 0u, nsel = 0u;
#pragma unroll
    for (int q = 0; q < 8; ++q) {
      if (q < per) {
        const bool eq = key[q] == thr;
        const bool sel = (key[q] > thr) || (eq && eq_before < remaining);
        eq_before += eq ? 1u : 0u;
        selmask |= sel ? (1u << q) : 0u;
        nsel += sel ? 1u : 0u;
      }
    }
    unsigned row = block_incl_scan(nsel, wsum, lane, w, tot) - nsel;
#pragma unroll
    for (int q = 0; q < 8; ++q) {
      if (q < per && ((selmask >> q) & 1u)) {
        const int tok = base + tid * per + q;
        const int rr = e * NROWS_E + rowbase + (int)row;
        p.SELTOK[rr] = tok;
        p.SELGATE[rr] = __uint_as_float(key[q]);
        p.INV[(size_t)tok * 16 + e] = rr;
        ++row;
      }
    }
  }
}

DI void phase6(const Params& p, char* smem, int l) {
  const int xcd = blockIdx.x & 7, nloc = gridDim.x >> 3;
  auto setup = [&](int s, int ar0, int ac, int n4, int kq, const u16*& q0, const u16*& q1, const u16*& q2, const u16*& q3, const float*& bp) {
    const int e = 2 * xcd + s / 96, rem = s % 96, tn = rem / 6, tm = rem % 6;
    const int* tok = p.SELTOK + e * NROWS_E + tm * 256 + ar0;
    q0 = p.H2 + (size_t)tok[0] * DM + ac; q1 = p.H2 + (size_t)tok[64] * DM + ac;
    q2 = p.H2 + (size_t)tok[128] * DM + ac; q3 = p.H2 + (size_t)tok[192] * DM + ac;
    bp = p.w_gu + ((size_t)l * 16 + e) * DM * 2048 + ((n4 >> 4) & 1) * 1024 + tn * 64 + 4 * (n4 & 15) + (size_t)(kq * 4) * 2048;
  };
  auto epi = [&](int s, f32x16(&acc)[2][4], int w, int r, int h) {
    int hq = h;
    asm volatile("" : "+v"(hq));
    const int e = 2 * xcd + s / 96, rem = s % 96, tn = rem / 6, tm = rem % 6;
    const int m0 = tm * 256, f0 = tn * 64;
    u16* act = p.ACT + ((size_t)e * NROWS_E + m0) * DM;
#pragma unroll
    for (int mt = 0; mt < 2; ++mt)
#pragma unroll
    for (int i = 0; i < 16; ++i) {
      const int ml = w * 64 + mt * 32 + crow(i, hq);
      const float a0 = acc[mt][0][i], a1 = acc[mt][1][i], a2 = acc[mt][2][i], a3 = acc[mt][3][i];
      const bool lo = r < 16;
      const float s0 = lo ? a2 : a0, s1 = lo ? a3 : a1;
      const float r0 = __shfl_xor(s0, 16), r1 = __shfl_xor(s1, 16);
      const float g0 = lo ? a0 : r0, g1 = lo ? a1 : r1;
      const float v0 = lo ? r0 : a2, v1 = lo ? r1 : a3;
      *(unsigned*)(act + (size_t)ml * DM + f0 + 4 * (r & 15) + (lo ? 0 : 2)) = pack2(silu(g0) * v0, silu(g1) * v1);
      if ((i & 3) == 3) __builtin_amdgcn_sched_barrier(0);
    }
  };
  gemm_phase<false>(smem, blockIdx.x >> 3, 192, nloc, setup, 2048, epi);
}

DI void phase7(const Params& p, char* smem, int l, u16* FF) {
  const int xcd = blockIdx.x & 7, nloc = gridDim.x >> 3;
  auto setup = [&](int s, int ar0, int ac, int n4, int kq, const u16*& q0, const u16*& q1, const u16*& q2, const u16*& q3, const float*& bp) {
    const int e = 2 * xcd + s / 48, rem = s % 48, tn = rem / 6, tm = rem % 6;
    const u16* ab = p.ACT + ((size_t)e * NROWS_E + tm * 256 + ar0) * DM + ac;
    q0 = ab; q1 = ab + 64 * DM; q2 = ab + 128 * DM; q3 = ab + 192 * DM;
    bp = p.w_down + ((size_t)l * 16 + e) * DM * DM + tn * 128 + 4 * n4 + (size_t)(kq * 4) * DM;
  };
  auto epi = [&](int s, f32x16(&acc)[2][4], int w, int r, int h) {
    int hq = h;
    asm volatile("" : "+v"(hq));
    const int e = 2 * xcd + s / 48, rem = s % 48, tn = rem / 6, tm = rem % 6;
    const int m0 = tm * 256, n0 = tn * 128;
    const float* gate = p.SELGATE + e * NROWS_E + m0;
#pragma unroll
    for (int mt = 0; mt < 2; ++mt)
#pragma unroll
    for (int i = 0; i < 16; ++i) {
      const int ml = w * 64 + mt * 32 + crow(i, hq);
      const float g = gate[ml];
      uint2 pk = {pack2(g * acc[mt][0][i], g * acc[mt][1][i]), pack2(g * acc[mt][2][i], g * acc[mt][3][i])};
      *(uint2*)(FF + ((size_t)e * NROWS_E + m0 + ml) * DM + n0 + 4 * r) = pk;
      if ((i & 3) == 3) __builtin_amdgcn_sched_barrier(0);
    }
  };
  gemm_phase<true>(smem, blockIdx.x >> 3, 96, nloc, setup, DM, epi);
}

DI void phase8(const Params& p, int l, float* dst, bool write_h) {
  const int tid = otid(), lane = tid & 63, w = tid >> 6;
  const float* lg = p.ln2g + l * DM;
  const float* lb = p.ln2b + l * DM;
  for (int T = blockIdx.x * 4 + w; T < NTOK; T += gridDim.x * 4) {
    const float* g2 = p.MOD + (size_t)(l * 5 + cond_of(T)) * 6144 + 5120;
    const float* modn = p.MOD + (size_t)(5 + cond_of(T)) * 6144;
    float4 x[4], ff[4];
#pragma unroll
    for (int i = 0; i < 4; ++i) ff[i] = make_float4(0.f, 0.f, 0.f, 0.f);
    const int myinv = p.INV[(size_t)T * 16 + (lane & 15)];
#pragma unroll 1
    for (int e = 0; e < 16; ++e) {
      const int row = __shfl(myinv, e);
      if (row >= 0) {
#pragma unroll
        for (int i = 0; i < 4; ++i) {
          const uint2 y = *(const uint2*)(p.YE + (size_t)row * DM + 256 * i + 4 * lane);
          ff[i].x += bflo(y.x); ff[i].y += bfhi(y.x); ff[i].z += bflo(y.y); ff[i].w += bfhi(y.y);
        }
      }
    }
    float s = 0.f;
#pragma unroll
    for (int i = 0; i < 4; ++i) {
      const int k = 256 * i + 4 * lane;
      const float4 a = *(const float4*)(p.X + (size_t)T * DM + k);
      const float4 f = ff[i];
      const float4 g = *(const float4*)(g2 + k);
      x[i].x = ALPHA * a.x + g.x * f.x; x[i].y = ALPHA * a.y + g.y * f.y; x[i].z = ALPHA * a.z + g.z * f.z; x[i].w = ALPHA * a.w + g.w * f.w;
      s += x[i].x + x[i].y + x[i].z + x[i].w;
    }
    const float mu = wave_sum(s) * (1.f / 1024.f);
    float vs = 0.f;
#pragma unroll
    for (int i = 0; i < 4; ++i) {
      x[i].x -= mu; x[i].y -= mu; x[i].z -= mu; x[i].w -= mu;
      vs += x[i].x * x[i].x + x[i].y * x[i].y + x[i].z * x[i].z + x[i].w * x[i].w;
    }
    const float rstd = rsqrtf(wave_sum(vs) * (1.f / 1024.f) + 1e-6f);
#pragma unroll
    for (int i = 0; i < 4; ++i) {
      const int k = 256 * i + 4 * lane;
      const float4 g = *(const float4*)(lg + k), bb = *(const float4*)(lb + k);
      float4 y;
      y.x = x[i].x * rstd * g.x + bb.x; y.y = x[i].y * rstd * g.y + bb.y; y.z = x[i].z * rstd * g.z + bb.z; y.w = x[i].w * rstd * g.w + bb.w;
      *(float4*)(dst + (size_t)T * DM + k) = y;
      if (write_h) {
        const float4 sc = *(const float4*)(modn + 1024 + k), sh = *(const float4*)(modn + k);
        uint2 pk = {pack2(y.x * (1.f + sc.x) + sh.x, y.y * (1.f + sc.y) + sh.y), pack2(y.z * (1.f + sc.z) + sh.z, y.w * (1.f + sc.w) + sh.w)};
        *(uint2*)(p.H2 + (size_t)T * DM + k) = pk;
      }
    }
  }
}

constexpr int kDynLds = 73728;
__global__ void __launch_bounds__(256, 2) mega(Params p) {
  extern __shared__ __attribute__((aligned(16))) char smem[];
  cg::grid_group grid = cg::this_grid();
  if (p.never) grid.sync();
  GBar gb;
  gb.bar = p.BAR; gb.x = xb_xcc_id(); gb.nloc = 0u; gb.nx = 0u;
  if (threadIdx.x == 0) (void)xb_add(&p.BAR[XB_XCNT(gb.x)], 1u);
  phase0(p, smem);
  gbar(gb);
  phase0b(p);
  gbar(gb);
#pragma unroll 1
  for (int l = 0; l < 2; ++l) {
    const float* xc = (l == 0) ? p.x_prompt : p.X;
    const float* xl = (l == 0) ? p.x_sample : (p.X + (size_t)NCTX * DM);
    phase1(p, smem, l);
    gbar(gb);
    if (PROBE == 1) { phase1(p, smem, l); gbar(gb); }
    phase2(p, smem, l);
    gbar(gb);
    if (PROBE == 3) { phase2(p, smem, l); gbar(gb); }
    phase2c(p, smem, l);
    gbar(gb);
    if (PROBE == 3) { phase2c(p, smem, l); gbar(gb); }
    phase3(p, smem, l, xc, xl);
    gbar(gb);
    if (PROBE == 1) { phase3(p, smem, l, xc, xl); gbar(gb); }
    phase4(p, smem, l, xc, xl);
    gbar(gb);
    phase5(p, smem);
    gbar(gb);
    phase6(p, smem, l);
    gbar(gb);
    if (PROBE == 1) { phase6(p, smem, l); gbar(gb); }
    phase7(p, smem, l, p.YE);
    gbar(gb);
    phase8(p, l, (l == 1) ? p.out : p.X, l == 0);
    if (l == 0) gbar(gb);
  }
}

extern "C" void kernel_launch(void* const* d_in, const int* in_sizes, int n_in, void* d_out, int out_size, void* d_ws,
                              size_t ws_size, hipStream_t stream) {
  static int grid_blocks = 0;
  if (!grid_blocks) {
    int dev = 0, cus = 0, per_cu = 0;
    hipGetDevice(&dev);
    hipDeviceGetAttribute(&cus, hipDeviceAttributeMultiprocessorCount, dev);
    hipFuncSetAttribute((const void*)mega, hipFuncAttributeMaxDynamicSharedMemorySize, kDynLds);
    hipOccupancyMaxActiveBlocksPerMultiprocessor(&per_cu, mega, 256, kDynLds);
    if (per_cu > 2) per_cu = 2;
    if (per_cu < 1) per_cu = 1;
    grid_blocks = cus * per_cu;
  }
  Params p{};
  const float** pf = (const float**)&p;
  for (int i = 0; i < 24; ++i) pf[i] = (const float*)d_in[i];
  p.out = (float*)d_out;
  char* ws = (char*)d_ws;
  size_t off = 0;
  auto take = [&](size_t bytes) { char* q = ws + off; off += (bytes + 255) & ~(size_t)255; return q; };
  p.MOD = (float*)take(2 * 5 * 6144 * 4);
  p.BAR = (unsigned*)take(XCD_BAR_WORDS * 4);
  p.ROPE = (float*)take(2048 * 4);
  p.X = (float*)take((size_t)NTOK * DM * 4);
  p.PRE = (float*)take((size_t)NTOK * DM * 4);
  p.KVS = (float*)take((size_t)20 * 4 * 2 * 16 * 4096 * 4);
  p.AFF = (float*)take((size_t)NTOK * 16 * 4);
  p.SELGATE = (float*)take((size_t)16 * NROWS_E * 4);
  p.SELTOK = (int*)take((size_t)16 * NROWS_E * 4);
  p.QKV = (u16*)take((size_t)NTOK * DIN * 2);
  p.CAT = (u16*)take((size_t)NTOK * DM * 2);
  p.H2 = (u16*)take((size_t)NTOK * DM * 2);
  p.ACT = (u16*)take((size_t)16 * NROWS_E * DM * 2);
  p.YE = (u16*)take((size_t)16 * NROWS_E * DM * 2);
  p.INV = (int*)take((size_t)NTOK * 16 * 4);
  p.never = 0;
  hipMemsetAsync(p.MOD, 0, (size_t)((char*)p.BAR - (char*)p.MOD) + XCD_BAR_WORDS * 4, stream);
  void* args[] = {&p};
  hipError_t e = hipLaunchCooperativeKernel((void*)mega, dim3(grid_blocks), dim3(256), args, kDynLds, stream);
  if (e != hipSuccess) fprintf(stderr, "cooperative launch failed: %s (grid %d)\n", hipGetErrorString(e), grid_blocks);
}
```

```cpp
#include <hip/hip_runtime.h>
#include <hip/hip_cooperative_groups.h>
#include <cstdio>
namespace cg = cooperative_groups;

#define DI __device__ __forceinline__
typedef short bf16x8 __attribute__((ext_vector_type(8)));
typedef float f32x16 __attribute__((ext_vector_type(16)));
typedef __bf16 bf2_t __attribute__((ext_vector_type(2)));
typedef float f2_t __attribute__((ext_vector_type(2)));
typedef unsigned short u16;
typedef unsigned u32x4 __attribute__((ext_vector_type(4)));
typedef float f32x4 __attribute__((ext_vector_type(4)));
typedef float f32x2 __attribute__((ext_vector_type(2)));

#define MFMA(a, b, c) __builtin_amdgcn_mfma_f32_32x32x16_bf16((a), (b), (c), 0, 0, 0)

#define PROBE 0
constexpr int NTOK = 12288;
constexpr int NCTX = 4096;
constexpr int DM = 1024;
constexpr int DIN = 2560;
constexpr int LDT = 72;
constexpr int LDT2 = 136;
constexpr int NROWS_E = 1536;
constexpr float NEG = -1e30f;
constexpr float ALPHA = 1.41421356237f;

constexpr size_t OFF_AK = 12582912, OFF_AV = 13631488, OFF_BK = 14680064, OFF_BV = 16777216, OFF_ST = 18874368;

struct Params {
  const float *x_prompt, *x_sample, *cak, *cav, *cbk, *cbv, *state, *c, *c_ctx, *w_ada, *b_ada, *w_in, *w_out, *sink, *rpb,
      *decay, *gn, *ln1g, *ln1b, *ln2g, *ln2b, *w_router, *w_gu, *w_down;
  float* out;
  float *MOD, *ROPE, *X, *PRE, *KVS, *AFF, *SELGATE;
  int* SELTOK;
  u16 *QKV, *CAT, *H2, *ACT, *CAK, *CAV, *CBK, *CBV;
  u16* YE;
  int* INV;
  unsigned* BAR;
  long never;
};

DI unsigned pack2(float a, float b) {
  f2_t v = {a, b};
  bf2_t r = __builtin_convertvector(v, bf2_t);
  return __builtin_bit_cast(unsigned, r);
}
DI int otid() { int x = threadIdx.x; asm volatile("" : "+v"(x)); return x; }
DI float bflo(unsigned u) { return __uint_as_float(u << 16); }
DI float bfhi(unsigned u) { return __uint_as_float(u & 0xffff0000u); }
DI int crow(int i, int h) { return (i & 3) + 8 * (i >> 2) + 4 * h; }
DI float silu(float x) { return x / (1.f + __expf(-x)); }
DI float wave_sum(float v) {
#pragma unroll
  for (int o = 32; o >= 1; o >>= 1) v += __shfl_xor(v, o);
  return v;
}
DI bf16x8 mk8(unsigned a, unsigned b, unsigned c, unsigned d) {
  uint4 u = {a, b, c, d};
  return __builtin_bit_cast(bf16x8, u);
}


#define XB_TMO 128
#define XB_XCNT(j) (256 + 64 * (j))
#define XB_XSUB(j) (1280 + 64 * (j))
#define XB_XGEN(j) (2304 + 64 * (j))
#define XB_TOP 3328
#define XB_TOPGEN 3392
#define XCD_BAR_WORDS 3456
#define XB_SPIN_CAP (1u << 20)
DI unsigned xb_ld(unsigned* p) { return __hip_atomic_load(p, __ATOMIC_RELAXED, __HIP_MEMORY_SCOPE_AGENT); }
DI unsigned xb_add(unsigned* p, unsigned v) { return __hip_atomic_fetch_add(p, v, __ATOMIC_RELAXED, __HIP_MEMORY_SCOPE_AGENT); }
DI unsigned xb_xcc_id() { return (unsigned)__builtin_amdgcn_s_getreg((3 << 11) | 20) & 0xFu; }
#define XB_SPIN(cond, bar)                                                            \
  do {                                                                                \
    unsigned _sp = 0;                                                                 \
    while (cond) {                                                                    \
      __builtin_amdgcn_s_sleep(1);                                                    \
      if ((++_sp & 255u) == 0u) {                                                     \
        if (xb_ld(&(bar)[XB_TMO])) break;                                             \
        if (_sp > XB_SPIN_CAP) { atomicAdd(&(bar)[XB_TMO], 1u); break; }              \
      }                                                                               \
    }                                                                                 \
  } while (0)
struct GBar { unsigned* bar; unsigned x, nloc, nx; };
DI void gbar_complete(unsigned* bar, unsigned x, unsigned& nloc, unsigned& nx) {
  const unsigned G = gridDim.x;
  unsigned sum, cnt, mine, sp = 0u;
  for (;;) {
    sum = 0u; cnt = 0u; mine = 0u;
#pragma unroll
    for (unsigned j = 0; j < 16; ++j) {
      const unsigned c = xb_ld(&bar[XB_XCNT(j)]);
      sum += c; cnt += (c > 0u) ? 1u : 0u; mine = (j == x) ? c : mine;
    }
    if (sum == G) break;
    __builtin_amdgcn_s_sleep(1);
    if ((++sp & 255u) == 0u) {
      if (xb_ld(&bar[XB_TMO])) break;
      if (sp > XB_SPIN_CAP) { atomicAdd(&bar[XB_TMO], 1u); break; }
    }
  }
  nloc = mine > 0u ? mine : 1u;
  nx = cnt > 0u ? cnt : 1u;
}
DI void gbar(GBar& b) {
  asm volatile("s_waitcnt vmcnt(0)" ::: "memory");
  __syncthreads();
  if (threadIdx.x == 0) {
    unsigned* bar = b.bar;
    __builtin_amdgcn_s_waitcnt(0);
    if (b.nloc == 0u) gbar_complete(bar, b.x, b.nloc, b.nx);
    const unsigned nloc = b.nloc, nx = b.nx;
    const unsigned old = xb_add(&bar[XB_XSUB(b.x)], 1u);
    const unsigned gen = old / nloc;
    if (old + 1u == (gen + 1u) * nloc) {
      __builtin_amdgcn_fence(__ATOMIC_RELEASE, "agent");
      asm volatile("s_waitcnt vmcnt(0)" ::: "memory");
      const unsigned og = xb_add(&bar[XB_TOP], 1u);
      const unsigned tg = og / nx;
      if (og + 1u == (tg + 1u) * nx) xb_add(&bar[XB_TOPGEN], 1u);
      else XB_SPIN(xb_ld(&bar[XB_TOPGEN]) == tg, bar);
      __builtin_amdgcn_fence(__ATOMIC_ACQUIRE, "agent");
      xb_add(&bar[XB_XGEN(b.x)], 1u);
      asm volatile("s_waitcnt vmcnt(0)" ::: "memory");
    } else {
      XB_SPIN(xb_ld(&bar[XB_XGEN(b.x)]) == gen, bar);
      __builtin_amdgcn_fence(__ATOMIC_ACQUIRE, "agent");
      asm volatile("s_waitcnt vmcnt(0)" ::: "memory");
    }
  }
  __syncthreads();
}

template <class Setup, class Epi>
DI void gemm_phase128(char* smem, int s0, int s_end, int s_step, Setup setup, int ldb, Epi epi) {
  if (s0 >= s_end) return;
  u16* sA0 = (u16*)smem;
  u16* sB0 = sA0 + 128 * LDT;
  u16* sA1 = sB0 + 128 * LDT;
  u16* sB1 = sA1 + 128 * LDT;
  const int tid = otid(), lane = tid & 63, w = tid >> 6, r = lane & 31, h = lane >> 5;
  const int a_r0 = tid >> 3, a_c = (tid & 7) * 8;
  const int b_n4 = tid & 31, b_kq = tid >> 5;
  const u16 *apb0, *apb1, *apb2, *apb3;
  const float* bp;
  setup(s0, a_r0, a_c, b_n4, b_kq, apb0, apb1, apb2, apb3, bp);

  u32x4 pa0, pa1, pa2, pa3;
  f32x4 pb[8];

#define G_LOAD(KT)                                                                       \
  {                                                                                      \
    const int k0_ = (KT) * 64;                                                           \
    pa0 = *(const u32x4*)(apb0 + k0_);                                                   \
    pa1 = *(const u32x4*)(apb1 + k0_);                                                   \
    pa2 = *(const u32x4*)(apb2 + k0_);                                                   \
    pa3 = *(const u32x4*)(apb3 + k0_);                                                   \
    _Pragma("unroll") for (int i_ = 0; i_ < 8; ++i_) pb[i_] = *(const f32x4*)(bp + (size_t)(k0_ + i_) * ldb); \
  }
#define G_STAGE(SA, SBB)                                                                 \
  {                                                                                      \
    *(u32x4*)&SA[(a_r0)*LDT + a_c] = pa0;                                                \
    *(u32x4*)&SA[(a_r0 + 32) * LDT + a_c] = pa1;                                         \
    *(u32x4*)&SA[(a_r0 + 64) * LDT + a_c] = pa2;                                         \
    *(u32x4*)&SA[(a_r0 + 96) * LDT + a_c] = pa3;                                         \
    _Pragma("unroll") for (int j_ = 0; j_ < 4; ++j_) {                                   \
      u32x4 pk_;                                                                         \
      pk_.x = pack2(pb[0][j_], pb[1][j_]);                                               \
      pk_.y = pack2(pb[2][j_], pb[3][j_]);                                               \
      pk_.z = pack2(pb[4][j_], pb[5][j_]);                                               \
      pk_.w = pack2(pb[6][j_], pb[7][j_]);                                               \
      *(u32x4*)&SBB[(j_ * 32 + b_n4) * LDT + b_kq * 8] = pk_;                            \
    }                                                                                    \
  }
  const int aoff = (w * 32 + r) * LDT + 8 * h, boff = r * LDT + 8 * h;
#define G_FRAG(BUF, SA, SBB, KS)                                                         \
  {                                                                                      \
    fa[BUF] = *(const bf16x8*)(SA + aoff + (KS) * 16);                                   \
    fb[BUF][0] = *(const bf16x8*)(SBB + boff + (KS) * 16);                               \
    fb[BUF][1] = *(const bf16x8*)(SBB + boff + 32 * LDT + (KS) * 16);                    \
    fb[BUF][2] = *(const bf16x8*)(SBB + boff + 64 * LDT + (KS) * 16);                    \
    fb[BUF][3] = *(const bf16x8*)(SBB + boff + 96 * LDT + (KS) * 16);                    \
  }
#define G_MFMA(BUF)                                                                      \
  {                                                                                      \
    acc[0] = MFMA(fa[BUF], fb[BUF][0], acc[0]);                                          \
    acc[1] = MFMA(fa[BUF], fb[BUF][1], acc[1]);                                          \
    acc[2] = MFMA(fa[BUF], fb[BUF][2], acc[2]);                                          \
    acc[3] = MFMA(fa[BUF], fb[BUF][3], acc[3]);                                          \
  }
#define SB() __builtin_amdgcn_sched_barrier(0)
#define G_COMPUTE(SA, SBB)                                                               \
  {                                                                                      \
    bf16x8 fa[2], fb[2][4];                                                              \
    G_FRAG(0, SA, SBB, 0);                                                               \
    G_FRAG(1, SA, SBB, 1);                                                               \
    SB();                                                                                \
    G_MFMA(0);                                                                           \
    SB();                                                                                \
    G_FRAG(0, SA, SBB, 2);                                                               \
    SB();                                                                                \
    G_MFMA(1);                                                                           \
    SB();                                                                                \
    G_FRAG(1, SA, SBB, 3);                                                               \
    SB();                                                                                \
    G_MFMA(0);                                                                           \
    SB();                                                                                \
    G_MFMA(1);                                                                           \
    SB();                                                                                \
  }

  G_LOAD(0);
  __syncthreads();
#pragma unroll 1
  for (int s = s0; s < s_end; s += s_step) {
    f32x16 acc[4];
#pragma unroll
    for (int a = 0; a < 4; ++a)
#pragma unroll
      for (int i = 0; i < 16; ++i) acc[a][i] = 0.f;
    const int sn = s + s_step;
    const bool has_next = sn < s_end;
    const u16 *n0 = apb0, *n1 = apb1, *n2 = apb2, *n3 = apb3;
    const float* nbp = bp;
    if (has_next) setup(sn, a_r0, a_c, b_n4, b_kq, n0, n1, n2, n3, nbp);
#pragma unroll 1
    for (int kt = 0; kt < 16; kt += 2) {
      G_STAGE(sA0, sB0);
      __syncthreads();
      G_LOAD(kt + 1);
      G_COMPUTE(sA0, sB0);
      G_STAGE(sA1, sB1);
      __syncthreads();
      {
        int kn = kt + 2;
        if (kt == 14) { apb0 = n0; apb1 = n1; apb2 = n2; apb3 = n3; bp = nbp; kn = 0; }
        G_LOAD(kn);
      }
      G_COMPUTE(sA1, sB1);
    }
    epi(s, acc, w, r, h);
  }
  __syncthreads();
#undef G_LOAD
#undef G_STAGE
#undef G_COMPUTE
#undef G_FRAG
#undef G_MFMA
}
#undef SB

template <bool CONTIG, class Setup, class Epi>
DI void gemm_phase(char* smem, int s0, int s_end, int s_step, Setup setup, int ldb, Epi epi) {
  asm volatile("" : "+s"(s_end));
  if (s0 >= s_end) return;
  constexpr int LDK = 40;
  u16* sA0 = (u16*)smem;
  u16* sB0 = sA0 + 256 * LDK;
  u16* sA1 = sB0 + 128 * LDK;
  u16* sB1 = sA1 + 256 * LDK;
  const int tid = otid(), lane = tid & 63, w = tid >> 6, r = lane & 31, h = lane >> 5;
  const int a_r0 = tid >> 2, a_c = (tid & 3) * 8;
  const int b_n4 = tid & 31, b_kq = tid >> 5;
  const u16 *apb0, *apb1, *apb2, *apb3;
  const float* bp;
  setup(s0, a_r0, a_c, b_n4, b_kq, apb0, apb1, apb2, apb3, bp);

  u32x4 pa0, pa1, pa2, pa3;
  f32x4 pb[4];

#define G_LOAD(KT)                                                                       \
  {                                                                                      \
    const int k0_ = (KT) * 32;                                                           \
    pa0 = *(const u32x4*)(apb0 + k0_);                                                   \
    pa1 = *(const u32x4*)((CONTIG ? apb0 + 64 * DM : apb1) + k0_);                       \
    pa2 = *(const u32x4*)((CONTIG ? apb0 + 128 * DM : apb2) + k0_);                      \
    pa3 = *(const u32x4*)((CONTIG ? apb0 + 192 * DM : apb3) + k0_);                      \
    _Pragma("unroll") for (int i_ = 0; i_ < 4; ++i_) pb[i_] = *(const f32x4*)(bp + (size_t)(k0_ + i_) * ldb); \
  }
#define G_STAGE(SA, SBB)                                                                 \
  {                                                                                      \
    *(u32x4*)&SA[(a_r0)*LDK + a_c] = pa0;                                                \
    *(u32x4*)&SA[(a_r0 + 64) * LDK + a_c] = pa1;                                         \
    *(u32x4*)&SA[(a_r0 + 128) * LDK + a_c] = pa2;                                        \
    *(u32x4*)&SA[(a_r0 + 192) * LDK + a_c] = pa3;                                        \
    _Pragma("unroll") for (int j_ = 0; j_ < 4; ++j_) {                                   \
      uint2 pk_;                                                                         \
      pk_.x = pack2(pb[0][j_], pb[1][j_]);                                               \
      pk_.y = pack2(pb[2][j_], pb[3][j_]);                                               \
      *(uint2*)&SBB[(j_ * 32 + b_n4) * LDK + b_kq * 4] = pk_;                            \
    }                                                                                    \
  }
  const int aoff = (w * 64 + r) * LDK + 8 * h, boff = r * LDK + 8 * h;
#define G_FRAG(FA, FB, SA, SBB, KS)                                                      \
  {                                                                                      \
    FA[0] = *(const bf16x8*)(SA + aoff + (KS) * 16);                                     \
    FA[1] = *(const bf16x8*)(SA + aoff + 32 * LDK + (KS) * 16);                          \
    FB[0] = *(const bf16x8*)(SBB + boff + (KS) * 16);                                    \
    FB[1] = *(const bf16x8*)(SBB + boff + 32 * LDK + (KS) * 16);                         \
    FB[2] = *(const bf16x8*)(SBB + boff + 64 * LDK + (KS) * 16);                         \
    FB[3] = *(const bf16x8*)(SBB + boff + 96 * LDK + (KS) * 16);                         \
  }
#define G_MFMA(FA, FB)                                                                   \
  {                                                                                      \
    _Pragma("unroll") for (int mt_ = 0; mt_ < 2; ++mt_)                                  \
    _Pragma("unroll") for (int nt_ = 0; nt_ < 4; ++nt_) acc[mt_][nt_] = MFMA(FA[mt_], FB[nt_], acc[mt_][nt_]); \
  }
#define SB() __builtin_amdgcn_sched_barrier(0)
#define G_COMPUTE(SA, SBB)                                                               \
  {                                                                                      \
    bf16x8 fa0[2], fb0[4];                                                               \
    G_FRAG(fa0, fb0, SA, SBB, 0);                                                        \
    SB();                                                                                \
    G_MFMA(fa0, fb0);                                                                    \
    SB();                                                                                \
    G_FRAG(fa0, fb0, SA, SBB, 1);                                                        \
    SB();                                                                                \
    G_MFMA(fa0, fb0);                                                                    \
    SB();                                                                                \
  }

  G_LOAD(0);
  __syncthreads();
#pragma unroll 1
  for (int s = s0; s < s_end; s += s_step) {
    f32x16 acc[2][4];
#pragma unroll
    for (int a = 0; a < 2; ++a)
#pragma unroll
      for (int b = 0; b < 4; ++b)
#pragma unroll
        for (int i = 0; i < 16; ++i) acc[a][b][i] = 0.f;
    const int sn = s + s_step;
    const bool has_next = sn < s_end;
    const u16 *n0 = apb0, *n1 = apb1, *n2 = apb2, *n3 = apb3;
    const float* nbp = bp;
    if (has_next) setup(sn, a_r0, a_c, b_n4, b_kq, n0, n1, n2, n3, nbp);
#pragma unroll 1
    for (int kt = 0; kt < 32; kt += 2) {
      G_STAGE(sA0, sB0);
      __syncthreads();
      G_LOAD(kt + 1);
      G_COMPUTE(sA0, sB0);
      G_STAGE(sA1, sB1);
      __syncthreads();
      {
        int kn = kt + 2;
        if (kt == 30) { apb0 = n0; apb1 = n1; apb2 = n2; apb3 = n3; bp = nbp; kn = 0; }
        G_LOAD(kn);
      }
      G_COMPUTE(sA1, sB1);
    }
    epi(s, acc, w, r, h);
  }
  __syncthreads();
#undef G_LOAD
#undef G_STAGE
#undef G_COMPUTE
#undef G_FRAG
#undef G_MFMA
}

DI void load4x4(const void* base, int stride, bool isf32, int rq, int c4, float v[4][4]) {
  if (isf32) {
#pragma unroll
    for (int i = 0; i < 4; ++i) {
      const float4 x = *(const float4*)((const float*)base + (size_t)(4 * rq + i) * stride + 4 * c4);
      v[i][0] = x.x; v[i][1] = x.y; v[i][2] = x.z; v[i][3] = x.w;
    }
  } else {
#pragma unroll
    for (int i = 0; i < 4; ++i) {
      const uint2 x = *(const uint2*)((const u16*)base + (size_t)(4 * rq + i) * stride + 4 * c4);
      v[i][0] = bflo(x.x); v[i][1] = bfhi(x.x); v[i][2] = bflo(x.y); v[i][3] = bfhi(x.y);
    }
  }
}
DI void store_n(u16* dst, int ld, int row0, int rq, int c4, const float v[4][4]) {
#pragma unroll
  for (int i = 0; i < 4; ++i) {
    uint2 pk = {pack2(v[i][0], v[i][1]), pack2(v[i][2], v[i][3])};
    *(uint2*)&dst[(row0 + 4 * rq + i) * ld + 4 * c4] = pk;
  }
}
DI void store_t(u16* dst, int ld, int col0, int rq, int c4, const float v[4][4], const float s[4]) {
#pragma unroll
  for (int j = 0; j < 4; ++j) {
    uint2 pk = {pack2(v[0][j] * s[0], v[1][j] * s[1]), pack2(v[2][j] * s[2], v[3][j] * s[3])};
    *(uint2*)&dst[(4 * c4 + j) * ld + col0 + 4 * rq] = pk;
  }
}

DI void attn_load(const u16* kp, const u16* vp, int stride, int rq, int c4, uint2 (&k)[4], uint2 (&v)[4]) {
#pragma unroll
  for (int i = 0; i < 4; ++i) {
    k[i] = *(const uint2*)(kp + (size_t)(4 * rq + i) * stride + 4 * c4);
    v[i] = *(const uint2*)(vp + (size_t)(4 * rq + i) * stride + 4 * c4);
  }
}
DI void attn_stage(u16* sK, u16* sVT, int rq, int c4, const uint2 (&k)[4], const uint2 (&v)[4]) {
#pragma unroll
  for (int i = 0; i < 4; ++i) *(uint2*)&sK[(4 * rq + i) * LDT + 4 * c4] = k[i];
  uint2 t0, t1, t2, t3;
  t0.x = (v[0].x & 0xffffu) | (v[1].x << 16);          t0.y = (v[2].x & 0xffffu) | (v[3].x << 16);
  t1.x = (v[0].x >> 16) | (v[1].x & 0xffff0000u);      t1.y = (v[2].x >> 16) | (v[3].x & 0xffff0000u);
  t2.x = (v[0].y & 0xffffu) | (v[1].y << 16);          t2.y = (v[2].y & 0xffffu) | (v[3].y << 16);
  t3.x = (v[0].y >> 16) | (v[1].y & 0xffff0000u);      t3.y = (v[2].y >> 16) | (v[3].y & 0xffff0000u);
  const int qs = 4 * (rq ^ ((c4 >> 1) & 7));
  *(uint2*)&sVT[(4 * c4 + 0) * LDT + qs] = t0;
  *(uint2*)&sVT[(4 * c4 + 1) * LDT + qs] = t1;
  *(uint2*)&sVT[(4 * c4 + 2) * LDT + qs] = t2;
  *(uint2*)&sVT[(4 * c4 + 3) * LDT + qs] = t3;
}

template <class TileSrc, class BiasF, class TMode>
DI void attn_core(char* smem, const u16* qbase, int ntiles, TileSrc src, BiasF biasf, TMode tmode, float m_init, bool has_sink, u16* obase) {
  u16* sK = (u16*)smem;
  u16* sVT = sK + 64 * LDT;
  const int tid = otid(), lane = tid & 63, w = tid >> 6, r = lane & 31, h = lane >> 5;
  const int rq = tid >> 4, c4 = tid & 15;
  const int ql = w * 32 + r;
  bf16x8 qf[4];
#pragma unroll
  for (int ks = 0; ks < 4; ++ks) qf[ks] = *(const bf16x8*)(qbase + (size_t)ql * DIN + ks * 16 + 8 * h);
  f32x16 O[2];
#pragma unroll
  for (int d = 0; d < 2; ++d)
#pragma unroll
    for (int i = 0; i < 16; ++i) O[d][i] = 0.f;
  float m = m_init, lsum = (has_sink && h == 0) ? 1.f : 0.f;

  auto nextv = [&](int j, const u16*& kp, const u16*& vp, int& stride) -> int {
    while (j < ntiles && !src(j, kp, vp, stride)) ++j;
    return j;
  };
  auto compute = [&](int jc) {
    const int mode = tmode(jc, w);
    if (mode != 2) {
      f32x16 S[2];
#pragma unroll
      for (int mt = 0; mt < 2; ++mt)
#pragma unroll
        for (int i = 0; i < 16; ++i) S[mt][i] = 0.f;
#pragma unroll
      for (int ks = 0; ks < 4; ++ks)
#pragma unroll
        for (int mt = 0; mt < 2; ++mt) {
          const bf16x8 kf = *(const bf16x8*)&sK[(mt * 32 + r) * LDT + ks * 16 + 8 * h];
          S[mt] = MFMA(kf, qf[ks], S[mt]);
        }
      const float C2 = 0.125f * 1.44269504f;
      float mx = NEG;
      if (mode == 1) {
#pragma unroll
        for (int mt = 0; mt < 2; ++mt)
#pragma unroll
          for (int i = 0; i < 16; ++i) {
            const float s = S[mt][i] * C2 + biasf(jc, mt * 32 + crow(i, h), ql);
            S[mt][i] = s;
            mx = fmaxf(mx, s);
          }
      } else {
#pragma unroll
        for (int mt = 0; mt < 2; ++mt)
#pragma unroll
          for (int i = 0; i < 16; ++i) {
            const float s = S[mt][i] * C2;
            S[mt][i] = s;
            mx = fmaxf(mx, s);
          }
      }
      mx = fmaxf(mx, __shfl_xor(mx, 32));
      const float mn = fmaxf(m, mx);
      if (__any(mn > m)) {
        const float alpha = __builtin_amdgcn_exp2f(m - mn);
        m = mn;
        lsum *= alpha;
#pragma unroll
        for (int d = 0; d < 2; ++d)
#pragma unroll
          for (int i = 0; i < 16; ++i) O[d][i] *= alpha;
      }
      float ps = 0.f;
#pragma unroll
      for (int mt = 0; mt < 2; ++mt)
#pragma unroll
        for (int i = 0; i < 16; ++i) {
          const float pv = __builtin_amdgcn_exp2f(S[mt][i] - m);
          S[mt][i] = pv;
          ps += pv;
        }
      lsum += ps;
#pragma unroll
      for (int mt = 0; mt < 2; ++mt)
#pragma unroll
        for (int s = 0; s < 2; ++s) {
          const bf16x8 pf = mk8(pack2(S[mt][8 * s + 0], S[mt][8 * s + 1]), pack2(S[mt][8 * s + 2], S[mt][8 * s + 3]),
                                pack2(S[mt][8 * s + 4], S[mt][8 * s + 5]), pack2(S[mt][8 * s + 6], S[mt][8 * s + 7]));
#pragma unroll
          for (int d = 0; d < 2; ++d) {
            const int sw = (d * 4 + (r >> 3)) & 7, q = mt * 8 + 4 * s + h;
            const u16* vrow = &sVT[(d * 32 + r) * LDT];
            const uint2 lo = *(const uint2*)(vrow + 4 * (q ^ sw));
            const uint2 hi = *(const uint2*)(vrow + 4 * ((q + 2) ^ sw));
            O[d] = MFMA(mk8(lo.x, lo.y, hi.x, hi.y), pf, O[d]);
          }
        }
    }
  };

  uint2 kA[4], vA[4], kB[4], vB[4];
#pragma unroll
  for (int i = 0; i < 4; ++i) { kA[i] = make_uint2(0u, 0u); vA[i] = kA[i]; kB[i] = kA[i]; vB[i] = kA[i]; }
  const u16 *kp = nullptr, *vp = nullptr;
  int stride = 0;
  int jA = nextv(0, kp, vp, stride);
  if (jA < ntiles) attn_load(kp, vp, stride, rq, c4, kA, vA);
  int jB = nextv(jA + 1, kp, vp, stride);
  if (jB < ntiles) attn_load(kp, vp, stride, rq, c4, kB, vB);
#pragma unroll 1
  for (;;) {
    if (jA >= ntiles) break;
    __syncthreads();
    attn_stage(sK, sVT, rq, c4, kA, vA);
    __syncthreads();
    {
      const int jc = jA;
      jA = nextv(jB + 1, kp, vp, stride);
      if (jA < ntiles) attn_load(kp, vp, stride, rq, c4, kA, vA);
      compute(jc);
    }
    if (jB >= ntiles) break;
    __syncthreads();
    attn_stage(sK, sVT, rq, c4, kB, vB);
    __syncthreads();
    {
      const int jc = jB;
      jB = nextv(jA + 1, kp, vp, stride);
      if (jB < ntiles) attn_load(kp, vp, stride, rq, c4, kB, vB);
      compute(jc);
    }
  }
  const float l = lsum + __shfl_xor(lsum, 32);
  const float inv = 1.f / l;
#pragma unroll
  for (int d = 0; d < 2; ++d)
#pragma unroll
    for (int g = 0; g < 4; ++g) {
      uint2 pk = {pack2(O[d][4 * g + 0] * inv, O[d][4 * g + 1] * inv), pack2(O[d][4 * g + 2] * inv, O[d][4 * g + 3] * inv)};
      *(uint2*)(obase + (size_t)ql * DM + d * 32 + 8 * g + 4 * h) = pk;
    }
}

DI void phase0(const Params& p, char* smem) {
  const int tid = otid();
  if (blockIdx.x == 0) {
    for (int idx = tid; idx < 1024; idx += 256) {
      const int pos = idx >> 4, j = idx & 15;
      const double inv = 1.0 / pow(10000.0, (double)j / 16.0);
      const float ang = (float)((double)pos * inv);
      p.ROPE[idx] = cosf(ang);
      p.ROPE[1024 + idx] = sinf(ang);
    }
  }
  float* scond = (float*)smem;
  for (int item = blockIdx.x; item < 768; item += gridDim.x) {
    const int l = item / 384, ks = (item / 24) % 16, jb = item % 24;
    __syncthreads();
    for (int idx = tid; idx < 320; idx += 256) {
      const int c = idx / 64, k = ks * 64 + (idx & 63);
      const float v = (c == 0) ? p.c_ctx[k] : p.c[(c - 1) * DM + k];
      scond[idx] = silu(v);
    }
    __syncthreads();
    const int j = jb * 256 + tid;
    const float* wp = p.w_ada + ((size_t)l * DM + ks * 64) * 6144 + j;
    float a[5] = {0.f, 0.f, 0.f, 0.f, 0.f};
#pragma unroll 8
    for (int k = 0; k < 64; ++k) {
      const float wv = wp[(size_t)k * 6144];
#pragma unroll
      for (int c = 0; c < 5; ++c) a[c] += scond[c * 64 + k] * wv;
    }
    const float bias = (ks == 0) ? p.b_ada[l * 6144 + j] : 0.f;
#pragma unroll
    for (int c = 0; c < 5; ++c) unsafeAtomicAdd(&p.MOD[(l * 5 + c) * 6144 + j], a[c] + bias);
  }
}

DI int cond_of(int T) { return T < NCTX ? 0 : 1 + ((T - NCTX) >> 11); }

DI void cvt_f32_bf16(const float* s, u16* d, int n4, int gtid, int gsz) {
  for (int i = gtid; i < n4; i += gsz) {
    const float4 x = *(const float4*)(s + (size_t)i * 4);
    uint2 pk = {pack2(x.x, x.y), pack2(x.z, x.w)};
    *(uint2*)(d + (size_t)i * 4) = pk;
  }
}
DI void phase0b(const Params& p) {
  const int tid = otid(), lane = tid & 63, w = tid >> 6;
  {
    const int gtid = blockIdx.x * 256 + tid, gsz = gridDim.x * 256;
    cvt_f32_bf16(p.cak, p.CAK, 4 * 2 * 512 * 128 / 4, gtid, gsz);
    cvt_f32_bf16(p.cav, p.CAV, 4 * 2 * 512 * 128 / 4, gtid, gsz);
    cvt_f32_bf16(p.cbk, p.CBK, 4 * 2 * 512 * 256 / 4, gtid, gsz);
    cvt_f32_bf16(p.cbv, p.CBV, 4 * 2 * 512 * 256 / 4, gtid, gsz);
  }
  for (int T = blockIdx.x * 4 + w; T < NTOK; T += gridDim.x * 4) {
    const float* mod = p.MOD + (size_t)cond_of(T) * 6144;
    const float* xr = (T < NCTX) ? (p.x_prompt + (size_t)T * DM) : (p.x_sample + (size_t)(T - NCTX) * DM);
#pragma unroll
    for (int i = 0; i < 4; ++i) {
      const int k = 256 * i + 4 * lane;
      const float4 x = *(const float4*)(xr + k);
      const float4 sc = *(const float4*)(mod + 1024 + k), sh = *(const float4*)(mod + k);
      uint2 pk = {pack2(x.x * (1.f + sc.x) + sh.x, x.y * (1.f + sc.y) + sh.y), pack2(x.z * (1.f + sc.z) + sh.z, x.w * (1.f + sc.w) + sh.w)};
      *(uint2*)(p.H2 + (size_t)T * DM + k) = pk;
    }
  }
}

DI void phase1(const Params& p, char* smem, int l) {
  const float* W = p.w_in + (size_t)l * DM * DIN;
  const int xcd = blockIdx.x & 7, nloc = gridDim.x >> 3;
  auto setup = [&](int s, int ar0, int ac, int n4, int kq, const u16*& q0, const u16*& q1, const u16*& q2, const u16*& q3, const float*& bp) {
    const int tm = 6 * xcd + s % 6, tn = s / 6;
    const u16* ab = p.H2 + ((size_t)tm * 256 + ar0) * DM + ac;
    q0 = ab; q1 = ab + 64 * DM; q2 = ab + 128 * DM; q3 = ab + 192 * DM;
    bp = W + tn * 128 + 4 * n4 + (size_t)(kq * 4) * DIN;
  };
  auto epi = [&](int s, f32x16(&acc)[2][4], int w, int r, int h) {
    int hq = h;
    asm volatile("" : "+v"(hq));
    const int tm = 6 * xcd + s % 6, tn = s / 6;
    const int m0 = tm * 256, n0 = tn * 128;
    const bool lat = m0 >= NCTX;
    const bool rope = lat && (n0 < 640);
    const int n = n0 + 4 * r;
    const int q = (r >> 2) & 3;
#pragma unroll
    for (int mt = 0; mt < 2; ++mt)
#pragma unroll
    for (int i = 0; i < 16; ++i) {
      const int T = m0 + w * 64 + mt * 32 + crow(i, hq);
      float v0 = acc[mt][0][i], v1 = acc[mt][1][i], v2 = acc[mt][2][i], v3 = acc[mt][3][i];
      if (rope) {
        const int t = (T - NCTX) & 2047;
        const int pos = (q < 2) ? (t >> 6) : (t & 63);
        const int jf = 4 * (r & 3);
        const float4 cs = *(const float4*)(p.ROPE + pos * 16 + jf), sn = *(const float4*)(p.ROPE + 1024 + pos * 16 + jf);
        const float o0 = __shfl_xor(v0, 4), o1 = __shfl_xor(v1, 4), o2 = __shfl_xor(v2, 4), o3 = __shfl_xor(v3, 4);
        if (q & 1) { v0 = o0 * sn.x + v0 * cs.x; v1 = o1 * sn.y + v1 * cs.y; v2 = o2 * sn.z + v2 * cs.z; v3 = o3 * sn.w + v3 * cs.w; }
        else { v0 = v0 * cs.x - o0 * sn.x; v1 = v1 * cs.y - o1 * sn.y; v2 = v2 * cs.z - o2 * sn.z; v3 = v3 * cs.w - o3 * sn.w; }
      }
      uint2 pk = {pack2(v0, v1), pack2(v2, v3)};
      *(uint2*)(p.QKV + (size_t)T * DIN + n) = pk;
      if (!lat) {
        const int b = T >> 8, t = T & 255;
        const float4 vv = {v0, v1, v2, v3};
        if (n0 == 512) *(float4*)(p.out + OFF_AK + ((size_t)(b * 2 + l) * 256 + t) * 128 + (n - 512)) = vv;
        else if (n0 == 640) *(float4*)(p.out + OFF_AV + ((size_t)(b * 2 + l) * 256 + t) * 128 + (n - 640)) = vv;
        else if (n0 == 1024 || n0 == 1152) *(float4*)(p.out + OFF_BK + ((size_t)(b * 2 + l) * 256 + t) * 256 + (n - 1024)) = vv;
        else if (n0 == 1280 || n0 == 1408) *(float4*)(p.out + OFF_BV + ((size_t)(b * 2 + l) * 256 + t) * 256 + (n - 1280)) = vv;
      }
      if ((i & 3) == 3) __builtin_amdgcn_sched_barrier(0);
    }
  };
  gemm_phase<true>(smem, blockIdx.x >> 3, 120, nloc, setup, DIN, epi);
}

DI float ret_lg(const Params& p, int l, int dir, int head) { return -__expf(p.decay[(l * 2 + dir) * 4 + head]); }

DI size_t kvs_slot(int req, int head, int dir, int c) { return ((size_t)((req * 4 + head) * 2 + dir) * 16 + c) * 4096; }

DI void retkv_item(const Params& p, char* smem, int l, int req, int head, int c) {
  u16* sKTf = (u16*)smem;
  u16* sKTb = sKTf + 64 * LDT2;
  u16* sVT = sKTb + 64 * LDT2;
  const int tid = otid(), lane = tid & 63, w = tid >> 6, r = lane & 31, h = lane >> 5;
  const int rq = tid >> 4, c4 = tid & 15;
  const int T0 = (req < 16 ? req * 256 : NCTX + (req - 16) * 2048) + c * 128;
  const float lgf = ret_lg(p, l, 0, head), lgb = ret_lg(p, l, 1, head);
  const float one4[4] = {1.f, 1.f, 1.f, 1.f};
  __syncthreads();
#pragma unroll
  for (int half = 0; half < 2; ++half) {
    float v[4][4];
    float sf[4], sb[4];
#pragma unroll
    for (int i = 0; i < 4; ++i) {
      const int j = half * 64 + 4 * rq + i;
      sf[i] = 0.125f * __expf(lgf * (float)(127 - j));
      sb[i] = 0.125f * __expf(lgb * (float)j);
    }
    load4x4(p.QKV + (size_t)(T0 + half * 64) * DIN + 1792 + head * 64, DIN, false, rq, c4, v);
    store_t(sKTf, LDT2, half * 64, rq, c4, v, sf);
    store_t(sKTb, LDT2, half * 64, rq, c4, v, sb);
    load4x4(p.QKV + (size_t)(T0 + half * 64) * DIN + 2048 + head * 64, DIN, false, rq, c4, v);
    store_t(sVT, LDT2, half * 64, rq, c4, v, one4);
  }
  __syncthreads();
  const int dir = w >> 1, mt = w & 1;
  const u16* sKT = dir ? sKTb : sKTf;
  f32x16 acc[2];
#pragma unroll
  for (int nt = 0; nt < 2; ++nt)
#pragma unroll
    for (int i = 0; i < 16; ++i) acc[nt][i] = 0.f;
#pragma unroll
  for (int ks = 0; ks < 8; ++ks) {
    const bf16x8 fa = *(const bf16x8*)&sKT[(mt * 32 + r) * LDT2 + ks * 16 + 8 * h];
#pragma unroll
    for (int nt = 0; nt < 2; ++nt) {
      const bf16x8 fb = *(const bf16x8*)&sVT[(nt * 32 + r) * LDT2 + ks * 16 + 8 * h];
      acc[nt] = MFMA(fa, fb, acc[nt]);
    }
  }
  float* dst = p.KVS + kvs_slot(req, head, dir, c);
#pragma unroll
  for (int nt = 0; nt < 2; ++nt)
#pragma unroll
    for (int i = 0; i < 16; ++i) dst[(mt * 32 + crow(i, h)) * 64 + nt * 32 + r] = acc[nt][i];
}

DI void phase2(const Params& p, char* smem, int l) {
  const int tid = otid();
  for (int item = blockIdx.x; item < 1536; item += gridDim.x) {
    if (item < 512) {
      const int b = item >> 7, head = (item >> 4) & 7, qb = item & 15, kvh = head >> 2;
      const int T0 = NCTX + b * 2048 + qb * 128;
      const u16* ck = p.CAK + ((size_t)(b * 2 + l) * 512) * 128 + kvh * 64;
      const u16* cv = p.CAV + ((size_t)(b * 2 + l) * 512) * 128 + kvh * 64;
      auto src = [&](int j, const u16*& kp, const u16*& vp, int& stride) -> bool {
        if (j < 8) {
          kp = ck + (size_t)j * 64 * 128; vp = cv + (size_t)j * 64 * 128; stride = 128;
          return true;
        }
        const int jj = j - 8, kb = qb - 1 + (jj >> 1);
        if (kb < 0 || kb >= 16) return false;
        const int Tk = NCTX + b * 2048 + kb * 128 + (jj & 1) * 64;
        kp = p.QKV + (size_t)Tk * DIN + 512 + kvh * 64; vp = p.QKV + (size_t)Tk * DIN + 640 + kvh * 64; stride = DIN;
        return true;
      };
      auto biasf = [&](int j, int key, int ql) -> float {
        if (j < 8) return 0.f;
        const int jj = j - 8;
        const int kj = (qb - 1 + (jj >> 1)) * 128 + (jj & 1) * 64 + key;
        const int qi = qb * 128 + ql;
        const int d = qi - kj;
        return (d <= 128 && d >= -128) ? 0.f : NEG;
      };
      auto tmode = [&](int j, int w) -> int {
        if (j < 8) return 0;
        const int jj = j - 8;
        const int k0 = (qb - 1 + (jj >> 1)) * 128 + (jj & 1) * 64, q0w = qb * 128 + w * 32;
        if (k0 - (q0w + 31) > 128 || q0w - (k0 + 63) > 128) return 2;
        if ((q0w + 31) - k0 <= 128 && (k0 + 63) - q0w <= 128) return 0;
        return 1;
      };
      attn_core(smem, p.QKV + (size_t)T0 * DIN + head * 64, 14, src, biasf, tmode, p.sink[l * 8 + head] * 1.44269504f, true,
                p.CAT + (size_t)T0 * DM + head * 64);
    } else if (item < 768) {
      const int it = item - 512;
      const int b = it >> 6, head = (it >> 4) & 3, qb = it & 15;
      const int T0 = NCTX + b * 2048 + qb * 128;
      float* srpb = (float*)(smem + 2 * 64 * LDT * 2);
      __syncthreads();
      for (int idx = tid; idx < 465; idx += 256) srpb[idx] = p.rpb[(size_t)(l * 4 + head) * 465 + idx] * 1.44269504f;
      const int r0 = 2 * qb;
      const int rmin = min(max(r0 - 4, 0), 24), rmax = min(max(r0 + 1 - 4, 0), 24) + 7;
      const u16* ck = p.CBK + ((size_t)(b * 2 + l) * 512) * 256 + head * 64;
      const u16* cv = p.CBV + ((size_t)(b * 2 + l) * 512) * 256 + head * 64;
      auto src = [&](int j, const u16*& kp, const u16*& vp, int& stride) -> bool {
        if (j < 8) {
          kp = ck + (size_t)j * 64 * 256; vp = cv + (size_t)j * 64 * 256; stride = 256;
          return true;
        }
        const int Tk = NCTX + b * 2048 + (rmin + j - 8) * 64;
        kp = p.QKV + (size_t)Tk * DIN + 1024 + head * 64; vp = p.QKV + (size_t)Tk * DIN + 1280 + head * 64; stride = DIN;
        return true;
      };
      auto biasf = [&](int j, int key, int ql) -> float {
        if (j < 8) return 0.f;
        const int kr = rmin + j - 8, kc = key;
        const int qr = r0 + (ql >> 6), qc = ql & 63;
        const int rs = min(max(qr - 4, 0), 24), cs = min(max(qc - 8, 0), 48);
        const bool ok = (kr >= rs) && (kr < rs + 8) && (kc >= cs) && (kc < cs + 16);
        const int bi = ok ? ((kr - qr + 7) * 31 + (kc - qc + 15)) : 0;
        const float bv = srpb[bi];
        return ok ? bv : NEG;
      };
      auto tmode = [&](int j, int w) -> int {
        if (j < 8) return 0;
        const int kr = rmin + j - 8, qr = r0 + (w >> 1);
        const int rs = min(max(qr - 4, 0), 24);
        return (kr >= rs && kr < rs + 8) ? 1 : 2;
      };
      attn_core(smem, p.QKV + (size_t)T0 * DIN + 768 + head * 64, 8 + (rmax - rmin + 1), src, biasf, tmode, NEG, false,
                p.CAT + (size_t)T0 * DM + 512 + head * 64);
    } else if (item < 1152) {
      const int it = item - 768;
      if (it < 256) retkv_item(p, smem, l, 16 + (it >> 6), (it >> 4) & 3, it & 15);
      else { const int i2 = it - 256; retkv_item(p, smem, l, i2 >> 3, (i2 >> 1) & 3, i2 & 1); }
    } else if (item < 1408) {
      const int it = item - 1152;
      const int b = it >> 4, head = (it >> 1) & 7, qh = it & 1, kvh = head >> 2;
      const int T0 = b * 256 + qh * 128;
      auto src = [&](int j, const u16*& kp, const u16*& vp, int& stride) -> bool {
        const int Tk = b * 256 + j * 64;
        kp = p.QKV + (size_t)Tk * DIN + 512 + kvh * 64; vp = p.QKV + (size_t)Tk * DIN + 640 + kvh * 64; stride = DIN;
        return true;
      };
      auto biasf = [&](int, int, int) -> float { return 0.f; };
      auto tmode = [&](int, int) -> int { return 0; };
      attn_core(smem, p.QKV + (size_t)T0 * DIN + head * 64, 4, src, biasf, tmode, p.sink[l * 8 + head] * 1.44269504f, true,
                p.CAT + (size_t)T0 * DM + head * 64);
    } else {
      const int it = item - 1408;
      const int b = it >> 3, head = (it >> 1) & 3, qh = it & 1;
      const int T0 = b * 256 + qh * 128;
      auto src = [&](int j, const u16*& kp, const u16*& vp, int& stride) -> bool {
        const int Tk = b * 256 + j * 64;
        kp = p.QKV + (size_t)Tk * DIN + 1024 + head * 64; vp = p.QKV + (size_t)Tk * DIN + 1280 + head * 64; stride = DIN;
        return true;
      };
      auto biasf = [&](int, int, int) -> float { return 0.f; };
      auto tmode = [&](int, int) -> int { return 0; };
      attn_core(smem, p.QKV + (size_t)T0 * DIN + 768 + head * 64, 4, src, biasf, tmode, NEG, false,
                p.CAT + (size_t)T0 * DM + 512 + head * 64);
    }
  }
}

DI void phase2c(const Params& p, char* smem, int l) {
  u16* sK = (u16*)smem;
  u16* sVT = sK + 128 * LDT;
  u16* sSTf = sVT + 64 * LDT2;
  u16* sSTb = sSTf + 64 * LDT;
  const int tid = otid(), lane = tid & 63, w = tid >> 6, r = lane & 31, h = lane >> 5;
  const int rq = tid >> 4, c4 = tid & 15;
  const float one4[4] = {1.f, 1.f, 1.f, 1.f};
  for (int item = blockIdx.x; item < 384; item += gridDim.x) {
    int req, head, c, nc;
    if (item < 256) { req = 16 + (item >> 6); head = (item >> 4) & 3; c = item & 15; nc = 16; }
    else { const int i2 = item - 256; req = i2 >> 3; head = (i2 >> 1) & 3; c = i2 & 1; nc = 2; }
    const bool lat = req >= 16;
    const int T0 = (lat ? NCTX + (req - 16) * 2048 : req * 256) + c * 128;
    const float lgf = ret_lg(p, l, 0, head), lgb = ret_lg(p, l, 1, head);
    const float gf = __expf(lgf * 128.f), gb = __expf(lgb * 128.f);
    __syncthreads();
    {
      const int d = tid >> 2, e0 = (tid & 3) * 16;
#pragma unroll
      for (int dir = 0; dir < 2; ++dir) {
        float s[16];
#pragma unroll
        for (int q = 0; q < 16; ++q) s[q] = 0.f;
        const float g = dir ? gb : gf;
        if (lat) {
          const float* s0 = p.state + ((size_t)(((req - 16) * 2 + l) * 2 + dir) * 4 + head) * 4096 + d * 64 + e0;
#pragma unroll
          for (int q = 0; q < 16; q += 4) {
            const float4 x = *(const float4*)(s0 + q);
            s[q] = x.x; s[q + 1] = x.y; s[q + 2] = x.z; s[q + 3] = x.w;
          }
        }
        const int nsteps = dir ? (nc - 1 - c) : c;
        for (int st = 0; st < nsteps; ++st) {
          const int cc = dir ? (nc - 1 - st) : st;
          const float* kv = p.KVS + kvs_slot(req, head, dir, cc) + d * 64 + e0;
#pragma unroll
          for (int q = 0; q < 16; q += 4) {
            const float4 x = *(const float4*)(kv + q);
            s[q] = s[q] * g + x.x; s[q + 1] = s[q + 1] * g + x.y; s[q + 2] = s[q + 2] * g + x.z; s[q + 3] = s[q + 3] * g + x.w;
          }
        }
        u16* sST = dir ? sSTb : sSTf;
#pragma unroll
        for (int q = 0; q < 16; ++q) sST[(e0 + q) * LDT + d] = (u16)(pack2(s[q], 0.f) & 0xffffu);
        if (!lat && c == 0) {
          const float* k0 = p.KVS + kvs_slot(req, head, dir, 0) + d * 64 + e0;
          const float* k1 = p.KVS + kvs_slot(req, head, dir, 1) + d * 64 + e0;
          float* o = p.out + OFF_ST + ((size_t)((req * 2 + l) * 2 + dir) * 4 + head) * 4096 + d * 64 + e0;
#pragma unroll
          for (int q = 0; q < 16; ++q) o[q] = dir ? (gb * k1[q] + k0[q]) : (gf * k0[q] + k1[q]);
        }
      }
    }
#pragma unroll
    for (int half = 0; half < 2; ++half) {
      float v[4][4];
      load4x4(p.QKV + (size_t)(T0 + half * 64) * DIN + 1792 + head * 64, DIN, false, rq, c4, v);
      store_n(sK, LDT, half * 64, rq, c4, v);
      load4x4(p.QKV + (size_t)(T0 + half * 64) * DIN + 2048 + head * 64, DIN, false, rq, c4, v);
      store_t(sVT, LDT2, half * 64, rq, c4, v, one4);
    }
    __syncthreads();
    const int qi = w * 32 + r;
    const u16* qrow = p.QKV + (size_t)(T0 + qi) * DIN + 1536 + head * 64;
    uint4 qraw[4];
#pragma unroll
    for (int ks = 0; ks < 4; ++ks) qraw[ks] = *(const uint4*)(qrow + ks * 16 + 8 * h);
    f32x16 O[2];
#pragma unroll
    for (int d = 0; d < 2; ++d)
#pragma unroll
      for (int i = 0; i < 16; ++i) O[d][i] = 0.f;
#pragma unroll 1
    for (int jt = 0; jt < 4; ++jt) {
      f32x16 S;
#pragma unroll
      for (int i = 0; i < 16; ++i) S[i] = 0.f;
#pragma unroll
      for (int ks = 0; ks < 4; ++ks) {
        const bf16x8 kf = *(const bf16x8*)&sK[(jt * 32 + r) * LDT + ks * 16 + 8 * h];
        S = MFMA(kf, __builtin_bit_cast(bf16x8, qraw[ks]), S);
      }
#pragma unroll
      for (int i = 0; i < 16; ++i) {
        const int j = jt * 32 + crow(i, h);
        const int dlt = qi - j;
        const float wgt = (dlt > 0) ? __expf(lgf * (float)dlt) : ((dlt < 0) ? __expf(lgb * (float)(-dlt)) : 2.f);
        S[i] = S[i] * 0.125f * wgt;
      }
#pragma unroll
      for (int s = 0; s < 2; ++s) {
        const bf16x8 pf = mk8(pack2(S[8 * s + 0], S[8 * s + 1]), pack2(S[8 * s + 2], S[8 * s + 3]),
                              pack2(S[8 * s + 4], S[8 * s + 5]), pack2(S[8 * s + 6], S[8 * s + 7]));
#pragma unroll
        for (int d = 0; d < 2; ++d) {
          const u16* vrow = &sVT[(d * 32 + r) * LDT2 + jt * 32 + 16 * s + 4 * h];
          const uint2 lo = *(const uint2*)vrow;
          const uint2 hi = *(const uint2*)(vrow + 8);
          O[d] = MFMA(mk8(lo.x, lo.y, hi.x, hi.y), pf, O[d]);
        }
      }
    }
    {
      const float xf = __expf(lgf * (float)(qi + 1)), xb = __expf(lgb * (float)(128 - qi));
#pragma unroll
      for (int ks = 0; ks < 4; ++ks) {
        const uint4 q = qraw[ks];
        const bf16x8 qsf = mk8(pack2(bflo(q.x) * xf, bfhi(q.x) * xf), pack2(bflo(q.y) * xf, bfhi(q.y) * xf),
                               pack2(bflo(q.z) * xf, bfhi(q.z) * xf), pack2(bflo(q.w) * xf, bfhi(q.w) * xf));
        const bf16x8 qsb = mk8(pack2(bflo(q.x) * xb, bfhi(q.x) * xb), pack2(bflo(q.y) * xb, bfhi(q.y) * xb),
                               pack2(bflo(q.z) * xb, bfhi(q.z) * xb), pack2(bflo(q.w) * xb, bfhi(q.w) * xb));
#pragma unroll
        for (int d = 0; d < 2; ++d) {
          const bf16x8 sf = *(const bf16x8*)&sSTf[(d * 32 + r) * LDT + ks * 16 + 8 * h];
          const bf16x8 sb = *(const bf16x8*)&sSTb[(d * 32 + r) * LDT + ks * 16 + 8 * h];
          O[d] = MFMA(sf, qsf, O[d]);
          O[d] = MFMA(sb, qsb, O[d]);
        }
      }
    }
    float sum = 0.f;
#pragma unroll
    for (int d = 0; d < 2; ++d)
#pragma unroll
      for (int i = 0; i < 16; ++i) sum += O[d][i];
    sum += __shfl_xor(sum, 32);
    const float mu = sum * (1.f / 64.f);
    float vs = 0.f;
#pragma unroll
    for (int d = 0; d < 2; ++d)
#pragma unroll
      for (int i = 0; i < 16; ++i) { const float t = O[d][i] - mu; vs += t * t; }
    vs += __shfl_xor(vs, 32);
    const float rstd = rsqrtf(vs * (1.f / 64.f) + 1e-6f);
    const u16* grow = p.QKV + (size_t)(T0 + qi) * DIN + 2304 + head * 64;
    const float* gnw = p.gn + l * 256 + head * 64;
    u16* orow = p.CAT + (size_t)(T0 + qi) * DM + 768 + head * 64;
#pragma unroll
    for (int d = 0; d < 2; ++d)
#pragma unroll
      for (int g = 0; g < 4; ++g) {
        const int e = d * 32 + 8 * g + 4 * h;
        const uint2 gr = *(const uint2*)(grow + e);
        const float4 gw = *(const float4*)(gnw + e);
        const float o0 = silu(bflo(gr.x)) * (O[d][4 * g + 0] - mu) * rstd * gw.x;
        const float o1 = silu(bfhi(gr.x)) * (O[d][4 * g + 1] - mu) * rstd * gw.y;
        const float o2 = silu(bflo(gr.y)) * (O[d][4 * g + 2] - mu) * rstd * gw.z;
        const float o3 = silu(bfhi(gr.y)) * (O[d][4 * g + 3] - mu) * rstd * gw.w;
        uint2 pk = {pack2(o0, o1), pack2(o2, o3)};
        *(uint2*)(orow + e) = pk;
      }
  }
}

DI void phase3(const Params& p, char* smem, int l, const float* xc, const float* xl) {
  const float* W = p.w_out + (size_t)l * DM * DM;
  const int xcd = blockIdx.x & 7, nloc = gridDim.x >> 3;
  auto setup = [&](int s, int ar0, int ac, int n4, int kq, const u16*& q0, const u16*& q1, const u16*& q2, const u16*& q3, const float*& bp) {
    const int tm = 12 * xcd + s % 12, tn = s / 12;
    const u16* ab = p.CAT + ((size_t)tm * 128 + ar0) * DM + ac;
    q0 = ab; q1 = ab + 32 * DM; q2 = ab + 64 * DM; q3 = ab + 96 * DM;
    bp = W + tn * 128 + 4 * n4 + (size_t)(kq * 8) * DM;
  };
  auto epi = [&](int s, f32x16(&acc)[4], int w, int r, int h) {
    int hq = h;
    asm volatile("" : "+v"(hq));
    const int tm = 12 * xcd + s % 12, tn = s / 12;
    const int m0 = tm * 128, n0 = tn * 128;
    const float* g1 = p.MOD + (size_t)(l * 5 + cond_of(m0)) * 6144 + 2048;
    const int n = n0 + 4 * r;
    const float4 g = *(const float4*)(g1 + n);
#pragma unroll
    for (int i = 0; i < 16; ++i) {
      const int ml = w * 32 + crow(i, hq);
      const float4 o = {g.x * acc[0][i], g.y * acc[1][i], g.z * acc[2][i], g.w * acc[3][i]};
      *(float4*)(p.PRE + (size_t)(m0 + ml) * DM + n) = o;
    }
  };
  gemm_phase128(smem, blockIdx.x >> 3, 96, nloc, setup, DM, epi);
}

DI void phase4(const Params& p, char* smem, int l, const float* xc, const float* xl) {
  float* swr = (float*)smem;
  const int tid = otid(), lane = tid & 63, w = tid >> 6;
  __syncthreads();
  for (int idx = tid; idx < 4096; idx += 256) {
    const float4 x = *(const float4*)(p.w_router + (size_t)l * DM * 16 + idx * 4);
    const int k = idx >> 2, e = (idx & 3) * 4;
    swr[(e + 0) * DM + k] = x.x; swr[(e + 1) * DM + k] = x.y; swr[(e + 2) * DM + k] = x.z; swr[(e + 3) * DM + k] = x.w;
  }
  __syncthreads();
  const float* lg = p.ln1g + l * DM;
  const float* lb = p.ln1b + l * DM;
  for (int T = blockIdx.x * 4 + w; T < NTOK; T += gridDim.x * 4) {
    const float* mod = p.MOD + (size_t)(l * 5 + cond_of(T)) * 6144;
    const float* xrow = (T < NCTX) ? (xc + (size_t)T * DM) : (xl + (size_t)(T - NCTX) * DM);
    float4 x[4];
    float s = 0.f;
#pragma unroll
    for (int i = 0; i < 4; ++i) {
      const float4 pr = *(const float4*)(p.PRE + (size_t)T * DM + 256 * i + 4 * lane);
      const float4 xi = *(const float4*)(xrow + 256 * i + 4 * lane);
      x[i].x = ALPHA * xi.x + pr.x; x[i].y = ALPHA * xi.y + pr.y; x[i].z = ALPHA * xi.z + pr.z; x[i].w = ALPHA * xi.w + pr.w;
      s += x[i].x + x[i].y + x[i].z + x[i].w;
    }
    const float mu = wave_sum(s) * (1.f / 1024.f);
    float vs = 0.f;
#pragma unroll
    for (int i = 0; i < 4; ++i) {
      x[i].x -= mu; x[i].y -= mu; x[i].z -= mu; x[i].w -= mu;
      vs += x[i].x * x[i].x + x[i].y * x[i].y + x[i].z * x[i].z + x[i].w * x[i].w;
    }
    const float rstd = rsqrtf(wave_sum(vs) * (1.f / 1024.f) + 1e-6f);
#pragma unroll
    for (int i = 0; i < 4; ++i) {
      const int k = 256 * i + 4 * lane;
      const float4 g = *(const float4*)(lg + k), bb = *(const float4*)(lb + k);
      float4 y;
      y.x = x[i].x * rstd * g.x + bb.x; y.y = x[i].y * rstd * g.y + bb.y; y.z = x[i].z * rstd * g.z + bb.z; y.w = x[i].w * rstd * g.w + bb.w;
      *(float4*)(p.X + (size_t)T * DM + k) = y;
      const float4 sc = *(const float4*)(mod + 4096 + k), sh = *(const float4*)(mod + 3072 + k);
      float4 hh;
      hh.x = y.x * (1.f + sc.x) + sh.x; hh.y = y.y * (1.f + sc.y) + sh.y; hh.z = y.z * (1.f + sc.z) + sh.z; hh.w = y.w * (1.f + sc.w) + sh.w;
      uint2 pk = {pack2(hh.x, hh.y), pack2(hh.z, hh.w)};
      *(uint2*)(p.H2 + (size_t)T * DM + k) = pk;
      x[i] = hh;
    }
    float a16[16];
#pragma unroll
    for (int e = 0; e < 16; ++e) {
      float a = 0.f;
#pragma unroll
      for (int i = 0; i < 4; ++i) {
        const float4 wv = *(const float4*)(swr + e * DM + 256 * i + 4 * lane);
        a += x[i].x * wv.x + x[i].y * wv.y + x[i].z * wv.z + x[i].w * wv.w;
      }
      a16[e] = a;
      if ((e & 3) == 3) __builtin_amdgcn_sched_barrier(0);
    }
    float a8[8], a4[4], a2[2], a1;
    {
      const bool hi = (lane & 32) != 0;
#pragma unroll
      for (int j = 0; j < 8; ++j) {
        const float snd = hi ? a16[j] : a16[8 + j];
        const float kp = hi ? a16[8 + j] : a16[j];
        a8[j] = kp + __shfl_xor(snd, 32);
      }
    }
    {
      const bool hi = (lane & 16) != 0;
#pragma unroll
      for (int j = 0; j < 4; ++j) {
        const float snd = hi ? a8[j] : a8[4 + j];
        const float kp = hi ? a8[4 + j] : a8[j];
        a4[j] = kp + __shfl_xor(snd, 16);
      }
    }
    {
      const bool hi = (lane & 8) != 0;
#pragma unroll
      for (int j = 0; j < 2; ++j) {
        const float snd = hi ? a4[j] : a4[2 + j];
        const float kp = hi ? a4[2 + j] : a4[j];
        a2[j] = kp + __shfl_xor(snd, 8);
      }
    }
    {
      const bool hi = (lane & 4) != 0;
      const float snd = hi ? a2[0] : a2[1];
      const float kp = hi ? a2[1] : a2[0];
      a1 = kp + __shfl_xor(snd, 4);
    }
    a1 += __shfl_xor(a1, 2);
    a1 += __shfl_xor(a1, 1);
    const int myexp = ((lane >> 5) & 1) * 8 + ((lane >> 4) & 1) * 4 + ((lane >> 3) & 1) * 2 + ((lane >> 2) & 1);
    float mx = a1;
#pragma unroll
    for (int o = 32; o >= 4; o >>= 1) mx = fmaxf(mx, __shfl_xor(mx, o));
    const float ex = __expf(a1 - mx);
    float den = ex;
#pragma unroll
    for (int o = 32; o >= 4; o >>= 1) den += __shfl_xor(den, o);
    if ((lane & 3) == 0) { p.AFF[(size_t)T * 16 + myexp] = ex / den; p.INV[(size_t)T * 16 + myexp] = -1; }
  }
}

DI unsigned block_incl_scan(unsigned v, unsigned* wsum, int lane, int w, unsigned& total) {
#pragma unroll
  for (int o = 1; o < 64; o <<= 1) {
    const unsigned t = __shfl_up(v, o);
    if (lane >= o) v += t;
  }
  __syncthreads();
  if (lane == 63) wsum[w] = v;
  __syncthreads();
  unsigned off = 0;
  total = 0;
#pragma unroll
  for (int i = 0; i < 4; ++i) {
    const unsigned s = wsum[i];
    if (i < w) off += s;
    total += s;
  }
  return v + off;
}

DI void phase5(const Params& p, char* smem) {
  unsigned* hist = (unsigned*)smem;
  unsigned* wsum = hist + 256;
  unsigned* bc = wsum + 4;
  const int tid = otid(), lane = tid & 63, w = tid >> 6;
  for (int item = blockIdx.x; item < 320; item += gridDim.x) {
    int n, base, e, cap, rowbase;
    if (item < 64) {
      const int b = item >> 4; e = item & 15;
      n = 2048; base = NCTX + b * 2048; cap = 256; rowbase = 512 + b * 256;
    } else {
      const int it = item - 64; const int rq = it >> 4; e = it & 15;
      n = 256; base = rq * 256; cap = 32; rowbase = rq * 32;
    }
    const int per = n >> 8;
    unsigned key[8];
#pragma unroll
    for (int q = 0; q < 8; ++q) key[q] = (q < per) ? __float_as_uint(p.AFF[(size_t)(base + tid * per + q) * 16 + e]) : 0u;
    unsigned prefix = 0u, mask = 0u;
    unsigned remaining = (unsigned)cap;
#pragma unroll 1
    for (int pass = 3; pass >= 0; --pass) {
      const int shift = pass * 8;
      __syncthreads();
      hist[tid] = 0u;
      __syncthreads();
#pragma unroll
      for (int q = 0; q < 8; ++q)
        if (q < per && (key[q] & mask) == prefix) atomicAdd(&hist[(key[q] >> shift) & 255u], 1u);
      __syncthreads();
      const unsigned hv = hist[tid];
      unsigned total;
      const unsigned incl = block_incl_scan(hv, wsum, lane, w, total);
      const unsigned above = total - incl;
      if (above < remaining && remaining <= above + hv) { bc[0] = (unsigned)tid; bc[1] = remaining - above; }
      __syncthreads();
      const unsigned bsel = bc[0];
      remaining = bc[1];
      prefix |= bsel << shift;
      mask |= 0xFFu << shift;
    }
    const unsigned thr = prefix;
    unsigned ceq = 0u;
#pragma unroll
    for (int q = 0; q < 8; ++q) ceq += (q < per && key[q] == thr) ? 1u : 0u;
    unsigned tot;
    unsigned eq_before = block_incl_scan(ceq, wsum, lane, w, tot) - ceq;
    unsigned selmask = 0u, nsel = 0u;
#pragma unroll
    for (int q = 0; q < 8; ++q) {
      if (q < per) {
        const bool eq = key[q] == thr;
        const bool sel = (key[q] > thr) || (eq && eq_before < remaining);
        eq_before += eq ? 1u : 0u;
        selmask |= sel ? (1u << q) : 0u;
        nsel += sel ? 1u : 0u;
      }
    }
    unsigned row = block_incl_scan(nsel, wsum, lane, w, tot) - nsel;
#pragma unroll
    for (int q = 0; q < 8; ++q) {
      if (q < per && ((selmask >> q) & 1u)) {
        const int tok = base + tid * per + q;
        const int rr = e * NROWS_E + rowbase + (int)row;
        p.SELTOK[rr] = tok;
        p.SELGATE[rr] = __uint_as_float(key[q]);
        p.INV[(size_t)tok * 16 + e] = rr;
        ++row;
      }
    }
  }
}

DI void phase6(const Params& p, char* smem, int l) {
  const int xcd = blockIdx.x & 7, nloc = gridDim.x >> 3;
  auto setup = [&](int s, int ar0, int ac, int n4, int kq, const u16*& q0, const u16*& q1, const u16*& q2, const u16*& q3, const float*& bp) {
    const int e = 2 * xcd + s / 96, rem = s % 96, tn = rem / 6, tm = rem % 6;
    const int* tok = p.SELTOK + e * NROWS_E + tm * 256 + ar0;
    q0 = p.H2 + (size_t)tok[0] * DM + ac; q1 = p.H2 + (size_t)tok[64] * DM + ac;
    q2 = p.H2 + (size_t)tok[128] * DM + ac; q3 = p.H2 + (size_t)tok[192] * DM + ac;
    bp = p.w_gu + ((size_t)l * 16 + e) * DM * 2048 + ((n4 >> 4) & 1) * 1024 + tn * 64 + 4 * (n4 & 15) + (size_t)(kq * 4) * 2048;
  };
  auto epi = [&](int s, f32x16(&acc)[2][4], int w, int r, int h) {
    int hq = h;
    asm volatile("" : "+v"(hq));
    const int e = 2 * xcd + s / 96, rem = s % 96, tn = rem / 6, tm = rem % 6;
    const int m0 = tm * 256, f0 = tn * 64;
    u16* act = p.ACT + ((size_t)e * NROWS_E + m0) * DM;
#pragma unroll
    for (int mt = 0; mt < 2; ++mt)
#pragma unroll
    for (int i = 0; i < 16; ++i) {
      const int ml = w * 64 + mt * 32 + crow(i, hq);
      const float a0 = acc[mt][0][i], a1 = acc[mt][1][i], a2 = acc[mt][2][i], a3 = acc[mt][3][i];
      const bool lo = r < 16;
      const float s0 = lo ? a2 : a0, s1 = lo ? a3 : a1;
      const float r0 = __shfl_xor(s0, 16), r1 = __shfl_xor(s1, 16);
      const float g0 = lo ? a0 : r0, g1 = lo ? a1 : r1;
      const float v0 = lo ? r0 : a2, v1 = lo ? r1 : a3;
      *(unsigned*)(act + (size_t)ml * DM + f0 + 4 * (r & 15) + (lo ? 0 : 2)) = pack2(silu(g0) * v0, silu(g1) * v1);
      if ((i & 3) == 3) __builtin_amdgcn_sched_barrier(0);
    }
  };
  gemm_phase<false>(smem, blockIdx.x >> 3, 192, nloc, setup, 2048, epi);
}

DI void phase7(const Params& p, char* smem, int l, u16* FF) {
  const int xcd = blockIdx.x & 7, nloc = gridDim.x >> 3;
  auto setup = [&](int s, int ar0, int ac, int n4, int kq, const u16*& q0, const u16*& q1, const u16*& q2, const u16*& q3, const float*& bp) {
    const int e = 2 * xcd + s / 48, rem = s % 48, tn = rem / 6, tm = rem % 6;
    const u16* ab = p.ACT + ((size_t)e * NROWS_E + tm * 256 + ar0) * DM + ac;
    q0 = ab; q1 = ab + 64 * DM; q2 = ab + 128 * DM; q3 = ab + 192 * DM;
    bp = p.w_down + ((size_t)l * 16 + e) * DM * DM + tn * 128 + 4 * n4 + (size_t)(kq * 4) * DM;
  };
  auto epi = [&](int s, f32x16(&acc)[2][4], int w, int r, int h) {
    int hq = h;
    asm volatile("" : "+v"(hq));
    const int e = 2 * xcd + s / 48, rem = s % 48, tn = rem / 6, tm = rem % 6;
    const int m0 = tm * 256, n0 = tn * 128;
    const float* gate = p.SELGATE + e * NROWS_E + m0;
#pragma unroll
    for (int mt = 0; mt < 2; ++mt)
#pragma unroll
    for (int i = 0; i < 16; ++i) {
      const int ml = w * 64 + mt * 32 + crow(i, hq);
      const float g = gate[ml];
      uint2 pk = {pack2(g * acc[mt][0][i], g * acc[mt][1][i]), pack2(g * acc[mt][2][i], g * acc[mt][3][i])};
      *(uint2*)(FF + ((size_t)e * NROWS_E + m0 + ml) * DM + n0 + 4 * r) = pk;
      if ((i & 3) == 3) __builtin_amdgcn_sched_barrier(0);
    }
  };
  gemm_phase<true>(smem, blockIdx.x >> 3, 96, nloc, setup, DM, epi);
}

DI void phase8(const Params& p, int l, float* dst, bool write_h) {
  const int tid = otid(), lane = tid & 63, w = tid >> 6;
  const float* lg = p.ln2g + l * DM;
  const float* lb = p.ln2b + l * DM;
  for (int T = blockIdx.x * 4 + w; T < NTOK; T += gridDim.x * 4) {
    const float* g2 = p.MOD + (size_t)(l * 5 + cond_of(T)) * 6144 + 5120;
    const float* modn = p.MOD + (size_t)(5 + cond_of(T)) * 6144;
    float4 x[4], ff[4];
#pragma unroll
    for (int i = 0; i < 4; ++i) ff[i] = make_float4(0.f, 0.f, 0.f, 0.f);
    const int myinv = p.INV[(size_t)T * 16 + (lane & 15)];
#pragma unroll 1
    for (int e = 0; e < 16; ++e) {
      const int row = __shfl(myinv, e);
      if (row >= 0) {
#pragma unroll
        for (int i = 0; i < 4; ++i) {
          const uint2 y = *(const uint2*)(p.YE + (size_t)row * DM + 256 * i + 4 * lane);
          ff[i].x += bflo(y.x); ff[i].y += bfhi(y.x); ff[i].z += bflo(y.y); ff[i].w += bfhi(y.y);
        }
      }
    }
    float s = 0.f;
#pragma unroll
    for (int i = 0; i < 4; ++i) {
      const int k = 256 * i + 4 * lane;
      const float4 a = *(const float4*)(p.X + (size_t)T * DM + k);
      const float4 f = ff[i];
      const float4 g = *(const float4*)(g2 + k);
      x[i].x = ALPHA * a.x + g.x * f.x; x[i].y = ALPHA * a.y + g.y * f.y; x[i].z = ALPHA * a.z + g.z * f.z; x[i].w = ALPHA * a.w + g.w * f.w;
      s += x[i].x + x[i].y + x[i].z + x[i].w;
    }
    const float mu = wave_sum(s) * (1.f / 1024.f);
    float vs = 0.f;
#pragma unroll
    for (int i = 0; i < 4; ++i) {
      x[i].x -= mu; x[i].y -= mu; x[i].z -= mu; x[i].w -= mu;
      vs += x[i].x * x[i].x + x[i].y * x[i].y + x[i].z * x[i].z + x[i].w * x[i].w;
    }
    const float rstd = rsqrtf(wave_sum(vs) * (1.f / 1024.f) + 1e-6f);
#pragma unroll
    for (int i = 0; i < 4; ++i) {
      const int k = 256 * i + 4 * lane;
      const float4 g = *(const float4*)(lg + k), bb = *(const float4*)(lb + k);
      float4 y;
      y.x = x[i].x * rstd * g.x + bb.x; y.y = x[i].y * rstd * g.y + bb.y; y.z = x[i].z * rstd * g.z + bb.z; y.w = x[i].w * rstd * g.w + bb.w;
      *(float4*)(dst + (size_t)T * DM + k) = y;
      if (write_h) {
        const float4 sc = *(const float4*)(modn + 1024 + k), sh = *(const float4*)(modn + k);
        uint2 pk = {pack2(y.x * (1.f + sc.x) + sh.x, y.y * (1.f + sc.y) + sh.y), pack2(y.z * (1.f + sc.z) + sh.z, y.w * (1.f + sc.w) + sh.w)};
        *(uint2*)(p.H2 + (size_t)T * DM + k) = pk;
      }
    }
  }
}

constexpr int kDynLds = 73728;
__global__ void __launch_bounds__(256, 2) mega(Params p) {
  extern __shared__ __attribute__((aligned(16))) char smem[];
  cg::grid_group grid = cg::this_grid();
  if (p.never) grid.sync();
  GBar gb;
  gb.bar = p.BAR; gb.x = xb_xcc_id(); gb.nloc = 0u; gb.nx = 0u;
  if (threadIdx.x == 0) (void)xb_add(&p.BAR[XB_XCNT(gb.x)], 1u);
  phase0(p, smem);
  gbar(gb);
  phase0b(p);
  gbar(gb);
#pragma unroll 1
  for (int l = 0; l < 2; ++l) {
    const float* xc = (l == 0) ? p.x_prompt : p.X;
    const float* xl = (l == 0) ? p.x_sample : (p.X + (size_t)NCTX * DM);
    phase1(p, smem, l);
    gbar(gb);
    if (PROBE == 1) { phase1(p, smem, l); gbar(gb); }
    phase2(p, smem, l);
    gbar(gb);
    if (PROBE == 3) { phase2(p, smem, l); gbar(gb); }
    phase2c(p, smem, l);
    gbar(gb);
    if (PROBE == 3) { phase2c(p, smem, l); gbar(gb); }
    phase3(p, smem, l, xc, xl);
    gbar(gb);
    if (PROBE == 1) { phase3(p, smem, l, xc, xl); gbar(gb); }
    phase4(p, smem, l, xc, xl);
    gbar(gb);
    phase5(p, smem);
    gbar(gb);
    phase6(p, smem, l);
    gbar(gb);
    if (PROBE == 1) { phase6(p, smem, l); gbar(gb); }
    phase7(p, smem, l, p.YE);
    gbar(gb);
    phase8(p, l, (l == 1) ? p.out : p.X, l == 0);
    if (l == 0) gbar(gb);
  }
}

extern "C" void kernel_launch(void* const* d_in, const int* in_sizes, int n_in, void* d_out, int out_size, void* d_ws,
                              size_t ws_size, hipStream_t stream) {
  static int grid_blocks = 0;
  if (!grid_blocks) {
    int dev = 0, cus = 0, per_cu = 0;
    hipGetDevice(&dev);
    hipDeviceGetAttribute(&cus, hipDeviceAttributeMultiprocessorCount, dev);
    hipFuncSetAttribute((const void*)mega, hipFuncAttributeMaxDynamicSharedMemorySize, kDynLds);
    hipOccupancyMaxActiveBlocksPerMultiprocessor(&per_cu, mega, 256, kDynLds);
    if (per_cu > 2) per_cu = 2;
    if (per_cu < 1) per_cu = 1;
    grid_blocks = cus * per_cu;
  }
  Params p{};
  const float** pf = (const float**)&p;
  for (int i = 0; i < 24; ++i) pf[i] = (const float*)d_in[i];
  p.out = (float*)d_out;
  char* ws = (char*)d_ws;
  size_t off = 0;
  auto take = [&](size_t bytes) { char* q = ws + off; off += (bytes + 255) & ~(size_t)255; return q; };
  p.MOD = (float*)take(2 * 5 * 6144 * 4);
  p.BAR = (unsigned*)take(XCD_BAR_WORDS * 4);
  p.ROPE = (float*)take(2048 * 4);
  p.X = (float*)take((size_t)NTOK * DM * 4);
  p.PRE = (float*)take((size_t)NTOK * DM * 4);
  p.KVS = (float*)take((size_t)20 * 4 * 2 * 16 * 4096 * 4);
  p.AFF = (float*)take((size_t)NTOK * 16 * 4);
  p.SELGATE = (float*)take((size_t)16 * NROWS_E * 4);
  p.SELTOK = (int*)take((size_t)16 * NROWS_E * 4);
  p.QKV = (u16*)take((size_t)NTOK * DIN * 2);
  p.CAT = (u16*)take((size_t)NTOK * DM * 2);
  p.H2 = (u16*)take((size_t)NTOK * DM * 2);
  p.ACT = (u16*)take((size_t)16 * NROWS_E * DM * 2);
  p.YE = (u16*)take((size_t)16 * NROWS_E * DM * 2);
  p.INV = (int*)take((size_t)NTOK * 16 * 4);
  p.CAK = (u16*)take((size_t)4 * 2 * 512 * 128 * 2);
  p.CAV = (u16*)take((size_t)4 * 2 * 512 * 128 * 2);
  p.CBK = (u16*)take((size_t)4 * 2 * 512 * 256 * 2);
  p.CBV = (u16*)take((size_t)4 * 2 * 512 * 256 * 2);
  p.never = 0;
  hipMemsetAsync(p.MOD, 0, (size_t)((char*)p.BAR - (char*)p.MOD) + XCD_BAR_WORDS * 4, stream);
  void* args[] = {&p};
  hipError_t e = hipLaunchCooperativeKernel((void*)mega, dim3(grid_blocks), dim3(256), args, kDynLds, stream);
  if (e != hipSuccess) fprintf(stderr, "cooperative launch failed: %s (grid %d)\n", hipGetErrorString(e), grid_blocks);
}
```

```cpp
#include <hip/hip_runtime.h>
#include <hip/hip_cooperative_groups.h>
#include <cstdio>
namespace cg = cooperative_groups;

#define DI __device__ __forceinline__
typedef short bf16x8 __attribute__((ext_vector_type(8)));
typedef float f32x16 __attribute__((ext_vector_type(16)));
typedef __bf16 bf2_t __attribute__((ext_vector_type(2)));
typedef float f2_t __attribute__((ext_vector_type(2)));
typedef unsigned short u16;
typedef unsigned u32x4 __attribute__((ext_vector_type(4)));
typedef float f32x4 __attribute__((ext_vector_type(4)));
typedef float f32x2 __attribute__((ext_vector_type(2)));

#define MFMA(a, b, c) __builtin_amdgcn_mfma_f32_32x32x16_bf16((a), (b), (c), 0, 0, 0)

#define PROBE 0
constexpr int NTOK = 12288;
constexpr int NCTX = 4096;
constexpr int DM = 1024;
constexpr int DIN = 2560;
constexpr int LDT = 72;
constexpr int LDT2 = 136;
constexpr int NROWS_E = 1536;
constexpr float NEG = -1e30f;
constexpr float ALPHA = 1.41421356237f;

constexpr size_t OFF_AK = 12582912, OFF_AV = 13631488, OFF_BK = 14680064, OFF_BV = 16777216, OFF_ST = 18874368;

struct Params {
  const float *x_prompt, *x_sample, *cak, *cav, *cbk, *cbv, *state, *c, *c_ctx, *w_ada, *b_ada, *w_in, *w_out, *sink, *rpb,
      *decay, *gn, *ln1g, *ln1b, *ln2g, *ln2b, *w_router, *w_gu, *w_down;
  float* out;
  float *MOD, *ROPE, *X, *PRE, *KVS, *AFF, *SELGATE;
  int* SELTOK;
  u16 *QKV, *CAT, *H2, *ACT, *CAK, *CAV, *CBK, *CBV;
  u16* YE;
  int* INV;
  unsigned* BAR;
  long never;
};

DI unsigned pack2(float a, float b) {
  f2_t v = {a, b};
  bf2_t r = __builtin_convertvector(v, bf2_t);
  return __builtin_bit_cast(unsigned, r);
}
DI int otid() { int x = threadIdx.x; asm volatile("" : "+v"(x)); return x; }
DI float bflo(unsigned u) { return __uint_as_float(u << 16); }
DI float bfhi(unsigned u) { return __uint_as_float(u & 0xffff0000u); }
DI int crow(int i, int h) { return (i & 3) + 8 * (i >> 2) + 4 * h; }
DI float silu(float x) { return x / (1.f + __expf(-x)); }
DI float wave_sum(float v) {
#pragma unroll
  for (int o = 32; o >= 1; o >>= 1) v += __shfl_xor(v, o);
  return v;
}
DI bf16x8 mk8(unsigned a, unsigned b, unsigned c, unsigned d) {
  uint4 u = {a, b, c, d};
  return __builtin_bit_cast(bf16x8, u);
}


#define XB_TMO 128
#define XB_XCNT(j) (256 + 64 * (j))
#define XB_XSUB(j) (1280 + 64 * (j))
#define XB_XGEN(j) (2304 + 64 * (j))
#define XB_TOP 3328
#define XB_TOPGEN 3392
#define XCD_BAR_WORDS 3456
#define XB_SPIN_CAP (1u << 20)
DI unsigned xb_ld(unsigned* p) { return __hip_atomic_load(p, __ATOMIC_RELAXED, __HIP_MEMORY_SCOPE_AGENT); }
DI unsigned xb_add(unsigned* p, unsigned v) { return __hip_atomic_fetch_add(p, v, __ATOMIC_RELAXED, __HIP_MEMORY_SCOPE_AGENT); }
DI unsigned xb_xcc_id() { return (unsigned)__builtin_amdgcn_s_getreg((3 << 11) | 20) & 0xFu; }
#define XB_SPIN(cond, bar)                                                            \
  do {                                                                                \
    unsigned _sp = 0;                                                                 \
    while (cond) {                                                                    \
      __builtin_amdgcn_s_sleep(1);                                                    \
      if ((++_sp & 255u) == 0u) {                                                     \
        if (xb_ld(&(bar)[XB_TMO])) break;                                             \
        if (_sp > XB_SPIN_CAP) { atomicAdd(&(bar)[XB_TMO], 1u); break; }              \
      }                                                                               \
    }                                                                                 \
  } while (0)
struct GBar { unsigned* bar; unsigned x, nloc, nx; };
DI void gbar_complete(unsigned* bar, unsigned x, unsigned& nloc, unsigned& nx) {
  const unsigned G = gridDim.x;
  unsigned sum, cnt, mine, sp = 0u;
  for (;;) {
    sum = 0u; cnt = 0u; mine = 0u;
#pragma unroll
    for (unsigned j = 0; j < 16; ++j) {
      const unsigned c = xb_ld(&bar[XB_XCNT(j)]);
      sum += c; cnt += (c > 0u) ? 1u : 0u; mine = (j == x) ? c : mine;
    }
    if (sum == G) break;
    __builtin_amdgcn_s_sleep(1);
    if ((++sp & 255u) == 0u) {
      if (xb_ld(&bar[XB_TMO])) break;
      if (sp > XB_SPIN_CAP) { atomicAdd(&bar[XB_TMO], 1u); break; }
    }
  }
  nloc = mine > 0u ? mine : 1u;
  nx = cnt > 0u ? cnt : 1u;
}
DI void gbar(GBar& b) {
  asm volatile("s_waitcnt vmcnt(0)" ::: "memory");
  __syncthreads();
  if (threadIdx.x == 0) {
    unsigned* bar = b.bar;
    __builtin_amdgcn_s_waitcnt(0);
    if (b.nloc == 0u) gbar_complete(bar, b.x, b.nloc, b.nx);
    const unsigned nloc = b.nloc, nx = b.nx;
    const unsigned old = xb_add(&bar[XB_XSUB(b.x)], 1u);
    const unsigned gen = old / nloc;
    if (old + 1u == (gen + 1u) * nloc) {
      __builtin_amdgcn_fence(__ATOMIC_RELEASE, "agent");
      asm volatile("s_waitcnt vmcnt(0)" ::: "memory");
      const unsigned og = xb_add(&bar[XB_TOP], 1u);
      const unsigned tg = og / nx;
      if (og + 1u == (tg + 1u) * nx) xb_add(&bar[XB_TOPGEN], 1u);
      else XB_SPIN(xb_ld(&bar[XB_TOPGEN]) == tg, bar);
      __builtin_amdgcn_fence(__ATOMIC_ACQUIRE, "agent");
      xb_add(&bar[XB_XGEN(b.x)], 1u);
      asm volatile("s_waitcnt vmcnt(0)" ::: "memory");
    } else {
      XB_SPIN(xb_ld(&bar[XB_XGEN(b.x)]) == gen, bar);
      __builtin_amdgcn_fence(__ATOMIC_ACQUIRE, "agent");
      asm volatile("s_waitcnt vmcnt(0)" ::: "memory");
    }
  }
  __syncthreads();
}

template <class Setup, class Epi>
DI void gemm_phase128(char* smem, int s0, int s_end, int s_step, Setup setup, int ldb, Epi epi) {
  if (s0 >= s_end) return;
  u16* sA0 = (u16*)smem;
  u16* sB0 = sA0 + 128 * LDT;
  u16* sA1 = sB0 + 128 * LDT;
  u16* sB1 = sA1 + 128 * LDT;
  const int tid = otid(), lane = tid & 63, w = tid >> 6, r = lane & 31, h = lane >> 5;
  const int a_r0 = tid >> 3, a_c = (tid & 7) * 8;
  const int b_n4 = tid & 31, b_kq = tid >> 5;
  const u16 *apb0, *apb1, *apb2, *apb3;
  const float* bp;
  setup(s0, a_r0, a_c, b_n4, b_kq, apb0, apb1, apb2, apb3, bp);

  u32x4 pa0, pa1, pa2, pa3;
  f32x4 pb[8];

#define G_LOAD(KT)                                                                       \
  {                                                                                      \
    const int k0_ = (KT) * 64;                                                           \
    pa0 = *(const u32x4*)(apb0 + k0_);                                                   \
    pa1 = *(const u32x4*)(apb1 + k0_);                                                   \
    pa2 = *(const u32x4*)(apb2 + k0_);                                                   \
    pa3 = *(const u32x4*)(apb3 + k0_);                                                   \
    _Pragma("unroll") for (int i_ = 0; i_ < 8; ++i_) pb[i_] = *(const f32x4*)(bp + (size_t)(k0_ + i_) * ldb); \
  }
#define G_STAGE(SA, SBB)                                                                 \
  {                                                                                      \
    *(u32x4*)&SA[(a_r0)*LDT + a_c] = pa0;                                                \
    *(u32x4*)&SA[(a_r0 + 32) * LDT + a_c] = pa1;                                         \
    *(u32x4*)&SA[(a_r0 + 64) * LDT + a_c] = pa2;                                         \
    *(u32x4*)&SA[(a_r0 + 96) * LDT + a_c] = pa3;                                         \
    _Pragma("unroll") for (int j_ = 0; j_ < 4; ++j_) {                                   \
      u32x4 pk_;                                                                         \
      pk_.x = pack2(pb[0][j_], pb[1][j_]);                                               \
      pk_.y = pack2(pb[2][j_], pb[3][j_]);                                               \
      pk_.z = pack2(pb[4][j_], pb[5][j_]);                                               \
      pk_.w = pack2(pb[6][j_], pb[7][j_]);                                               \
      *(u32x4*)&SBB[(j_ * 32 + b_n4) * LDT + b_kq * 8] = pk_;                            \
    }                                                                                    \
  }
  const int aoff = (w * 32 + r) * LDT + 8 * h, boff = r * LDT + 8 * h;
#define G_FRAG(BUF, SA, SBB, KS)                                                         \
  {                                                                                      \
    fa[BUF] = *(const bf16x8*)(SA + aoff + (KS) * 16);                                   \
    fb[BUF][0] = *(const bf16x8*)(SBB + boff + (KS) * 16);                               \
    fb[BUF][1] = *(const bf16x8*)(SBB + boff + 32 * LDT + (KS) * 16);                    \
    fb[BUF][2] = *(const bf16x8*)(SBB + boff + 64 * LDT + (KS) * 16);                    \
    fb[BUF][3] = *(const bf16x8*)(SBB + boff + 96 * LDT + (KS) * 16);                    \
  }
#define G_MFMA(BUF)                                                                      \
  {                                                                                      \
    acc[0] = MFMA(fa[BUF], fb[BUF][0], acc[0]);                                          \
    acc[1] = MFMA(fa[BUF], fb[BUF][1], acc[1]);                                          \
    acc[2] = MFMA(fa[BUF], fb[BUF][2], acc[2]);                                          \
    acc[3] = MFMA(fa[BUF], fb[BUF][3], acc[3]);                                          \
  }
#define SB() __builtin_amdgcn_sched_barrier(0)
#define G_COMPUTE(SA, SBB)                                                               \
  {                                                                                      \
    bf16x8 fa[2], fb[2][4];                                                              \
    G_FRAG(0, SA, SBB, 0);                                                               \
    G_FRAG(1, SA, SBB, 1);                                                               \
    SB();                                                                                \
    G_MFMA(0);                                                                           \
    SB();                                                                                \
    G_FRAG(0, SA, SBB, 2);                                                               \
    SB();                                                                                \
    G_MFMA(1);                                                                           \
    SB();                                                                                \
    G_FRAG(1, SA, SBB, 3);                                                               \
    SB();                                                                                \
    G_MFMA(0);                                                                           \
    SB();                                                                                \
    G_MFMA(1);                                                                           \
    SB();                                                                                \
  }

  G_LOAD(0);
  __syncthreads();
#pragma unroll 1
  for (int s = s0; s < s_end; s += s_step) {
    f32x16 acc[4];
#pragma unroll
    for (int a = 0; a < 4; ++a)
#pragma unroll
      for (int i = 0; i < 16; ++i) acc[a][i] = 0.f;
    const int sn = s + s_step;
    const bool has_next = sn < s_end;
    const u16 *n0 = apb0, *n1 = apb1, *n2 = apb2, *n3 = apb3;
    const float* nbp = bp;
    if (has_next) setup(sn, a_r0, a_c, b_n4, b_kq, n0, n1, n2, n3, nbp);
#pragma unroll 1
    for (int kt = 0; kt < 16; kt += 2) {
      G_STAGE(sA0, sB0);
      __syncthreads();
      G_LOAD(kt + 1);
      G_COMPUTE(sA0, sB0);
      G_STAGE(sA1, sB1);
      __syncthreads();
      {
        int kn = kt + 2;
        if (kt == 14) { apb0 = n0; apb1 = n1; apb2 = n2; apb3 = n3; bp = nbp; kn = 0; }
        G_LOAD(kn);
      }
      G_COMPUTE(sA1, sB1);
    }
    epi(s, acc, w, r, h);
  }
  __syncthreads();
#undef G_LOAD
#undef G_STAGE
#undef G_COMPUTE
#undef G_FRAG
#undef G_MFMA
}
#undef SB

template <bool CONTIG, class Setup, class Epi>
DI void gemm_phase(char* smem, int s0, int s_end, int s_step, Setup setup, int ldb, Epi epi) {
  asm volatile("" : "+s"(s_end));
  if (s0 >= s_end) return;
  constexpr int LDK = 40;
  u16* sA0 = (u16*)smem;
  u16* sB0 = sA0 + 256 * LDK;
  u16* sA1 = sB0 + 128 * LDK;
  u16* sB1 = sA1 + 256 * LDK;
  const int tid = otid(), lane = tid & 63, w = tid >> 6, r = lane & 31, h = lane >> 5;
  const int a_r0 = tid >> 2, a_c = (tid & 3) * 8;
  const int b_n4 = tid & 31, b_kq = tid >> 5;
  const u16 *apb0, *apb1, *apb2, *apb3;
  const float* bp;
  setup(s0, a_r0, a_c, b_n4, b_kq, apb0, apb1, apb2, apb3, bp);

  u32x4 pa0, pa1, pa2, pa3;
  f32x4 pb[4];

#define G_LOAD(KT)                                                                       \
  {                                                                                      \
    const int k0_ = (KT) * 32;                                                           \
    pa0 = *(const u32x4*)(apb0 + k0_);                                                   \
    pa1 = *(const u32x4*)((CONTIG ? apb0 + 64 * DM : apb1) + k0_);                       \
    pa2 = *(const u32x4*)((CONTIG ? apb0 + 128 * DM : apb2) + k0_);                      \
    pa3 = *(const u32x4*)((CONTIG ? apb0 + 192 * DM : apb3) + k0_);                      \
    _Pragma("unroll") for (int i_ = 0; i_ < 4; ++i_) pb[i_] = *(const f32x4*)(bp + (size_t)(k0_ + i_) * ldb); \
  }
#define G_STAGE(SA, SBB)                                                                 \
  {                                                                                      \
    *(u32x4*)&SA[(a_r0)*LDK + a_c] = pa0;                                                \
    *(u32x4*)&SA[(a_r0 + 64) * LDK + a_c] = pa1;                                         \
    *(u32x4*)&SA[(a_r0 + 128) * LDK + a_c] = pa2;                                        \
    *(u32x4*)&SA[(a_r0 + 192) * LDK + a_c] = pa3;                                        \
    _Pragma("unroll") for (int j_ = 0; j_ < 4; ++j_) {                                   \
      uint2 pk_;                                                                         \
      pk_.x = pack2(pb[0][j_], pb[1][j_]);                                               \
      pk_.y = pack2(pb[2][j_], pb[3][j_]);                                               \
      *(uint2*)&SBB[(j_ * 32 + b_n4) * LDK + b_kq * 4] = pk_;                            \
    }                                                                                    \
  }
  const int aoff = (w * 64 + r) * LDK + 8 * h, boff = r * LDK + 8 * h;
#define G_FRAG(FA, FB, SA, SBB, KS)                                                      \
  {                                                                                      \
    FA[0] = *(const bf16x8*)(SA + aoff + (KS) * 16);                                     \
    FA[1] = *(const bf16x8*)(SA + aoff + 32 * LDK + (KS) * 16);                          \
    FB[0] = *(const bf16x8*)(SBB + boff + (KS) * 16);                                    \
    FB[1] = *(const bf16x8*)(SBB + boff + 32 * LDK + (KS) * 16);                         \
    FB[2] = *(const bf16x8*)(SBB + boff + 64 * LDK + (KS) * 16);                         \
    FB[3] = *(const bf16x8*)(SBB + boff + 96 * LDK + (KS) * 16);                         \
  }
#define G_MFMA(FA, FB)                                                                   \
  {                                                                                      \
    _Pragma("unroll") for (int mt_ = 0; mt_ < 2; ++mt_)                                  \
    _Pragma("unroll") for (int nt_ = 0; nt_ < 4; ++nt_) acc[mt_][nt_] = MFMA(FA[mt_], FB[nt_], acc[mt_][nt_]); \
  }
#define SB() __builtin_amdgcn_sched_barrier(0)
#define G_COMPUTE(SA, SBB)                                                               \
  {                                                                                      \
    bf16x8 fa0[2], fb0[4];                                                               \
    G_FRAG(fa0, fb0, SA, SBB, 0);                                                        \
    SB();                                                                                \
    G_MFMA(fa0, fb0);                                                                    \
    SB();                                                                                \
    G_FRAG(fa0, fb0, SA, SBB, 1);                                                        \
    SB();                                                                                \
    G_MFMA(fa0, fb0);                                                                    \
    SB();                                                                                \
  }

  G_LOAD(0);
  __syncthreads();
#pragma unroll 1
  for (int s = s0; s < s_end; s += s_step) {
    f32x16 acc[2][4];
#pragma unroll
    for (int a = 0; a < 2; ++a)
#pragma unroll
      for (int b = 0; b < 4; ++b)
#pragma unroll
        for (int i = 0; i < 16; ++i) acc[a][b][i] = 0.f;
    const int sn = s + s_step;
    const bool has_next = sn < s_end;
    const u16 *n0 = apb0, *n1 = apb1, *n2 = apb2, *n3 = apb3;
    const float* nbp = bp;
    if (has_next) setup(sn, a_r0, a_c, b_n4, b_kq, n0, n1, n2, n3, nbp);
#pragma unroll 1
    for (int kt = 0; kt < 32; kt += 2) {
      G_STAGE(sA0, sB0);
      __syncthreads();
      G_LOAD(kt + 1);
      G_COMPUTE(sA0, sB0);
      G_STAGE(sA1, sB1);
      __syncthreads();
      {
        int kn = kt + 2;
        if (kt == 30) { apb0 = n0; apb1 = n1; apb2 = n2; apb3 = n3; bp = nbp; kn = 0; }
        G_LOAD(kn);
      }
      G_COMPUTE(sA1, sB1);
    }
    epi(s, acc, w, r, h);
  }
  __syncthreads();
#undef G_LOAD
#undef G_STAGE
#undef G_COMPUTE
#undef G_FRAG
#undef G_MFMA
}

DI void load4x4(const void* base, int stride, bool isf32, int rq, int c4, float v[4][4]) {
  if (isf32) {
#pragma unroll
    for (int i = 0; i < 4; ++i) {
      const float4 x = *(const float4*)((const float*)base + (size_t)(4 * rq + i) * stride + 4 * c4);
      v[i][0] = x.x; v[i][1] = x.y; v[i][2] = x.z; v[i][3] = x.w;
    }
  } else {
#pragma unroll
    for (int i = 0; i < 4; ++i) {
      const uint2 x = *(const uint2*)((const u16*)base + (size_t)(4 * rq + i) * stride + 4 * c4);
      v[i][0] = bflo(x.x); v[i][1] = bfhi(x.x); v[i][2] = bflo(x.y); v[i][3] = bfhi(x.y);
    }
  }
}
DI void store_n(u16* dst, int ld, int row0, int rq, int c4, const float v[4][4]) {
#pragma unroll
  for (int i = 0; i < 4; ++i) {
    uint2 pk = {pack2(v[i][0], v[i][1]), pack2(v[i][2], v[i][3])};
    *(uint2*)&dst[(row0 + 4 * rq + i) * ld + 4 * c4] = pk;
  }
}
DI void store_t(u16* dst, int ld, int col0, int rq, int c4, const float v[4][4], const float s[4]) {
#pragma unroll
  for (int j = 0; j < 4; ++j) {
    uint2 pk = {pack2(v[0][j] * s[0], v[1][j] * s[1]), pack2(v[2][j] * s[2], v[3][j] * s[3])};
    *(uint2*)&dst[(4 * c4 + j) * ld + col0 + 4 * rq] = pk;
  }
}

DI void attn_load(const u16* kp, const u16* vp, int stride, int rq, int c4, uint2 (&k)[4], uint2 (&v)[4]) {
#pragma unroll
  for (int i = 0; i < 4; ++i) {
    k[i] = *(const uint2*)(kp + (size_t)(4 * rq + i) * stride + 4 * c4);
    v[i] = *(const uint2*)(vp + (size_t)(4 * rq + i) * stride + 4 * c4);
  }
}
DI void attn_stage(u16* sK, u16* sVT, int rq, int c4, const uint2 (&k)[4], const uint2 (&v)[4]) {
#pragma unroll
  for (int i = 0; i < 4; ++i) *(uint2*)&sK[(4 * rq + i) * LDT + 4 * c4] = k[i];
  uint2 t0, t1, t2, t3;
  t0.x = (v[0].x & 0xffffu) | (v[1].x << 16);          t0.y = (v[2].x & 0xffffu) | (v[3].x << 16);
  t1.x = (v[0].x >> 16) | (v[1].x & 0xffff0000u);      t1.y = (v[2].x >> 16) | (v[3].x & 0xffff0000u);
  t2.x = (v[0].y & 0xffffu) | (v[1].y << 16);          t2.y = (v[2].y & 0xffffu) | (v[3].y << 16);
  t3.x = (v[0].y >> 16) | (v[1].y & 0xffff0000u);      t3.y = (v[2].y >> 16) | (v[3].y & 0xffff0000u);
  const int qs = 4 * (rq ^ ((c4 >> 1) & 7));
  *(uint2*)&sVT[(4 * c4 + 0) * LDT + qs] = t0;
  *(uint2*)&sVT[(4 * c4 + 1) * LDT + qs] = t1;
  *(uint2*)&sVT[(4 * c4 + 2) * LDT + qs] = t2;
  *(uint2*)&sVT[(4 * c4 + 3) * LDT + qs] = t3;
}

template <class TileSrc, class BiasF, class TMode>
DI void attn_core(char* smem, const u16* qbase, int ntiles, TileSrc src, BiasF biasf, TMode tmode, float m_init, bool has_sink, u16* obase) {
  u16* sK = (u16*)smem;
  u16* sVT = sK + 64 * LDT;
  const int tid = otid(), lane = tid & 63, w = tid >> 6, r = lane & 31, h = lane >> 5;
  const int rq = tid >> 4, c4 = tid & 15;
  const int ql = w * 32 + r;
  bf16x8 qf[4];
#pragma unroll
  for (int ks = 0; ks < 4; ++ks) qf[ks] = *(const bf16x8*)(qbase + (size_t)ql * DIN + ks * 16 + 8 * h);
  f32x16 O[2];
#pragma unroll
  for (int d = 0; d < 2; ++d)
#pragma unroll
    for (int i = 0; i < 16; ++i) O[d][i] = 0.f;
  float m = m_init, lsum = (has_sink && h == 0) ? 1.f : 0.f;

  auto nextv = [&](int j, const u16*& kp, const u16*& vp, int& stride) -> int {
    while (j < ntiles && !src(j, kp, vp, stride)) ++j;
    return j;
  };
  auto compute = [&](int jc) {
    const int mode = tmode(jc, w);
    if (mode != 2) {
      f32x16 S[2];
#pragma unroll
      for (int mt = 0; mt < 2; ++mt)
#pragma unroll
        for (int i = 0; i < 16; ++i) S[mt][i] = 0.f;
#pragma unroll
      for (int ks = 0; ks < 4; ++ks)
#pragma unroll
        for (int mt = 0; mt < 2; ++mt) {
          const bf16x8 kf = *(const bf16x8*)&sK[(mt * 32 + r) * LDT + ks * 16 + 8 * h];
          S[mt] = MFMA(kf, qf[ks], S[mt]);
        }
      const float C2 = 0.125f * 1.44269504f;
      float mx = NEG;
      if (mode == 1) {
#pragma unroll
        for (int mt = 0; mt < 2; ++mt)
#pragma unroll
          for (int i = 0; i < 16; ++i) {
            const float s = S[mt][i] * C2 + biasf(jc, mt * 32 + crow(i, h), ql);
            S[mt][i] = s;
            mx = fmaxf(mx, s);
          }
      } else {
#pragma unroll
        for (int mt = 0; mt < 2; ++mt)
#pragma unroll
          for (int i = 0; i < 16; ++i) {
            const float s = S[mt][i] * C2;
            S[mt][i] = s;
            mx = fmaxf(mx, s);
          }
      }
      mx = fmaxf(mx, __shfl_xor(mx, 32));
      const float mn = fmaxf(m, mx);
      if (__any(mn > m)) {
        const float alpha = __builtin_amdgcn_exp2f(m - mn);
        m = mn;
        lsum *= alpha;
#pragma unroll
        for (int d = 0; d < 2; ++d)
#pragma unroll
          for (int i = 0; i < 16; ++i) O[d][i] *= alpha;
      }
      float ps = 0.f;
#pragma unroll
      for (int mt = 0; mt < 2; ++mt)
#pragma unroll
        for (int i = 0; i < 16; ++i) {
          const float pv = __builtin_amdgcn_exp2f(S[mt][i] - m);
          S[mt][i] = pv;
          ps += pv;
        }
      lsum += ps;
#pragma unroll
      for (int mt = 0; mt < 2; ++mt)
#pragma unroll
        for (int s = 0; s < 2; ++s) {
          const bf16x8 pf = mk8(pack2(S[mt][8 * s + 0], S[mt][8 * s + 1]), pack2(S[mt][8 * s + 2], S[mt][8 * s + 3]),
                                pack2(S[mt][8 * s + 4], S[mt][8 * s + 5]), pack2(S[mt][8 * s + 6], S[mt][8 * s + 7]));
#pragma unroll
          for (int d = 0; d < 2; ++d) {
            const int sw = (d * 4 + (r >> 3)) & 7, q = mt * 8 + 4 * s + h;
            const u16* vrow = &sVT[(d * 32 + r) * LDT];
            const uint2 lo = *(const uint2*)(vrow + 4 * (q ^ sw));
            const uint2 hi = *(const uint2*)(vrow + 4 * ((q + 2) ^ sw));
            O[d] = MFMA(mk8(lo.x, lo.y, hi.x, hi.y), pf, O[d]);
          }
        }
    }
  };

  uint2 kA[4], vA[4], kB[4], vB[4];
#pragma unroll
  for (int i = 0; i < 4; ++i) { kA[i] = make_uint2(0u, 0u); vA[i] = kA[i]; kB[i] = kA[i]; vB[i] = kA[i]; }
  const u16 *kp = nullptr, *vp = nullptr;
  int stride = 0;
  int jA = nextv(0, kp, vp, stride);
  if (jA < ntiles) attn_load(kp, vp, stride, rq, c4, kA, vA);
  int jB = nextv(jA + 1, kp, vp, stride);
  if (jB < ntiles) attn_load(kp, vp, stride, rq, c4, kB, vB);
#pragma unroll 1
  for (;;) {
    if (jA >= ntiles) break;
    __syncthreads();
    attn_stage(sK, sVT, rq, c4, kA, vA);
    __syncthreads();
    {
      const int jc = jA;
      jA = nextv(jB + 1, kp, vp, stride);
      if (jA < ntiles) attn_load(kp, vp, stride, rq, c4, kA, vA);
      compute(jc);
    }
    if (jB >= ntiles) break;
    __syncthreads();
    attn_stage(sK, sVT, rq, c4, kB, vB);
    __syncthreads();
    {
      const int jc = jB;
      jB = nextv(jA + 1, kp, vp, stride);
      if (jB < ntiles) attn_load(kp, vp, stride, rq, c4, kB, vB);
      compute(jc);
    }
  }
  const float l = lsum + __shfl_xor(lsum, 32);
  const float inv = 1.f / l;
#pragma unroll
  for (int d = 0; d < 2; ++d)
#pragma unroll
    for (int g = 0; g < 4; ++g) {
      uint2 pk = {pack2(O[d][4 * g + 0] * inv, O[d][4 * g + 1] * inv), pack2(O[d][4 * g + 2] * inv, O[d][4 * g + 3] * inv)};
      *(uint2*)(obase + (size_t)ql * DM + d * 32 + 8 * g + 4 * h) = pk;
    }
}

DI void phase0(const Params& p, char* smem) {
  const int tid = otid();
  if (blockIdx.x == 0) {
    for (int idx = tid; idx < 1024; idx += 256) {
      const int pos = idx >> 4, j = idx & 15;
      const double inv = 1.0 / pow(10000.0, (double)j / 16.0);
      const float ang = (float)((double)pos * inv);
      p.ROPE[idx] = cosf(ang);
      p.ROPE[1024 + idx] = sinf(ang);
    }
  }
  float* scond = (float*)smem;
  for (int item = blockIdx.x; item < 768; item += gridDim.x) {
    const int l = item / 384, ks = (item / 24) % 16, jb = item % 24;
    __syncthreads();
    for (int idx = tid; idx < 320; idx += 256) {
      const int c = idx / 64, k = ks * 64 + (idx & 63);
      const float v = (c == 0) ? p.c_ctx[k] : p.c[(c - 1) * DM + k];
      scond[idx] = silu(v);
    }
    __syncthreads();
    const int j = jb * 256 + tid;
    const float* wp = p.w_ada + ((size_t)l * DM + ks * 64) * 6144 + j;
    float a[5] = {0.f, 0.f, 0.f, 0.f, 0.f};
#pragma unroll 8
    for (int k = 0; k < 64; ++k) {
      const float wv = wp[(size_t)k * 6144];
#pragma unroll
      for (int c = 0; c < 5; ++c) a[c] += scond[c * 64 + k] * wv;
    }
    const float bias = (ks == 0) ? p.b_ada[l * 6144 + j] : 0.f;
#pragma unroll
    for (int c = 0; c < 5; ++c) unsafeAtomicAdd(&p.MOD[(l * 5 + c) * 6144 + j], a[c] + bias);
  }
}

DI int cond_of(int T) { return T < NCTX ? 0 : 1 + ((T - NCTX) >> 11); }

DI void cvt_f32_bf16(const float* s, u16* d, int n4, int gtid, int gsz) {
  for (int i = gtid; i < n4; i += gsz) {
    const float4 x = *(const float4*)(s + (size_t)i * 4);
    uint2 pk = {pack2(x.x, x.y), pack2(x.z, x.w)};
    *(uint2*)(d + (size_t)i * 4) = pk;
  }
}
DI void phase0b(const Params& p) {
  const int tid = otid(), lane = tid & 63, w = tid >> 6;
  {
    const int gtid = blockIdx.x * 256 + tid, gsz = gridDim.x * 256;
    cvt_f32_bf16(p.cak, p.CAK, 4 * 2 * 512 * 128 / 4, gtid, gsz);
    cvt_f32_bf16(p.cav, p.CAV, 4 * 2 * 512 * 128 / 4, gtid, gsz);
    cvt_f32_bf16(p.cbk, p.CBK, 4 * 2 * 512 * 256 / 4, gtid, gsz);
    cvt_f32_bf16(p.cbv, p.CBV, 4 * 2 * 512 * 256 / 4, gtid, gsz);
  }
  for (int T = blockIdx.x * 4 + w; T < NTOK; T += gridDim.x * 4) {
    const float* mod = p.MOD + (size_t)cond_of(T) * 6144;
    const float* xr = (T < NCTX) ? (p.x_prompt + (size_t)T * DM) : (p.x_sample + (size_t)(T - NCTX) * DM);
#pragma unroll
    for (int i = 0; i < 4; ++i) {
      const int k = 256 * i + 4 * lane;
      const float4 x = *(const float4*)(xr + k);
      const float4 sc = *(const float4*)(mod + 1024 + k), sh = *(const float4*)(mod + k);
      uint2 pk = {pack2(x.x * (1.f + sc.x) + sh.x, x.y * (1.f + sc.y) + sh.y), pack2(x.z * (1.f + sc.z) + sh.z, x.w * (1.f + sc.w) + sh.w)};
      *(uint2*)(p.H2 + (size_t)T * DM + k) = pk;
    }
  }
}

DI void phase1(const Params& p, char* smem, int l) {
  const float* W = p.w_in + (size_t)l * DM * DIN;
  const int xcd = blockIdx.x & 7, nloc = gridDim.x >> 3;
  auto setup = [&](int s, int ar0, int ac, int n4, int kq, const u16*& q0, const u16*& q1, const u16*& q2, const u16*& q3, const float*& bp) {
    const int tm = 6 * xcd + s % 6, tn = s / 6;
    const u16* ab = p.H2 + ((size_t)tm * 256 + ar0) * DM + ac;
    q0 = ab; q1 = ab + 64 * DM; q2 = ab + 128 * DM; q3 = ab + 192 * DM;
    bp = W + tn * 128 + 4 * n4 + (size_t)(kq * 4) * DIN;
  };
  auto epi = [&](int s, f32x16(&acc)[2][4], int w, int r, int h) {
    int hq = h;
    asm volatile("" : "+v"(hq));
    const int tm = 6 * xcd + s % 6, tn = s / 6;
    const int m0 = tm * 256, n0 = tn * 128;
    const bool lat = m0 >= NCTX;
    const bool rope = lat && (n0 < 640);
    const int n = n0 + 4 * r;
    const int q = (r >> 2) & 3;
#pragma unroll
    for (int mt = 0; mt < 2; ++mt)
#pragma unroll
    for (int i = 0; i < 16; ++i) {
      const int T = m0 + w * 64 + mt * 32 + crow(i, hq);
      float v0 = acc[mt][0][i], v1 = acc[mt][1][i], v2 = acc[mt][2][i], v3 = acc[mt][3][i];
      if (rope) {
        const int t = (T - NCTX) & 2047;
        const int pos = (q < 2) ? (t >> 6) : (t & 63);
        const int jf = 4 * (r & 3);
        const float4 cs = *(const float4*)(p.ROPE + pos * 16 + jf), sn = *(const float4*)(p.ROPE + 1024 + pos * 16 + jf);
        const float o0 = __shfl_xor(v0, 4), o1 = __shfl_xor(v1, 4), o2 = __shfl_xor(v2, 4), o3 = __shfl_xor(v3, 4);
        if (q & 1) { v0 = o0 * sn.x + v0 * cs.x; v1 = o1 * sn.y + v1 * cs.y; v2 = o2 * sn.z + v2 * cs.z; v3 = o3 * sn.w + v3 * cs.w; }
        else { v0 = v0 * cs.x - o0 * sn.x; v1 = v1 * cs.y - o1 * sn.y; v2 = v2 * cs.z - o2 * sn.z; v3 = v3 * cs.w - o3 * sn.w; }
      }
      uint2 pk = {pack2(v0, v1), pack2(v2, v3)};
      *(uint2*)(p.QKV + (size_t)T * DIN + n) = pk;
      if (!lat) {
        const int b = T >> 8, t = T & 255;
        const float4 vv = {v0, v1, v2, v3};
        if (n0 == 512) *(float4*)(p.out + OFF_AK + ((size_t)(b * 2 + l) * 256 + t) * 128 + (n - 512)) = vv;
        else if (n0 == 640) *(float4*)(p.out + OFF_AV + ((size_t)(b * 2 + l) * 256 + t) * 128 + (n - 640)) = vv;
        else if (n0 == 1024 || n0 == 1152) *(float4*)(p.out + OFF_BK + ((size_t)(b * 2 + l) * 256 + t) * 256 + (n - 1024)) = vv;
        else if (n0 == 1280 || n0 == 1408) *(float4*)(p.out + OFF_BV + ((size_t)(b * 2 + l) * 256 + t) * 256 + (n - 1280)) = vv;
      }
      if ((i & 3) == 3) __builtin_amdgcn_sched_barrier(0);
    }
  };
  gemm_phase<true>(smem, blockIdx.x >> 3, 120, nloc, setup, DIN, epi);
}

DI float ret_lg(const Params& p, int l, int dir, int head) { return -__expf(p.decay[(l * 2 + dir) * 4 + head]); }

DI size_t kvs_slot(int req, int head, int dir, int c) { return ((size_t)((req * 4 + head) * 2 + dir) * 16 + c) * 4096; }

DI void retkv_item(const Params& p, char* smem, int l, int req, int head, int c) {
  u16* sKTf = (u16*)smem;
  u16* sKTb = sKTf + 64 * LDT2;
  u16* sVT = sKTb + 64 * LDT2;
  const int tid = otid(), lane = tid & 63, w = tid >> 6, r = lane & 31, h = lane >> 5;
  const int rq = tid >> 4, c4 = tid & 15;
  const int T0 = (req < 16 ? req * 256 : NCTX + (req - 16) * 2048) + c * 128;
  const float lgf = ret_lg(p, l, 0, head), lgb = ret_lg(p, l, 1, head);
  const float one4[4] = {1.f, 1.f, 1.f, 1.f};
  __syncthreads();
#pragma unroll
  for (int half = 0; half < 2; ++half) {
    float v[4][4];
    float sf[4], sb[4];
#pragma unroll
    for (int i = 0; i < 4; ++i) {
      const int j = half * 64 + 4 * rq + i;
      sf[i] = 0.125f * __expf(lgf * (float)(127 - j));
      sb[i] = 0.125f * __expf(lgb * (float)j);
    }
    load4x4(p.QKV + (size_t)(T0 + half * 64) * DIN + 1792 + head * 64, DIN, false, rq, c4, v);
    store_t(sKTf, LDT2, half * 64, rq, c4, v, sf);
    store_t(sKTb, LDT2, half * 64, rq, c4, v, sb);
    load4x4(p.QKV + (size_t)(T0 + half * 64) * DIN + 2048 + head * 64, DIN, false, rq, c4, v);
    store_t(sVT, LDT2, half * 64, rq, c4, v, one4);
  }
  __syncthreads();
  const int dir = w >> 1, mt = w & 1;
  const u16* sKT = dir ? sKTb : sKTf;
  f32x16 acc[2];
#pragma unroll
  for (int nt = 0; nt < 2; ++nt)
#pragma unroll
    for (int i = 0; i < 16; ++i) acc[nt][i] = 0.f;
#pragma unroll
  for (int ks = 0; ks < 8; ++ks) {
    const bf16x8 fa = *(const bf16x8*)&sKT[(mt * 32 + r) * LDT2 + ks * 16 + 8 * h];
#pragma unroll
    for (int nt = 0; nt < 2; ++nt) {
      const bf16x8 fb = *(const bf16x8*)&sVT[(nt * 32 + r) * LDT2 + ks * 16 + 8 * h];
      acc[nt] = MFMA(fa, fb, acc[nt]);
    }
  }
  float* dst = p.KVS + kvs_slot(req, head, dir, c);
#pragma unroll
  for (int nt = 0; nt < 2; ++nt)
#pragma unroll
    for (int i = 0; i < 16; ++i) dst[(mt * 32 + crow(i, h)) * 64 + nt * 32 + r] = acc[nt][i];
}

DI void phase2(const Params& p, char* smem, int l) {
  const int tid = otid();
  for (int item = blockIdx.x; item < 1536; item += gridDim.x) {
    if (item < 512) {
      const int b = item >> 7, head = (item >> 4) & 7, qb = item & 15, kvh = head >> 2;
      const int T0 = NCTX + b * 2048 + qb * 128;
      const u16* ck = p.CAK + ((size_t)(b * 2 + l) * 512) * 128 + kvh * 64;
      const u16* cv = p.CAV + ((size_t)(b * 2 + l) * 512) * 128 + kvh * 64;
      auto src = [&](int j, const u16*& kp, const u16*& vp, int& stride) -> bool {
        if (j < 8) {
          kp = ck + (size_t)j * 64 * 128; vp = cv + (size_t)j * 64 * 128; stride = 128;
          return true;
        }
        const int jj = j - 8, kb = qb - 1 + (jj >> 1);
        if (kb < 0 || kb >= 16) return false;
        const int Tk = NCTX + b * 2048 + kb * 128 + (jj & 1) * 64;
        kp = p.QKV + (size_t)Tk * DIN + 512 + kvh * 64; vp = p.QKV + (size_t)Tk * DIN + 640 + kvh * 64; stride = DIN;
        return true;
      };
      auto biasf = [&](int j, int key, int ql) -> float {
        if (j < 8) return 0.f;
        const int jj = j - 8;
        const int kj = (qb - 1 + (jj >> 1)) * 128 + (jj & 1) * 64 + key;
        const int qi = qb * 128 + ql;
        const int d = qi - kj;
        return (d <= 128 && d >= -128) ? 0.f : NEG;
      };
      auto tmode = [&](int j, int w) -> int {
        if (j < 8) return 0;
        const int jj = j - 8;
        const int k0 = (qb - 1 + (jj >> 1)) * 128 + (jj & 1) * 64, q0w = qb * 128 + w * 32;
        if (k0 - (q0w + 31) > 128 || q0w - (k0 + 63) > 128) return 2;
        if ((q0w + 31) - k0 <= 128 && (k0 + 63) - q0w <= 128) return 0;
        return 1;
      };
      attn_core(smem, p.QKV + (size_t)T0 * DIN + head * 64, 14, src, biasf, tmode, p.sink[l * 8 + head] * 1.44269504f, true,
                p.CAT + (size_t)T0 * DM + head * 64);
    } else if (item < 768) {
      const int it = item - 512;
      const int b = it >> 6, head = (it >> 4) & 3, qb = it & 15;
      const int T0 = NCTX + b * 2048 + qb * 128;
      float* srpb = (float*)(smem + 2 * 64 * LDT * 2);
      __syncthreads();
      for (int idx = tid; idx < 465; idx += 256) srpb[idx] = p.rpb[(size_t)(l * 4 + head) * 465 + idx] * 1.44269504f;
      const int r0 = 2 * qb;
      const int rmin = min(max(r0 - 4, 0), 24), rmax = min(max(r0 + 1 - 4, 0), 24) + 7;
      const u16* ck = p.CBK + ((size_t)(b * 2 + l) * 512) * 256 + head * 64;
      const u16* cv = p.CBV + ((size_t)(b * 2 + l) * 512) * 256 + head * 64;
      auto src = [&](int j, const u16*& kp, const u16*& vp, int& stride) -> bool {
        if (j < 8) {
          kp = ck + (size_t)j * 64 * 256; vp = cv + (size_t)j * 64 * 256; stride = 256;
          return true;
        }
        const int Tk = NCTX + b * 2048 + (rmin + j - 8) * 64;
        kp = p.QKV + (size_t)Tk * DIN + 1024 + head * 64; vp = p.QKV + (size_t)Tk * DIN + 1280 + head * 64; stride = DIN;
        return true;
      };
      auto biasf = [&](int j, int key, int ql) -> float {
        if (j < 8) return 0.f;
        const int kr = rmin + j - 8, kc = key;
        const int qr = r0 + (ql >> 6), qc = ql & 63;
        const int rs = min(max(qr - 4, 0), 24), cs = min(max(qc - 8, 0), 48);
        const bool ok = (kr >= rs) && (kr < rs + 8) && (kc >= cs) && (kc < cs + 16);
        const int bi = ok ? ((kr - qr + 7) * 31 + (kc - qc + 15)) : 0;
        const float bv = srpb[bi];
        return ok ? bv : NEG;
      };
      auto tmode = [&](int j, int w) -> int {
        if (j < 8) return 0;
        const int kr = rmin + j - 8, qr = r0 + (w >> 1);
        const int rs = min(max(qr - 4, 0), 24);
        return (kr >= rs && kr < rs + 8) ? 1 : 2;
      };
      attn_core(smem, p.QKV + (size_t)T0 * DIN + 768 + head * 64, 8 + (rmax - rmin + 1), src, biasf, tmode, NEG, false,
                p.CAT + (size_t)T0 * DM + 512 + head * 64);
    } else if (item < 1152) {
      const int it = item - 768;
      if (it < 256) retkv_item(p, smem, l, 16 + (it >> 6), (it >> 4) & 3, it & 15);
      else { const int i2 = it - 256; retkv_item(p, smem, l, i2 >> 3, (i2 >> 1) & 3, i2 & 1); }
    } else if (item < 1408) {
      const int it = item - 1152;
      const int b = it >> 4, head = (it >> 1) & 7, qh = it & 1, kvh = head >> 2;
      const int T0 = b * 256 + qh * 128;
      auto src = [&](int j, const u16*& kp, const u16*& vp, int& stride) -> bool {
        const int Tk = b * 256 + j * 64;
        kp = p.QKV + (size_t)Tk * DIN + 512 + kvh * 64; vp = p.QKV + (size_t)Tk * DIN + 640 + kvh * 64; stride = DIN;
        return true;
      };
      auto biasf = [&](int, int, int) -> float { return 0.f; };
      auto tmode = [&](int, int) -> int { return 0; };
      attn_core(smem, p.QKV + (size_t)T0 * DIN + head * 64, 4, src, biasf, tmode, p.sink[l * 8 + head] * 1.44269504f, true,
                p.CAT + (size_t)T0 * DM + head * 64);
    } else {
      const int it = item - 1408;
      const int b = it >> 3, head = (it >> 1) & 3, qh = it & 1;
      const int T0 = b * 256 + qh * 128;
      auto src = [&](int j, const u16*& kp, const u16*& vp, int& stride) -> bool {
        const int Tk = b * 256 + j * 64;
        kp = p.QKV + (size_t)Tk * DIN + 1024 + head * 64; vp = p.QKV + (size_t)Tk * DIN + 1280 + head * 64; stride = DIN;
        return true;
      };
      auto biasf = [&](int, int, int) -> float { return 0.f; };
      auto tmode = [&](int, int) -> int { return 0; };
      attn_core(smem, p.QKV + (size_t)T0 * DIN + 768 + head * 64, 4, src, biasf, tmode, NEG, false,
                p.CAT + (size_t)T0 * DM + 512 + head * 64);
    }
  }
}

DI void phase2c(const Params& p, char* smem, int l) {
  u16* sK = (u16*)smem;
  u16* sVT = sK + 128 * LDT;
  u16* sSTf = sVT + 64 * LDT2;
  u16* sSTb = sSTf + 64 * LDT;
  const int tid = otid(), lane = tid & 63, w = tid >> 6, r = lane & 31, h = lane >> 5;
  const int rq = tid >> 4, c4 = tid & 15;
  const float one4[4] = {1.f, 1.f, 1.f, 1.f};
  for (int item = blockIdx.x; item < 384; item += gridDim.x) {
    int req, head, c, nc;
    if (item < 256) { req = 16 + (item >> 6); head = (item >> 4) & 3; c = item & 15; nc = 16; }
    else { const int i2 = item - 256; req = i2 >> 3; head = (i2 >> 1) & 3; c = i2 & 1; nc = 2; }
    const bool lat = req >= 16;
    const int T0 = (lat ? NCTX + (req - 16) * 2048 : req * 256) + c * 128;
    const float lgf = ret_lg(p, l, 0, head), lgb = ret_lg(p, l, 1, head);
    const float gf = __expf(lgf * 128.f), gb = __expf(lgb * 128.f);
    __syncthreads();
    {
      const int d = tid >> 2, e0 = (tid & 3) * 16;
#pragma unroll
      for (int dir = 0; dir < 2; ++dir) {
        float s[16];
#pragma unroll
        for (int q = 0; q < 16; ++q) s[q] = 0.f;
        const float g = dir ? gb : gf;
        if (lat) {
          const float* s0 = p.state + ((size_t)(((req - 16) * 2 + l) * 2 + dir) * 4 + head) * 4096 + d * 64 + e0;
#pragma unroll
          for (int q = 0; q < 16; q += 4) {
            const float4 x = *(const float4*)(s0 + q);
            s[q] = x.x; s[q + 1] = x.y; s[q + 2] = x.z; s[q + 3] = x.w;
          }
        }
        const int nsteps = dir ? (nc - 1 - c) : c;
        for (int st = 0; st < nsteps; ++st) {
          const int cc = dir ? (nc - 1 - st) : st;
          const float* kv = p.KVS + kvs_slot(req, head, dir, cc) + d * 64 + e0;
#pragma unroll
          for (int q = 0; q < 16; q += 4) {
            const float4 x = *(const float4*)(kv + q);
            s[q] = s[q] * g + x.x; s[q + 1] = s[q + 1] * g + x.y; s[q + 2] = s[q + 2] * g + x.z; s[q + 3] = s[q + 3] * g + x.w;
          }
        }
        u16* sST = dir ? sSTb : sSTf;
#pragma unroll
        for (int q = 0; q < 16; ++q) sST[(e0 + q) * LDT + d] = (u16)(pack2(s[q], 0.f) & 0xffffu);
        if (!lat && c == 0) {
          const float* k0 = p.KVS + kvs_slot(req, head, dir, 0) + d * 64 + e0;
          const float* k1 = p.KVS + kvs_slot(req, head, dir, 1) + d * 64 + e0;
          float* o = p.out + OFF_ST + ((size_t)((req * 2 + l) * 2 + dir) * 4 + head) * 4096 + d * 64 + e0;
#pragma unroll
          for (int q = 0; q < 16; ++q) o[q] = dir ? (gb * k1[q] + k0[q]) : (gf * k0[q] + k1[q]);
        }
      }
    }
#pragma unroll
    for (int half = 0; half < 2; ++half) {
      float v[4][4];
      load4x4(p.QKV + (size_t)(T0 + half * 64) * DIN + 1792 + head * 64, DIN, false, rq, c4, v);
      store_n(sK, LDT, half * 64, rq, c4, v);
      load4x4(p.QKV + (size_t)(T0 + half * 64) * DIN + 2048 + head * 64, DIN, false, rq, c4, v);
      store_t(sVT, LDT2, half * 64, rq, c4, v, one4);
    }
    __syncthreads();
    const int qi = w * 32 + r;
    const u16* qrow = p.QKV + (size_t)(T0 + qi) * DIN + 1536 + head * 64;
    uint4 qraw[4];
#pragma unroll
    for (int ks = 0; ks < 4; ++ks) qraw[ks] = *(const uint4*)(qrow + ks * 16 + 8 * h);
    f32x16 O[2];
#pragma unroll
    for (int d = 0; d < 2; ++d)
#pragma unroll
      for (int i = 0; i < 16; ++i) O[d][i] = 0.f;
#pragma unroll 1
    for (int jt = 0; jt < 4; ++jt) {
      f32x16 S;
#pragma unroll
      for (int i = 0; i < 16; ++i) S[i] = 0.f;
#pragma unroll
      for (int ks = 0; ks < 4; ++ks) {
        const bf16x8 kf = *(const bf16x8*)&sK[(jt * 32 + r) * LDT + ks * 16 + 8 * h];
        S = MFMA(kf, __builtin_bit_cast(bf16x8, qraw[ks]), S);
      }
#pragma unroll
      for (int i = 0; i < 16; ++i) {
        const int j = jt * 32 + crow(i, h);
        const int dlt = qi - j;
        const float wgt = (dlt > 0) ? __expf(lgf * (float)dlt) : ((dlt < 0) ? __expf(lgb * (float)(-dlt)) : 2.f);
        S[i] = S[i] * 0.125f * wgt;
      }
#pragma unroll
      for (int s = 0; s < 2; ++s) {
        const bf16x8 pf = mk8(pack2(S[8 * s + 0], S[8 * s + 1]), pack2(S[8 * s + 2], S[8 * s + 3]),
                              pack2(S[8 * s + 4], S[8 * s + 5]), pack2(S[8 * s + 6], S[8 * s + 7]));
#pragma unroll
        for (int d = 0; d < 2; ++d) {
          const u16* vrow = &sVT[(d * 32 + r) * LDT2 + jt * 32 + 16 * s + 4 * h];
          const uint2 lo = *(const uint2*)vrow;
          const uint2 hi = *(const uint2*)(vrow + 8);
          O[d] = MFMA(mk8(lo.x, lo.y, hi.x, hi.y), pf, O[d]);
        }
      }
    }
    {
      const float xf = __expf(lgf * (float)(qi + 1)), xb = __expf(lgb * (float)(128 - qi));
#pragma unroll
      for (int ks = 0; ks < 4; ++ks) {
        const uint4 q = qraw[ks];
        const bf16x8 qsf = mk8(pack2(bflo(q.x) * xf, bfhi(q.x) * xf), pack2(bflo(q.y) * xf, bfhi(q.y) * xf),
                               pack2(bflo(q.z) * xf, bfhi(q.z) * xf), pack2(bflo(q.w) * xf, bfhi(q.w) * xf));
        const bf16x8 qsb = mk8(pack2(bflo(q.x) * xb, bfhi(q.x) * xb), pack2(bflo(q.y) * xb, bfhi(q.y) * xb),
                               pack2(bflo(q.z) * xb, bfhi(q.z) * xb), pack2(bflo(q.w) * xb, bfhi(q.w) * xb));
#pragma unroll
        for (int d = 0; d < 2; ++d) {
          const bf16x8 sf = *(const bf16x8*)&sSTf[(d * 32 + r) * LDT + ks * 16 + 8 * h];
          const bf16x8 sb = *(const bf16x8*)&sSTb[(d * 32 + r) * LDT + ks * 16 + 8 * h];
          O[d] = MFMA(sf, qsf, O[d]);
          O[d] = MFMA(sb, qsb, O[d]);
        }
      }
    }
    float sum = 0.f;
#pragma unroll
    for (int d = 0; d < 2; ++d)
#pragma unroll
      for (int i = 0; i < 16; ++i) sum += O[d][i];
    sum += __shfl_xor(sum, 32);
    const float mu = sum * (1.f / 64.f);
    float vs = 0.f;
#pragma unroll
    for (int d = 0; d < 2; ++d)
#pragma unroll
      for (int i = 0; i < 16; ++i) { const float t = O[d][i] - mu; vs += t * t; }
    vs += __shfl_xor(vs, 32);
    const float rstd = rsqrtf(vs * (1.f / 64.f) + 1e-6f);
    const u16* grow = p.QKV + (size_t)(T0 + qi) * DIN + 2304 + head * 64;
    const float* gnw = p.gn + l * 256 + head * 64;
    u16* orow = p.CAT + (size_t)(T0 + qi) * DM + 768 + head * 64;
#pragma unroll
    for (int d = 0; d < 2; ++d)
#pragma unroll
      for (int g = 0; g < 4; ++g) {
        const int e = d * 32 + 8 * g + 4 * h;
        const uint2 gr = *(const uint2*)(grow + e);
        const float4 gw = *(const float4*)(gnw + e);
        const float o0 = silu(bflo(gr.x)) * (O[d][4 * g + 0] - mu) * rstd * gw.x;
        const float o1 = silu(bfhi(gr.x)) * (O[d][4 * g + 1] - mu) * rstd * gw.y;
        const float o2 = silu(bflo(gr.y)) * (O[d][4 * g + 2] - mu) * rstd * gw.z;
        const float o3 = silu(bfhi(gr.y)) * (O[d][4 * g + 3] - mu) * rstd * gw.w;
        uint2 pk = {pack2(o0, o1), pack2(o2, o3)};
        *(uint2*)(orow + e) = pk;
      }
  }
}

DI void phase3(const Params& p, char* smem, int l, const float* xc, const float* xl) {
  const float* W = p.w_out + (size_t)l * DM * DM;
  u16* PREB = (u16*)p.PRE;
  const int xcd = blockIdx.x & 7, nloc = gridDim.x >> 3;
  auto setup = [&](int s, int ar0, int ac, int n4, int kq, const u16*& q0, const u16*& q1, const u16*& q2, const u16*& q3, const float*& bp) {
    const int tm = 6 * xcd + s % 6, tn = s / 6;
    const u16* ab = p.CAT + ((size_t)tm * 256 + ar0) * DM + ac;
    q0 = ab; q1 = ab + 64 * DM; q2 = ab + 128 * DM; q3 = ab + 192 * DM;
    bp = W + tn * 128 + 4 * n4 + (size_t)(kq * 4) * DM;
  };
  auto epi = [&](int s, f32x16(&acc)[2][4], int w, int r, int h) {
    int hq = h;
    asm volatile("" : "+v"(hq));
    const int tm = 6 * xcd + s % 6, tn = s / 6;
    const int m0 = tm * 256, n0 = tn * 128;
    const float* g1 = p.MOD + (size_t)(l * 5 + cond_of(m0)) * 6144 + 2048 + n0 + 4 * r;
    const float g0 = g1[0], g1v = g1[1], g2 = g1[2], g3 = g1[3];
#pragma unroll
    for (int mt = 0; mt < 2; ++mt)
#pragma unroll
    for (int i = 0; i < 16; ++i) {
      const int ml = w * 64 + mt * 32 + crow(i, hq);
      uint2 pk = {pack2(g0 * acc[mt][0][i], g1v * acc[mt][1][i]), pack2(g2 * acc[mt][2][i], g3 * acc[mt][3][i])};
      *(uint2*)(PREB + (size_t)(m0 + ml) * DM + n0 + 4 * r) = pk;
      if ((i & 3) == 3) __builtin_amdgcn_sched_barrier(0);
    }
  };
  gemm_phase<true>(smem, blockIdx.x >> 3, 48, nloc, setup, DM, epi);
}

DI void phase4(const Params& p, char* smem, int l, const float* xc, const float* xl) {
  float* swr = (float*)smem;
  const int tid = otid(), lane = tid & 63, w = tid >> 6;
  __syncthreads();
  for (int idx = tid; idx < 4096; idx += 256) {
    const float4 x = *(const float4*)(p.w_router + (size_t)l * DM * 16 + idx * 4);
    const int k = idx >> 2, e = (idx & 3) * 4;
    swr[(e + 0) * DM + k] = x.x; swr[(e + 1) * DM + k] = x.y; swr[(e + 2) * DM + k] = x.z; swr[(e + 3) * DM + k] = x.w;
  }
  __syncthreads();
  const float* lg = p.ln1g + l * DM;
  const float* lb = p.ln1b + l * DM;
  for (int T = blockIdx.x * 4 + w; T < NTOK; T += gridDim.x * 4) {
    const float* mod = p.MOD + (size_t)(l * 5 + cond_of(T)) * 6144;
    const float* xrow = (T < NCTX) ? (xc + (size_t)T * DM) : (xl + (size_t)(T - NCTX) * DM);
    float4 x[4];
    float s = 0.f;
#pragma unroll
    for (int i = 0; i < 4; ++i) {
      const uint2 prb = *(const uint2*)((const u16*)p.PRE + (size_t)T * DM + 256 * i + 4 * lane);
      const float4 pr = {bflo(prb.x), bfhi(prb.x), bflo(prb.y), bfhi(prb.y)};
      const float4 xi = *(const float4*)(xrow + 256 * i + 4 * lane);
      x[i].x = ALPHA * xi.x + pr.x; x[i].y = ALPHA * xi.y + pr.y; x[i].z = ALPHA * xi.z + pr.z; x[i].w = ALPHA * xi.w + pr.w;
      s += x[i].x + x[i].y + x[i].z + x[i].w;
    }
    const float mu = wave_sum(s) * (1.f / 1024.f);
    float vs = 0.f;
#pragma unroll
    for (int i = 0; i < 4; ++i) {
      x[i].x -= mu; x[i].y -= mu; x[i].z -= mu; x[i].w -= mu;
      vs += x[i].x * x[i].x + x[i].y * x[i].y + x[i].z * x[i].z + x[i].w * x[i].w;
    }
    const float rstd = rsqrtf(wave_sum(vs) * (1.f / 1024.f) + 1e-6f);
#pragma unroll
    for (int i = 0; i < 4; ++i) {
      const int k = 256 * i + 4 * lane;
      const float4 g = *(const float4*)(lg + k), bb = *(const float4*)(lb + k);
      float4 y;
      y.x = x[i].x * rstd * g.x + bb.x; y.y = x[i].y * rstd * g.y + bb.y; y.z = x[i].z * rstd * g.z + bb.z; y.w = x[i].w * rstd * g.w + bb.w;
      *(float4*)(p.X + (size_t)T * DM + k) = y;
      const float4 sc = *(const float4*)(mod + 4096 + k), sh = *(const float4*)(mod + 3072 + k);
      float4 hh;
      hh.x = y.x * (1.f + sc.x) + sh.x; hh.y = y.y * (1.f + sc.y) + sh.y; hh.z = y.z * (1.f + sc.z) + sh.z; hh.w = y.w * (1.f + sc.w) + sh.w;
      uint2 pk = {pack2(hh.x, hh.y), pack2(hh.z, hh.w)};
      *(uint2*)(p.H2 + (size_t)T * DM + k) = pk;
      x[i] = hh;
    }
    float a16[16];
#pragma unroll
    for (int e = 0; e < 16; ++e) {
      float a = 0.f;
#pragma unroll
      for (int i = 0; i < 4; ++i) {
        const float4 wv = *(const float4*)(swr + e * DM + 256 * i + 4 * lane);
        a += x[i].x * wv.x + x[i].y * wv.y + x[i].z * wv.z + x[i].w * wv.w;
      }
      a16[e] = a;
      if ((e & 3) == 3) __builtin_amdgcn_sched_barrier(0);
    }
    float a8[8], a4[4], a2[2], a1;
    {
      const bool hi = (lane & 32) != 0;
#pragma unroll
      for (int j = 0; j < 8; ++j) {
        const float snd = hi ? a16[j] : a16[8 + j];
        const float kp = hi ? a16[8 + j] : a16[j];
        a8[j] = kp + __shfl_xor(snd, 32);
      }
    }
    {
      const bool hi = (lane & 16) != 0;
#pragma unroll
      for (int j = 0; j < 4; ++j) {
        const float snd = hi ? a8[j] : a8[4 + j];
        const float kp = hi ? a8[4 + j] : a8[j];
        a4[j] = kp + __shfl_xor(snd, 16);
      }
    }
    {
      const bool hi = (lane & 8) != 0;
#pragma unroll
      for (int j = 0; j < 2; ++j) {
        const float snd = hi ? a4[j] : a4[2 + j];
        const float kp = hi ? a4[2 + j] : a4[j];
        a2[j] = kp + __shfl_xor(snd, 8);
      }
    }
    {
      const bool hi = (lane & 4) != 0;
      const float snd = hi ? a2[0] : a2[1];
      const float kp = hi ? a2[1] : a2[0];
      a1 = kp + __shfl_xor(snd, 4);
    }
    a1 += __shfl_xor(a1, 2);
    a1 += __shfl_xor(a1, 1);
    const int myexp = ((lane >> 5) & 1) * 8 + ((lane >> 4) & 1) * 4 + ((lane >> 3) & 1) * 2 + ((lane >> 2) & 1);
    float mx = a1;
#pragma unroll
    for (int o = 32; o >= 4; o >>= 1) mx = fmaxf(mx, __shfl_xor(mx, o));
    const float ex = __expf(a1 - mx);
    float den = ex;
#pragma unroll
    for (int o = 32; o >= 4; o >>= 1) den += __shfl_xor(den, o);
    if ((lane & 3) == 0) { p.AFF[(size_t)T * 16 + myexp] = ex / den; p.INV[(size_t)T * 16 + myexp] = -1; }
  }
}

DI unsigned block_incl_scan(unsigned v, unsigned* wsum, int lane, int w, unsigned& total) {
#pragma unroll
  for (int o = 1; o < 64; o <<= 1) {
    const unsigned t = __shfl_up(v, o);
    if (lane >= o) v += t;
  }
  __syncthreads();
  if (lane == 63) wsum[w] = v;
  __syncthreads();
  unsigned off = 0;
  total = 0;
#pragma unroll
  for (int i = 0; i < 4; ++i) {
    const unsigned s = wsum[i];
    if (i < w) off += s;
    total += s;
  }
  return v + off;
}

DI void phase5(const Params& p, char* smem) {
  unsigned* hist = (unsigned*)smem;
  unsigned* wsum = hist + 256;
  unsigned* bc = wsum + 4;
  const int tid = otid(), lane = tid & 63, w = tid >> 6;
  for (int item = blockIdx.x; item < 320; item += gridDim.x) {
    int n, base, e, cap, rowbase;
    if (item < 64) {
      const int b = item >> 4; e = item & 15;
      n = 2048; base = NCTX + b * 2048; cap = 256; rowbase = 512 + b * 256;
    } else {
      const int it = item - 64; const int rq = it >> 4; e = it & 15;
      n = 256; base = rq * 256; cap = 32; rowbase = rq * 32;
    }
    const int per = n >> 8;
    unsigned key[8];
#pragma unroll
    for (int q = 0; q < 8; ++q) key[q] = (q < per) ? __float_as_uint(p.AFF[(size_t)(base + tid * per + q) * 16 + e]) : 0u;
    unsigned prefix = 0u, mask = 0u;
    unsigned remaining = (unsigned)cap;
#pragma unroll 1
    for (int pass = 3; pass >= 0; --pass) {
      const int shift = pass * 8;
      __syncthreads();
      hist[tid] = 0u;
      __syncthreads();
#pragma unroll
      for (int q = 0; q < 8; ++q)
        if (q < per && (key[q] & mask) == prefix) atomicAdd(&hist[(key[q] >> shift) & 255u], 1u);
      __syncthreads();
      const unsigned hv = hist[tid];
      unsigned total;
      const unsigned incl = block_incl_scan(hv, wsum, lane, w, total);
      const unsigned above = total - incl;
      if (above < remaining && remaining <= above + hv) { bc[0] = (unsigned)tid; bc[1] = remaining - above; }
      __syncthreads();
      const unsigned bsel = bc[0];
      remaining = bc[1];
      prefix |= bsel << shift;
      mask |= 0xFFu << shift;
    }
    const unsigned thr = prefix;
    unsigned ceq = 0u;
#pragma unroll
    for (int q = 0; q < 8; ++q) ceq += (q < per && key[q] == thr) ? 1u : 0u;
    unsigned tot;
    unsigned eq_before = block_incl_scan(ceq, wsum, lane, w, tot) - ceq;
    unsigned selmask = 0u, nsel = 0u;
#pragma unroll
    for (int q = 0; q < 8; ++q) {
      if (q < per) {
        const bool eq = key[q] == thr;
        const bool sel = (key[q] > thr) || (eq && eq_before < remaining);
        eq_before += eq ? 1u : 0u;
        selmask |= sel ? (1u << q) : 0u;
        nsel += sel ? 1u : 0u;
      }
    }
    unsigned row = block_incl_scan(nsel, wsum, lane, w, tot) - nsel;
#pragma unroll
    for (int q = 0; q < 8; ++q) {
      if (q < per && ((selmask >> q) & 1u)) {
        const int tok = base + tid * per + q;
        const int rr = e * NROWS_E + rowbase + (int)row;
        p.SELTOK[rr] = tok;
        p.SELGATE[rr] = __uint_as_float(key[q]);
        p.INV[(size_t)tok * 16 + e] = rr;
        ++row;
      }
    }
  }
}

DI void phase6(const Params& p, char* smem, int l) {
  const int xcd = blockIdx.x & 7, nloc = gridDim.x >> 3;
  auto setup = [&](int s, int ar0, int ac, int n4, int kq, const u16*& q0, const u16*& q1, const u16*& q2, const u16*& q3, const float*& bp) {
    const int e = 2 * xcd + s / 96, rem = s % 96, tn = rem / 6, tm = rem % 6;
    const int* tok = p.SELTOK + e * NROWS_E + tm * 256 + ar0;
    q0 = p.H2 + (size_t)tok[0] * DM + ac; q1 = p.H2 + (size_t)tok[64] * DM + ac;
    q2 = p.H2 + (size_t)tok[128] * DM + ac; q3 = p.H2 + (size_t)tok[192] * DM + ac;
    bp = p.w_gu + ((size_t)l * 16 + e) * DM * 2048 + ((n4 >> 4) & 1) * 1024 + tn * 64 + 4 * (n4 & 15) + (size_t)(kq * 4) * 2048;
  };
  auto epi = [&](int s, f32x16(&acc)[2][4], int w, int r, int h) {
    int hq = h;
    asm volatile("" : "+v"(hq));
    const int e = 2 * xcd + s / 96, rem = s % 96, tn = rem / 6, tm = rem % 6;
    const int m0 = tm * 256, f0 = tn * 64;
    u16* act = p.ACT + ((size_t)e * NROWS_E + m0) * DM;
#pragma unroll
    for (int mt = 0; mt < 2; ++mt)
#pragma unroll
    for (int i = 0; i < 16; ++i) {
      const int ml = w * 64 + mt * 32 + crow(i, hq);
      const float a0 = acc[mt][0][i], a1 = acc[mt][1][i], a2 = acc[mt][2][i], a3 = acc[mt][3][i];
      const bool lo = r < 16;
      const float s0 = lo ? a2 : a0, s1 = lo ? a3 : a1;
      const float r0 = __shfl_xor(s0, 16), r1 = __shfl_xor(s1, 16);
      const float g0 = lo ? a0 : r0, g1 = lo ? a1 : r1;
      const float v0 = lo ? r0 : a2, v1 = lo ? r1 : a3;
      *(unsigned*)(act + (size_t)ml * DM + f0 + 4 * (r & 15) + (lo ? 0 : 2)) = pack2(silu(g0) * v0, silu(g1) * v1);
      if ((i & 3) == 3) __builtin_amdgcn_sched_barrier(0);
    }
  };
  gemm_phase<false>(smem, blockIdx.x >> 3, 192, nloc, setup, 2048, epi);
}

DI void phase7(const Params& p, char* smem, int l, u16* FF) {
  const int xcd = blockIdx.x & 7, nloc = gridDim.x >> 3;
  auto setup = [&](int s, int ar0, int ac, int n4, int kq, const u16*& q0, const u16*& q1, const u16*& q2, const u16*& q3, const float*& bp) {
    const int e = 2 * xcd + s / 48, rem = s % 48, tn = rem / 6, tm = rem % 6;
    const u16* ab = p.ACT + ((size_t)e * NROWS_E + tm * 256 + ar0) * DM + ac;
    q0 = ab; q1 = ab + 64 * DM; q2 = ab + 128 * DM; q3 = ab + 192 * DM;
    bp = p.w_down + ((size_t)l * 16 + e) * DM * DM + tn * 128 + 4 * n4 + (size_t)(kq * 4) * DM;
  };
  auto epi = [&](int s, f32x16(&acc)[2][4], int w, int r, int h) {
    int hq = h;
    asm volatile("" : "+v"(hq));
    const int e = 2 * xcd + s / 48, rem = s % 48, tn = rem / 6, tm = rem % 6;
    const int m0 = tm * 256, n0 = tn * 128;
    const float* gate = p.SELGATE + e * NROWS_E + m0;
#pragma unroll
    for (int mt = 0; mt < 2; ++mt)
#pragma unroll
    for (int i = 0; i < 16; ++i) {
      const int ml = w * 64 + mt * 32 + crow(i, hq);
      const float g = gate[ml];
      uint2 pk = {pack2(g * acc[mt][0][i], g * acc[mt][1][i]), pack2(g * acc[mt][2][i], g * acc[mt][3][i])};
      *(uint2*)(FF + ((size_t)e * NROWS_E + m0 + ml) * DM + n0 + 4 * r) = pk;
      if ((i & 3) == 3) __builtin_amdgcn_sched_barrier(0);
    }
  };
  gemm_phase<true>(smem, blockIdx.x >> 3, 96, nloc, setup, DM, epi);
}

DI void phase8(const Params& p, int l, float* dst, bool write_h) {
  const int tid = otid(), lane = tid & 63, w = tid >> 6;
  const float* lg = p.ln2g + l * DM;
  const float* lb = p.ln2b + l * DM;
  for (int T = blockIdx.x * 4 + w; T < NTOK; T += gridDim.x * 4) {
    const float* g2 = p.MOD + (size_t)(l * 5 + cond_of(T)) * 6144 + 5120;
    const float* modn = p.MOD + (size_t)(5 + cond_of(T)) * 6144;
    float4 x[4], ff[4];
#pragma unroll
    for (int i = 0; i < 4; ++i) ff[i] = make_float4(0.f, 0.f, 0.f, 0.f);
    const int myinv = p.INV[(size_t)T * 16 + (lane & 15)];
#pragma unroll 1
    for (int e = 0; e < 16; ++e) {
      const int row = __shfl(myinv, e);
      if (row >= 0) {
#pragma unroll
        for (int i = 0; i < 4; ++i) {
          const uint2 y = *(const uint2*)(p.YE + (size_t)row * DM + 256 * i + 4 * lane);
          ff[i].x += bflo(y.x); ff[i].y += bfhi(y.x); ff[i].z += bflo(y.y); ff[i].w += bfhi(y.y);
        }
      }
    }
    float s = 0.f;
#pragma unroll
    for (int i = 0; i < 4; ++i) {
      const int k = 256 * i + 4 * lane;
      const float4 a = *(const float4*)(p.X + (size_t)T * DM + k);
      const float4 f = ff[i];
      const float4 g = *(const float4*)(g2 + k);
      x[i].x = ALPHA * a.x + g.x * f.x; x[i].y = ALPHA * a.y + g.y * f.y; x[i].z = ALPHA * a.z + g.z * f.z; x[i].w = ALPHA * a.w + g.w * f.w;
      s += x[i].x + x[i].y + x[i].z + x[i].w;
    }
    const float mu = wave_sum(s) * (1.f / 1024.f);
    float vs = 0.f;
#pragma unroll
    for (int i = 0; i < 4; ++i) {
      x[i].x -= mu; x[i].y -= mu; x[i].z -= mu; x[i].w -= mu;
      vs += x[i].x * x[i].x + x[i].y * x[i].y + x[i].z * x[i].z + x[i].w * x[i].w;
    }
    const float rstd = rsqrtf(wave_sum(vs) * (1.f / 1024.f) + 1e-6f);
#pragma unroll
    for (int i = 0; i < 4; ++i) {
      const int k = 256 * i + 4 * lane;
      const float4 g = *(const float4*)(lg + k), bb = *(const float4*)(lb + k);
      float4 y;
      y.x = x[i].x * rstd * g.x + bb.x; y.y = x[i].y * rstd * g.y + bb.y; y.z = x[i].z * rstd * g.z + bb.z; y.w = x[i].w * rstd * g.w + bb.w;
      *(float4*)(dst + (size_t)T * DM + k) = y;
      if (write_h) {
        const float4 sc = *(const float4*)(modn + 1024 + k), sh = *(const float4*)(modn + k);
        uint2 pk = {pack2(y.x * (1.f + sc.x) + sh.x, y.y * (1.f + sc.y) + sh.y), pack2(y.z * (1.f + sc.z) + sh.z, y.w * (1.f + sc.w) + sh.w)};
        *(uint2*)(p.H2 + (size_t)T * DM + k) = pk;
      }
    }
  }
}

constexpr int kDynLds = 73728;
__global__ void __launch_bounds__(256, 2) mega(Params p) {
  extern __shared__ __attribute__((aligned(16))) char smem[];
  cg::grid_group grid = cg::this_grid();
  if (p.never) grid.sync();
  GBar gb;
  gb.bar = p.BAR; gb.x = xb_xcc_id(); gb.nloc = 0u; gb.nx = 0u;
  if (threadIdx.x == 0) (void)xb_add(&p.BAR[XB_XCNT(gb.x)], 1u);
  phase0(p, smem);
  gbar(gb);
  phase0b(p);
  gbar(gb);
#pragma unroll 1
  for (int l = 0; l < 2; ++l) {
    const float* xc = (l == 0) ? p.x_prompt : p.X;
    const float* xl = (l == 0) ? p.x_sample : (p.X + (size_t)NCTX * DM);
    phase1(p, smem, l);
    gbar(gb);
    if (PROBE == 1) { phase1(p, smem, l); gbar(gb); }
    phase2(p, smem, l);
    gbar(gb);
    if (PROBE == 3) { phase2(p, smem, l); gbar(gb); }
    phase2c(p, smem, l);
    gbar(gb);
    if (PROBE == 3) { phase2c(p, smem, l); gbar(gb); }
    phase3(p, smem, l, xc, xl);
    gbar(gb);
    if (PROBE == 1) { phase3(p, smem, l, xc, xl); gbar(gb); }
    phase4(p, smem, l, xc, xl);
    gbar(gb);
    phase5(p, smem);
    gbar(gb);
    phase6(p, smem, l);
    gbar(gb);
    if (PROBE == 1) { phase6(p, smem, l); gbar(gb); }
    phase7(p, smem, l, p.YE);
    gbar(gb);
    phase8(p, l, (l == 1) ? p.out : p.X, l == 0);
    if (l == 0) gbar(gb);
  }
}

extern "C" void kernel_launch(void* const* d_in, const int* in_sizes, int n_in, void* d_out, int out_size, void* d_ws,
                              size_t ws_size, hipStream_t stream) {
  static int grid_blocks = 0;
  if (!grid_blocks) {
    int dev = 0, cus = 0, per_cu = 0;
    hipGetDevice(&dev);
    hipDeviceGetAttribute(&cus, hipDeviceAttributeMultiprocessorCount, dev);
    hipFuncSetAttribute((const void*)mega, hipFuncAttributeMaxDynamicSharedMemorySize, kDynLds);
    hipOccupancyMaxActiveBlocksPerMultiprocessor(&per_cu, mega, 256, kDynLds);
    if (per_cu > 2) per_cu = 2;
    if (per_cu < 1) per_cu = 1;
    grid_blocks = cus * per_cu;
  }
  Params p{};
  const float** pf = (const float**)&p;
  for (int i = 0; i < 24; ++i) pf[i] = (const float*)d_in[i];
  p.out = (float*)d_out;
  char* ws = (char*)d_ws;
  size_t off = 0;
  auto take = [&](size_t bytes) { char* q = ws + off; off += (bytes + 255) & ~(size_t)255; return q; };
  p.MOD = (float*)take(2 * 5 * 6144 * 4);
  p.BAR = (unsigned*)take(XCD_BAR_WORDS * 4);
  p.ROPE = (float*)take(2048 * 4);
  p.X = (float*)take((size_t)NTOK * DM * 4);
  p.PRE = (float*)take((size_t)NTOK * DM * 4);
  p.KVS = (float*)take((size_t)20 * 4 * 2 * 16 * 4096 * 4);
  p.AFF = (float*)take((size_t)NTOK * 16 * 4);
  p.SELGATE = (float*)take((size_t)16 * NROWS_E * 4);
  p.SELTOK = (int*)take((size_t)16 * NROWS_E * 4);
  p.QKV = (u16*)take((size_t)NTOK * DIN * 2);
  p.CAT = (u16*)take((size_t)NTOK * DM * 2);
  p.H2 = (u16*)take((size_t)NTOK * DM * 2);
  p.ACT = (u16*)take((size_t)16 * NROWS_E * DM * 2);
  p.YE = (u16*)take((size_t)16 * NROWS_E * DM * 2);
  p.INV = (int*)take((size_t)NTOK * 16 * 4);
  p.CAK = (u16*)take((size_t)4 * 2 * 512 * 128 * 2);
  p.CAV = (u16*)take((size_t)4 * 2 * 512 * 128 * 2);
  p.CBK = (u16*)take((size_t)4 * 2 * 512 * 256 * 2);
  p.CBV = (u16*)take((size_t)4 * 2 * 512 * 256 * 2);
  p.never = 0;
  hipMemsetAsync(p.MOD, 0, (size_t)((char*)p.BAR - (char*)p.MOD) + XCD_BAR_WORDS * 4, stream);
  void* args[] = {&p};
  hipError_t e = hipLaunchCooperativeKernel((void*)mega, dim3(grid_blocks), dim3(256), args, kDynLds, stream);
  if (e != hipSuccess) fprintf(stderr, "cooperative launch failed: %s (grid %d)\n", hipGetErrorString(e), grid_blocks);
}
```

```cpp
#include <hip/hip_runtime.h>
#include <hip/hip_cooperative_groups.h>
#include <cstdio>
namespace cg = cooperative_groups;

#define DI __device__ __forceinline__
typedef short bf16x8 __attribute__((ext_vector_type(8)));
typedef float f32x16 __attribute__((ext_vector_type(16)));
typedef __bf16 bf2_t __attribute__((ext_vector_type(2)));
typedef float f2_t __attribute__((ext_vector_type(2)));
typedef unsigned short u16;
typedef unsigned u32x4 __attribute__((ext_vector_type(4)));
typedef float f32x4 __attribute__((ext_vector_type(4)));
typedef float f32x2 __attribute__((ext_vector_type(2)));

#define MFMA(a, b, c) __builtin_amdgcn_mfma_f32_32x32x16_bf16((a), (b), (c), 0, 0, 0)

#define PROBE 0
constexpr int NTOK = 12288;
constexpr int NCTX = 4096;
constexpr int DM = 1024;
constexpr int DIN = 2560;
constexpr int LDT = 72;
constexpr int LDT2 = 136;
constexpr int NROWS_E = 1536;
constexpr float NEG = -1e30f;
constexpr float ALPHA = 1.41421356237f;

constexpr size_t OFF_AK = 12582912, OFF_AV = 13631488, OFF_BK = 14680064, OFF_BV = 16777216, OFF_ST = 18874368;

struct Params {
  const float *x_prompt, *x_sample, *cak, *cav, *cbk, *cbv, *state, *c, *c_ctx, *w_ada, *b_ada, *w_in, *w_out, *sink, *rpb,
      *decay, *gn, *ln1g, *ln1b, *ln2g, *ln2b, *w_router, *w_gu, *w_down;
  float* out;
  float *MOD, *ROPE, *X, *PRE, *KVS, *AFF, *SELGATE;
  int* SELTOK;
  u16 *QKV, *CAT, *H2, *ACT, *CAK, *CAV, *CBK, *CBV;
  u16* YE;
  int* INV;
  unsigned* BAR;
  long never;
};

DI unsigned pack2(float a, float b) {
  f2_t v = {a, b};
  bf2_t r = __builtin_convertvector(v, bf2_t);
  return __builtin_bit_cast(unsigned, r);
}
DI int otid() { int x = threadIdx.x; asm volatile("" : "+v"(x)); return x; }
DI float bflo(unsigned u) { return __uint_as_float(u << 16); }
DI float bfhi(unsigned u) { return __uint_as_float(u & 0xffff0000u); }
DI int crow(int i, int h) { return (i & 3) + 8 * (i >> 2) + 4 * h; }
DI float silu(float x) { return x / (1.f + __expf(-x)); }
DI float wave_sum(float v) {
#pragma unroll
  for (int o = 32; o >= 1; o >>= 1) v += __shfl_xor(v, o);
  return v;
}
DI bf16x8 mk8(unsigned a, unsigned b, unsigned c, unsigned d) {
  uint4 u = {a, b, c, d};
  return __builtin_bit_cast(bf16x8, u);
}


#define XB_TMO 128
#define XB_XCNT(j) (256 + 64 * (j))
#define XB_XSUB(j) (1280 + 64 * (j))
#define XB_XGEN(j) (2304 + 64 * (j))
#define XB_TOP 3328
#define XB_TOPGEN 3392
#define XCD_BAR_WORDS 3456
#define XB_SPIN_CAP (1u << 20)
DI unsigned xb_ld(unsigned* p) { return __hip_atomic_load(p, __ATOMIC_RELAXED, __HIP_MEMORY_SCOPE_AGENT); }
DI unsigned xb_add(unsigned* p, unsigned v) { return __hip_atomic_fetch_add(p, v, __ATOMIC_RELAXED, __HIP_MEMORY_SCOPE_AGENT); }
DI unsigned xb_xcc_id() { return (unsigned)__builtin_amdgcn_s_getreg((3 << 11) | 20) & 0xFu; }
#define XB_SPIN(cond, bar)                                                            \
  do {                                                                                \
    unsigned _sp = 0;                                                                 \
    while (cond) {                                                                    \
      __builtin_amdgcn_s_sleep(1);                                                    \
      if ((++_sp & 255u) == 0u) {                                                     \
        if (xb_ld(&(bar)[XB_TMO])) break;                                             \
        if (_sp > XB_SPIN_CAP) { atomicAdd(&(bar)[XB_TMO], 1u); break; }              \
      }                                                                               \
    }                                                                                 \
  } while (0)
struct GBar { unsigned* bar; unsigned x, nloc, nx; };
DI void gbar_complete(unsigned* bar, unsigned x, unsigned& nloc, unsigned& nx) {
  const unsigned G = gridDim.x;
  unsigned sum, cnt, mine, sp = 0u;
  for (;;) {
    sum = 0u; cnt = 0u; mine = 0u;
#pragma unroll
    for (unsigned j = 0; j < 16; ++j) {
      const unsigned c = xb_ld(&bar[XB_XCNT(j)]);
      sum += c; cnt += (c > 0u) ? 1u : 0u; mine = (j == x) ? c : mine;
    }
    if (sum == G) break;
    __builtin_amdgcn_s_sleep(1);
    if ((++sp & 255u) == 0u) {
      if (xb_ld(&bar[XB_TMO])) break;
      if (sp > XB_SPIN_CAP) { atomicAdd(&bar[XB_TMO], 1u); break; }
    }
  }
  nloc = mine > 0u ? mine : 1u;
  nx = cnt > 0u ? cnt : 1u;
}
DI void gbar(GBar& b) {
  asm volatile("s_waitcnt vmcnt(0)" ::: "memory");
  __syncthreads();
  if (threadIdx.x == 0) {
    unsigned* bar = b.bar;
    __builtin_amdgcn_s_waitcnt(0);
    if (b.nloc == 0u) gbar_complete(bar, b.x, b.nloc, b.nx);
    const unsigned nloc = b.nloc, nx = b.nx;
    const unsigned old = xb_add(&bar[XB_XSUB(b.x)], 1u);
    const unsigned gen = old / nloc;
    if (old + 1u == (gen + 1u) * nloc) {
      __builtin_amdgcn_fence(__ATOMIC_RELEASE, "agent");
      asm volatile("s_waitcnt vmcnt(0)" ::: "memory");
      const unsigned og = xb_add(&bar[XB_TOP], 1u);
      const unsigned tg = og / nx;
      if (og + 1u == (tg + 1u) * nx) xb_add(&bar[XB_TOPGEN], 1u);
      else XB_SPIN(xb_ld(&bar[XB_TOPGEN]) == tg, bar);
      __builtin_amdgcn_fence(__ATOMIC_ACQUIRE, "agent");
      xb_add(&bar[XB_XGEN(b.x)], 1u);
      asm volatile("s_waitcnt vmcnt(0)" ::: "memory");
    } else {
      XB_SPIN(xb_ld(&bar[XB_XGEN(b.x)]) == gen, bar);
      __builtin_amdgcn_fence(__ATOMIC_ACQUIRE, "agent");
      asm volatile("s_waitcnt vmcnt(0)" ::: "memory");
    }
  }
  __syncthreads();
}

template <class Setup, class Epi>
DI void gemm_phase128(char* smem, int s0, int s_end, int s_step, Setup setup, int ldb, Epi epi) {
  if (s0 >= s_end) return;
  u16* sA0 = (u16*)smem;
  u16* sB0 = sA0 + 128 * LDT;
  u16* sA1 = sB0 + 128 * LDT;
  u16* sB1 = sA1 + 128 * LDT;
  const int tid = otid(), lane = tid & 63, w = tid >> 6, r = lane & 31, h = lane >> 5;
  const int a_r0 = tid >> 3, a_c = (tid & 7) * 8;
  const int b_n4 = tid & 31, b_kq = tid >> 5;
  const u16 *apb0, *apb1, *apb2, *apb3;
  const float* bp;
  setup(s0, a_r0, a_c, b_n4, b_kq, apb0, apb1, apb2, apb3, bp);

  u32x4 pa0, pa1, pa2, pa3;
  f32x4 pb[8];

#define G_LOAD(KT)                                                                       \
  {                                                                                      \
    const int k0_ = (KT) * 64;                                                           \
    pa0 = *(const u32x4*)(apb0 + k0_);                                                   \
    pa1 = *(const u32x4*)(apb1 + k0_);                                                   \
    pa2 = *(const u32x4*)(apb2 + k0_);                                                   \
    pa3 = *(const u32x4*)(apb3 + k0_);                                                   \
    _Pragma("unroll") for (int i_ = 0; i_ < 8; ++i_) pb[i_] = *(const f32x4*)(bp + (size_t)(k0_ + i_) * ldb); \
  }
#define G_STAGE(SA, SBB)                                                                 \
  {                                                                                      \
    *(u32x4*)&SA[(a_r0)*LDT + a_c] = pa0;                                                \
    *(u32x4*)&SA[(a_r0 + 32) * LDT + a_c] = pa1;                                         \
    *(u32x4*)&SA[(a_r0 + 64) * LDT + a_c] = pa2;                                         \
    *(u32x4*)&SA[(a_r0 + 96) * LDT + a_c] = pa3;                                         \
    _Pragma("unroll") for (int j_ = 0; j_ < 4; ++j_) {                                   \
      u32x4 pk_;                                                                         \
      pk_.x = pack2(pb[0][j_], pb[1][j_]);                                               \
      pk_.y = pack2(pb[2][j_], pb[3][j_]);                                               \
      pk_.z = pack2(pb[4][j_], pb[5][j_]);                                               \
      pk_.w = pack2(pb[6][j_], pb[7][j_]);                                               \
      *(u32x4*)&SBB[(j_ * 32 + b_n4) * LDT + b_kq * 8] = pk_;                            \
    }                                                                                    \
  }
  const int aoff = (w * 32 + r) * LDT + 8 * h, boff = r * LDT + 8 * h;
#define G_FRAG(BUF, SA, SBB, KS)                                                         \
  {                                                                                      \
    fa[BUF] = *(const bf16x8*)(SA + aoff + (KS) * 16);                                   \
    fb[BUF][0] = *(const bf16x8*)(SBB + boff + (KS) * 16);                               \
    fb[BUF][1] = *(const bf16x8*)(SBB + boff + 32 * LDT + (KS) * 16);                    \
    fb[BUF][2] = *(const bf16x8*)(SBB + boff + 64 * LDT + (KS) * 16);                    \
    fb[BUF][3] = *(const bf16x8*)(SBB + boff + 96 * LDT + (KS) * 16);                    \
  }
#define G_MFMA(BUF)                                                                      \
  {                                                                                      \
    acc[0] = MFMA(fa[BUF], fb[BUF][0], acc[0]);                                          \
    acc[1] = MFMA(fa[BUF], fb[BUF][1], acc[1]);                                          \
    acc[2] = MFMA(fa[BUF], fb[BUF][2], acc[2]);                                          \
    acc[3] = MFMA(fa[BUF], fb[BUF][3], acc[3]);                                          \
  }
#define SB() __builtin_amdgcn_sched_barrier(0)
#define G_COMPUTE(SA, SBB)                                                               \
  {                                                                                      \
    bf16x8 fa[2], fb[2][4];                                                              \
    G_FRAG(0, SA, SBB, 0);                                                               \
    G_FRAG(1, SA, SBB, 1);                                                               \
    SB();                                                                                \
    G_MFMA(0);                                                                           \
    SB();                                                                                \
    G_FRAG(0, SA, SBB, 2);                                                               \
    SB();                                                                                \
    G_MFMA(1);                                                                           \
    SB();                                                                                \
    G_FRAG(1, SA, SBB, 3);                                                               \
    SB();                                                                                \
    G_MFMA(0);                                                                           \
    SB();                                                                                \
    G_MFMA(1);                                                                           \
    SB();                                                                                \
  }

  G_LOAD(0);
  __syncthreads();
#pragma unroll 1
  for (int s = s0; s < s_end; s += s_step) {
    f32x16 acc[4];
#pragma unroll
    for (int a = 0; a < 4; ++a)
#pragma unroll
      for (int i = 0; i < 16; ++i) acc[a][i] = 0.f;
    const int sn = s + s_step;
    const bool has_next = sn < s_end;
    const u16 *n0 = apb0, *n1 = apb1, *n2 = apb2, *n3 = apb3;
    const float* nbp = bp;
    if (has_next) setup(sn, a_r0, a_c, b_n4, b_kq, n0, n1, n2, n3, nbp);
#pragma unroll 1
    for (int kt = 0; kt < 16; kt += 2) {
      G_STAGE(sA0, sB0);
      __syncthreads();
      G_LOAD(kt + 1);
      G_COMPUTE(sA0, sB0);
      G_STAGE(sA1, sB1);
      __syncthreads();
      {
        int kn = kt + 2;
        if (kt == 14) { apb0 = n0; apb1 = n1; apb2 = n2; apb3 = n3; bp = nbp; kn = 0; }
        G_LOAD(kn);
      }
      G_COMPUTE(sA1, sB1);
    }
    epi(s, acc, w, r, h);
  }
  __syncthreads();
#undef G_LOAD
#undef G_STAGE
#undef G_COMPUTE
#undef G_FRAG
#undef G_MFMA
}
#undef SB

template <bool CONTIG, class Setup, class Epi>
DI void gemm_phase(char* smem, int s0, int s_end, int s_step, Setup setup, int ldb, Epi epi) {
  asm volatile("" : "+s"(s_end));
  if (s0 >= s_end) return;
  constexpr int LDK = 40;
  u16* sA0 = (u16*)smem;
  u16* sB0 = sA0 + 256 * LDK;
  u16* sA1 = sB0 + 128 * LDK;
  u16* sB1 = sA1 + 256 * LDK;
  const int tid = otid(), lane = tid & 63, w = tid >> 6, r = lane & 31, h = lane >> 5;
  const int a_r0 = tid >> 2, a_c = (tid & 3) * 8;
  const int b_n4 = tid & 31, b_kq = tid >> 5;
  const u16 *apb0, *apb1, *apb2, *apb3;
  const float* bp;
  setup(s0, a_r0, a_c, b_n4, b_kq, apb0, apb1, apb2, apb3, bp);

  u32x4 pa0, pa1, pa2, pa3;
  f32x4 pb[4];

#define G_LOAD(KT)                                                                       \
  {                                                                                      \
    const int k0_ = (KT) * 32;                                                           \
    pa0 = *(const u32x4*)(apb0 + k0_);                                                   \
    pa1 = *(const u32x4*)((CONTIG ? apb0 + 64 * DM : apb1) + k0_);                       \
    pa2 = *(const u32x4*)((CONTIG ? apb0 + 128 * DM : apb2) + k0_);                      \
    pa3 = *(const u32x4*)((CONTIG ? apb0 + 192 * DM : apb3) + k0_);                      \
    _Pragma("unroll") for (int i_ = 0; i_ < 4; ++i_) pb[i_] = *(const f32x4*)(bp + (size_t)(k0_ + i_) * ldb); \
  }
#define G_STAGE(SA, SBB)                                                                 \
  {                                                                                      \
    *(u32x4*)&SA[(a_r0)*LDK + a_c] = pa0;                                                \
    *(u32x4*)&SA[(a_r0 + 64) * LDK + a_c] = pa1;                                         \
    *(u32x4*)&SA[(a_r0 + 128) * LDK + a_c] = pa2;                                        \
    *(u32x4*)&SA[(a_r0 + 192) * LDK + a_c] = pa3;                                        \
    _Pragma("unroll") for (int j_ = 0; j_ < 4; ++j_) {                                   \
      uint2 pk_;                                                                         \
      pk_.x = pack2(pb[0][j_], pb[1][j_]);                                               \
      pk_.y = pack2(pb[2][j_], pb[3][j_]);                                               \
      *(uint2*)&SBB[(j_ * 32 + b_n4) * LDK + b_kq * 4] = pk_;                            \
    }                                                                                    \
  }
  const int aoff = (w * 64 + r) * LDK + 8 * h, boff = r * LDK + 8 * h;
#define G_FRAG(FA, FB, SA, SBB, KS)                                                      \
  {                                                                                      \
    FA[0] = *(const bf16x8*)(SA + aoff + (KS) * 16);                                     \
    FA[1] = *(const bf16x8*)(SA + aoff + 32 * LDK + (KS) * 16);                          \
    FB[0] = *(const bf16x8*)(SBB + boff + (KS) * 16);                                    \
    FB[1] = *(const bf16x8*)(SBB + boff + 32 * LDK + (KS) * 16);                         \
    FB[2] = *(const bf16x8*)(SBB + boff + 64 * LDK + (KS) * 16);                         \
    FB[3] = *(const bf16x8*)(SBB + boff + 96 * LDK + (KS) * 16);                         \
  }
#define G_MFMA(FA, FB)                                                                   \
  {                                                                                      \
    _Pragma("unroll") for (int mt_ = 0; mt_ < 2; ++mt_)                                  \
    _Pragma("unroll") for (int nt_ = 0; nt_ < 4; ++nt_) acc[mt_][nt_] = MFMA(FA[mt_], FB[nt_], acc[mt_][nt_]); \
  }
#define SB() __builtin_amdgcn_sched_barrier(0)
#define G_COMPUTE(SA, SBB)                                                               \
  {                                                                                      \
    bf16x8 fa0[2], fb0[4];                                                               \
    G_FRAG(fa0, fb0, SA, SBB, 0);                                                        \
    SB();                                                                                \
    G_MFMA(fa0, fb0);                                                                    \
    SB();                                                                                \
    G_FRAG(fa0, fb0, SA, SBB, 1);                                                        \
    SB();                                                                                \
    G_MFMA(fa0, fb0);                                                                    \
    SB();                                                                                \
  }

  G_LOAD(0);
  __syncthreads();
#pragma unroll 1
  for (int s = s0; s < s_end; s += s_step) {
    f32x16 acc[2][4];
#pragma unroll
    for (int a = 0; a < 2; ++a)
#pragma unroll
      for (int b = 0; b < 4; ++b)
#pragma unroll
        for (int i = 0; i < 16; ++i) acc[a][b][i] = 0.f;
    const int sn = s + s_step;
    const bool has_next = sn < s_end;
    const u16 *n0 = apb0, *n1 = apb1, *n2 = apb2, *n3 = apb3;
    const float* nbp = bp;
    if (has_next) setup(sn, a_r0, a_c, b_n4, b_kq, n0, n1, n2, n3, nbp);
#pragma unroll 1
    for (int kt = 0; kt < 32; kt += 2) {
      G_STAGE(sA0, sB0);
      __syncthreads();
      G_LOAD(kt + 1);
      G_COMPUTE(sA0, sB0);
      G_STAGE(sA1, sB1);
      __syncthreads();
      {
        int kn = kt + 2;
        if (kt == 30) { apb0 = n0; apb1 = n1; apb2 = n2; apb3 = n3; bp = nbp; kn = 0; }
        G_LOAD(kn);
      }
      G_COMPUTE(sA1, sB1);
    }
    epi(s, acc, w, r, h);
  }
  __syncthreads();
#undef G_LOAD
#undef G_STAGE
#undef G_COMPUTE
#undef G_FRAG
#undef G_MFMA
}

DI void load4x4(const void* base, int stride, bool isf32, int rq, int c4, float v[4][4]) {
  if (isf32) {
#pragma unroll
    for (int i = 0; i < 4; ++i) {
      const float4 x = *(const float4*)((const float*)base + (size_t)(4 * rq + i) * stride + 4 * c4);
      v[i][0] = x.x; v[i][1] = x.y; v[i][2] = x.z; v[i][3] = x.w;
    }
  } else {
#pragma unroll
    for (int i = 0; i < 4; ++i) {
      const uint2 x = *(const uint2*)((const u16*)base + (size_t)(4 * rq + i) * stride + 4 * c4);
      v[i][0] = bflo(x.x); v[i][1] = bfhi(x.x); v[i][2] = bflo(x.y); v[i][3] = bfhi(x.y);
    }
  }
}
DI void store_n(u16* dst, int ld, int row0, int rq, int c4, const float v[4][4]) {
#pragma unroll
  for (int i = 0; i < 4; ++i) {
    uint2 pk = {pack2(v[i][0], v[i][1]), pack2(v[i][2], v[i][3])};
    *(uint2*)&dst[(row0 + 4 * rq + i) * ld + 4 * c4] = pk;
  }
}
DI void store_t(u16* dst, int ld, int col0, int rq, int c4, const float v[4][4], const float s[4]) {
#pragma unroll
  for (int j = 0; j < 4; ++j) {
    uint2 pk = {pack2(v[0][j] * s[0], v[1][j] * s[1]), pack2(v[2][j] * s[2], v[3][j] * s[3])};
    *(uint2*)&dst[(4 * c4 + j) * ld + col0 + 4 * rq] = pk;
  }
}

DI void attn_load(const u16* kp, const u16* vp, int stride, int rq, int c4, uint2 (&k)[4], uint2 (&v)[4]) {
#pragma unroll
  for (int i = 0; i < 4; ++i) {
    k[i] = *(const uint2*)(kp + (size_t)(4 * rq + i) * stride + 4 * c4);
    v[i] = *(const uint2*)(vp + (size_t)(4 * rq + i) * stride + 4 * c4);
  }
}
DI void attn_stage(u16* sK, u16* sVT, int rq, int c4, const uint2 (&k)[4], const uint2 (&v)[4]) {
#pragma unroll
  for (int i = 0; i < 4; ++i) *(uint2*)&sK[(4 * rq + i) * LDT + 4 * c4] = k[i];
  uint2 t0, t1, t2, t3;
  t0.x = (v[0].x & 0xffffu) | (v[1].x << 16);          t0.y = (v[2].x & 0xffffu) | (v[3].x << 16);
  t1.x = (v[0].x >> 16) | (v[1].x & 0xffff0000u);      t1.y = (v[2].x >> 16) | (v[3].x & 0xffff0000u);
  t2.x = (v[0].y & 0xffffu) | (v[1].y << 16);          t2.y = (v[2].y & 0xffffu) | (v[3].y << 16);
  t3.x = (v[0].y >> 16) | (v[1].y & 0xffff0000u);      t3.y = (v[2].y >> 16) | (v[3].y & 0xffff0000u);
  const int qs = 4 * (rq ^ ((c4 >> 1) & 7));
  *(uint2*)&sVT[(4 * c4 + 0) * LDT + qs] = t0;
  *(uint2*)&sVT[(4 * c4 + 1) * LDT + qs] = t1;
  *(uint2*)&sVT[(4 * c4 + 2) * LDT + qs] = t2;
  *(uint2*)&sVT[(4 * c4 + 3) * LDT + qs] = t3;
}

template <class TileSrc, class BiasF, class TMode>
DI void attn_core(char* smem, const u16* qbase, int ntiles, TileSrc src, BiasF biasf, TMode tmode, float m_init, bool has_sink, u16* obase) {
  u16* sK = (u16*)smem;
  u16* sVT = sK + 64 * LDT;
  const int tid = otid(), lane = tid & 63, w = tid >> 6, r = lane & 31, h = lane >> 5;
  const int rq = tid >> 4, c4 = tid & 15;
  const int ql = w * 32 + r;
  bf16x8 qf[4];
#pragma unroll
  for (int ks = 0; ks < 4; ++ks) qf[ks] = *(const bf16x8*)(qbase + (size_t)ql * DIN + ks * 16 + 8 * h);
  f32x16 O[2];
#pragma unroll
  for (int d = 0; d < 2; ++d)
#pragma unroll
    for (int i = 0; i < 16; ++i) O[d][i] = 0.f;
  float m = m_init, lsum = (has_sink && h == 0) ? 1.f : 0.f;

  auto nextv = [&](int j, const u16*& kp, const u16*& vp, int& stride) -> int {
    while (j < ntiles && !src(j, kp, vp, stride)) ++j;
    return j;
  };
  auto compute = [&](int jc) {
    const int mode = tmode(jc, w);
    if (mode != 2) {
      f32x16 S[2];
#pragma unroll
      for (int mt = 0; mt < 2; ++mt)
#pragma unroll
        for (int i = 0; i < 16; ++i) S[mt][i] = 0.f;
#pragma unroll
      for (int ks = 0; ks < 4; ++ks)
#pragma unroll
        for (int mt = 0; mt < 2; ++mt) {
          const bf16x8 kf = *(const bf16x8*)&sK[(mt * 32 + r) * LDT + ks * 16 + 8 * h];
          S[mt] = MFMA(kf, qf[ks], S[mt]);
        }
      const float C2 = 0.125f * 1.44269504f;
      float mx = NEG;
      if (mode == 1) {
#pragma unroll
        for (int mt = 0; mt < 2; ++mt)
#pragma unroll
          for (int i = 0; i < 16; ++i) {
            const float s = S[mt][i] * C2 + biasf(jc, mt * 32 + crow(i, h), ql);
            S[mt][i] = s;
            mx = fmaxf(mx, s);
          }
      } else {
#pragma unroll
        for (int mt = 0; mt < 2; ++mt)
#pragma unroll
          for (int i = 0; i < 16; ++i) {
            const float s = S[mt][i] * C2;
            S[mt][i] = s;
            mx = fmaxf(mx, s);
          }
      }
      mx = fmaxf(mx, __shfl_xor(mx, 32));
      const float mn = fmaxf(m, mx);
      if (__any(mn > m)) {
        const float alpha = __builtin_amdgcn_exp2f(m - mn);
        m = mn;
        lsum *= alpha;
#pragma unroll
        for (int d = 0; d < 2; ++d)
#pragma unroll
          for (int i = 0; i < 16; ++i) O[d][i] *= alpha;
      }
      float ps = 0.f;
#pragma unroll
      for (int mt = 0; mt < 2; ++mt)
#pragma unroll
        for (int i = 0; i < 16; ++i) {
          const float pv = __builtin_amdgcn_exp2f(S[mt][i] - m);
          S[mt][i] = pv;
          ps += pv;
        }
      lsum += ps;
#pragma unroll
      for (int mt = 0; mt < 2; ++mt)
#pragma unroll
        for (int s = 0; s < 2; ++s) {
          const bf16x8 pf = mk8(pack2(S[mt][8 * s + 0], S[mt][8 * s + 1]), pack2(S[mt][8 * s + 2], S[mt][8 * s + 3]),
                                pack2(S[mt][8 * s + 4], S[mt][8 * s + 5]), pack2(S[mt][8 * s + 6], S[mt][8 * s + 7]));
#pragma unroll
          for (int d = 0; d < 2; ++d) {
            const int sw = (d * 4 + (r >> 3)) & 7, q = mt * 8 + 4 * s + h;
            const u16* vrow = &sVT[(d * 32 + r) * LDT];
            const uint2 lo = *(const uint2*)(vrow + 4 * (q ^ sw));
            const uint2 hi = *(const uint2*)(vrow + 4 * ((q + 2) ^ sw));
            O[d] = MFMA(mk8(lo.x, lo.y, hi.x, hi.y), pf, O[d]);
          }
        }
    }
  };

  uint2 kA[4], vA[4], kB[4], vB[4];
#pragma unroll
  for (int i = 0; i < 4; ++i) { kA[i] = make_uint2(0u, 0u); vA[i] = kA[i]; kB[i] = kA[i]; vB[i] = kA[i]; }
  const u16 *kp = nullptr, *vp = nullptr;
  int stride = 0;
  int jA = nextv(0, kp, vp, stride);
  if (jA < ntiles) attn_load(kp, vp, stride, rq, c4, kA, vA);
  int jB = nextv(jA + 1, kp, vp, stride);
  if (jB < ntiles) attn_load(kp, vp, stride, rq, c4, kB, vB);
#pragma unroll 1
  for (;;) {
    if (jA >= ntiles) break;
    __syncthreads();
    attn_stage(sK, sVT, rq, c4, kA, vA);
    __syncthreads();
    {
      const int jc = jA;
      jA = nextv(jB + 1, kp, vp, stride);
      if (jA < ntiles) attn_load(kp, vp, stride, rq, c4, kA, vA);
      compute(jc);
    }
    if (jB >= ntiles) break;
    __syncthreads();
    attn_stage(sK, sVT, rq, c4, kB, vB);
    __syncthreads();
    {
      const int jc = jB;
      jB = nextv(jA + 1, kp, vp, stride);
      if (jB < ntiles) attn_load(kp, vp, stride, rq, c4, kB, vB);
      compute(jc);
    }
  }
  const float l = lsum + __shfl_xor(lsum, 32);
  const float inv = 1.f / l;
#pragma unroll
  for (int d = 0; d < 2; ++d)
#pragma unroll
    for (int g = 0; g < 4; ++g) {
      uint2 pk = {pack2(O[d][4 * g + 0] * inv, O[d][4 * g + 1] * inv), pack2(O[d][4 * g + 2] * inv, O[d][4 * g + 3] * inv)};
      *(uint2*)(obase + (size_t)ql * DM + d * 32 + 8 * g + 4 * h) = pk;
    }
}

DI void phase0(const Params& p, char* smem) {
  const int tid = otid();
  if (blockIdx.x == 0) {
    for (int idx = tid; idx < 1024; idx += 256) {
      const int pos = idx >> 4, j = idx & 15;
      const double inv = 1.0 / pow(10000.0, (double)j / 16.0);
      const float ang = (float)((double)pos * inv);
      p.ROPE[idx] = cosf(ang);
      p.ROPE[1024 + idx] = sinf(ang);
    }
  }
  float* scond = (float*)smem;
  for (int item = blockIdx.x; item < 768; item += gridDim.x) {
    const int l = item / 384, ks = (item / 24) % 16, jb = item % 24;
    __syncthreads();
    for (int idx = tid; idx < 320; idx += 256) {
      const int c = idx / 64, k = ks * 64 + (idx & 63);
      const float v = (c == 0) ? p.c_ctx[k] : p.c[(c - 1) * DM + k];
      scond[idx] = silu(v);
    }
    __syncthreads();
    const int j = jb * 256 + tid;
    const float* wp = p.w_ada + ((size_t)l * DM + ks * 64) * 6144 + j;
    float a[5] = {0.f, 0.f, 0.f, 0.f, 0.f};
#pragma unroll 8
    for (int k = 0; k < 64; ++k) {
      const float wv = wp[(size_t)k * 6144];
#pragma unroll
      for (int c = 0; c < 5; ++c) a[c] += scond[c * 64 + k] * wv;
    }
    const float bias = (ks == 0) ? p.b_ada[l * 6144 + j] : 0.f;
#pragma unroll
    for (int c = 0; c < 5; ++c) unsafeAtomicAdd(&p.MOD[(l * 5 + c) * 6144 + j], a[c] + bias);
  }
}

DI int cond_of(int T) { return T < NCTX ? 0 : 1 + ((T - NCTX) >> 11); }

DI void cvt_f32_bf16(const float* s, u16* d, int n4, int gtid, int gsz) {
  for (int i = gtid; i < n4; i += gsz) {
    const float4 x = *(const float4*)(s + (size_t)i * 4);
    uint2 pk = {pack2(x.x, x.y), pack2(x.z, x.w)};
    *(uint2*)(d + (size_t)i * 4) = pk;
  }
}
DI void phase0b(const Params& p) {
  const int tid = otid(), lane = tid & 63, w = tid >> 6;
  {
    const int gtid = blockIdx.x * 256 + tid, gsz = gridDim.x * 256;
    cvt_f32_bf16(p.cak, p.CAK, 4 * 2 * 512 * 128 / 4, gtid, gsz);
    cvt_f32_bf16(p.cav, p.CAV, 4 * 2 * 512 * 128 / 4, gtid, gsz);
    cvt_f32_bf16(p.cbk, p.CBK, 4 * 2 * 512 * 256 / 4, gtid, gsz);
    cvt_f32_bf16(p.cbv, p.CBV, 4 * 2 * 512 * 256 / 4, gtid, gsz);
  }
  for (int T = blockIdx.x * 4 + w; T < NTOK; T += gridDim.x * 4) {
    const float* mod = p.MOD + (size_t)cond_of(T) * 6144;
    const float* xr = (T < NCTX) ? (p.x_prompt + (size_t)T * DM) : (p.x_sample + (size_t)(T - NCTX) * DM);
#pragma unroll
    for (int i = 0; i < 4; ++i) {
      const int k = 256 * i + 4 * lane;
      const float4 x = *(const float4*)(xr + k);
      const float4 sc = *(const float4*)(mod + 1024 + k), sh = *(const float4*)(mod + k);
      uint2 pk = {pack2(x.x * (1.f + sc.x) + sh.x, x.y * (1.f + sc.y) + sh.y), pack2(x.z * (1.f + sc.z) + sh.z, x.w * (1.f + sc.w) + sh.w)};
      *(uint2*)(p.H2 + (size_t)T * DM + k) = pk;
    }
  }
}

DI void phase1(const Params& p, char* smem, int l) {
  const float* W = p.w_in + (size_t)l * DM * DIN;
  const int xcd = blockIdx.x & 7, nloc = gridDim.x >> 3;
  auto setup = [&](int s, int ar0, int ac, int n4, int kq, const u16*& q0, const u16*& q1, const u16*& q2, const u16*& q3, const float*& bp) {
    const int tm = 6 * xcd + s % 6, tn = s / 6;
    const u16* ab = p.H2 + ((size_t)tm * 256 + ar0) * DM + ac;
    q0 = ab; q1 = ab + 64 * DM; q2 = ab + 128 * DM; q3 = ab + 192 * DM;
    bp = W + tn * 128 + 4 * n4 + (size_t)(kq * 4) * DIN;
  };
  auto epi = [&](int s, f32x16(&acc)[2][4], int w, int r, int h) {
    int hq = h;
    asm volatile("" : "+v"(hq));
    const int tm = 6 * xcd + s % 6, tn = s / 6;
    const int m0 = tm * 256, n0 = tn * 128;
    const bool lat = m0 >= NCTX;
    const bool rope = lat && (n0 < 640);
    const int n = n0 + 4 * r;
    const int q = (r >> 2) & 3;
#pragma unroll
    for (int mt = 0; mt < 2; ++mt)
#pragma unroll
    for (int i = 0; i < 16; ++i) {
      const int T = m0 + w * 64 + mt * 32 + crow(i, hq);
      float v0 = acc[mt][0][i], v1 = acc[mt][1][i], v2 = acc[mt][2][i], v3 = acc[mt][3][i];
      if (rope) {
        const int t = (T - NCTX) & 2047;
        const int pos = (q < 2) ? (t >> 6) : (t & 63);
        const int jf = 4 * (r & 3);
        const float4 cs = *(const float4*)(p.ROPE + pos * 16 + jf), sn = *(const float4*)(p.ROPE + 1024 + pos * 16 + jf);
        const float o0 = __shfl_xor(v0, 4), o1 = __shfl_xor(v1, 4), o2 = __shfl_xor(v2, 4), o3 = __shfl_xor(v3, 4);
        if (q & 1) { v0 = o0 * sn.x + v0 * cs.x; v1 = o1 * sn.y + v1 * cs.y; v2 = o2 * sn.z + v2 * cs.z; v3 = o3 * sn.w + v3 * cs.w; }
        else { v0 = v0 * cs.x - o0 * sn.x; v1 = v1 * cs.y - o1 * sn.y; v2 = v2 * cs.z - o2 * sn.z; v3 = v3 * cs.w - o3 * sn.w; }
      }
      uint2 pk = {pack2(v0, v1), pack2(v2, v3)};
      *(uint2*)(p.QKV + (size_t)T * DIN + n) = pk;
      if (!lat) {
        const int b = T >> 8, t = T & 255;
        const float4 vv = {v0, v1, v2, v3};
        if (n0 == 512) *(float4*)(p.out + OFF_AK + ((size_t)(b * 2 + l) * 256 + t) * 128 + (n - 512)) = vv;
        else if (n0 == 640) *(float4*)(p.out + OFF_AV + ((size_t)(b * 2 + l) * 256 + t) * 128 + (n - 640)) = vv;
        else if (n0 == 1024 || n0 == 1152) *(float4*)(p.out + OFF_BK + ((size_t)(b * 2 + l) * 256 + t) * 256 + (n - 1024)) = vv;
        else if (n0 == 1280 || n0 == 1408) *(float4*)(p.out + OFF_BV + ((size_t)(b * 2 + l) * 256 + t) * 256 + (n - 1280)) = vv;
      }
      if ((i & 3) == 3) __builtin_amdgcn_sched_barrier(0);
    }
  };
  gemm_phase<true>(smem, blockIdx.x >> 3, 120, nloc, setup, DIN, epi);
}

DI float ret_lg(const Params& p, int l, int dir, int head) { return -__expf(p.decay[(l * 2 + dir) * 4 + head]); }

DI size_t kvs_slot(int req, int head, int dir, int c) { return ((size_t)((req * 4 + head) * 2 + dir) * 16 + c) * 4096; }

DI void retkv_item(const Params& p, char* smem, int l, int req, int head, int c) {
  u16* sKTf = (u16*)smem;
  u16* sKTb = sKTf + 64 * LDT2;
  u16* sVT = sKTb + 64 * LDT2;
  const int tid = otid(), lane = tid & 63, w = tid >> 6, r = lane & 31, h = lane >> 5;
  const int rq = tid >> 4, c4 = tid & 15;
  const int T0 = (req < 16 ? req * 256 : NCTX + (req - 16) * 2048) + c * 128;
  const float lgf = ret_lg(p, l, 0, head), lgb = ret_lg(p, l, 1, head);
  const float one4[4] = {1.f, 1.f, 1.f, 1.f};
  __syncthreads();
#pragma unroll
  for (int half = 0; half < 2; ++half) {
    float v[4][4];
    float sf[4], sb[4];
#pragma unroll
    for (int i = 0; i < 4; ++i) {
      const int j = half * 64 + 4 * rq + i;
      sf[i] = 0.125f * __expf(lgf * (float)(127 - j));
      sb[i] = 0.125f * __expf(lgb * (float)j);
    }
    load4x4(p.QKV + (size_t)(T0 + half * 64) * DIN + 1792 + head * 64, DIN, false, rq, c4, v);
    store_t(sKTf, LDT2, half * 64, rq, c4, v, sf);
    store_t(sKTb, LDT2, half * 64, rq, c4, v, sb);
    load4x4(p.QKV + (size_t)(T0 + half * 64) * DIN + 2048 + head * 64, DIN, false, rq, c4, v);
    store_t(sVT, LDT2, half * 64, rq, c4, v, one4);
  }
  __syncthreads();
  const int dir = w >> 1, mt = w & 1;
  const u16* sKT = dir ? sKTb : sKTf;
  f32x16 acc[2];
#pragma unroll
  for (int nt = 0; nt < 2; ++nt)
#pragma unroll
    for (int i = 0; i < 16; ++i) acc[nt][i] = 0.f;
#pragma unroll
  for (int ks = 0; ks < 8; ++ks) {
    const bf16x8 fa = *(const bf16x8*)&sKT[(mt * 32 + r) * LDT2 + ks * 16 + 8 * h];
#pragma unroll
    for (int nt = 0; nt < 2; ++nt) {
      const bf16x8 fb = *(const bf16x8*)&sVT[(nt * 32 + r) * LDT2 + ks * 16 + 8 * h];
      acc[nt] = MFMA(fa, fb, acc[nt]);
    }
  }
  float* dst = p.KVS + kvs_slot(req, head, dir, c);
#pragma unroll
  for (int nt = 0; nt < 2; ++nt)
#pragma unroll
    for (int i = 0; i < 16; ++i) dst[(mt * 32 + crow(i, h)) * 64 + nt * 32 + r] = acc[nt][i];
}

DI void phase2(const Params& p, char* smem, int l) {
  const int tid = otid();
  for (int item = blockIdx.x; item < 1536; item += gridDim.x) {
    if (item < 512) {
      const int b = item >> 7, head = (item >> 4) & 7, qb = item & 15, kvh = head >> 2;
      const int T0 = NCTX + b * 2048 + qb * 128;
      const u16* ck = p.CAK + ((size_t)(b * 2 + l) * 512) * 128 + kvh * 64;
      const u16* cv = p.CAV + ((size_t)(b * 2 + l) * 512) * 128 + kvh * 64;
      auto src = [&](int j, const u16*& kp, const u16*& vp, int& stride) -> bool {
        if (j < 8) {
          kp = ck + (size_t)j * 64 * 128; vp = cv + (size_t)j * 64 * 128; stride = 128;
          return true;
        }
        const int jj = j - 8, kb = qb - 1 + (jj >> 1);
        if (kb < 0 || kb >= 16) return false;
        const int Tk = NCTX + b * 2048 + kb * 128 + (jj & 1) * 64;
        kp = p.QKV + (size_t)Tk * DIN + 512 + kvh * 64; vp = p.QKV + (size_t)Tk * DIN + 640 + kvh * 64; stride = DIN;
        return true;
      };
      auto biasf = [&](int j, int key, int ql) -> float {
        if (j < 8) return 0.f;
        const int jj = j - 8;
        const int kj = (qb - 1 + (jj >> 1)) * 128 + (jj & 1) * 64 + key;
        const int qi = qb * 128 + ql;
        const int d = qi - kj;
        return (d <= 128 && d >= -128) ? 0.f : NEG;
      };
      auto tmode = [&](int j, int w) -> int {
        if (j < 8) return 0;
        const int jj = j - 8;
        const int k0 = (qb - 1 + (jj >> 1)) * 128 + (jj & 1) * 64, q0w = qb * 128 + w * 32;
        if (k0 - (q0w + 31) > 128 || q0w - (k0 + 63) > 128) return 2;
        if ((q0w + 31) - k0 <= 128 && (k0 + 63) - q0w <= 128) return 0;
        return 1;
      };
      attn_core(smem, p.QKV + (size_t)T0 * DIN + head * 64, 14, src, biasf, tmode, p.sink[l * 8 + head] * 1.44269504f, true,
                p.CAT + (size_t)T0 * DM + head * 64);
    } else if (item < 768) {
      const int it = item - 512;
      const int b = it >> 6, head = (it >> 4) & 3, qb = it & 15;
      const int T0 = NCTX + b * 2048 + qb * 128;
      float* srpb = (float*)(smem + 2 * 64 * LDT * 2);
      __syncthreads();
      for (int idx = tid; idx < 465; idx += 256) srpb[idx] = p.rpb[(size_t)(l * 4 + head) * 465 + idx] * 1.44269504f;
      const int r0 = 2 * qb;
      const int rmin = min(max(r0 - 4, 0), 24), rmax = min(max(r0 + 1 - 4, 0), 24) + 7;
      const u16* ck = p.CBK + ((size_t)(b * 2 + l) * 512) * 256 + head * 64;
      const u16* cv = p.CBV + ((size_t)(b * 2 + l) * 512) * 256 + head * 64;
      auto src = [&](int j, const u16*& kp, const u16*& vp, int& stride) -> bool {
        if (j < 8) {
          kp = ck + (size_t)j * 64 * 256; vp = cv + (size_t)j * 64 * 256; stride = 256;
          return true;
        }
        const int Tk = NCTX + b * 2048 + (rmin + j - 8) * 64;
        kp = p.QKV + (size_t)Tk * DIN + 1024 + head * 64; vp = p.QKV + (size_t)Tk * DIN + 1280 + head * 64; stride = DIN;
        return true;
      };
      auto biasf = [&](int j, int key, int ql) -> float {
        if (j < 8) return 0.f;
        const int kr = rmin + j - 8, kc = key;
        const int qr = r0 + (ql >> 6), qc = ql & 63;
        const int rs = min(max(qr - 4, 0), 24), cs = min(max(qc - 8, 0), 48);
        const bool ok = (kr >= rs) && (kr < rs + 8) && (kc >= cs) && (kc < cs + 16);
        const int bi = ok ? ((kr - qr + 7) * 31 + (kc - qc + 15)) : 0;
        const float bv = srpb[bi];
        return ok ? bv : NEG;
      };
      auto tmode = [&](int j, int w) -> int {
        if (j < 8) return 0;
        const int kr = rmin + j - 8, qr = r0 + (w >> 1);
        const int rs = min(max(qr - 4, 0), 24);
        return (kr >= rs && kr < rs + 8) ? 1 : 2;
      };
      attn_core(smem, p.QKV + (size_t)T0 * DIN + 768 + head * 64, 8 + (rmax - rmin + 1), src, biasf, tmode, NEG, false,
                p.CAT + (size_t)T0 * DM + 512 + head * 64);
    } else if (item < 1152) {
      const int it = item - 768;
      if (it < 256) retkv_item(p, smem, l, 16 + (it >> 6), (it >> 4) & 3, it & 15);
      else { const int i2 = it - 256; retkv_item(p, smem, l, i2 >> 3, (i2 >> 1) & 3, i2 & 1); }
    } else if (item < 1408) {
      const int it = item - 1152;
      const int b = it >> 4, head = (it >> 1) & 7, qh = it & 1, kvh = head >> 2;
      const int T0 = b * 256 + qh * 128;
      auto src = [&](int j, const u16*& kp, const u16*& vp, int& stride) -> bool {
        const int Tk = b * 256 + j * 64;
        kp = p.QKV + (size_t)Tk * DIN + 512 + kvh * 64; vp = p.QKV + (size_t)Tk * DIN + 640 + kvh * 64; stride = DIN;
        return true;
      };
      auto biasf = [&](int, int, int) -> float { return 0.f; };
      auto tmode = [&](int, int) -> int { return 0; };
      attn_core(smem, p.QKV + (size_t)T0 * DIN + head * 64, 4, src, biasf, tmode, p.sink[l * 8 + head] * 1.44269504f, true,
                p.CAT + (size_t)T0 * DM + head * 64);
    } else {
      const int it = item - 1408;
      const int b = it >> 3, head = (it >> 1) & 3, qh = it & 1;
      const int T0 = b * 256 + qh * 128;
      auto src = [&](int j, const u16*& kp, const u16*& vp, int& stride) -> bool {
        const int Tk = b * 256 + j * 64;
        kp = p.QKV + (size_t)Tk * DIN + 1024 + head * 64; vp = p.QKV + (size_t)Tk * DIN + 1280 + head * 64; stride = DIN;
        return true;
      };
      auto biasf = [&](int, int, int) -> float { return 0.f; };
      auto tmode = [&](int, int) -> int { return 0; };
      attn_core(smem, p.QKV + (size_t)T0 * DIN + 768 + head * 64, 4, src, biasf, tmode, NEG, false,
                p.CAT + (size_t)T0 * DM + 512 + head * 64);
    }
  }
}

DI void phase2c(const Params& p, char* smem, int l) {
  u16* sK = (u16*)smem;
  u16* sVT = sK + 128 * LDT;
  u16* sSTf = sVT + 64 * LDT2;
  u16* sSTb = sSTf + 64 * LDT;
  const int tid = otid(), lane = tid & 63, w = tid >> 6, r = lane & 31, h = lane >> 5;
  const int rq = tid >> 4, c4 = tid & 15;
  const float one4[4] = {1.f, 1.f, 1.f, 1.f};
  for (int item = blockIdx.x; item < 384; item += gridDim.x) {
    int req, head, c, nc;
    if (item < 256) { req = 16 + (item >> 6); head = (item >> 4) & 3; c = item & 15; nc = 16; }
    else { const int i2 = item - 256; req = i2 >> 3; head = (i2 >> 1) & 3; c = i2 & 1; nc = 2; }
    const bool lat = req >= 16;
    const int T0 = (lat ? NCTX + (req - 16) * 2048 : req * 256) + c * 128;
    const float lgf = ret_lg(p, l, 0, head), lgb = ret_lg(p, l, 1, head);
    const float gf = __expf(lgf * 128.f), gb = __expf(lgb * 128.f);
    __syncthreads();
    {
      const int d = tid >> 2, e0 = (tid & 3) * 16;
#pragma unroll
      for (int dir = 0; dir < 2; ++dir) {
        float s[16];
#pragma unroll
        for (int q = 0; q < 16; ++q) s[q] = 0.f;
        const float g = dir ? gb : gf;
        if (lat) {
          const float* s0 = p.state + ((size_t)(((req - 16) * 2 + l) * 2 + dir) * 4 + head) * 4096 + d * 64 + e0;
#pragma unroll
          for (int q = 0; q < 16; q += 4) {
            const float4 x = *(const float4*)(s0 + q);
            s[q] = x.x; s[q + 1] = x.y; s[q + 2] = x.z; s[q + 3] = x.w;
          }
        }
        const int nsteps = dir ? (nc - 1 - c) : c;
        for (int st = 0; st < nsteps; ++st) {
          const int cc = dir ? (nc - 1 - st) : st;
          const float* kv = p.KVS + kvs_slot(req, head, dir, cc) + d * 64 + e0;
#pragma unroll
          for (int q = 0; q < 16; q += 4) {
            const float4 x = *(const float4*)(kv + q);
            s[q] = s[q] * g + x.x; s[q + 1] = s[q + 1] * g + x.y; s[q + 2] = s[q + 2] * g + x.z; s[q + 3] = s[q + 3] * g + x.w;
          }
        }
        u16* sST = dir ? sSTb : sSTf;
#pragma unroll
        for (int q = 0; q < 16; ++q) sST[(e0 + q) * LDT + d] = (u16)(pack2(s[q], 0.f) & 0xffffu);
        if (!lat && c == 0) {
          const float* k0 = p.KVS + kvs_slot(req, head, dir, 0) + d * 64 + e0;
          const float* k1 = p.KVS + kvs_slot(req, head, dir, 1) + d * 64 + e0;
          float* o = p.out + OFF_ST + ((size_t)((req * 2 + l) * 2 + dir) * 4 + head) * 4096 + d * 64 + e0;
#pragma unroll
          for (int q = 0; q < 16; ++q) o[q] = dir ? (gb * k1[q] + k0[q]) : (gf * k0[q] + k1[q]);
        }
      }
    }
#pragma unroll
    for (int half = 0; half < 2; ++half) {
      float v[4][4];
      load4x4(p.QKV + (size_t)(T0 + half * 64) * DIN + 1792 + head * 64, DIN, false, rq, c4, v);
      store_n(sK, LDT, half * 64, rq, c4, v);
      load4x4(p.QKV + (size_t)(T0 + half * 64) * DIN + 2048 + head * 64, DIN, false, rq, c4, v);
      store_t(sVT, LDT2, half * 64, rq, c4, v, one4);
    }
    __syncthreads();
    const int qi = w * 32 + r;
    const u16* qrow = p.QKV + (size_t)(T0 + qi) * DIN + 1536 + head * 64;
    uint4 qraw[4];
#pragma unroll
    for (int ks = 0; ks < 4; ++ks) qraw[ks] = *(const uint4*)(qrow + ks * 16 + 8 * h);
    f32x16 O[2];
#pragma unroll
    for (int d = 0; d < 2; ++d)
#pragma unroll
      for (int i = 0; i < 16; ++i) O[d][i] = 0.f;
#pragma unroll 1
    for (int jt = 0; jt < 4; ++jt) {
      f32x16 S;
#pragma unroll
      for (int i = 0; i < 16; ++i) S[i] = 0.f;
#pragma unroll
      for (int ks = 0; ks < 4; ++ks) {
        const bf16x8 kf = *(const bf16x8*)&sK[(jt * 32 + r) * LDT + ks * 16 + 8 * h];
        S = MFMA(kf, __builtin_bit_cast(bf16x8, qraw[ks]), S);
      }
#pragma unroll
      for (int i = 0; i < 16; ++i) {
        const int j = jt * 32 + crow(i, h);
        const int dlt = qi - j;
        const float wgt = (dlt > 0) ? __expf(lgf * (float)dlt) : ((dlt < 0) ? __expf(lgb * (float)(-dlt)) : 2.f);
        S[i] = S[i] * 0.125f * wgt;
      }
#pragma unroll
      for (int s = 0; s < 2; ++s) {
        const bf16x8 pf = mk8(pack2(S[8 * s + 0], S[8 * s + 1]), pack2(S[8 * s + 2], S[8 * s + 3]),
                              pack2(S[8 * s + 4], S[8 * s + 5]), pack2(S[8 * s + 6], S[8 * s + 7]));
#pragma unroll
        for (int d = 0; d < 2; ++d) {
          const u16* vrow = &sVT[(d * 32 + r) * LDT2 + jt * 32 + 16 * s + 4 * h];
          const uint2 lo = *(const uint2*)vrow;
          const uint2 hi = *(const uint2*)(vrow + 8);
          O[d] = MFMA(mk8(lo.x, lo.y, hi.x, hi.y), pf, O[d]);
        }
      }
    }
    {
      const float xf = __expf(lgf * (float)(qi + 1)), xb = __expf(lgb * (float)(128 - qi));
#pragma unroll
      for (int ks = 0; ks < 4; ++ks) {
        const uint4 q = qraw[ks];
        const bf16x8 qsf = mk8(pack2(bflo(q.x) * xf, bfhi(q.x) * xf), pack2(bflo(q.y) * xf, bfhi(q.y) * xf),
                               pack2(bflo(q.z) * xf, bfhi(q.z) * xf), pack2(bflo(q.w) * xf, bfhi(q.w) * xf));
        const bf16x8 qsb = mk8(pack2(bflo(q.x) * xb, bfhi(q.x) * xb), pack2(bflo(q.y) * xb, bfhi(q.y) * xb),
                               pack2(bflo(q.z) * xb, bfhi(q.z) * xb), pack2(bflo(q.w) * xb, bfhi(q.w) * xb));
#pragma unroll
        for (int d = 0; d < 2; ++d) {
          const bf16x8 sf = *(const bf16x8*)&sSTf[(d * 32 + r) * LDT + ks * 16 + 8 * h];
          const bf16x8 sb = *(const bf16x8*)&sSTb[(d * 32 + r) * LDT + ks * 16 + 8 * h];
          O[d] = MFMA(sf, qsf, O[d]);
          O[d] = MFMA(sb, qsb, O[d]);
        }
      }
    }
    float sum = 0.f;
#pragma unroll
    for (int d = 0; d < 2; ++d)
#pragma unroll
      for (int i = 0; i < 16; ++i) sum += O[d][i];
    sum += __shfl_xor(sum, 32);
    const float mu = sum * (1.f / 64.f);
    float vs = 0.f;
#pragma unroll
    for (int d = 0; d < 2; ++d)
#pragma unroll
      for (int i = 0; i < 16; ++i) { const float t = O[d][i] - mu; vs += t * t; }
    vs += __shfl_xor(vs, 32);
    const float rstd = rsqrtf(vs * (1.f / 64.f) + 1e-6f);
    const u16* grow = p.QKV + (size_t)(T0 + qi) * DIN + 2304 + head * 64;
    const float* gnw = p.gn + l * 256 + head * 64;
    u16* orow = p.CAT + (size_t)(T0 + qi) * DM + 768 + head * 64;
#pragma unroll
    for (int d = 0; d < 2; ++d)
#pragma unroll
      for (int g = 0; g < 4; ++g) {
        const int e = d * 32 + 8 * g + 4 * h;
        const uint2 gr = *(const uint2*)(grow + e);
        const float4 gw = *(const float4*)(gnw + e);
        const float o0 = silu(bflo(gr.x)) * (O[d][4 * g + 0] - mu) * rstd * gw.x;
        const float o1 = silu(bfhi(gr.x)) * (O[d][4 * g + 1] - mu) * rstd * gw.y;
        const float o2 = silu(bflo(gr.y)) * (O[d][4 * g + 2] - mu) * rstd * gw.z;
        const float o3 = silu(bfhi(gr.y)) * (O[d][4 * g + 3] - mu) * rstd * gw.w;
        uint2 pk = {pack2(o0, o1), pack2(o2, o3)};
        *(uint2*)(orow + e) = pk;
      }
  }
}

DI void phase3(const Params& p, char* smem, int l, const float* xc, const float* xl) {
  const float* W = p.w_out + (size_t)l * DM * DM;
  u16* PREB = (u16*)p.PRE;
  const int xcd = blockIdx.x & 7, nloc = gridDim.x >> 3;
  auto setup = [&](int s, int ar0, int ac, int n4, int kq, const u16*& q0, const u16*& q1, const u16*& q2, const u16*& q3, const float*& bp) {
    const int tm = 6 * xcd + s % 6, tn = s / 6;
    const u16* ab = p.CAT + ((size_t)tm * 256 + ar0) * DM + ac;
    q0 = ab; q1 = ab + 64 * DM; q2 = ab + 128 * DM; q3 = ab + 192 * DM;
    bp = W + tn * 128 + 4 * n4 + (size_t)(kq * 4) * DM;
  };
  auto epi = [&](int s, f32x16(&acc)[2][4], int w, int r, int h) {
    int hq = h;
    asm volatile("" : "+v"(hq));
    const int tm = 6 * xcd + s % 6, tn = s / 6;
    const int m0 = tm * 256, n0 = tn * 128;
    const float* g1 = p.MOD + (size_t)(l * 5 + cond_of(m0)) * 6144 + 2048 + n0 + 4 * r;
    const float g0 = g1[0], g1v = g1[1], g2 = g1[2], g3 = g1[3];
#pragma unroll
    for (int mt = 0; mt < 2; ++mt)
#pragma unroll
    for (int i = 0; i < 16; ++i) {
      const int ml = w * 64 + mt * 32 + crow(i, hq);
      uint2 pk = {pack2(g0 * acc[mt][0][i], g1v * acc[mt][1][i]), pack2(g2 * acc[mt][2][i], g3 * acc[mt][3][i])};
      *(uint2*)(PREB + (size_t)(m0 + ml) * DM + n0 + 4 * r) = pk;
      if ((i & 3) == 3) __builtin_amdgcn_sched_barrier(0);
    }
  };
  gemm_phase<true>(smem, blockIdx.x >> 3, 48, nloc, setup, DM, epi);
}

DI void phase4(const Params& p, char* smem, int l, const float* xc, const float* xl) {
  float* swr = (float*)smem;
  const int tid = otid(), lane = tid & 63, w = tid >> 6;
  __syncthreads();
  for (int idx = tid; idx < 4096; idx += 256) {
    const float4 x = *(const float4*)(p.w_router + (size_t)l * DM * 16 + idx * 4);
    const int k = idx >> 2, e = (idx & 3) * 4;
    swr[(e + 0) * DM + k] = x.x; swr[(e + 1) * DM + k] = x.y; swr[(e + 2) * DM + k] = x.z; swr[(e + 3) * DM + k] = x.w;
  }
  __syncthreads();
  const float* lg = p.ln1g + l * DM;
  const float* lb = p.ln1b + l * DM;
  const int rstride = gridDim.x * 4;
  uint2 nprb[4];
  float4 nxi[4];
  {
    const int T0 = blockIdx.x * 4 + w;
    if (T0 < NTOK) {
      const float* xr0 = (T0 < NCTX) ? (xc + (size_t)T0 * DM) : (xl + (size_t)(T0 - NCTX) * DM);
#pragma unroll
      for (int i = 0; i < 4; ++i) {
        nprb[i] = *(const uint2*)((const u16*)p.PRE + (size_t)T0 * DM + 256 * i + 4 * lane);
        nxi[i] = *(const float4*)(xr0 + 256 * i + 4 * lane);
      }
    }
  }
  for (int T = blockIdx.x * 4 + w; T < NTOK; T += rstride) {
    const float* mod = p.MOD + (size_t)(l * 5 + cond_of(T)) * 6144;
    float4 x[4];
    float s = 0.f;
#pragma unroll
    for (int i = 0; i < 4; ++i) {
      const uint2 prb = nprb[i];
      const float4 xi = nxi[i];
      const float4 pr = {bflo(prb.x), bfhi(prb.x), bflo(prb.y), bfhi(prb.y)};
      x[i].x = ALPHA * xi.x + pr.x; x[i].y = ALPHA * xi.y + pr.y; x[i].z = ALPHA * xi.z + pr.z; x[i].w = ALPHA * xi.w + pr.w;
      s += x[i].x + x[i].y + x[i].z + x[i].w;
    }
    {
      const int Tn = T + rstride;
      if (Tn < NTOK) {
        const float* xrn = (Tn < NCTX) ? (xc + (size_t)Tn * DM) : (xl + (size_t)(Tn - NCTX) * DM);
#pragma unroll
        for (int i = 0; i < 4; ++i) {
          nprb[i] = *(const uint2*)((const u16*)p.PRE + (size_t)Tn * DM + 256 * i + 4 * lane);
          nxi[i] = *(const float4*)(xrn + 256 * i + 4 * lane);
        }
      }
    }
    const float mu = wave_sum(s) * (1.f / 1024.f);
    float vs = 0.f;
#pragma unroll
    for (int i = 0; i < 4; ++i) {
      x[i].x -= mu; x[i].y -= mu; x[i].z -= mu; x[i].w -= mu;
      vs += x[i].x * x[i].x + x[i].y * x[i].y + x[i].z * x[i].z + x[i].w * x[i].w;
    }
    const float rstd = rsqrtf(wave_sum(vs) * (1.f / 1024.f) + 1e-6f);
#pragma unroll
    for (int i = 0; i < 4; ++i) {
      const int k = 256 * i + 4 * lane;
      const float4 g = *(const float4*)(lg + k), bb = *(const float4*)(lb + k);
      float4 y;
      y.x = x[i].x * rstd * g.x + bb.x; y.y = x[i].y * rstd * g.y + bb.y; y.z = x[i].z * rstd * g.z + bb.z; y.w = x[i].w * rstd * g.w + bb.w;
      *(float4*)(p.X + (size_t)T * DM + k) = y;
      const float4 sc = *(const float4*)(mod + 4096 + k), sh = *(const float4*)(mod + 3072 + k);
      float4 hh;
      hh.x = y.x * (1.f + sc.x) + sh.x; hh.y = y.y * (1.f + sc.y) + sh.y; hh.z = y.z * (1.f + sc.z) + sh.z; hh.w = y.w * (1.f + sc.w) + sh.w;
      uint2 pk = {pack2(hh.x, hh.y), pack2(hh.z, hh.w)};
      *(uint2*)(p.H2 + (size_t)T * DM + k) = pk;
      x[i] = hh;
    }
    float a16[16];
#pragma unroll
    for (int e = 0; e < 16; ++e) {
      float a = 0.f;
#pragma unroll
      for (int i = 0; i < 4; ++i) {
        const float4 wv = *(const float4*)(swr + e * DM + 256 * i + 4 * lane);
        a += x[i].x * wv.x + x[i].y * wv.y + x[i].z * wv.z + x[i].w * wv.w;
      }
      a16[e] = a;
      if ((e & 3) == 3) __builtin_amdgcn_sched_barrier(0);
    }
    float a8[8], a4[4], a2[2], a1;
    {
      const bool hi = (lane & 32) != 0;
#pragma unroll
      for (int j = 0; j < 8; ++j) {
        const float snd = hi ? a16[j] : a16[8 + j];
        const float kp = hi ? a16[8 + j] : a16[j];
        a8[j] = kp + __shfl_xor(snd, 32);
      }
    }
    {
      const bool hi = (lane & 16) != 0;
#pragma unroll
      for (int j = 0; j < 4; ++j) {
        const float snd = hi ? a8[j] : a8[4 + j];
        const float kp = hi ? a8[4 + j] : a8[j];
        a4[j] = kp + __shfl_xor(snd, 16);
      }
    }
    {
      const bool hi = (lane & 8) != 0;
#pragma unroll
      for (int j = 0; j < 2; ++j) {
        const float snd = hi ? a4[j] : a4[2 + j];
        const float kp = hi ? a4[2 + j] : a4[j];
        a2[j] = kp + __shfl_xor(snd, 8);
      }
    }
    {
      const bool hi = (lane & 4) != 0;
      const float snd = hi ? a2[0] : a2[1];
      const float kp = hi ? a2[1] : a2[0];
      a1 = kp + __shfl_xor(snd, 4);
    }
    a1 += __shfl_xor(a1, 2);
    a1 += __shfl_xor(a1, 1);
    const int myexp = ((lane >> 5) & 1) * 8 + ((lane >> 4) & 1) * 4 + ((lane >> 3) & 1) * 2 + ((lane >> 2) & 1);
    float mx = a1;
#pragma unroll
    for (int o = 32; o >= 4; o >>= 1) mx = fmaxf(mx, __shfl_xor(mx, o));
    const float ex = __expf(a1 - mx);
    float den = ex;
#pragma unroll
    for (int o = 32; o >= 4; o >>= 1) den += __shfl_xor(den, o);
    if ((lane & 3) == 0) { p.AFF[(size_t)T * 16 + myexp] = ex / den; p.INV[(size_t)T * 16 + myexp] = -1; }
  }
}

DI unsigned block_incl_scan(unsigned v, unsigned* wsum, int lane, int w, unsigned& total) {
#pragma unroll
  for (int o = 1; o < 64; o <<= 1) {
    const unsigned t = __shfl_up(v, o);
    if (lane >= o) v += t;
  }
  __syncthreads();
  if (lane == 63) wsum[w] = v;
  __syncthreads();
  unsigned off = 0;
  total = 0;
#pragma unroll
  for (int i = 0; i < 4; ++i) {
    const unsigned s = wsum[i];
    if (i < w) off += s;
    total += s;
  }
  return v + off;
}

DI void phase5(const Params& p, char* smem) {
  unsigned* hist = (unsigned*)smem;
  unsigned* wsum = hist + 256;
  unsigned* bc = wsum + 4;
  const int tid = otid(), lane = tid & 63, w = tid >> 6;
  for (int item = blockIdx.x; item < 320; item += gridDim.x) {
    int n, base, e, cap, rowbase;
    if (item < 64) {
      const int b = item >> 4; e = item & 15;
      n = 2048; base = NCTX + b * 2048; cap = 256; rowbase = 512 + b * 256;
    } else {
      const int it = item - 64; const int rq = it >> 4; e = it & 15;
      n = 256; base = rq * 256; cap = 32; rowbase = rq * 32;
    }
    const int per = n >> 8;
    unsigned key[8];
#pragma unroll
    for (int q = 0; q < 8; ++q) key[q] = (q < per) ? __float_as_uint(p.AFF[(size_t)(base + tid * per + q) * 16 + e]) : 0u;
    unsigned prefix = 0u, mask = 0u;
    unsigned remaining = (unsigned)cap;
#pragma unroll 1
    for (int pass = 3; pass >= 0; --pass) {
      const int shift = pass * 8;
      __syncthreads();
      hist[tid] = 0u;
      __syncthreads();
#pragma unroll
      for (int q = 0; q < 8; ++q)
        if (q < per && (key[q] & mask) == prefix) atomicAdd(&hist[(key[q] >> shift) & 255u], 1u);
      __syncthreads();
      const unsigned hv = hist[tid];
      unsigned total;
      const unsigned incl = block_incl_scan(hv, wsum, lane, w, total);
      const unsigned above = total - incl;
      if (above < remaining && remaining <= above + hv) { bc[0] = (unsigned)tid; bc[1] = remaining - above; }
      __syncthreads();
      const unsigned bsel = bc[0];
      remaining = bc[1];
      prefix |= bsel << shift;
      mask |= 0xFFu << shift;
    }
    const unsigned thr = prefix;
    unsigned ceq = 0u;
#pragma unroll
    for (int q = 0; q < 8; ++q) ceq += (q < per && key[q] == thr) ? 1u : 0u;
    unsigned tot;
    unsigned eq_before = block_incl_scan(ceq, wsum, lane, w, tot) - ceq;
    unsigned selmask = 0u, nsel = 0u;
#pragma unroll
    for (int q = 0; q < 8; ++q) {
      if (q < per) {
        const bool eq = key[q] == thr;
        const bool sel = (key[q] > thr) || (eq && eq_before < remaining);
        eq_before += eq ? 1u : 0u;
        selmask |= sel ? (1u << q) : 0u;
        nsel += sel ? 1u : 0u;
      }
    }
    unsigned row = block_incl_scan(nsel, wsum, lane, w, tot) - nsel;
#pragma unroll
    for (int q = 0; q < 8; ++q) {
      if (q < per && ((selmask >> q) & 1u)) {
        const int tok = base + tid * per + q;
        const int rr = e * NROWS_E + rowbase + (int)row;
        p.SELTOK[rr] = tok;
        p.SELGATE[rr] = __uint_as_float(key[q]);
        p.INV[(size_t)tok * 16 + e] = rr;
        ++row;
      }
    }
  }
}

DI void phase6(const Params& p, char* smem, int l) {
  const int xcd = blockIdx.x & 7, nloc = gridDim.x >> 3;
  auto setup = [&](int s, int ar0, int ac, int n4, int kq, const u16*& q0, const u16*& q1, const u16*& q2, const u16*& q3, const float*& bp) {
    const int e = 2 * xcd + s / 96, rem = s % 96, tn = rem / 6, tm = rem % 6;
    const int* tok = p.SELTOK + e * NROWS_E + tm * 256 + ar0;
    q0 = p.H2 + (size_t)tok[0] * DM + ac; q1 = p.H2 + (size_t)tok[64] * DM + ac;
    q2 = p.H2 + (size_t)tok[128] * DM + ac; q3 = p.H2 + (size_t)tok[192] * DM + ac;
    bp = p.w_gu + ((size_t)l * 16 + e) * DM * 2048 + ((n4 >> 4) & 1) * 1024 + tn * 64 + 4 * (n4 & 15) + (size_t)(kq * 4) * 2048;
  };
  auto epi = [&](int s, f32x16(&acc)[2][4], int w, int r, int h) {
    int hq = h;
    asm volatile("" : "+v"(hq));
    const int e = 2 * xcd + s / 96, rem = s % 96, tn = rem / 6, tm = rem % 6;
    const int m0 = tm * 256, f0 = tn * 64;
    u16* act = p.ACT + ((size_t)e * NROWS_E + m0) * DM;
#pragma unroll
    for (int mt = 0; mt < 2; ++mt)
#pragma unroll
    for (int i = 0; i < 16; ++i) {
      const int ml = w * 64 + mt * 32 + crow(i, hq);
      const float a0 = acc[mt][0][i], a1 = acc[mt][1][i], a2 = acc[mt][2][i], a3 = acc[mt][3][i];
      const bool lo = r < 16;
      const float s0 = lo ? a2 : a0, s1 = lo ? a3 : a1;
      const float r0 = __shfl_xor(s0, 16), r1 = __shfl_xor(s1, 16);
      const float g0 = lo ? a0 : r0, g1 = lo ? a1 : r1;
      const float v0 = lo ? r0 : a2, v1 = lo ? r1 : a3;
      *(unsigned*)(act + (size_t)ml * DM + f0 + 4 * (r & 15) + (lo ? 0 : 2)) = pack2(silu(g0) * v0, silu(g1) * v1);
      if ((i & 3) == 3) __builtin_amdgcn_sched_barrier(0);
    }
  };
  gemm_phase<false>(smem, blockIdx.x >> 3, 192, nloc, setup, 2048, epi);
}

DI void phase7(const Params& p, char* smem, int l, u16* FF) {
  const int xcd = blockIdx.x & 7, nloc = gridDim.x >> 3;
  auto setup = [&](int s, int ar0, int ac, int n4, int kq, const u16*& q0, const u16*& q1, const u16*& q2, const u16*& q3, const float*& bp) {
    const int e = 2 * xcd + s / 48, rem = s % 48, tn = rem / 6, tm = rem % 6;
    const u16* ab = p.ACT + ((size_t)e * NROWS_E + tm * 256 + ar0) * DM + ac;
    q0 = ab; q1 = ab + 64 * DM; q2 = ab + 128 * DM; q3 = ab + 192 * DM;
    bp = p.w_down + ((size_t)l * 16 + e) * DM * DM + tn * 128 + 4 * n4 + (size_t)(kq * 4) * DM;
  };
  auto epi = [&](int s, f32x16(&acc)[2][4], int w, int r, int h) {
    int hq = h;
    asm volatile("" : "+v"(hq));
    const int e = 2 * xcd + s / 48, rem = s % 48, tn = rem / 6, tm = rem % 6;
    const int m0 = tm * 256, n0 = tn * 128;
    const float* gate = p.SELGATE + e * NROWS_E + m0;
#pragma unroll
    for (int mt = 0; mt < 2; ++mt)
#pragma unroll
    for (int i = 0; i < 16; ++i) {
      const int ml = w * 64 + mt * 32 + crow(i, hq);
      const float g = gate[ml];
      uint2 pk = {pack2(g * acc[mt][0][i], g * acc[mt][1][i]), pack2(g * acc[mt][2][i], g * acc[mt][3][i])};
      *(uint2*)(FF + ((size_t)e * NROWS_E + m0 + ml) * DM + n0 + 4 * r) = pk;
      if ((i & 3) == 3) __builtin_amdgcn_sched_barrier(0);
    }
  };
  gemm_phase<true>(smem, blockIdx.x >> 3, 96, nloc, setup, DM, epi);
}

DI void phase8(const Params& p, int l, float* dst, bool write_h) {
  const int tid = otid(), lane = tid & 63, w = tid >> 6;
  const float* lg = p.ln2g + l * DM;
  const float* lb = p.ln2b + l * DM;
  const int rstride = gridDim.x * 4;
  float4 nxa[4];
  int ninv = -1;
  {
    const int T0 = blockIdx.x * 4 + w;
    if (T0 < NTOK) {
#pragma unroll
      for (int i = 0; i < 4; ++i) nxa[i] = *(const float4*)(p.X + (size_t)T0 * DM + 256 * i + 4 * lane);
      ninv = (lane < 16) ? p.INV[(size_t)T0 * 16 + lane] : -1;
    }
  }
  for (int T = blockIdx.x * 4 + w; T < NTOK; T += rstride) {
    const float* g2 = p.MOD + (size_t)(l * 5 + cond_of(T)) * 6144 + 5120;
    const float* modn = p.MOD + (size_t)(5 + cond_of(T)) * 6144;
    float4 x[4], ff[4], xa[4];
#pragma unroll
    for (int i = 0; i < 4; ++i) { ff[i] = make_float4(0.f, 0.f, 0.f, 0.f); xa[i] = nxa[i]; }
    const int myinv = ninv;
    {
      const int Tn = T + rstride;
      if (Tn < NTOK) {
#pragma unroll
        for (int i = 0; i < 4; ++i) nxa[i] = *(const float4*)(p.X + (size_t)Tn * DM + 256 * i + 4 * lane);
        ninv = (lane < 16) ? p.INV[(size_t)Tn * 16 + lane] : -1;
      }
    }
    unsigned long long sel = __ballot(myinv >= 0);
#pragma unroll 1
    while (sel) {
      int rows[4];
#pragma unroll
      for (int q = 0; q < 4; ++q) {
        if (sel) {
          const int e = __ffsll((long long)sel) - 1;
          sel &= sel - 1;
          rows[q] = __shfl(myinv, e);
        } else {
          rows[q] = -1;
        }
      }
      uint2 y[4][4];
#pragma unroll
      for (int q = 0; q < 4; ++q) {
        const u16* yr = p.YE + (size_t)(rows[q] >= 0 ? rows[q] : 0) * DM + 4 * lane;
#pragma unroll
        for (int i = 0; i < 4; ++i) y[q][i] = *(const uint2*)(yr + 256 * i);
      }
#pragma unroll
      for (int q = 0; q < 4; ++q) {
        const float wq = rows[q] >= 0 ? 1.f : 0.f;
#pragma unroll
        for (int i = 0; i < 4; ++i) {
          ff[i].x += wq * bflo(y[q][i].x); ff[i].y += wq * bfhi(y[q][i].x); ff[i].z += wq * bflo(y[q][i].y); ff[i].w += wq * bfhi(y[q][i].y);
        }
      }
    }
    float s = 0.f;
#pragma unroll
    for (int i = 0; i < 4; ++i) {
      const int k = 256 * i + 4 * lane;
      const float4 a = xa[i];
      const float4 f = ff[i];
      const float4 g = *(const float4*)(g2 + k);
      x[i].x = ALPHA * a.x + g.x * f.x; x[i].y = ALPHA * a.y + g.y * f.y; x[i].z = ALPHA * a.z + g.z * f.z; x[i].w = ALPHA * a.w + g.w * f.w;
      s += x[i].x + x[i].y + x[i].z + x[i].w;
    }
    const float mu = wave_sum(s) * (1.f / 1024.f);
    float vs = 0.f;
#pragma unroll
    for (int i = 0; i < 4; ++i) {
      x[i].x -= mu; x[i].y -= mu; x[i].z -= mu; x[i].w -= mu;
      vs += x[i].x * x[i].x + x[i].y * x[i].y + x[i].z * x[i].z + x[i].w * x[i].w;
    }
    const float rstd = rsqrtf(wave_sum(vs) * (1.f / 1024.f) + 1e-6f);
#pragma unroll
    for (int i = 0; i < 4; ++i) {
      const int k = 256 * i + 4 * lane;
      const float4 g = *(const float4*)(lg + k), bb = *(const float4*)(lb + k);
      float4 y;
      y.x = x[i].x * rstd * g.x + bb.x; y.y = x[i].y * rstd * g.y + bb.y; y.z = x[i].z * rstd * g.z + bb.z; y.w = x[i].w * rstd * g.w + bb.w;
      *(float4*)(dst + (size_t)T * DM + k) = y;
      if (write_h) {
        const float4 sc = *(const float4*)(modn + 1024 + k), sh = *(const float4*)(modn + k);
        uint2 pk = {pack2(y.x * (1.f + sc.x) + sh.x, y.y * (1.f + sc.y) + sh.y), pack2(y.z * (1.f + sc.z) + sh.z, y.w * (1.f + sc.w) + sh.w)};
        *(uint2*)(p.H2 + (size_t)T * DM + k) = pk;
      }
    }
  }
}

constexpr int kDynLds = 73728;
__global__ void __launch_bounds__(256, 2) mega(Params p) {
  extern __shared__ __attribute__((aligned(16))) char smem[];
  cg::grid_group grid = cg::this_grid();
  if (p.never) grid.sync();
  GBar gb;
  gb.bar = p.BAR; gb.x = xb_xcc_id(); gb.nloc = 0u; gb.nx = 0u;
  if (threadIdx.x == 0) (void)xb_add(&p.BAR[XB_XCNT(gb.x)], 1u);
  phase0(p, smem);
  gbar(gb);
  phase0b(p);
  gbar(gb);
#pragma unroll 1
  for (int l = 0; l < 2; ++l) {
    const float* xc = (l == 0) ? p.x_prompt : p.X;
    const float* xl = (l == 0) ? p.x_sample : (p.X + (size_t)NCTX * DM);
    phase1(p, smem, l);
    gbar(gb);
    if (PROBE == 1) { phase1(p, smem, l); gbar(gb); }
    phase2(p, smem, l);
    gbar(gb);
    if (PROBE == 3) { phase2(p, smem, l); gbar(gb); }
    phase2c(p, smem, l);
    gbar(gb);
    if (PROBE == 3) { phase2c(p, smem, l); gbar(gb); }
    phase3(p, smem, l, xc, xl);
    gbar(gb);
    if (PROBE == 1) { phase3(p, smem, l, xc, xl); gbar(gb); }
    phase4(p, smem, l, xc, xl);
    gbar(gb);
    phase5(p, smem);
    gbar(gb);
    phase6(p, smem, l);
    gbar(gb);
    if (PROBE == 1) { phase6(p, smem, l); gbar(gb); }
    phase7(p, smem, l, p.YE);
    gbar(gb);
    phase8(p, l, (l == 1) ? p.out : p.X, l == 0);
    if (l == 0) gbar(gb);
  }
}

extern "C" void kernel_launch(void* const* d_in, const int* in_sizes, int n_in, void* d_out, int out_size, void* d_ws,
                              size_t ws_size, hipStream_t stream) {
  static int grid_blocks = 0;
  if (!grid_blocks) {
    int dev = 0, cus = 0, per_cu = 0;
    hipGetDevice(&dev);
    hipDeviceGetAttribute(&cus, hipDeviceAttributeMultiprocessorCount, dev);
    hipFuncSetAttribute((const void*)mega, hipFuncAttributeMaxDynamicSharedMemorySize, kDynLds);
    hipOccupancyMaxActiveBlocksPerMultiprocessor(&per_cu, mega, 256, kDynLds);
    if (per_cu > 2) per_cu = 2;
    if (per_cu < 1) per_cu = 1;
    grid_blocks = cus * per_cu;
  }
  Params p{};
  const float** pf = (const float**)&p;
  for (int i = 0; i < 24; ++i) pf[i] = (const float*)d_in[i];
  p.out = (float*)d_out;
  char* ws = (char*)d_ws;
  size_t off = 0;
  auto take = [&](size_t bytes) { char* q = ws + off; off += (bytes + 255) & ~(size_t)255; return q; };
  p.MOD = (float*)take(2 * 5 * 6144 * 4);
  p.BAR = (unsigned*)take(XCD_BAR_WORDS * 4);
  p.ROPE = (float*)take(2048 * 4);
  p.X = (float*)take((size_t)NTOK * DM * 4);
  p.PRE = (float*)take((size_t)NTOK * DM * 4);
  p.KVS = (float*)take((size_t)20 * 4 * 2 * 16 * 4096 * 4);
  p.AFF = (float*)take((size_t)NTOK * 16 * 4);
  p.SELGATE = (float*)take((size_t)16 * NROWS_E * 4);
  p.SELTOK = (int*)take((size_t)16 * NROWS_E * 4);
  p.QKV = (u16*)take((size_t)NTOK * DIN * 2);
  p.CAT = (u16*)take((size_t)NTOK * DM * 2);
  p.H2 = (u16*)take((size_t)NTOK * DM * 2);
  p.ACT = (u16*)take((size_t)16 * NROWS_E * DM * 2);
  p.YE = (u16*)take((size_t)16 * NROWS_E * DM * 2);
  p.INV = (int*)take((size_t)NTOK * 16 * 4);
  p.CAK = (u16*)take((size_t)4 * 2 * 512 * 128 * 2);
  p.CAV = (u16*)take((size_t)4 * 2 * 512 * 128 * 2);
  p.CBK = (u16*)take((size_t)4 * 2 * 512 * 256 * 2);
  p.CBV = (u16*)take((size_t)4 * 2 * 512 * 256 * 2);
  p.never = 0;
  hipMemsetAsync(p.MOD, 0, (size_t)((char*)p.BAR - (char*)p.MOD) + XCD_BAR_WORDS * 4, stream);
  void* args[] = {&p};
  hipError_t e = hipLaunchCooperativeKernel((void*)mega, dim3(grid_blocks), dim3(256), args, kDynLds, stream);
  if (e != hipSuccess) fprintf(stderr, "cooperative launch failed: %s (grid %d)\n", hipGetErrorString(e), grid_blocks);
}
```

```cpp
#include <hip/hip_runtime.h>
#include <hip/hip_cooperative_groups.h>
#include <cstdio>
namespace cg = cooperative_groups;

#define DI __device__ __forceinline__
typedef short bf16x8 __attribute__((ext_vector_type(8)));
typedef float f32x16 __attribute__((ext_vector_type(16)));
typedef __bf16 bf2_t __attribute__((ext_vector_type(2)));
typedef float f2_t __attribute__((ext_vector_type(2)));
typedef unsigned short u16;
typedef unsigned u32x4 __attribute__((ext_vector_type(4)));
typedef float f32x4 __attribute__((ext_vector_type(4)));
typedef float f32x2 __attribute__((ext_vector_type(2)));

#define MFMA(a, b, c) __builtin_amdgcn_mfma_f32_32x32x16_bf16((a), (b), (c), 0, 0, 0)

#define PROBE 0
constexpr int NTOK = 12288;
constexpr int NCTX = 4096;
constexpr int DM = 1024;
constexpr int DIN = 2560;
constexpr int LDT = 72;
constexpr int LDT2 = 136;
constexpr int NROWS_E = 1536;
constexpr float NEG = -1e30f;
constexpr float ALPHA = 1.41421356237f;

constexpr size_t OFF_AK = 12582912, OFF_AV = 13631488, OFF_BK = 14680064, OFF_BV = 16777216, OFF_ST = 18874368;

struct Params {
  const float *x_prompt, *x_sample, *cak, *cav, *cbk, *cbv, *state, *c, *c_ctx, *w_ada, *b_ada, *w_in, *w_out, *sink, *rpb,
      *decay, *gn, *ln1g, *ln1b, *ln2g, *ln2b, *w_router, *w_gu, *w_down;
  float* out;
  float *MOD, *ROPE, *X, *PRE, *KVS, *AFF, *SELGATE;
  int* SELTOK;
  u16 *QKV, *CAT, *H2, *ACT, *CAK, *CAV, *CBK, *CBV;
  u16* YE;
  int* INV;
  unsigned* BAR;
  long never;
};

DI unsigned pack2(float a, float b) {
  f2_t v = {a, b};
  bf2_t r = __builtin_convertvector(v, bf2_t);
  return __builtin_bit_cast(unsigned, r);
}
DI int otid() { int x = threadIdx.x; asm volatile("" : "+v"(x)); return x; }
DI float bflo(unsigned u) { return __uint_as_float(u << 16); }
DI float bfhi(unsigned u) { return __uint_as_float(u & 0xffff0000u); }
DI int crow(int i, int h) { return (i & 3) + 8 * (i >> 2) + 4 * h; }
DI float silu(float x) { return x / (1.f + __expf(-x)); }
DI float wave_sum(float v) {
#pragma unroll
  for (int o = 32; o >= 1; o >>= 1) v += __shfl_xor(v, o);
  return v;
}
DI bf16x8 mk8(unsigned a, unsigned b, unsigned c, unsigned d) {
  uint4 u = {a, b, c, d};
  return __builtin_bit_cast(bf16x8, u);
}


#define XB_TMO 128
#define XB_XCNT(j) (256 + 64 * (j))
#define XB_XSUB(j) (1280 + 64 * (j))
#define XB_XGEN(j) (2304 + 64 * (j))
#define XB_TOP 3328
#define XB_TOPGEN 3392
#define XCD_BAR_WORDS 3456
#define XB_SPIN_CAP (1u << 20)
DI unsigned xb_ld(unsigned* p) { return __hip_atomic_load(p, __ATOMIC_RELAXED, __HIP_MEMORY_SCOPE_AGENT); }
DI unsigned xb_add(unsigned* p, unsigned v) { return __hip_atomic_fetch_add(p, v, __ATOMIC_RELAXED, __HIP_MEMORY_SCOPE_AGENT); }
DI unsigned xb_xcc_id() { return (unsigned)__builtin_amdgcn_s_getreg((3 << 11) | 20) & 0xFu; }
#define XB_SPIN(cond, bar)                                                            \
  do {                                                                                \
    unsigned _sp = 0;                                                                 \
    while (cond) {                                                                    \
      __builtin_amdgcn_s_sleep(1);                                                    \
      if ((++_sp & 255u) == 0u) {                                                     \
        if (xb_ld(&(bar)[XB_TMO])) break;                                             \
        if (_sp > XB_SPIN_CAP) { atomicAdd(&(bar)[XB_TMO], 1u); break; }              \
      }                                                                               \
    }                                                                                 \
  } while (0)
struct GBar { unsigned* bar; unsigned x, nloc, nx; };
DI void gbar_complete(unsigned* bar, unsigned x, unsigned& nloc, unsigned& nx) {
  const unsigned G = gridDim.x;
  unsigned sum, cnt, mine, sp = 0u;
  for (;;) {
    sum = 0u; cnt = 0u; mine = 0u;
#pragma unroll
    for (unsigned j = 0; j < 16; ++j) {
      const unsigned c = xb_ld(&bar[XB_XCNT(j)]);
      sum += c; cnt += (c > 0u) ? 1u : 0u; mine = (j == x) ? c : mine;
    }
    if (sum == G) break;
    __builtin_amdgcn_s_sleep(1);
    if ((++sp & 255u) == 0u) {
      if (xb_ld(&bar[XB_TMO])) break;
      if (sp > XB_SPIN_CAP) { atomicAdd(&bar[XB_TMO], 1u); break; }
    }
  }
  nloc = mine > 0u ? mine : 1u;
  nx = cnt > 0u ? cnt : 1u;
}
DI void gbar(GBar& b) {
  asm volatile("s_waitcnt vmcnt(0)" ::: "memory");
  __syncthreads();
  if (threadIdx.x == 0) {
    unsigned* bar = b.bar;
    __builtin_amdgcn_s_waitcnt(0);
    if (b.nloc == 0u) gbar_complete(bar, b.x, b.nloc, b.nx);
    const unsigned nloc = b.nloc, nx = b.nx;
    const unsigned old = xb_add(&bar[XB_XSUB(b.x)], 1u);
    const unsigned gen = old / nloc;
    if (old + 1u == (gen + 1u) * nloc) {
      __builtin_amdgcn_fence(__ATOMIC_RELEASE, "agent");
      asm volatile("s_waitcnt vmcnt(0)" ::: "memory");
      const unsigned og = xb_add(&bar[XB_TOP], 1u);
      const unsigned tg = og / nx;
      if (og + 1u == (tg + 1u) * nx) xb_add(&bar[XB_TOPGEN], 1u);
      else XB_SPIN(xb_ld(&bar[XB_TOPGEN]) == tg, bar);
      __builtin_amdgcn_fence(__ATOMIC_ACQUIRE, "agent");
      xb_add(&bar[XB_XGEN(b.x)], 1u);
      asm volatile("s_waitcnt vmcnt(0)" ::: "memory");
    } else {
      XB_SPIN(xb_ld(&bar[XB_XGEN(b.x)]) == gen, bar);
      __builtin_amdgcn_fence(__ATOMIC_ACQUIRE, "agent");
      asm volatile("s_waitcnt vmcnt(0)" ::: "memory");
    }
  }
  __syncthreads();
}

template <class Setup, class Epi>
DI void gemm_phase128(char* smem, int s0, int s_end, int s_step, Setup setup, int ldb, Epi epi) {
  if (s0 >= s_end) return;
  u16* sA0 = (u16*)smem;
  u16* sB0 = sA0 + 128 * LDT;
  u16* sA1 = sB0 + 128 * LDT;
  u16* sB1 = sA1 + 128 * LDT;
  const int tid = otid(), lane = tid & 63, w = tid >> 6, r = lane & 31, h = lane >> 5;
  const int a_r0 = tid >> 3, a_c = (tid & 7) * 8;
  const int b_n4 = tid & 31, b_kq = tid >> 5;
  const u16 *apb0, *apb1, *apb2, *apb3;
  const float* bp;
  setup(s0, a_r0, a_c, b_n4, b_kq, apb0, apb1, apb2, apb3, bp);

  u32x4 pa0, pa1, pa2, pa3;
  f32x4 pb[8];

#define G_LOAD(KT)                                                                       \
  {                                                                                      \
    const int k0_ = (KT) * 64;                                                           \
    pa0 = *(const u32x4*)(apb0 + k0_);                                                   \
    pa1 = *(const u32x4*)(apb1 + k0_);                                                   \
    pa2 = *(const u32x4*)(apb2 + k0_);                                                   \
    pa3 = *(const u32x4*)(apb3 + k0_);                                                   \
    _Pragma("unroll") for (int i_ = 0; i_ < 8; ++i_) pb[i_] = *(const f32x4*)(bp + (size_t)(k0_ + i_) * ldb); \
  }
#define G_STAGE(SA, SBB)                                                                 \
  {                                                                                      \
    *(u32x4*)&SA[(a_r0)*LDT + a_c] = pa0;                                                \
    *(u32x4*)&SA[(a_r0 + 32) * LDT + a_c] = pa1;                                         \
    *(u32x4*)&SA[(a_r0 + 64) * LDT + a_c] = pa2;                                         \
    *(u32x4*)&SA[(a_r0 + 96) * LDT + a_c] = pa3;                                         \
    _Pragma("unroll") for (int j_ = 0; j_ < 4; ++j_) {                                   \
      u32x4 pk_;                                                                         \
      pk_.x = pack2(pb[0][j_], pb[1][j_]);                                               \
      pk_.y = pack2(pb[2][j_], pb[3][j_]);                                               \
      pk_.z = pack2(pb[4][j_], pb[5][j_]);                                               \
      pk_.w = pack2(pb[6][j_], pb[7][j_]);                                               \
      *(u32x4*)&SBB[(j_ * 32 + b_n4) * LDT + b_kq * 8] = pk_;                            \
    }                                                                                    \
  }
  const int aoff = (w * 32 + r) * LDT + 8 * h, boff = r * LDT + 8 * h;
#define G_FRAG(BUF, SA, SBB, KS)                                                         \
  {                                                                                      \
    fa[BUF] = *(const bf16x8*)(SA + aoff + (KS) * 16);                                   \
    fb[BUF][0] = *(const bf16x8*)(SBB + boff + (KS) * 16);                               \
    fb[BUF][1] = *(const bf16x8*)(SBB + boff + 32 * LDT + (KS) * 16);                    \
    fb[BUF][2] = *(const bf16x8*)(SBB + boff + 64 * LDT + (KS) * 16);                    \
    fb[BUF][3] = *(const bf16x8*)(SBB + boff + 96 * LDT + (KS) * 16);                    \
  }
#define G_MFMA(BUF)                                                                      \
  {                                                                                      \
    acc[0] = MFMA(fa[BUF], fb[BUF][0], acc[0]);                                          \
    acc[1] = MFMA(fa[BUF], fb[BUF][1], acc[1]);                                          \
    acc[2] = MFMA(fa[BUF], fb[BUF][2], acc[2]);                                          \
    acc[3] = MFMA(fa[BUF], fb[BUF][3], acc[3]);                                          \
  }
#define SB() __builtin_amdgcn_sched_barrier(0)
#define G_COMPUTE(SA, SBB)                                                               \
  {                                                                                      \
    bf16x8 fa[2], fb[2][4];                                                              \
    G_FRAG(0, SA, SBB, 0);                                                               \
    G_FRAG(1, SA, SBB, 1);                                                               \
    SB();                                                                                \
    G_MFMA(0);                                                                           \
    SB();                                                                                \
    G_FRAG(0, SA, SBB, 2);                                                               \
    SB();                                                                                \
    G_MFMA(1);                                                                           \
    SB();                                                                                \
    G_FRAG(1, SA, SBB, 3);                                                               \
    SB();                                                                                \
    G_MFMA(0);                                                                           \
    SB();                                                                                \
    G_MFMA(1);                                                                           \
    SB();                                                                                \
  }

  G_LOAD(0);
  __syncthreads();
#pragma unroll 1
  for (int s = s0; s < s_end; s += s_step) {
    f32x16 acc[4];
#pragma unroll
    for (int a = 0; a < 4; ++a)
#pragma unroll
      for (int i = 0; i < 16; ++i) acc[a][i] = 0.f;
    const int sn = s + s_step;
    const bool has_next = sn < s_end;
    const u16 *n0 = apb0, *n1 = apb1, *n2 = apb2, *n3 = apb3;
    const float* nbp = bp;
    if (has_next) setup(sn, a_r0, a_c, b_n4, b_kq, n0, n1, n2, n3, nbp);
#pragma unroll 1
    for (int kt = 0; kt < 16; kt += 2) {
      G_STAGE(sA0, sB0);
      __syncthreads();
      G_LOAD(kt + 1);
      G_COMPUTE(sA0, sB0);
      G_STAGE(sA1, sB1);
      __syncthreads();
      {
        int kn = kt + 2;
        if (kt == 14) { apb0 = n0; apb1 = n1; apb2 = n2; apb3 = n3; bp = nbp; kn = 0; }
        G_LOAD(kn);
      }
      G_COMPUTE(sA1, sB1);
    }
    epi(s, acc, w, r, h);
  }
  __syncthreads();
#undef G_LOAD
#undef G_STAGE
#undef G_COMPUTE
#undef G_FRAG
#undef G_MFMA
}
#undef SB

template <bool CONTIG, class Setup, class Epi, class Pre>
DI void gemm_phase(char* smem, int s0, int s_end, int s_step, Setup setup, int ldb, Epi epi, Pre pre) {
  asm volatile("" : "+s"(s_end));
  if (s0 >= s_end) return;
  constexpr int LDK = 40;
  u16* sA0 = (u16*)smem;
  u16* sB0 = sA0 + 256 * LDK;
  u16* sA1 = sB0 + 128 * LDK;
  u16* sB1 = sA1 + 256 * LDK;
  const int tid = otid(), lane = tid & 63, w = tid >> 6, r = lane & 31, h = lane >> 5;
  const int a_r0 = tid >> 2, a_c = (tid & 3) * 8;
  const int b_n4 = tid & 31, b_kq = tid >> 5;
  const u16* abase;
  const float* bbase;
  unsigned ao0, ao1, ao2, ao3, bo;
  setup(s0, a_r0, a_c, b_n4, b_kq, abase, ao0, ao1, ao2, ao3, bbase, bo);

  u32x4 pa0, pa1, pa2, pa3;
  f32x4 pbA[4], pbB[4];

#define G_LOADA(KT)                                                                      \
  {                                                                                      \
    const int k0_ = (KT) * 32;                                                           \
    pa0 = *(const u32x4*)(abase + k0_ + (size_t)ao0);                                    \
    pa1 = *(const u32x4*)(abase + k0_ + (size_t)(CONTIG ? ao0 + 64u * DM : ao1));        \
    pa2 = *(const u32x4*)(abase + k0_ + (size_t)(CONTIG ? ao0 + 128u * DM : ao2));       \
    pa3 = *(const u32x4*)(abase + k0_ + (size_t)(CONTIG ? ao0 + 192u * DM : ao3));       \
  }
#define G_LOADB(PB, BP, KT)                                                              \
  {                                                                                      \
    const int k0_ = (KT) * 32;                                                           \
    _Pragma("unroll") for (int i_ = 0; i_ < 4; ++i_) PB[i_] = *(const f32x4*)((BP) + (size_t)(k0_ + i_) * ldb + (size_t)bo); \
  }
#define G_STAGE(SA, SBB, PB)                                                               \
  {                                                                                      \
    *(u32x4*)&SA[(a_r0)*LDK + a_c] = pa0;                                                \
    *(u32x4*)&SA[(a_r0 + 64) * LDK + a_c] = pa1;                                         \
    *(u32x4*)&SA[(a_r0 + 128) * LDK + a_c] = pa2;                                        \
    *(u32x4*)&SA[(a_r0 + 192) * LDK + a_c] = pa3;                                        \
    _Pragma("unroll") for (int j_ = 0; j_ < 4; ++j_) {                                   \
      uint2 pk_;                                                                         \
      pk_.x = pack2(PB[0][j_], PB[1][j_]);                                               \
      pk_.y = pack2(PB[2][j_], PB[3][j_]);                                               \
      *(uint2*)&SBB[(j_ * 32 + b_n4) * LDK + b_kq * 4] = pk_;                            \
    }                                                                                    \
  }
  const int aoff = (w * 64 + r) * LDK + 8 * h, boff = r * LDK + 8 * h;
#define G_FRAG(FA, FB, SA, SBB, KS)                                                      \
  {                                                                                      \
    FA[0] = *(const bf16x8*)(SA + aoff + (KS) * 16);                                     \
    FA[1] = *(const bf16x8*)(SA + aoff + 32 * LDK + (KS) * 16);                          \
    FB[0] = *(const bf16x8*)(SBB + boff + (KS) * 16);                                    \
    FB[1] = *(const bf16x8*)(SBB + boff + 32 * LDK + (KS) * 16);                         \
    FB[2] = *(const bf16x8*)(SBB + boff + 64 * LDK + (KS) * 16);                         \
    FB[3] = *(const bf16x8*)(SBB + boff + 96 * LDK + (KS) * 16);                         \
  }
#define G_MFMA(FA, FB)                                                                   \
  {                                                                                      \
    _Pragma("unroll") for (int mt_ = 0; mt_ < 2; ++mt_)                                  \
    _Pragma("unroll") for (int nt_ = 0; nt_ < 4; ++nt_) acc[mt_][nt_] = MFMA(FA[mt_], FB[nt_], acc[mt_][nt_]); \
  }
#define SB() __builtin_amdgcn_sched_barrier(0)
#define G_COMPUTE(SA, SBB)                                                               \
  {                                                                                      \
    bf16x8 fa0[2], fb0[4];                                                               \
    G_FRAG(fa0, fb0, SA, SBB, 0);                                                        \
    SB();                                                                                \
    G_MFMA(fa0, fb0);                                                                    \
    SB();                                                                                \
    G_FRAG(fa0, fb0, SA, SBB, 1);                                                        \
    SB();                                                                                \
    G_MFMA(fa0, fb0);                                                                    \
    SB();                                                                                \
  }

  G_LOADA(0);
  G_LOADB(pbA, bbase, 0);
  G_LOADB(pbB, bbase, 1);
  __syncthreads();
#pragma unroll 1
  for (int s = s0; s < s_end; s += s_step) {
    f32x16 acc[2][4];
#pragma unroll
    for (int a = 0; a < 2; ++a)
#pragma unroll
      for (int b = 0; b < 4; ++b)
#pragma unroll
        for (int i = 0; i < 16; ++i) acc[a][b][i] = 0.f;
    pre(s, tid);
    const int sn = s + s_step;
    const bool has_next = sn < s_end;
    const u16* nabase = abase;
    const float* nbbase = bbase;
    unsigned n0 = ao0, n1 = ao1, n2 = ao2, n3 = ao3, nbo = bo;
    if (has_next) setup(sn, a_r0, a_c, b_n4, b_kq, nabase, n0, n1, n2, n3, nbbase, nbo);
#pragma unroll 1
    for (int kt = 0; kt < 32; kt += 2) {
      G_STAGE(sA0, sB0, pbA);
      __syncthreads();
      G_LOADA(kt + 1);
      {
        const bool last = (kt == 30);
        const float* bq = last ? nbbase : bbase;
        const int kb = last ? 0 : kt + 2;
        G_LOADB(pbA, bq, kb);
      }
      G_COMPUTE(sA0, sB0);
      G_STAGE(sA1, sB1, pbB);
      __syncthreads();
      {
        int ka = kt + 2, kb = kt + 3;
        if (kt == 30) { abase = nabase; ao0 = n0; ao1 = n1; ao2 = n2; ao3 = n3; bbase = nbbase; ka = 0; kb = 1; }
        G_LOADA(ka);
        G_LOADB(pbB, bbase, kb);
      }
      G_COMPUTE(sA1, sB1);
    }
    epi(s, acc, w, r, h);
  }
  __syncthreads();
#undef G_LOADA
#undef G_LOADB
#undef G_STAGE
#undef G_COMPUTE
#undef G_FRAG
#undef G_MFMA
}

DI void load4x4(const void* base, int stride, bool isf32, int rq, int c4, float v[4][4]) {
  if (isf32) {
#pragma unroll
    for (int i = 0; i < 4; ++i) {
      const float4 x = *(const float4*)((const float*)base + (size_t)(4 * rq + i) * stride + 4 * c4);
      v[i][0] = x.x; v[i][1] = x.y; v[i][2] = x.z; v[i][3] = x.w;
    }
  } else {
#pragma unroll
    for (int i = 0; i < 4; ++i) {
      const uint2 x = *(const uint2*)((const u16*)base + (size_t)(4 * rq + i) * stride + 4 * c4);
      v[i][0] = bflo(x.x); v[i][1] = bfhi(x.x); v[i][2] = bflo(x.y); v[i][3] = bfhi(x.y);
    }
  }
}
DI void store_n(u16* dst, int ld, int row0, int rq, int c4, const float v[4][4]) {
#pragma unroll
  for (int i = 0; i < 4; ++i) {
    uint2 pk = {pack2(v[i][0], v[i][1]), pack2(v[i][2], v[i][3])};
    *(uint2*)&dst[(row0 + 4 * rq + i) * ld + 4 * c4] = pk;
  }
}
DI void store_t(u16* dst, int ld, int col0, int rq, int c4, const float v[4][4], const float s[4]) {
#pragma unroll
  for (int j = 0; j < 4; ++j) {
    uint2 pk = {pack2(v[0][j] * s[0], v[1][j] * s[1]), pack2(v[2][j] * s[2], v[3][j] * s[3])};
    *(uint2*)&dst[(4 * c4 + j) * ld + col0 + 4 * rq] = pk;
  }
}

DI void attn_load(const u16* kp, const u16* vp, int stride, int rq, int c4, uint2 (&k)[4], uint2 (&v)[4]) {
#pragma unroll
  for (int i = 0; i < 4; ++i) {
    k[i] = *(const uint2*)(kp + (size_t)(4 * rq + i) * stride + 4 * c4);
    v[i] = *(const uint2*)(vp + (size_t)(4 * rq + i) * stride + 4 * c4);
  }
}
DI void attn_stage(u16* sK, u16* sVT, int rq, int c4, const uint2 (&k)[4], const uint2 (&v)[4]) {
#pragma unroll
  for (int i = 0; i < 4; ++i) *(uint2*)&sK[(4 * rq + i) * LDT + 4 * c4] = k[i];
  uint2 t0, t1, t2, t3;
  t0.x = (v[0].x & 0xffffu) | (v[1].x << 16);          t0.y = (v[2].x & 0xffffu) | (v[3].x << 16);
  t1.x = (v[0].x >> 16) | (v[1].x & 0xffff0000u);      t1.y = (v[2].x >> 16) | (v[3].x & 0xffff0000u);
  t2.x = (v[0].y & 0xffffu) | (v[1].y << 16);          t2.y = (v[2].y & 0xffffu) | (v[3].y << 16);
  t3.x = (v[0].y >> 16) | (v[1].y & 0xffff0000u);      t3.y = (v[2].y >> 16) | (v[3].y & 0xffff0000u);
  const int qs = 4 * (rq ^ ((c4 >> 1) & 7));
  *(uint2*)&sVT[(4 * c4 + 0) * LDT + qs] = t0;
  *(uint2*)&sVT[(4 * c4 + 1) * LDT + qs] = t1;
  *(uint2*)&sVT[(4 * c4 + 2) * LDT + qs] = t2;
  *(uint2*)&sVT[(4 * c4 + 3) * LDT + qs] = t3;
}

template <class TileSrc, class BiasF, class TMode>
DI void attn_core(char* smem, const u16* qbase, int ntiles, TileSrc src, BiasF biasf, TMode tmode, float m_init, bool has_sink, u16* obase) {
  u16* sK = (u16*)smem;
  u16* sVT = sK + 64 * LDT;
  const int tid = otid(), lane = tid & 63, w = tid >> 6, r = lane & 31, h = lane >> 5;
  const int rq = tid >> 4, c4 = tid & 15;
  const int ql = w * 32 + r;
  bf16x8 qf[4];
#pragma unroll
  for (int ks = 0; ks < 4; ++ks) qf[ks] = *(const bf16x8*)(qbase + (size_t)ql * DIN + ks * 16 + 8 * h);
  f32x16 O[2];
#pragma unroll
  for (int d = 0; d < 2; ++d)
#pragma unroll
    for (int i = 0; i < 16; ++i) O[d][i] = 0.f;
  float m = m_init, lsum = (has_sink && h == 0) ? 1.f : 0.f;

  auto nextv = [&](int j, const u16*& kp, const u16*& vp, int& stride) -> int {
    while (j < ntiles && !src(j, kp, vp, stride)) ++j;
    return j;
  };
  auto compute = [&](int jc) {
    const int mode = tmode(jc, w);
    if (mode != 2) {
      f32x16 S[2];
#pragma unroll
      for (int mt = 0; mt < 2; ++mt)
#pragma unroll
        for (int i = 0; i < 16; ++i) S[mt][i] = 0.f;
#pragma unroll
      for (int ks = 0; ks < 4; ++ks)
#pragma unroll
        for (int mt = 0; mt < 2; ++mt) {
          const bf16x8 kf = *(const bf16x8*)&sK[(mt * 32 + r) * LDT + ks * 16 + 8 * h];
          S[mt] = MFMA(kf, qf[ks], S[mt]);
        }
      const float C2 = 0.125f * 1.44269504f;
      float mx = NEG;
      if (mode == 1) {
#pragma unroll
        for (int mt = 0; mt < 2; ++mt)
#pragma unroll
          for (int i = 0; i < 16; ++i) {
            const float s = S[mt][i] * C2 + biasf(jc, mt * 32 + crow(i, h), ql);
            S[mt][i] = s;
            mx = fmaxf(mx, s);
          }
      } else {
#pragma unroll
        for (int mt = 0; mt < 2; ++mt)
#pragma unroll
          for (int i = 0; i < 16; ++i) {
            const float s = S[mt][i] * C2;
            S[mt][i] = s;
            mx = fmaxf(mx, s);
          }
      }
      mx = fmaxf(mx, __shfl_xor(mx, 32));
      const float mn = fmaxf(m, mx);
      if (__any(mn > m)) {
        const float alpha = __builtin_amdgcn_exp2f(m - mn);
        m = mn;
        lsum *= alpha;
#pragma unroll
        for (int d = 0; d < 2; ++d)
#pragma unroll
          for (int i = 0; i < 16; ++i) O[d][i] *= alpha;
      }
      float ps = 0.f;
#pragma unroll
      for (int mt = 0; mt < 2; ++mt)
#pragma unroll
        for (int i = 0; i < 16; ++i) {
          const float pv = __builtin_amdgcn_exp2f(S[mt][i] - m);
          S[mt][i] = pv;
          ps += pv;
        }
      lsum += ps;
#pragma unroll
      for (int mt = 0; mt < 2; ++mt)
#pragma unroll
        for (int s = 0; s < 2; ++s) {
          const bf16x8 pf = mk8(pack2(S[mt][8 * s + 0], S[mt][8 * s + 1]), pack2(S[mt][8 * s + 2], S[mt][8 * s + 3]),
                                pack2(S[mt][8 * s + 4], S[mt][8 * s + 5]), pack2(S[mt][8 * s + 6], S[mt][8 * s + 7]));
#pragma unroll
          for (int d = 0; d < 2; ++d) {
            const int sw = (d * 4 + (r >> 3)) & 7, q = mt * 8 + 4 * s + h;
            const u16* vrow = &sVT[(d * 32 + r) * LDT];
            const uint2 lo = *(const uint2*)(vrow + 4 * (q ^ sw));
            const uint2 hi = *(const uint2*)(vrow + 4 * ((q + 2) ^ sw));
            O[d] = MFMA(mk8(lo.x, lo.y, hi.x, hi.y), pf, O[d]);
          }
        }
    }
  };

  uint2 kA[4], vA[4], kB[4], vB[4];
#pragma unroll
  for (int i = 0; i < 4; ++i) { kA[i] = make_uint2(0u, 0u); vA[i] = kA[i]; kB[i] = kA[i]; vB[i] = kA[i]; }
  const u16 *kp = nullptr, *vp = nullptr;
  int stride = 0;
  int jA = nextv(0, kp, vp, stride);
  if (jA < ntiles) attn_load(kp, vp, stride, rq, c4, kA, vA);
  int jB = nextv(jA + 1, kp, vp, stride);
  if (jB < ntiles) attn_load(kp, vp, stride, rq, c4, kB, vB);
#pragma unroll 1
  for (;;) {
    if (jA >= ntiles) break;
    __syncthreads();
    attn_stage(sK, sVT, rq, c4, kA, vA);
    __syncthreads();
    {
      const int jc = jA;
      jA = nextv(jB + 1, kp, vp, stride);
      if (jA < ntiles) attn_load(kp, vp, stride, rq, c4, kA, vA);
      compute(jc);
    }
    if (jB >= ntiles) break;
    __syncthreads();
    attn_stage(sK, sVT, rq, c4, kB, vB);
    __syncthreads();
    {
      const int jc = jB;
      jB = nextv(jA + 1, kp, vp, stride);
      if (jB < ntiles) attn_load(kp, vp, stride, rq, c4, kB, vB);
      compute(jc);
    }
  }
  const float l = lsum + __shfl_xor(lsum, 32);
  const float inv = 1.f / l;
#pragma unroll
  for (int d = 0; d < 2; ++d)
#pragma unroll
    for (int g = 0; g < 4; ++g) {
      uint2 pk = {pack2(O[d][4 * g + 0] * inv, O[d][4 * g + 1] * inv), pack2(O[d][4 * g + 2] * inv, O[d][4 * g + 3] * inv)};
      *(uint2*)(obase + (size_t)ql * DM + d * 32 + 8 * g + 4 * h) = pk;
    }
}

DI void phase0(const Params& p, char* smem) {
  const int tid = otid();
  if (blockIdx.x == 0) {
    for (int idx = tid; idx < 1024; idx += 256) {
      const int pos = idx >> 4, j = idx & 15;
      const double inv = 1.0 / pow(10000.0, (double)j / 16.0);
      const float ang = (float)((double)pos * inv);
      p.ROPE[idx] = cosf(ang);
      p.ROPE[1024 + idx] = sinf(ang);
    }
  }
  float* scond = (float*)smem;
  for (int item = blockIdx.x; item < 768; item += gridDim.x) {
    const int l = item / 384, ks = (item / 24) % 16, jb = item % 24;
    __syncthreads();
    for (int idx = tid; idx < 320; idx += 256) {
      const int c = idx / 64, k = ks * 64 + (idx & 63);
      const float v = (c == 0) ? p.c_ctx[k] : p.c[(c - 1) * DM + k];
      scond[idx] = silu(v);
    }
    __syncthreads();
    const int j = jb * 256 + tid;
    const float* wp = p.w_ada + ((size_t)l * DM + ks * 64) * 6144 + j;
    float a[5] = {0.f, 0.f, 0.f, 0.f, 0.f};
#pragma unroll 8
    for (int k = 0; k < 64; ++k) {
      const float wv = wp[(size_t)k * 6144];
#pragma unroll
      for (int c = 0; c < 5; ++c) a[c] += scond[c * 64 + k] * wv;
    }
    const float bias = (ks == 0) ? p.b_ada[l * 6144 + j] : 0.f;
#pragma unroll
    for (int c = 0; c < 5; ++c) unsafeAtomicAdd(&p.MOD[(l * 5 + c) * 6144 + j], a[c] + bias);
  }
}

DI int cond_of(int T) { return T < NCTX ? 0 : 1 + ((T - NCTX) >> 11); }

DI void cvt_f32_bf16(const float* s, u16* d, int n4, int gtid, int gsz) {
  for (int i = gtid; i < n4; i += gsz) {
    const float4 x = *(const float4*)(s + (size_t)i * 4);
    uint2 pk = {pack2(x.x, x.y), pack2(x.z, x.w)};
    *(uint2*)(d + (size_t)i * 4) = pk;
  }
}
DI void phase0b(const Params& p) {
  const int tid = otid(), lane = tid & 63, w = tid >> 6;
  {
    const int gtid = blockIdx.x * 256 + tid, gsz = gridDim.x * 256;
    cvt_f32_bf16(p.cak, p.CAK, 4 * 2 * 512 * 128 / 4, gtid, gsz);
    cvt_f32_bf16(p.cav, p.CAV, 4 * 2 * 512 * 128 / 4, gtid, gsz);
    cvt_f32_bf16(p.cbk, p.CBK, 4 * 2 * 512 * 256 / 4, gtid, gsz);
    cvt_f32_bf16(p.cbv, p.CBV, 4 * 2 * 512 * 256 / 4, gtid, gsz);
  }
  for (int T = blockIdx.x * 4 + w; T < NTOK; T += gridDim.x * 4) {
    const float* mod = p.MOD + (size_t)cond_of(T) * 6144;
    const float* xr = (T < NCTX) ? (p.x_prompt + (size_t)T * DM) : (p.x_sample + (size_t)(T - NCTX) * DM);
#pragma unroll
    for (int i = 0; i < 4; ++i) {
      const int k = 256 * i + 4 * lane;
      const float4 x = *(const float4*)(xr + k);
      const float4 sc = *(const float4*)(mod + 1024 + k), sh = *(const float4*)(mod + k);
      uint2 pk = {pack2(x.x * (1.f + sc.x) + sh.x, x.y * (1.f + sc.y) + sh.y), pack2(x.z * (1.f + sc.z) + sh.z, x.w * (1.f + sc.w) + sh.w)};
      *(uint2*)(p.H2 + (size_t)T * DM + k) = pk;
    }
  }
}

DI void phase1(const Params& p, char* smem, int l) {
  const float* W = p.w_in + (size_t)l * DM * DIN;
  const int xcd = blockIdx.x & 7, nloc = gridDim.x >> 3;
  float* sR = (float*)(smem + 61440);
  for (int idx = otid(); idx < 2048; idx += 256) sR[idx] = p.ROPE[idx];
  auto setup = [&](int s, int ar0, int ac, int n4, int kq, const u16*& ab, unsigned& o0, unsigned& o1, unsigned& o2, unsigned& o3, const float*& bb, unsigned& bo) {
    const int tm = 6 * xcd + s % 6, tn = s / 6;
    ab = p.H2 + (size_t)tm * 256 * DM;
    o0 = (unsigned)(ar0 * DM + ac); o1 = o0 + 64u * DM; o2 = o0 + 128u * DM; o3 = o0 + 192u * DM;
    bb = W + tn * 128;
    bo = (unsigned)(4 * n4 + kq * 4 * DIN);
  };
  auto epi = [&](int s, f32x16(&acc)[2][4], int w, int r, int h) {
    int hq = h;
    asm volatile("" : "+v"(hq));
    const int tm = 6 * xcd + s % 6, tn = s / 6;
    const int m0 = tm * 256, n0 = tn * 128;
    const bool lat = m0 >= NCTX;
    const bool rope = lat && (n0 < 640);
    const int n = n0 + 4 * r;
    const int q = (r >> 2) & 3;
#pragma unroll
    for (int mt = 0; mt < 2; ++mt)
#pragma unroll
    for (int i = 0; i < 16; ++i) {
      const int T = m0 + w * 64 + mt * 32 + crow(i, hq);
      float v0 = acc[mt][0][i], v1 = acc[mt][1][i], v2 = acc[mt][2][i], v3 = acc[mt][3][i];
      if (rope) {
        const int t = (T - NCTX) & 2047;
        const int pos = (q < 2) ? (t >> 6) : (t & 63);
        const int jf = 4 * (r & 3);
        const float4 cs = *(const float4*)(sR + pos * 16 + jf), sn = *(const float4*)(sR + 1024 + pos * 16 + jf);
        const float o0 = __shfl_xor(v0, 4), o1 = __shfl_xor(v1, 4), o2 = __shfl_xor(v2, 4), o3 = __shfl_xor(v3, 4);
        if (q & 1) { v0 = o0 * sn.x + v0 * cs.x; v1 = o1 * sn.y + v1 * cs.y; v2 = o2 * sn.z + v2 * cs.z; v3 = o3 * sn.w + v3 * cs.w; }
        else { v0 = v0 * cs.x - o0 * sn.x; v1 = v1 * cs.y - o1 * sn.y; v2 = v2 * cs.z - o2 * sn.z; v3 = v3 * cs.w - o3 * sn.w; }
      }
      uint2 pk = {pack2(v0, v1), pack2(v2, v3)};
      *(uint2*)(p.QKV + (size_t)T * DIN + n) = pk;
      if (!lat) {
        const int b = T >> 8, t = T & 255;
        const float4 vv = {v0, v1, v2, v3};
        if (n0 == 512) *(float4*)(p.out + OFF_AK + ((size_t)(b * 2 + l) * 256 + t) * 128 + (n - 512)) = vv;
        else if (n0 == 640) *(float4*)(p.out + OFF_AV + ((size_t)(b * 2 + l) * 256 + t) * 128 + (n - 640)) = vv;
        else if (n0 == 1024 || n0 == 1152) *(float4*)(p.out + OFF_BK + ((size_t)(b * 2 + l) * 256 + t) * 256 + (n - 1024)) = vv;
        else if (n0 == 1280 || n0 == 1408) *(float4*)(p.out + OFF_BV + ((size_t)(b * 2 + l) * 256 + t) * 256 + (n - 1280)) = vv;
      }
      if ((i & 3) == 3) __builtin_amdgcn_sched_barrier(0);
    }
  };
  gemm_phase<true>(smem, blockIdx.x >> 3, 120, nloc, setup, DIN, epi, [](int, int) {});
}

DI float ret_lg(const Params& p, int l, int dir, int head) { return -__expf(p.decay[(l * 2 + dir) * 4 + head]); }

DI size_t kvs_slot(int req, int head, int dir, int c) { return ((size_t)((req * 4 + head) * 2 + dir) * 16 + c) * 4096; }

DI void retkv_item(const Params& p, char* smem, int l, int req, int head, int c) {
  u16* sKTf = (u16*)smem;
  u16* sKTb = sKTf + 64 * LDT2;
  u16* sVT = sKTb + 64 * LDT2;
  const int tid = otid(), lane = tid & 63, w = tid >> 6, r = lane & 31, h = lane >> 5;
  const int rq = tid >> 4, c4 = tid & 15;
  const int T0 = (req < 16 ? req * 256 : NCTX + (req - 16) * 2048) + c * 128;
  const float lgf = ret_lg(p, l, 0, head), lgb = ret_lg(p, l, 1, head);
  const float one4[4] = {1.f, 1.f, 1.f, 1.f};
  __syncthreads();
#pragma unroll
  for (int half = 0; half < 2; ++half) {
    float v[4][4];
    float sf[4], sb[4];
#pragma unroll
    for (int i = 0; i < 4; ++i) {
      const int j = half * 64 + 4 * rq + i;
      sf[i] = 0.125f * __expf(lgf * (float)(127 - j));
      sb[i] = 0.125f * __expf(lgb * (float)j);
    }
    load4x4(p.QKV + (size_t)(T0 + half * 64) * DIN + 1792 + head * 64, DIN, false, rq, c4, v);
    store_t(sKTf, LDT2, half * 64, rq, c4, v, sf);
    store_t(sKTb, LDT2, half * 64, rq, c4, v, sb);
    load4x4(p.QKV + (size_t)(T0 + half * 64) * DIN + 2048 + head * 64, DIN, false, rq, c4, v);
    store_t(sVT, LDT2, half * 64, rq, c4, v, one4);
  }
  __syncthreads();
  const int dir = w >> 1, mt = w & 1;
  const u16* sKT = dir ? sKTb : sKTf;
  f32x16 acc[2];
#pragma unroll
  for (int nt = 0; nt < 2; ++nt)
#pragma unroll
    for (int i = 0; i < 16; ++i) acc[nt][i] = 0.f;
#pragma unroll
  for (int ks = 0; ks < 8; ++ks) {
    const bf16x8 fa = *(const bf16x8*)&sKT[(mt * 32 + r) * LDT2 + ks * 16 + 8 * h];
#pragma unroll
    for (int nt = 0; nt < 2; ++nt) {
      const bf16x8 fb = *(const bf16x8*)&sVT[(nt * 32 + r) * LDT2 + ks * 16 + 8 * h];
      acc[nt] = MFMA(fa, fb, acc[nt]);
    }
  }
  float* dst = p.KVS + kvs_slot(req, head, dir, c);
#pragma unroll
  for (int nt = 0; nt < 2; ++nt)
#pragma unroll
    for (int i = 0; i < 16; ++i) dst[(mt * 32 + crow(i, h)) * 64 + nt * 32 + r] = acc[nt][i];
}

DI void phase2(const Params& p, char* smem, int l) {
  const int tid = otid();
  for (int item = blockIdx.x; item < 1536; item += gridDim.x) {
    if (item < 512) {
      const int b = item >> 7, head = (item >> 4) & 7, qb = item & 15, kvh = head >> 2;
      const int T0 = NCTX + b * 2048 + qb * 128;
      const u16* ck = p.CAK + ((size_t)(b * 2 + l) * 512) * 128 + kvh * 64;
      const u16* cv = p.CAV + ((size_t)(b * 2 + l) * 512) * 128 + kvh * 64;
      auto src = [&](int j, const u16*& kp, const u16*& vp, int& stride) -> bool {
        if (j < 8) {
          kp = ck + (size_t)j * 64 * 128; vp = cv + (size_t)j * 64 * 128; stride = 128;
          return true;
        }
        const int jj = j - 8, kb = qb - 1 + (jj >> 1);
        if (kb < 0 || kb >= 16) return false;
        const int Tk = NCTX + b * 2048 + kb * 128 + (jj & 1) * 64;
        kp = p.QKV + (size_t)Tk * DIN + 512 + kvh * 64; vp = p.QKV + (size_t)Tk * DIN + 640 + kvh * 64; stride = DIN;
        return true;
      };
      auto biasf = [&](int j, int key, int ql) -> float {
        if (j < 8) return 0.f;
        const int jj = j - 8;
        const int kj = (qb - 1 + (jj >> 1)) * 128 + (jj & 1) * 64 + key;
        const int qi = qb * 128 + ql;
        const int d = qi - kj;
        return (d <= 128 && d >= -128) ? 0.f : NEG;
      };
      auto tmode = [&](int j, int w) -> int {
        if (j < 8) return 0;
        const int jj = j - 8;
        const int k0 = (qb - 1 + (jj >> 1)) * 128 + (jj & 1) * 64, q0w = qb * 128 + w * 32;
        if (k0 - (q0w + 31) > 128 || q0w - (k0 + 63) > 128) return 2;
        if ((q0w + 31) - k0 <= 128 && (k0 + 63) - q0w <= 128) return 0;
        return 1;
      };
      attn_core(smem, p.QKV + (size_t)T0 * DIN + head * 64, 14, src, biasf, tmode, p.sink[l * 8 + head] * 1.44269504f, true,
                p.CAT + (size_t)T0 * DM + head * 64);
    } else if (item < 768) {
      const int it = item - 512;
      const int b = it >> 6, head = (it >> 4) & 3, qb = it & 15;
      const int T0 = NCTX + b * 2048 + qb * 128;
      float* srpb = (float*)(smem + 2 * 64 * LDT * 2);
      __syncthreads();
      for (int idx = tid; idx < 465; idx += 256) srpb[idx] = p.rpb[(size_t)(l * 4 + head) * 465 + idx] * 1.44269504f;
      const int r0 = 2 * qb;
      const int rmin = min(max(r0 - 4, 0), 24), rmax = min(max(r0 + 1 - 4, 0), 24) + 7;
      const u16* ck = p.CBK + ((size_t)(b * 2 + l) * 512) * 256 + head * 64;
      const u16* cv = p.CBV + ((size_t)(b * 2 + l) * 512) * 256 + head * 64;
      auto src = [&](int j, const u16*& kp, const u16*& vp, int& stride) -> bool {
        if (j < 8) {
          kp = ck + (size_t)j * 64 * 256; vp = cv + (size_t)j * 64 * 256; stride = 256;
          return true;
        }
        const int Tk = NCTX + b * 2048 + (rmin + j - 8) * 64;
        kp = p.QKV + (size_t)Tk * DIN + 1024 + head * 64; vp = p.QKV + (size_t)Tk * DIN + 1280 + head * 64; stride = DIN;
        return true;
      };
      auto biasf = [&](int j, int key, int ql) -> float {
        if (j < 8) return 0.f;
        const int kr = rmin + j - 8, kc = key;
        const int qr = r0 + (ql >> 6), qc = ql & 63;
        const int rs = min(max(qr - 4, 0), 24), cs = min(max(qc - 8, 0), 48);
        const bool ok = (kr >= rs) && (kr < rs + 8) && (kc >= cs) && (kc < cs + 16);
        const int bi = ok ? ((kr - qr + 7) * 31 + (kc - qc + 15)) : 0;
        const float bv = srpb[bi];
        return ok ? bv : NEG;
      };
      auto tmode = [&](int j, int w) -> int {
        if (j < 8) return 0;
        const int kr = rmin + j - 8, qr = r0 + (w >> 1);
        const int rs = min(max(qr - 4, 0), 24);
        return (kr >= rs && kr < rs + 8) ? 1 : 2;
      };
      attn_core(smem, p.QKV + (size_t)T0 * DIN + 768 + head * 64, 8 + (rmax - rmin + 1), src, biasf, tmode, NEG, false,
                p.CAT + (size_t)T0 * DM + 512 + head * 64);
    } else if (item < 1152) {
      const int it = item - 768;
      if (it < 256) retkv_item(p, smem, l, 16 + (it >> 6), (it >> 4) & 3, it & 15);
      else { const int i2 = it - 256; retkv_item(p, smem, l, i2 >> 3, (i2 >> 1) & 3, i2 & 1); }
    } else if (item < 1408) {
      const int it = item - 1152;
      const int b = it >> 4, head = (it >> 1) & 7, qh = it & 1, kvh = head >> 2;
      const int T0 = b * 256 + qh * 128;
      auto src = [&](int j, const u16*& kp, const u16*& vp, int& stride) -> bool {
        const int Tk = b * 256 + j * 64;
        kp = p.QKV + (size_t)Tk * DIN + 512 + kvh * 64; vp = p.QKV + (size_t)Tk * DIN + 640 + kvh * 64; stride = DIN;
        return true;
      };
      auto biasf = [&](int, int, int) -> float { return 0.f; };
      auto tmode = [&](int, int) -> int { return 0; };
      attn_core(smem, p.QKV + (size_t)T0 * DIN + head * 64, 4, src, biasf, tmode, p.sink[l * 8 + head] * 1.44269504f, true,
                p.CAT + (size_t)T0 * DM + head * 64);
    } else {
      const int it = item - 1408;
      const int b = it >> 3, head = (it >> 1) & 3, qh = it & 1;
      const int T0 = b * 256 + qh * 128;
      auto src = [&](int j, const u16*& kp, const u16*& vp, int& stride) -> bool {
        const int Tk = b * 256 + j * 64;
        kp = p.QKV + (size_t)Tk * DIN + 1024 + head * 64; vp = p.QKV + (size_t)Tk * DIN + 1280 + head * 64; stride = DIN;
        return true;
      };
      auto biasf = [&](int, int, int) -> float { return 0.f; };
      auto tmode = [&](int, int) -> int { return 0; };
      attn_core(smem, p.QKV + (size_t)T0 * DIN + 768 + head * 64, 4, src, biasf, tmode, NEG, false,
                p.CAT + (size_t)T0 * DM + 512 + head * 64);
    }
  }
}

DI void phase2c(const Params& p, char* smem, int l) {
  u16* sK = (u16*)smem;
  u16* sVT = sK + 128 * LDT;
  u16* sSTf = sVT + 64 * LDT2;
  u16* sSTb = sSTf + 64 * LDT;
  const int tid = otid(), lane = tid & 63, w = tid >> 6, r = lane & 31, h = lane >> 5;
  const int rq = tid >> 4, c4 = tid & 15;
  const float one4[4] = {1.f, 1.f, 1.f, 1.f};
  for (int item = blockIdx.x; item < 384; item += gridDim.x) {
    int req, head, c, nc;
    if (item < 256) { req = 16 + (item >> 6); head = (item >> 4) & 3; c = item & 15; nc = 16; }
    else { const int i2 = item - 256; req = i2 >> 3; head = (i2 >> 1) & 3; c = i2 & 1; nc = 2; }
    const bool lat = req >= 16;
    const int T0 = (lat ? NCTX + (req - 16) * 2048 : req * 256) + c * 128;
    const float lgf = ret_lg(p, l, 0, head), lgb = ret_lg(p, l, 1, head);
    const float gf = __expf(lgf * 128.f), gb = __expf(lgb * 128.f);
    __syncthreads();
    {
      const int d = tid >> 2, e0 = (tid & 3) * 16;
#pragma unroll
      for (int dir = 0; dir < 2; ++dir) {
        float s[16];
#pragma unroll
        for (int q = 0; q < 16; ++q) s[q] = 0.f;
        const float g = dir ? gb : gf;
        if (lat) {
          const float* s0 = p.state + ((size_t)(((req - 16) * 2 + l) * 2 + dir) * 4 + head) * 4096 + d * 64 + e0;
#pragma unroll
          for (int q = 0; q < 16; q += 4) {
            const float4 x = *(const float4*)(s0 + q);
            s[q] = x.x; s[q + 1] = x.y; s[q + 2] = x.z; s[q + 3] = x.w;
          }
        }
        const int nsteps = dir ? (nc - 1 - c) : c;
        for (int st = 0; st < nsteps; ++st) {
          const int cc = dir ? (nc - 1 - st) : st;
          const float* kv = p.KVS + kvs_slot(req, head, dir, cc) + d * 64 + e0;
#pragma unroll
          for (int q = 0; q < 16; q += 4) {
            const float4 x = *(const float4*)(kv + q);
            s[q] = s[q] * g + x.x; s[q + 1] = s[q + 1] * g + x.y; s[q + 2] = s[q + 2] * g + x.z; s[q + 3] = s[q + 3] * g + x.w;
          }
        }
        u16* sST = dir ? sSTb : sSTf;
#pragma unroll
        for (int q = 0; q < 16; ++q) sST[(e0 + q) * LDT + d] = (u16)(pack2(s[q], 0.f) & 0xffffu);
        if (!lat && c == 0) {
          const float* k0 = p.KVS + kvs_slot(req, head, dir, 0) + d * 64 + e0;
          const float* k1 = p.KVS + kvs_slot(req, head, dir, 1) + d * 64 + e0;
          float* o = p.out + OFF_ST + ((size_t)((req * 2 + l) * 2 + dir) * 4 + head) * 4096 + d * 64 + e0;
#pragma unroll
          for (int q = 0; q < 16; ++q) o[q] = dir ? (gb * k1[q] + k0[q]) : (gf * k0[q] + k1[q]);
        }
      }
    }
#pragma unroll
    for (int half = 0; half < 2; ++half) {
      float v[4][4];
      load4x4(p.QKV + (size_t)(T0 + half * 64) * DIN + 1792 + head * 64, DIN, false, rq, c4, v);
      store_n(sK, LDT, half * 64, rq, c4, v);
      load4x4(p.QKV + (size_t)(T0 + half * 64) * DIN + 2048 + head * 64, DIN, false, rq, c4, v);
      store_t(sVT, LDT2, half * 64, rq, c4, v, one4);
    }
    __syncthreads();
    const int qi = w * 32 + r;
    const u16* qrow = p.QKV + (size_t)(T0 + qi) * DIN + 1536 + head * 64;
    uint4 qraw[4];
#pragma unroll
    for (int ks = 0; ks < 4; ++ks) qraw[ks] = *(const uint4*)(qrow + ks * 16 + 8 * h);
    f32x16 O[2];
#pragma unroll
    for (int d = 0; d < 2; ++d)
#pragma unroll
      for (int i = 0; i < 16; ++i) O[d][i] = 0.f;
#pragma unroll 1
    for (int jt = 0; jt < 4; ++jt) {
      f32x16 S;
#pragma unroll
      for (int i = 0; i < 16; ++i) S[i] = 0.f;
#pragma unroll
      for (int ks = 0; ks < 4; ++ks) {
        const bf16x8 kf = *(const bf16x8*)&sK[(jt * 32 + r) * LDT + ks * 16 + 8 * h];
        S = MFMA(kf, __builtin_bit_cast(bf16x8, qraw[ks]), S);
      }
#pragma unroll
      for (int i = 0; i < 16; ++i) {
        const int j = jt * 32 + crow(i, h);
        const int dlt = qi - j;
        const float wgt = (dlt > 0) ? __expf(lgf * (float)dlt) : ((dlt < 0) ? __expf(lgb * (float)(-dlt)) : 2.f);
        S[i] = S[i] * 0.125f * wgt;
      }
#pragma unroll
      for (int s = 0; s < 2; ++s) {
        const bf16x8 pf = mk8(pack2(S[8 * s + 0], S[8 * s + 1]), pack2(S[8 * s + 2], S[8 * s + 3]),
                              pack2(S[8 * s + 4], S[8 * s + 5]), pack2(S[8 * s + 6], S[8 * s + 7]));
#pragma unroll
        for (int d = 0; d < 2; ++d) {
          const u16* vrow = &sVT[(d * 32 + r) * LDT2 + jt * 32 + 16 * s + 4 * h];
          const uint2 lo = *(const uint2*)vrow;
          const uint2 hi = *(const uint2*)(vrow + 8);
          O[d] = MFMA(mk8(lo.x, lo.y, hi.x, hi.y), pf, O[d]);
        }
      }
    }
    {
      const float xf = __expf(lgf * (float)(qi + 1)), xb = __expf(lgb * (float)(128 - qi));
#pragma unroll
      for (int ks = 0; ks < 4; ++ks) {
        const uint4 q = qraw[ks];
        const bf16x8 qsf = mk8(pack2(bflo(q.x) * xf, bfhi(q.x) * xf), pack2(bflo(q.y) * xf, bfhi(q.y) * xf),
                               pack2(bflo(q.z) * xf, bfhi(q.z) * xf), pack2(bflo(q.w) * xf, bfhi(q.w) * xf));
        const bf16x8 qsb = mk8(pack2(bflo(q.x) * xb, bfhi(q.x) * xb), pack2(bflo(q.y) * xb, bfhi(q.y) * xb),
                               pack2(bflo(q.z) * xb, bfhi(q.z) * xb), pack2(bflo(q.w) * xb, bfhi(q.w) * xb));
#pragma unroll
        for (int d = 0; d < 2; ++d) {
          const bf16x8 sf = *(const bf16x8*)&sSTf[(d * 32 + r) * LDT + ks * 16 + 8 * h];
          const bf16x8 sb = *(const bf16x8*)&sSTb[(d * 32 + r) * LDT + ks * 16 + 8 * h];
          O[d] = MFMA(sf, qsf, O[d]);
          O[d] = MFMA(sb, qsb, O[d]);
        }
      }
    }
    float sum = 0.f;
#pragma unroll
    for (int d = 0; d < 2; ++d)
#pragma unroll
      for (int i = 0; i < 16; ++i) sum += O[d][i];
    sum += __shfl_xor(sum, 32);
    const float mu = sum * (1.f / 64.f);
    float vs = 0.f;
#pragma unroll
    for (int d = 0; d < 2; ++d)
#pragma unroll
      for (int i = 0; i < 16; ++i) { const float t = O[d][i] - mu; vs += t * t; }
    vs += __shfl_xor(vs, 32);
    const float rstd = rsqrtf(vs * (1.f / 64.f) + 1e-6f);
    const u16* grow = p.QKV + (size_t)(T0 + qi) * DIN + 2304 + head * 64;
    const float* gnw = p.gn + l * 256 + head * 64;
    u16* orow = p.CAT + (size_t)(T0 + qi) * DM + 768 + head * 64;
#pragma unroll
    for (int d = 0; d < 2; ++d)
#pragma unroll
      for (int g = 0; g < 4; ++g) {
        const int e = d * 32 + 8 * g + 4 * h;
        const uint2 gr = *(const uint2*)(grow + e);
        const float4 gw = *(const float4*)(gnw + e);
        const float o0 = silu(bflo(gr.x)) * (O[d][4 * g + 0] - mu) * rstd * gw.x;
        const float o1 = silu(bfhi(gr.x)) * (O[d][4 * g + 1] - mu) * rstd * gw.y;
        const float o2 = silu(bflo(gr.y)) * (O[d][4 * g + 2] - mu) * rstd * gw.z;
        const float o3 = silu(bfhi(gr.y)) * (O[d][4 * g + 3] - mu) * rstd * gw.w;
        uint2 pk = {pack2(o0, o1), pack2(o2, o3)};
        *(uint2*)(orow + e) = pk;
      }
  }
}

DI void phase3(const Params& p, char* smem, int l, const float* xc, const float* xl) {
  const float* W = p.w_out + (size_t)l * DM * DM;
  u16* PREB = (u16*)p.PRE;
  const int xcd = blockIdx.x & 7, nloc = gridDim.x >> 3;
  auto setup = [&](int s, int ar0, int ac, int n4, int kq, const u16*& ab, unsigned& o0, unsigned& o1, unsigned& o2, unsigned& o3, const float*& bb, unsigned& bo) {
    const int tm = 6 * xcd + s % 6, tn = s / 6;
    ab = p.CAT + (size_t)tm * 256 * DM;
    o0 = (unsigned)(ar0 * DM + ac); o1 = o0 + 64u * DM; o2 = o0 + 128u * DM; o3 = o0 + 192u * DM;
    bb = W + tn * 128;
    bo = (unsigned)(4 * n4 + kq * 4 * DM);
  };
  auto epi = [&](int s, f32x16(&acc)[2][4], int w, int r, int h) {
    int hq = h;
    asm volatile("" : "+v"(hq));
    const int tm = 6 * xcd + s % 6, tn = s / 6;
    const int m0 = tm * 256, n0 = tn * 128;
    const float* g1 = p.MOD + (size_t)(l * 5 + cond_of(m0)) * 6144 + 2048 + n0 + 4 * r;
    const float g0 = g1[0], g1v = g1[1], g2 = g1[2], g3 = g1[3];
#pragma unroll
    for (int mt = 0; mt < 2; ++mt)
#pragma unroll
    for (int i = 0; i < 16; ++i) {
      const int ml = w * 64 + mt * 32 + crow(i, hq);
      uint2 pk = {pack2(g0 * acc[mt][0][i], g1v * acc[mt][1][i]), pack2(g2 * acc[mt][2][i], g3 * acc[mt][3][i])};
      *(uint2*)(PREB + (size_t)(m0 + ml) * DM + n0 + 4 * r) = pk;
      if ((i & 3) == 3) __builtin_amdgcn_sched_barrier(0);
    }
  };
  gemm_phase<true>(smem, blockIdx.x >> 3, 48, nloc, setup, DM, epi, [](int, int) {});
}

DI void phase4(const Params& p, char* smem, int l, const float* xc, const float* xl) {
  float* swr = (float*)smem;
  const int tid = otid(), lane = tid & 63, w = tid >> 6;
  __syncthreads();
  for (int idx = tid; idx < 4096; idx += 256) {
    const float4 x = *(const float4*)(p.w_router + (size_t)l * DM * 16 + idx * 4);
    const int k = idx >> 2, e = (idx & 3) * 4;
    swr[(e + 0) * DM + k] = x.x; swr[(e + 1) * DM + k] = x.y; swr[(e + 2) * DM + k] = x.z; swr[(e + 3) * DM + k] = x.w;
  }
  __syncthreads();
  const float* lg = p.ln1g + l * DM;
  const float* lb = p.ln1b + l * DM;
  const int rstride = gridDim.x * 4;
  uint2 nprb[4];
  float4 nxi[4];
  {
    const int T0 = blockIdx.x * 4 + w;
    if (T0 < NTOK) {
      const float* xr0 = (T0 < NCTX) ? (xc + (size_t)T0 * DM) : (xl + (size_t)(T0 - NCTX) * DM);
#pragma unroll
      for (int i = 0; i < 4; ++i) {
        nprb[i] = *(const uint2*)((const u16*)p.PRE + (size_t)T0 * DM + 256 * i + 4 * lane);
        nxi[i] = *(const float4*)(xr0 + 256 * i + 4 * lane);
      }
    }
  }
  for (int T = blockIdx.x * 4 + w; T < NTOK; T += rstride) {
    const float* mod = p.MOD + (size_t)(l * 5 + cond_of(T)) * 6144;
    float4 x[4];
    float s = 0.f;
#pragma unroll
    for (int i = 0; i < 4; ++i) {
      const uint2 prb = nprb[i];
      const float4 xi = nxi[i];
      const float4 pr = {bflo(prb.x), bfhi(prb.x), bflo(prb.y), bfhi(prb.y)};
      x[i].x = ALPHA * xi.x + pr.x; x[i].y = ALPHA * xi.y + pr.y; x[i].z = ALPHA * xi.z + pr.z; x[i].w = ALPHA * xi.w + pr.w;
      s += x[i].x + x[i].y + x[i].z + x[i].w;
    }
    {
      const int Tn = T + rstride;
      if (Tn < NTOK) {
        const float* xrn = (Tn < NCTX) ? (xc + (size_t)Tn * DM) : (xl + (size_t)(Tn - NCTX) * DM);
#pragma unroll
        for (int i = 0; i < 4; ++i) {
          nprb[i] = *(const uint2*)((const u16*)p.PRE + (size_t)Tn * DM + 256 * i + 4 * lane);
          nxi[i] = *(const float4*)(xrn + 256 * i + 4 * lane);
        }
      }
    }
    const float mu = wave_sum(s) * (1.f / 1024.f);
    float vs = 0.f;
#pragma unroll
    for (int i = 0; i < 4; ++i) {
      x[i].x -= mu; x[i].y -= mu; x[i].z -= mu; x[i].w -= mu;
      vs += x[i].x * x[i].x + x[i].y * x[i].y + x[i].z * x[i].z + x[i].w * x[i].w;
    }
    const float rstd = rsqrtf(wave_sum(vs) * (1.f / 1024.f) + 1e-6f);
#pragma unroll
    for (int i = 0; i < 4; ++i) {
      const int k = 256 * i + 4 * lane;
      const float4 g = *(const float4*)(lg + k), bb = *(const float4*)(lb + k);
      float4 y;
      y.x = x[i].x * rstd * g.x + bb.x; y.y = x[i].y * rstd * g.y + bb.y; y.z = x[i].z * rstd * g.z + bb.z; y.w = x[i].w * rstd * g.w + bb.w;
      *(float4*)(p.X + (size_t)T * DM + k) = y;
      const float4 sc = *(const float4*)(mod + 4096 + k), sh = *(const float4*)(mod + 3072 + k);
      float4 hh;
      hh.x = y.x * (1.f + sc.x) + sh.x; hh.y = y.y * (1.f + sc.y) + sh.y; hh.z = y.z * (1.f + sc.z) + sh.z; hh.w = y.w * (1.f + sc.w) + sh.w;
      uint2 pk = {pack2(hh.x, hh.y), pack2(hh.z, hh.w)};
      *(uint2*)(p.H2 + (size_t)T * DM + k) = pk;
      x[i] = hh;
    }
    float a16[16];
#pragma unroll
    for (int e = 0; e < 16; ++e) {
      float a = 0.f;
#pragma unroll
      for (int i = 0; i < 4; ++i) {
        const float4 wv = *(const float4*)(swr + e * DM + 256 * i + 4 * lane);
        a += x[i].x * wv.x + x[i].y * wv.y + x[i].z * wv.z + x[i].w * wv.w;
      }
      a16[e] = a;
      if ((e & 3) == 3) __builtin_amdgcn_sched_barrier(0);
    }
    float a8[8], a4[4], a2[2], a1;
    {
      const bool hi = (lane & 32) != 0;
#pragma unroll
      for (int j = 0; j < 8; ++j) {
        const float snd = hi ? a16[j] : a16[8 + j];
        const float kp = hi ? a16[8 + j] : a16[j];
        a8[j] = kp + __shfl_xor(snd, 32);
      }
    }
    {
      const bool hi = (lane & 16) != 0;
#pragma unroll
      for (int j = 0; j < 4; ++j) {
        const float snd = hi ? a8[j] : a8[4 + j];
        const float kp = hi ? a8[4 + j] : a8[j];
        a4[j] = kp + __shfl_xor(snd, 16);
      }
    }
    {
      const bool hi = (lane & 8) != 0;
#pragma unroll
      for (int j = 0; j < 2; ++j) {
        const float snd = hi ? a4[j] : a4[2 + j];
        const float kp = hi ? a4[2 + j] : a4[j];
        a2[j] = kp + __shfl_xor(snd, 8);
      }
    }
    {
      const bool hi = (lane & 4) != 0;
      const float snd = hi ? a2[0] : a2[1];
      const float kp = hi ? a2[1] : a2[0];
      a1 = kp + __shfl_xor(snd, 4);
    }
    a1 += __shfl_xor(a1, 2);
    a1 += __shfl_xor(a1, 1);
    const int myexp = ((lane >> 5) & 1) * 8 + ((lane >> 4) & 1) * 4 + ((lane >> 3) & 1) * 2 + ((lane >> 2) & 1);
    float mx = a1;
#pragma unroll
    for (int o = 32; o >= 4; o >>= 1) mx = fmaxf(mx, __shfl_xor(mx, o));
    const float ex = __expf(a1 - mx);
    float den = ex;
#pragma unroll
    for (int o = 32; o >= 4; o >>= 1) den += __shfl_xor(den, o);
    if ((lane & 3) == 0) { p.AFF[(size_t)T * 16 + myexp] = ex / den; p.INV[(size_t)T * 16 + myexp] = -1; }
  }
}

DI unsigned block_incl_scan(unsigned v, unsigned* wsum, int lane, int w, unsigned& total) {
#pragma unroll
  for (int o = 1; o < 64; o <<= 1) {
    const unsigned t = __shfl_up(v, o);
    if (lane >= o) v += t;
  }
  __syncthreads();
  if (lane == 63) wsum[w] = v;
  __syncthreads();
  unsigned off = 0;
  total = 0;
#pragma unroll
  for (int i = 0; i < 4; ++i) {
    const unsigned s = wsum[i];
    if (i < w) off += s;
    total += s;
  }
  return v + off;
}

DI void phase5(const Params& p, char* smem) {
  unsigned* hist = (unsigned*)smem;
  unsigned* wsum = hist + 256;
  unsigned* bc = wsum + 4;
  const int tid = otid(), lane = tid & 63, w = tid >> 6;
  for (int item = blockIdx.x; item < 320; item += gridDim.x) {
    int n, base, e, cap, rowbase;
    if (item < 64) {
      const int b = item >> 4; e = item & 15;
      n = 2048; base = NCTX + b * 2048; cap = 256; rowbase = 512 + b * 256;
    } else {
      const int it = item - 64; const int rq = it >> 4; e = it & 15;
      n = 256; base = rq * 256; cap = 32; rowbase = rq * 32;
    }
    const int per = n >> 8;
    unsigned key[8];
#pragma unroll
    for (int q = 0; q < 8; ++q) key[q] = (q < per) ? __float_as_uint(p.AFF[(size_t)(base + tid * per + q) * 16 + e]) : 0u;
    unsigned prefix = 0u, mask = 0u;
    unsigned remaining = (unsigned)cap;
#pragma unroll 1
    for (int pass = 3; pass >= 0; --pass) {
      const int shift = pass * 8;
      __syncthreads();
      hist[tid] = 0u;
      __syncthreads();
#pragma unroll
      for (int q = 0; q < 8; ++q)
        if (q < per && (key[q] & mask) == prefix) atomicAdd(&hist[(key[q] >> shift) & 255u], 1u);
      __syncthreads();
      const unsigned hv = hist[tid];
      unsigned total;
      const unsigned incl = block_incl_scan(hv, wsum, lane, w, total);
      const unsigned above = total - incl;
      if (above < remaining && remaining <= above + hv) { bc[0] = (unsigned)tid; bc[1] = remaining - above; }
      __syncthreads();
      const unsigned bsel = bc[0];
      remaining = bc[1];
      prefix |= bsel << shift;
      mask |= 0xFFu << shift;
    }
    const unsigned thr = prefix;
    unsigned ceq = 0u;
#pragma unroll
    for (int q = 0; q < 8; ++q) ceq += (q < per && key[q] == thr) ? 1u : 0u;
    unsigned tot;
    unsigned eq_before = block_incl_scan(ceq, wsum, lane, w, tot) - ceq;
    unsigned selmask = 0u, nsel = 0u;
#pragma unroll
    for (int q = 0; q < 8; ++q) {
      if (q < per) {
        const bool eq = key[q] == thr;
        const bool sel = (key[q] > thr) || (eq && eq_before < remaining);
        eq_before += eq ? 1u : 0u;
        selmask |= sel ? (1u << q) : 0u;
        nsel += sel ? 1u : 0u;
      }
    }
    unsigned row = block_incl_scan(nsel, wsum, lane, w, tot) - nsel;
#pragma unroll
    for (int q = 0; q < 8; ++q) {
      if (q < per && ((selmask >> q) & 1u)) {
        const int tok = base + tid * per + q;
        const int rr = e * NROWS_E + rowbase + (int)row;
        p.SELTOK[rr] = tok;
        p.SELGATE[rr] = __uint_as_float(key[q]);
        p.INV[(size_t)tok * 16 + e] = rr;
        ++row;
      }
    }
  }
}

DI void phase6(const Params& p, char* smem, int l) {
  const int xcd = blockIdx.x & 7, nloc = gridDim.x >> 3;
  auto setup = [&](int s, int ar0, int ac, int n4, int kq, const u16*& ab, unsigned& o0, unsigned& o1, unsigned& o2, unsigned& o3, const float*& bb, unsigned& bo) {
    const int e = 2 * xcd + s / 96, rem = s % 96, tn = rem / 6, tm = rem % 6;
    const int* tok = p.SELTOK + e * NROWS_E + tm * 256 + ar0;
    ab = p.H2;
    o0 = (unsigned)(tok[0] * DM + ac); o1 = (unsigned)(tok[64] * DM + ac);
    o2 = (unsigned)(tok[128] * DM + ac); o3 = (unsigned)(tok[192] * DM + ac);
    bb = p.w_gu + ((size_t)l * 16 + e) * DM * 2048 + tn * 64;
    bo = (unsigned)(((n4 >> 4) & 1) * 1024 + 4 * (n4 & 15) + kq * 4 * 2048);
  };
  auto epi = [&](int s, f32x16(&acc)[2][4], int w, int r, int h) {
    int hq = h;
    asm volatile("" : "+v"(hq));
    const int e = 2 * xcd + s / 96, rem = s % 96, tn = rem / 6, tm = rem % 6;
    const int m0 = tm * 256, f0 = tn * 64;
    u16* act = p.ACT + ((size_t)e * NROWS_E + m0) * DM;
#pragma unroll
    for (int mt = 0; mt < 2; ++mt)
#pragma unroll
    for (int i = 0; i < 16; ++i) {
      const int ml = w * 64 + mt * 32 + crow(i, hq);
      const float a0 = acc[mt][0][i], a1 = acc[mt][1][i], a2 = acc[mt][2][i], a3 = acc[mt][3][i];
      const bool lo = r < 16;
      const float s0 = lo ? a2 : a0, s1 = lo ? a3 : a1;
      const float r0 = __shfl_xor(s0, 16), r1 = __shfl_xor(s1, 16);
      const float g0 = lo ? a0 : r0, g1 = lo ? a1 : r1;
      const float v0 = lo ? r0 : a2, v1 = lo ? r1 : a3;
      *(unsigned*)(act + (size_t)ml * DM + f0 + 4 * (r & 15) + (lo ? 0 : 2)) = pack2(silu(g0) * v0, silu(g1) * v1);
      if ((i & 3) == 3) __builtin_amdgcn_sched_barrier(0);
    }
  };
  gemm_phase<false>(smem, blockIdx.x >> 3, 192, nloc, setup, 2048, epi, [](int, int) {});
}

DI void phase7(const Params& p, char* smem, int l, u16* FF) {
  const int xcd = blockIdx.x & 7, nloc = gridDim.x >> 3;
  auto setup = [&](int s, int ar0, int ac, int n4, int kq, const u16*& ab, unsigned& o0, unsigned& o1, unsigned& o2, unsigned& o3, const float*& bb, unsigned& bo) {
    const int e = 2 * xcd + s / 48, rem = s % 48, tn = rem / 6, tm = rem % 6;
    ab = p.ACT + ((size_t)e * NROWS_E + tm * 256) * DM;
    o0 = (unsigned)(ar0 * DM + ac); o1 = o0 + 64u * DM; o2 = o0 + 128u * DM; o3 = o0 + 192u * DM;
    bb = p.w_down + ((size_t)l * 16 + e) * DM * DM + tn * 128;
    bo = (unsigned)(4 * n4 + kq * 4 * DM);
  };
  float* sG = (float*)(smem + 61440);
  int par = 1;
  auto pre = [&](int s, int tid) {
    par ^= 1;
    const int e = 2 * xcd + s / 48, rem = s % 48, tm = rem % 6;
    sG[par * 256 + tid] = p.SELGATE[e * NROWS_E + tm * 256 + tid];
  };
  auto epi = [&](int s, f32x16(&acc)[2][4], int w, int r, int h) {
    int hq = h;
    asm volatile("" : "+v"(hq));
    const int e = 2 * xcd + s / 48, rem = s % 48, tn = rem / 6, tm = rem % 6;
    const int m0 = tm * 256, n0 = tn * 128;
#pragma unroll
    for (int mt = 0; mt < 2; ++mt)
#pragma unroll
    for (int i = 0; i < 16; ++i) {
      const int ml = w * 64 + mt * 32 + crow(i, hq);
      const float g = sG[par * 256 + ml];
      uint2 pk = {pack2(g * acc[mt][0][i], g * acc[mt][1][i]), pack2(g * acc[mt][2][i], g * acc[mt][3][i])};
      *(uint2*)(FF + ((size_t)e * NROWS_E + m0 + ml) * DM + n0 + 4 * r) = pk;
      if ((i & 3) == 3) __builtin_amdgcn_sched_barrier(0);
    }
  };
  gemm_phase<true>(smem, blockIdx.x >> 3, 96, nloc, setup, DM, epi, pre);
}

DI void phase8(const Params& p, int l, float* dst, bool write_h) {
  const int tid = otid(), lane = tid & 63, w = tid >> 6;
  const float* lg = p.ln2g + l * DM;
  const float* lb = p.ln2b + l * DM;
  const int rstride = gridDim.x * 4;
  float4 nxa[4];
  int ninv = -1;
  {
    const int T0 = blockIdx.x * 4 + w;
    if (T0 < NTOK) {
#pragma unroll
      for (int i = 0; i < 4; ++i) nxa[i] = *(const float4*)(p.X + (size_t)T0 * DM + 256 * i + 4 * lane);
      ninv = (lane < 16) ? p.INV[(size_t)T0 * 16 + lane] : -1;
    }
  }
  for (int T = blockIdx.x * 4 + w; T < NTOK; T += rstride) {
    const float* g2 = p.MOD + (size_t)(l * 5 + cond_of(T)) * 6144 + 5120;
    const float* modn = p.MOD + (size_t)(5 + cond_of(T)) * 6144;
    float4 x[4], ff[4], xa[4];
#pragma unroll
    for (int i = 0; i < 4; ++i) { ff[i] = make_float4(0.f, 0.f, 0.f, 0.f); xa[i] = nxa[i]; }
    const int myinv = ninv;
    {
      const int Tn = T + rstride;
      if (Tn < NTOK) {
#pragma unroll
        for (int i = 0; i < 4; ++i) nxa[i] = *(const float4*)(p.X + (size_t)Tn * DM + 256 * i + 4 * lane);
        ninv = (lane < 16) ? p.INV[(size_t)Tn * 16 + lane] : -1;
      }
    }
    unsigned long long sel = __ballot(myinv >= 0);
#pragma unroll 1
    while (sel) {
      int rows[4];
#pragma unroll
      for (int q = 0; q < 4; ++q) {
        if (sel) {
          const int e = __ffsll((long long)sel) - 1;
          sel &= sel - 1;
          rows[q] = __shfl(myinv, e);
        } else {
          rows[q] = -1;
        }
      }
      uint2 y[4][4];
#pragma unroll
      for (int q = 0; q < 4; ++q) {
        const u16* yr = p.YE + (size_t)(rows[q] >= 0 ? rows[q] : 0) * DM + 4 * lane;
#pragma unroll
        for (int i = 0; i < 4; ++i) y[q][i] = *(const uint2*)(yr + 256 * i);
      }
#pragma unroll
      for (int q = 0; q < 4; ++q) {
        const float wq = rows[q] >= 0 ? 1.f : 0.f;
#pragma unroll
        for (int i = 0; i < 4; ++i) {
          ff[i].x += wq * bflo(y[q][i].x); ff[i].y += wq * bfhi(y[q][i].x); ff[i].z += wq * bflo(y[q][i].y); ff[i].w += wq * bfhi(y[q][i].y);
        }
      }
    }
    float s = 0.f;
#pragma unroll
    for (int i = 0; i < 4; ++i) {
      const int k = 256 * i + 4 * lane;
      const float4 a = xa[i];
      const float4 f = ff[i];
      const float4 g = *(const float4*)(g2 + k);
      x[i].x = ALPHA * a.x + g.x * f.x; x[i].y = ALPHA * a.y + g.y * f.y; x[i].z = ALPHA * a.z + g.z * f.z; x[i].w = ALPHA * a.w + g.w * f.w;
      s += x[i].x + x[i].y + x[i].z + x[i].w;
    }
    const float mu = wave_sum(s) * (1.f / 1024.f);
    float vs = 0.f;
#pragma unroll
    for (int i = 0; i < 4; ++i) {
      x[i].x -= mu; x[i].y -= mu; x[i].z -= mu; x[i].w -= mu;
      vs += x[i].x * x[i].x + x[i].y * x[i].y + x[i].z * x[i].z + x[i].w * x[i].w;
    }
    const float rstd = rsqrtf(wave_sum(vs) * (1.f / 1024.f) + 1e-6f);
#pragma unroll
    for (int i = 0; i < 4; ++i) {
      const int k = 256 * i + 4 * lane;
      const float4 g = *(const float4*)(lg + k), bb = *(const float4*)(lb + k);
      float4 y;
      y.x = x[i].x * rstd * g.x + bb.x; y.y = x[i].y * rstd * g.y + bb.y; y.z = x[i].z * rstd * g.z + bb.z; y.w = x[i].w * rstd * g.w + bb.w;
      *(float4*)(dst + (size_t)T * DM + k) = y;
      if (write_h) {
        const float4 sc = *(const float4*)(modn + 1024 + k), sh = *(const float4*)(modn + k);
        uint2 pk = {pack2(y.x * (1.f + sc.x) + sh.x, y.y * (1.f + sc.y) + sh.y), pack2(y.z * (1.f + sc.z) + sh.z, y.w * (1.f + sc.w) + sh.w)};
        *(uint2*)(p.H2 + (size_t)T * DM + k) = pk;
      }
    }
  }
}

constexpr int kDynLds = 73728;
__global__ void __launch_bounds__(256, 2) mega(Params p) {
  extern __shared__ __attribute__((aligned(16))) char smem[];
  cg::grid_group grid = cg::this_grid();
  if (p.never) grid.sync();
  GBar gb;
  gb.bar = p.BAR; gb.x = xb_xcc_id(); gb.nloc = 0u; gb.nx = 0u;
  if (threadIdx.x == 0) (void)xb_add(&p.BAR[XB_XCNT(gb.x)], 1u);
  phase0(p, smem);
  gbar(gb);
  phase0b(p);
  gbar(gb);
#pragma unroll 1
  for (int l = 0; l < 2; ++l) {
    const float* xc = (l == 0) ? p.x_prompt : p.X;
    const float* xl = (l == 0) ? p.x_sample : (p.X + (size_t)NCTX * DM);
    phase1(p, smem, l);
    gbar(gb);
    if (PROBE == 1) { phase1(p, smem, l); gbar(gb); }
    phase2(p, smem, l);
    gbar(gb);
    if (PROBE == 3) { phase2(p, smem, l); gbar(gb); }
    phase2c(p, smem, l);
    gbar(gb);
    if (PROBE == 3) { phase2c(p, smem, l); gbar(gb); }
    phase3(p, smem, l, xc, xl);
    gbar(gb);
    if (PROBE == 1) { phase3(p, smem, l, xc, xl); gbar(gb); }
    phase4(p, smem, l, xc, xl);
    gbar(gb);
    phase5(p, smem);
    gbar(gb);
    phase6(p, smem, l);
    gbar(gb);
    if (PROBE == 1) { phase6(p, smem, l); gbar(gb); }
    phase7(p, smem, l, p.YE);
    gbar(gb);
    phase8(p, l, (l == 1) ? p.out : p.X, l == 0);
    if (l == 0) gbar(gb);
  }
}

extern "C" void kernel_launch(void* const* d_in, const int* in_sizes, int n_in, void* d_out, int out_size, void* d_ws,
                              size_t ws_size, hipStream_t stream) {
  static int grid_blocks = 0;
  if (!grid_blocks) {
    int dev = 0, cus = 0, per_cu = 0;
    hipGetDevice(&dev);
    hipDeviceGetAttribute(&cus, hipDeviceAttributeMultiprocessorCount, dev);
    hipFuncSetAttribute((const void*)mega, hipFuncAttributeMaxDynamicSharedMemorySize, kDynLds);
    hipOccupancyMaxActiveBlocksPerMultiprocessor(&per_cu, mega, 256, kDynLds);
    if (per_cu > 2) per_cu = 2;
    if (per_cu < 1) per_cu = 1;
    grid_blocks = cus * per_cu;
  }
  Params p{};
  const float** pf = (const float**)&p;
  for (int i = 0; i < 24; ++i) pf[i] = (const float*)d_in[i];
  p.out = (float*)d_out;
  char* ws = (char*)d_ws;
  size_t off = 0;
  auto take = [&](size_t bytes) { char* q = ws + off; off += (bytes + 255) & ~(size_t)255; return q; };
  p.MOD = (float*)take(2 * 5 * 6144 * 4);
  p.BAR = (unsigned*)take(XCD_BAR_WORDS * 4);
  p.ROPE = (float*)take(2048 * 4);
  p.X = (float*)take((size_t)NTOK * DM * 4);
  p.PRE = (float*)take((size_t)NTOK * DM * 4);
  p.KVS = (float*)take((size_t)20 * 4 * 2 * 16 * 4096 * 4);
  p.AFF = (float*)take((size_t)NTOK * 16 * 4);
  p.SELGATE = (float*)take((size_t)16 * NROWS_E * 4);
  p.SELTOK = (int*)take((size_t)16 * NROWS_E * 4);
  p.QKV = (u16*)take((size_t)NTOK * DIN * 2);
  p.CAT = (u16*)take((size_t)NTOK * DM * 2);
  p.H2 = (u16*)take((size_t)NTOK * DM * 2);
  p.ACT = (u16*)take((size_t)16 * NROWS_E * DM * 2);
  p.YE = (u16*)take((size_t)16 * NROWS_E * DM * 2);
  p.INV = (int*)take((size_t)NTOK * 16 * 4);
  p.CAK = (u16*)take((size_t)4 * 2 * 512 * 128 * 2);
  p.CAV = (u16*)take((size_t)4 * 2 * 512 * 128 * 2);
  p.CBK = (u16*)take((size_t)4 * 2 * 512 * 256 * 2);
  p.CBV = (u16*)take((size_t)4 * 2 * 512 * 256 * 2);
  p.never = 0;
  hipMemsetAsync(p.MOD, 0, (size_t)((char*)p.BAR - (char*)p.MOD) + XCD_BAR_WORDS * 4, stream);
  void* args[] = {&p};
  hipError_t e = hipLaunchCooperativeKernel((void*)mega, dim3(grid_blocks), dim3(256), args, kDynLds, stream);
  if (e != hipSuccess) fprintf(stderr, "cooperative launch failed: %s (grid %d)\n", hipGetErrorString(e), grid_blocks);
}
```

```cpp
#include <hip/hip_runtime.h>
#include <hip/hip_cooperative_groups.h>
#include <cstdio>
namespace cg = cooperative_groups;

#define DI __device__ __forceinline__
typedef short bf16x8 __attribute__((ext_vector_type(8)));
typedef float f32x16 __attribute__((ext_vector_type(16)));
typedef __bf16 bf2_t __attribute__((ext_vector_type(2)));
typedef float f2_t __attribute__((ext_vector_type(2)));
typedef unsigned short u16;
typedef unsigned u32x4 __attribute__((ext_vector_type(4)));
typedef float f32x4 __attribute__((ext_vector_type(4)));
typedef float f32x2 __attribute__((ext_vector_type(2)));

#define MFMA(a, b, c) __builtin_amdgcn_mfma_f32_32x32x16_bf16((a), (b), (c), 0, 0, 0)

#define PROBE 0
constexpr int NTOK = 12288;
constexpr int NCTX = 4096;
constexpr int DM = 1024;
constexpr int DIN = 2560;
constexpr int LDT = 72;
constexpr int LDT2 = 136;
constexpr int NROWS_E = 1536;
constexpr float NEG = -1e30f;
constexpr float ALPHA = 1.41421356237f;

constexpr size_t OFF_AK = 12582912, OFF_AV = 13631488, OFF_BK = 14680064, OFF_BV = 16777216, OFF_ST = 18874368;

struct Params {
  const float *x_prompt, *x_sample, *cak, *cav, *cbk, *cbv, *state, *c, *c_ctx, *w_ada, *b_ada, *w_in, *w_out, *sink, *rpb,
      *decay, *gn, *ln1g, *ln1b, *ln2g, *ln2b, *w_router, *w_gu, *w_down;
  float* out;
  float *MOD, *ROPE, *X, *PRE, *KVS, *AFF, *SELGATE;
  int* SELTOK;
  u16 *QKV, *CAT, *H2, *ACT, *CAK, *CAV, *CBK, *CBV;
  u16* YE;
  int* INV;
  unsigned* BAR;
  long never;
};

DI unsigned pack2(float a, float b) {
  f2_t v = {a, b};
  bf2_t r = __builtin_convertvector(v, bf2_t);
  return __builtin_bit_cast(unsigned, r);
}
DI int otid() { int x = threadIdx.x; asm volatile("" : "+v"(x)); return x; }
DI float bflo(unsigned u) { return __uint_as_float(u << 16); }
DI float bfhi(unsigned u) { return __uint_as_float(u & 0xffff0000u); }
DI int crow(int i, int h) { return (i & 3) + 8 * (i >> 2) + 4 * h; }
DI float silu(float x) { return x / (1.f + __expf(-x)); }
DI float wave_sum(float v) {
#pragma unroll
  for (int o = 32; o >= 1; o >>= 1) v += __shfl_xor(v, o);
  return v;
}
DI bf16x8 mk8(unsigned a, unsigned b, unsigned c, unsigned d) {
  uint4 u = {a, b, c, d};
  return __builtin_bit_cast(bf16x8, u);
}


#define XB_TMO 128
#define XB_XCNT(j) (256 + 64 * (j))
#define XB_XSUB(j) (1280 + 64 * (j))
#define XB_XGEN(j) (2304 + 64 * (j))
#define XB_TOP 3328
#define XB_TOPGEN 3392
#define XCD_BAR_WORDS 3456
#define XB_SPIN_CAP (1u << 20)
DI unsigned xb_ld(unsigned* p) { return __hip_atomic_load(p, __ATOMIC_RELAXED, __HIP_MEMORY_SCOPE_AGENT); }
DI unsigned xb_add(unsigned* p, unsigned v) { return __hip_atomic_fetch_add(p, v, __ATOMIC_RELAXED, __HIP_MEMORY_SCOPE_AGENT); }
DI unsigned xb_xcc_id() { return (unsigned)__builtin_amdgcn_s_getreg((3 << 11) | 20) & 0xFu; }
#define XB_SPIN(cond, bar)                                                            \
  do {                                                                                \
    unsigned _sp = 0;                                                                 \
    while (cond) {                                                                    \
      __builtin_amdgcn_s_sleep(1);                                                    \
      if ((++_sp & 255u) == 0u) {                                                     \
        if (xb_ld(&(bar)[XB_TMO])) break;                                             \
        if (_sp > XB_SPIN_CAP) { atomicAdd(&(bar)[XB_TMO], 1u); break; }              \
      }                                                                               \
    }                                                                                 \
  } while (0)
struct GBar { unsigned* bar; unsigned x, nloc, nx; };
DI void gbar_complete(unsigned* bar, unsigned x, unsigned& nloc, unsigned& nx) {
  const unsigned G = gridDim.x;
  unsigned sum, cnt, mine, sp = 0u;
  for (;;) {
    sum = 0u; cnt = 0u; mine = 0u;
#pragma unroll
    for (unsigned j = 0; j < 16; ++j) {
      const unsigned c = xb_ld(&bar[XB_XCNT(j)]);
      sum += c; cnt += (c > 0u) ? 1u : 0u; mine = (j == x) ? c : mine;
    }
    if (sum == G) break;
    __builtin_amdgcn_s_sleep(1);
    if ((++sp & 255u) == 0u) {
      if (xb_ld(&bar[XB_TMO])) break;
      if (sp > XB_SPIN_CAP) { atomicAdd(&bar[XB_TMO], 1u); break; }
    }
  }
  nloc = mine > 0u ? mine : 1u;
  nx = cnt > 0u ? cnt : 1u;
}
DI void gbar(GBar& b) {
  asm volatile("s_waitcnt vmcnt(0)" ::: "memory");
  __syncthreads();
  if (threadIdx.x == 0) {
    unsigned* bar = b.bar;
    __builtin_amdgcn_s_waitcnt(0);
    if (b.nloc == 0u) gbar_complete(bar, b.x, b.nloc, b.nx);
    const unsigned nloc = b.nloc, nx = b.nx;
    const unsigned old = xb_add(&bar[XB_XSUB(b.x)], 1u);
    const unsigned gen = old / nloc;
    if (old + 1u == (gen + 1u) * nloc) {
      __builtin_amdgcn_fence(__ATOMIC_RELEASE, "agent");
      asm volatile("s_waitcnt vmcnt(0)" ::: "memory");
      const unsigned og = xb_add(&bar[XB_TOP], 1u);
      const unsigned tg = og / nx;
      if (og + 1u == (tg + 1u) * nx) xb_add(&bar[XB_TOPGEN], 1u);
      else XB_SPIN(xb_ld(&bar[XB_TOPGEN]) == tg, bar);
      __builtin_amdgcn_fence(__ATOMIC_ACQUIRE, "agent");
      xb_add(&bar[XB_XGEN(b.x)], 1u);
      asm volatile("s_waitcnt vmcnt(0)" ::: "memory");
    } else {
      XB_SPIN(xb_ld(&bar[XB_XGEN(b.x)]) == gen, bar);
      __builtin_amdgcn_fence(__ATOMIC_ACQUIRE, "agent");
      asm volatile("s_waitcnt vmcnt(0)" ::: "memory");
    }
  }
  __syncthreads();
}

template <class Setup, class Epi>
DI void gemm_phase128(char* smem, int s0, int s_end, int s_step, Setup setup, int ldb, Epi epi) {
  if (s0 >= s_end) return;
  u16* sA0 = (u16*)smem;
  u16* sB0 = sA0 + 128 * LDT;
  u16* sA1 = sB0 + 128 * LDT;
  u16* sB1 = sA1 + 128 * LDT;
  const int tid = otid(), lane = tid & 63, w = tid >> 6, r = lane & 31, h = lane >> 5;
  const int a_r0 = tid >> 3, a_c = (tid & 7) * 8;
  const int b_n4 = tid & 31, b_kq = tid >> 5;
  const u16 *apb0, *apb1, *apb2, *apb3;
  const float* bp;
  setup(s0, a_r0, a_c, b_n4, b_kq, apb0, apb1, apb2, apb3, bp);

  u32x4 pa0, pa1, pa2, pa3;
  f32x4 pb[8];

#define G_LOAD(KT)                                                                       \
  {                                                                                      \
    const int k0_ = (KT) * 64;                                                           \
    pa0 = *(const u32x4*)(apb0 + k0_);                                                   \
    pa1 = *(const u32x4*)(apb1 + k0_);                                                   \
    pa2 = *(const u32x4*)(apb2 + k0_);                                                   \
    pa3 = *(const u32x4*)(apb3 + k0_);                                                   \
    _Pragma("unroll") for (int i_ = 0; i_ < 8; ++i_) pb[i_] = *(const f32x4*)(bp + (size_t)(k0_ + i_) * ldb); \
  }
#define G_STAGE(SA, SBB)                                                                 \
  {                                                                                      \
    *(u32x4*)&SA[(a_r0)*LDT + a_c] = pa0;                                                \
    *(u32x4*)&SA[(a_r0 + 32) * LDT + a_c] = pa1;                                         \
    *(u32x4*)&SA[(a_r0 + 64) * LDT + a_c] = pa2;                                         \
    *(u32x4*)&SA[(a_r0 + 96) * LDT + a_c] = pa3;                                         \
    _Pragma("unroll") for (int j_ = 0; j_ < 4; ++j_) {                                   \
      u32x4 pk_;                                                                         \
      pk_.x = pack2(pb[0][j_], pb[1][j_]);                                               \
      pk_.y = pack2(pb[2][j_], pb[3][j_]);                                               \
      pk_.z = pack2(pb[4][j_], pb[5][j_]);                                               \
      pk_.w = pack2(pb[6][j_], pb[7][j_]);                                               \
      *(u32x4*)&SBB[(j_ * 32 + b_n4) * LDT + b_kq * 8] = pk_;                            \
    }                                                                                    \
  }
  const int aoff = (w * 32 + r) * LDT + 8 * h, boff = r * LDT + 8 * h;
#define G_FRAG(BUF, SA, SBB, KS)                                                         \
  {                                                                                      \
    fa[BUF] = *(const bf16x8*)(SA + aoff + (KS) * 16);                                   \
    fb[BUF][0] = *(const bf16x8*)(SBB + boff + (KS) * 16);                               \
    fb[BUF][1] = *(const bf16x8*)(SBB + boff + 32 * LDT + (KS) * 16);                    \
    fb[BUF][2] = *(const bf16x8*)(SBB + boff + 64 * LDT + (KS) * 16);                    \
    fb[BUF][3] = *(const bf16x8*)(SBB + boff + 96 * LDT + (KS) * 16);                    \
  }
#define G_MFMA(BUF)                                                                      \
  {                                                                                      \
    acc[0] = MFMA(fa[BUF], fb[BUF][0], acc[0]);                                          \
    acc[1] = MFMA(fa[BUF], fb[BUF][1], acc[1]);                                          \
    acc[2] = MFMA(fa[BUF], fb[BUF][2], acc[2]);                                          \
    acc[3] = MFMA(fa[BUF], fb[BUF][3], acc[3]);                                          \
  }
#define SB() __builtin_amdgcn_sched_barrier(0)
#define G_COMPUTE(SA, SBB)                                                               \
  {                                                                                      \
    bf16x8 fa[2], fb[2][4];                                                              \
    G_FRAG(0, SA, SBB, 0);                                                               \
    G_FRAG(1, SA, SBB, 1);                                                               \
    SB();                                                                                \
    G_MFMA(0);                                                                           \
    SB();                                                                                \
    G_FRAG(0, SA, SBB, 2);                                                               \
    SB();                                                                                \
    G_MFMA(1);                                                                           \
    SB();                                                                                \
    G_FRAG(1, SA, SBB, 3);                                                               \
    SB();                                                                                \
    G_MFMA(0);                                                                           \
    SB();                                                                                \
    G_MFMA(1);                                                                           \
    SB();                                                                                \
  }

  G_LOAD(0);
  __syncthreads();
#pragma unroll 1
  for (int s = s0; s < s_end; s += s_step) {
    f32x16 acc[4];
#pragma unroll
    for (int a = 0; a < 4; ++a)
#pragma unroll
      for (int i = 0; i < 16; ++i) acc[a][i] = 0.f;
    const int sn = s + s_step;
    const bool has_next = sn < s_end;
    const u16 *n0 = apb0, *n1 = apb1, *n2 = apb2, *n3 = apb3;
    const float* nbp = bp;
    if (has_next) setup(sn, a_r0, a_c, b_n4, b_kq, n0, n1, n2, n3, nbp);
#pragma unroll 1
    for (int kt = 0; kt < 16; kt += 2) {
      G_STAGE(sA0, sB0);
      __syncthreads();
      G_LOAD(kt + 1);
      G_COMPUTE(sA0, sB0);
      G_STAGE(sA1, sB1);
      __syncthreads();
      {
        int kn = kt + 2;
        if (kt == 14) { apb0 = n0; apb1 = n1; apb2 = n2; apb3 = n3; bp = nbp; kn = 0; }
        G_LOAD(kn);
      }
      G_COMPUTE(sA1, sB1);
    }
    epi(s, acc, w, r, h);
  }
  __syncthreads();
#undef G_LOAD
#undef G_STAGE
#undef G_COMPUTE
#undef G_FRAG
#undef G_MFMA
}
#undef SB

template <bool CONTIG, class Setup, class Epi, class Pre>
DI void gemm_phase(char* smem, int s0, int s_end, int s_step, Setup setup, int ldb, Epi epi, Pre pre) {
  asm volatile("" : "+s"(s_end));
  if (s0 >= s_end) return;
  constexpr int LDK = 40;
  u16* sA0 = (u16*)smem;
  u16* sB0 = sA0 + 256 * LDK;
  u16* sA1 = sB0 + 128 * LDK;
  u16* sB1 = sA1 + 256 * LDK;
  const int tid = otid(), lane = tid & 63, w = tid >> 6, r = lane & 31, h = lane >> 5;
  const int a_r0 = tid >> 2, a_c = (tid & 3) * 8;
  const int b_n4 = tid & 31, b_kq = tid >> 5;
  const u16* abase;
  const float* bbase;
  unsigned ao0, ao1, ao2, ao3, bo;
  setup(s0, a_r0, a_c, b_n4, b_kq, abase, ao0, ao1, ao2, ao3, bbase, bo);

  u32x4 pa0, pa1, pa2, pa3;
  f32x4 pbA[4], pbB[4];

#define G_LOADA(KT)                                                                      \
  {                                                                                      \
    const int k0_ = (KT) * 32;                                                           \
    pa0 = *(const u32x4*)(abase + k0_ + (size_t)ao0);                                    \
    pa1 = *(const u32x4*)(abase + k0_ + (size_t)(CONTIG ? ao0 + 64u * DM : ao1));        \
    pa2 = *(const u32x4*)(abase + k0_ + (size_t)(CONTIG ? ao0 + 128u * DM : ao2));       \
    pa3 = *(const u32x4*)(abase + k0_ + (size_t)(CONTIG ? ao0 + 192u * DM : ao3));       \
  }
#define G_LOADB(PB, BP, KT)                                                              \
  {                                                                                      \
    const int k0_ = (KT) * 32;                                                           \
    _Pragma("unroll") for (int i_ = 0; i_ < 4; ++i_) PB[i_] = *(const f32x4*)((BP) + (size_t)(k0_ + i_) * ldb + (size_t)bo); \
  }
#define G_STAGE(SA, SBB, PB)                                                               \
  {                                                                                      \
    *(u32x4*)&SA[(a_r0)*LDK + a_c] = pa0;                                                \
    *(u32x4*)&SA[(a_r0 + 64) * LDK + a_c] = pa1;                                         \
    *(u32x4*)&SA[(a_r0 + 128) * LDK + a_c] = pa2;                                        \
    *(u32x4*)&SA[(a_r0 + 192) * LDK + a_c] = pa3;                                        \
    _Pragma("unroll") for (int j_ = 0; j_ < 4; ++j_) {                                   \
      uint2 pk_;                                                                         \
      pk_.x = pack2(PB[0][j_], PB[1][j_]);                                               \
      pk_.y = pack2(PB[2][j_], PB[3][j_]);                                               \
      *(uint2*)&SBB[(j_ * 32 + b_n4) * LDK + b_kq * 4] = pk_;                            \
    }                                                                                    \
  }
  const int aoff = (w * 64 + r) * LDK + 8 * h, boff = r * LDK + 8 * h;
#define G_FRAG(FA, FB, SA, SBB, KS)                                                      \
  {                                                                                      \
    FA[0] = *(const bf16x8*)(SA + aoff + (KS) * 16);                                     \
    FA[1] = *(const bf16x8*)(SA + aoff + 32 * LDK + (KS) * 16);                          \
    FB[0] = *(const bf16x8*)(SBB + boff + (KS) * 16);                                    \
    FB[1] = *(const bf16x8*)(SBB + boff + 32 * LDK + (KS) * 16);                         \
    FB[2] = *(const bf16x8*)(SBB + boff + 64 * LDK + (KS) * 16);                         \
    FB[3] = *(const bf16x8*)(SBB + boff + 96 * LDK + (KS) * 16);                         \
  }
#define G_MFMA(FA, FB)                                                                   \
  {                                                                                      \
    _Pragma("unroll") for (int mt_ = 0; mt_ < 2; ++mt_)                                  \
    _Pragma("unroll") for (int nt_ = 0; nt_ < 4; ++nt_) acc[mt_][nt_] = MFMA(FA[mt_], FB[nt_], acc[mt_][nt_]); \
  }
#define SB() __builtin_amdgcn_sched_barrier(0)
#define G_COMPUTE(SA, SBB)                                                               \
  {                                                                                      \
    bf16x8 fa0[2], fb0[4];                                                               \
    G_FRAG(fa0, fb0, SA, SBB, 0);                                                        \
    SB();                                                                                \
    G_MFMA(fa0, fb0);                                                                    \
    SB();                                                                                \
    G_FRAG(fa0, fb0, SA, SBB, 1);                                                        \
    SB();                                                                                \
    G_MFMA(fa0, fb0);                                                                    \
    SB();                                                                                \
  }

  G_LOADA(0);
  G_LOADB(pbA, bbase, 0);
  G_LOADB(pbB, bbase, 1);
  __syncthreads();
#pragma unroll 1
  for (int s = s0; s < s_end; s += s_step) {
    f32x16 acc[2][4];
#pragma unroll
    for (int a = 0; a < 2; ++a)
#pragma unroll
      for (int b = 0; b < 4; ++b)
#pragma unroll
        for (int i = 0; i < 16; ++i) acc[a][b][i] = 0.f;
    pre(s, tid);
    const int sn = s + s_step;
    const bool has_next = sn < s_end;
    const u16* nabase = abase;
    const float* nbbase = bbase;
    unsigned n0 = ao0, n1 = ao1, n2 = ao2, n3 = ao3, nbo = bo;
    if (has_next) setup(sn, a_r0, a_c, b_n4, b_kq, nabase, n0, n1, n2, n3, nbbase, nbo);
#pragma unroll 1
    for (int kt = 0; kt < 32; kt += 2) {
      G_STAGE(sA0, sB0, pbA);
      __syncthreads();
      G_LOADA(kt + 1);
      {
        const bool last = (kt == 30);
        const float* bq = last ? nbbase : bbase;
        const int kb = last ? 0 : kt + 2;
        G_LOADB(pbA, bq, kb);
      }
      G_COMPUTE(sA0, sB0);
      G_STAGE(sA1, sB1, pbB);
      __syncthreads();
      {
        int ka = kt + 2, kb = kt + 3;
        if (kt == 30) { abase = nabase; ao0 = n0; ao1 = n1; ao2 = n2; ao3 = n3; bbase = nbbase; ka = 0; kb = 1; }
        G_LOADA(ka);
        G_LOADB(pbB, bbase, kb);
      }
      G_COMPUTE(sA1, sB1);
    }
    epi(s, acc, w, r, h);
  }
  __syncthreads();
#undef G_LOADA
#undef G_LOADB
#undef G_STAGE
#undef G_COMPUTE
#undef G_FRAG
#undef G_MFMA
}

DI void load4x4(const void* base, int stride, bool isf32, int rq, int c4, float v[4][4]) {
  if (isf32) {
#pragma unroll
    for (int i = 0; i < 4; ++i) {
      const float4 x = *(const float4*)((const float*)base + (size_t)(4 * rq + i) * stride + 4 * c4);
      v[i][0] = x.x; v[i][1] = x.y; v[i][2] = x.z; v[i][3] = x.w;
    }
  } else {
#pragma unroll
    for (int i = 0; i < 4; ++i) {
      const uint2 x = *(const uint2*)((const u16*)base + (size_t)(4 * rq + i) * stride + 4 * c4);
      v[i][0] = bflo(x.x); v[i][1] = bfhi(x.x); v[i][2] = bflo(x.y); v[i][3] = bfhi(x.y);
    }
  }
}
DI void store_n(u16* dst, int ld, int row0, int rq, int c4, const float v[4][4]) {
#pragma unroll
  for (int i = 0; i < 4; ++i) {
    uint2 pk = {pack2(v[i][0], v[i][1]), pack2(v[i][2], v[i][3])};
    *(uint2*)&dst[(row0 + 4 * rq + i) * ld + 4 * c4] = pk;
  }
}
DI void store_t(u16* dst, int ld, int col0, int rq, int c4, const float v[4][4], const float s[4]) {
#pragma unroll
  for (int j = 0; j < 4; ++j) {
    uint2 pk = {pack2(v[0][j] * s[0], v[1][j] * s[1]), pack2(v[2][j] * s[2], v[3][j] * s[3])};
    *(uint2*)&dst[(4 * c4 + j) * ld + col0 + 4 * rq] = pk;
  }
}

DI void attn_load(const u16* kp, const u16* vp, int stride, int rq, int c4, uint2 (&k)[4], uint2 (&v)[4]) {
#pragma unroll
  for (int i = 0; i < 4; ++i) {
    k[i] = *(const uint2*)(kp + (size_t)(4 * rq + i) * stride + 4 * c4);
    v[i] = *(const uint2*)(vp + (size_t)(4 * rq + i) * stride + 4 * c4);
  }
}
DI void attn_stage(u16* sK, u16* sVT, int rq, int c4, const uint2 (&k)[4], const uint2 (&v)[4]) {
#pragma unroll
  for (int i = 0; i < 4; ++i) *(uint2*)&sK[(4 * rq + i) * LDT + 4 * c4] = k[i];
  uint2 t0, t1, t2, t3;
  t0.x = (v[0].x & 0xffffu) | (v[1].x << 16);          t0.y = (v[2].x & 0xffffu) | (v[3].x << 16);
  t1.x = (v[0].x >> 16) | (v[1].x & 0xffff0000u);      t1.y = (v[2].x >> 16) | (v[3].x & 0xffff0000u);
  t2.x = (v[0].y & 0xffffu) | (v[1].y << 16);          t2.y = (v[2].y & 0xffffu) | (v[3].y << 16);
  t3.x = (v[0].y >> 16) | (v[1].y & 0xffff0000u);      t3.y = (v[2].y >> 16) | (v[3].y & 0xffff0000u);
  const int qs = 4 * (rq ^ ((c4 >> 1) & 7));
  *(uint2*)&sVT[(4 * c4 + 0) * LDT + qs] = t0;
  *(uint2*)&sVT[(4 * c4 + 1) * LDT + qs] = t1;
  *(uint2*)&sVT[(4 * c4 + 2) * LDT + qs] = t2;
  *(uint2*)&sVT[(4 * c4 + 3) * LDT + qs] = t3;
}

template <class TileSrc, class BiasF, class TMode>
DI void attn_core(char* smem, const u16* qbase, int ntiles, TileSrc src, BiasF biasf, TMode tmode, float m_init, bool has_sink, u16* obase) {
  u16* sK0 = (u16*)smem;
  u16* sVT0 = sK0 + 64 * LDT;
  u16* sK1 = sVT0 + 64 * LDT;
  u16* sVT1 = sK1 + 64 * LDT;
  const int tid = otid(), lane = tid & 63, w = tid >> 6, r = lane & 31, h = lane >> 5;
  const int rq = tid >> 4, c4 = tid & 15;
  const int ql = w * 32 + r;
  bf16x8 qf[4];
#pragma unroll
  for (int ks = 0; ks < 4; ++ks) qf[ks] = *(const bf16x8*)(qbase + (size_t)ql * DIN + ks * 16 + 8 * h);
  f32x16 O[2];
#pragma unroll
  for (int d = 0; d < 2; ++d)
#pragma unroll
    for (int i = 0; i < 16; ++i) O[d][i] = 0.f;
  float m = m_init, lsum = (has_sink && h == 0) ? 1.f : 0.f;

  auto nextv = [&](int j, const u16*& kp, const u16*& vp, int& stride) -> int {
    while (j < ntiles && !src(j, kp, vp, stride)) ++j;
    return j;
  };
  auto compute = [&](int jc, const u16* sK, const u16* sVT) {
    const int mode = tmode(jc, w);
    if (mode != 2) {
      f32x16 S[2];
#pragma unroll
      for (int mt = 0; mt < 2; ++mt)
#pragma unroll
        for (int i = 0; i < 16; ++i) S[mt][i] = 0.f;
#pragma unroll
      for (int ks = 0; ks < 4; ++ks)
#pragma unroll
        for (int mt = 0; mt < 2; ++mt) {
          const bf16x8 kf = *(const bf16x8*)&sK[(mt * 32 + r) * LDT + ks * 16 + 8 * h];
          S[mt] = MFMA(kf, qf[ks], S[mt]);
        }
      const float C2 = 0.125f * 1.44269504f;
      float mx = NEG;
      if (mode == 1) {
#pragma unroll
        for (int mt = 0; mt < 2; ++mt)
#pragma unroll
          for (int i = 0; i < 16; ++i) {
            const float s = S[mt][i] * C2 + biasf(jc, mt * 32 + crow(i, h), ql);
            S[mt][i] = s;
            mx = fmaxf(mx, s);
          }
      } else {
#pragma unroll
        for (int mt = 0; mt < 2; ++mt)
#pragma unroll
          for (int i = 0; i < 16; ++i) {
            const float s = S[mt][i] * C2;
            S[mt][i] = s;
            mx = fmaxf(mx, s);
          }
      }
      mx = fmaxf(mx, __shfl_xor(mx, 32));
      const float mn = fmaxf(m, mx);
      if (__any(mn > m)) {
        const float alpha = __builtin_amdgcn_exp2f(m - mn);
        m = mn;
        lsum *= alpha;
#pragma unroll
        for (int d = 0; d < 2; ++d)
#pragma unroll
          for (int i = 0; i < 16; ++i) O[d][i] *= alpha;
      }
      float ps = 0.f;
#pragma unroll
      for (int mt = 0; mt < 2; ++mt)
#pragma unroll
        for (int i = 0; i < 16; ++i) {
          const float pv = __builtin_amdgcn_exp2f(S[mt][i] - m);
          S[mt][i] = pv;
          ps += pv;
        }
      lsum += ps;
#pragma unroll
      for (int mt = 0; mt < 2; ++mt)
#pragma unroll
        for (int s = 0; s < 2; ++s) {
          const bf16x8 pf = mk8(pack2(S[mt][8 * s + 0], S[mt][8 * s + 1]), pack2(S[mt][8 * s + 2], S[mt][8 * s + 3]),
                                pack2(S[mt][8 * s + 4], S[mt][8 * s + 5]), pack2(S[mt][8 * s + 6], S[mt][8 * s + 7]));
#pragma unroll
          for (int d = 0; d < 2; ++d) {
            const int sw = (d * 4 + (r >> 3)) & 7, q = mt * 8 + 4 * s + h;
            const u16* vrow = &sVT[(d * 32 + r) * LDT];
            const uint2 lo = *(const uint2*)(vrow + 4 * (q ^ sw));
            const uint2 hi = *(const uint2*)(vrow + 4 * ((q + 2) ^ sw));
            O[d] = MFMA(mk8(lo.x, lo.y, hi.x, hi.y), pf, O[d]);
          }
        }
    }
  };

  uint2 kA[4], vA[4], kB[4], vB[4];
#pragma unroll
  for (int i = 0; i < 4; ++i) { kA[i] = make_uint2(0u, 0u); vA[i] = kA[i]; kB[i] = kA[i]; vB[i] = kA[i]; }
  const u16 *kp = nullptr, *vp = nullptr;
  int stride = 0;
  int jA = nextv(0, kp, vp, stride);
  if (jA < ntiles) attn_load(kp, vp, stride, rq, c4, kA, vA);
  int jB = nextv(jA + 1, kp, vp, stride);
  if (jB < ntiles) attn_load(kp, vp, stride, rq, c4, kB, vB);
  __syncthreads();
#pragma unroll 1
  for (;;) {
    if (jA >= ntiles) break;
    attn_stage(sK0, sVT0, rq, c4, kA, vA);
    __syncthreads();
    {
      const int jc = jA;
      jA = nextv(jB + 1, kp, vp, stride);
      if (jA < ntiles) attn_load(kp, vp, stride, rq, c4, kA, vA);
      compute(jc, sK0, sVT0);
    }
    if (jB >= ntiles) break;
    attn_stage(sK1, sVT1, rq, c4, kB, vB);
    __syncthreads();
    {
      const int jc = jB;
      jB = nextv(jA + 1, kp, vp, stride);
      if (jB < ntiles) attn_load(kp, vp, stride, rq, c4, kB, vB);
      compute(jc, sK1, sVT1);
    }
  }
  const float l = lsum + __shfl_xor(lsum, 32);
  const float inv = 1.f / l;
#pragma unroll
  for (int d = 0; d < 2; ++d)
#pragma unroll
    for (int g = 0; g < 4; ++g) {
      uint2 pk = {pack2(O[d][4 * g + 0] * inv, O[d][4 * g + 1] * inv), pack2(O[d][4 * g + 2] * inv, O[d][4 * g + 3] * inv)};
      *(uint2*)(obase + (size_t)ql * DM + d * 32 + 8 * g + 4 * h) = pk;
    }
}

DI void phase0(const Params& p, char* smem) {
  const int tid = otid();
  if (blockIdx.x == 0) {
    for (int idx = tid; idx < 1024; idx += 256) {
      const int pos = idx >> 4, j = idx & 15;
      const double inv = 1.0 / pow(10000.0, (double)j / 16.0);
      const float ang = (float)((double)pos * inv);
      p.ROPE[idx] = cosf(ang);
      p.ROPE[1024 + idx] = sinf(ang);
    }
  }
  float* scond = (float*)smem;
  for (int item = blockIdx.x; item < 768; item += gridDim.x) {
    const int l = item / 384, ks = (item / 24) % 16, jb = item % 24;
    __syncthreads();
    for (int idx = tid; idx < 320; idx += 256) {
      const int c = idx / 64, k = ks * 64 + (idx & 63);
      const float v = (c == 0) ? p.c_ctx[k] : p.c[(c - 1) * DM + k];
      scond[idx] = silu(v);
    }
    __syncthreads();
    const int j = jb * 256 + tid;
    const float* wp = p.w_ada + ((size_t)l * DM + ks * 64) * 6144 + j;
    float a[5] = {0.f, 0.f, 0.f, 0.f, 0.f};
#pragma unroll 8
    for (int k = 0; k < 64; ++k) {
      const float wv = wp[(size_t)k * 6144];
#pragma unroll
      for (int c = 0; c < 5; ++c) a[c] += scond[c * 64 + k] * wv;
    }
    const float bias = (ks == 0) ? p.b_ada[l * 6144 + j] : 0.f;
#pragma unroll
    for (int c = 0; c < 5; ++c) unsafeAtomicAdd(&p.MOD[(l * 5 + c) * 6144 + j], a[c] + bias);
  }
}

DI int cond_of(int T) { return T < NCTX ? 0 : 1 + ((T - NCTX) >> 11); }

DI void cvt_f32_bf16(const float* s, u16* d, int n4, int gtid, int gsz) {
  for (int i = gtid; i < n4; i += gsz) {
    const float4 x = *(const float4*)(s + (size_t)i * 4);
    uint2 pk = {pack2(x.x, x.y), pack2(x.z, x.w)};
    *(uint2*)(d + (size_t)i * 4) = pk;
  }
}
DI void phase0b(const Params& p) {
  const int tid = otid(), lane = tid & 63, w = tid >> 6;
  {
    const int gtid = blockIdx.x * 256 + tid, gsz = gridDim.x * 256;
    cvt_f32_bf16(p.cak, p.CAK, 4 * 2 * 512 * 128 / 4, gtid, gsz);
    cvt_f32_bf16(p.cav, p.CAV, 4 * 2 * 512 * 128 / 4, gtid, gsz);
    cvt_f32_bf16(p.cbk, p.CBK, 4 * 2 * 512 * 256 / 4, gtid, gsz);
    cvt_f32_bf16(p.cbv, p.CBV, 4 * 2 * 512 * 256 / 4, gtid, gsz);
  }
  for (int T = blockIdx.x * 4 + w; T < NTOK; T += gridDim.x * 4) {
    const float* mod = p.MOD + (size_t)cond_of(T) * 6144;
    const float* xr = (T < NCTX) ? (p.x_prompt + (size_t)T * DM) : (p.x_sample + (size_t)(T - NCTX) * DM);
#pragma unroll
    for (int i = 0; i < 4; ++i) {
      const int k = 256 * i + 4 * lane;
      const float4 x = *(const float4*)(xr + k);
      const float4 sc = *(const float4*)(mod + 1024 + k), sh = *(const float4*)(mod + k);
      uint2 pk = {pack2(x.x * (1.f + sc.x) + sh.x, x.y * (1.f + sc.y) + sh.y), pack2(x.z * (1.f + sc.z) + sh.z, x.w * (1.f + sc.w) + sh.w)};
      *(uint2*)(p.H2 + (size_t)T * DM + k) = pk;
    }
  }
}

DI void phase1(const Params& p, char* smem, int l) {
  const float* W = p.w_in + (size_t)l * DM * DIN;
  const int xcd = blockIdx.x & 7, nloc = gridDim.x >> 3;
  float* sR = (float*)(smem + 61440);
  for (int idx = otid(); idx < 2048; idx += 256) sR[idx] = p.ROPE[idx];
  auto setup = [&](int s, int ar0, int ac, int n4, int kq, const u16*& ab, unsigned& o0, unsigned& o1, unsigned& o2, unsigned& o3, const float*& bb, unsigned& bo) {
    const int tm = 6 * xcd + s % 6, tn = s / 6;
    ab = p.H2 + (size_t)tm * 256 * DM;
    o0 = (unsigned)(ar0 * DM + ac); o1 = o0 + 64u * DM; o2 = o0 + 128u * DM; o3 = o0 + 192u * DM;
    bb = W + tn * 128;
    bo = (unsigned)(4 * n4 + kq * 4 * DIN);
  };
  auto epi = [&](int s, f32x16(&acc)[2][4], int w, int r, int h) {
    int hq = h;
    asm volatile("" : "+v"(hq));
    const int tm = 6 * xcd + s % 6, tn = s / 6;
    const int m0 = tm * 256, n0 = tn * 128;
    const bool lat = m0 >= NCTX;
    const bool rope = lat && (n0 < 640);
    const int n = n0 + 4 * r;
    const int q = (r >> 2) & 3;
#pragma unroll
    for (int mt = 0; mt < 2; ++mt)
#pragma unroll
    for (int i = 0; i < 16; ++i) {
      const int T = m0 + w * 64 + mt * 32 + crow(i, hq);
      float v0 = acc[mt][0][i], v1 = acc[mt][1][i], v2 = acc[mt][2][i], v3 = acc[mt][3][i];
      if (rope) {
        const int t = (T - NCTX) & 2047;
        const int pos = (q < 2) ? (t >> 6) : (t & 63);
        const int jf = 4 * (r & 3);
        const float4 cs = *(const float4*)(sR + pos * 16 + jf), sn = *(const float4*)(sR + 1024 + pos * 16 + jf);
        const float o0 = __shfl_xor(v0, 4), o1 = __shfl_xor(v1, 4), o2 = __shfl_xor(v2, 4), o3 = __shfl_xor(v3, 4);
        if (q & 1) { v0 = o0 * sn.x + v0 * cs.x; v1 = o1 * sn.y + v1 * cs.y; v2 = o2 * sn.z + v2 * cs.z; v3 = o3 * sn.w + v3 * cs.w; }
        else { v0 = v0 * cs.x - o0 * sn.x; v1 = v1 * cs.y - o1 * sn.y; v2 = v2 * cs.z - o2 * sn.z; v3 = v3 * cs.w - o3 * sn.w; }
      }
      uint2 pk = {pack2(v0, v1), pack2(v2, v3)};
      *(uint2*)(p.QKV + (size_t)T * DIN + n) = pk;
      if (!lat) {
        const int b = T >> 8, t = T & 255;
        const float4 vv = {v0, v1, v2, v3};
        if (n0 == 512) *(float4*)(p.out + OFF_AK + ((size_t)(b * 2 + l) * 256 + t) * 128 + (n - 512)) = vv;
        else if (n0 == 640) *(float4*)(p.out + OFF_AV + ((size_t)(b * 2 + l) * 256 + t) * 128 + (n - 640)) = vv;
        else if (n0 == 1024 || n0 == 1152) *(float4*)(p.out + OFF_BK + ((size_t)(b * 2 + l) * 256 + t) * 256 + (n - 1024)) = vv;
        else if (n0 == 1280 || n0 == 1408) *(float4*)(p.out + OFF_BV + ((size_t)(b * 2 + l) * 256 + t) * 256 + (n - 1280)) = vv;
      }
      if ((i & 3) == 3) __builtin_amdgcn_sched_barrier(0);
    }
  };
  gemm_phase<true>(smem, blockIdx.x >> 3, 120, nloc, setup, DIN, epi, [](int, int) {});
}

DI float ret_lg(const Params& p, int l, int dir, int head) { return -__expf(p.decay[(l * 2 + dir) * 4 + head]); }

DI size_t kvs_slot(int req, int head, int dir, int c) { return ((size_t)((req * 4 + head) * 2 + dir) * 16 + c) * 4096; }

DI void retkv_item(const Params& p, char* smem, int l, int req, int head, int c) {
  u16* sKTf = (u16*)smem;
  u16* sKTb = sKTf + 64 * LDT2;
  u16* sVT = sKTb + 64 * LDT2;
  const int tid = otid(), lane = tid & 63, w = tid >> 6, r = lane & 31, h = lane >> 5;
  const int rq = tid >> 4, c4 = tid & 15;
  const int T0 = (req < 16 ? req * 256 : NCTX + (req - 16) * 2048) + c * 128;
  const float lgf = ret_lg(p, l, 0, head), lgb = ret_lg(p, l, 1, head);
  const float one4[4] = {1.f, 1.f, 1.f, 1.f};
  __syncthreads();
#pragma unroll
  for (int half = 0; half < 2; ++half) {
    float v[4][4];
    float sf[4], sb[4];
#pragma unroll
    for (int i = 0; i < 4; ++i) {
      const int j = half * 64 + 4 * rq + i;
      sf[i] = 0.125f * __expf(lgf * (float)(127 - j));
      sb[i] = 0.125f * __expf(lgb * (float)j);
    }
    load4x4(p.QKV + (size_t)(T0 + half * 64) * DIN + 1792 + head * 64, DIN, false, rq, c4, v);
    store_t(sKTf, LDT2, half * 64, rq, c4, v, sf);
    store_t(sKTb, LDT2, half * 64, rq, c4, v, sb);
    load4x4(p.QKV + (size_t)(T0 + half * 64) * DIN + 2048 + head * 64, DIN, false, rq, c4, v);
    store_t(sVT, LDT2, half * 64, rq, c4, v, one4);
  }
  __syncthreads();
  const int dir = w >> 1, mt = w & 1;
  const u16* sKT = dir ? sKTb : sKTf;
  f32x16 acc[2];
#pragma unroll
  for (int nt = 0; nt < 2; ++nt)
#pragma unroll
    for (int i = 0; i < 16; ++i) acc[nt][i] = 0.f;
#pragma unroll
  for (int ks = 0; ks < 8; ++ks) {
    const bf16x8 fa = *(const bf16x8*)&sKT[(mt * 32 + r) * LDT2 + ks * 16 + 8 * h];
#pragma unroll
    for (int nt = 0; nt < 2; ++nt) {
      const bf16x8 fb = *(const bf16x8*)&sVT[(nt * 32 + r) * LDT2 + ks * 16 + 8 * h];
      acc[nt] = MFMA(fa, fb, acc[nt]);
    }
  }
  float* dst = p.KVS + kvs_slot(req, head, dir, c);
#pragma unroll
  for (int nt = 0; nt < 2; ++nt)
#pragma unroll
    for (int i = 0; i < 16; ++i) dst[(mt * 32 + crow(i, h)) * 64 + nt * 32 + r] = acc[nt][i];
}

DI void phase2(const Params& p, char* smem, int l) {
  const int tid = otid();
  for (int item = blockIdx.x; item < 1536; item += gridDim.x) {
    if (item < 512) {
      const int b = item >> 7, head = (item >> 4) & 7, qb = item & 15, kvh = head >> 2;
      const int T0 = NCTX + b * 2048 + qb * 128;
      const u16* ck = p.CAK + ((size_t)(b * 2 + l) * 512) * 128 + kvh * 64;
      const u16* cv = p.CAV + ((size_t)(b * 2 + l) * 512) * 128 + kvh * 64;
      auto src = [&](int j, const u16*& kp, const u16*& vp, int& stride) -> bool {
        if (j < 8) {
          kp = ck + (size_t)j * 64 * 128; vp = cv + (size_t)j * 64 * 128; stride = 128;
          return true;
        }
        const int jj = j - 8, kb = qb - 1 + (jj >> 1);
        if (kb < 0 || kb >= 16) return false;
        const int Tk = NCTX + b * 2048 + kb * 128 + (jj & 1) * 64;
        kp = p.QKV + (size_t)Tk * DIN + 512 + kvh * 64; vp = p.QKV + (size_t)Tk * DIN + 640 + kvh * 64; stride = DIN;
        return true;
      };
      auto biasf = [&](int j, int key, int ql) -> float {
        if (j < 8) return 0.f;
        const int jj = j - 8;
        const int kj = (qb - 1 + (jj >> 1)) * 128 + (jj & 1) * 64 + key;
        const int qi = qb * 128 + ql;
        const int d = qi - kj;
        return (d <= 128 && d >= -128) ? 0.f : NEG;
      };
      auto tmode = [&](int j, int w) -> int {
        if (j < 8) return 0;
        const int jj = j - 8;
        const int k0 = (qb - 1 + (jj >> 1)) * 128 + (jj & 1) * 64, q0w = qb * 128 + w * 32;
        if (k0 - (q0w + 31) > 128 || q0w - (k0 + 63) > 128) return 2;
        if ((q0w + 31) - k0 <= 128 && (k0 + 63) - q0w <= 128) return 0;
        return 1;
      };
      attn_core(smem, p.QKV + (size_t)T0 * DIN + head * 64, 14, src, biasf, tmode, p.sink[l * 8 + head] * 1.44269504f, true,
                p.CAT + (size_t)T0 * DM + head * 64);
    } else if (item < 768) {
      const int it = item - 512;
      const int b = it >> 6, head = (it >> 4) & 3, qb = it & 15;
      const int T0 = NCTX + b * 2048 + qb * 128;
      float* srpb = (float*)(smem + 4 * 64 * LDT * 2);
      __syncthreads();
      for (int idx = tid; idx < 465; idx += 256) srpb[idx] = p.rpb[(size_t)(l * 4 + head) * 465 + idx] * 1.44269504f;
      const int r0 = 2 * qb;
      const int rmin = min(max(r0 - 4, 0), 24), rmax = min(max(r0 + 1 - 4, 0), 24) + 7;
      const u16* ck = p.CBK + ((size_t)(b * 2 + l) * 512) * 256 + head * 64;
      const u16* cv = p.CBV + ((size_t)(b * 2 + l) * 512) * 256 + head * 64;
      auto src = [&](int j, const u16*& kp, const u16*& vp, int& stride) -> bool {
        if (j < 8) {
          kp = ck + (size_t)j * 64 * 256; vp = cv + (size_t)j * 64 * 256; stride = 256;
          return true;
        }
        const int Tk = NCTX + b * 2048 + (rmin + j - 8) * 64;
        kp = p.QKV + (size_t)Tk * DIN + 1024 + head * 64; vp = p.QKV + (size_t)Tk * DIN + 1280 + head * 64; stride = DIN;
        return true;
      };
      auto biasf = [&](int j, int key, int ql) -> float {
        if (j < 8) return 0.f;
        const int kr = rmin + j - 8, kc = key;
        const int qr = r0 + (ql >> 6), qc = ql & 63;
        const int rs = min(max(qr - 4, 0), 24), cs = min(max(qc - 8, 0), 48);
        const bool ok = (kr >= rs) && (kr < rs + 8) && (kc >= cs) && (kc < cs + 16);
        const int bi = ok ? ((kr - qr + 7) * 31 + (kc - qc + 15)) : 0;
        const float bv = srpb[bi];
        return ok ? bv : NEG;
      };
      auto tmode = [&](int j, int w) -> int {
        if (j < 8) return 0;
        const int kr = rmin + j - 8, qr = r0 + (w >> 1);
        const int rs = min(max(qr - 4, 0), 24);
        return (kr >= rs && kr < rs + 8) ? 1 : 2;
      };
      attn_core(smem, p.QKV + (size_t)T0 * DIN + 768 + head * 64, 8 + (rmax - rmin + 1), src, biasf, tmode, NEG, false,
                p.CAT + (size_t)T0 * DM + 512 + head * 64);
    } else if (item < 1152) {
      const int it = item - 768;
      if (it < 256) retkv_item(p, smem, l, 16 + (it >> 6), (it >> 4) & 3, it & 15);
      else { const int i2 = it - 256; retkv_item(p, smem, l, i2 >> 3, (i2 >> 1) & 3, i2 & 1); }
    } else if (item < 1408) {
      const int it = item - 1152;
      const int b = it >> 4, head = (it >> 1) & 7, qh = it & 1, kvh = head >> 2;
      const int T0 = b * 256 + qh * 128;
      auto src = [&](int j, const u16*& kp, const u16*& vp, int& stride) -> bool {
        const int Tk = b * 256 + j * 64;
        kp = p.QKV + (size_t)Tk * DIN + 512 + kvh * 64; vp = p.QKV + (size_t)Tk * DIN + 640 + kvh * 64; stride = DIN;
        return true;
      };
      auto biasf = [&](int, int, int) -> float { return 0.f; };
      auto tmode = [&](int, int) -> int { return 0; };
      attn_core(smem, p.QKV + (size_t)T0 * DIN + head * 64, 4, src, biasf, tmode, p.sink[l * 8 + head] * 1.44269504f, true,
                p.CAT + (size_t)T0 * DM + head * 64);
    } else {
      const int it = item - 1408;
      const int b = it >> 3, head = (it >> 1) & 3, qh = it & 1;
      const int T0 = b * 256 + qh * 128;
      auto src = [&](int j, const u16*& kp, const u16*& vp, int& stride) -> bool {
        const int Tk = b * 256 + j * 64;
        kp = p.QKV + (size_t)Tk * DIN + 1024 + head * 64; vp = p.QKV + (size_t)Tk * DIN + 1280 + head * 64; stride = DIN;
        return true;
      };
      auto biasf = [&](int, int, int) -> float { return 0.f; };
      auto tmode = [&](int, int) -> int { return 0; };
      attn_core(smem, p.QKV + (size_t)T0 * DIN + 768 + head * 64, 4, src, biasf, tmode, NEG, false,
                p.CAT + (size_t)T0 * DM + 512 + head * 64);
    }
  }
}

DI void phase2c(const Params& p, char* smem, int l) {
  u16* sK = (u16*)smem;
  u16* sVT = sK + 128 * LDT;
  u16* sSTf = sVT + 64 * LDT2;
  u16* sSTb = sSTf + 64 * LDT;
  const int tid = otid(), lane = tid & 63, w = tid >> 6, r = lane & 31, h = lane >> 5;
  const int rq = tid >> 4, c4 = tid & 15;
  const float one4[4] = {1.f, 1.f, 1.f, 1.f};
  for (int item = blockIdx.x; item < 384; item += gridDim.x) {
    int req, head, c, nc;
    if (item < 256) { req = 16 + (item >> 6); head = (item >> 4) & 3; c = item & 15; nc = 16; }
    else { const int i2 = item - 256; req = i2 >> 3; head = (i2 >> 1) & 3; c = i2 & 1; nc = 2; }
    const bool lat = req >= 16;
    const int T0 = (lat ? NCTX + (req - 16) * 2048 : req * 256) + c * 128;
    const float lgf = ret_lg(p, l, 0, head), lgb = ret_lg(p, l, 1, head);
    const float gf = __expf(lgf * 128.f), gb = __expf(lgb * 128.f);
    __syncthreads();
    {
      const int d = tid >> 2, e0 = (tid & 3) * 16;
#pragma unroll
      for (int dir = 0; dir < 2; ++dir) {
        float s[16];
#pragma unroll
        for (int q = 0; q < 16; ++q) s[q] = 0.f;
        const float g = dir ? gb : gf;
        if (lat) {
          const float* s0 = p.state + ((size_t)(((req - 16) * 2 + l) * 2 + dir) * 4 + head) * 4096 + d * 64 + e0;
#pragma unroll
          for (int q = 0; q < 16; q += 4) {
            const float4 x = *(const float4*)(s0 + q);
            s[q] = x.x; s[q + 1] = x.y; s[q + 2] = x.z; s[q + 3] = x.w;
          }
        }
        const int nsteps = dir ? (nc - 1 - c) : c;
        for (int st = 0; st < nsteps; ++st) {
          const int cc = dir ? (nc - 1 - st) : st;
          const float* kv = p.KVS + kvs_slot(req, head, dir, cc) + d * 64 + e0;
#pragma unroll
          for (int q = 0; q < 16; q += 4) {
            const float4 x = *(const float4*)(kv + q);
            s[q] = s[q] * g + x.x; s[q + 1] = s[q + 1] * g + x.y; s[q + 2] = s[q + 2] * g + x.z; s[q + 3] = s[q + 3] * g + x.w;
          }
        }
        u16* sST = dir ? sSTb : sSTf;
#pragma unroll
        for (int q = 0; q < 16; ++q) sST[(e0 + q) * LDT + d] = (u16)(pack2(s[q], 0.f) & 0xffffu);
        if (!lat && c == 0) {
          const float* k0 = p.KVS + kvs_slot(req, head, dir, 0) + d * 64 + e0;
          const float* k1 = p.KVS + kvs_slot(req, head, dir, 1) + d * 64 + e0;
          float* o = p.out + OFF_ST + ((size_t)((req * 2 + l) * 2 + dir) * 4 + head) * 4096 + d * 64 + e0;
#pragma unroll
          for (int q = 0; q < 16; ++q) o[q] = dir ? (gb * k1[q] + k0[q]) : (gf * k0[q] + k1[q]);
        }
      }
    }
#pragma unroll
    for (int half = 0; half < 2; ++half) {
      float v[4][4];
      load4x4(p.QKV + (size_t)(T0 + half * 64) * DIN + 1792 + head * 64, DIN, false, rq, c4, v);
      store_n(sK, LDT, half * 64, rq, c4, v);
      load4x4(p.QKV + (size_t)(T0 + half * 64) * DIN + 2048 + head * 64, DIN, false, rq, c4, v);
      store_t(sVT, LDT2, half * 64, rq, c4, v, one4);
    }
    __syncthreads();
    const int qi = w * 32 + r;
    const u16* qrow = p.QKV + (size_t)(T0 + qi) * DIN + 1536 + head * 64;
    uint4 qraw[4];
#pragma unroll
    for (int ks = 0; ks < 4; ++ks) qraw[ks] = *(const uint4*)(qrow + ks * 16 + 8 * h);
    f32x16 O[2];
#pragma unroll
    for (int d = 0; d < 2; ++d)
#pragma unroll
      for (int i = 0; i < 16; ++i) O[d][i] = 0.f;
#pragma unroll 1
    for (int jt = 0; jt < 4; ++jt) {
      f32x16 S;
#pragma unroll
      for (int i = 0; i < 16; ++i) S[i] = 0.f;
#pragma unroll
      for (int ks = 0; ks < 4; ++ks) {
        const bf16x8 kf = *(const bf16x8*)&sK[(jt * 32 + r) * LDT + ks * 16 + 8 * h];
        S = MFMA(kf, __builtin_bit_cast(bf16x8, qraw[ks]), S);
      }
#pragma unroll
      for (int i = 0; i < 16; ++i) {
        const int j = jt * 32 + crow(i, h);
        const int dlt = qi - j;
        const float wgt = (dlt > 0) ? __expf(lgf * (float)dlt) : ((dlt < 0) ? __expf(lgb * (float)(-dlt)) : 2.f);
        S[i] = S[i] * 0.125f * wgt;
      }
#pragma unroll
      for (int s = 0; s < 2; ++s) {
        const bf16x8 pf = mk8(pack2(S[8 * s + 0], S[8 * s + 1]), pack2(S[8 * s + 2], S[8 * s + 3]),
                              pack2(S[8 * s + 4], S[8 * s + 5]), pack2(S[8 * s + 6], S[8 * s + 7]));
#pragma unroll
        for (int d = 0; d < 2; ++d) {
          const u16* vrow = &sVT[(d * 32 + r) * LDT2 + jt * 32 + 16 * s + 4 * h];
          const uint2 lo = *(const uint2*)vrow;
          const uint2 hi = *(const uint2*)(vrow + 8);
          O[d] = MFMA(mk8(lo.x, lo.y, hi.x, hi.y), pf, O[d]);
        }
      }
    }
    {
      const float xf = __expf(lgf * (float)(qi + 1)), xb = __expf(lgb * (float)(128 - qi));
#pragma unroll
      for (int ks = 0; ks < 4; ++ks) {
        const uint4 q = qraw[ks];
        const bf16x8 qsf = mk8(pack2(bflo(q.x) * xf, bfhi(q.x) * xf), pack2(bflo(q.y) * xf, bfhi(q.y) * xf),
                               pack2(bflo(q.z) * xf, bfhi(q.z) * xf), pack2(bflo(q.w) * xf, bfhi(q.w) * xf));
        const bf16x8 qsb = mk8(pack2(bflo(q.x) * xb, bfhi(q.x) * xb), pack2(bflo(q.y) * xb, bfhi(q.y) * xb),
                               pack2(bflo(q.z) * xb, bfhi(q.z) * xb), pack2(bflo(q.w) * xb, bfhi(q.w) * xb));
#pragma unroll
        for (int d = 0; d < 2; ++d) {
          const bf16x8 sf = *(const bf16x8*)&sSTf[(d * 32 + r) * LDT + ks * 16 + 8 * h];
          const bf16x8 sb = *(const bf16x8*)&sSTb[(d * 32 + r) * LDT + ks * 16 + 8 * h];
          O[d] = MFMA(sf, qsf, O[d]);
          O[d] = MFMA(sb, qsb, O[d]);
        }
      }
    }
    float sum = 0.f;
#pragma unroll
    for (int d = 0; d < 2; ++d)
#pragma unroll
      for (int i = 0; i < 16; ++i) sum += O[d][i];
    sum += __shfl_xor(sum, 32);
    const float mu = sum * (1.f / 64.f);
    float vs = 0.f;
#pragma unroll
    for (int d = 0; d < 2; ++d)
#pragma unroll
      for (int i = 0; i < 16; ++i) { const float t = O[d][i] - mu; vs += t * t; }
    vs += __shfl_xor(vs, 32);
    const float rstd = rsqrtf(vs * (1.f / 64.f) + 1e-6f);
    const u16* grow = p.QKV + (size_t)(T0 + qi) * DIN + 2304 + head * 64;
    const float* gnw = p.gn + l * 256 + head * 64;
    u16* orow = p.CAT + (size_t)(T0 + qi) * DM + 768 + head * 64;
#pragma unroll
    for (int d = 0; d < 2; ++d)
#pragma unroll
      for (int g = 0; g < 4; ++g) {
        const int e = d * 32 + 8 * g + 4 * h;
        const uint2 gr = *(const uint2*)(grow + e);
        const float4 gw = *(const float4*)(gnw + e);
        const float o0 = silu(bflo(gr.x)) * (O[d][4 * g + 0] - mu) * rstd * gw.x;
        const float o1 = silu(bfhi(gr.x)) * (O[d][4 * g + 1] - mu) * rstd * gw.y;
        const float o2 = silu(bflo(gr.y)) * (O[d][4 * g + 2] - mu) * rstd * gw.z;
        const float o3 = silu(bfhi(gr.y)) * (O[d][4 * g + 3] - mu) * rstd * gw.w;
        uint2 pk = {pack2(o0, o1), pack2(o2, o3)};
        *(uint2*)(orow + e) = pk;
      }
  }
}

DI void phase3(const Params& p, char* smem, int l, const float* xc, const float* xl) {
  const float* W = p.w_out + (size_t)l * DM * DM;
  u16* PREB = (u16*)p.PRE;
  const int xcd = blockIdx.x & 7, nloc = gridDim.x >> 3;
  auto setup = [&](int s, int ar0, int ac, int n4, int kq, const u16*& ab, unsigned& o0, unsigned& o1, unsigned& o2, unsigned& o3, const float*& bb, unsigned& bo) {
    const int tm = 6 * xcd + s % 6, tn = s / 6;
    ab = p.CAT + (size_t)tm * 256 * DM;
    o0 = (unsigned)(ar0 * DM + ac); o1 = o0 + 64u * DM; o2 = o0 + 128u * DM; o3 = o0 + 192u * DM;
    bb = W + tn * 128;
    bo = (unsigned)(4 * n4 + kq * 4 * DM);
  };
  auto epi = [&](int s, f32x16(&acc)[2][4], int w, int r, int h) {
    int hq = h;
    asm volatile("" : "+v"(hq));
    const int tm = 6 * xcd + s % 6, tn = s / 6;
    const int m0 = tm * 256, n0 = tn * 128;
    const float* g1 = p.MOD + (size_t)(l * 5 + cond_of(m0)) * 6144 + 2048 + n0 + 4 * r;
    const float g0 = g1[0], g1v = g1[1], g2 = g1[2], g3 = g1[3];
#pragma unroll
    for (int mt = 0; mt < 2; ++mt)
#pragma unroll
    for (int i = 0; i < 16; ++i) {
      const int ml = w * 64 + mt * 32 + crow(i, hq);
      uint2 pk = {pack2(g0 * acc[mt][0][i], g1v * acc[mt][1][i]), pack2(g2 * acc[mt][2][i], g3 * acc[mt][3][i])};
      *(uint2*)(PREB + (size_t)(m0 + ml) * DM + n0 + 4 * r) = pk;
      if ((i & 3) == 3) __builtin_amdgcn_sched_barrier(0);
    }
  };
  gemm_phase<true>(smem, blockIdx.x >> 3, 48, nloc, setup, DM, epi, [](int, int) {});
}

DI void phase4(const Params& p, char* smem, int l, const float* xc, const float* xl) {
  float* swr = (float*)smem;
  const int tid = otid(), lane = tid & 63, w = tid >> 6;
  __syncthreads();
  for (int idx = tid; idx < 4096; idx += 256) {
    const float4 x = *(const float4*)(p.w_router + (size_t)l * DM * 16 + idx * 4);
    const int k = idx >> 2, e = (idx & 3) * 4;
    swr[(e + 0) * DM + k] = x.x; swr[(e + 1) * DM + k] = x.y; swr[(e + 2) * DM + k] = x.z; swr[(e + 3) * DM + k] = x.w;
  }
  __syncthreads();
  const float* lg = p.ln1g + l * DM;
  const float* lb = p.ln1b + l * DM;
  const int rstride = gridDim.x * 4;
  uint2 nprb[4];
  float4 nxi[4];
  {
    const int T0 = blockIdx.x * 4 + w;
    if (T0 < NTOK) {
      const float* xr0 = (T0 < NCTX) ? (xc + (size_t)T0 * DM) : (xl + (size_t)(T0 - NCTX) * DM);
#pragma unroll
      for (int i = 0; i < 4; ++i) {
        nprb[i] = *(const uint2*)((const u16*)p.PRE + (size_t)T0 * DM + 256 * i + 4 * lane);
        nxi[i] = *(const float4*)(xr0 + 256 * i + 4 * lane);
      }
    }
  }
  for (int T = blockIdx.x * 4 + w; T < NTOK; T += rstride) {
    const float* mod = p.MOD + (size_t)(l * 5 + cond_of(T)) * 6144;
    float4 x[4];
    float s = 0.f;
#pragma unroll
    for (int i = 0; i < 4; ++i) {
      const uint2 prb = nprb[i];
      const float4 xi = nxi[i];
      const float4 pr = {bflo(prb.x), bfhi(prb.x), bflo(prb.y), bfhi(prb.y)};
      x[i].x = ALPHA * xi.x + pr.x; x[i].y = ALPHA * xi.y + pr.y; x[i].z = ALPHA * xi.z + pr.z; x[i].w = ALPHA * xi.w + pr.w;
      s += x[i].x + x[i].y + x[i].z + x[i].w;
    }
    {
      const int Tn = T + rstride;
      if (Tn < NTOK) {
        const float* xrn = (Tn < NCTX) ? (xc + (size_t)Tn * DM) : (xl + (size_t)(Tn - NCTX) * DM);
#pragma unroll
        for (int i = 0; i < 4; ++i) {
          nprb[i] = *(const uint2*)((const u16*)p.PRE + (size_t)Tn * DM + 256 * i + 4 * lane);
          nxi[i] = *(const float4*)(xrn + 256 * i + 4 * lane);
        }
      }
    }
    const float mu = wave_sum(s) * (1.f / 1024.f);
    float vs = 0.f;
#pragma unroll
    for (int i = 0; i < 4; ++i) {
      x[i].x -= mu; x[i].y -= mu; x[i].z -= mu; x[i].w -= mu;
      vs += x[i].x * x[i].x + x[i].y * x[i].y + x[i].z * x[i].z + x[i].w * x[i].w;
    }
    const float rstd = rsqrtf(wave_sum(vs) * (1.f / 1024.f) + 1e-6f);
#pragma unroll
    for (int i = 0; i < 4; ++i) {
      const int k = 256 * i + 4 * lane;
      const float4 g = *(const float4*)(lg + k), bb = *(const float4*)(lb + k);
      float4 y;
      y.x = x[i].x * rstd * g.x + bb.x; y.y = x[i].y * rstd * g.y + bb.y; y.z = x[i].z * rstd * g.z + bb.z; y.w = x[i].w * rstd * g.w + bb.w;
      *(float4*)(p.X + (size_t)T * DM + k) = y;
      const float4 sc = *(const float4*)(mod + 4096 + k), sh = *(const float4*)(mod + 3072 + k);
      float4 hh;
      hh.x = y.x * (1.f + sc.x) + sh.x; hh.y = y.y * (1.f + sc.y) + sh.y; hh.z = y.z * (1.f + sc.z) + sh.z; hh.w = y.w * (1.f + sc.w) + sh.w;
      uint2 pk = {pack2(hh.x, hh.y), pack2(hh.z, hh.w)};
      *(uint2*)(p.H2 + (size_t)T * DM + k) = pk;
      x[i] = hh;
    }
    float a16[16];
#pragma unroll
    for (int e = 0; e < 16; ++e) {
      float a = 0.f;
#pragma unroll
      for (int i = 0; i < 4; ++i) {
        const float4 wv = *(const float4*)(swr + e * DM + 256 * i + 4 * lane);
        a += x[i].x * wv.x + x[i].y * wv.y + x[i].z * wv.z + x[i].w * wv.w;
      }
      a16[e] = a;
      if ((e & 3) == 3) __builtin_amdgcn_sched_barrier(0);
    }
    float a8[8], a4[4], a2[2], a1;
    {
      const bool hi = (lane & 32) != 0;
#pragma unroll
      for (int j = 0; j < 8; ++j) {
        const float snd = hi ? a16[j] : a16[8 + j];
        const float kp = hi ? a16[8 + j] : a16[j];
        a8[j] = kp + __shfl_xor(snd, 32);
      }
    }
    {
      const bool hi = (lane & 16) != 0;
#pragma unroll
      for (int j = 0; j < 4; ++j) {
        const float snd = hi ? a8[j] : a8[4 + j];
        const float kp = hi ? a8[4 + j] : a8[j];
        a4[j] = kp + __shfl_xor(snd, 16);
      }
    }
    {
      const bool hi = (lane & 8) != 0;
#pragma unroll
      for (int j = 0; j < 2; ++j) {
        const float snd = hi ? a4[j] : a4[2 + j];
        const float kp = hi ? a4[2 + j] : a4[j];
        a2[j] = kp + __shfl_xor(snd, 8);
      }
    }
    {
      const bool hi = (lane & 4) != 0;
      const float snd = hi ? a2[0] : a2[1];
      const float kp = hi ? a2[1] : a2[0];
      a1 = kp + __shfl_xor(snd, 4);
    }
    a1 += __shfl_xor(a1, 2);
    a1 += __shfl_xor(a1, 1);
    const int myexp = ((lane >> 5) & 1) * 8 + ((lane >> 4) & 1) * 4 + ((lane >> 3) & 1) * 2 + ((lane >> 2) & 1);
    float mx = a1;
#pragma unroll
    for (int o = 32; o >= 4; o >>= 1) mx = fmaxf(mx, __shfl_xor(mx, o));
    const float ex = __expf(a1 - mx);
    float den = ex;
#pragma unroll
    for (int o = 32; o >= 4; o >>= 1) den += __shfl_xor(den, o);
    if ((lane & 3) == 0) { p.AFF[(size_t)T * 16 + myexp] = ex / den; p.INV[(size_t)T * 16 + myexp] = -1; }
  }
}

DI unsigned block_incl_scan(unsigned v, unsigned* wsum, int lane, int w, unsigned& total) {
#pragma unroll
  for (int o = 1; o < 64; o <<= 1) {
    const unsigned t = __shfl_up(v, o);
    if (lane >= o) v += t;
  }
  __syncthreads();
  if (lane == 63) wsum[w] = v;
  __syncthreads();
  unsigned off = 0;
  total = 0;
#pragma unroll
  for (int i = 0; i < 4; ++i) {
    const unsigned s = wsum[i];
    if (i < w) off += s;
    total += s;
  }
  return v + off;
}

DI void phase5(const Params& p, char* smem) {
  unsigned* hist = (unsigned*)smem;
  unsigned* wsum = hist + 256;
  unsigned* bc = wsum + 4;
  const int tid = otid(), lane = tid & 63, w = tid >> 6;
  for (int item = blockIdx.x; item < 320; item += gridDim.x) {
    int n, base, e, cap, rowbase;
    if (item < 64) {
      const int b = item >> 4; e = item & 15;
      n = 2048; base = NCTX + b * 2048; cap = 256; rowbase = 512 + b * 256;
    } else {
      const int it = item - 64; const int rq = it >> 4; e = it & 15;
      n = 256; base = rq * 256; cap = 32; rowbase = rq * 32;
    }
    const int per = n >> 8;
    unsigned key[8];
#pragma unroll
    for (int q = 0; q < 8; ++q) key[q] = (q < per) ? __float_as_uint(p.AFF[(size_t)(base + tid * per + q) * 16 + e]) : 0u;
    unsigned prefix = 0u, mask = 0u;
    unsigned remaining = (unsigned)cap;
#pragma unroll 1
    for (int pass = 3; pass >= 0; --pass) {
      const int shift = pass * 8;
      __syncthreads();
      hist[tid] = 0u;
      __syncthreads();
#pragma unroll
      for (int q = 0; q < 8; ++q)
        if (q < per && (key[q] & mask) == prefix) atomicAdd(&hist[(key[q] >> shift) & 255u], 1u);
      __syncthreads();
      const unsigned hv = hist[tid];
      unsigned total;
      const unsigned incl = block_incl_scan(hv, wsum, lane, w, total);
      const unsigned above = total - incl;
      if (above < remaining && remaining <= above + hv) { bc[0] = (unsigned)tid; bc[1] = remaining - above; }
      __syncthreads();
      const unsigned bsel = bc[0];
      remaining = bc[1];
      prefix |= bsel << shift;
      mask |= 0xFFu << shift;
    }
    const unsigned thr = prefix;
    unsigned ceq = 0u;
#pragma unroll
    for (int q = 0; q < 8; ++q) ceq += (q < per && key[q] == thr) ? 1u : 0u;
    unsigned tot;
    unsigned eq_before = block_incl_scan(ceq, wsum, lane, w, tot) - ceq;
    unsigned selmask = 0u, nsel = 0u;
#pragma unroll
    for (int q = 0; q < 8; ++q) {
      if (q < per) {
        const bool eq = key[q] == thr;
        const bool sel = (key[q] > thr) || (eq && eq_before < remaining);
        eq_before += eq ? 1u : 0u;
        selmask |= sel ? (1u << q) : 0u;
        nsel += sel ? 1u : 0u;
      }
    }
    unsigned row = block_incl_scan(nsel, wsum, lane, w, tot) - nsel;
#pragma unroll
    for (int q = 0; q < 8; ++q) {
      if (q < per && ((selmask >> q) & 1u)) {
        const int tok = base + tid * per + q;
        const int rr = e * NROWS_E + rowbase + (int)row;
        p.SELTOK[rr] = tok;
        p.SELGATE[rr] = __uint_as_float(key[q]);
        p.INV[(size_t)tok * 16 + e] = rr;
        ++row;
      }
    }
  }
}

DI void phase6(const Params& p, char* smem, int l) {
  const int xcd = blockIdx.x & 7, nloc = gridDim.x >> 3;
  auto setup = [&](int s, int ar0, int ac, int n4, int kq, const u16*& ab, unsigned& o0, unsigned& o1, unsigned& o2, unsigned& o3, const float*& bb, unsigned& bo) {
    const int e = 2 * xcd + s / 96, rem = s % 96, tn = rem / 6, tm = rem % 6;
    const int* tok = p.SELTOK + e * NROWS_E + tm * 256 + ar0;
    ab = p.H2;
    o0 = (unsigned)(tok[0] * DM + ac); o1 = (unsigned)(tok[64] * DM + ac);
    o2 = (unsigned)(tok[128] * DM + ac); o3 = (unsigned)(tok[192] * DM + ac);
    bb = p.w_gu + ((size_t)l * 16 + e) * DM * 2048 + tn * 64;
    bo = (unsigned)(((n4 >> 4) & 1) * 1024 + 4 * (n4 & 15) + kq * 4 * 2048);
  };
  auto epi = [&](int s, f32x16(&acc)[2][4], int w, int r, int h) {
    int hq = h;
    asm volatile("" : "+v"(hq));
    const int e = 2 * xcd + s / 96, rem = s % 96, tn = rem / 6, tm = rem % 6;
    const int m0 = tm * 256, f0 = tn * 64;
    u16* act = p.ACT + ((size_t)e * NROWS_E + m0) * DM;
#pragma unroll
    for (int mt = 0; mt < 2; ++mt)
#pragma unroll
    for (int i = 0; i < 16; ++i) {
      const int ml = w * 64 + mt * 32 + crow(i, hq);
      const float a0 = acc[mt][0][i], a1 = acc[mt][1][i], a2 = acc[mt][2][i], a3 = acc[mt][3][i];
      const bool lo = r < 16;
      const float s0 = lo ? a2 : a0, s1 = lo ? a3 : a1;
      const float r0 = __shfl_xor(s0, 16), r1 = __shfl_xor(s1, 16);
      const float g0 = lo ? a0 : r0, g1 = lo ? a1 : r1;
      const float v0 = lo ? r0 : a2, v1 = lo ? r1 : a3;
      *(unsigned*)(act + (size_t)ml * DM + f0 + 4 * (r & 15) + (lo ? 0 : 2)) = pack2(silu(g0) * v0, silu(g1) * v1);
      if ((i & 3) == 3) __builtin_amdgcn_sched_barrier(0);
    }
  };
  gemm_phase<false>(smem, blockIdx.x >> 3, 192, nloc, setup, 2048, epi, [](int, int) {});
}

DI void phase7(const Params& p, char* smem, int l, u16* FF) {
  const int xcd = blockIdx.x & 7, nloc = gridDim.x >> 3;
  auto setup = [&](int s, int ar0, int ac, int n4, int kq, const u16*& ab, unsigned& o0, unsigned& o1, unsigned& o2, unsigned& o3, const float*& bb, unsigned& bo) {
    const int e = 2 * xcd + s / 48, rem = s % 48, tn = rem / 6, tm = rem % 6;
    ab = p.ACT + ((size_t)e * NROWS_E + tm * 256) * DM;
    o0 = (unsigned)(ar0 * DM + ac); o1 = o0 + 64u * DM; o2 = o0 + 128u * DM; o3 = o0 + 192u * DM;
    bb = p.w_down + ((size_t)l * 16 + e) * DM * DM + tn * 128;
    bo = (unsigned)(4 * n4 + kq * 4 * DM);
  };
  float* sG = (float*)(smem + 61440);
  int par = 1;
  auto pre = [&](int s, int tid) {
    par ^= 1;
    const int e = 2 * xcd + s / 48, rem = s % 48, tm = rem % 6;
    sG[par * 256 + tid] = p.SELGATE[e * NROWS_E + tm * 256 + tid];
  };
  auto epi = [&](int s, f32x16(&acc)[2][4], int w, int r, int h) {
    int hq = h;
    asm volatile("" : "+v"(hq));
    const int e = 2 * xcd + s / 48, rem = s % 48, tn = rem / 6, tm = rem % 6;
    const int m0 = tm * 256, n0 = tn * 128;
#pragma unroll
    for (int mt = 0; mt < 2; ++mt)
#pragma unroll
    for (int i = 0; i < 16; ++i) {
      const int ml = w * 64 + mt * 32 + crow(i, hq);
      const float g = sG[par * 256 + ml];
      uint2 pk = {pack2(g * acc[mt][0][i], g * acc[mt][1][i]), pack2(g * acc[mt][2][i], g * acc[mt][3][i])};
      *(uint2*)(FF + ((size_t)e * NROWS_E + m0 + ml) * DM + n0 + 4 * r) = pk;
      if ((i & 3) == 3) __builtin_amdgcn_sched_barrier(0);
    }
  };
  gemm_phase<true>(smem, blockIdx.x >> 3, 96, nloc, setup, DM, epi, pre);
}

DI void phase8(const Params& p, int l, float* dst, bool write_h) {
  const int tid = otid(), lane = tid & 63, w = tid >> 6;
  const float* lg = p.ln2g + l * DM;
  const float* lb = p.ln2b + l * DM;
  const int rstride = gridDim.x * 4;
  float4 nxa[4];
  int ninv = -1;
  {
    const int T0 = blockIdx.x * 4 + w;
    if (T0 < NTOK) {
#pragma unroll
      for (int i = 0; i < 4; ++i) nxa[i] = *(const float4*)(p.X + (size_t)T0 * DM + 256 * i + 4 * lane);
      ninv = (lane < 16) ? p.INV[(size_t)T0 * 16 + lane] : -1;
    }
  }
  for (int T = blockIdx.x * 4 + w; T < NTOK; T += rstride) {
    const float* g2 = p.MOD + (size_t)(l * 5 + cond_of(T)) * 6144 + 5120;
    const float* modn = p.MOD + (size_t)(5 + cond_of(T)) * 6144;
    float4 x[4], ff[4], xa[4];
#pragma unroll
    for (int i = 0; i < 4; ++i) { ff[i] = make_float4(0.f, 0.f, 0.f, 0.f); xa[i] = nxa[i]; }
    const int myinv = ninv;
    {
      const int Tn = T + rstride;
      if (Tn < NTOK) {
#pragma unroll
        for (int i = 0; i < 4; ++i) nxa[i] = *(const float4*)(p.X + (size_t)Tn * DM + 256 * i + 4 * lane);
        ninv = (lane < 16) ? p.INV[(size_t)Tn * 16 + lane] : -1;
      }
    }
    unsigned long long sel = __ballot(myinv >= 0);
#pragma unroll 1
    while (sel) {
      int rows[4];
#pragma unroll
      for (int q = 0; q < 4; ++q) {
        if (sel) {
          const int e = __ffsll((long long)sel) - 1;
          sel &= sel - 1;
          rows[q] = __shfl(myinv, e);
        } else {
          rows[q] = -1;
        }
      }
      uint2 y[4][4];
#pragma unroll
      for (int q = 0; q < 4; ++q) {
        const u16* yr = p.YE + (size_t)(rows[q] >= 0 ? rows[q] : 0) * DM + 4 * lane;
#pragma unroll
        for (int i = 0; i < 4; ++i) y[q][i] = *(const uint2*)(yr + 256 * i);
      }
#pragma unroll
      for (int q = 0; q < 4; ++q) {
        const float wq = rows[q] >= 0 ? 1.f : 0.f;
#pragma unroll
        for (int i = 0; i < 4; ++i) {
          ff[i].x += wq * bflo(y[q][i].x); ff[i].y += wq * bfhi(y[q][i].x); ff[i].z += wq * bflo(y[q][i].y); ff[i].w += wq * bfhi(y[q][i].y);
        }
      }
    }
    float s = 0.f;
#pragma unroll
    for (int i = 0; i < 4; ++i) {
      const int k = 256 * i + 4 * lane;
      const float4 a = xa[i];
      const float4 f = ff[i];
      const float4 g = *(const float4*)(g2 + k);
      x[i].x = ALPHA * a.x + g.x * f.x; x[i].y = ALPHA * a.y + g.y * f.y; x[i].z = ALPHA * a.z + g.z * f.z; x[i].w = ALPHA * a.w + g.w * f.w;
      s += x[i].x + x[i].y + x[i].z + x[i].w;
    }
    const float mu = wave_sum(s) * (1.f / 1024.f);
    float vs = 0.f;
#pragma unroll
    for (int i = 0; i < 4; ++i) {
      x[i].x -= mu; x[i].y -= mu; x[i].z -= mu; x[i].w -= mu;
      vs += x[i].x * x[i].x + x[i].y * x[i].y + x[i].z * x[i].z + x[i].w * x[i].w;
    }
    const float rstd = rsqrtf(wave_sum(vs) * (1.f / 1024.f) + 1e-6f);
#pragma unroll
    for (int i = 0; i < 4; ++i) {
      const int k = 256 * i + 4 * lane;
      const float4 g = *(const float4*)(lg + k), bb = *(const float4*)(lb + k);
      float4 y;
      y.x = x[i].x * rstd * g.x + bb.x; y.y = x[i].y * rstd * g.y + bb.y; y.z = x[i].z * rstd * g.z + bb.z; y.w = x[i].w * rstd * g.w + bb.w;
      *(float4*)(dst + (size_t)T * DM + k) = y;
      if (write_h) {
        const float4 sc = *(const float4*)(modn + 1024 + k), sh = *(const float4*)(modn + k);
        uint2 pk = {pack2(y.x * (1.f + sc.x) + sh.x, y.y * (1.f + sc.y) + sh.y), pack2(y.z * (1.f + sc.z) + sh.z, y.w * (1.f + sc.w) + sh.w)};
        *(uint2*)(p.H2 + (size_t)T * DM + k) = pk;
      }
    }
  }
}

constexpr int kDynLds = 73728;
__global__ void __launch_bounds__(256, 2) mega(Params p) {
  extern __shared__ __attribute__((aligned(16))) char smem[];
  cg::grid_group grid = cg::this_grid();
  if (p.never) grid.sync();
  GBar gb;
  gb.bar = p.BAR; gb.x = xb_xcc_id(); gb.nloc = 0u; gb.nx = 0u;
  if (threadIdx.x == 0) (void)xb_add(&p.BAR[XB_XCNT(gb.x)], 1u);
  phase0(p, smem);
  gbar(gb);
  phase0b(p);
  gbar(gb);
#pragma unroll 1
  for (int l = 0; l < 2; ++l) {
    const float* xc = (l == 0) ? p.x_prompt : p.X;
    const float* xl = (l == 0) ? p.x_sample : (p.X + (size_t)NCTX * DM);
    phase1(p, smem, l);
    gbar(gb);
    if (PROBE == 1) { phase1(p, smem, l); gbar(gb); }
    phase2(p, smem, l);
    gbar(gb);
    if (PROBE == 3) { phase2(p, smem, l); gbar(gb); }
    phase2c(p, smem, l);
    gbar(gb);
    if (PROBE == 3) { phase2c(p, smem, l); gbar(gb); }
    phase3(p, smem, l, xc, xl);
    gbar(gb);
    if (PROBE == 1) { phase3(p, smem, l, xc, xl); gbar(gb); }
    phase4(p, smem, l, xc, xl);
    gbar(gb);
    phase5(p, smem);
    gbar(gb);
    phase6(p, smem, l);
    gbar(gb);
    if (PROBE == 1) { phase6(p, smem, l); gbar(gb); }
    phase7(p, smem, l, p.YE);
    gbar(gb);
    phase8(p, l, (l == 1) ? p.out : p.X, l == 0);
    if (l == 0) gbar(gb);
  }
}

extern "C" void kernel_launch(void* const* d_in, const int* in_sizes, int n_in, void* d_out, int out_size, void* d_ws,
                              size_t ws_size, hipStream_t stream) {
  static int grid_blocks = 0;
  if (!grid_blocks) {
    int dev = 0, cus = 0, per_cu = 0;
    hipGetDevice(&dev);
    hipDeviceGetAttribute(&cus, hipDeviceAttributeMultiprocessorCount, dev);
    hipFuncSetAttribute((const void*)mega, hipFuncAttributeMaxDynamicSharedMemorySize, kDynLds);
    hipOccupancyMaxActiveBlocksPerMultiprocessor(&per_cu, mega, 256, kDynLds);
    if (per_cu > 2) per_cu = 2;
    if (per_cu < 1) per_cu = 1;
    grid_blocks = cus * per_cu;
  }
  Params p{};
  const float** pf = (const float**)&p;
  for (int i = 0; i < 24; ++i) pf[i] = (const float*)d_in[i];
  p.out = (float*)d_out;
  char* ws = (char*)d_ws;
  size_t off = 0;
  auto take = [&](size_t bytes) { char* q = ws + off; off += (bytes + 255) & ~(size_t)255; return q; };
  p.MOD = (float*)take(2 * 5 * 6144 * 4);
  p.BAR = (unsigned*)take(XCD_BAR_WORDS * 4);
  p.ROPE = (float*)take(2048 * 4);
  p.X = (float*)take((size_t)NTOK * DM * 4);
  p.PRE = (float*)take((size_t)NTOK * DM * 4);
  p.KVS = (float*)take((size_t)20 * 4 * 2 * 16 * 4096 * 4);
  p.AFF = (float*)take((size_t)NTOK * 16 * 4);
  p.SELGATE = (float*)take((size_t)16 * NROWS_E * 4);
  p.SELTOK = (int*)take((size_t)16 * NROWS_E * 4);
  p.QKV = (u16*)take((size_t)NTOK * DIN * 2);
  p.CAT = (u16*)take((size_t)NTOK * DM * 2);
  p.H2 = (u16*)take((size_t)NTOK * DM * 2);
  p.ACT = (u16*)take((size_t)16 * NROWS_E * DM * 2);
  p.YE = (u16*)take((size_t)16 * NROWS_E * DM * 2);
  p.INV = (int*)take((size_t)NTOK * 16 * 4);
  p.CAK = (u16*)take((size_t)4 * 2 * 512 * 128 * 2);
  p.CAV = (u16*)take((size_t)4 * 2 * 512 * 128 * 2);
  p.CBK = (u16*)take((size_t)4 * 2 * 512 * 256 * 2);
  p.CBV = (u16*)take((size_t)4 * 2 * 512 * 256 * 2);
  p.never = 0;
  hipMemsetAsync(p.MOD, 0, (size_t)((char*)p.BAR - (char*)p.MOD) + XCD_BAR_WORDS * 4, stream);
  void* args[] = {&p};
  hipError_t e = hipLaunchCooperativeKernel((void*)mega, dim3(grid_blocks), dim3(256), args, kDynLds, stream);
  if (e != hipSuccess) fprintf(stderr, "cooperative launch failed: %s (grid %d)\n", hipGetErrorString(e), grid_blocks);
}
```

```cpp
#include <hip/hip_runtime.h>
#include <hip/hip_cooperative_groups.h>
#include <cstdio>
namespace cg = cooperative_groups;

#define DI __device__ __forceinline__
typedef short bf16x8 __attribute__((ext_vector_type(8)));
typedef float f32x16 __attribute__((ext_vector_type(16)));
typedef __bf16 bf2_t __attribute__((ext_vector_type(2)));
typedef float f2_t __attribute__((ext_vector_type(2)));
typedef unsigned short u16;
typedef unsigned u32x4 __attribute__((ext_vector_type(4)));
typedef float f32x4 __attribute__((ext_vector_type(4)));
typedef float f32x2 __attribute__((ext_vector_type(2)));

#define MFMA(a, b, c) __builtin_amdgcn_mfma_f32_32x32x16_bf16((a), (b), (c), 0, 0, 0)

#define PROBE 0
constexpr int NTOK = 12288;
constexpr int NCTX = 4096;
constexpr int DM = 1024;
constexpr int DIN = 2560;
constexpr int LDT = 72;
constexpr int LDT2 = 136;
constexpr int NROWS_E = 1536;
constexpr float NEG = -1e30f;
constexpr float ALPHA = 1.41421356237f;

constexpr size_t OFF_AK = 12582912, OFF_AV = 13631488, OFF_BK = 14680064, OFF_BV = 16777216, OFF_ST = 18874368;

struct Params {
  const float *x_prompt, *x_sample, *cak, *cav, *cbk, *cbv, *state, *c, *c_ctx, *w_ada, *b_ada, *w_in, *w_out, *sink, *rpb,
      *decay, *gn, *ln1g, *ln1b, *ln2g, *ln2b, *w_router, *w_gu, *w_down;
  float* out;
  float *MOD, *ROPE, *X, *PRE, *KVS, *AFF, *SELGATE;
  int* SELTOK;
  u16 *QKV, *CAT, *H2, *ACT, *CAK, *CAV, *CBK, *CBV;
  u16* YE;
  int* INV;
  unsigned* BAR;
  long never;
};

DI unsigned pack2(float a, float b) {
  f2_t v = {a, b};
  bf2_t r = __builtin_convertvector(v, bf2_t);
  return __builtin_bit_cast(unsigned, r);
}
DI int otid() { int x = threadIdx.x; asm volatile("" : "+v"(x)); return x; }
DI float bflo(unsigned u) { return __uint_as_float(u << 16); }
DI float bfhi(unsigned u) { return __uint_as_float(u & 0xffff0000u); }
DI int crow(int i, int h) { return (i & 3) + 8 * (i >> 2) + 4 * h; }
DI float silu(float x) { return x / (1.f + __expf(-x)); }
template <int CTRL>
DI float dpp_mov(float v) {
  return __int_as_float(__builtin_amdgcn_update_dpp(0, __float_as_int(v), CTRL, 0xF, 0xF, true));
}
DI float wave_sum(float v) {
  v += dpp_mov<0xB1>(v);
  v += dpp_mov<0x4E>(v);
  v += dpp_mov<0x141>(v);
  v += dpp_mov<0x140>(v);
  const int iv = __float_as_int(v);
  const float r0 = __int_as_float(__builtin_amdgcn_readlane(iv, 0)), r1 = __int_as_float(__builtin_amdgcn_readlane(iv, 16));
  const float r2 = __int_as_float(__builtin_amdgcn_readlane(iv, 32)), r3 = __int_as_float(__builtin_amdgcn_readlane(iv, 48));
  return (r0 + r1) + (r2 + r3);
}
DI bf16x8 mk8(unsigned a, unsigned b, unsigned c, unsigned d) {
  uint4 u = {a, b, c, d};
  return __builtin_bit_cast(bf16x8, u);
}


#define XB_TMO 128
#define XB_XCNT(j) (256 + 64 * (j))
#define XB_XSUB(j) (1280 + 64 * (j))
#define XB_XGEN(j) (2304 + 64 * (j))
#define XB_TOP 3328
#define XB_TOPGEN 3392
#define XCD_BAR_WORDS 3456
#define XB_SPIN_CAP (1u << 20)
DI unsigned xb_ld(unsigned* p) { return __hip_atomic_load(p, __ATOMIC_RELAXED, __HIP_MEMORY_SCOPE_AGENT); }
DI unsigned xb_add(unsigned* p, unsigned v) { return __hip_atomic_fetch_add(p, v, __ATOMIC_RELAXED, __HIP_MEMORY_SCOPE_AGENT); }
DI unsigned xb_xcc_id() { return (unsigned)__builtin_amdgcn_s_getreg((3 << 11) | 20) & 0xFu; }
#define XB_SPIN(cond, bar)                                                            \
  do {                                                                                \
    unsigned _sp = 0;                                                                 \
    while (cond) {                                                                    \
      __builtin_amdgcn_s_sleep(1);                                                    \
      if ((++_sp & 255u) == 0u) {                                                     \
        if (xb_ld(&(bar)[XB_TMO])) break;                                             \
        if (_sp > XB_SPIN_CAP) { atomicAdd(&(bar)[XB_TMO], 1u); break; }              \
      }                                                                               \
    }                                                                                 \
  } while (0)
struct GBar { unsigned* bar; unsigned x, nloc, nx; };
DI void gbar_complete(unsigned* bar, unsigned x, unsigned& nloc, unsigned& nx) {
  const unsigned G = gridDim.x;
  unsigned sum, cnt, mine, sp = 0u;
  for (;;) {
    sum = 0u; cnt = 0u; mine = 0u;
#pragma unroll
    for (unsigned j = 0; j < 16; ++j) {
      const unsigned c = xb_ld(&bar[XB_XCNT(j)]);
      sum += c; cnt += (c > 0u) ? 1u : 0u; mine = (j == x) ? c : mine;
    }
    if (sum == G) break;
    __builtin_amdgcn_s_sleep(1);
    if ((++sp & 255u) == 0u) {
      if (xb_ld(&bar[XB_TMO])) break;
      if (sp > XB_SPIN_CAP) { atomicAdd(&bar[XB_TMO], 1u); break; }
    }
  }
  nloc = mine > 0u ? mine : 1u;
  nx = cnt > 0u ? cnt : 1u;
}
DI void gbar(GBar& b) {
  asm volatile("s_waitcnt vmcnt(0)" ::: "memory");
  __syncthreads();
  if (threadIdx.x == 0) {
    unsigned* bar = b.bar;
    __builtin_amdgcn_s_waitcnt(0);
    if (b.nloc == 0u) gbar_complete(bar, b.x, b.nloc, b.nx);
    const unsigned nloc = b.nloc, nx = b.nx;
    const unsigned old = xb_add(&bar[XB_XSUB(b.x)], 1u);
    const unsigned gen = old / nloc;
    if (old + 1u == (gen + 1u) * nloc) {
      __builtin_amdgcn_fence(__ATOMIC_RELEASE, "agent");
      asm volatile("s_waitcnt vmcnt(0)" ::: "memory");
      const unsigned og = xb_add(&bar[XB_TOP], 1u);
      const unsigned tg = og / nx;
      if (og + 1u == (tg + 1u) * nx) xb_add(&bar[XB_TOPGEN], 1u);
      else XB_SPIN(xb_ld(&bar[XB_TOPGEN]) == tg, bar);
      __builtin_amdgcn_fence(__ATOMIC_ACQUIRE, "agent");
      xb_add(&bar[XB_XGEN(b.x)], 1u);
      asm volatile("s_waitcnt vmcnt(0)" ::: "memory");
    } else {
      XB_SPIN(xb_ld(&bar[XB_XGEN(b.x)]) == gen, bar);
      __builtin_amdgcn_fence(__ATOMIC_ACQUIRE, "agent");
      asm volatile("s_waitcnt vmcnt(0)" ::: "memory");
    }
  }
  __syncthreads();
}

template <class Setup, class Epi>
DI void gemm_phase128(char* smem, int s0, int s_end, int s_step, Setup setup, int ldb, Epi epi) {
  if (s0 >= s_end) return;
  u16* sA0 = (u16*)smem;
  u16* sB0 = sA0 + 128 * LDT;
  u16* sA1 = sB0 + 128 * LDT;
  u16* sB1 = sA1 + 128 * LDT;
  const int tid = otid(), lane = tid & 63, w = tid >> 6, r = lane & 31, h = lane >> 5;
  const int a_r0 = tid >> 3, a_c = (tid & 7) * 8;
  const int b_n4 = tid & 31, b_kq = tid >> 5;
  const u16 *apb0, *apb1, *apb2, *apb3;
  const float* bp;
  setup(s0, a_r0, a_c, b_n4, b_kq, apb0, apb1, apb2, apb3, bp);

  u32x4 pa0, pa1, pa2, pa3;
  f32x4 pb[8];

#define G_LOAD(KT)                                                                       \
  {                                                                                      \
    const int k0_ = (KT) * 64;                                                           \
    pa0 = *(const u32x4*)(apb0 + k0_);                                                   \
    pa1 = *(const u32x4*)(apb1 + k0_);                                                   \
    pa2 = *(const u32x4*)(apb2 + k0_);                                                   \
    pa3 = *(const u32x4*)(apb3 + k0_);                                                   \
    _Pragma("unroll") for (int i_ = 0; i_ < 8; ++i_) pb[i_] = *(const f32x4*)(bp + (size_t)(k0_ + i_) * ldb); \
  }
#define G_STAGE(SA, SBB)                                                                 \
  {                                                                                      \
    *(u32x4*)&SA[(a_r0)*LDT + a_c] = pa0;                                                \
    *(u32x4*)&SA[(a_r0 + 32) * LDT + a_c] = pa1;                                         \
    *(u32x4*)&SA[(a_r0 + 64) * LDT + a_c] = pa2;                                         \
    *(u32x4*)&SA[(a_r0 + 96) * LDT + a_c] = pa3;                                         \
    _Pragma("unroll") for (int j_ = 0; j_ < 4; ++j_) {                                   \
      u32x4 pk_;                                                                         \
      pk_.x = pack2(pb[0][j_], pb[1][j_]);                                               \
      pk_.y = pack2(pb[2][j_], pb[3][j_]);                                               \
      pk_.z = pack2(pb[4][j_], pb[5][j_]);                                               \
      pk_.w = pack2(pb[6][j_], pb[7][j_]);                                               \
      *(u32x4*)&SBB[(j_ * 32 + b_n4) * LDT + b_kq * 8] = pk_;                            \
    }                                                                                    \
  }
  const int aoff = (w * 32 + r) * LDT + 8 * h, boff = r * LDT + 8 * h;
#define G_FRAG(BUF, SA, SBB, KS)                                                         \
  {                                                                                      \
    fa[BUF] = *(const bf16x8*)(SA + aoff + (KS) * 16);                                   \
    fb[BUF][0] = *(const bf16x8*)(SBB + boff + (KS) * 16);                               \
    fb[BUF][1] = *(const bf16x8*)(SBB + boff + 32 * LDT + (KS) * 16);                    \
    fb[BUF][2] = *(const bf16x8*)(SBB + boff + 64 * LDT + (KS) * 16);                    \
    fb[BUF][3] = *(const bf16x8*)(SBB + boff + 96 * LDT + (KS) * 16);                    \
  }
#define G_MFMA(BUF)                                                                      \
  {                                                                                      \
    acc[0] = MFMA(fa[BUF], fb[BUF][0], acc[0]);                                          \
    acc[1] = MFMA(fa[BUF], fb[BUF][1], acc[1]);                                          \
    acc[2] = MFMA(fa[BUF], fb[BUF][2], acc[2]);                                          \
    acc[3] = MFMA(fa[BUF], fb[BUF][3], acc[3]);                                          \
  }
#define SB() __builtin_amdgcn_sched_barrier(0)
#define G_COMPUTE(SA, SBB)                                                               \
  {                                                                                      \
    bf16x8 fa[2], fb[2][4];                                                              \
    G_FRAG(0, SA, SBB, 0);                                                               \
    G_FRAG(1, SA, SBB, 1);                                                               \
    SB();                                                                                \
    G_MFMA(0);                                                                           \
    SB();                                                                                \
    G_FRAG(0, SA, SBB, 2);                                                               \
    SB();                                                                                \
    G_MFMA(1);                                                                           \
    SB();                                                                                \
    G_FRAG(1, SA, SBB, 3);                                                               \
    SB();                                                                                \
    G_MFMA(0);                                                                           \
    SB();                                                                                \
    G_MFMA(1);                                                                           \
    SB();                                                                                \
  }

  G_LOAD(0);
  __syncthreads();
#pragma unroll 1
  for (int s = s0; s < s_end; s += s_step) {
    f32x16 acc[4];
#pragma unroll
    for (int a = 0; a < 4; ++a)
#pragma unroll
      for (int i = 0; i < 16; ++i) acc[a][i] = 0.f;
    const int sn = s + s_step;
    const bool has_next = sn < s_end;
    const u16 *n0 = apb0, *n1 = apb1, *n2 = apb2, *n3 = apb3;
    const float* nbp = bp;
    if (has_next) setup(sn, a_r0, a_c, b_n4, b_kq, n0, n1, n2, n3, nbp);
#pragma unroll 1
    for (int kt = 0; kt < 16; kt += 2) {
      G_STAGE(sA0, sB0);
      __syncthreads();
      G_LOAD(kt + 1);
      G_COMPUTE(sA0, sB0);
      G_STAGE(sA1, sB1);
      __syncthreads();
      {
        int kn = kt + 2;
        if (kt == 14) { apb0 = n0; apb1 = n1; apb2 = n2; apb3 = n3; bp = nbp; kn = 0; }
        G_LOAD(kn);
      }
      G_COMPUTE(sA1, sB1);
    }
    epi(s, acc, w, r, h);
  }
  __syncthreads();
#undef G_LOAD
#undef G_STAGE
#undef G_COMPUTE
#undef G_FRAG
#undef G_MFMA
}
#undef SB

template <bool CONTIG, class Setup, class Epi, class Pre>
DI void gemm_phase(char* smem, int s0, int s_end, int s_step, Setup setup, int ldb, Epi epi, Pre pre) {
  asm volatile("" : "+s"(s_end));
  if (s0 >= s_end) return;
  constexpr int LDK = 40;
  u16* sA0 = (u16*)smem;
  u16* sB0 = sA0 + 256 * LDK;
  u16* sA1 = sB0 + 128 * LDK;
  u16* sB1 = sA1 + 256 * LDK;
  const int tid = otid(), lane = tid & 63, w = tid >> 6, r = lane & 31, h = lane >> 5;
  const int a_r0 = tid >> 2, a_c = (tid & 3) * 8;
  const int b_n4 = tid & 31, b_kq = tid >> 5;
  const u16* abase;
  const float* bbase;
  unsigned ao0, ao1, ao2, ao3, bo;
  setup(s0, a_r0, a_c, b_n4, b_kq, abase, ao0, ao1, ao2, ao3, bbase, bo);

  u32x4 pa0, pa1, pa2, pa3;
  f32x4 pbA[4], pbB[4];

#define G_LOADA(KT)                                                                      \
  {                                                                                      \
    const int k0_ = (KT) * 32;                                                           \
    pa0 = *(const u32x4*)(abase + k0_ + (size_t)ao0);                                    \
    pa1 = *(const u32x4*)(abase + k0_ + (size_t)(CONTIG ? ao0 + 64u * DM : ao1));        \
    pa2 = *(const u32x4*)(abase + k0_ + (size_t)(CONTIG ? ao0 + 128u * DM : ao2));       \
    pa3 = *(const u32x4*)(abase + k0_ + (size_t)(CONTIG ? ao0 + 192u * DM : ao3));       \
  }
#define G_LOADB(PB, BP, KT)                                                              \
  {                                                                                      \
    const int k0_ = (KT) * 32;                                                           \
    _Pragma("unroll") for (int i_ = 0; i_ < 4; ++i_) PB[i_] = *(const f32x4*)((BP) + (size_t)(k0_ + i_) * ldb + (size_t)bo); \
  }
#define G_STAGE(SA, SBB, PB)                                                               \
  {                                                                                      \
    *(u32x4*)&SA[(a_r0)*LDK + a_c] = pa0;                                                \
    *(u32x4*)&SA[(a_r0 + 64) * LDK + a_c] = pa1;                                         \
    *(u32x4*)&SA[(a_r0 + 128) * LDK + a_c] = pa2;                                        \
    *(u32x4*)&SA[(a_r0 + 192) * LDK + a_c] = pa3;                                        \
    _Pragma("unroll") for (int j_ = 0; j_ < 4; ++j_) {                                   \
      uint2 pk_;                                                                         \
      pk_.x = pack2(PB[0][j_], PB[1][j_]);                                               \
      pk_.y = pack2(PB[2][j_], PB[3][j_]);                                               \
      *(uint2*)&SBB[(j_ * 32 + b_n4) * LDK + b_kq * 4] = pk_;                            \
    }                                                                                    \
  }
  const int aoff = (w * 64 + r) * LDK + 8 * h, boff = r * LDK + 8 * h;
#define G_FRAG(FA, FB, SA, SBB, KS)                                                      \
  {                                                                                      \
    FA[0] = *(const bf16x8*)(SA + aoff + (KS) * 16);                                     \
    FA[1] = *(const bf16x8*)(SA + aoff + 32 * LDK + (KS) * 16);                          \
    FB[0] = *(const bf16x8*)(SBB + boff + (KS) * 16);                                    \
    FB[1] = *(const bf16x8*)(SBB + boff + 32 * LDK + (KS) * 16);                         \
    FB[2] = *(const bf16x8*)(SBB + boff + 64 * LDK + (KS) * 16);                         \
    FB[3] = *(const bf16x8*)(SBB + boff + 96 * LDK + (KS) * 16);                         \
  }
#define G_MFMA(FA, FB)                                                                   \
  {                                                                                      \
    _Pragma("unroll") for (int mt_ = 0; mt_ < 2; ++mt_)                                  \
    _Pragma("unroll") for (int nt_ = 0; nt_ < 4; ++nt_) acc[mt_][nt_] = MFMA(FA[mt_], FB[nt_], acc[mt_][nt_]); \
  }
#define SB() __builtin_amdgcn_sched_barrier(0)
#define G_COMPUTE(SA, SBB)                                                               \
  {                                                                                      \
    bf16x8 fa0[2], fb0[4];                                                               \
    G_FRAG(fa0, fb0, SA, SBB, 0);                                                        \
    SB();                                                                                \
    G_MFMA(fa0, fb0);                                                                    \
    SB();                                                                                \
    G_FRAG(fa0, fb0, SA, SBB, 1);                                                        \
    SB();                                                                                \
    G_MFMA(fa0, fb0);                                                                    \
    SB();                                                                                \
  }

  G_LOADA(0);
  G_LOADB(pbA, bbase, 0);
  G_LOADB(pbB, bbase, 1);
  __syncthreads();
#pragma unroll 1
  for (int s = s0; s < s_end; s += s_step) {
    f32x16 acc[2][4];
#pragma unroll
    for (int a = 0; a < 2; ++a)
#pragma unroll
      for (int b = 0; b < 4; ++b)
#pragma unroll
        for (int i = 0; i < 16; ++i) acc[a][b][i] = 0.f;
    pre(s, tid);
    const int sn = s + s_step;
    const bool has_next = sn < s_end;
    const u16* nabase = abase;
    const float* nbbase = bbase;
    unsigned n0 = ao0, n1 = ao1, n2 = ao2, n3 = ao3, nbo = bo;
    if (has_next) setup(sn, a_r0, a_c, b_n4, b_kq, nabase, n0, n1, n2, n3, nbbase, nbo);
#pragma unroll 1
    for (int kt = 0; kt < 32; kt += 2) {
      G_STAGE(sA0, sB0, pbA);
      G_LOADA(kt + 1);
      __syncthreads();
      {
        const bool last = (kt == 30);
        const float* bq = last ? nbbase : bbase;
        const int kb = last ? 0 : kt + 2;
        G_LOADB(pbA, bq, kb);
      }
      G_COMPUTE(sA0, sB0);
      G_STAGE(sA1, sB1, pbB);
      {
        int ka = kt + 2, kb = kt + 3;
        if (kt == 30) { abase = nabase; ao0 = n0; ao1 = n1; ao2 = n2; ao3 = n3; bbase = nbbase; ka = 0; kb = 1; }
        G_LOADA(ka);
        G_LOADB(pbB, bbase, kb);
      }
      __syncthreads();
      G_COMPUTE(sA1, sB1);
    }
    epi(s, acc, w, r, h);
  }
  __syncthreads();
#undef G_LOADA
#undef G_LOADB
#undef G_STAGE
#undef G_COMPUTE
#undef G_FRAG
#undef G_MFMA
}

DI void load4x4(const void* base, int stride, bool isf32, int rq, int c4, float v[4][4]) {
  if (isf32) {
#pragma unroll
    for (int i = 0; i < 4; ++i) {
      const float4 x = *(const float4*)((const float*)base + (size_t)(4 * rq + i) * stride + 4 * c4);
      v[i][0] = x.x; v[i][1] = x.y; v[i][2] = x.z; v[i][3] = x.w;
    }
  } else {
#pragma unroll
    for (int i = 0; i < 4; ++i) {
      const uint2 x = *(const uint2*)((const u16*)base + (size_t)(4 * rq + i) * stride + 4 * c4);
      v[i][0] = bflo(x.x); v[i][1] = bfhi(x.x); v[i][2] = bflo(x.y); v[i][3] = bfhi(x.y);
    }
  }
}
DI void store_n(u16* dst, int ld, int row0, int rq, int c4, const float v[4][4]) {
#pragma unroll
  for (int i = 0; i < 4; ++i) {
    uint2 pk = {pack2(v[i][0], v[i][1]), pack2(v[i][2], v[i][3])};
    *(uint2*)&dst[(row0 + 4 * rq + i) * ld + 4 * c4] = pk;
  }
}
DI void store_t(u16* dst, int ld, int col0, int rq, int c4, const float v[4][4], const float s[4]) {
#pragma unroll
  for (int j = 0; j < 4; ++j) {
    uint2 pk = {pack2(v[0][j] * s[0], v[1][j] * s[1]), pack2(v[2][j] * s[2], v[3][j] * s[3])};
    *(uint2*)&dst[(4 * c4 + j) * ld + col0 + 4 * rq] = pk;
  }
}

DI void attn_load(const u16* kp, const u16* vp, int stride, int rq, int c4, uint2 (&k)[4], uint2 (&v)[4]) {
#pragma unroll
  for (int i = 0; i < 4; ++i) {
    k[i] = *(const uint2*)(kp + (size_t)(4 * rq + i) * stride + 4 * c4);
    v[i] = *(const uint2*)(vp + (size_t)(4 * rq + i) * stride + 4 * c4);
  }
}
DI void attn_stage(u16* sK, u16* sVT, int rq, int c4, const uint2 (&k)[4], const uint2 (&v)[4]) {
#pragma unroll
  for (int i = 0; i < 4; ++i) *(uint2*)&sK[(4 * rq + i) * LDT + 4 * c4] = k[i];
  uint2 t0, t1, t2, t3;
  t0.x = (v[0].x & 0xffffu) | (v[1].x << 16);          t0.y = (v[2].x & 0xffffu) | (v[3].x << 16);
  t1.x = (v[0].x >> 16) | (v[1].x & 0xffff0000u);      t1.y = (v[2].x >> 16) | (v[3].x & 0xffff0000u);
  t2.x = (v[0].y & 0xffffu) | (v[1].y << 16);          t2.y = (v[2].y & 0xffffu) | (v[3].y << 16);
  t3.x = (v[0].y >> 16) | (v[1].y & 0xffff0000u);      t3.y = (v[2].y >> 16) | (v[3].y & 0xffff0000u);
  const int qs = 4 * (rq ^ ((c4 >> 1) & 7));
  *(uint2*)&sVT[(4 * c4 + 0) * LDT + qs] = t0;
  *(uint2*)&sVT[(4 * c4 + 1) * LDT + qs] = t1;
  *(uint2*)&sVT[(4 * c4 + 2) * LDT + qs] = t2;
  *(uint2*)&sVT[(4 * c4 + 3) * LDT + qs] = t3;
}

template <class TileSrc, class BiasF, class TMode>
DI void attn_core(char* smem, const u16* qbase, int ntiles, TileSrc src, BiasF biasf, TMode tmode, float m_init, bool has_sink, u16* obase) {
  u16* sK0 = (u16*)smem;
  u16* sVT0 = sK0 + 64 * LDT;
  u16* sK1 = sVT0 + 64 * LDT;
  u16* sVT1 = sK1 + 64 * LDT;
  const int tid = otid(), lane = tid & 63, w = tid >> 6, r = lane & 31, h = lane >> 5;
  const int rq = tid >> 4, c4 = tid & 15;
  const int ql = w * 32 + r;
  bf16x8 qf[4];
#pragma unroll
  for (int ks = 0; ks < 4; ++ks) qf[ks] = *(const bf16x8*)(qbase + (size_t)ql * DIN + ks * 16 + 8 * h);
  f32x16 O[2];
#pragma unroll
  for (int d = 0; d < 2; ++d)
#pragma unroll
    for (int i = 0; i < 16; ++i) O[d][i] = 0.f;
  float m = m_init, lsum = (has_sink && h == 0) ? 1.f : 0.f;

  auto nextv = [&](int j, const u16*& kp, const u16*& vp, int& stride) -> int {
    while (j < ntiles && !src(j, kp, vp, stride)) ++j;
    return j;
  };
  auto compute = [&](int jc, const u16* sK, const u16* sVT) {
    const int mode = tmode(jc, w);
    if (mode != 2) {
      f32x16 S[2];
#pragma unroll
      for (int mt = 0; mt < 2; ++mt)
#pragma unroll
        for (int i = 0; i < 16; ++i) S[mt][i] = 0.f;
#pragma unroll
      for (int ks = 0; ks < 4; ++ks)
#pragma unroll
        for (int mt = 0; mt < 2; ++mt) {
          const bf16x8 kf = *(const bf16x8*)&sK[(mt * 32 + r) * LDT + ks * 16 + 8 * h];
          S[mt] = MFMA(kf, qf[ks], S[mt]);
        }
      const float C2 = 0.125f * 1.44269504f;
      float mx = NEG;
      if (mode == 1) {
#pragma unroll
        for (int mt = 0; mt < 2; ++mt)
#pragma unroll
          for (int i = 0; i < 16; ++i) {
            const float s = S[mt][i] * C2 + biasf(jc, mt * 32 + crow(i, h), ql);
            S[mt][i] = s;
            mx = fmaxf(mx, s);
          }
      } else {
#pragma unroll
        for (int mt = 0; mt < 2; ++mt)
#pragma unroll
          for (int i = 0; i < 16; ++i) {
            const float s = S[mt][i] * C2;
            S[mt][i] = s;
            mx = fmaxf(mx, s);
          }
      }
      mx = fmaxf(mx, __shfl_xor(mx, 32));
      const float mn = fmaxf(m, mx);
      if (__any(mn > m)) {
        const float alpha = __builtin_amdgcn_exp2f(m - mn);
        m = mn;
        lsum *= alpha;
#pragma unroll
        for (int d = 0; d < 2; ++d)
#pragma unroll
          for (int i = 0; i < 16; ++i) O[d][i] *= alpha;
      }
      float ps = 0.f;
#pragma unroll
      for (int mt = 0; mt < 2; ++mt)
#pragma unroll
        for (int i = 0; i < 16; ++i) {
          const float pv = __builtin_amdgcn_exp2f(S[mt][i] - m);
          S[mt][i] = pv;
          ps += pv;
        }
      lsum += ps;
#pragma unroll
      for (int mt = 0; mt < 2; ++mt)
#pragma unroll
        for (int s = 0; s < 2; ++s) {
          const bf16x8 pf = mk8(pack2(S[mt][8 * s + 0], S[mt][8 * s + 1]), pack2(S[mt][8 * s + 2], S[mt][8 * s + 3]),
                                pack2(S[mt][8 * s + 4], S[mt][8 * s + 5]), pack2(S[mt][8 * s + 6], S[mt][8 * s + 7]));
#pragma unroll
          for (int d = 0; d < 2; ++d) {
            const int sw = (d * 4 + (r >> 3)) & 7, q = mt * 8 + 4 * s + h;
            const u16* vrow = &sVT[(d * 32 + r) * LDT];
            const uint2 lo = *(const uint2*)(vrow + 4 * (q ^ sw));
            const uint2 hi = *(const uint2*)(vrow + 4 * ((q + 2) ^ sw));
            O[d] = MFMA(mk8(lo.x, lo.y, hi.x, hi.y), pf, O[d]);
          }
        }
    }
  };

  uint2 kA[4], vA[4], kB[4], vB[4];
#pragma unroll
  for (int i = 0; i < 4; ++i) { kA[i] = make_uint2(0u, 0u); vA[i] = kA[i]; kB[i] = kA[i]; vB[i] = kA[i]; }
  const u16 *kp = nullptr, *vp = nullptr;
  int stride = 0;
  int jA = nextv(0, kp, vp, stride);
  if (jA < ntiles) attn_load(kp, vp, stride, rq, c4, kA, vA);
  int jB = nextv(jA + 1, kp, vp, stride);
  if (jB < ntiles) attn_load(kp, vp, stride, rq, c4, kB, vB);
  __syncthreads();
#pragma unroll 1
  for (;;) {
    if (jA >= ntiles) break;
    attn_stage(sK0, sVT0, rq, c4, kA, vA);
    {
      const int jc = jA;
      jA = nextv(jB + 1, kp, vp, stride);
      if (jA < ntiles) attn_load(kp, vp, stride, rq, c4, kA, vA);
      __syncthreads();
      compute(jc, sK0, sVT0);
    }
    if (jB >= ntiles) break;
    attn_stage(sK1, sVT1, rq, c4, kB, vB);
    {
      const int jc = jB;
      jB = nextv(jA + 1, kp, vp, stride);
      if (jB < ntiles) attn_load(kp, vp, stride, rq, c4, kB, vB);
      __syncthreads();
      compute(jc, sK1, sVT1);
    }
  }
  const float l = lsum + __shfl_xor(lsum, 32);
  const float inv = 1.f / l;
#pragma unroll
  for (int d = 0; d < 2; ++d)
#pragma unroll
    for (int g = 0; g < 4; ++g) {
      uint2 pk = {pack2(O[d][4 * g + 0] * inv, O[d][4 * g + 1] * inv), pack2(O[d][4 * g + 2] * inv, O[d][4 * g + 3] * inv)};
      *(uint2*)(obase + (size_t)ql * DM + d * 32 + 8 * g + 4 * h) = pk;
    }
}

DI void phase0(const Params& p, char* smem) {
  const int tid = otid();
  if (blockIdx.x == 0) {
    for (int idx = tid; idx < 1024; idx += 256) {
      const int pos = idx >> 4, j = idx & 15;
      const double inv = 1.0 / pow(10000.0, (double)j / 16.0);
      const float ang = (float)((double)pos * inv);
      p.ROPE[idx] = cosf(ang);
      p.ROPE[1024 + idx] = sinf(ang);
    }
  }
  float* scond = (float*)smem;
  for (int item = blockIdx.x; item < 768; item += gridDim.x) {
    const int l = item / 384, ks = (item / 24) % 16, jb = item % 24;
    __syncthreads();
    for (int idx = tid; idx < 320; idx += 256) {
      const int c = idx / 64, k = ks * 64 + (idx & 63);
      const float v = (c == 0) ? p.c_ctx[k] : p.c[(c - 1) * DM + k];
      scond[idx] = silu(v);
    }
    __syncthreads();
    const int j = jb * 256 + tid;
    const float* wp = p.w_ada + ((size_t)l * DM + ks * 64) * 6144 + j;
    float a[5] = {0.f, 0.f, 0.f, 0.f, 0.f};
#pragma unroll 8
    for (int k = 0; k < 64; ++k) {
      const float wv = wp[(size_t)k * 6144];
#pragma unroll
      for (int c = 0; c < 5; ++c) a[c] += scond[c * 64 + k] * wv;
    }
    const float bias = (ks == 0) ? p.b_ada[l * 6144 + j] : 0.f;
#pragma unroll
    for (int c = 0; c < 5; ++c) unsafeAtomicAdd(&p.MOD[(l * 5 + c) * 6144 + j], a[c] + bias);
  }
}

DI int cond_of(int T) { return T < NCTX ? 0 : 1 + ((T - NCTX) >> 11); }

DI void cvt_f32_bf16(const float* s, u16* d, int n4, int gtid, int gsz) {
  for (int i = gtid; i < n4; i += gsz) {
    const float4 x = *(const float4*)(s + (size_t)i * 4);
    uint2 pk = {pack2(x.x, x.y), pack2(x.z, x.w)};
    *(uint2*)(d + (size_t)i * 4) = pk;
  }
}
DI void phase0b(const Params& p) {
  const int tid = otid(), lane = tid & 63, w = tid >> 6;
  {
    const int gtid = blockIdx.x * 256 + tid, gsz = gridDim.x * 256;
    cvt_f32_bf16(p.cak, p.CAK, 4 * 2 * 512 * 128 / 4, gtid, gsz);
    cvt_f32_bf16(p.cav, p.CAV, 4 * 2 * 512 * 128 / 4, gtid, gsz);
    cvt_f32_bf16(p.cbk, p.CBK, 4 * 2 * 512 * 256 / 4, gtid, gsz);
    cvt_f32_bf16(p.cbv, p.CBV, 4 * 2 * 512 * 256 / 4, gtid, gsz);
  }
  for (int T = blockIdx.x * 4 + w; T < NTOK; T += gridDim.x * 4) {
    const float* mod = p.MOD + (size_t)cond_of(T) * 6144;
    const float* xr = (T < NCTX) ? (p.x_prompt + (size_t)T * DM) : (p.x_sample + (size_t)(T - NCTX) * DM);
#pragma unroll
    for (int i = 0; i < 4; ++i) {
      const int k = 256 * i + 4 * lane;
      const float4 x = *(const float4*)(xr + k);
      const float4 sc = *(const float4*)(mod + 1024 + k), sh = *(const float4*)(mod + k);
      uint2 pk = {pack2(x.x * (1.f + sc.x) + sh.x, x.y * (1.f + sc.y) + sh.y), pack2(x.z * (1.f + sc.z) + sh.z, x.w * (1.f + sc.w) + sh.w)};
      *(uint2*)(p.H2 + (size_t)T * DM + k) = pk;
    }
  }
}

DI void phase1(const Params& p, char* smem, int l) {
  const float* W = p.w_in + (size_t)l * DM * DIN;
  const int xcd = blockIdx.x & 7, nloc = gridDim.x >> 3;
  float* sR = (float*)(smem + 61440);
  for (int idx = otid(); idx < 2048; idx += 256) sR[idx] = p.ROPE[idx];
  auto setup = [&](int s, int ar0, int ac, int n4, int kq, const u16*& ab, unsigned& o0, unsigned& o1, unsigned& o2, unsigned& o3, const float*& bb, unsigned& bo) {
    const int tm = 6 * xcd + s % 6, tn = s / 6;
    ab = p.H2 + (size_t)tm * 256 * DM;
    o0 = (unsigned)(ar0 * DM + ac); o1 = o0 + 64u * DM; o2 = o0 + 128u * DM; o3 = o0 + 192u * DM;
    bb = W + tn * 128;
    bo = (unsigned)(4 * n4 + kq * 4 * DIN);
  };
  auto epi = [&](int s, f32x16(&acc)[2][4], int w, int r, int h) {
    int hq = h;
    asm volatile("" : "+v"(hq));
    const int tm = 6 * xcd + s % 6, tn = s / 6;
    const int m0 = tm * 256, n0 = tn * 128;
    const bool lat = m0 >= NCTX;
    const bool rope = lat && (n0 < 640);
    const int n = n0 + 4 * r;
    const int q = (r >> 2) & 3;
#pragma unroll
    for (int mt = 0; mt < 2; ++mt)
#pragma unroll
    for (int i = 0; i < 16; ++i) {
      const int T = m0 + w * 64 + mt * 32 + crow(i, hq);
      float v0 = acc[mt][0][i], v1 = acc[mt][1][i], v2 = acc[mt][2][i], v3 = acc[mt][3][i];
      if (rope) {
        const int t = (T - NCTX) & 2047;
        const int pos = (q < 2) ? (t >> 6) : (t & 63);
        const int jf = 4 * (r & 3);
        const float4 cs = *(const float4*)(sR + pos * 16 + jf), sn = *(const float4*)(sR + 1024 + pos * 16 + jf);
        const float o0 = __shfl_xor(v0, 4), o1 = __shfl_xor(v1, 4), o2 = __shfl_xor(v2, 4), o3 = __shfl_xor(v3, 4);
        if (q & 1) { v0 = o0 * sn.x + v0 * cs.x; v1 = o1 * sn.y + v1 * cs.y; v2 = o2 * sn.z + v2 * cs.z; v3 = o3 * sn.w + v3 * cs.w; }
        else { v0 = v0 * cs.x - o0 * sn.x; v1 = v1 * cs.y - o1 * sn.y; v2 = v2 * cs.z - o2 * sn.z; v3 = v3 * cs.w - o3 * sn.w; }
      }
      uint2 pk = {pack2(v0, v1), pack2(v2, v3)};
      *(uint2*)(p.QKV + (size_t)T * DIN + n) = pk;
      if (!lat) {
        const int b = T >> 8, t = T & 255;
        const float4 vv = {v0, v1, v2, v3};
        if (n0 == 512) *(float4*)(p.out + OFF_AK + ((size_t)(b * 2 + l) * 256 + t) * 128 + (n - 512)) = vv;
        else if (n0 == 640) *(float4*)(p.out + OFF_AV + ((size_t)(b * 2 + l) * 256 + t) * 128 + (n - 640)) = vv;
        else if (n0 == 1024 || n0 == 1152) *(float4*)(p.out + OFF_BK + ((size_t)(b * 2 + l) * 256 + t) * 256 + (n - 1024)) = vv;
        else if (n0 == 1280 || n0 == 1408) *(float4*)(p.out + OFF_BV + ((size_t)(b * 2 + l) * 256 + t) * 256 + (n - 1280)) = vv;
      }
      if ((i & 3) == 3) __builtin_amdgcn_sched_barrier(0);
    }
  };
  gemm_phase<true>(smem, blockIdx.x >> 3, 120, nloc, setup, DIN, epi, [](int, int) {});
}

DI float ret_lg(const Params& p, int l, int dir, int head) { return -__expf(p.decay[(l * 2 + dir) * 4 + head]); }

DI size_t kvs_slot(int req, int head, int dir, int c) { return ((size_t)((req * 4 + head) * 2 + dir) * 16 + c) * 4096; }

DI void retkv_item(const Params& p, char* smem, int l, int req, int head, int c) {
  u16* sKTf = (u16*)smem;
  u16* sKTb = sKTf + 64 * LDT2;
  u16* sVT = sKTb + 64 * LDT2;
  const int tid = otid(), lane = tid & 63, w = tid >> 6, r = lane & 31, h = lane >> 5;
  const int rq = tid >> 4, c4 = tid & 15;
  const int T0 = (req < 16 ? req * 256 : NCTX + (req - 16) * 2048) + c * 128;
  const float lgf = ret_lg(p, l, 0, head), lgb = ret_lg(p, l, 1, head);
  const float one4[4] = {1.f, 1.f, 1.f, 1.f};
  __syncthreads();
#pragma unroll
  for (int half = 0; half < 2; ++half) {
    float v[4][4];
    float sf[4], sb[4];
#pragma unroll
    for (int i = 0; i < 4; ++i) {
      const int j = half * 64 + 4 * rq + i;
      sf[i] = 0.125f * __expf(lgf * (float)(127 - j));
      sb[i] = 0.125f * __expf(lgb * (float)j);
    }
    load4x4(p.QKV + (size_t)(T0 + half * 64) * DIN + 1792 + head * 64, DIN, false, rq, c4, v);
    store_t(sKTf, LDT2, half * 64, rq, c4, v, sf);
    store_t(sKTb, LDT2, half * 64, rq, c4, v, sb);
    load4x4(p.QKV + (size_t)(T0 + half * 64) * DIN + 2048 + head * 64, DIN, false, rq, c4, v);
    store_t(sVT, LDT2, half * 64, rq, c4, v, one4);
  }
  __syncthreads();
  const int dir = w >> 1, mt = w & 1;
  const u16* sKT = dir ? sKTb : sKTf;
  f32x16 acc[2];
#pragma unroll
  for (int nt = 0; nt < 2; ++nt)
#pragma unroll
    for (int i = 0; i < 16; ++i) acc[nt][i] = 0.f;
#pragma unroll
  for (int ks = 0; ks < 8; ++ks) {
    const bf16x8 fa = *(const bf16x8*)&sKT[(mt * 32 + r) * LDT2 + ks * 16 + 8 * h];
#pragma unroll
    for (int nt = 0; nt < 2; ++nt) {
      const bf16x8 fb = *(const bf16x8*)&sVT[(nt * 32 + r) * LDT2 + ks * 16 + 8 * h];
      acc[nt] = MFMA(fa, fb, acc[nt]);
    }
  }
  float* dst = p.KVS + kvs_slot(req, head, dir, c);
#pragma unroll
  for (int nt = 0; nt < 2; ++nt)
#pragma unroll
    for (int i = 0; i < 16; ++i) dst[(mt * 32 + crow(i, h)) * 64 + nt * 32 + r] = acc[nt][i];
}

DI void phase2(const Params& p, char* smem, int l) {
  const int tid = otid();
  for (int item = blockIdx.x; item < 1536; item += gridDim.x) {
    if (item < 512) {
      const int b = item >> 7, head = (item >> 4) & 7, qb = item & 15, kvh = head >> 2;
      const int T0 = NCTX + b * 2048 + qb * 128;
      const u16* ck = p.CAK + ((size_t)(b * 2 + l) * 512) * 128 + kvh * 64;
      const u16* cv = p.CAV + ((size_t)(b * 2 + l) * 512) * 128 + kvh * 64;
      auto src = [&](int j, const u16*& kp, const u16*& vp, int& stride) -> bool {
        if (j < 8) {
          kp = ck + (size_t)j * 64 * 128; vp = cv + (size_t)j * 64 * 128; stride = 128;
          return true;
        }
        const int jj = j - 8, kb = qb - 1 + (jj >> 1);
        if (kb < 0 || kb >= 16) return false;
        const int Tk = NCTX + b * 2048 + kb * 128 + (jj & 1) * 64;
        kp = p.QKV + (size_t)Tk * DIN + 512 + kvh * 64; vp = p.QKV + (size_t)Tk * DIN + 640 + kvh * 64; stride = DIN;
        return true;
      };
      auto biasf = [&](int j, int key, int ql) -> float {
        if (j < 8) return 0.f;
        const int jj = j - 8;
        const int kj = (qb - 1 + (jj >> 1)) * 128 + (jj & 1) * 64 + key;
        const int qi = qb * 128 + ql;
        const int d = qi - kj;
        return (d <= 128 && d >= -128) ? 0.f : NEG;
      };
      auto tmode = [&](int j, int w) -> int {
        if (j < 8) return 0;
        const int jj = j - 8;
        const int k0 = (qb - 1 + (jj >> 1)) * 128 + (jj & 1) * 64, q0w = qb * 128 + w * 32;
        if (k0 - (q0w + 31) > 128 || q0w - (k0 + 63) > 128) return 2;
        if ((q0w + 31) - k0 <= 128 && (k0 + 63) - q0w <= 128) return 0;
        return 1;
      };
      attn_core(smem, p.QKV + (size_t)T0 * DIN + head * 64, 14, src, biasf, tmode, p.sink[l * 8 + head] * 1.44269504f, true,
                p.CAT + (size_t)T0 * DM + head * 64);
    } else if (item < 768) {
      const int it = item - 512;
      const int b = it >> 6, head = (it >> 4) & 3, qb = it & 15;
      const int T0 = NCTX + b * 2048 + qb * 128;
      float* srpb = (float*)(smem + 4 * 64 * LDT * 2);
      __syncthreads();
      for (int idx = tid; idx < 465; idx += 256) srpb[idx] = p.rpb[(size_t)(l * 4 + head) * 465 + idx] * 1.44269504f;
      const int r0 = 2 * qb;
      const int rmin = min(max(r0 - 4, 0), 24), rmax = min(max(r0 + 1 - 4, 0), 24) + 7;
      const u16* ck = p.CBK + ((size_t)(b * 2 + l) * 512) * 256 + head * 64;
      const u16* cv = p.CBV + ((size_t)(b * 2 + l) * 512) * 256 + head * 64;
      auto src = [&](int j, const u16*& kp, const u16*& vp, int& stride) -> bool {
        if (j < 8) {
          kp = ck + (size_t)j * 64 * 256; vp = cv + (size_t)j * 64 * 256; stride = 256;
          return true;
        }
        const int Tk = NCTX + b * 2048 + (rmin + j - 8) * 64;
        kp = p.QKV + (size_t)Tk * DIN + 1024 + head * 64; vp = p.QKV + (size_t)Tk * DIN + 1280 + head * 64; stride = DIN;
        return true;
      };
      auto biasf = [&](int j, int key, int ql) -> float {
        if (j < 8) return 0.f;
        const int kr = rmin + j - 8, kc = key;
        const int qr = r0 + (ql >> 6), qc = ql & 63;
        const int rs = min(max(qr - 4, 0), 24), cs = min(max(qc - 8, 0), 48);
        const bool ok = (kr >= rs) && (kr < rs + 8) && (kc >= cs) && (kc < cs + 16);
        const int bi = ok ? ((kr - qr + 7) * 31 + (kc - qc + 15)) : 0;
        const float bv = srpb[bi];
        return ok ? bv : NEG;
      };
      auto tmode = [&](int j, int w) -> int {
        if (j < 8) return 0;
        const int kr = rmin + j - 8, qr = r0 + (w >> 1);
        const int rs = min(max(qr - 4, 0), 24);
        return (kr >= rs && kr < rs + 8) ? 1 : 2;
      };
      attn_core(smem, p.QKV + (size_t)T0 * DIN + 768 + head * 64, 8 + (rmax - rmin + 1), src, biasf, tmode, NEG, false,
                p.CAT + (size_t)T0 * DM + 512 + head * 64);
    } else if (item < 1152) {
      const int it = item - 768;
      if (it < 256) retkv_item(p, smem, l, 16 + (it >> 6), (it >> 4) & 3, it & 15);
      else { const int i2 = it - 256; retkv_item(p, smem, l, i2 >> 3, (i2 >> 1) & 3, i2 & 1); }
    } else if (item < 1408) {
      const int it = item - 1152;
      const int b = it >> 4, head = (it >> 1) & 7, qh = it & 1, kvh = head >> 2;
      const int T0 = b * 256 + qh * 128;
      auto src = [&](int j, const u16*& kp, const u16*& vp, int& stride) -> bool {
        const int Tk = b * 256 + j * 64;
        kp = p.QKV + (size_t)Tk * DIN + 512 + kvh * 64; vp = p.QKV + (size_t)Tk * DIN + 640 + kvh * 64; stride = DIN;
        return true;
      };
      auto biasf = [&](int, int, int) -> float { return 0.f; };
      auto tmode = [&](int, int) -> int { return 0; };
      attn_core(smem, p.QKV + (size_t)T0 * DIN + head * 64, 4, src, biasf, tmode, p.sink[l * 8 + head] * 1.44269504f, true,
                p.CAT + (size_t)T0 * DM + head * 64);
    } else {
      const int it = item - 1408;
      const int b = it >> 3, head = (it >> 1) & 3, qh = it & 1;
      const int T0 = b * 256 + qh * 128;
      auto src = [&](int j, const u16*& kp, const u16*& vp, int& stride) -> bool {
        const int Tk = b * 256 + j * 64;
        kp = p.QKV + (size_t)Tk * DIN + 1024 + head * 64; vp = p.QKV + (size_t)Tk * DIN + 1280 + head * 64; stride = DIN;
        return true;
      };
      auto biasf = [&](int, int, int) -> float { return 0.f; };
      auto tmode = [&](int, int) -> int { return 0; };
      attn_core(smem, p.QKV + (size_t)T0 * DIN + 768 + head * 64, 4, src, biasf, tmode, NEG, false,
                p.CAT + (size_t)T0 * DM + 512 + head * 64);
    }
  }
}

DI void phase2c(const Params& p, char* smem, int l) {
  u16* sK = (u16*)smem;
  u16* sVT = sK + 128 * LDT;
  u16* sSTf = sVT + 64 * LDT2;
  u16* sSTb = sSTf + 64 * LDT;
  const int tid = otid(), lane = tid & 63, w = tid >> 6, r = lane & 31, h = lane >> 5;
  const int rq = tid >> 4, c4 = tid & 15;
  const float one4[4] = {1.f, 1.f, 1.f, 1.f};
  for (int item = blockIdx.x; item < 384; item += gridDim.x) {
    int req, head, c, nc;
    if (item < 256) { req = 16 + (item >> 6); head = (item >> 4) & 3; c = item & 15; nc = 16; }
    else { const int i2 = item - 256; req = i2 >> 3; head = (i2 >> 1) & 3; c = i2 & 1; nc = 2; }
    const bool lat = req >= 16;
    const int T0 = (lat ? NCTX + (req - 16) * 2048 : req * 256) + c * 128;
    const float lgf = ret_lg(p, l, 0, head), lgb = ret_lg(p, l, 1, head);
    const float gf = __expf(lgf * 128.f), gb = __expf(lgb * 128.f);
    __syncthreads();
    {
      const int d = tid >> 2, e0 = (tid & 3) * 16;
#pragma unroll
      for (int dir = 0; dir < 2; ++dir) {
        float s[16];
#pragma unroll
        for (int q = 0; q < 16; ++q) s[q] = 0.f;
        const float g = dir ? gb : gf;
        if (lat) {
          const float* s0 = p.state + ((size_t)(((req - 16) * 2 + l) * 2 + dir) * 4 + head) * 4096 + d * 64 + e0;
#pragma unroll
          for (int q = 0; q < 16; q += 4) {
            const float4 x = *(const float4*)(s0 + q);
            s[q] = x.x; s[q + 1] = x.y; s[q + 2] = x.z; s[q + 3] = x.w;
          }
        }
        const int nsteps = dir ? (nc - 1 - c) : c;
        for (int st = 0; st < nsteps; ++st) {
          const int cc = dir ? (nc - 1 - st) : st;
          const float* kv = p.KVS + kvs_slot(req, head, dir, cc) + d * 64 + e0;
#pragma unroll
          for (int q = 0; q < 16; q += 4) {
            const float4 x = *(const float4*)(kv + q);
            s[q] = s[q] * g + x.x; s[q + 1] = s[q + 1] * g + x.y; s[q + 2] = s[q + 2] * g + x.z; s[q + 3] = s[q + 3] * g + x.w;
          }
        }
        u16* sST = dir ? sSTb : sSTf;
#pragma unroll
        for (int q = 0; q < 16; ++q) sST[(e0 + q) * LDT + d] = (u16)(pack2(s[q], 0.f) & 0xffffu);
        if (!lat && c == 0) {
          const float* k0 = p.KVS + kvs_slot(req, head, dir, 0) + d * 64 + e0;
          const float* k1 = p.KVS + kvs_slot(req, head, dir, 1) + d * 64 + e0;
          float* o = p.out + OFF_ST + ((size_t)((req * 2 + l) * 2 + dir) * 4 + head) * 4096 + d * 64 + e0;
#pragma unroll
          for (int q = 0; q < 16; ++q) o[q] = dir ? (gb * k1[q] + k0[q]) : (gf * k0[q] + k1[q]);
        }
      }
    }
#pragma unroll
    for (int half = 0; half < 2; ++half) {
      float v[4][4];
      load4x4(p.QKV + (size_t)(T0 + half * 64) * DIN + 1792 + head * 64, DIN, false, rq, c4, v);
      store_n(sK, LDT, half * 64, rq, c4, v);
      load4x4(p.QKV + (size_t)(T0 + half * 64) * DIN + 2048 + head * 64, DIN, false, rq, c4, v);
      store_t(sVT, LDT2, half * 64, rq, c4, v, one4);
    }
    __syncthreads();
    const int qi = w * 32 + r;
    const u16* qrow = p.QKV + (size_t)(T0 + qi) * DIN + 1536 + head * 64;
    uint4 qraw[4];
#pragma unroll
    for (int ks = 0; ks < 4; ++ks) qraw[ks] = *(const uint4*)(qrow + ks * 16 + 8 * h);
    f32x16 O[2];
#pragma unroll
    for (int d = 0; d < 2; ++d)
#pragma unroll
      for (int i = 0; i < 16; ++i) O[d][i] = 0.f;
#pragma unroll 1
    for (int jt = 0; jt < 4; ++jt) {
      f32x16 S;
#pragma unroll
      for (int i = 0; i < 16; ++i) S[i] = 0.f;
#pragma unroll
      for (int ks = 0; ks < 4; ++ks) {
        const bf16x8 kf = *(const bf16x8*)&sK[(jt * 32 + r) * LDT + ks * 16 + 8 * h];
        S = MFMA(kf, __builtin_bit_cast(bf16x8, qraw[ks]), S);
      }
#pragma unroll
      for (int i = 0; i < 16; ++i) {
        const int j = jt * 32 + crow(i, h);
        const int dlt = qi - j;
        const float wgt = (dlt > 0) ? __expf(lgf * (float)dlt) : ((dlt < 0) ? __expf(lgb * (float)(-dlt)) : 2.f);
        S[i] = S[i] * 0.125f * wgt;
      }
#pragma unroll
      for (int s = 0; s < 2; ++s) {
        const bf16x8 pf = mk8(pack2(S[8 * s + 0], S[8 * s + 1]), pack2(S[8 * s + 2], S[8 * s + 3]),
                              pack2(S[8 * s + 4], S[8 * s + 5]), pack2(S[8 * s + 6], S[8 * s + 7]));
#pragma unroll
        for (int d = 0; d < 2; ++d) {
          const u16* vrow = &sVT[(d * 32 + r) * LDT2 + jt * 32 + 16 * s + 4 * h];
          const uint2 lo = *(const uint2*)vrow;
          const uint2 hi = *(const uint2*)(vrow + 8);
          O[d] = MFMA(mk8(lo.x, lo.y, hi.x, hi.y), pf, O[d]);
        }
      }
    }
    {
      const float xf = __expf(lgf * (float)(qi + 1)), xb = __expf(lgb * (float)(128 - qi));
#pragma unroll
      for (int ks = 0; ks < 4; ++ks) {
        const uint4 q = qraw[ks];
        const bf16x8 qsf = mk8(pack2(bflo(q.x) * xf, bfhi(q.x) * xf), pack2(bflo(q.y) * xf, bfhi(q.y) * xf),
                               pack2(bflo(q.z) * xf, bfhi(q.z) * xf), pack2(bflo(q.w) * xf, bfhi(q.w) * xf));
        const bf16x8 qsb = mk8(pack2(bflo(q.x) * xb, bfhi(q.x) * xb), pack2(bflo(q.y) * xb, bfhi(q.y) * xb),
                               pack2(bflo(q.z) * xb, bfhi(q.z) * xb), pack2(bflo(q.w) * xb, bfhi(q.w) * xb));
#pragma unroll
        for (int d = 0; d < 2; ++d) {
          const bf16x8 sf = *(const bf16x8*)&sSTf[(d * 32 + r) * LDT + ks * 16 + 8 * h];
          const bf16x8 sb = *(const bf16x8*)&sSTb[(d * 32 + r) * LDT + ks * 16 + 8 * h];
          O[d] = MFMA(sf, qsf, O[d]);
          O[d] = MFMA(sb, qsb, O[d]);
        }
      }
    }
    float sum = 0.f;
#pragma unroll
    for (int d = 0; d < 2; ++d)
#pragma unroll
      for (int i = 0; i < 16; ++i) sum += O[d][i];
    sum += __shfl_xor(sum, 32);
    const float mu = sum * (1.f / 64.f);
    float vs = 0.f;
#pragma unroll
    for (int d = 0; d < 2; ++d)
#pragma unroll
      for (int i = 0; i < 16; ++i) { const float t = O[d][i] - mu; vs += t * t; }
    vs += __shfl_xor(vs, 32);
    const float rstd = rsqrtf(vs * (1.f / 64.f) + 1e-6f);
    const u16* grow = p.QKV + (size_t)(T0 + qi) * DIN + 2304 + head * 64;
    const float* gnw = p.gn + l * 256 + head * 64;
    u16* orow = p.CAT + (size_t)(T0 + qi) * DM + 768 + head * 64;
#pragma unroll
    for (int d = 0; d < 2; ++d)
#pragma unroll
      for (int g = 0; g < 4; ++g) {
        const int e = d * 32 + 8 * g + 4 * h;
        const uint2 gr = *(const uint2*)(grow + e);
        const float4 gw = *(const float4*)(gnw + e);
        const float o0 = silu(bflo(gr.x)) * (O[d][4 * g + 0] - mu) * rstd * gw.x;
        const float o1 = silu(bfhi(gr.x)) * (O[d][4 * g + 1] - mu) * rstd * gw.y;
        const float o2 = silu(bflo(gr.y)) * (O[d][4 * g + 2] - mu) * rstd * gw.z;
        const float o3 = silu(bfhi(gr.y)) * (O[d][4 * g + 3] - mu) * rstd * gw.w;
        uint2 pk = {pack2(o0, o1), pack2(o2, o3)};
        *(uint2*)(orow + e) = pk;
      }
  }
}

DI void phase3(const Params& p, char* smem, int l, const float* xc, const float* xl) {
  const float* W = p.w_out + (size_t)l * DM * DM;
  u16* PREB = (u16*)p.PRE;
  const int xcd = blockIdx.x & 7, nloc = gridDim.x >> 3;
  auto setup = [&](int s, int ar0, int ac, int n4, int kq, const u16*& ab, unsigned& o0, unsigned& o1, unsigned& o2, unsigned& o3, const float*& bb, unsigned& bo) {
    const int tm = 6 * xcd + s % 6, tn = s / 6;
    ab = p.CAT + (size_t)tm * 256 * DM;
    o0 = (unsigned)(ar0 * DM + ac); o1 = o0 + 64u * DM; o2 = o0 + 128u * DM; o3 = o0 + 192u * DM;
    bb = W + tn * 128;
    bo = (unsigned)(4 * n4 + kq * 4 * DM);
  };
  auto epi = [&](int s, f32x16(&acc)[2][4], int w, int r, int h) {
    int hq = h;
    asm volatile("" : "+v"(hq));
    const int tm = 6 * xcd + s % 6, tn = s / 6;
    const int m0 = tm * 256, n0 = tn * 128;
    const float* g1 = p.MOD + (size_t)(l * 5 + cond_of(m0)) * 6144 + 2048 + n0 + 4 * r;
    const float g0 = g1[0], g1v = g1[1], g2 = g1[2], g3 = g1[3];
#pragma unroll
    for (int mt = 0; mt < 2; ++mt)
#pragma unroll
    for (int i = 0; i < 16; ++i) {
      const int ml = w * 64 + mt * 32 + crow(i, hq);
      uint2 pk = {pack2(g0 * acc[mt][0][i], g1v * acc[mt][1][i]), pack2(g2 * acc[mt][2][i], g3 * acc[mt][3][i])};
      *(uint2*)(PREB + (size_t)(m0 + ml) * DM + n0 + 4 * r) = pk;
      if ((i & 3) == 3) __builtin_amdgcn_sched_barrier(0);
    }
  };
  gemm_phase<true>(smem, blockIdx.x >> 3, 48, nloc, setup, DM, epi, [](int, int) {});
}

DI void phase4(const Params& p, char* smem, int l, const float* xc, const float* xl) {
  float* swr = (float*)smem;
  const int tid = otid(), lane = tid & 63, w = tid >> 6;
  __syncthreads();
  for (int idx = tid; idx < 4096; idx += 256) {
    const float4 x = *(const float4*)(p.w_router + (size_t)l * DM * 16 + idx * 4);
    const int k = idx >> 2, e = (idx & 3) * 4;
    swr[(e + 0) * DM + k] = x.x; swr[(e + 1) * DM + k] = x.y; swr[(e + 2) * DM + k] = x.z; swr[(e + 3) * DM + k] = x.w;
  }
  __syncthreads();
  const float* lg = p.ln1g + l * DM;
  const float* lb = p.ln1b + l * DM;
  const int rstride = gridDim.x * 4;
  uint2 nprb[4];
  float4 nxi[4];
  {
    const int T0 = blockIdx.x * 4 + w;
    if (T0 < NTOK) {
      const float* xr0 = (T0 < NCTX) ? (xc + (size_t)T0 * DM) : (xl + (size_t)(T0 - NCTX) * DM);
#pragma unroll
      for (int i = 0; i < 4; ++i) {
        nprb[i] = *(const uint2*)((const u16*)p.PRE + (size_t)T0 * DM + 256 * i + 4 * lane);
        nxi[i] = *(const float4*)(xr0 + 256 * i + 4 * lane);
      }
    }
  }
  for (int T = blockIdx.x * 4 + w; T < NTOK; T += rstride) {
    const float* mod = p.MOD + (size_t)(l * 5 + cond_of(T)) * 6144;
    float4 x[4];
    float s = 0.f;
#pragma unroll
    for (int i = 0; i < 4; ++i) {
      const uint2 prb = nprb[i];
      const float4 xi = nxi[i];
      const float4 pr = {bflo(prb.x), bfhi(prb.x), bflo(prb.y), bfhi(prb.y)};
      x[i].x = ALPHA * xi.x + pr.x; x[i].y = ALPHA * xi.y + pr.y; x[i].z = ALPHA * xi.z + pr.z; x[i].w = ALPHA * xi.w + pr.w;
      s += x[i].x + x[i].y + x[i].z + x[i].w;
    }
    {
      const int Tn = T + rstride;
      if (Tn < NTOK) {
        const float* xrn = (Tn < NCTX) ? (xc + (size_t)Tn * DM) : (xl + (size_t)(Tn - NCTX) * DM);
#pragma unroll
        for (int i = 0; i < 4; ++i) {
          nprb[i] = *(const uint2*)((const u16*)p.PRE + (size_t)Tn * DM + 256 * i + 4 * lane);
          nxi[i] = *(const float4*)(xrn + 256 * i + 4 * lane);
        }
      }
    }
    const float mu = wave_sum(s) * (1.f / 1024.f);
    float vs = 0.f;
#pragma unroll
    for (int i = 0; i < 4; ++i) {
      x[i].x -= mu; x[i].y -= mu; x[i].z -= mu; x[i].w -= mu;
      vs += x[i].x * x[i].x + x[i].y * x[i].y + x[i].z * x[i].z + x[i].w * x[i].w;
    }
    const float rstd = rsqrtf(wave_sum(vs) * (1.f / 1024.f) + 1e-6f);
#pragma unroll
    for (int i = 0; i < 4; ++i) {
      const int k = 256 * i + 4 * lane;
      const float4 g = *(const float4*)(lg + k), bb = *(const float4*)(lb + k);
      float4 y;
      y.x = x[i].x * rstd * g.x + bb.x; y.y = x[i].y * rstd * g.y + bb.y; y.z = x[i].z * rstd * g.z + bb.z; y.w = x[i].w * rstd * g.w + bb.w;
      *(float4*)(p.X + (size_t)T * DM + k) = y;
      const float4 sc = *(const float4*)(mod + 4096 + k), sh = *(const float4*)(mod + 3072 + k);
      float4 hh;
      hh.x = y.x * (1.f + sc.x) + sh.x; hh.y = y.y * (1.f + sc.y) + sh.y; hh.z = y.z * (1.f + sc.z) + sh.z; hh.w = y.w * (1.f + sc.w) + sh.w;
      uint2 pk = {pack2(hh.x, hh.y), pack2(hh.z, hh.w)};
      *(uint2*)(p.H2 + (size_t)T * DM + k) = pk;
      x[i] = hh;
    }
    float a16[16];
#pragma unroll
    for (int e = 0; e < 16; ++e) {
      float a = 0.f;
#pragma unroll
      for (int i = 0; i < 4; ++i) {
        const float4 wv = *(const float4*)(swr + e * DM + 256 * i + 4 * lane);
        a += x[i].x * wv.x + x[i].y * wv.y + x[i].z * wv.z + x[i].w * wv.w;
      }
      a16[e] = a;
      if ((e & 3) == 3) __builtin_amdgcn_sched_barrier(0);
    }
    float a8[8], a4[4], a2[2], a1;
    {
      const bool hi = (lane & 32) != 0;
#pragma unroll
      for (int j = 0; j < 8; ++j) {
        const float snd = hi ? a16[j] : a16[8 + j];
        const float kp = hi ? a16[8 + j] : a16[j];
        a8[j] = kp + __shfl_xor(snd, 32);
      }
    }
    {
      const bool hi = (lane & 16) != 0;
#pragma unroll
      for (int j = 0; j < 4; ++j) {
        const float snd = hi ? a8[j] : a8[4 + j];
        const float kp = hi ? a8[4 + j] : a8[j];
        a4[j] = kp + __shfl_xor(snd, 16);
      }
    }
    {
      const bool hi = (lane & 8) != 0;
#pragma unroll
      for (int j = 0; j < 2; ++j) {
        const float snd = hi ? a4[j] : a4[2 + j];
        const float kp = hi ? a4[2 + j] : a4[j];
        a2[j] = kp + __shfl_xor(snd, 8);
      }
    }
    {
      const bool hi = (lane & 4) != 0;
      const float snd = hi ? a2[0] : a2[1];
      const float kp = hi ? a2[1] : a2[0];
      a1 = kp + __shfl_xor(snd, 4);
    }
    a1 += __shfl_xor(a1, 2);
    a1 += __shfl_xor(a1, 1);
    const int myexp = ((lane >> 5) & 1) * 8 + ((lane >> 4) & 1) * 4 + ((lane >> 3) & 1) * 2 + ((lane >> 2) & 1);
    float mx = a1;
#pragma unroll
    for (int o = 32; o >= 4; o >>= 1) mx = fmaxf(mx, __shfl_xor(mx, o));
    const float ex = __expf(a1 - mx);
    float den = ex;
#pragma unroll
    for (int o = 32; o >= 4; o >>= 1) den += __shfl_xor(den, o);
    if ((lane & 3) == 0) { p.AFF[(size_t)T * 16 + myexp] = ex / den; p.INV[(size_t)T * 16 + myexp] = -1; }
  }
}

DI unsigned block_incl_scan(unsigned v, unsigned* wsum, int lane, int w, unsigned& total) {
#pragma unroll
  for (int o = 1; o < 64; o <<= 1) {
    const unsigned t = __shfl_up(v, o);
    if (lane >= o) v += t;
  }
  __syncthreads();
  if (lane == 63) wsum[w] = v;
  __syncthreads();
  unsigned off = 0;
  total = 0;
#pragma unroll
  for (int i = 0; i < 4; ++i) {
    const unsigned s = wsum[i];
    if (i < w) off += s;
    total += s;
  }
  return v + off;
}

DI void phase5(const Params& p, char* smem) {
  unsigned* hist = (unsigned*)smem;
  unsigned* wsum = hist + 256;
  unsigned* bc = wsum + 4;
  const int tid = otid(), lane = tid & 63, w = tid >> 6;
  for (int item = blockIdx.x; item < 320; item += gridDim.x) {
    int n, base, e, cap, rowbase;
    if (item < 64) {
      const int b = item >> 4; e = item & 15;
      n = 2048; base = NCTX + b * 2048; cap = 256; rowbase = 512 + b * 256;
    } else {
      const int it = item - 64; const int rq = it >> 4; e = it & 15;
      n = 256; base = rq * 256; cap = 32; rowbase = rq * 32;
    }
    const int per = n >> 8;
    unsigned key[8];
#pragma unroll
    for (int q = 0; q < 8; ++q) key[q] = (q < per) ? __float_as_uint(p.AFF[(size_t)(base + tid * per + q) * 16 + e]) : 0u;
    unsigned prefix = 0u, mask = 0u;
    unsigned remaining = (unsigned)cap;
#pragma unroll 1
    for (int pass = 3; pass >= 0; --pass) {
      const int shift = pass * 8;
      __syncthreads();
      hist[tid] = 0u;
      __syncthreads();
#pragma unroll
      for (int q = 0; q < 8; ++q)
        if (q < per && (key[q] & mask) == prefix) atomicAdd(&hist[(key[q] >> shift) & 255u], 1u);
      __syncthreads();
      const unsigned hv = hist[tid];
      unsigned total;
      const unsigned incl = block_incl_scan(hv, wsum, lane, w, total);
      const unsigned above = total - incl;
      if (above < remaining && remaining <= above + hv) { bc[0] = (unsigned)tid; bc[1] = remaining - above; }
      __syncthreads();
      const unsigned bsel = bc[0];
      remaining = bc[1];
      prefix |= bsel << shift;
      mask |= 0xFFu << shift;
    }
    const unsigned thr = prefix;
    unsigned ceq = 0u;
#pragma unroll
    for (int q = 0; q < 8; ++q) ceq += (q < per && key[q] == thr) ? 1u : 0u;
    unsigned tot;
    unsigned eq_before = block_incl_scan(ceq, wsum, lane, w, tot) - ceq;
    unsigned selmask = 0u, nsel = 0u;
#pragma unroll
    for (int q = 0; q < 8; ++q) {
      if (q < per) {
        const bool eq = key[q] == thr;
        const bool sel = (key[q] > thr) || (eq && eq_before < remaining);
        eq_before += eq ? 1u : 0u;
        selmask |= sel ? (1u << q) : 0u;
        nsel += sel ? 1u : 0u;
      }
    }
    unsigned row = block_incl_scan(nsel, wsum, lane, w, tot) - nsel;
#pragma unroll
    for (int q = 0; q < 8; ++q) {
      if (q < per && ((selmask >> q) & 1u)) {
        const int tok = base + tid * per + q;
        const int rr = e * NROWS_E + rowbase + (int)row;
        p.SELTOK[rr] = tok;
        p.SELGATE[rr] = __uint_as_float(key[q]);
        p.INV[(size_t)tok * 16 + e] = rr;
        ++row;
      }
    }
  }
}

DI void phase6(const Params& p, char* smem, int l) {
  const int xcd = blockIdx.x & 7, nloc = gridDim.x >> 3;
  auto setup = [&](int s, int ar0, int ac, int n4, int kq, const u16*& ab, unsigned& o0, unsigned& o1, unsigned& o2, unsigned& o3, const float*& bb, unsigned& bo) {
    const int e = 2 * xcd + s / 96, rem = s % 96, tn = rem / 6, tm = rem % 6;
    const int* tok = p.SELTOK + e * NROWS_E + tm * 256 + ar0;
    ab = p.H2;
    o0 = (unsigned)(tok[0] * DM + ac); o1 = (unsigned)(tok[64] * DM + ac);
    o2 = (unsigned)(tok[128] * DM + ac); o3 = (unsigned)(tok[192] * DM + ac);
    bb = p.w_gu + ((size_t)l * 16 + e) * DM * 2048 + tn * 64;
    bo = (unsigned)(((n4 >> 4) & 1) * 1024 + 4 * (n4 & 15) + kq * 4 * 2048);
  };
  auto epi = [&](int s, f32x16(&acc)[2][4], int w, int r, int h) {
    int hq = h;
    asm volatile("" : "+v"(hq));
    const int e = 2 * xcd + s / 96, rem = s % 96, tn = rem / 6, tm = rem % 6;
    const int m0 = tm * 256, f0 = tn * 64;
    u16* act = p.ACT + ((size_t)e * NROWS_E + m0) * DM;
#pragma unroll
    for (int mt = 0; mt < 2; ++mt)
#pragma unroll
    for (int i = 0; i < 16; ++i) {
      const int ml = w * 64 + mt * 32 + crow(i, hq);
      const float a0 = acc[mt][0][i], a1 = acc[mt][1][i], a2 = acc[mt][2][i], a3 = acc[mt][3][i];
      const bool lo = r < 16;
      const float s0 = lo ? a2 : a0, s1 = lo ? a3 : a1;
      const float r0 = __shfl_xor(s0, 16), r1 = __shfl_xor(s1, 16);
      const float g0 = lo ? a0 : r0, g1 = lo ? a1 : r1;
      const float v0 = lo ? r0 : a2, v1 = lo ? r1 : a3;
      *(unsigned*)(act + (size_t)ml * DM + f0 + 4 * (r & 15) + (lo ? 0 : 2)) = pack2(silu(g0) * v0, silu(g1) * v1);
      if ((i & 3) == 3) __builtin_amdgcn_sched_barrier(0);
    }
  };
  gemm_phase<false>(smem, blockIdx.x >> 3, 192, nloc, setup, 2048, epi, [](int, int) {});
}

DI void phase7(const Params& p, char* smem, int l, u16* FF) {
  const int xcd = blockIdx.x & 7, nloc = gridDim.x >> 3;
  auto setup = [&](int s, int ar0, int ac, int n4, int kq, const u16*& ab, unsigned& o0, unsigned& o1, unsigned& o2, unsigned& o3, const float*& bb, unsigned& bo) {
    const int e = 2 * xcd + s / 48, rem = s % 48, tn = rem / 6, tm = rem % 6;
    ab = p.ACT + ((size_t)e * NROWS_E + tm * 256) * DM;
    o0 = (unsigned)(ar0 * DM + ac); o1 = o0 + 64u * DM; o2 = o0 + 128u * DM; o3 = o0 + 192u * DM;
    bb = p.w_down + ((size_t)l * 16 + e) * DM * DM + tn * 128;
    bo = (unsigned)(4 * n4 + kq * 4 * DM);
  };
  float* sG = (float*)(smem + 61440);
  int par = 1;
  auto pre = [&](int s, int tid) {
    par ^= 1;
    const int e = 2 * xcd + s / 48, rem = s % 48, tm = rem % 6;
    sG[par * 256 + tid] = p.SELGATE[e * NROWS_E + tm * 256 + tid];
  };
  auto epi = [&](int s, f32x16(&acc)[2][4], int w, int r, int h) {
    int hq = h;
    asm volatile("" : "+v"(hq));
    const int e = 2 * xcd + s / 48, rem = s % 48, tn = rem / 6, tm = rem % 6;
    const int m0 = tm * 256, n0 = tn * 128;
#pragma unroll
    for (int mt = 0; mt < 2; ++mt)
#pragma unroll
    for (int i = 0; i < 16; ++i) {
      const int ml = w * 64 + mt * 32 + crow(i, hq);
      const float g = sG[par * 256 + ml];
      uint2 pk = {pack2(g * acc[mt][0][i], g * acc[mt][1][i]), pack2(g * acc[mt][2][i], g * acc[mt][3][i])};
      *(uint2*)(FF + ((size_t)e * NROWS_E + m0 + ml) * DM + n0 + 4 * r) = pk;
      if ((i & 3) == 3) __builtin_amdgcn_sched_barrier(0);
    }
  };
  gemm_phase<true>(smem, blockIdx.x >> 3, 96, nloc, setup, DM, epi, pre);
}

DI void phase8(const Params& p, int l, float* dst, bool write_h) {
  const int tid = otid(), lane = tid & 63, w = tid >> 6;
  const float* lg = p.ln2g + l * DM;
  const float* lb = p.ln2b + l * DM;
  const int rstride = gridDim.x * 4;
  float4 nxa[4];
  int ninv = -1;
  {
    const int T0 = blockIdx.x * 4 + w;
    if (T0 < NTOK) {
#pragma unroll
      for (int i = 0; i < 4; ++i) nxa[i] = *(const float4*)(p.X + (size_t)T0 * DM + 256 * i + 4 * lane);
      ninv = (lane < 16) ? p.INV[(size_t)T0 * 16 + lane] : -1;
    }
  }
  for (int T = blockIdx.x * 4 + w; T < NTOK; T += rstride) {
    const float* g2 = p.MOD + (size_t)(l * 5 + cond_of(T)) * 6144 + 5120;
    const float* modn = p.MOD + (size_t)(5 + cond_of(T)) * 6144;
    float4 x[4], ff[4], xa[4];
#pragma unroll
    for (int i = 0; i < 4; ++i) { ff[i] = make_float4(0.f, 0.f, 0.f, 0.f); xa[i] = nxa[i]; }
    const int myinv = ninv;
    {
      const int Tn = T + rstride;
      if (Tn < NTOK) {
#pragma unroll
        for (int i = 0; i < 4; ++i) nxa[i] = *(const float4*)(p.X + (size_t)Tn * DM + 256 * i + 4 * lane);
        ninv = (lane < 16) ? p.INV[(size_t)Tn * 16 + lane] : -1;
      }
    }
    unsigned long long sel = __ballot(myinv >= 0);
#pragma unroll 1
    while (sel) {
      int rows[4];
#pragma unroll
      for (int q = 0; q < 4; ++q) {
        if (sel) {
          const int e = __ffsll((long long)sel) - 1;
          sel &= sel - 1;
          rows[q] = __shfl(myinv, e);
        } else {
          rows[q] = -1;
        }
      }
      uint2 y[4][4];
#pragma unroll
      for (int q = 0; q < 4; ++q) {
        const u16* yr = p.YE + (size_t)(rows[q] >= 0 ? rows[q] : 0) * DM + 4 * lane;
#pragma unroll
        for (int i = 0; i < 4; ++i) y[q][i] = *(const uint2*)(yr + 256 * i);
      }
#pragma unroll
      for (int q = 0; q < 4; ++q) {
        const float wq = rows[q] >= 0 ? 1.f : 0.f;
#pragma unroll
        for (int i = 0; i < 4; ++i) {
          ff[i].x += wq * bflo(y[q][i].x); ff[i].y += wq * bfhi(y[q][i].x); ff[i].z += wq * bflo(y[q][i].y); ff[i].w += wq * bfhi(y[q][i].y);
        }
      }
    }
    float s = 0.f;
#pragma unroll
    for (int i = 0; i < 4; ++i) {
      const int k = 256 * i + 4 * lane;
      const float4 a = xa[i];
      const float4 f = ff[i];
      const float4 g = *(const float4*)(g2 + k);
      x[i].x = ALPHA * a.x + g.x * f.x; x[i].y = ALPHA * a.y + g.y * f.y; x[i].z = ALPHA * a.z + g.z * f.z; x[i].w = ALPHA * a.w + g.w * f.w;
      s += x[i].x + x[i].y + x[i].z + x[i].w;
    }
    const float mu = wave_sum(s) * (1.f / 1024.f);
    float vs = 0.f;
#pragma unroll
    for (int i = 0; i < 4; ++i) {
      x[i].x -= mu; x[i].y -= mu; x[i].z -= mu; x[i].w -= mu;
      vs += x[i].x * x[i].x + x[i].y * x[i].y + x[i].z * x[i].z + x[i].w * x[i].w;
    }
    const float rstd = rsqrtf(wave_sum(vs) * (1.f / 1024.f) + 1e-6f);
#pragma unroll
    for (int i = 0; i < 4; ++i) {
      const int k = 256 * i + 4 * lane;
      const float4 g = *(const float4*)(lg + k), bb = *(const float4*)(lb + k);
      float4 y;
      y.x = x[i].x * rstd * g.x + bb.x; y.y = x[i].y * rstd * g.y + bb.y; y.z = x[i].z * rstd * g.z + bb.z; y.w = x[i].w * rstd * g.w + bb.w;
      *(float4*)(dst + (size_t)T * DM + k) = y;
      if (write_h) {
        const float4 sc = *(const float4*)(modn + 1024 + k), sh = *(const float4*)(modn + k);
        uint2 pk = {pack2(y.x * (1.f + sc.x) + sh.x, y.y * (1.f + sc.y) + sh.y), pack2(y.z * (1.f + sc.z) + sh.z, y.w * (1.f + sc.w) + sh.w)};
        *(uint2*)(p.H2 + (size_t)T * DM + k) = pk;
      }
    }
  }
}

constexpr int kDynLds = 73728;
__global__ void __launch_bounds__(256, 2) mega(Params p) {
  extern __shared__ __attribute__((aligned(16))) char smem[];
  cg::grid_group grid = cg::this_grid();
  if (p.never) grid.sync();
  GBar gb;
  gb.bar = p.BAR; gb.x = xb_xcc_id(); gb.nloc = 0u; gb.nx = 0u;
  if (threadIdx.x == 0) (void)xb_add(&p.BAR[XB_XCNT(gb.x)], 1u);
  phase0(p, smem);
  gbar(gb);
  phase0b(p);
  gbar(gb);
#pragma unroll 1
  for (int l = 0; l < 2; ++l) {
    const float* xc = (l == 0) ? p.x_prompt : p.X;
    const float* xl = (l == 0) ? p.x_sample : (p.X + (size_t)NCTX * DM);
    phase1(p, smem, l);
    gbar(gb);
    if (PROBE == 1) { phase1(p, smem, l); gbar(gb); }
    phase2(p, smem, l);
    gbar(gb);
    if (PROBE == 3) { phase2(p, smem, l); gbar(gb); }
    phase2c(p, smem, l);
    gbar(gb);
    if (PROBE == 3) { phase2c(p, smem, l); gbar(gb); }
    phase3(p, smem, l, xc, xl);
    gbar(gb);
    if (PROBE == 1) { phase3(p, smem, l, xc, xl); gbar(gb); }
    phase4(p, smem, l, xc, xl);
    gbar(gb);
    phase5(p, smem);
    gbar(gb);
    phase6(p, smem, l);
    gbar(gb);
    if (PROBE == 1) { phase6(p, smem, l); gbar(gb); }
    phase7(p, smem, l, p.YE);
    gbar(gb);
    phase8(p, l, (l == 1) ? p.out : p.X, l == 0);
    if (l == 0) gbar(gb);
  }
}

extern "C" void kernel_launch(void* const* d_in, const int* in_sizes, int n_in, void* d_out, int out_size, void* d_ws,
                              size_t ws_size, hipStream_t stream) {
  static int grid_blocks = 0;
  if (!grid_blocks) {
    int dev = 0, cus = 0, per_cu = 0;
    hipGetDevice(&dev);
    hipDeviceGetAttribute(&cus, hipDeviceAttributeMultiprocessorCount, dev);
    hipFuncSetAttribute((const void*)mega, hipFuncAttributeMaxDynamicSharedMemorySize, kDynLds);
    hipOccupancyMaxActiveBlocksPerMultiprocessor(&per_cu, mega, 256, kDynLds);
    if (per_cu > 2) per_cu = 2;
    if (per_cu < 1) per_cu = 1;
    grid_blocks = cus * per_cu;
  }
  Params p{};
  const float** pf = (const float**)&p;
  for (int i = 0; i < 24; ++i) pf[i] = (const float*)d_in[i];
  p.out = (float*)d_out;
  char* ws = (char*)d_ws;
  size_t off = 0;
  auto take = [&](size_t bytes) { char* q = ws + off; off += (bytes + 255) & ~(size_t)255; return q; };
  p.MOD = (float*)take(2 * 5 * 6144 * 4);
  p.BAR = (unsigned*)take(XCD_BAR_WORDS * 4);
  p.ROPE = (float*)take(2048 * 4);
  p.X = (float*)take((size_t)NTOK * DM * 4);
  p.PRE = (float*)take((size_t)NTOK * DM * 4);
  p.KVS = (float*)take((size_t)20 * 4 * 2 * 16 * 4096 * 4);
  p.AFF = (float*)take((size_t)NTOK * 16 * 4);
  p.SELGATE = (float*)take((size_t)16 * NROWS_E * 4);
  p.SELTOK = (int*)take((size_t)16 * NROWS_E * 4);
  p.QKV = (u16*)take((size_t)NTOK * DIN * 2);
  p.CAT = (u16*)take((size_t)NTOK * DM * 2);
  p.H2 = (u16*)take((size_t)NTOK * DM * 2);
  p.ACT = (u16*)take((size_t)16 * NROWS_E * DM * 2);
  p.YE = (u16*)take((size_t)16 * NROWS_E * DM * 2);
  p.INV = (int*)take((size_t)NTOK * 16 * 4);
  p.CAK = (u16*)take((size_t)4 * 2 * 512 * 128 * 2);
  p.CAV = (u16*)take((size_t)4 * 2 * 512 * 128 * 2);
  p.CBK = (u16*)take((size_t)4 * 2 * 512 * 256 * 2);
  p.CBV = (u16*)take((size_t)4 * 2 * 512 * 256 * 2);
  p.never = 0;
  hipMemsetAsync(p.MOD, 0, (size_t)((char*)p.BAR - (char*)p.MOD) + XCD_BAR_WORDS * 4, stream);
  void* args[] = {&p};
  hipError_t e = hipLaunchCooperativeKernel((void*)mega, dim3(grid_blocks), dim3(256), args, kDynLds, stream);
  if (e != hipSuccess) fprintf(stderr, "cooperative launch failed: %s (grid %d)\n", hipGetErrorString(e), grid_blocks);
}
```

```cpp
#include <hip/hip_runtime.h>
#include <hip/hip_cooperative_groups.h>
#include <cstdio>
namespace cg = cooperative_groups;

#define DI __device__ __forceinline__
typedef short bf16x8 __attribute__((ext_vector_type(8)));
typedef float f32x16 __attribute__((ext_vector_type(16)));
typedef __bf16 bf2_t __attribute__((ext_vector_type(2)));
typedef float f2_t __attribute__((ext_vector_type(2)));
typedef unsigned short u16;
typedef unsigned u32x4 __attribute__((ext_vector_type(4)));
typedef float f32x4 __attribute__((ext_vector_type(4)));
typedef float f32x2 __attribute__((ext_vector_type(2)));

#define MFMA(a, b, c) __builtin_amdgcn_mfma_f32_32x32x16_bf16((a), (b), (c), 0, 0, 0)

#define PROBE 0
constexpr int NTOK = 12288;
constexpr int NCTX = 4096;
constexpr int DM = 1024;
constexpr int DIN = 2560;
constexpr int LDT = 72;
constexpr int LDT2 = 136;
constexpr int NROWS_E = 1536;
constexpr float NEG = -1e30f;
constexpr float ALPHA = 1.41421356237f;

constexpr size_t OFF_AK = 12582912, OFF_AV = 13631488, OFF_BK = 14680064, OFF_BV = 16777216, OFF_ST = 18874368;

struct Params {
  const float *x_prompt, *x_sample, *cak, *cav, *cbk, *cbv, *state, *c, *c_ctx, *w_ada, *b_ada, *w_in, *w_out, *sink, *rpb,
      *decay, *gn, *ln1g, *ln1b, *ln2g, *ln2b, *w_router, *w_gu, *w_down;
  float* out;
  float *MOD, *ROPE, *X, *PRE, *KVS, *AFF, *SELGATE;
  int* SELTOK;
  u16 *QKV, *CAT, *H2, *ACT, *CAK, *CAV, *CBK, *CBV;
  u16* YE;
  int* INV;
  unsigned* BAR;
  long never;
};

DI unsigned pack2(float a, float b) {
  f2_t v = {a, b};
  bf2_t r = __builtin_convertvector(v, bf2_t);
  return __builtin_bit_cast(unsigned, r);
}
DI int otid() { int x = threadIdx.x; asm volatile("" : "+v"(x)); return x; }
DI float bflo(unsigned u) { return __uint_as_float(u << 16); }
DI float bfhi(unsigned u) { return __uint_as_float(u & 0xffff0000u); }
DI int crow(int i, int h) { return (i & 3) + 8 * (i >> 2) + 4 * h; }
DI float silu(float x) { return x * __builtin_amdgcn_rcpf(1.f + __expf(-x)); }
DI float wave_sum(float v) {
#pragma unroll
  for (int o = 32; o >= 1; o >>= 1) v += __shfl_xor(v, o);
  return v;
}
DI bf16x8 mk8(unsigned a, unsigned b, unsigned c, unsigned d) {
  uint4 u = {a, b, c, d};
  return __builtin_bit_cast(bf16x8, u);
}


#define XB_TMO 128
#define XB_XCNT(j) (256 + 64 * (j))
#define XB_XSUB(j) (1280 + 64 * (j))
#define XB_XGEN(j) (2304 + 64 * (j))
#define XB_TOP 3328
#define XB_TOPGEN 3392
#define XCD_BAR_WORDS 3456
#define XB_SPIN_CAP (1u << 20)
DI unsigned xb_ld(unsigned* p) { return __hip_atomic_load(p, __ATOMIC_RELAXED, __HIP_MEMORY_SCOPE_AGENT); }
DI unsigned xb_add(unsigned* p, unsigned v) { return __hip_atomic_fetch_add(p, v, __ATOMIC_RELAXED, __HIP_MEMORY_SCOPE_AGENT); }
DI unsigned xb_xcc_id() { return (unsigned)__builtin_amdgcn_s_getreg((3 << 11) | 20) & 0xFu; }
#define XB_SPIN(cond, bar)                                                            \
  do {                                                                                \
    unsigned _sp = 0;                                                                 \
    while (cond) {                                                                    \
      __builtin_amdgcn_s_sleep(1);                                                    \
      if ((++_sp & 255u) == 0u) {                                                     \
        if (xb_ld(&(bar)[XB_TMO])) break;                                             \
        if (_sp > XB_SPIN_CAP) { atomicAdd(&(bar)[XB_TMO], 1u); break; }              \
      }                                                                               \
    }                                                                                 \
  } while (0)
struct GBar { unsigned* bar; unsigned x, nloc, nx; };
DI void gbar_complete(unsigned* bar, unsigned x, unsigned& nloc, unsigned& nx) {
  const unsigned G = gridDim.x;
  unsigned sum, cnt, mine, sp = 0u;
  for (;;) {
    sum = 0u; cnt = 0u; mine = 0u;
#pragma unroll
    for (unsigned j = 0; j < 16; ++j) {
      const unsigned c = xb_ld(&bar[XB_XCNT(j)]);
      sum += c; cnt += (c > 0u) ? 1u : 0u; mine = (j == x) ? c : mine;
    }
    if (sum == G) break;
    __builtin_amdgcn_s_sleep(1);
    if ((++sp & 255u) == 0u) {
      if (xb_ld(&bar[XB_TMO])) break;
      if (sp > XB_SPIN_CAP) { atomicAdd(&bar[XB_TMO], 1u); break; }
    }
  }
  nloc = mine > 0u ? mine : 1u;
  nx = cnt > 0u ? cnt : 1u;
}
DI void gbar(GBar& b) {
  asm volatile("s_waitcnt vmcnt(0)" ::: "memory");
  __syncthreads();
  if (threadIdx.x == 0) {
    unsigned* bar = b.bar;
    __builtin_amdgcn_s_waitcnt(0);
    if (b.nloc == 0u) gbar_complete(bar, b.x, b.nloc, b.nx);
    const unsigned nloc = b.nloc, nx = b.nx;
    const unsigned old = xb_add(&bar[XB_XSUB(b.x)], 1u);
    const unsigned gen = old / nloc;
    if (old + 1u == (gen + 1u) * nloc) {
      __builtin_amdgcn_fence(__ATOMIC_RELEASE, "agent");
      asm volatile("s_waitcnt vmcnt(0)" ::: "memory");
      const unsigned og = xb_add(&bar[XB_TOP], 1u);
      const unsigned tg = og / nx;
      if (og + 1u == (tg + 1u) * nx) xb_add(&bar[XB_TOPGEN], 1u);
      else XB_SPIN(xb_ld(&bar[XB_TOPGEN]) == tg, bar);
      __builtin_amdgcn_fence(__ATOMIC_ACQUIRE, "agent");
      xb_add(&bar[XB_XGEN(b.x)], 1u);
      asm volatile("s_waitcnt vmcnt(0)" ::: "memory");
    } else {
      XB_SPIN(xb_ld(&bar[XB_XGEN(b.x)]) == gen, bar);
      __builtin_amdgcn_fence(__ATOMIC_ACQUIRE, "agent");
      asm volatile("s_waitcnt vmcnt(0)" ::: "memory");
    }
  }
  __syncthreads();
}

template <class Setup, class Epi>
DI void gemm_phase128(char* smem, int s0, int s_end, int s_step, Setup setup, int ldb, Epi epi) {
  if (s0 >= s_end) return;
  u16* sA0 = (u16*)smem;
  u16* sB0 = sA0 + 128 * LDT;
  u16* sA1 = sB0 + 128 * LDT;
  u16* sB1 = sA1 + 128 * LDT;
  const int tid = otid(), lane = tid & 63, w = tid >> 6, r = lane & 31, h = lane >> 5;
  const int a_r0 = tid >> 3, a_c = (tid & 7) * 8;
  const int b_n4 = tid & 31, b_kq = tid >> 5;
  const u16 *apb0, *apb1, *apb2, *apb3;
  const float* bp;
  setup(s0, a_r0, a_c, b_n4, b_kq, apb0, apb1, apb2, apb3, bp);

  u32x4 pa0, pa1, pa2, pa3;
  f32x4 pb[8];

#define G_LOAD(KT)                                                                       \
  {                                                                                      \
    const int k0_ = (KT) * 64;                                                           \
    pa0 = *(const u32x4*)(apb0 + k0_);                                                   \
    pa1 = *(const u32x4*)(apb1 + k0_);                                                   \
    pa2 = *(const u32x4*)(apb2 + k0_);                                                   \
    pa3 = *(const u32x4*)(apb3 + k0_);                                                   \
    _Pragma("unroll") for (int i_ = 0; i_ < 8; ++i_) pb[i_] = *(const f32x4*)(bp + (size_t)(k0_ + i_) * ldb); \
  }
#define G_STAGE(SA, SBB)                                                                 \
  {                                                                                      \
    *(u32x4*)&SA[(a_r0)*LDT + a_c] = pa0;                                                \
    *(u32x4*)&SA[(a_r0 + 32) * LDT + a_c] = pa1;                                         \
    *(u32x4*)&SA[(a_r0 + 64) * LDT + a_c] = pa2;                                         \
    *(u32x4*)&SA[(a_r0 + 96) * LDT + a_c] = pa3;                                         \
    _Pragma("unroll") for (int j_ = 0; j_ < 4; ++j_) {                                   \
      u32x4 pk_;                                                                         \
      pk_.x = pack2(pb[0][j_], pb[1][j_]);                                               \
      pk_.y = pack2(pb[2][j_], pb[3][j_]);                                               \
      pk_.z = pack2(pb[4][j_], pb[5][j_]);                                               \
      pk_.w = pack2(pb[6][j_], pb[7][j_]);                                               \
      *(u32x4*)&SBB[(j_ * 32 + b_n4) * LDT + b_kq * 8] = pk_;                            \
    }                                                                                    \
  }
  const int aoff = (w * 32 + r) * LDT + 8 * h, boff = r * LDT + 8 * h;
#define G_FRAG(BUF, SA, SBB, KS)                                                         \
  {                                                                                      \
    fa[BUF] = *(const bf16x8*)(SA + aoff + (KS) * 16);                                   \
    fb[BUF][0] = *(const bf16x8*)(SBB + boff + (KS) * 16);                               \
    fb[BUF][1] = *(const bf16x8*)(SBB + boff + 32 * LDT + (KS) * 16);                    \
    fb[BUF][2] = *(const bf16x8*)(SBB + boff + 64 * LDT + (KS) * 16);                    \
    fb[BUF][3] = *(const bf16x8*)(SBB + boff + 96 * LDT + (KS) * 16);                    \
  }
#define G_MFMA(BUF)                                                                      \
  {                                                                                      \
    acc[0] = MFMA(fa[BUF], fb[BUF][0], acc[0]);                                          \
    acc[1] = MFMA(fa[BUF], fb[BUF][1], acc[1]);                                          \
    acc[2] = MFMA(fa[BUF], fb[BUF][2], acc[2]);                                          \
    acc[3] = MFMA(fa[BUF], fb[BUF][3], acc[3]);                                          \
  }
#define SB() __builtin_amdgcn_sched_barrier(0)
#define G_COMPUTE(SA, SBB)                                                               \
  {                                                                                      \
    bf16x8 fa[2], fb[2][4];                                                              \
    G_FRAG(0, SA, SBB, 0);                                                               \
    G_FRAG(1, SA, SBB, 1);                                                               \
    SB();                                                                                \
    G_MFMA(0);                                                                           \
    SB();                                                                                \
    G_FRAG(0, SA, SBB, 2);                                                               \
    SB();                                                                                \
    G_MFMA(1);                                                                           \
    SB();                                                                                \
    G_FRAG(1, SA, SBB, 3);                                                               \
    SB();                                                                                \
    G_MFMA(0);                                                                           \
    SB();                                                                                \
    G_MFMA(1);                                                                           \
    SB();                                                                                \
  }

  G_LOAD(0);
  __syncthreads();
#pragma unroll 1
  for (int s = s0; s < s_end; s += s_step) {
    f32x16 acc[4];
#pragma unroll
    for (int a = 0; a < 4; ++a)
#pragma unroll
      for (int i = 0; i < 16; ++i) acc[a][i] = 0.f;
    const int sn = s + s_step;
    const bool has_next = sn < s_end;
    const u16 *n0 = apb0, *n1 = apb1, *n2 = apb2, *n3 = apb3;
    const float* nbp = bp;
    if (has_next) setup(sn, a_r0, a_c, b_n4, b_kq, n0, n1, n2, n3, nbp);
#pragma unroll 1
    for (int kt = 0; kt < 16; kt += 2) {
      G_STAGE(sA0, sB0);
      __syncthreads();
      G_LOAD(kt + 1);
      G_COMPUTE(sA0, sB0);
      G_STAGE(sA1, sB1);
      __syncthreads();
      {
        int kn = kt + 2;
        if (kt == 14) { apb0 = n0; apb1 = n1; apb2 = n2; apb3 = n3; bp = nbp; kn = 0; }
        G_LOAD(kn);
      }
      G_COMPUTE(sA1, sB1);
    }
    epi(s, acc, w, r, h);
  }
  __syncthreads();
#undef G_LOAD
#undef G_STAGE
#undef G_COMPUTE
#undef G_FRAG
#undef G_MFMA
}
#undef SB

template <bool CONTIG, class Setup, class Epi, class Pre>
DI void gemm_phase(char* smem, int s0, int s_end, int s_step, Setup setup, int ldb, Epi epi, Pre pre) {
  asm volatile("" : "+s"(s_end));
  if (s0 >= s_end) return;
  constexpr int LDK = 40;
  u16* sA0 = (u16*)smem;
  u16* sB0 = sA0 + 256 * LDK;
  u16* sA1 = sB0 + 128 * LDK;
  u16* sB1 = sA1 + 256 * LDK;
  const int tid = otid(), lane = tid & 63, w = tid >> 6, r = lane & 31, h = lane >> 5;
  const int a_r0 = tid >> 2, a_c = (tid & 3) * 8;
  const int b_n4 = tid & 31, b_kq = tid >> 5;
  const u16* abase;
  const float* bbase;
  unsigned ao0, ao1, ao2, ao3, bo;
  setup(s0, a_r0, a_c, b_n4, b_kq, abase, ao0, ao1, ao2, ao3, bbase, bo);

  u32x4 pa0, pa1, pa2, pa3;
  f32x4 pbA[4], pbB[4];

#define G_LOADA(KT)                                                                      \
  {                                                                                      \
    const int k0_ = (KT) * 32;                                                           \
    pa0 = *(const u32x4*)(abase + k0_ + (size_t)ao0);                                    \
    pa1 = *(const u32x4*)(abase + k0_ + (size_t)(CONTIG ? ao0 + 64u * DM : ao1));        \
    pa2 = *(const u32x4*)(abase + k0_ + (size_t)(CONTIG ? ao0 + 128u * DM : ao2));       \
    pa3 = *(const u32x4*)(abase + k0_ + (size_t)(CONTIG ? ao0 + 192u * DM : ao3));       \
  }
#define G_LOADB(PB, BP, KT)                                                              \
  {                                                                                      \
    const int k0_ = (KT) * 32;                                                           \
    _Pragma("unroll") for (int i_ = 0; i_ < 4; ++i_) PB[i_] = *(const f32x4*)((BP) + (size_t)(k0_ + i_) * ldb + (size_t)bo); \
  }
#define G_STAGE(SA, SBB, PB)                                                               \
  {                                                                                      \
    *(u32x4*)&SA[(a_r0)*LDK + a_c] = pa0;                                                \
    *(u32x4*)&SA[(a_r0 + 64) * LDK + a_c] = pa1;                                         \
    *(u32x4*)&SA[(a_r0 + 128) * LDK + a_c] = pa2;                                        \
    *(u32x4*)&SA[(a_r0 + 192) * LDK + a_c] = pa3;                                        \
    _Pragma("unroll") for (int j_ = 0; j_ < 4; ++j_) {                                   \
      uint2 pk_;                                                                         \
      pk_.x = pack2(PB[0][j_], PB[1][j_]);                                               \
      pk_.y = pack2(PB[2][j_], PB[3][j_]);                                               \
      *(uint2*)&SBB[(j_ * 32 + b_n4) * LDK + b_kq * 4] = pk_;                            \
    }                                                                                    \
  }
  const int aoff = (w * 64 + r) * LDK + 8 * h, boff = r * LDK + 8 * h;
#define G_FRAG(FA, FB, SA, SBB, KS)                                                      \
  {                                                                                      \
    FA[0] = *(const bf16x8*)(SA + aoff + (KS) * 16);                                     \
    FA[1] = *(const bf16x8*)(SA + aoff + 32 * LDK + (KS) * 16);                          \
    FB[0] = *(const bf16x8*)(SBB + boff + (KS) * 16);                                    \
    FB[1] = *(const bf16x8*)(SBB + boff + 32 * LDK + (KS) * 16);                         \
    FB[2] = *(const bf16x8*)(SBB + boff + 64 * LDK + (KS) * 16);                         \
    FB[3] = *(const bf16x8*)(SBB + boff + 96 * LDK + (KS) * 16);                         \
  }
#define G_MFMA(FA, FB)                                                                   \
  {                                                                                      \
    _Pragma("unroll") for (int mt_ = 0; mt_ < 2; ++mt_)                                  \
    _Pragma("unroll") for (int nt_ = 0; nt_ < 4; ++nt_) acc[mt_][nt_] = MFMA(FA[mt_], FB[nt_], acc[mt_][nt_]); \
  }
#define SB() __builtin_amdgcn_sched_barrier(0)
#define G_COMPUTE(SA, SBB)                                                               \
  {                                                                                      \
    bf16x8 fa0[2], fb0[4];                                                               \
    G_FRAG(fa0, fb0, SA, SBB, 0);                                                        \
    SB();                                                                                \
    G_MFMA(fa0, fb0);                                                                    \
    SB();                                                                                \
    G_FRAG(fa0, fb0, SA, SBB, 1);                                                        \
    SB();                                                                                \
    G_MFMA(fa0, fb0);                                                                    \
    SB();                                                                                \
  }

  G_LOADA(0);
  G_LOADB(pbA, bbase, 0);
  G_LOADB(pbB, bbase, 1);
  __syncthreads();
#pragma unroll 1
  for (int s = s0; s < s_end; s += s_step) {
    f32x16 acc[2][4];
#pragma unroll
    for (int a = 0; a < 2; ++a)
#pragma unroll
      for (int b = 0; b < 4; ++b)
#pragma unroll
        for (int i = 0; i < 16; ++i) acc[a][b][i] = 0.f;
    pre(s, tid);
    const int sn = s + s_step;
    const bool has_next = sn < s_end;
    const u16* nabase = abase;
    const float* nbbase = bbase;
    unsigned n0 = ao0, n1 = ao1, n2 = ao2, n3 = ao3, nbo = bo;
    if (has_next) setup(sn, a_r0, a_c, b_n4, b_kq, nabase, n0, n1, n2, n3, nbbase, nbo);
#pragma unroll 1
    for (int kt = 0; kt < 32; kt += 2) {
      G_STAGE(sA0, sB0, pbA);
      G_LOADA(kt + 1);
      __syncthreads();
      {
        const bool last = (kt == 30);
        const float* bq = last ? nbbase : bbase;
        const int kb = last ? 0 : kt + 2;
        G_LOADB(pbA, bq, kb);
      }
      G_COMPUTE(sA0, sB0);
      G_STAGE(sA1, sB1, pbB);
      {
        int ka = kt + 2, kb = kt + 3;
        if (kt == 30) { abase = nabase; ao0 = n0; ao1 = n1; ao2 = n2; ao3 = n3; bbase = nbbase; ka = 0; kb = 1; }
        G_LOADA(ka);
        G_LOADB(pbB, bbase, kb);
      }
      __syncthreads();
      G_COMPUTE(sA1, sB1);
    }
    epi(s, acc, w, r, h);
  }
  __syncthreads();
#undef G_LOADA
#undef G_LOADB
#undef G_STAGE
#undef G_COMPUTE
#undef G_FRAG
#undef G_MFMA
}

DI void load4x4(const void* base, int stride, bool isf32, int rq, int c4, float v[4][4]) {
  if (isf32) {
#pragma unroll
    for (int i = 0; i < 4; ++i) {
      const float4 x = *(const float4*)((const float*)base + (size_t)(4 * rq + i) * stride + 4 * c4);
      v[i][0] = x.x; v[i][1] = x.y; v[i][2] = x.z; v[i][3] = x.w;
    }
  } else {
#pragma unroll
    for (int i = 0; i < 4; ++i) {
      const uint2 x = *(const uint2*)((const u16*)base + (size_t)(4 * rq + i) * stride + 4 * c4);
      v[i][0] = bflo(x.x); v[i][1] = bfhi(x.x); v[i][2] = bflo(x.y); v[i][3] = bfhi(x.y);
    }
  }
}
DI void store_n(u16* dst, int ld, int row0, int rq, int c4, const float v[4][4]) {
#pragma unroll
  for (int i = 0; i < 4; ++i) {
    uint2 pk = {pack2(v[i][0], v[i][1]), pack2(v[i][2], v[i][3])};
    *(uint2*)&dst[(row0 + 4 * rq + i) * ld + 4 * c4] = pk;
  }
}
DI void store_t(u16* dst, int ld, int col0, int rq, int c4, const float v[4][4], const float s[4]) {
#pragma unroll
  for (int j = 0; j < 4; ++j) {
    uint2 pk = {pack2(v[0][j] * s[0], v[1][j] * s[1]), pack2(v[2][j] * s[2], v[3][j] * s[3])};
    *(uint2*)&dst[(4 * c4 + j) * ld + col0 + 4 * rq] = pk;
  }
}

DI void attn_load(const u16* kp, const u16* vp, int stride, int rq, int c4, uint2 (&k)[4], uint2 (&v)[4]) {
#pragma unroll
  for (int i = 0; i < 4; ++i) {
    k[i] = *(const uint2*)(kp + (size_t)(4 * rq + i) * stride + 4 * c4);
    v[i] = *(const uint2*)(vp + (size_t)(4 * rq + i) * stride + 4 * c4);
  }
}
DI void attn_stage(u16* sK, u16* sVT, int rq, int c4, const uint2 (&k)[4], const uint2 (&v)[4]) {
#pragma unroll
  for (int i = 0; i < 4; ++i) *(uint2*)&sK[(4 * rq + i) * LDT + 4 * c4] = k[i];
  uint2 t0, t1, t2, t3;
  t0.x = (v[0].x & 0xffffu) | (v[1].x << 16);          t0.y = (v[2].x & 0xffffu) | (v[3].x << 16);
  t1.x = (v[0].x >> 16) | (v[1].x & 0xffff0000u);      t1.y = (v[2].x >> 16) | (v[3].x & 0xffff0000u);
  t2.x = (v[0].y & 0xffffu) | (v[1].y << 16);          t2.y = (v[2].y & 0xffffu) | (v[3].y << 16);
  t3.x = (v[0].y >> 16) | (v[1].y & 0xffff0000u);      t3.y = (v[2].y >> 16) | (v[3].y & 0xffff0000u);
  const int qs = 4 * (rq ^ ((c4 >> 1) & 7));
  *(uint2*)&sVT[(4 * c4 + 0) * LDT + qs] = t0;
  *(uint2*)&sVT[(4 * c4 + 1) * LDT + qs] = t1;
  *(uint2*)&sVT[(4 * c4 + 2) * LDT + qs] = t2;
  *(uint2*)&sVT[(4 * c4 + 3) * LDT + qs] = t3;
}

template <class TileSrc, class BiasF, class TMode>
DI void attn_core(char* smem, const u16* qbase, int ntiles, TileSrc src, BiasF biasf, TMode tmode, float m_init, bool has_sink, u16* obase) {
  u16* sK0 = (u16*)smem;
  u16* sVT0 = sK0 + 64 * LDT;
  u16* sK1 = sVT0 + 64 * LDT;
  u16* sVT1 = sK1 + 64 * LDT;
  const int tid = otid(), lane = tid & 63, w = tid >> 6, r = lane & 31, h = lane >> 5;
  const int rq = tid >> 4, c4 = tid & 15;
  const int ql = w * 32 + r;
  bf16x8 qf[4];
#pragma unroll
  for (int ks = 0; ks < 4; ++ks) qf[ks] = *(const bf16x8*)(qbase + (size_t)ql * DIN + ks * 16 + 8 * h);
  f32x16 O[2];
#pragma unroll
  for (int d = 0; d < 2; ++d)
#pragma unroll
    for (int i = 0; i < 16; ++i) O[d][i] = 0.f;
  float m = m_init, lsum = (has_sink && h == 0) ? 1.f : 0.f;

  auto nextv = [&](int j, const u16*& kp, const u16*& vp, int& stride) -> int {
    while (j < ntiles && !src(j, kp, vp, stride)) ++j;
    return j;
  };
  auto compute = [&](int jc, const u16* sK, const u16* sVT) {
    const int mode = tmode(jc, w);
    if (mode != 2) {
      f32x16 S[2];
#pragma unroll
      for (int mt = 0; mt < 2; ++mt)
#pragma unroll
        for (int i = 0; i < 16; ++i) S[mt][i] = 0.f;
#pragma unroll
      for (int ks = 0; ks < 4; ++ks)
#pragma unroll
        for (int mt = 0; mt < 2; ++mt) {
          const bf16x8 kf = *(const bf16x8*)&sK[(mt * 32 + r) * LDT + ks * 16 + 8 * h];
          S[mt] = MFMA(kf, qf[ks], S[mt]);
        }
      const float C2 = 0.125f * 1.44269504f;
      float mx = NEG;
      if (mode == 1) {
#pragma unroll
        for (int mt = 0; mt < 2; ++mt)
#pragma unroll
          for (int i = 0; i < 16; ++i) {
            const float s = S[mt][i] * C2 + biasf(jc, mt * 32 + crow(i, h), ql);
            S[mt][i] = s;
            mx = fmaxf(mx, s);
          }
      } else {
#pragma unroll
        for (int mt = 0; mt < 2; ++mt)
#pragma unroll
          for (int i = 0; i < 16; ++i) {
            const float s = S[mt][i] * C2;
            S[mt][i] = s;
            mx = fmaxf(mx, s);
          }
      }
      mx = fmaxf(mx, __shfl_xor(mx, 32));
      const float mn = fmaxf(m, mx);
      if (__any(mn > m)) {
        const float alpha = __builtin_amdgcn_exp2f(m - mn);
        m = mn;
        lsum *= alpha;
#pragma unroll
        for (int d = 0; d < 2; ++d)
#pragma unroll
          for (int i = 0; i < 16; ++i) O[d][i] *= alpha;
      }
      float ps = 0.f;
#pragma unroll
      for (int mt = 0; mt < 2; ++mt)
#pragma unroll
        for (int i = 0; i < 16; ++i) {
          const float pv = __builtin_amdgcn_exp2f(S[mt][i] - m);
          S[mt][i] = pv;
          ps += pv;
        }
      lsum += ps;
#pragma unroll
      for (int mt = 0; mt < 2; ++mt)
#pragma unroll
        for (int s = 0; s < 2; ++s) {
          const bf16x8 pf = mk8(pack2(S[mt][8 * s + 0], S[mt][8 * s + 1]), pack2(S[mt][8 * s + 2], S[mt][8 * s + 3]),
                                pack2(S[mt][8 * s + 4], S[mt][8 * s + 5]), pack2(S[mt][8 * s + 6], S[mt][8 * s + 7]));
#pragma unroll
          for (int d = 0; d < 2; ++d) {
            const int sw = (d * 4 + (r >> 3)) & 7, q = mt * 8 + 4 * s + h;
            const u16* vrow = &sVT[(d * 32 + r) * LDT];
            const uint2 lo = *(const uint2*)(vrow + 4 * (q ^ sw));
            const uint2 hi = *(const uint2*)(vrow + 4 * ((q + 2) ^ sw));
            O[d] = MFMA(mk8(lo.x, lo.y, hi.x, hi.y), pf, O[d]);
          }
        }
    }
  };

  uint2 kA[4], vA[4], kB[4], vB[4];
#pragma unroll
  for (int i = 0; i < 4; ++i) { kA[i] = make_uint2(0u, 0u); vA[i] = kA[i]; kB[i] = kA[i]; vB[i] = kA[i]; }
  const u16 *kp = nullptr, *vp = nullptr;
  int stride = 0;
  int jA = nextv(0, kp, vp, stride);
  if (jA < ntiles) attn_load(kp, vp, stride, rq, c4, kA, vA);
  int jB = nextv(jA + 1, kp, vp, stride);
  if (jB < ntiles) attn_load(kp, vp, stride, rq, c4, kB, vB);
  __syncthreads();
#pragma unroll 1
  for (;;) {
    if (jA >= ntiles) break;
    attn_stage(sK0, sVT0, rq, c4, kA, vA);
    {
      const int jc = jA;
      jA = nextv(jB + 1, kp, vp, stride);
      if (jA < ntiles) attn_load(kp, vp, stride, rq, c4, kA, vA);
      __syncthreads();
      compute(jc, sK0, sVT0);
    }
    if (jB >= ntiles) break;
    attn_stage(sK1, sVT1, rq, c4, kB, vB);
    {
      const int jc = jB;
      jB = nextv(jA + 1, kp, vp, stride);
      if (jB < ntiles) attn_load(kp, vp, stride, rq, c4, kB, vB);
      __syncthreads();
      compute(jc, sK1, sVT1);
    }
  }
  const float l = lsum + __shfl_xor(lsum, 32);
  const float inv = 1.f / l;
#pragma unroll
  for (int d = 0; d < 2; ++d)
#pragma unroll
    for (int g = 0; g < 4; ++g) {
      uint2 pk = {pack2(O[d][4 * g + 0] * inv, O[d][4 * g + 1] * inv), pack2(O[d][4 * g + 2] * inv, O[d][4 * g + 3] * inv)};
      *(uint2*)(obase + (size_t)ql * DM + d * 32 + 8 * g + 4 * h) = pk;
    }
}

DI void phase0(const Params& p, char* smem) {
  const int tid = otid();
  if (blockIdx.x == 0) {
    for (int idx = tid; idx < 1024; idx += 256) {
      const int pos = idx >> 4, j = idx & 15;
      const double inv = 1.0 / pow(10000.0, (double)j / 16.0);
      const float ang = (float)((double)pos * inv);
      p.ROPE[idx] = cosf(ang);
      p.ROPE[1024 + idx] = sinf(ang);
    }
  }
  float* scond = (float*)smem;
  for (int item = blockIdx.x; item < 768; item += gridDim.x) {
    const int l = item / 384, ks = (item / 24) % 16, jb = item % 24;
    __syncthreads();
    for (int idx = tid; idx < 320; idx += 256) {
      const int c = idx / 64, k = ks * 64 + (idx & 63);
      const float v = (c == 0) ? p.c_ctx[k] : p.c[(c - 1) * DM + k];
      scond[idx] = silu(v);
    }
    __syncthreads();
    const int j = jb * 256 + tid;
    const float* wp = p.w_ada + ((size_t)l * DM + ks * 64) * 6144 + j;
    float a[5] = {0.f, 0.f, 0.f, 0.f, 0.f};
#pragma unroll 8
    for (int k = 0; k < 64; ++k) {
      const float wv = wp[(size_t)k * 6144];
#pragma unroll
      for (int c = 0; c < 5; ++c) a[c] += scond[c * 64 + k] * wv;
    }
    const float bias = (ks == 0) ? p.b_ada[l * 6144 + j] : 0.f;
#pragma unroll
    for (int c = 0; c < 5; ++c) unsafeAtomicAdd(&p.MOD[(l * 5 + c) * 6144 + j], a[c] + bias);
  }
}

DI int cond_of(int T) { return T < NCTX ? 0 : 1 + ((T - NCTX) >> 11); }

DI void cvt_f32_bf16(const float* s, u16* d, int n4, int gtid, int gsz) {
  for (int i = gtid; i < n4; i += gsz) {
    const float4 x = *(const float4*)(s + (size_t)i * 4);
    uint2 pk = {pack2(x.x, x.y), pack2(x.z, x.w)};
    *(uint2*)(d + (size_t)i * 4) = pk;
  }
}
DI void phase0b(const Params& p) {
  const int tid = otid(), lane = tid & 63, w = tid >> 6;
  {
    const int gtid = blockIdx.x * 256 + tid, gsz = gridDim.x * 256;
    cvt_f32_bf16(p.cak, p.CAK, 4 * 2 * 512 * 128 / 4, gtid, gsz);
    cvt_f32_bf16(p.cav, p.CAV, 4 * 2 * 512 * 128 / 4, gtid, gsz);
    cvt_f32_bf16(p.cbk, p.CBK, 4 * 2 * 512 * 256 / 4, gtid, gsz);
    cvt_f32_bf16(p.cbv, p.CBV, 4 * 2 * 512 * 256 / 4, gtid, gsz);
  }
  for (int T = blockIdx.x * 4 + w; T < NTOK; T += gridDim.x * 4) {
    const float* mod = p.MOD + (size_t)cond_of(T) * 6144;
    const float* xr = (T < NCTX) ? (p.x_prompt + (size_t)T * DM) : (p.x_sample + (size_t)(T - NCTX) * DM);
#pragma unroll
    for (int i = 0; i < 4; ++i) {
      const int k = 256 * i + 4 * lane;
      const float4 x = *(const float4*)(xr + k);
      const float4 sc = *(const float4*)(mod + 1024 + k), sh = *(const float4*)(mod + k);
      uint2 pk = {pack2(x.x * (1.f + sc.x) + sh.x, x.y * (1.f + sc.y) + sh.y), pack2(x.z * (1.f + sc.z) + sh.z, x.w * (1.f + sc.w) + sh.w)};
      *(uint2*)(p.H2 + (size_t)T * DM + k) = pk;
    }
  }
}

DI void phase1(const Params& p, char* smem, int l) {
  const float* W = p.w_in + (size_t)l * DM * DIN;
  const int xcd = blockIdx.x & 7, nloc = gridDim.x >> 3;
  float* sR = (float*)(smem + 61440);
  for (int idx = otid(); idx < 2048; idx += 256) sR[idx] = p.ROPE[idx];
  auto setup = [&](int s, int ar0, int ac, int n4, int kq, const u16*& ab, unsigned& o0, unsigned& o1, unsigned& o2, unsigned& o3, const float*& bb, unsigned& bo) {
    const int tm = 6 * xcd + s % 6, tn = s / 6;
    ab = p.H2 + (size_t)tm * 256 * DM;
    o0 = (unsigned)(ar0 * DM + ac); o1 = o0 + 64u * DM; o2 = o0 + 128u * DM; o3 = o0 + 192u * DM;
    bb = W + tn * 128;
    bo = (unsigned)(4 * n4 + kq * 4 * DIN);
  };
  auto epi = [&](int s, f32x16(&acc)[2][4], int w, int r, int h) {
    int hq = h;
    asm volatile("" : "+v"(hq));
    const int tm = 6 * xcd + s % 6, tn = s / 6;
    const int m0 = tm * 256, n0 = tn * 128;
    const bool lat = m0 >= NCTX;
    const bool rope = lat && (n0 < 640);
    const int n = n0 + 4 * r;
    const int q = (r >> 2) & 3;
#pragma unroll
    for (int mt = 0; mt < 2; ++mt)
#pragma unroll
    for (int i = 0; i < 16; ++i) {
      const int T = m0 + w * 64 + mt * 32 + crow(i, hq);
      float v0 = acc[mt][0][i], v1 = acc[mt][1][i], v2 = acc[mt][2][i], v3 = acc[mt][3][i];
      if (rope) {
        const int t = (T - NCTX) & 2047;
        const int pos = (q < 2) ? (t >> 6) : (t & 63);
        const int jf = 4 * (r & 3);
        const float4 cs = *(const float4*)(sR + pos * 16 + jf), sn = *(const float4*)(sR + 1024 + pos * 16 + jf);
        const float o0 = __shfl_xor(v0, 4), o1 = __shfl_xor(v1, 4), o2 = __shfl_xor(v2, 4), o3 = __shfl_xor(v3, 4);
        if (q & 1) { v0 = o0 * sn.x + v0 * cs.x; v1 = o1 * sn.y + v1 * cs.y; v2 = o2 * sn.z + v2 * cs.z; v3 = o3 * sn.w + v3 * cs.w; }
        else { v0 = v0 * cs.x - o0 * sn.x; v1 = v1 * cs.y - o1 * sn.y; v2 = v2 * cs.z - o2 * sn.z; v3 = v3 * cs.w - o3 * sn.w; }
      }
      uint2 pk = {pack2(v0, v1), pack2(v2, v3)};
      *(uint2*)(p.QKV + (size_t)T * DIN + n) = pk;
      if (!lat) {
        const int b = T >> 8, t = T & 255;
        const float4 vv = {v0, v1, v2, v3};
        if (n0 == 512) *(float4*)(p.out + OFF_AK + ((size_t)(b * 2 + l) * 256 + t) * 128 + (n - 512)) = vv;
        else if (n0 == 640) *(float4*)(p.out + OFF_AV + ((size_t)(b * 2 + l) * 256 + t) * 128 + (n - 640)) = vv;
        else if (n0 == 1024 || n0 == 1152) *(float4*)(p.out + OFF_BK + ((size_t)(b * 2 + l) * 256 + t) * 256 + (n - 1024)) = vv;
        else if (n0 == 1280 || n0 == 1408) *(float4*)(p.out + OFF_BV + ((size_t)(b * 2 + l) * 256 + t) * 256 + (n - 1280)) = vv;
      }
      if ((i & 3) == 3) __builtin_amdgcn_sched_barrier(0);
    }
  };
  gemm_phase<true>(smem, blockIdx.x >> 3, 120, nloc, setup, DIN, epi, [](int, int) {});
}

DI float ret_lg(const Params& p, int l, int dir, int head) { return -__expf(p.decay[(l * 2 + dir) * 4 + head]); }

DI size_t kvs_slot(int req, int head, int dir, int c) { return ((size_t)((req * 4 + head) * 2 + dir) * 16 + c) * 4096; }

DI void retkv_item(const Params& p, char* smem, int l, int req, int head, int c) {
  u16* sKTf = (u16*)smem;
  u16* sKTb = sKTf + 64 * LDT2;
  u16* sVT = sKTb + 64 * LDT2;
  const int tid = otid(), lane = tid & 63, w = tid >> 6, r = lane & 31, h = lane >> 5;
  const int rq = tid >> 4, c4 = tid & 15;
  const int T0 = (req < 16 ? req * 256 : NCTX + (req - 16) * 2048) + c * 128;
  const float lgf = ret_lg(p, l, 0, head), lgb = ret_lg(p, l, 1, head);
  const float one4[4] = {1.f, 1.f, 1.f, 1.f};
  __syncthreads();
#pragma unroll
  for (int half = 0; half < 2; ++half) {
    float v[4][4];
    float sf[4], sb[4];
#pragma unroll
    for (int i = 0; i < 4; ++i) {
      const int j = half * 64 + 4 * rq + i;
      sf[i] = 0.125f * __expf(lgf * (float)(127 - j));
      sb[i] = 0.125f * __expf(lgb * (float)j);
    }
    load4x4(p.QKV + (size_t)(T0 + half * 64) * DIN + 1792 + head * 64, DIN, false, rq, c4, v);
    store_t(sKTf, LDT2, half * 64, rq, c4, v, sf);
    store_t(sKTb, LDT2, half * 64, rq, c4, v, sb);
    load4x4(p.QKV + (size_t)(T0 + half * 64) * DIN + 2048 + head * 64, DIN, false, rq, c4, v);
    store_t(sVT, LDT2, half * 64, rq, c4, v, one4);
  }
  __syncthreads();
  const int dir = w >> 1, mt = w & 1;
  const u16* sKT = dir ? sKTb : sKTf;
  f32x16 acc[2];
#pragma unroll
  for (int nt = 0; nt < 2; ++nt)
#pragma unroll
    for (int i = 0; i < 16; ++i) acc[nt][i] = 0.f;
#pragma unroll
  for (int ks = 0; ks < 8; ++ks) {
    const bf16x8 fa = *(const bf16x8*)&sKT[(mt * 32 + r) * LDT2 + ks * 16 + 8 * h];
#pragma unroll
    for (int nt = 0; nt < 2; ++nt) {
      const bf16x8 fb = *(const bf16x8*)&sVT[(nt * 32 + r) * LDT2 + ks * 16 + 8 * h];
      acc[nt] = MFMA(fa, fb, acc[nt]);
    }
  }
  float* dst = p.KVS + kvs_slot(req, head, dir, c);
#pragma unroll
  for (int nt = 0; nt < 2; ++nt)
#pragma unroll
    for (int i = 0; i < 16; ++i) dst[(mt * 32 + crow(i, h)) * 64 + nt * 32 + r] = acc[nt][i];
}

DI void phase2(const Params& p, char* smem, int l) {
  const int tid = otid();
  for (int item = blockIdx.x; item < 1536; item += gridDim.x) {
    if (item < 512) {
      const int b = item >> 7, head = (item >> 4) & 7, qb = item & 15, kvh = head >> 2;
      const int T0 = NCTX + b * 2048 + qb * 128;
      const u16* ck = p.CAK + ((size_t)(b * 2 + l) * 512) * 128 + kvh * 64;
      const u16* cv = p.CAV + ((size_t)(b * 2 + l) * 512) * 128 + kvh * 64;
      auto src = [&](int j, const u16*& kp, const u16*& vp, int& stride) -> bool {
        if (j < 8) {
          kp = ck + (size_t)j * 64 * 128; vp = cv + (size_t)j * 64 * 128; stride = 128;
          return true;
        }
        const int jj = j - 8, kb = qb - 1 + (jj >> 1);
        if (kb < 0 || kb >= 16) return false;
        const int Tk = NCTX + b * 2048 + kb * 128 + (jj & 1) * 64;
        kp = p.QKV + (size_t)Tk * DIN + 512 + kvh * 64; vp = p.QKV + (size_t)Tk * DIN + 640 + kvh * 64; stride = DIN;
        return true;
      };
      auto biasf = [&](int j, int key, int ql) -> float {
        if (j < 8) return 0.f;
        const int jj = j - 8;
        const int kj = (qb - 1 + (jj >> 1)) * 128 + (jj & 1) * 64 + key;
        const int qi = qb * 128 + ql;
        const int d = qi - kj;
        return (d <= 128 && d >= -128) ? 0.f : NEG;
      };
      auto tmode = [&](int j, int w) -> int {
        if (j < 8) return 0;
        const int jj = j - 8;
        const int k0 = (qb - 1 + (jj >> 1)) * 128 + (jj & 1) * 64, q0w = qb * 128 + w * 32;
        if (k0 - (q0w + 31) > 128 || q0w - (k0 + 63) > 128) return 2;
        if ((q0w + 31) - k0 <= 128 && (k0 + 63) - q0w <= 128) return 0;
        return 1;
      };
      attn_core(smem, p.QKV + (size_t)T0 * DIN + head * 64, 14, src, biasf, tmode, p.sink[l * 8 + head] * 1.44269504f, true,
                p.CAT + (size_t)T0 * DM + head * 64);
    } else if (item < 768) {
      const int it = item - 512;
      const int b = it >> 6, head = (it >> 4) & 3, qb = it & 15;
      const int T0 = NCTX + b * 2048 + qb * 128;
      float* srpb = (float*)(smem + 4 * 64 * LDT * 2);
      __syncthreads();
      for (int idx = tid; idx < 465; idx += 256) srpb[idx] = p.rpb[(size_t)(l * 4 + head) * 465 + idx] * 1.44269504f;
      const int r0 = 2 * qb;
      const int rmin = min(max(r0 - 4, 0), 24), rmax = min(max(r0 + 1 - 4, 0), 24) + 7;
      const u16* ck = p.CBK + ((size_t)(b * 2 + l) * 512) * 256 + head * 64;
      const u16* cv = p.CBV + ((size_t)(b * 2 + l) * 512) * 256 + head * 64;
      auto src = [&](int j, const u16*& kp, const u16*& vp, int& stride) -> bool {
        if (j < 8) {
          kp = ck + (size_t)j * 64 * 256; vp = cv + (size_t)j * 64 * 256; stride = 256;
          return true;
        }
        const int Tk = NCTX + b * 2048 + (rmin + j - 8) * 64;
        kp = p.QKV + (size_t)Tk * DIN + 1024 + head * 64; vp = p.QKV + (size_t)Tk * DIN + 1280 + head * 64; stride = DIN;
        return true;
      };
      auto biasf = [&](int j, int key, int ql) -> float {
        if (j < 8) return 0.f;
        const int kr = rmin + j - 8, kc = key;
        const int qr = r0 + (ql >> 6), qc = ql & 63;
        const int rs = min(max(qr - 4, 0), 24), cs = min(max(qc - 8, 0), 48);
        const bool ok = (kr >= rs) && (kr < rs + 8) && (kc >= cs) && (kc < cs + 16);
        const int bi = ok ? ((kr - qr + 7) * 31 + (kc - qc + 15)) : 0;
        const float bv = srpb[bi];
        return ok ? bv : NEG;
      };
      auto tmode = [&](int j, int w) -> int {
        if (j < 8) return 0;
        const int kr = rmin + j - 8, qr = r0 + (w >> 1);
        const int rs = min(max(qr - 4, 0), 24);
        return (kr >= rs && kr < rs + 8) ? 1 : 2;
      };
      attn_core(smem, p.QKV + (size_t)T0 * DIN + 768 + head * 64, 8 + (rmax - rmin + 1), src, biasf, tmode, NEG, false,
                p.CAT + (size_t)T0 * DM + 512 + head * 64);
    } else if (item < 1152) {
      const int it = item - 768;
      if (it < 256) retkv_item(p, smem, l, 16 + (it >> 6), (it >> 4) & 3, it & 15);
      else { const int i2 = it - 256; retkv_item(p, smem, l, i2 >> 3, (i2 >> 1) & 3, i2 & 1); }
    } else if (item < 1408) {
      const int it = item - 1152;
      const int b = it >> 4, head = (it >> 1) & 7, qh = it & 1, kvh = head >> 2;
      const int T0 = b * 256 + qh * 128;
      auto src = [&](int j, const u16*& kp, const u16*& vp, int& stride) -> bool {
        const int Tk = b * 256 + j * 64;
        kp = p.QKV + (size_t)Tk * DIN + 512 + kvh * 64; vp = p.QKV + (size_t)Tk * DIN + 640 + kvh * 64; stride = DIN;
        return true;
      };
      auto biasf = [&](int, int, int) -> float { return 0.f; };
      auto tmode = [&](int, int) -> int { return 0; };
      attn_core(smem, p.QKV + (size_t)T0 * DIN + head * 64, 4, src, biasf, tmode, p.sink[l * 8 + head] * 1.44269504f, true,
                p.CAT + (size_t)T0 * DM + head * 64);
    } else {
      const int it = item - 1408;
      const int b = it >> 3, head = (it >> 1) & 3, qh = it & 1;
      const int T0 = b * 256 + qh * 128;
      auto src = [&](int j, const u16*& kp, const u16*& vp, int& stride) -> bool {
        const int Tk = b * 256 + j * 64;
        kp = p.QKV + (size_t)Tk * DIN + 1024 + head * 64; vp = p.QKV + (size_t)Tk * DIN + 1280 + head * 64; stride = DIN;
        return true;
      };
      auto biasf = [&](int, int, int) -> float { return 0.f; };
      auto tmode = [&](int, int) -> int { return 0; };
      attn_core(smem, p.QKV + (size_t)T0 * DIN + 768 + head * 64, 4, src, biasf, tmode, NEG, false,
                p.CAT + (size_t)T0 * DM + 512 + head * 64);
    }
  }
}

DI void phase2c(const Params& p, char* smem, int l) {
  u16* sK = (u16*)smem;
  u16* sVT = sK + 128 * LDT;
  u16* sSTf = sVT + 64 * LDT2;
  u16* sSTb = sSTf + 64 * LDT;
  const int tid = otid(), lane = tid & 63, w = tid >> 6, r = lane & 31, h = lane >> 5;
  const int rq = tid >> 4, c4 = tid & 15;
  const float one4[4] = {1.f, 1.f, 1.f, 1.f};
  for (int item = blockIdx.x; item < 384; item += gridDim.x) {
    int req, head, c, nc;
    if (item < 256) { req = 16 + (item >> 6); head = (item >> 4) & 3; c = item & 15; nc = 16; }
    else { const int i2 = item - 256; req = i2 >> 3; head = (i2 >> 1) & 3; c = i2 & 1; nc = 2; }
    const bool lat = req >= 16;
    const int T0 = (lat ? NCTX + (req - 16) * 2048 : req * 256) + c * 128;
    const float lgf = ret_lg(p, l, 0, head), lgb = ret_lg(p, l, 1, head);
    const float gf = __expf(lgf * 128.f), gb = __expf(lgb * 128.f);
    __syncthreads();
    {
      const int d = tid >> 2, e0 = (tid & 3) * 16;
#pragma unroll
      for (int dir = 0; dir < 2; ++dir) {
        float s[16];
#pragma unroll
        for (int q = 0; q < 16; ++q) s[q] = 0.f;
        const float g = dir ? gb : gf;
        if (lat) {
          const float* s0 = p.state + ((size_t)(((req - 16) * 2 + l) * 2 + dir) * 4 + head) * 4096 + d * 64 + e0;
#pragma unroll
          for (int q = 0; q < 16; q += 4) {
            const float4 x = *(const float4*)(s0 + q);
            s[q] = x.x; s[q + 1] = x.y; s[q + 2] = x.z; s[q + 3] = x.w;
          }
        }
        const int nsteps = dir ? (nc - 1 - c) : c;
        for (int st = 0; st < nsteps; ++st) {
          const int cc = dir ? (nc - 1 - st) : st;
          const float* kv = p.KVS + kvs_slot(req, head, dir, cc) + d * 64 + e0;
#pragma unroll
          for (int q = 0; q < 16; q += 4) {
            const float4 x = *(const float4*)(kv + q);
            s[q] = s[q] * g + x.x; s[q + 1] = s[q + 1] * g + x.y; s[q + 2] = s[q + 2] * g + x.z; s[q + 3] = s[q + 3] * g + x.w;
          }
        }
        u16* sST = dir ? sSTb : sSTf;
#pragma unroll
        for (int q = 0; q < 16; ++q) sST[(e0 + q) * LDT + d] = (u16)(pack2(s[q], 0.f) & 0xffffu);
        if (!lat && c == 0) {
          const float* k0 = p.KVS + kvs_slot(req, head, dir, 0) + d * 64 + e0;
          const float* k1 = p.KVS + kvs_slot(req, head, dir, 1) + d * 64 + e0;
          float* o = p.out + OFF_ST + ((size_t)((req * 2 + l) * 2 + dir) * 4 + head) * 4096 + d * 64 + e0;
#pragma unroll
          for (int q = 0; q < 16; ++q) o[q] = dir ? (gb * k1[q] + k0[q]) : (gf * k0[q] + k1[q]);
        }
      }
    }
#pragma unroll
    for (int half = 0; half < 2; ++half) {
      float v[4][4];
      load4x4(p.QKV + (size_t)(T0 + half * 64) * DIN + 1792 + head * 64, DIN, false, rq, c4, v);
      store_n(sK, LDT, half * 64, rq, c4, v);
      load4x4(p.QKV + (size_t)(T0 + half * 64) * DIN + 2048 + head * 64, DIN, false, rq, c4, v);
      store_t(sVT, LDT2, half * 64, rq, c4, v, one4);
    }
    __syncthreads();
    const int qi = w * 32 + r;
    const u16* qrow = p.QKV + (size_t)(T0 + qi) * DIN + 1536 + head * 64;
    uint4 qraw[4];
#pragma unroll
    for (int ks = 0; ks < 4; ++ks) qraw[ks] = *(const uint4*)(qrow + ks * 16 + 8 * h);
    f32x16 O[2];
#pragma unroll
    for (int d = 0; d < 2; ++d)
#pragma unroll
      for (int i = 0; i < 16; ++i) O[d][i] = 0.f;
#pragma unroll 1
    for (int jt = 0; jt < 4; ++jt) {
      f32x16 S;
#pragma unroll
      for (int i = 0; i < 16; ++i) S[i] = 0.f;
#pragma unroll
      for (int ks = 0; ks < 4; ++ks) {
        const bf16x8 kf = *(const bf16x8*)&sK[(jt * 32 + r) * LDT + ks * 16 + 8 * h];
        S = MFMA(kf, __builtin_bit_cast(bf16x8, qraw[ks]), S);
      }
#pragma unroll
      for (int i = 0; i < 16; ++i) {
        const int j = jt * 32 + crow(i, h);
        const int dlt = qi - j;
        const float wgt = (dlt > 0) ? __expf(lgf * (float)dlt) : ((dlt < 0) ? __expf(lgb * (float)(-dlt)) : 2.f);
        S[i] = S[i] * 0.125f * wgt;
      }
#pragma unroll
      for (int s = 0; s < 2; ++s) {
        const bf16x8 pf = mk8(pack2(S[8 * s + 0], S[8 * s + 1]), pack2(S[8 * s + 2], S[8 * s + 3]),
                              pack2(S[8 * s + 4], S[8 * s + 5]), pack2(S[8 * s + 6], S[8 * s + 7]));
#pragma unroll
        for (int d = 0; d < 2; ++d) {
          const u16* vrow = &sVT[(d * 32 + r) * LDT2 + jt * 32 + 16 * s + 4 * h];
          const uint2 lo = *(const uint2*)vrow;
          const uint2 hi = *(const uint2*)(vrow + 8);
          O[d] = MFMA(mk8(lo.x, lo.y, hi.x, hi.y), pf, O[d]);
        }
      }
    }
    {
      const float xf = __expf(lgf * (float)(qi + 1)), xb = __expf(lgb * (float)(128 - qi));
#pragma unroll
      for (int ks = 0; ks < 4; ++ks) {
        const uint4 q = qraw[ks];
        const bf16x8 qsf = mk8(pack2(bflo(q.x) * xf, bfhi(q.x) * xf), pack2(bflo(q.y) * xf, bfhi(q.y) * xf),
                               pack2(bflo(q.z) * xf, bfhi(q.z) * xf), pack2(bflo(q.w) * xf, bfhi(q.w) * xf));
        const bf16x8 qsb = mk8(pack2(bflo(q.x) * xb, bfhi(q.x) * xb), pack2(bflo(q.y) * xb, bfhi(q.y) * xb),
                               pack2(bflo(q.z) * xb, bfhi(q.z) * xb), pack2(bflo(q.w) * xb, bfhi(q.w) * xb));
#pragma unroll
        for (int d = 0; d < 2; ++d) {
          const bf16x8 sf = *(const bf16x8*)&sSTf[(d * 32 + r) * LDT + ks * 16 + 8 * h];
          const bf16x8 sb = *(const bf16x8*)&sSTb[(d * 32 + r) * LDT + ks * 16 + 8 * h];
          O[d] = MFMA(sf, qsf, O[d]);
          O[d] = MFMA(sb, qsb, O[d]);
        }
      }
    }
    float sum = 0.f;
#pragma unroll
    for (int d = 0; d < 2; ++d)
#pragma unroll
      for (int i = 0; i < 16; ++i) sum += O[d][i];
    sum += __shfl_xor(sum, 32);
    const float mu = sum * (1.f / 64.f);
    float vs = 0.f;
#pragma unroll
    for (int d = 0; d < 2; ++d)
#pragma unroll
      for (int i = 0; i < 16; ++i) { const float t = O[d][i] - mu; vs += t * t; }
    vs += __shfl_xor(vs, 32);
    const float rstd = rsqrtf(vs * (1.f / 64.f) + 1e-6f);
    const u16* grow = p.QKV + (size_t)(T0 + qi) * DIN + 2304 + head * 64;
    const float* gnw = p.gn + l * 256 + head * 64;
    u16* orow = p.CAT + (size_t)(T0 + qi) * DM + 768 + head * 64;
#pragma unroll
    for (int d = 0; d < 2; ++d)
#pragma unroll
      for (int g = 0; g < 4; ++g) {
        const int e = d * 32 + 8 * g + 4 * h;
        const uint2 gr = *(const uint2*)(grow + e);
        const float4 gw = *(const float4*)(gnw + e);
        const float o0 = silu(bflo(gr.x)) * (O[d][4 * g + 0] - mu) * rstd * gw.x;
        const float o1 = silu(bfhi(gr.x)) * (O[d][4 * g + 1] - mu) * rstd * gw.y;
        const float o2 = silu(bflo(gr.y)) * (O[d][4 * g + 2] - mu) * rstd * gw.z;
        const float o3 = silu(bfhi(gr.y)) * (O[d][4 * g + 3] - mu) * rstd * gw.w;
        uint2 pk = {pack2(o0, o1), pack2(o2, o3)};
        *(uint2*)(orow + e) = pk;
      }
  }
}

DI void phase3(const Params& p, char* smem, int l, const float* xc, const float* xl) {
  const float* W = p.w_out + (size_t)l * DM * DM;
  u16* PREB = (u16*)p.PRE;
  const int xcd = blockIdx.x & 7, nloc = gridDim.x >> 3;
  auto setup = [&](int s, int ar0, int ac, int n4, int kq, const u16*& ab, unsigned& o0, unsigned& o1, unsigned& o2, unsigned& o3, const float*& bb, unsigned& bo) {
    const int tm = 6 * xcd + s % 6, tn = s / 6;
    ab = p.CAT + (size_t)tm * 256 * DM;
    o0 = (unsigned)(ar0 * DM + ac); o1 = o0 + 64u * DM; o2 = o0 + 128u * DM; o3 = o0 + 192u * DM;
    bb = W + tn * 128;
    bo = (unsigned)(4 * n4 + kq * 4 * DM);
  };
  auto epi = [&](int s, f32x16(&acc)[2][4], int w, int r, int h) {
    int hq = h;
    asm volatile("" : "+v"(hq));
    const int tm = 6 * xcd + s % 6, tn = s / 6;
    const int m0 = tm * 256, n0 = tn * 128;
    const float* g1 = p.MOD + (size_t)(l * 5 + cond_of(m0)) * 6144 + 2048 + n0 + 4 * r;
    const float g0 = g1[0], g1v = g1[1], g2 = g1[2], g3 = g1[3];
#pragma unroll
    for (int mt = 0; mt < 2; ++mt)
#pragma unroll
    for (int i = 0; i < 16; ++i) {
      const int ml = w * 64 + mt * 32 + crow(i, hq);
      uint2 pk = {pack2(g0 * acc[mt][0][i], g1v * acc[mt][1][i]), pack2(g2 * acc[mt][2][i], g3 * acc[mt][3][i])};
      *(uint2*)(PREB + (size_t)(m0 + ml) * DM + n0 + 4 * r) = pk;
      if ((i & 3) == 3) __builtin_amdgcn_sched_barrier(0);
    }
  };
  gemm_phase<true>(smem, blockIdx.x >> 3, 48, nloc, setup, DM, epi, [](int, int) {});
}

DI void phase4(const Params& p, char* smem, int l, const float* xc, const float* xl) {
  float* swr = (float*)smem;
  const int tid = otid(), lane = tid & 63, w = tid >> 6;
  __syncthreads();
  for (int idx = tid; idx < 4096; idx += 256) {
    const float4 x = *(const float4*)(p.w_router + (size_t)l * DM * 16 + idx * 4);
    const int k = idx >> 2, e = (idx & 3) * 4;
    swr[(e + 0) * DM + k] = x.x; swr[(e + 1) * DM + k] = x.y; swr[(e + 2) * DM + k] = x.z; swr[(e + 3) * DM + k] = x.w;
  }
  __syncthreads();
  const float* lg = p.ln1g + l * DM;
  const float* lb = p.ln1b + l * DM;
  const int rstride = gridDim.x * 4;
  uint2 nprb[4];
  float4 nxi[4];
  {
    const int T0 = blockIdx.x * 4 + w;
    if (T0 < NTOK) {
      const float* xr0 = (T0 < NCTX) ? (xc + (size_t)T0 * DM) : (xl + (size_t)(T0 - NCTX) * DM);
#pragma unroll
      for (int i = 0; i < 4; ++i) {
        nprb[i] = *(const uint2*)((const u16*)p.PRE + (size_t)T0 * DM + 256 * i + 4 * lane);
        nxi[i] = *(const float4*)(xr0 + 256 * i + 4 * lane);
      }
    }
  }
  for (int T = blockIdx.x * 4 + w; T < NTOK; T += rstride) {
    const float* mod = p.MOD + (size_t)(l * 5 + cond_of(T)) * 6144;
    float4 x[4];
    float s = 0.f;
#pragma unroll
    for (int i = 0; i < 4; ++i) {
      const uint2 prb = nprb[i];
      const float4 xi = nxi[i];
      const float4 pr = {bflo(prb.x), bfhi(prb.x), bflo(prb.y), bfhi(prb.y)};
      x[i].x = ALPHA * xi.x + pr.x; x[i].y = ALPHA * xi.y + pr.y; x[i].z = ALPHA * xi.z + pr.z; x[i].w = ALPHA * xi.w + pr.w;
      s += x[i].x + x[i].y + x[i].z + x[i].w;
    }
    {
      const int Tn = T + rstride;
      if (Tn < NTOK) {
        const float* xrn = (Tn < NCTX) ? (xc + (size_t)Tn * DM) : (xl + (size_t)(Tn - NCTX) * DM);
#pragma unroll
        for (int i = 0; i < 4; ++i) {
          nprb[i] = *(const uint2*)((const u16*)p.PRE + (size_t)Tn * DM + 256 * i + 4 * lane);
          nxi[i] = *(const float4*)(xrn + 256 * i + 4 * lane);
        }
      }
    }
    const float mu = wave_sum(s) * (1.f / 1024.f);
    float vs = 0.f;
#pragma unroll
    for (int i = 0; i < 4; ++i) {
      x[i].x -= mu; x[i].y -= mu; x[i].z -= mu; x[i].w -= mu;
      vs += x[i].x * x[i].x + x[i].y * x[i].y + x[i].z * x[i].z + x[i].w * x[i].w;
    }
    const float rstd = rsqrtf(wave_sum(vs) * (1.f / 1024.f) + 1e-6f);
#pragma unroll
    for (int i = 0; i < 4; ++i) {
      const int k = 256 * i + 4 * lane;
      const float4 g = *(const float4*)(lg + k), bb = *(const float4*)(lb + k);
      float4 y;
      y.x = x[i].x * rstd * g.x + bb.x; y.y = x[i].y * rstd * g.y + bb.y; y.z = x[i].z * rstd * g.z + bb.z; y.w = x[i].w * rstd * g.w + bb.w;
      *(float4*)(p.X + (size_t)T * DM + k) = y;
      const float4 sc = *(const float4*)(mod + 4096 + k), sh = *(const float4*)(mod + 3072 + k);
      float4 hh;
      hh.x = y.x * (1.f + sc.x) + sh.x; hh.y = y.y * (1.f + sc.y) + sh.y; hh.z = y.z * (1.f + sc.z) + sh.z; hh.w = y.w * (1.f + sc.w) + sh.w;
      uint2 pk = {pack2(hh.x, hh.y), pack2(hh.z, hh.w)};
      *(uint2*)(p.H2 + (size_t)T * DM + k) = pk;
      x[i] = hh;
    }
    float a16[16];
#pragma unroll
    for (int e = 0; e < 16; ++e) {
      float a = 0.f;
#pragma unroll
      for (int i = 0; i < 4; ++i) {
        const float4 wv = *(const float4*)(swr + e * DM + 256 * i + 4 * lane);
        a += x[i].x * wv.x + x[i].y * wv.y + x[i].z * wv.z + x[i].w * wv.w;
      }
      a16[e] = a;
      if ((e & 3) == 3) __builtin_amdgcn_sched_barrier(0);
    }
    float a8[8], a4[4], a2[2], a1;
    {
      const bool hi = (lane & 32) != 0;
#pragma unroll
      for (int j = 0; j < 8; ++j) {
        const float snd = hi ? a16[j] : a16[8 + j];
        const float kp = hi ? a16[8 + j] : a16[j];
        a8[j] = kp + __shfl_xor(snd, 32);
      }
    }
    {
      const bool hi = (lane & 16) != 0;
#pragma unroll
      for (int j = 0; j < 4; ++j) {
        const float snd = hi ? a8[j] : a8[4 + j];
        const float kp = hi ? a8[4 + j] : a8[j];
        a4[j] = kp + __shfl_xor(snd, 16);
      }
    }
    {
      const bool hi = (lane & 8) != 0;
#pragma unroll
      for (int j = 0; j < 2; ++j) {
        const float snd = hi ? a4[j] : a4[2 + j];
        const float kp = hi ? a4[2 + j] : a4[j];
        a2[j] = kp + __shfl_xor(snd, 8);
      }
    }
    {
      const bool hi = (lane & 4) != 0;
      const float snd = hi ? a2[0] : a2[1];
      const float kp = hi ? a2[1] : a2[0];
      a1 = kp + __shfl_xor(snd, 4);
    }
    a1 += __shfl_xor(a1, 2);
    a1 += __shfl_xor(a1, 1);
    const int myexp = ((lane >> 5) & 1) * 8 + ((lane >> 4) & 1) * 4 + ((lane >> 3) & 1) * 2 + ((lane >> 2) & 1);
    float mx = a1;
#pragma unroll
    for (int o = 32; o >= 4; o >>= 1) mx = fmaxf(mx, __shfl_xor(mx, o));
    const float ex = __expf(a1 - mx);
    float den = ex;
#pragma unroll
    for (int o = 32; o >= 4; o >>= 1) den += __shfl_xor(den, o);
    if ((lane & 3) == 0) { p.AFF[(size_t)T * 16 + myexp] = ex / den; p.INV[(size_t)T * 16 + myexp] = -1; }
  }
}

DI unsigned block_incl_scan(unsigned v, unsigned* wsum, int lane, int w, unsigned& total) {
#pragma unroll
  for (int o = 1; o < 64; o <<= 1) {
    const unsigned t = __shfl_up(v, o);
    if (lane >= o) v += t;
  }
  __syncthreads();
  if (lane == 63) wsum[w] = v;
  __syncthreads();
  unsigned off = 0;
  total = 0;
#pragma unroll
  for (int i = 0; i < 4; ++i) {
    const unsigned s = wsum[i];
    if (i < w) off += s;
    total += s;
  }
  return v + off;
}

DI void phase5(const Params& p, char* smem) {
  unsigned* hist = (unsigned*)smem;
  unsigned* wsum = hist + 256;
  unsigned* bc = wsum + 4;
  const int tid = otid(), lane = tid & 63, w = tid >> 6;
  for (int item = blockIdx.x; item < 320; item += gridDim.x) {
    int n, base, e, cap, rowbase;
    if (item < 64) {
      const int b = item >> 4; e = item & 15;
      n = 2048; base = NCTX + b * 2048; cap = 256; rowbase = 512 + b * 256;
    } else {
      const int it = item - 64; const int rq = it >> 4; e = it & 15;
      n = 256; base = rq * 256; cap = 32; rowbase = rq * 32;
    }
    const int per = n >> 8;
    unsigned key[8];
#pragma unroll
    for (int q = 0; q < 8; ++q) key[q] = (q < per) ? __float_as_uint(p.AFF[(size_t)(base + tid * per + q) * 16 + e]) : 0u;
    unsigned prefix = 0u, mask = 0u;
    unsigned remaining = (unsigned)cap;
#pragma unroll 1
    for (int pass = 3; pass >= 0; --pass) {
      const int shift = pass * 8;
      __syncthreads();
      hist[tid] = 0u;
      __syncthreads();
#pragma unroll
      for (int q = 0; q < 8; ++q)
        if (q < per && (key[q] & mask) == prefix) atomicAdd(&hist[(key[q] >> shift) & 255u], 1u);
      __syncthreads();
      const unsigned hv = hist[tid];
      unsigned total;
      const unsigned incl = block_incl_scan(hv, wsum, lane, w, total);
      const unsigned above = total - incl;
      if (above < remaining && remaining <= above + hv) { bc[0] = (unsigned)tid; bc[1] = remaining - above; }
      __syncthreads();
      const unsigned bsel = bc[0];
      remaining = bc[1];
      prefix |= bsel << shift;
      mask |= 0xFFu << shift;
    }
    const unsigned thr = prefix;
    unsigned ceq = 0u;
#pragma unroll
    for (int q = 0; q < 8; ++q) ceq += (q < per && key[q] == thr) ? 1u : 0u;
    unsigned tot;
    unsigned eq_before = block_incl_scan(ceq, wsum, lane, w, tot) - ceq;
    unsigned selmask = 0u, nsel = 0u;
#pragma unroll
    for (int q = 0; q < 8; ++q) {
      if (q < per) {
        const bool eq = key[q] == thr;
        const bool sel = (key[q] > thr) || (eq && eq_before < remaining);
        eq_before += eq ? 1u : 0u;
        selmask |= sel ? (1u << q) : 0u;
        nsel += sel ? 1u : 0u;
      }
    }
    unsigned row = block_incl_scan(nsel, wsum, lane, w, tot) - nsel;
#pragma unroll
    for (int q = 0; q < 8; ++q) {
      if (q < per && ((selmask >> q) & 1u)) {
        const int tok = base + tid * per + q;
        const int rr = e * NROWS_E + rowbase + (int)row;
        p.SELTOK[rr] = tok;
        p.SELGATE[rr] = __uint_as_float(key[q]);
        p.INV[(size_t)tok * 16 + e] = rr;
        ++row;
      }
    }
  }
}

DI void phase6(const Params& p, char* smem, int l) {
  const int xcd = blockIdx.x & 7, nloc = gridDim.x >> 3;
  auto setup = [&](int s, int ar0, int ac, int n4, int kq, const u16*& ab, unsigned& o0, unsigned& o1, unsigned& o2, unsigned& o3, const float*& bb, unsigned& bo) {
    const int e = 2 * xcd + s / 96, rem = s % 96, tn = rem / 6, tm = rem % 6;
    const int* tok = p.SELTOK + e * NROWS_E + tm * 256 + ar0;
    ab = p.H2;
    o0 = (unsigned)(tok[0] * DM + ac); o1 = (unsigned)(tok[64] * DM + ac);
    o2 = (unsigned)(tok[128] * DM + ac); o3 = (unsigned)(tok[192] * DM + ac);
    bb = p.w_gu + ((size_t)l * 16 + e) * DM * 2048 + tn * 64;
    bo = (unsigned)(((n4 >> 4) & 1) * 1024 + 4 * (n4 & 15) + kq * 4 * 2048);
  };
  auto epi = [&](int s, f32x16(&acc)[2][4], int w, int r, int h) {
    int hq = h;
    asm volatile("" : "+v"(hq));
    const int e = 2 * xcd + s / 96, rem = s % 96, tn = rem / 6, tm = rem % 6;
    const int m0 = tm * 256, f0 = tn * 64;
    u16* act = p.ACT + ((size_t)e * NROWS_E + m0) * DM;
#pragma unroll
    for (int mt = 0; mt < 2; ++mt)
#pragma unroll
    for (int i = 0; i < 16; ++i) {
      const int ml = w * 64 + mt * 32 + crow(i, hq);
      const float a0 = acc[mt][0][i], a1 = acc[mt][1][i], a2 = acc[mt][2][i], a3 = acc[mt][3][i];
      const bool lo = r < 16;
      const float s0 = lo ? a2 : a0, s1 = lo ? a3 : a1;
      const float r0 = __shfl_xor(s0, 16), r1 = __shfl_xor(s1, 16);
      const float g0 = lo ? a0 : r0, g1 = lo ? a1 : r1;
      const float v0 = lo ? r0 : a2, v1 = lo ? r1 : a3;
      *(unsigned*)(act + (size_t)ml * DM + f0 + 4 * (r & 15) + (lo ? 0 : 2)) = pack2(silu(g0) * v0, silu(g1) * v1);
      if ((i & 3) == 3) __builtin_amdgcn_sched_barrier(0);
    }
  };
  gemm_phase<false>(smem, blockIdx.x >> 3, 192, nloc, setup, 2048, epi, [](int, int) {});
}

DI void phase7(const Params& p, char* smem, int l, u16* FF) {
  const int xcd = blockIdx.x & 7, nloc = gridDim.x >> 3;
  auto setup = [&](int s, int ar0, int ac, int n4, int kq, const u16*& ab, unsigned& o0, unsigned& o1, unsigned& o2, unsigned& o3, const float*& bb, unsigned& bo) {
    const int e = 2 * xcd + s / 48, rem = s % 48, tn = rem / 6, tm = rem % 6;
    ab = p.ACT + ((size_t)e * NROWS_E + tm * 256) * DM;
    o0 = (unsigned)(ar0 * DM + ac); o1 = o0 + 64u * DM; o2 = o0 + 128u * DM; o3 = o0 + 192u * DM;
    bb = p.w_down + ((size_t)l * 16 + e) * DM * DM + tn * 128;
    bo = (unsigned)(4 * n4 + kq * 4 * DM);
  };
  float* sG = (float*)(smem + 61440);
  int par = 1;
  auto pre = [&](int s, int tid) {
    par ^= 1;
    const int e = 2 * xcd + s / 48, rem = s % 48, tm = rem % 6;
    sG[par * 256 + tid] = p.SELGATE[e * NROWS_E + tm * 256 + tid];
  };
  auto epi = [&](int s, f32x16(&acc)[2][4], int w, int r, int h) {
    int hq = h;
    asm volatile("" : "+v"(hq));
    const int e = 2 * xcd + s / 48, rem = s % 48, tn = rem / 6, tm = rem % 6;
    const int m0 = tm * 256, n0 = tn * 128;
#pragma unroll
    for (int mt = 0; mt < 2; ++mt)
#pragma unroll
    for (int i = 0; i < 16; ++i) {
      const int ml = w * 64 + mt * 32 + crow(i, hq);
      const float g = sG[par * 256 + ml];
      uint2 pk = {pack2(g * acc[mt][0][i], g * acc[mt][1][i]), pack2(g * acc[mt][2][i], g * acc[mt][3][i])};
      *(uint2*)(FF + ((size_t)e * NROWS_E + m0 + ml) * DM + n0 + 4 * r) = pk;
      if ((i & 3) == 3) __builtin_amdgcn_sched_barrier(0);
    }
  };
  gemm_phase<true>(smem, blockIdx.x >> 3, 96, nloc, setup, DM, epi, pre);
}

DI void phase8(const Params& p, int l, float* dst, bool write_h) {
  const int tid = otid(), lane = tid & 63, w = tid >> 6;
  const float* lg = p.ln2g + l * DM;
  const float* lb = p.ln2b + l * DM;
  const int rstride = gridDim.x * 4;
  float4 nxa[4];
  int ninv = -1;
  {
    const int T0 = blockIdx.x * 4 + w;
    if (T0 < NTOK) {
#pragma unroll
      for (int i = 0; i < 4; ++i) nxa[i] = *(const float4*)(p.X + (size_t)T0 * DM + 256 * i + 4 * lane);
      ninv = (lane < 16) ? p.INV[(size_t)T0 * 16 + lane] : -1;
    }
  }
  for (int T = blockIdx.x * 4 + w; T < NTOK; T += rstride) {
    const float* g2 = p.MOD + (size_t)(l * 5 + cond_of(T)) * 6144 + 5120;
    const float* modn = p.MOD + (size_t)(5 + cond_of(T)) * 6144;
    float4 x[4], ff[4], xa[4];
#pragma unroll
    for (int i = 0; i < 4; ++i) { ff[i] = make_float4(0.f, 0.f, 0.f, 0.f); xa[i] = nxa[i]; }
    const int myinv = ninv;
    {
      const int Tn = T + rstride;
      if (Tn < NTOK) {
#pragma unroll
        for (int i = 0; i < 4; ++i) nxa[i] = *(const float4*)(p.X + (size_t)Tn * DM + 256 * i + 4 * lane);
        ninv = (lane < 16) ? p.INV[(size_t)Tn * 16 + lane] : -1;
      }
    }
    unsigned long long sel = __ballot(myinv >= 0);
#pragma unroll 1
    while (sel) {
      int rows[4];
#pragma unroll
      for (int q = 0; q < 4; ++q) {
        if (sel) {
          const int e = __ffsll((long long)sel) - 1;
          sel &= sel - 1;
          rows[q] = __shfl(myinv, e);
        } else {
          rows[q] = -1;
        }
      }
      uint2 y[4][4];
#pragma unroll
      for (int q = 0; q < 4; ++q) {
        const u16* yr = p.YE + (size_t)(rows[q] >= 0 ? rows[q] : 0) * DM + 4 * lane;
#pragma unroll
        for (int i = 0; i < 4; ++i) y[q][i] = *(const uint2*)(yr + 256 * i);
      }
#pragma unroll
      for (int q = 0; q < 4; ++q) {
        const float wq = rows[q] >= 0 ? 1.f : 0.f;
#pragma unroll
        for (int i = 0; i < 4; ++i) {
          ff[i].x += wq * bflo(y[q][i].x); ff[i].y += wq * bfhi(y[q][i].x); ff[i].z += wq * bflo(y[q][i].y); ff[i].w += wq * bfhi(y[q][i].y);
        }
      }
    }
    float s = 0.f;
#pragma unroll
    for (int i = 0; i < 4; ++i) {
      const int k = 256 * i + 4 * lane;
      const float4 a = xa[i];
      const float4 f = ff[i];
      const float4 g = *(const float4*)(g2 + k);
      x[i].x = ALPHA * a.x + g.x * f.x; x[i].y = ALPHA * a.y + g.y * f.y; x[i].z = ALPHA * a.z + g.z * f.z; x[i].w = ALPHA * a.w + g.w * f.w;
      s += x[i].x + x[i].y + x[i].z + x[i].w;
    }
    const float mu = wave_sum(s) * (1.f / 1024.f);
    float vs = 0.f;
#pragma unroll
    for (int i = 0; i < 4; ++i) {
      x[i].x -= mu; x[i].y -= mu; x[i].z -= mu; x[i].w -= mu;
      vs += x[i].x * x[i].x + x[i].y * x[i].y + x[i].z * x[i].z + x[i].w * x[i].w;
    }
    const float rstd = rsqrtf(wave_sum(vs) * (1.f / 1024.f) + 1e-6f);
#pragma unroll
    for (int i = 0; i < 4; ++i) {
      const int k = 256 * i + 4 * lane;
      const float4 g = *(const float4*)(lg + k), bb = *(const float4*)(lb + k);
      float4 y;
      y.x = x[i].x * rstd * g.x + bb.x; y.y = x[i].y * rstd * g.y + bb.y; y.z = x[i].z * rstd * g.z + bb.z; y.w = x[i].w * rstd * g.w + bb.w;
      *(float4*)(dst + (size_t)T * DM + k) = y;
      if (write_h) {
        const float4 sc = *(const float4*)(modn + 1024 + k), sh = *(const float4*)(modn + k);
        uint2 pk = {pack2(y.x * (1.f + sc.x) + sh.x, y.y * (1.f + sc.y) + sh.y), pack2(y.z * (1.f + sc.z) + sh.z, y.w * (1.f + sc.w) + sh.w)};
        *(uint2*)(p.H2 + (size_t)T * DM + k) = pk;
      }
    }
  }
}

constexpr int kDynLds = 73728;
__global__ void __launch_bounds__(256, 2) mega(Params p) {
  extern __shared__ __attribute__((aligned(16))) char smem[];
  cg::grid_group grid = cg::this_grid();
  if (p.never) grid.sync();
  GBar gb;
  gb.bar = p.BAR; gb.x = xb_xcc_id(); gb.nloc = 0u; gb.nx = 0u;
  if (threadIdx.x == 0) (void)xb_add(&p.BAR[XB_XCNT(gb.x)], 1u);
  phase0(p, smem);
  gbar(gb);
  phase0b(p);
  gbar(gb);
#pragma unroll 1
  for (int l = 0; l < 2; ++l) {
    const float* xc = (l == 0) ? p.x_prompt : p.X;
    const float* xl = (l == 0) ? p.x_sample : (p.X + (size_t)NCTX * DM);
    phase1(p, smem, l);
    gbar(gb);
    if (PROBE == 1) { phase1(p, smem, l); gbar(gb); }
    phase2(p, smem, l);
    gbar(gb);
    if (PROBE == 3) { phase2(p, smem, l); gbar(gb); }
    phase2c(p, smem, l);
    gbar(gb);
    if (PROBE == 3) { phase2c(p, smem, l); gbar(gb); }
    phase3(p, smem, l, xc, xl);
    gbar(gb);
    if (PROBE == 1) { phase3(p, smem, l, xc, xl); gbar(gb); }
    phase4(p, smem, l, xc, xl);
    gbar(gb);
    phase5(p, smem);
    gbar(gb);
    phase6(p, smem, l);
    gbar(gb);
    if (PROBE == 1) { phase6(p, smem, l); gbar(gb); }
    phase7(p, smem, l, p.YE);
    gbar(gb);
    phase8(p, l, (l == 1) ? p.out : p.X, l == 0);
    if (l == 0) gbar(gb);
  }
}

extern "C" void kernel_launch(void* const* d_in, const int* in_sizes, int n_in, void* d_out, int out_size, void* d_ws,
                              size_t ws_size, hipStream_t stream) {
  static int grid_blocks = 0;
  if (!grid_blocks) {
    int dev = 0, cus = 0, per_cu = 0;
    hipGetDevice(&dev);
    hipDeviceGetAttribute(&cus, hipDeviceAttributeMultiprocessorCount, dev);
    hipFuncSetAttribute((const void*)mega, hipFuncAttributeMaxDynamicSharedMemorySize, kDynLds);
    hipOccupancyMaxActiveBlocksPerMultiprocessor(&per_cu, mega, 256, kDynLds);
    if (per_cu > 2) per_cu = 2;
    if (per_cu < 1) per_cu = 1;
    grid_blocks = cus * per_cu;
  }
  Params p{};
  const float** pf = (const float**)&p;
  for (int i = 0; i < 24; ++i) pf[i] = (const float*)d_in[i];
  p.out = (float*)d_out;
  char* ws = (char*)d_ws;
  size_t off = 0;
  auto take = [&](size_t bytes) { char* q = ws + off; off += (bytes + 255) & ~(size_t)255; return q; };
  p.MOD = (float*)take(2 * 5 * 6144 * 4);
  p.BAR = (unsigned*)take(XCD_BAR_WORDS * 4);
  p.ROPE = (float*)take(2048 * 4);
  p.X = (float*)take((size_t)NTOK * DM * 4);
  p.PRE = (float*)take((size_t)NTOK * DM * 4);
  p.KVS = (float*)take((size_t)20 * 4 * 2 * 16 * 4096 * 4);
  p.AFF = (float*)take((size_t)NTOK * 16 * 4);
  p.SELGATE = (float*)take((size_t)16 * NROWS_E * 4);
  p.SELTOK = (int*)take((size_t)16 * NROWS_E * 4);
  p.QKV = (u16*)take((size_t)NTOK * DIN * 2);
  p.CAT = (u16*)take((size_t)NTOK * DM * 2);
  p.H2 = (u16*)take((size_t)NTOK * DM * 2);
  p.ACT = (u16*)take((size_t)16 * NROWS_E * DM * 2);
  p.YE = (u16*)take((size_t)16 * NROWS_E * DM * 2);
  p.INV = (int*)take((size_t)NTOK * 16 * 4);
  p.CAK = (u16*)take((size_t)4 * 2 * 512 * 128 * 2);
  p.CAV = (u16*)take((size_t)4 * 2 * 512 * 128 * 2);
  p.CBK = (u16*)take((size_t)4 * 2 * 512 * 256 * 2);
  p.CBV = (u16*)take((size_t)4 * 2 * 512 * 256 * 2);
  p.never = 0;
  hipMemsetAsync(p.MOD, 0, (size_t)((char*)p.BAR - (char*)p.MOD) + XCD_BAR_WORDS * 4, stream);
  void* args[] = {&p};
  hipError_t e = hipLaunchCooperativeKernel((void*)mega, dim3(grid_blocks), dim3(256), args, kDynLds, stream);
  if (e != hipSuccess) fprintf(stderr, "cooperative launch failed: %s (grid %d)\n", hipGetErrorString(e), grid_blocks);
}
```

```cpp
#include <hip/hip_runtime.h>
#include <hip/hip_cooperative_groups.h>
#include <cstdio>
namespace cg = cooperative_groups;

#define DI __device__ __forceinline__
typedef short bf16x8 __attribute__((ext_vector_type(8)));
typedef float f32x16 __attribute__((ext_vector_type(16)));
typedef __bf16 bf2_t __attribute__((ext_vector_type(2)));
typedef float f2_t __attribute__((ext_vector_type(2)));
typedef unsigned short u16;
typedef unsigned u32x4 __attribute__((ext_vector_type(4)));
typedef float f32x4 __attribute__((ext_vector_type(4)));
typedef float f32x2 __attribute__((ext_vector_type(2)));

#define MFMA(a, b, c) __builtin_amdgcn_mfma_f32_32x32x16_bf16((a), (b), (c), 0, 0, 0)

#define PROBE 0
constexpr int NTOK = 12288;
constexpr int NCTX = 4096;
constexpr int DM = 1024;
constexpr int DIN = 2560;
constexpr int LDT = 72;
constexpr int LDT2 = 136;
constexpr int NROWS_E = 1536;
constexpr float NEG = -1e30f;
constexpr float ALPHA = 1.41421356237f;

constexpr size_t OFF_AK = 12582912, OFF_AV = 13631488, OFF_BK = 14680064, OFF_BV = 16777216, OFF_ST = 18874368;

struct Params {
  const float *x_prompt, *x_sample, *cak, *cav, *cbk, *cbv, *state, *c, *c_ctx, *w_ada, *b_ada, *w_in, *w_out, *sink, *rpb,
      *decay, *gn, *ln1g, *ln1b, *ln2g, *ln2b, *w_router, *w_gu, *w_down;
  float* out;
  float *MOD, *ROPE, *X, *PRE, *KVS, *AFF, *SELGATE;
  int* SELTOK;
  u16 *QKV, *CAT, *H2, *ACT, *CAK, *CAV, *CBK, *CBV;
  u16* YE;
  int* INV;
  unsigned* BAR;
  long never;
};

DI unsigned pack2(float a, float b) {
  f2_t v = {a, b};
  bf2_t r = __builtin_convertvector(v, bf2_t);
  return __builtin_bit_cast(unsigned, r);
}
DI int otid() { int x = threadIdx.x; asm volatile("" : "+v"(x)); return x; }
DI float bflo(unsigned u) { return __uint_as_float(u << 16); }
DI float bfhi(unsigned u) { return __uint_as_float(u & 0xffff0000u); }
DI int crow(int i, int h) { return (i & 3) + 8 * (i >> 2) + 4 * h; }
DI float silu(float x) { return x * __builtin_amdgcn_rcpf(1.f + __expf(-x)); }
DI float wave_sum(float v) {
#pragma unroll
  for (int o = 32; o >= 1; o >>= 1) v += __shfl_xor(v, o);
  return v;
}
DI bf16x8 mk8(unsigned a, unsigned b, unsigned c, unsigned d) {
  uint4 u = {a, b, c, d};
  return __builtin_bit_cast(bf16x8, u);
}


#define XB_TMO 128
#define XB_XCNT(j) (256 + 64 * (j))
#define XB_XSUB(j) (1280 + 64 * (j))
#define XB_XGEN(j) (2304 + 64 * (j))
#define XB_TOP 3328
#define XB_TOPGEN 3392
#define XCD_BAR_WORDS 3456
#define XB_SPIN_CAP (1u << 20)
DI unsigned xb_ld(unsigned* p) { return __hip_atomic_load(p, __ATOMIC_RELAXED, __HIP_MEMORY_SCOPE_AGENT); }
DI unsigned xb_add(unsigned* p, unsigned v) { return __hip_atomic_fetch_add(p, v, __ATOMIC_RELAXED, __HIP_MEMORY_SCOPE_AGENT); }
DI unsigned xb_xcc_id() { return (unsigned)__builtin_amdgcn_s_getreg((3 << 11) | 20) & 0xFu; }
#define XB_SPIN(cond, bar)                                                            \
  do {                                                                                \
    unsigned _sp = 0;                                                                 \
    while (cond) {                                                                    \
      __builtin_amdgcn_s_sleep(1);                                                    \
      if ((++_sp & 255u) == 0u) {                                                     \
        if (xb_ld(&(bar)[XB_TMO])) break;                                             \
        if (_sp > XB_SPIN_CAP) { atomicAdd(&(bar)[XB_TMO], 1u); break; }              \
      }                                                                               \
    }                                                                                 \
  } while (0)
struct GBar { unsigned* bar; unsigned x, nloc, nx; };
DI void gbar_complete(unsigned* bar, unsigned x, unsigned& nloc, unsigned& nx) {
  const unsigned G = gridDim.x;
  unsigned sum, cnt, mine, sp = 0u;
  for (;;) {
    sum = 0u; cnt = 0u; mine = 0u;
#pragma unroll
    for (unsigned j = 0; j < 16; ++j) {
      const unsigned c = xb_ld(&bar[XB_XCNT(j)]);
      sum += c; cnt += (c > 0u) ? 1u : 0u; mine = (j == x) ? c : mine;
    }
    if (sum == G) break;
    __builtin_amdgcn_s_sleep(1);
    if ((++sp & 255u) == 0u) {
      if (xb_ld(&bar[XB_TMO])) break;
      if (sp > XB_SPIN_CAP) { atomicAdd(&bar[XB_TMO], 1u); break; }
    }
  }
  nloc = mine > 0u ? mine : 1u;
  nx = cnt > 0u ? cnt : 1u;
}
DI void gbar(GBar& b) {
  asm volatile("s_waitcnt vmcnt(0)" ::: "memory");
  __syncthreads();
  if (threadIdx.x == 0) {
    unsigned* bar = b.bar;
    __builtin_amdgcn_s_waitcnt(0);
    if (b.nloc == 0u) gbar_complete(bar, b.x, b.nloc, b.nx);
    const unsigned nloc = b.nloc, nx = b.nx;
    const unsigned old = xb_add(&bar[XB_XSUB(b.x)], 1u);
    const unsigned gen = old / nloc;
    if (old + 1u == (gen + 1u) * nloc) {
      __builtin_amdgcn_fence(__ATOMIC_RELEASE, "agent");
      asm volatile("s_waitcnt vmcnt(0)" ::: "memory");
      const unsigned og = xb_add(&bar[XB_TOP], 1u);
      const unsigned tg = og / nx;
      if (og + 1u == (tg + 1u) * nx) xb_add(&bar[XB_TOPGEN], 1u);
      else XB_SPIN(xb_ld(&bar[XB_TOPGEN]) == tg, bar);
      __builtin_amdgcn_fence(__ATOMIC_ACQUIRE, "agent");
      xb_add(&bar[XB_XGEN(b.x)], 1u);
      asm volatile("s_waitcnt vmcnt(0)" ::: "memory");
    } else {
      XB_SPIN(xb_ld(&bar[XB_XGEN(b.x)]) == gen, bar);
      __builtin_amdgcn_fence(__ATOMIC_ACQUIRE, "agent");
      asm volatile("s_waitcnt vmcnt(0)" ::: "memory");
    }
  }
  __syncthreads();
}

template <class Setup, class Epi>
DI void gemm_phase128(char* smem, int s0, int s_end, int s_step, Setup setup, int ldb, Epi epi) {
  if (s0 >= s_end) return;
  u16* sA0 = (u16*)smem;
  u16* sB0 = sA0 + 128 * LDT;
  u16* sA1 = sB0 + 128 * LDT;
  u16* sB1 = sA1 + 128 * LDT;
  const int tid = otid(), lane = tid & 63, w = tid >> 6, r = lane & 31, h = lane >> 5;
  const int a_r0 = tid >> 3, a_c = (tid & 7) * 8;
  const int b_n4 = tid & 31, b_kq = tid >> 5;
  const u16 *apb0, *apb1, *apb2, *apb3;
  const float* bp;
  setup(s0, a_r0, a_c, b_n4, b_kq, apb0, apb1, apb2, apb3, bp);

  u32x4 pa0, pa1, pa2, pa3;
  f32x4 pb[8];

#define G_LOAD(KT)                                                                       \
  {                                                                                      \
    const int k0_ = (KT) * 64;                                                           \
    pa0 = *(const u32x4*)(apb0 + k0_);                                                   \
    pa1 = *(const u32x4*)(apb1 + k0_);                                                   \
    pa2 = *(const u32x4*)(apb2 + k0_);                                                   \
    pa3 = *(const u32x4*)(apb3 + k0_);                                                   \
    _Pragma("unroll") for (int i_ = 0; i_ < 8; ++i_) pb[i_] = *(const f32x4*)(bp + (size_t)(k0_ + i_) * ldb); \
  }
#define G_STAGE(SA, SBB)                                                                 \
  {                                                                                      \
    *(u32x4*)&SA[(a_r0)*LDT + a_c] = pa0;                                                \
    *(u32x4*)&SA[(a_r0 + 32) * LDT + a_c] = pa1;                                         \
    *(u32x4*)&SA[(a_r0 + 64) * LDT + a_c] = pa2;                                         \
    *(u32x4*)&SA[(a_r0 + 96) * LDT + a_c] = pa3;                                         \
    _Pragma("unroll") for (int j_ = 0; j_ < 4; ++j_) {                                   \
      u32x4 pk_;                                                                         \
      pk_.x = pack2(pb[0][j_], pb[1][j_]);                                               \
      pk_.y = pack2(pb[2][j_], pb[3][j_]);                                               \
      pk_.z = pack2(pb[4][j_], pb[5][j_]);                                               \
      pk_.w = pack2(pb[6][j_], pb[7][j_]);                                               \
      *(u32x4*)&SBB[(j_ * 32 + b_n4) * LDT + b_kq * 8] = pk_;                            \
    }                                                                                    \
  }
  const int aoff = (w * 32 + r) * LDT + 8 * h, boff = r * LDT + 8 * h;
#define G_FRAG(BUF, SA, SBB, KS)                                                         \
  {                                                                                      \
    fa[BUF] = *(const bf16x8*)(SA + aoff + (KS) * 16);                                   \
    fb[BUF][0] = *(const bf16x8*)(SBB + boff + (KS) * 16);                               \
    fb[BUF][1] = *(const bf16x8*)(SBB + boff + 32 * LDT + (KS) * 16);                    \
    fb[BUF][2] = *(const bf16x8*)(SBB + boff + 64 * LDT + (KS) * 16);                    \
    fb[BUF][3] = *(const bf16x8*)(SBB + boff + 96 * LDT + (KS) * 16);                    \
  }
#define G_MFMA(BUF)                                                                      \
  {                                                                                      \
    acc[0] = MFMA(fa[BUF], fb[BUF][0], acc[0]);                                          \
    acc[1] = MFMA(fa[BUF], fb[BUF][1], acc[1]);                                          \
    acc[2] = MFMA(fa[BUF], fb[BUF][2], acc[2]);                                          \
    acc[3] = MFMA(fa[BUF], fb[BUF][3], acc[3]);                                          \
  }
#define SB() __builtin_amdgcn_sched_barrier(0)
#define G_COMPUTE(SA, SBB)                                                               \
  {                                                                                      \
    bf16x8 fa[2], fb[2][4];                                                              \
    G_FRAG(0, SA, SBB, 0);                                                               \
    G_FRAG(1, SA, SBB, 1);                                                               \
    SB();                                                                                \
    G_MFMA(0);                                                                           \
    SB();                                                                                \
    G_FRAG(0, SA, SBB, 2);                                                               \
    SB();                                                                                \
    G_MFMA(1);                                                                           \
    SB();                                                                                \
    G_FRAG(1, SA, SBB, 3);                                                               \
    SB();                                                                                \
    G_MFMA(0);                                                                           \
    SB();                                                                                \
    G_MFMA(1);                                                                           \
    SB();                                                                                \
  }

  G_LOAD(0);
  __syncthreads();
#pragma unroll 1
  for (int s = s0; s < s_end; s += s_step) {
    f32x16 acc[4];
#pragma unroll
    for (int a = 0; a < 4; ++a)
#pragma unroll
      for (int i = 0; i < 16; ++i) acc[a][i] = 0.f;
    const int sn = s + s_step;
    const bool has_next = sn < s_end;
    const u16 *n0 = apb0, *n1 = apb1, *n2 = apb2, *n3 = apb3;
    const float* nbp = bp;
    if (has_next) setup(sn, a_r0, a_c, b_n4, b_kq, n0, n1, n2, n3, nbp);
#pragma unroll 1
    for (int kt = 0; kt < 16; kt += 2) {
      G_STAGE(sA0, sB0);
      __syncthreads();
      G_LOAD(kt + 1);
      G_COMPUTE(sA0, sB0);
      G_STAGE(sA1, sB1);
      __syncthreads();
      {
        int kn = kt + 2;
        if (kt == 14) { apb0 = n0; apb1 = n1; apb2 = n2; apb3 = n3; bp = nbp; kn = 0; }
        G_LOAD(kn);
      }
      G_COMPUTE(sA1, sB1);
    }
    epi(s, acc, w, r, h);
  }
  __syncthreads();
#undef G_LOAD
#undef G_STAGE
#undef G_COMPUTE
#undef G_FRAG
#undef G_MFMA
}
#undef SB

template <bool CONTIG, class Setup, class Epi, class Pre>
DI void gemm_phase(char* smem, int s0, int s_end, int s_step, Setup setup, int ldb, Epi epi, Pre pre) {
  asm volatile("" : "+s"(s_end));
  if (s0 >= s_end) return;
  constexpr int LDK = 40;
  u16* sA0 = (u16*)smem;
  u16* sB0 = sA0 + 256 * LDK;
  u16* sA1 = sB0 + 128 * LDK;
  u16* sB1 = sA1 + 256 * LDK;
  const int tid = otid(), lane = tid & 63, w = tid >> 6, r = lane & 31, h = lane >> 5;
  const int a_r0 = tid >> 2, a_c = (tid & 3) * 8;
  const int b_n4 = tid & 31, b_kq = tid >> 5;
  const u16* abase;
  const float* bbase;
  unsigned ao0, ao1, ao2, ao3, bo;
  setup(s0, a_r0, a_c, b_n4, b_kq, abase, ao0, ao1, ao2, ao3, bbase, bo);

  u32x4 pa0, pa1, pa2, pa3;
  f32x4 pbA[4], pbB[4];

#define G_LOADA(KT)                                                                      \
  {                                                                                      \
    const int k0_ = (((KT) + rot) & 31) * 32;               \
    pa0 = *(const u32x4*)(abase + k0_ + (size_t)ao0);                                    \
    pa1 = *(const u32x4*)(abase + k0_ + (size_t)(CONTIG ? ao0 + 64u * DM : ao1));        \
    pa2 = *(const u32x4*)(abase + k0_ + (size_t)(CONTIG ? ao0 + 128u * DM : ao2));       \
    pa3 = *(const u32x4*)(abase + k0_ + (size_t)(CONTIG ? ao0 + 192u * DM : ao3));       \
  }
#define G_LOADB(PB, BP, KT, ROT)                                                         \
  {                                                                                      \
    const int k0_ = (((KT) + (ROT)) & 31) * 32;                                          \
    _Pragma("unroll") for (int i_ = 0; i_ < 4; ++i_) PB[i_] = *(const f32x4*)((BP) + (size_t)(k0_ + i_) * ldb + (size_t)bo); \
  }
#define G_STAGE(SA, SBB, PB)                                                               \
  {                                                                                      \
    *(u32x4*)&SA[(a_r0)*LDK + a_c] = pa0;                                                \
    *(u32x4*)&SA[(a_r0 + 64) * LDK + a_c] = pa1;                                         \
    *(u32x4*)&SA[(a_r0 + 128) * LDK + a_c] = pa2;                                        \
    *(u32x4*)&SA[(a_r0 + 192) * LDK + a_c] = pa3;                                        \
    _Pragma("unroll") for (int j_ = 0; j_ < 4; ++j_) {                                   \
      uint2 pk_;                                                                         \
      pk_.x = pack2(PB[0][j_], PB[1][j_]);                                               \
      pk_.y = pack2(PB[2][j_], PB[3][j_]);                                               \
      *(uint2*)&SBB[(j_ * 32 + b_n4) * LDK + b_kq * 4] = pk_;                            \
    }                                                                                    \
  }
  const int aoff = (w * 64 + r) * LDK + 8 * h, boff = r * LDK + 8 * h;
#define G_FRAG(FA, FB, SA, SBB, KS)                                                      \
  {                                                                                      \
    FA[0] = *(const bf16x8*)(SA + aoff + (KS) * 16);                                     \
    FA[1] = *(const bf16x8*)(SA + aoff + 32 * LDK + (KS) * 16);                          \
    FB[0] = *(const bf16x8*)(SBB + boff + (KS) * 16);                                    \
    FB[1] = *(const bf16x8*)(SBB + boff + 32 * LDK + (KS) * 16);                         \
    FB[2] = *(const bf16x8*)(SBB + boff + 64 * LDK + (KS) * 16);                         \
    FB[3] = *(const bf16x8*)(SBB + boff + 96 * LDK + (KS) * 16);                         \
  }
#define G_MFMA(FA, FB)                                                                   \
  {                                                                                      \
    _Pragma("unroll") for (int mt_ = 0; mt_ < 2; ++mt_)                                  \
    _Pragma("unroll") for (int nt_ = 0; nt_ < 4; ++nt_) acc[mt_][nt_] = MFMA(FA[mt_], FB[nt_], acc[mt_][nt_]); \
  }
#define SB() __builtin_amdgcn_sched_barrier(0)
#define G_COMPUTE(SA, SBB)                                                               \
  {                                                                                      \
    bf16x8 fa0[2], fb0[4];                                                               \
    G_FRAG(fa0, fb0, SA, SBB, 0);                                                        \
    SB();                                                                                \
    G_MFMA(fa0, fb0);                                                                    \
    SB();                                                                                \
    G_FRAG(fa0, fb0, SA, SBB, 1);                                                        \
    SB();                                                                                \
    G_MFMA(fa0, fb0);                                                                    \
    SB();                                                                                \
  }

  int rot = 2 * (s0 % 6);
  G_LOADA(0);
  G_LOADB(pbA, bbase, 0, rot);
  G_LOADB(pbB, bbase, 1, rot);
  __syncthreads();
#pragma unroll 1
  for (int s = s0; s < s_end; s += s_step) {
    f32x16 acc[2][4];
#pragma unroll
    for (int a = 0; a < 2; ++a)
#pragma unroll
      for (int b = 0; b < 4; ++b)
#pragma unroll
        for (int i = 0; i < 16; ++i) acc[a][b][i] = 0.f;
    pre(s, tid);
    const int sn = s + s_step;
    const bool has_next = sn < s_end;
    const u16* nabase = abase;
    const float* nbbase = bbase;
    unsigned n0 = ao0, n1 = ao1, n2 = ao2, n3 = ao3, nbo = bo;
    if (has_next) setup(sn, a_r0, a_c, b_n4, b_kq, nabase, n0, n1, n2, n3, nbbase, nbo);
    const int nrot = has_next ? 2 * (sn % 6) : rot;
#pragma unroll 1
    for (int kt = 0; kt < 32; kt += 2) {
      G_STAGE(sA0, sB0, pbA);
      G_LOADA(kt + 1);
      __syncthreads();
      {
        const bool last = (kt == 30);
        const float* bq = last ? nbbase : bbase;
        const int kb = last ? 0 : kt + 2;
        G_LOADB(pbA, bq, kb, last ? nrot : rot);
      }
      G_COMPUTE(sA0, sB0);
      G_STAGE(sA1, sB1, pbB);
      {
        int ka = kt + 2, kb = kt + 3;
        if (kt == 30) { abase = nabase; ao0 = n0; ao1 = n1; ao2 = n2; ao3 = n3; bbase = nbbase; rot = nrot; ka = 0; kb = 1; }
        G_LOADA(ka);
        G_LOADB(pbB, bbase, kb, rot);
      }
      __syncthreads();
      G_COMPUTE(sA1, sB1);
    }
    epi(s, acc, w, r, h);
  }
  __syncthreads();
#undef G_LOADA
#undef G_LOADB
#undef G_STAGE
#undef G_COMPUTE
#undef G_FRAG
#undef G_MFMA
}

DI void load4x4(const void* base, int stride, bool isf32, int rq, int c4, float v[4][4]) {
  if (isf32) {
#pragma unroll
    for (int i = 0; i < 4; ++i) {
      const float4 x = *(const float4*)((const float*)base + (size_t)(4 * rq + i) * stride + 4 * c4);
      v[i][0] = x.x; v[i][1] = x.y; v[i][2] = x.z; v[i][3] = x.w;
    }
  } else {
#pragma unroll
    for (int i = 0; i < 4; ++i) {
      const uint2 x = *(const uint2*)((const u16*)base + (size_t)(4 * rq + i) * stride + 4 * c4);
      v[i][0] = bflo(x.x); v[i][1] = bfhi(x.x); v[i][2] = bflo(x.y); v[i][3] = bfhi(x.y);
    }
  }
}
DI void store_n(u16* dst, int ld, int row0, int rq, int c4, const float v[4][4]) {
#pragma unroll
  for (int i = 0; i < 4; ++i) {
    uint2 pk = {pack2(v[i][0], v[i][1]), pack2(v[i][2], v[i][3])};
    *(uint2*)&dst[(row0 + 4 * rq + i) * ld + 4 * c4] = pk;
  }
}
DI void store_t(u16* dst, int ld, int col0, int rq, int c4, const float v[4][4], const float s[4]) {
#pragma unroll
  for (int j = 0; j < 4; ++j) {
    uint2 pk = {pack2(v[0][j] * s[0], v[1][j] * s[1]), pack2(v[2][j] * s[2], v[3][j] * s[3])};
    *(uint2*)&dst[(4 * c4 + j) * ld + col0 + 4 * rq] = pk;
  }
}

DI void attn_load(const u16* kp, const u16* vp, int stride, int rq, int c4, uint2 (&k)[4], uint2 (&v)[4]) {
#pragma unroll
  for (int i = 0; i < 4; ++i) {
    k[i] = *(const uint2*)(kp + (size_t)(4 * rq + i) * stride + 4 * c4);
    v[i] = *(const uint2*)(vp + (size_t)(4 * rq + i) * stride + 4 * c4);
  }
}
DI void attn_stage(u16* sK, u16* sVT, int rq, int c4, const uint2 (&k)[4], const uint2 (&v)[4]) {
#pragma unroll
  for (int i = 0; i < 4; ++i) *(uint2*)&sK[(4 * rq + i) * LDT + 4 * c4] = k[i];
  uint2 t0, t1, t2, t3;
  t0.x = (v[0].x & 0xffffu) | (v[1].x << 16);          t0.y = (v[2].x & 0xffffu) | (v[3].x << 16);
  t1.x = (v[0].x >> 16) | (v[1].x & 0xffff0000u);      t1.y = (v[2].x >> 16) | (v[3].x & 0xffff0000u);
  t2.x = (v[0].y & 0xffffu) | (v[1].y << 16);          t2.y = (v[2].y & 0xffffu) | (v[3].y << 16);
  t3.x = (v[0].y >> 16) | (v[1].y & 0xffff0000u);      t3.y = (v[2].y >> 16) | (v[3].y & 0xffff0000u);
  const int qs = 4 * (rq ^ ((c4 >> 1) & 7));
  *(uint2*)&sVT[(4 * c4 + 0) * LDT + qs] = t0;
  *(uint2*)&sVT[(4 * c4 + 1) * LDT + qs] = t1;
  *(uint2*)&sVT[(4 * c4 + 2) * LDT + qs] = t2;
  *(uint2*)&sVT[(4 * c4 + 3) * LDT + qs] = t3;
}

template <class TileSrc, class BiasF, class TMode>
DI void attn_core(char* smem, const u16* qbase, int ntiles, TileSrc src, BiasF biasf, TMode tmode, float m_init, bool has_sink, u16* obase) {
  u16* sK0 = (u16*)smem;
  u16* sVT0 = sK0 + 64 * LDT;
  u16* sK1 = sVT0 + 64 * LDT;
  u16* sVT1 = sK1 + 64 * LDT;
  const int tid = otid(), lane = tid & 63, w = tid >> 6, r = lane & 31, h = lane >> 5;
  const int rq = tid >> 4, c4 = tid & 15;
  const int ql = w * 32 + r;
  bf16x8 qf[4];
#pragma unroll
  for (int ks = 0; ks < 4; ++ks) qf[ks] = *(const bf16x8*)(qbase + (size_t)ql * DIN + ks * 16 + 8 * h);
  f32x16 O[2];
#pragma unroll
  for (int d = 0; d < 2; ++d)
#pragma unroll
    for (int i = 0; i < 16; ++i) O[d][i] = 0.f;
  float m = m_init, lsum = (has_sink && h == 0) ? 1.f : 0.f;

  auto nextv = [&](int j, const u16*& kp, const u16*& vp, int& stride) -> int {
    while (j < ntiles && !src(j, kp, vp, stride)) ++j;
    return j;
  };
  auto compute = [&](int jc, const u16* sK, const u16* sVT) {
    const int mode = tmode(jc, w);
    if (mode != 2) {
      f32x16 S[2];
#pragma unroll
      for (int mt = 0; mt < 2; ++mt)
#pragma unroll
        for (int i = 0; i < 16; ++i) S[mt][i] = 0.f;
#pragma unroll
      for (int ks = 0; ks < 4; ++ks)
#pragma unroll
        for (int mt = 0; mt < 2; ++mt) {
          const bf16x8 kf = *(const bf16x8*)&sK[(mt * 32 + r) * LDT + ks * 16 + 8 * h];
          S[mt] = MFMA(kf, qf[ks], S[mt]);
        }
      const float C2 = 0.125f * 1.44269504f;
      float mx = NEG;
      if (mode == 1) {
#pragma unroll
        for (int mt = 0; mt < 2; ++mt)
#pragma unroll
          for (int i = 0; i < 16; ++i) {
            const float s = S[mt][i] * C2 + biasf(jc, mt * 32 + crow(i, h), ql);
            S[mt][i] = s;
            mx = fmaxf(mx, s);
          }
      } else {
#pragma unroll
        for (int mt = 0; mt < 2; ++mt)
#pragma unroll
          for (int i = 0; i < 16; ++i) {
            const float s = S[mt][i] * C2;
            S[mt][i] = s;
            mx = fmaxf(mx, s);
          }
      }
      mx = fmaxf(mx, __shfl_xor(mx, 32));
      const float mn = fmaxf(m, mx);
      if (__any(mn > m)) {
        const float alpha = __builtin_amdgcn_exp2f(m - mn);
        m = mn;
        lsum *= alpha;
#pragma unroll
        for (int d = 0; d < 2; ++d)
#pragma unroll
          for (int i = 0; i < 16; ++i) O[d][i] *= alpha;
      }
      float ps = 0.f;
#pragma unroll
      for (int mt = 0; mt < 2; ++mt)
#pragma unroll
        for (int i = 0; i < 16; ++i) {
          const float pv = __builtin_amdgcn_exp2f(S[mt][i] - m);
          S[mt][i] = pv;
          ps += pv;
        }
      lsum += ps;
#pragma unroll
      for (int mt = 0; mt < 2; ++mt)
#pragma unroll
        for (int s = 0; s < 2; ++s) {
          const bf16x8 pf = mk8(pack2(S[mt][8 * s + 0], S[mt][8 * s + 1]), pack2(S[mt][8 * s + 2], S[mt][8 * s + 3]),
                                pack2(S[mt][8 * s + 4], S[mt][8 * s + 5]), pack2(S[mt][8 * s + 6], S[mt][8 * s + 7]));
#pragma unroll
          for (int d = 0; d < 2; ++d) {
            const int sw = (d * 4 + (r >> 3)) & 7, q = mt * 8 + 4 * s + h;
            const u16* vrow = &sVT[(d * 32 + r) * LDT];
            const uint2 lo = *(const uint2*)(vrow + 4 * (q ^ sw));
            const uint2 hi = *(const uint2*)(vrow + 4 * ((q + 2) ^ sw));
            O[d] = MFMA(mk8(lo.x, lo.y, hi.x, hi.y), pf, O[d]);
          }
        }
    }
  };

  uint2 kA[4], vA[4], kB[4], vB[4];
#pragma unroll
  for (int i = 0; i < 4; ++i) { kA[i] = make_uint2(0u, 0u); vA[i] = kA[i]; kB[i] = kA[i]; vB[i] = kA[i]; }
  const u16 *kp = nullptr, *vp = nullptr;
  int stride = 0;
  int jA = nextv(0, kp, vp, stride);
  if (jA < ntiles) attn_load(kp, vp, stride, rq, c4, kA, vA);
  int jB = nextv(jA + 1, kp, vp, stride);
  if (jB < ntiles) attn_load(kp, vp, stride, rq, c4, kB, vB);
  __syncthreads();
#pragma unroll 1
  for (;;) {
    if (jA >= ntiles) break;
    attn_stage(sK0, sVT0, rq, c4, kA, vA);
    {
      const int jc = jA;
      jA = nextv(jB + 1, kp, vp, stride);
      if (jA < ntiles) attn_load(kp, vp, stride, rq, c4, kA, vA);
      __syncthreads();
      compute(jc, sK0, sVT0);
    }
    if (jB >= ntiles) break;
    attn_stage(sK1, sVT1, rq, c4, kB, vB);
    {
      const int jc = jB;
      jB = nextv(jA + 1, kp, vp, stride);
      if (jB < ntiles) attn_load(kp, vp, stride, rq, c4, kB, vB);
      __syncthreads();
      compute(jc, sK1, sVT1);
    }
  }
  const float l = lsum + __shfl_xor(lsum, 32);
  const float inv = 1.f / l;
#pragma unroll
  for (int d = 0; d < 2; ++d)
#pragma unroll
    for (int g = 0; g < 4; ++g) {
      uint2 pk = {pack2(O[d][4 * g + 0] * inv, O[d][4 * g + 1] * inv), pack2(O[d][4 * g + 2] * inv, O[d][4 * g + 3] * inv)};
      *(uint2*)(obase + (size_t)ql * DM + d * 32 + 8 * g + 4 * h) = pk;
    }
}

DI void phase0(const Params& p, char* smem) {
  const int tid = otid();
  if (blockIdx.x == 0) {
    for (int idx = tid; idx < 1024; idx += 256) {
      const int pos = idx >> 4, j = idx & 15;
      const double inv = 1.0 / pow(10000.0, (double)j / 16.0);
      const float ang = (float)((double)pos * inv);
      p.ROPE[idx] = cosf(ang);
      p.ROPE[1024 + idx] = sinf(ang);
    }
  }
  float* scond = (float*)smem;
  for (int item = blockIdx.x; item < 768; item += gridDim.x) {
    const int l = item / 384, ks = (item / 24) % 16, jb = item % 24;
    __syncthreads();
    for (int idx = tid; idx < 320; idx += 256) {
      const int c = idx / 64, k = ks * 64 + (idx & 63);
      const float v = (c == 0) ? p.c_ctx[k] : p.c[(c - 1) * DM + k];
      scond[idx] = silu(v);
    }
    __syncthreads();
    const int j = jb * 256 + tid;
    const float* wp = p.w_ada + ((size_t)l * DM + ks * 64) * 6144 + j;
    float a[5] = {0.f, 0.f, 0.f, 0.f, 0.f};
#pragma unroll 8
    for (int k = 0; k < 64; ++k) {
      const float wv = wp[(size_t)k * 6144];
#pragma unroll
      for (int c = 0; c < 5; ++c) a[c] += scond[c * 64 + k] * wv;
    }
    const float bias = (ks == 0) ? p.b_ada[l * 6144 + j] : 0.f;
#pragma unroll
    for (int c = 0; c < 5; ++c) unsafeAtomicAdd(&p.MOD[(l * 5 + c) * 6144 + j], a[c] + bias);
  }
}

DI int cond_of(int T) { return T < NCTX ? 0 : 1 + ((T - NCTX) >> 11); }

DI void cvt_f32_bf16(const float* s, u16* d, int n4, int gtid, int gsz) {
  for (int i = gtid; i < n4; i += gsz) {
    const float4 x = *(const float4*)(s + (size_t)i * 4);
    uint2 pk = {pack2(x.x, x.y), pack2(x.z, x.w)};
    *(uint2*)(d + (size_t)i * 4) = pk;
  }
}
DI void phase0b(const Params& p) {
  const int tid = otid(), lane = tid & 63, w = tid >> 6;
  {
    const int gtid = blockIdx.x * 256 + tid, gsz = gridDim.x * 256;
    cvt_f32_bf16(p.cak, p.CAK, 4 * 2 * 512 * 128 / 4, gtid, gsz);
    cvt_f32_bf16(p.cav, p.CAV, 4 * 2 * 512 * 128 / 4, gtid, gsz);
    cvt_f32_bf16(p.cbk, p.CBK, 4 * 2 * 512 * 256 / 4, gtid, gsz);
    cvt_f32_bf16(p.cbv, p.CBV, 4 * 2 * 512 * 256 / 4, gtid, gsz);
  }
  for (int T = blockIdx.x * 4 + w; T < NTOK; T += gridDim.x * 4) {
    const float* mod = p.MOD + (size_t)cond_of(T) * 6144;
    const float* xr = (T < NCTX) ? (p.x_prompt + (size_t)T * DM) : (p.x_sample + (size_t)(T - NCTX) * DM);
#pragma unroll
    for (int i = 0; i < 4; ++i) {
      const int k = 256 * i + 4 * lane;
      const float4 x = *(const float4*)(xr + k);
      const float4 sc = *(const float4*)(mod + 1024 + k), sh = *(const float4*)(mod + k);
      uint2 pk = {pack2(x.x * (1.f + sc.x) + sh.x, x.y * (1.f + sc.y) + sh.y), pack2(x.z * (1.f + sc.z) + sh.z, x.w * (1.f + sc.w) + sh.w)};
      *(uint2*)(p.H2 + (size_t)T * DM + k) = pk;
    }
  }
}

DI void phase1(const Params& p, char* smem, int l) {
  const float* W = p.w_in + (size_t)l * DM * DIN;
  const int xcd = blockIdx.x & 7, nloc = gridDim.x >> 3;
  float* sR = (float*)(smem + 61440);
  for (int idx = otid(); idx < 2048; idx += 256) sR[idx] = p.ROPE[idx];
  auto setup = [&](int s, int ar0, int ac, int n4, int kq, const u16*& ab, unsigned& o0, unsigned& o1, unsigned& o2, unsigned& o3, const float*& bb, unsigned& bo) {
    const int tm = 6 * xcd + s % 6, tn = s / 6;
    ab = p.H2 + (size_t)tm * 256 * DM;
    o0 = (unsigned)(ar0 * DM + ac); o1 = o0 + 64u * DM; o2 = o0 + 128u * DM; o3 = o0 + 192u * DM;
    bb = W + tn * 128;
    bo = (unsigned)(4 * n4 + kq * 4 * DIN);
  };
  auto epi = [&](int s, f32x16(&acc)[2][4], int w, int r, int h) {
    int hq = h;
    asm volatile("" : "+v"(hq));
    const int tm = 6 * xcd + s % 6, tn = s / 6;
    const int m0 = tm * 256, n0 = tn * 128;
    const bool lat = m0 >= NCTX;
    const bool rope = lat && (n0 < 640);
    const int n = n0 + 4 * r;
    const int q = (r >> 2) & 3;
#pragma unroll
    for (int mt = 0; mt < 2; ++mt)
#pragma unroll
    for (int i = 0; i < 16; ++i) {
      const int T = m0 + w * 64 + mt * 32 + crow(i, hq);
      float v0 = acc[mt][0][i], v1 = acc[mt][1][i], v2 = acc[mt][2][i], v3 = acc[mt][3][i];
      if (rope) {
        const int t = (T - NCTX) & 2047;
        const int pos = (q < 2) ? (t >> 6) : (t & 63);
        const int jf = 4 * (r & 3);
        const float4 cs = *(const float4*)(sR + pos * 16 + jf), sn = *(const float4*)(sR + 1024 + pos * 16 + jf);
        const float o0 = __shfl_xor(v0, 4), o1 = __shfl_xor(v1, 4), o2 = __shfl_xor(v2, 4), o3 = __shfl_xor(v3, 4);
        if (q & 1) { v0 = o0 * sn.x + v0 * cs.x; v1 = o1 * sn.y + v1 * cs.y; v2 = o2 * sn.z + v2 * cs.z; v3 = o3 * sn.w + v3 * cs.w; }
        else { v0 = v0 * cs.x - o0 * sn.x; v1 = v1 * cs.y - o1 * sn.y; v2 = v2 * cs.z - o2 * sn.z; v3 = v3 * cs.w - o3 * sn.w; }
      }
      uint2 pk = {pack2(v0, v1), pack2(v2, v3)};
      *(uint2*)(p.QKV + (size_t)T * DIN + n) = pk;
      if (!lat) {
        const int b = T >> 8, t = T & 255;
        const float4 vv = {v0, v1, v2, v3};
        if (n0 == 512) *(float4*)(p.out + OFF_AK + ((size_t)(b * 2 + l) * 256 + t) * 128 + (n - 512)) = vv;
        else if (n0 == 640) *(float4*)(p.out + OFF_AV + ((size_t)(b * 2 + l) * 256 + t) * 128 + (n - 640)) = vv;
        else if (n0 == 1024 || n0 == 1152) *(float4*)(p.out + OFF_BK + ((size_t)(b * 2 + l) * 256 + t) * 256 + (n - 1024)) = vv;
        else if (n0 == 1280 || n0 == 1408) *(float4*)(p.out + OFF_BV + ((size_t)(b * 2 + l) * 256 + t) * 256 + (n - 1280)) = vv;
      }
      if ((i & 3) == 3) __builtin_amdgcn_sched_barrier(0);
    }
  };
  gemm_phase<true>(smem, blockIdx.x >> 3, 120, nloc, setup, DIN, epi, [](int, int) {});
}

DI float ret_lg(const Params& p, int l, int dir, int head) { return -__expf(p.decay[(l * 2 + dir) * 4 + head]); }

DI size_t kvs_slot(int req, int head, int dir, int c) { return ((size_t)((req * 4 + head) * 2 + dir) * 16 + c) * 4096; }

DI void retkv_item(const Params& p, char* smem, int l, int req, int head, int c) {
  u16* sKTf = (u16*)smem;
  u16* sKTb = sKTf + 64 * LDT2;
  u16* sVT = sKTb + 64 * LDT2;
  const int tid = otid(), lane = tid & 63, w = tid >> 6, r = lane & 31, h = lane >> 5;
  const int rq = tid >> 4, c4 = tid & 15;
  const int T0 = (req < 16 ? req * 256 : NCTX + (req - 16) * 2048) + c * 128;
  const float lgf = ret_lg(p, l, 0, head), lgb = ret_lg(p, l, 1, head);
  const float one4[4] = {1.f, 1.f, 1.f, 1.f};
  __syncthreads();
#pragma unroll
  for (int half = 0; half < 2; ++half) {
    float v[4][4];
    float sf[4], sb[4];
#pragma unroll
    for (int i = 0; i < 4; ++i) {
      const int j = half * 64 + 4 * rq + i;
      sf[i] = 0.125f * __expf(lgf * (float)(127 - j));
      sb[i] = 0.125f * __expf(lgb * (float)j);
    }
    load4x4(p.QKV + (size_t)(T0 + half * 64) * DIN + 1792 + head * 64, DIN, false, rq, c4, v);
    store_t(sKTf, LDT2, half * 64, rq, c4, v, sf);
    store_t(sKTb, LDT2, half * 64, rq, c4, v, sb);
    load4x4(p.QKV + (size_t)(T0 + half * 64) * DIN + 2048 + head * 64, DIN, false, rq, c4, v);
    store_t(sVT, LDT2, half * 64, rq, c4, v, one4);
  }
  __syncthreads();
  const int dir = w >> 1, mt = w & 1;
  const u16* sKT = dir ? sKTb : sKTf;
  f32x16 acc[2];
#pragma unroll
  for (int nt = 0; nt < 2; ++nt)
#pragma unroll
    for (int i = 0; i < 16; ++i) acc[nt][i] = 0.f;
#pragma unroll
  for (int ks = 0; ks < 8; ++ks) {
    const bf16x8 fa = *(const bf16x8*)&sKT[(mt * 32 + r) * LDT2 + ks * 16 + 8 * h];
#pragma unroll
    for (int nt = 0; nt < 2; ++nt) {
      const bf16x8 fb = *(const bf16x8*)&sVT[(nt * 32 + r) * LDT2 + ks * 16 + 8 * h];
      acc[nt] = MFMA(fa, fb, acc[nt]);
    }
  }
  float* dst = p.KVS + kvs_slot(req, head, dir, c);
#pragma unroll
  for (int nt = 0; nt < 2; ++nt)
#pragma unroll
    for (int i = 0; i < 16; ++i) dst[(mt * 32 + crow(i, h)) * 64 + nt * 32 + r] = acc[nt][i];
}

DI void phase2(const Params& p, char* smem, int l) {
  const int tid = otid();
  for (int item = blockIdx.x; item < 1536; item += gridDim.x) {
    if (item < 512) {
      const int b = item >> 7, head = (item >> 4) & 7, qb = item & 15, kvh = head >> 2;
      const int T0 = NCTX + b * 2048 + qb * 128;
      const u16* ck = p.CAK + ((size_t)(b * 2 + l) * 512) * 128 + kvh * 64;
      const u16* cv = p.CAV + ((size_t)(b * 2 + l) * 512) * 128 + kvh * 64;
      auto src = [&](int j, const u16*& kp, const u16*& vp, int& stride) -> bool {
        if (j < 8) {
          kp = ck + (size_t)j * 64 * 128; vp = cv + (size_t)j * 64 * 128; stride = 128;
          return true;
        }
        const int jj = j - 8, kb = qb - 1 + (jj >> 1);
        if (kb < 0 || kb >= 16) return false;
        const int Tk = NCTX + b * 2048 + kb * 128 + (jj & 1) * 64;
        kp = p.QKV + (size_t)Tk * DIN + 512 + kvh * 64; vp = p.QKV + (size_t)Tk * DIN + 640 + kvh * 64; stride = DIN;
        return true;
      };
      auto biasf = [&](int j, int key, int ql) -> float {
        if (j < 8) return 0.f;
        const int jj = j - 8;
        const int kj = (qb - 1 + (jj >> 1)) * 128 + (jj & 1) * 64 + key;
        const int qi = qb * 128 + ql;
        const int d = qi - kj;
        return (d <= 128 && d >= -128) ? 0.f : NEG;
      };
      auto tmode = [&](int j, int w) -> int {
        if (j < 8) return 0;
        const int jj = j - 8;
        const int k0 = (qb - 1 + (jj >> 1)) * 128 + (jj & 1) * 64, q0w = qb * 128 + w * 32;
        if (k0 - (q0w + 31) > 128 || q0w - (k0 + 63) > 128) return 2;
        if ((q0w + 31) - k0 <= 128 && (k0 + 63) - q0w <= 128) return 0;
        return 1;
      };
      attn_core(smem, p.QKV + (size_t)T0 * DIN + head * 64, 14, src, biasf, tmode, p.sink[l * 8 + head] * 1.44269504f, true,
                p.CAT + (size_t)T0 * DM + head * 64);
    } else if (item < 768) {
      const int it = item - 512;
      const int b = it >> 6, head = (it >> 4) & 3, qb = it & 15;
      const int T0 = NCTX + b * 2048 + qb * 128;
      float* srpb = (float*)(smem + 4 * 64 * LDT * 2);
      __syncthreads();
      for (int idx = tid; idx < 465; idx += 256) srpb[idx] = p.rpb[(size_t)(l * 4 + head) * 465 + idx] * 1.44269504f;
      const int r0 = 2 * qb;
      const int rmin = min(max(r0 - 4, 0), 24), rmax = min(max(r0 + 1 - 4, 0), 24) + 7;
      const u16* ck = p.CBK + ((size_t)(b * 2 + l) * 512) * 256 + head * 64;
      const u16* cv = p.CBV + ((size_t)(b * 2 + l) * 512) * 256 + head * 64;
      auto src = [&](int j, const u16*& kp, const u16*& vp, int& stride) -> bool {
        if (j < 8) {
          kp = ck + (size_t)j * 64 * 256; vp = cv + (size_t)j * 64 * 256; stride = 256;
          return true;
        }
        const int Tk = NCTX + b * 2048 + (rmin + j - 8) * 64;
        kp = p.QKV + (size_t)Tk * DIN + 1024 + head * 64; vp = p.QKV + (size_t)Tk * DIN + 1280 + head * 64; stride = DIN;
        return true;
      };
      auto biasf = [&](int j, int key, int ql) -> float {
        if (j < 8) return 0.f;
        const int kr = rmin + j - 8, kc = key;
        const int qr = r0 + (ql >> 6), qc = ql & 63;
        const int rs = min(max(qr - 4, 0), 24), cs = min(max(qc - 8, 0), 48);
        const bool ok = (kr >= rs) && (kr < rs + 8) && (kc >= cs) && (kc < cs + 16);
        const int bi = ok ? ((kr - qr + 7) * 31 + (kc - qc + 15)) : 0;
        const float bv = srpb[bi];
        return ok ? bv : NEG;
      };
      auto tmode = [&](int j, int w) -> int {
        if (j < 8) return 0;
        const int kr = rmin + j - 8, qr = r0 + (w >> 1);
        const int rs = min(max(qr - 4, 0), 24);
        return (kr >= rs && kr < rs + 8) ? 1 : 2;
      };
      attn_core(smem, p.QKV + (size_t)T0 * DIN + 768 + head * 64, 8 + (rmax - rmin + 1), src, biasf, tmode, NEG, false,
                p.CAT + (size_t)T0 * DM + 512 + head * 64);
    } else if (item < 1152) {
      const int it = item - 768;
      if (it < 256) retkv_item(p, smem, l, 16 + (it >> 6), (it >> 4) & 3, it & 15);
      else { const int i2 = it - 256; retkv_item(p, smem, l, i2 >> 3, (i2 >> 1) & 3, i2 & 1); }
    } else if (item < 1408) {
      const int it = item - 1152;
      const int b = it >> 4, head = (it >> 1) & 7, qh = it & 1, kvh = head >> 2;
      const int T0 = b * 256 + qh * 128;
      auto src = [&](int j, const u16*& kp, const u16*& vp, int& stride) -> bool {
        const int Tk = b * 256 + j * 64;
        kp = p.QKV + (size_t)Tk * DIN + 512 + kvh * 64; vp = p.QKV + (size_t)Tk * DIN + 640 + kvh * 64; stride = DIN;
        return true;
      };
      auto biasf = [&](int, int, int) -> float { return 0.f; };
      auto tmode = [&](int, int) -> int { return 0; };
      attn_core(smem, p.QKV + (size_t)T0 * DIN + head * 64, 4, src, biasf, tmode, p.sink[l * 8 + head] * 1.44269504f, true,
                p.CAT + (size_t)T0 * DM + head * 64);
    } else {
      const int it = item - 1408;
      const int b = it >> 3, head = (it >> 1) & 3, qh = it & 1;
      const int T0 = b * 256 + qh * 128;
      auto src = [&](int j, const u16*& kp, const u16*& vp, int& stride) -> bool {
        const int Tk = b * 256 + j * 64;
        kp = p.QKV + (size_t)Tk * DIN + 1024 + head * 64; vp = p.QKV + (size_t)Tk * DIN + 1280 + head * 64; stride = DIN;
        return true;
      };
      auto biasf = [&](int, int, int) -> float { return 0.f; };
      auto tmode = [&](int, int) -> int { return 0; };
      attn_core(smem, p.QKV + (size_t)T0 * DIN + 768 + head * 64, 4, src, biasf, tmode, NEG, false,
                p.CAT + (size_t)T0 * DM + 512 + head * 64);
    }
  }
}

DI void phase2c(const Params& p, char* smem, int l) {
  u16* sK = (u16*)smem;
  u16* sVT = sK + 128 * LDT;
  u16* sSTf = sVT + 64 * LDT2;
  u16* sSTb = sSTf + 64 * LDT;
  const int tid = otid(), lane = tid & 63, w = tid >> 6, r = lane & 31, h = lane >> 5;
  const int rq = tid >> 4, c4 = tid & 15;
  const float one4[4] = {1.f, 1.f, 1.f, 1.f};
  for (int item = blockIdx.x; item < 384; item += gridDim.x) {
    int req, head, c, nc;
    if (item < 256) { req = 16 + (item >> 6); head = (item >> 4) & 3; c = item & 15; nc = 16; }
    else { const int i2 = item - 256; req = i2 >> 3; head = (i2 >> 1) & 3; c = i2 & 1; nc = 2; }
    const bool lat = req >= 16;
    const int T0 = (lat ? NCTX + (req - 16) * 2048 : req * 256) + c * 128;
    const float lgf = ret_lg(p, l, 0, head), lgb = ret_lg(p, l, 1, head);
    const float gf = __expf(lgf * 128.f), gb = __expf(lgb * 128.f);
    __syncthreads();
    {
      const int d = tid >> 2, e0 = (tid & 3) * 16;
#pragma unroll
      for (int dir = 0; dir < 2; ++dir) {
        float s[16];
#pragma unroll
        for (int q = 0; q < 16; ++q) s[q] = 0.f;
        const float g = dir ? gb : gf;
        if (lat) {
          const float* s0 = p.state + ((size_t)(((req - 16) * 2 + l) * 2 + dir) * 4 + head) * 4096 + d * 64 + e0;
#pragma unroll
          for (int q = 0; q < 16; q += 4) {
            const float4 x = *(const float4*)(s0 + q);
            s[q] = x.x; s[q + 1] = x.y; s[q + 2] = x.z; s[q + 3] = x.w;
          }
        }
        const int nsteps = dir ? (nc - 1 - c) : c;
        for (int st = 0; st < nsteps; ++st) {
          const int cc = dir ? (nc - 1 - st) : st;
          const float* kv = p.KVS + kvs_slot(req, head, dir, cc) + d * 64 + e0;
#pragma unroll
          for (int q = 0; q < 16; q += 4) {
            const float4 x = *(const float4*)(kv + q);
            s[q] = s[q] * g + x.x; s[q + 1] = s[q + 1] * g + x.y; s[q + 2] = s[q + 2] * g + x.z; s[q + 3] = s[q + 3] * g + x.w;
          }
        }
        u16* sST = dir ? sSTb : sSTf;
#pragma unroll
        for (int q = 0; q < 16; ++q) sST[(e0 + q) * LDT + d] = (u16)(pack2(s[q], 0.f) & 0xffffu);
        if (!lat && c == 0) {
          const float* k0 = p.KVS + kvs_slot(req, head, dir, 0) + d * 64 + e0;
          const float* k1 = p.KVS + kvs_slot(req, head, dir, 1) + d * 64 + e0;
          float* o = p.out + OFF_ST + ((size_t)((req * 2 + l) * 2 + dir) * 4 + head) * 4096 + d * 64 + e0;
#pragma unroll
          for (int q = 0; q < 16; ++q) o[q] = dir ? (gb * k1[q] + k0[q]) : (gf * k0[q] + k1[q]);
        }
      }
    }
#pragma unroll
    for (int half = 0; half < 2; ++half) {
      float v[4][4];
      load4x4(p.QKV + (size_t)(T0 + half * 64) * DIN + 1792 + head * 64, DIN, false, rq, c4, v);
      store_n(sK, LDT, half * 64, rq, c4, v);
      load4x4(p.QKV + (size_t)(T0 + half * 64) * DIN + 2048 + head * 64, DIN, false, rq, c4, v);
      store_t(sVT, LDT2, half * 64, rq, c4, v, one4);
    }
    __syncthreads();
    const int qi = w * 32 + r;
    const u16* qrow = p.QKV + (size_t)(T0 + qi) * DIN + 1536 + head * 64;
    uint4 qraw[4];
#pragma unroll
    for (int ks = 0; ks < 4; ++ks) qraw[ks] = *(const uint4*)(qrow + ks * 16 + 8 * h);
    f32x16 O[2];
#pragma unroll
    for (int d = 0; d < 2; ++d)
#pragma unroll
      for (int i = 0; i < 16; ++i) O[d][i] = 0.f;
#pragma unroll 1
    for (int jt = 0; jt < 4; ++jt) {
      f32x16 S;
#pragma unroll
      for (int i = 0; i < 16; ++i) S[i] = 0.f;
#pragma unroll
      for (int ks = 0; ks < 4; ++ks) {
        const bf16x8 kf = *(const bf16x8*)&sK[(jt * 32 + r) * LDT + ks * 16 + 8 * h];
        S = MFMA(kf, __builtin_bit_cast(bf16x8, qraw[ks]), S);
      }
#pragma unroll
      for (int i = 0; i < 16; ++i) {
        const int j = jt * 32 + crow(i, h);
        const int dlt = qi - j;
        const float wgt = (dlt > 0) ? __expf(lgf * (float)dlt) : ((dlt < 0) ? __expf(lgb * (float)(-dlt)) : 2.f);
        S[i] = S[i] * 0.125f * wgt;
      }
#pragma unroll
      for (int s = 0; s < 2; ++s) {
        const bf16x8 pf = mk8(pack2(S[8 * s + 0], S[8 * s + 1]), pack2(S[8 * s + 2], S[8 * s + 3]),
                              pack2(S[8 * s + 4], S[8 * s + 5]), pack2(S[8 * s + 6], S[8 * s + 7]));
#pragma unroll
        for (int d = 0; d < 2; ++d) {
          const u16* vrow = &sVT[(d * 32 + r) * LDT2 + jt * 32 + 16 * s + 4 * h];
          const uint2 lo = *(const uint2*)vrow;
          const uint2 hi = *(const uint2*)(vrow + 8);
          O[d] = MFMA(mk8(lo.x, lo.y, hi.x, hi.y), pf, O[d]);
        }
      }
    }
    {
      const float xf = __expf(lgf * (float)(qi + 1)), xb = __expf(lgb * (float)(128 - qi));
#pragma unroll
      for (int ks = 0; ks < 4; ++ks) {
        const uint4 q = qraw[ks];
        const bf16x8 qsf = mk8(pack2(bflo(q.x) * xf, bfhi(q.x) * xf), pack2(bflo(q.y) * xf, bfhi(q.y) * xf),
                               pack2(bflo(q.z) * xf, bfhi(q.z) * xf), pack2(bflo(q.w) * xf, bfhi(q.w) * xf));
        const bf16x8 qsb = mk8(pack2(bflo(q.x) * xb, bfhi(q.x) * xb), pack2(bflo(q.y) * xb, bfhi(q.y) * xb),
                               pack2(bflo(q.z) * xb, bfhi(q.z) * xb), pack2(bflo(q.w) * xb, bfhi(q.w) * xb));
#pragma unroll
        for (int d = 0; d < 2; ++d) {
          const bf16x8 sf = *(const bf16x8*)&sSTf[(d * 32 + r) * LDT + ks * 16 + 8 * h];
          const bf16x8 sb = *(const bf16x8*)&sSTb[(d * 32 + r) * LDT + ks * 16 + 8 * h];
          O[d] = MFMA(sf, qsf, O[d]);
          O[d] = MFMA(sb, qsb, O[d]);
        }
      }
    }
    float sum = 0.f;
#pragma unroll
    for (int d = 0; d < 2; ++d)
#pragma unroll
      for (int i = 0; i < 16; ++i) sum += O[d][i];
    sum += __shfl_xor(sum, 32);
    const float mu = sum * (1.f / 64.f);
    float vs = 0.f;
#pragma unroll
    for (int d = 0; d < 2; ++d)
#pragma unroll
      for (int i = 0; i < 16; ++i) { const float t = O[d][i] - mu; vs += t * t; }
    vs += __shfl_xor(vs, 32);
    const float rstd = rsqrtf(vs * (1.f / 64.f) + 1e-6f);
    const u16* grow = p.QKV + (size_t)(T0 + qi) * DIN + 2304 + head * 64;
    const float* gnw = p.gn + l * 256 + head * 64;
    u16* orow = p.CAT + (size_t)(T0 + qi) * DM + 768 + head * 64;
#pragma unroll
    for (int d = 0; d < 2; ++d)
#pragma unroll
      for (int g = 0; g < 4; ++g) {
        const int e = d * 32 + 8 * g + 4 * h;
        const uint2 gr = *(const uint2*)(grow + e);
        const float4 gw = *(const float4*)(gnw + e);
        const float o0 = silu(bflo(gr.x)) * (O[d][4 * g + 0] - mu) * rstd * gw.x;
        const float o1 = silu(bfhi(gr.x)) * (O[d][4 * g + 1] - mu) * rstd * gw.y;
        const float o2 = silu(bflo(gr.y)) * (O[d][4 * g + 2] - mu) * rstd * gw.z;
        const float o3 = silu(bfhi(gr.y)) * (O[d][4 * g + 3] - mu) * rstd * gw.w;
        uint2 pk = {pack2(o0, o1), pack2(o2, o3)};
        *(uint2*)(orow + e) = pk;
      }
  }
}

DI void phase3(const Params& p, char* smem, int l, const float* xc, const float* xl) {
  const float* W = p.w_out + (size_t)l * DM * DM;
  u16* PREB = (u16*)p.PRE;
  const int xcd = blockIdx.x & 7, nloc = gridDim.x >> 3;
  auto setup = [&](int s, int ar0, int ac, int n4, int kq, const u16*& ab, unsigned& o0, unsigned& o1, unsigned& o2, unsigned& o3, const float*& bb, unsigned& bo) {
    const int tm = 6 * xcd + s % 6, tn = s / 6;
    ab = p.CAT + (size_t)tm * 256 * DM;
    o0 = (unsigned)(ar0 * DM + ac); o1 = o0 + 64u * DM; o2 = o0 + 128u * DM; o3 = o0 + 192u * DM;
    bb = W + tn * 128;
    bo = (unsigned)(4 * n4 + kq * 4 * DM);
  };
  auto epi = [&](int s, f32x16(&acc)[2][4], int w, int r, int h) {
    int hq = h;
    asm volatile("" : "+v"(hq));
    const int tm = 6 * xcd + s % 6, tn = s / 6;
    const int m0 = tm * 256, n0 = tn * 128;
    const float* g1 = p.MOD + (size_t)(l * 5 + cond_of(m0)) * 6144 + 2048 + n0 + 4 * r;
    const float g0 = g1[0], g1v = g1[1], g2 = g1[2], g3 = g1[3];
#pragma unroll
    for (int mt = 0; mt < 2; ++mt)
#pragma unroll
    for (int i = 0; i < 16; ++i) {
      const int ml = w * 64 + mt * 32 + crow(i, hq);
      uint2 pk = {pack2(g0 * acc[mt][0][i], g1v * acc[mt][1][i]), pack2(g2 * acc[mt][2][i], g3 * acc[mt][3][i])};
      *(uint2*)(PREB + (size_t)(m0 + ml) * DM + n0 + 4 * r) = pk;
      if ((i & 3) == 3) __builtin_amdgcn_sched_barrier(0);
    }
  };
  gemm_phase<true>(smem, blockIdx.x >> 3, 48, nloc, setup, DM, epi, [](int, int) {});
}

DI void phase4(const Params& p, char* smem, int l, const float* xc, const float* xl) {
  float* swr = (float*)smem;
  const int tid = otid(), lane = tid & 63, w = tid >> 6;
  __syncthreads();
  for (int idx = tid; idx < 4096; idx += 256) {
    const float4 x = *(const float4*)(p.w_router + (size_t)l * DM * 16 + idx * 4);
    const int k = idx >> 2, e = (idx & 3) * 4;
    swr[(e + 0) * DM + k] = x.x; swr[(e + 1) * DM + k] = x.y; swr[(e + 2) * DM + k] = x.z; swr[(e + 3) * DM + k] = x.w;
  }
  __syncthreads();
  const float* lg = p.ln1g + l * DM;
  const float* lb = p.ln1b + l * DM;
  const int rstride = gridDim.x * 4;
  uint2 nprb[4];
  float4 nxi[4];
  {
    const int T0 = blockIdx.x * 4 + w;
    if (T0 < NTOK) {
      const float* xr0 = (T0 < NCTX) ? (xc + (size_t)T0 * DM) : (xl + (size_t)(T0 - NCTX) * DM);
#pragma unroll
      for (int i = 0; i < 4; ++i) {
        nprb[i] = *(const uint2*)((const u16*)p.PRE + (size_t)T0 * DM + 256 * i + 4 * lane);
        nxi[i] = *(const float4*)(xr0 + 256 * i + 4 * lane);
      }
    }
  }
  for (int T = blockIdx.x * 4 + w; T < NTOK; T += rstride) {
    const float* mod = p.MOD + (size_t)(l * 5 + cond_of(T)) * 6144;
    float4 x[4];
    float s = 0.f;
#pragma unroll
    for (int i = 0; i < 4; ++i) {
      const uint2 prb = nprb[i];
      const float4 xi = nxi[i];
      const float4 pr = {bflo(prb.x), bfhi(prb.x), bflo(prb.y), bfhi(prb.y)};
      x[i].x = ALPHA * xi.x + pr.x; x[i].y = ALPHA * xi.y + pr.y; x[i].z = ALPHA * xi.z + pr.z; x[i].w = ALPHA * xi.w + pr.w;
      s += x[i].x + x[i].y + x[i].z + x[i].w;
    }
    {
      const int Tn = T + rstride;
      if (Tn < NTOK) {
        const float* xrn = (Tn < NCTX) ? (xc + (size_t)Tn * DM) : (xl + (size_t)(Tn - NCTX) * DM);
#pragma unroll
        for (int i = 0; i < 4; ++i) {
          nprb[i] = *(const uint2*)((const u16*)p.PRE + (size_t)Tn * DM + 256 * i + 4 * lane);
          nxi[i] = *(const float4*)(xrn + 256 * i + 4 * lane);
        }
      }
    }
    const float mu = wave_sum(s) * (1.f / 1024.f);
    float vs = 0.f;
#pragma unroll
    for (int i = 0; i < 4; ++i) {
      x[i].x -= mu; x[i].y -= mu; x[i].z -= mu; x[i].w -= mu;
      vs += x[i].x * x[i].x + x[i].y * x[i].y + x[i].z * x[i].z + x[i].w * x[i].w;
    }
    const float rstd = rsqrtf(wave_sum(vs) * (1.f / 1024.f) + 1e-6f);
#pragma unroll
    for (int i = 0; i < 4; ++i) {
      const int k = 256 * i + 4 * lane;
      const float4 g = *(const float4*)(lg + k), bb = *(const float4*)(lb + k);
      float4 y;
      y.x = x[i].x * rstd * g.x + bb.x; y.y = x[i].y * rstd * g.y + bb.y; y.z = x[i].z * rstd * g.z + bb.z; y.w = x[i].w * rstd * g.w + bb.w;
      *(float4*)(p.X + (size_t)T * DM + k) = y;
      const float4 sc = *(const float4*)(mod + 4096 + k), sh = *(const float4*)(mod + 3072 + k);
      float4 hh;
      hh.x = y.x * (1.f + sc.x) + sh.x; hh.y = y.y * (1.f + sc.y) + sh.y; hh.z = y.z * (1.f + sc.z) + sh.z; hh.w = y.w * (1.f + sc.w) + sh.w;
      uint2 pk = {pack2(hh.x, hh.y), pack2(hh.z, hh.w)};
      *(uint2*)(p.H2 + (size_t)T * DM + k) = pk;
      x[i] = hh;
    }
    float a16[16];
#pragma unroll
    for (int e = 0; e < 16; ++e) {
      float a = 0.f;
#pragma unroll
      for (int i = 0; i < 4; ++i) {
        const float4 wv = *(const float4*)(swr + e * DM + 256 * i + 4 * lane);
        a += x[i].x * wv.x + x[i].y * wv.y + x[i].z * wv.z + x[i].w * wv.w;
      }
      a16[e] = a;
      if ((e & 3) == 3) __builtin_amdgcn_sched_barrier(0);
    }
    float a8[8], a4[4], a2[2], a1;
    {
      const bool hi = (lane & 32) != 0;
#pragma unroll
      for (int j = 0; j < 8; ++j) {
        const float snd = hi ? a16[j] : a16[8 + j];
        const float kp = hi ? a16[8 + j] : a16[j];
        a8[j] = kp + __shfl_xor(snd, 32);
      }
    }
    {
      const bool hi = (lane & 16) != 0;
#pragma unroll
      for (int j = 0; j < 4; ++j) {
        const float snd = hi ? a8[j] : a8[4 + j];
        const float kp = hi ? a8[4 + j] : a8[j];
        a4[j] = kp + __shfl_xor(snd, 16);
      }
    }
    {
      const bool hi = (lane & 8) != 0;
#pragma unroll
      for (int j = 0; j < 2; ++j) {
        const float snd = hi ? a4[j] : a4[2 + j];
        const float kp = hi ? a4[2 + j] : a4[j];
        a2[j] = kp + __shfl_xor(snd, 8);
      }
    }
    {
      const bool hi = (lane & 4) != 0;
      const float snd = hi ? a2[0] : a2[1];
      const float kp = hi ? a2[1] : a2[0];
      a1 = kp + __shfl_xor(snd, 4);
    }
    a1 += __shfl_xor(a1, 2);
    a1 += __shfl_xor(a1, 1);
    const int myexp = ((lane >> 5) & 1) * 8 + ((lane >> 4) & 1) * 4 + ((lane >> 3) & 1) * 2 + ((lane >> 2) & 1);
    float mx = a1;
#pragma unroll
    for (int o = 32; o >= 4; o >>= 1) mx = fmaxf(mx, __shfl_xor(mx, o));
    const float ex = __expf(a1 - mx);
    float den = ex;
#pragma unroll
    for (int o = 32; o >= 4; o >>= 1) den += __shfl_xor(den, o);
    if ((lane & 3) == 0) { p.AFF[(size_t)T * 16 + myexp] = ex / den; p.INV[(size_t)T * 16 + myexp] = -1; }
  }
}

DI unsigned block_incl_scan(unsigned v, unsigned* wsum, int lane, int w, unsigned& total) {
#pragma unroll
  for (int o = 1; o < 64; o <<= 1) {
    const unsigned t = __shfl_up(v, o);
    if (lane >= o) v += t;
  }
  __syncthreads();
  if (lane == 63) wsum[w] = v;
  __syncthreads();
  unsigned off = 0;
  total = 0;
#pragma unroll
  for (int i = 0; i < 4; ++i) {
    const unsigned s = wsum[i];
    if (i < w) off += s;
    total += s;
  }
  return v + off;
}

DI void phase5(const Params& p, char* smem) {
  unsigned* hist = (unsigned*)smem;
  unsigned* wsum = hist + 256;
  unsigned* bc = wsum + 4;
  const int tid = otid(), lane = tid & 63, w = tid >> 6;
  for (int item = blockIdx.x; item < 320; item += gridDim.x) {
    int n, base, e, cap, rowbase;
    if (item < 64) {
      const int b = item >> 4; e = item & 15;
      n = 2048; base = NCTX + b * 2048; cap = 256; rowbase = 512 + b * 256;
    } else {
      const int it = item - 64; const int rq = it >> 4; e = it & 15;
      n = 256; base = rq * 256; cap = 32; rowbase = rq * 32;
    }
    const int per = n >> 8;
    unsigned key[8];
#pragma unroll
    for (int q = 0; q < 8; ++q) key[q] = (q < per) ? __float_as_uint(p.AFF[(size_t)(base + tid * per + q) * 16 + e]) : 0u;
    unsigned prefix = 0u, mask = 0u;
    unsigned remaining = (unsigned)cap;
#pragma unroll 1
    for (int pass = 3; pass >= 0; --pass) {
      const int shift = pass * 8;
      __syncthreads();
      hist[tid] = 0u;
      __syncthreads();
#pragma unroll
      for (int q = 0; q < 8; ++q)
        if (q < per && (key[q] & mask) == prefix) atomicAdd(&hist[(key[q] >> shift) & 255u], 1u);
      __syncthreads();
      const unsigned hv = hist[tid];
      unsigned total;
      const unsigned incl = block_incl_scan(hv, wsum, lane, w, total);
      const unsigned above = total - incl;
      if (above < remaining && remaining <= above + hv) { bc[0] = (unsigned)tid; bc[1] = remaining - above; }
      __syncthreads();
      const unsigned bsel = bc[0];
      remaining = bc[1];
      prefix |= bsel << shift;
      mask |= 0xFFu << shift;
    }
    const unsigned thr = prefix;
    unsigned ceq = 0u;
#pragma unroll
    for (int q = 0; q < 8; ++q) ceq += (q < per && key[q] == thr) ? 1u : 0u;
    unsigned tot;
    unsigned eq_before = block_incl_scan(ceq, wsum, lane, w, tot) - ceq;
    unsigned selmask = 0u, nsel = 0u;
#pragma unroll
    for (int q = 0; q < 8; ++q) {
      if (q < per) {
        const bool eq = key[q] == thr;
        const bool sel = (key[q] > thr) || (eq && eq_before < remaining);
        eq_before += eq ? 1u : 0u;
        selmask |= sel ? (1u << q) : 0u;
        nsel += sel ? 1u : 0u;
      }
    }
    unsigned row = block_incl_scan(nsel, wsum, lane, w, tot) - nsel;
#pragma unroll
    for (int q = 0; q < 8; ++q) {
      if (q < per && ((selmask >> q) & 1u)) {
        const int tok = base + tid * per + q;
        const int rr = e * NROWS_E + rowbase + (int)row;
        p.SELTOK[rr] = tok;
        p.SELGATE[rr] = __uint_as_float(key[q]);
        p.INV[(size_t)tok * 16 + e] = rr;
        ++row;
      }
    }
  }
}

DI void phase6(const Params& p, char* smem, int l) {
  const int xcd = blockIdx.x & 7, nloc = gridDim.x >> 3;
  auto setup = [&](int s, int ar0, int ac, int n4, int kq, const u16*& ab, unsigned& o0, unsigned& o1, unsigned& o2, unsigned& o3, const float*& bb, unsigned& bo) {
    const int e = 2 * xcd + s / 96, rem = s % 96, tn = rem / 6, tm = rem % 6;
    const int* tok = p.SELTOK + e * NROWS_E + tm * 256 + ar0;
    ab = p.H2;
    o0 = (unsigned)(tok[0] * DM + ac); o1 = (unsigned)(tok[64] * DM + ac);
    o2 = (unsigned)(tok[128] * DM + ac); o3 = (unsigned)(tok[192] * DM + ac);
    bb = p.w_gu + ((size_t)l * 16 + e) * DM * 2048 + tn * 64;
    bo = (unsigned)(((n4 >> 4) & 1) * 1024 + 4 * (n4 & 15) + kq * 4 * 2048);
  };
  auto epi = [&](int s, f32x16(&acc)[2][4], int w, int r, int h) {
    int hq = h;
    asm volatile("" : "+v"(hq));
    const int e = 2 * xcd + s / 96, rem = s % 96, tn = rem / 6, tm = rem % 6;
    const int m0 = tm * 256, f0 = tn * 64;
    u16* act = p.ACT + ((size_t)e * NROWS_E + m0) * DM;
#pragma unroll
    for (int mt = 0; mt < 2; ++mt)
#pragma unroll
    for (int i = 0; i < 16; ++i) {
      const int ml = w * 64 + mt * 32 + crow(i, hq);
      const float a0 = acc[mt][0][i], a1 = acc[mt][1][i], a2 = acc[mt][2][i], a3 = acc[mt][3][i];
      const bool lo = r < 16;
      const float s0 = lo ? a2 : a0, s1 = lo ? a3 : a1;
      const float r0 = __shfl_xor(s0, 16), r1 = __shfl_xor(s1, 16);
      const float g0 = lo ? a0 : r0, g1 = lo ? a1 : r1;
      const float v0 = lo ? r0 : a2, v1 = lo ? r1 : a3;
      *(unsigned*)(act + (size_t)ml * DM + f0 + 4 * (r & 15) + (lo ? 0 : 2)) = pack2(silu(g0) * v0, silu(g1) * v1);
      if ((i & 3) == 3) __builtin_amdgcn_sched_barrier(0);
    }
  };
  gemm_phase<false>(smem, blockIdx.x >> 3, 192, nloc, setup, 2048, epi, [](int, int) {});
}

DI void phase7(const Params& p, char* smem, int l, u16* FF) {
  const int xcd = blockIdx.x & 7, nloc = gridDim.x >> 3;
  auto setup = [&](int s, int ar0, int ac, int n4, int kq, const u16*& ab, unsigned& o0, unsigned& o1, unsigned& o2, unsigned& o3, const float*& bb, unsigned& bo) {
    const int e = 2 * xcd + s / 48, rem = s % 48, tn = rem / 6, tm = rem % 6;
    ab = p.ACT + ((size_t)e * NROWS_E + tm * 256) * DM;
    o0 = (unsigned)(ar0 * DM + ac); o1 = o0 + 64u * DM; o2 = o0 + 128u * DM; o3 = o0 + 192u * DM;
    bb = p.w_down + ((size_t)l * 16 + e) * DM * DM + tn * 128;
    bo = (unsigned)(4 * n4 + kq * 4 * DM);
  };
  float* sG = (float*)(smem + 61440);
  int par = 1;
  auto pre = [&](int s, int tid) {
    par ^= 1;
    const int e = 2 * xcd + s / 48, rem = s % 48, tm = rem % 6;
    sG[par * 256 + tid] = p.SELGATE[e * NROWS_E + tm * 256 + tid];
  };
  auto epi = [&](int s, f32x16(&acc)[2][4], int w, int r, int h) {
    int hq = h;
    asm volatile("" : "+v"(hq));
    const int e = 2 * xcd + s / 48, rem = s % 48, tn = rem / 6, tm = rem % 6;
    const int m0 = tm * 256, n0 = tn * 128;
#pragma unroll
    for (int mt = 0; mt < 2; ++mt)
#pragma unroll
    for (int i = 0; i < 16; ++i) {
      const int ml = w * 64 + mt * 32 + crow(i, hq);
      const float g = sG[par * 256 + ml];
      uint2 pk = {pack2(g * acc[mt][0][i], g * acc[mt][1][i]), pack2(g * acc[mt][2][i], g * acc[mt][3][i])};
      *(uint2*)(FF + ((size_t)e * NROWS_E + m0 + ml) * DM + n0 + 4 * r) = pk;
      if ((i & 3) == 3) __builtin_amdgcn_sched_barrier(0);
    }
  };
  gemm_phase<true>(smem, blockIdx.x >> 3, 96, nloc, setup, DM, epi, pre);
}

DI void phase8(const Params& p, int l, float* dst, bool write_h) {
  const int tid = otid(), lane = tid & 63, w = tid >> 6;
  const float* lg = p.ln2g + l * DM;
  const float* lb = p.ln2b + l * DM;
  const int rstride = gridDim.x * 4;
  float4 nxa[4];
  int ninv = -1;
  {
    const int T0 = blockIdx.x * 4 + w;
    if (T0 < NTOK) {
#pragma unroll
      for (int i = 0; i < 4; ++i) nxa[i] = *(const float4*)(p.X + (size_t)T0 * DM + 256 * i + 4 * lane);
      ninv = (lane < 16) ? p.INV[(size_t)T0 * 16 + lane] : -1;
    }
  }
  for (int T = blockIdx.x * 4 + w; T < NTOK; T += rstride) {
    const float* g2 = p.MOD + (size_t)(l * 5 + cond_of(T)) * 6144 + 5120;
    const float* modn = p.MOD + (size_t)(5 + cond_of(T)) * 6144;
    float4 x[4], ff[4], xa[4];
#pragma unroll
    for (int i = 0; i < 4; ++i) { ff[i] = make_float4(0.f, 0.f, 0.f, 0.f); xa[i] = nxa[i]; }
    const int myinv = ninv;
    {
      const int Tn = T + rstride;
      if (Tn < NTOK) {
#pragma unroll
        for (int i = 0; i < 4; ++i) nxa[i] = *(const float4*)(p.X + (size_t)Tn * DM + 256 * i + 4 * lane);
        ninv = (lane < 16) ? p.INV[(size_t)Tn * 16 + lane] : -1;
      }
    }
    unsigned long long sel = __ballot(myinv >= 0);
#pragma unroll 1
    while (sel) {
      int rows[4];
#pragma unroll
      for (int q = 0; q < 4; ++q) {
        if (sel) {
          const int e = __ffsll((long long)sel) - 1;
          sel &= sel - 1;
          rows[q] = __shfl(myinv, e);
        } else {
          rows[q] = -1;
        }
      }
      uint2 y[4][4];
#pragma unroll
      for (int q = 0; q < 4; ++q) {
        const u16* yr = p.YE + (size_t)(rows[q] >= 0 ? rows[q] : 0) * DM + 4 * lane;
#pragma unroll
        for (int i = 0; i < 4; ++i) y[q][i] = *(const uint2*)(yr + 256 * i);
      }
#pragma unroll
      for (int q = 0; q < 4; ++q) {
        const float wq = rows[q] >= 0 ? 1.f : 0.f;
#pragma unroll
        for (int i = 0; i < 4; ++i) {
          ff[i].x += wq * bflo(y[q][i].x); ff[i].y += wq * bfhi(y[q][i].x); ff[i].z += wq * bflo(y[q][i].y); ff[i].w += wq * bfhi(y[q][i].y);
        }
      }
    }
    float s = 0.f;
#pragma unroll
    for (int i = 0; i < 4; ++i) {
      const int k = 256 * i + 4 * lane;
      const float4 a = xa[i];
      const float4 f = ff[i];
      const float4 g = *(const float4*)(g2 + k);
      x[i].x = ALPHA * a.x + g.x * f.x; x[i].y = ALPHA * a.y + g.y * f.y; x[i].z = ALPHA * a.z + g.z * f.z; x[i].w = ALPHA * a.w + g.w * f.w;
      s += x[i].x + x[i].y + x[i].z + x[i].w;
    }
    const float mu = wave_sum(s) * (1.f / 1024.f);
    float vs = 0.f;
#pragma unroll
    for (int i = 0; i < 4; ++i) {
      x[i].x -= mu; x[i].y -= mu; x[i].z -= mu; x[i].w -= mu;
      vs += x[i].x * x[i].x + x[i].y * x[i].y + x[i].z * x[i].z + x[i].w * x[i].w;
    }
    const float rstd = rsqrtf(wave_sum(vs) * (1.f / 1024.f) + 1e-6f);
#pragma unroll
    for (int i = 0; i < 4; ++i) {
      const int k = 256 * i + 4 * lane;
      const float4 g = *(const float4*)(lg + k), bb = *(const float4*)(lb + k);
      float4 y;
      y.x = x[i].x * rstd * g.x + bb.x; y.y = x[i].y * rstd * g.y + bb.y; y.z = x[i].z * rstd * g.z + bb.z; y.w = x[i].w * rstd * g.w + bb.w;
      *(float4*)(dst + (size_t)T * DM + k) = y;
      if (write_h) {
        const float4 sc = *(const float4*)(modn + 1024 + k), sh = *(const float4*)(modn + k);
        uint2 pk = {pack2(y.x * (1.f + sc.x) + sh.x, y.y * (1.f + sc.y) + sh.y), pack2(y.z * (1.f + sc.z) + sh.z, y.w * (1.f + sc.w) + sh.w)};
        *(uint2*)(p.H2 + (size_t)T * DM + k) = pk;
      }
    }
  }
}

constexpr int kDynLds = 73728;
__global__ void __launch_bounds__(256, 2) mega(Params p) {
  extern __shared__ __attribute__((aligned(16))) char smem[];
  cg::grid_group grid = cg::this_grid();
  if (p.never) grid.sync();
  GBar gb;
  gb.bar = p.BAR; gb.x = xb_xcc_id(); gb.nloc = 0u; gb.nx = 0u;
  if (threadIdx.x == 0) (void)xb_add(&p.BAR[XB_XCNT(gb.x)], 1u);
  phase0(p, smem);
  gbar(gb);
  phase0b(p);
  gbar(gb);
#pragma unroll 1
  for (int l = 0; l < 2; ++l) {
    const float* xc = (l == 0) ? p.x_prompt : p.X;
    const float* xl = (l == 0) ? p.x_sample : (p.X + (size_t)NCTX * DM);
    phase1(p, smem, l);
    gbar(gb);
    if (PROBE == 1) { phase1(p, smem, l); gbar(gb); }
    phase2(p, smem, l);
    gbar(gb);
    if (PROBE == 3) { phase2(p, smem, l); gbar(gb); }
    phase2c(p, smem, l);
    gbar(gb);
    if (PROBE == 3) { phase2c(p, smem, l); gbar(gb); }
    phase3(p, smem, l, xc, xl);
    gbar(gb);
    if (PROBE == 1) { phase3(p, smem, l, xc, xl); gbar(gb); }
    phase4(p, smem, l, xc, xl);
    gbar(gb);
    phase5(p, smem);
    gbar(gb);
    phase6(p, smem, l);
    gbar(gb);
    if (PROBE == 1) { phase6(p, smem, l); gbar(gb); }
    phase7(p, smem, l, p.YE);
    gbar(gb);
    phase8(p, l, (l == 1) ? p.out : p.X, l == 0);
    if (l == 0) gbar(gb);
  }
}

extern "C" void kernel_launch(void* const* d_in, const int* in_sizes, int n_in, void* d_out, int out_size, void* d_ws,
                              size_t ws_size, hipStream_t stream) {
  static int grid_blocks = 0;
  if (!grid_blocks) {
    int dev = 0, cus = 0, per_cu = 0;
    hipGetDevice(&dev);
    hipDeviceGetAttribute(&cus, hipDeviceAttributeMultiprocessorCount, dev);
    hipFuncSetAttribute((const void*)mega, hipFuncAttributeMaxDynamicSharedMemorySize, kDynLds);
    hipOccupancyMaxActiveBlocksPerMultiprocessor(&per_cu, mega, 256, kDynLds);
    if (per_cu > 2) per_cu = 2;
    if (per_cu < 1) per_cu = 1;
    grid_blocks = cus * per_cu;
  }
  Params p{};
  const float** pf = (const float**)&p;
  for (int i = 0; i < 24; ++i) pf[i] = (const float*)d_in[i];
  p.out = (float*)d_out;
  char* ws = (char*)d_ws;
  size_t off = 0;
  auto take = [&](size_t bytes) { char* q = ws + off; off += (bytes + 255) & ~(size_t)255; return q; };
  p.MOD = (float*)take(2 * 5 * 6144 * 4);
  p.BAR = (unsigned*)take(XCD_BAR_WORDS * 4);
  p.ROPE = (float*)take(2048 * 4);
  p.X = (float*)take((size_t)NTOK * DM * 4);
  p.PRE = (float*)take((size_t)NTOK * DM * 4);
  p.KVS = (float*)take((size_t)20 * 4 * 2 * 16 * 4096 * 4);
  p.AFF = (float*)take((size_t)NTOK * 16 * 4);
  p.SELGATE = (float*)take((size_t)16 * NROWS_E * 4);
  p.SELTOK = (int*)take((size_t)16 * NROWS_E * 4);
  p.QKV = (u16*)take((size_t)NTOK * DIN * 2);
  p.CAT = (u16*)take((size_t)NTOK * DM * 2);
  p.H2 = (u16*)take((size_t)NTOK * DM * 2);
  p.ACT = (u16*)take((size_t)16 * NROWS_E * DM * 2);
  p.YE = (u16*)take((size_t)16 * NROWS_E * DM * 2);
  p.INV = (int*)take((size_t)NTOK * 16 * 4);
  p.CAK = (u16*)take((size_t)4 * 2 * 512 * 128 * 2);
  p.CAV = (u16*)take((size_t)4 * 2 * 512 * 128 * 2);
  p.CBK = (u16*)take((size_t)4 * 2 * 512 * 256 * 2);
  p.CBV = (u16*)take((size_t)4 * 2 * 512 * 256 * 2);
  p.never = 0;
  hipMemsetAsync(p.MOD, 0, (size_t)((char*)p.BAR - (char*)p.MOD) + XCD_BAR_WORDS * 4, stream);
  void* args[] = {&p};
  hipError_t e = hipLaunchCooperativeKernel((void*)mega, dim3(grid_blocks), dim3(256), args, kDynLds, stream);
  if (e != hipSuccess) fprintf(stderr, "cooperative launch failed: %s (grid %d)\n", hipGetErrorString(e), grid_blocks);
}
```

```cpp
#include <hip/hip_runtime.h>
#include <hip/hip_cooperative_groups.h>
#include <cstdio>
namespace cg = cooperative_groups;

#define DI __device__ __forceinline__
typedef short bf16x8 __attribute__((ext_vector_type(8)));
typedef float f32x16 __attribute__((ext_vector_type(16)));
typedef __bf16 bf2_t __attribute__((ext_vector_type(2)));
typedef float f2_t __attribute__((ext_vector_type(2)));
typedef unsigned short u16;
typedef unsigned u32x4 __attribute__((ext_vector_type(4)));
typedef float f32x4 __attribute__((ext_vector_type(4)));
typedef float f32x2 __attribute__((ext_vector_type(2)));

#define MFMA(a, b, c) __builtin_amdgcn_mfma_f32_32x32x16_bf16((a), (b), (c), 0, 0, 0)

#define PROBE 0
constexpr int NTOK = 12288;
constexpr int NCTX = 4096;
constexpr int DM = 1024;
constexpr int DIN = 2560;
constexpr int LDT = 72;
constexpr int LDT2 = 136;
constexpr int NROWS_E = 1536;
constexpr float NEG = -1e30f;
constexpr float ALPHA = 1.41421356237f;

constexpr size_t OFF_AK = 12582912, OFF_AV = 13631488, OFF_BK = 14680064, OFF_BV = 16777216, OFF_ST = 18874368;

struct Params {
  const float *x_prompt, *x_sample, *cak, *cav, *cbk, *cbv, *state, *c, *c_ctx, *w_ada, *b_ada, *w_in, *w_out, *sink, *rpb,
      *decay, *gn, *ln1g, *ln1b, *ln2g, *ln2b, *w_router, *w_gu, *w_down;
  float* out;
  float *MOD, *ROPE, *X, *PRE, *KVS, *AFF, *SELGATE;
  int* SELTOK;
  u16 *QKV, *CAT, *H2, *ACT, *CAK, *CAV, *CBK, *CBV;
  u16* YE;
  int* INV;
  unsigned* BAR;
  long never;
};

DI unsigned pack2(float a, float b) {
  f2_t v = {a, b};
  bf2_t r = __builtin_convertvector(v, bf2_t);
  return __builtin_bit_cast(unsigned, r);
}
DI int otid() { int x = threadIdx.x; asm volatile("" : "+v"(x)); return x; }
DI float bflo(unsigned u) { return __uint_as_float(u << 16); }
DI float bfhi(unsigned u) { return __uint_as_float(u & 0xffff0000u); }
DI int crow(int i, int h) { return (i & 3) + 8 * (i >> 2) + 4 * h; }
DI float silu(float x) { return x * __builtin_amdgcn_rcpf(1.f + __expf(-x)); }
DI float wave_sum(float v) {
#pragma unroll
  for (int o = 32; o >= 1; o >>= 1) v += __shfl_xor(v, o);
  return v;
}
DI bf16x8 mk8(unsigned a, unsigned b, unsigned c, unsigned d) {
  uint4 u = {a, b, c, d};
  return __builtin_bit_cast(bf16x8, u);
}


#define XB_TMO 128
#define XB_XCNT(j) (256 + 64 * (j))
#define XB_XSUB(j) (1280 + 64 * (j))
#define XB_XGEN(j) (2304 + 64 * (j))
#define XB_TOP 3328
#define XB_TOPGEN 3392
#define XCD_BAR_WORDS 3456
#define XB_SPIN_CAP (1u << 20)
DI unsigned xb_ld(unsigned* p) { return __hip_atomic_load(p, __ATOMIC_RELAXED, __HIP_MEMORY_SCOPE_AGENT); }
DI unsigned xb_add(unsigned* p, unsigned v) { return __hip_atomic_fetch_add(p, v, __ATOMIC_RELAXED, __HIP_MEMORY_SCOPE_AGENT); }
DI unsigned xb_xcc_id() { return (unsigned)__builtin_amdgcn_s_getreg((3 << 11) | 20) & 0xFu; }
#define XB_SPIN(cond, bar)                                                            \
  do {                                                                                \
    unsigned _sp = 0;                                                                 \
    while (cond) {                                                                    \
      __builtin_amdgcn_s_sleep(1);                                                    \
      if ((++_sp & 255u) == 0u) {                                                     \
        if (xb_ld(&(bar)[XB_TMO])) break;                                             \
        if (_sp > XB_SPIN_CAP) { atomicAdd(&(bar)[XB_TMO], 1u); break; }              \
      }                                                                               \
    }                                                                                 \
  } while (0)
struct GBar { unsigned* bar; unsigned x, nloc, nx; };
DI void gbar_complete(unsigned* bar, unsigned x, unsigned& nloc, unsigned& nx) {
  const unsigned G = gridDim.x;
  unsigned sum, cnt, mine, sp = 0u;
  for (;;) {
    sum = 0u; cnt = 0u; mine = 0u;
#pragma unroll
    for (unsigned j = 0; j < 16; ++j) {
      const unsigned c = xb_ld(&bar[XB_XCNT(j)]);
      sum += c; cnt += (c > 0u) ? 1u : 0u; mine = (j == x) ? c : mine;
    }
    if (sum == G) break;
    __builtin_amdgcn_s_sleep(1);
    if ((++sp & 255u) == 0u) {
      if (xb_ld(&bar[XB_TMO])) break;
      if (sp > XB_SPIN_CAP) { atomicAdd(&bar[XB_TMO], 1u); break; }
    }
  }
  nloc = mine > 0u ? mine : 1u;
  nx = cnt > 0u ? cnt : 1u;
}
DI void gbar(GBar& b) {
  asm volatile("s_waitcnt vmcnt(0)" ::: "memory");
  __syncthreads();
  if (threadIdx.x == 0) {
    unsigned* bar = b.bar;
    __builtin_amdgcn_s_waitcnt(0);
    if (b.nloc == 0u) gbar_complete(bar, b.x, b.nloc, b.nx);
    const unsigned nloc = b.nloc, nx = b.nx;
    const unsigned old = xb_add(&bar[XB_XSUB(b.x)], 1u);
    const unsigned gen = old / nloc;
    if (old + 1u == (gen + 1u) * nloc) {
      __builtin_amdgcn_fence(__ATOMIC_RELEASE, "agent");
      asm volatile("s_waitcnt vmcnt(0)" ::: "memory");
      const unsigned og = xb_add(&bar[XB_TOP], 1u);
      const unsigned tg = og / nx;
      if (og + 1u == (tg + 1u) * nx) xb_add(&bar[XB_TOPGEN], 1u);
      else XB_SPIN(xb_ld(&bar[XB_TOPGEN]) == tg, bar);
      __builtin_amdgcn_fence(__ATOMIC_ACQUIRE, "agent");
      xb_add(&bar[XB_XGEN(b.x)], 1u);
      asm volatile("s_waitcnt vmcnt(0)" ::: "memory");
    } else {
      XB_SPIN(xb_ld(&bar[XB_XGEN(b.x)]) == gen, bar);
      __builtin_amdgcn_fence(__ATOMIC_ACQUIRE, "agent");
      asm volatile("s_waitcnt vmcnt(0)" ::: "memory");
    }
  }
  __syncthreads();
}

template <class Setup, class Epi>
DI void gemm_phase128(char* smem, int s0, int s_end, int s_step, Setup setup, int ldb, Epi epi) {
  if (s0 >= s_end) return;
  u16* sA0 = (u16*)smem;
  u16* sB0 = sA0 + 128 * LDT;
  u16* sA1 = sB0 + 128 * LDT;
  u16* sB1 = sA1 + 128 * LDT;
  const int tid = otid(), lane = tid & 63, w = tid >> 6, r = lane & 31, h = lane >> 5;
  const int a_r0 = tid >> 3, a_c = (tid & 7) * 8;
  const int b_n4 = tid & 31, b_kq = tid >> 5;
  const u16 *apb0, *apb1, *apb2, *apb3;
  const float* bp;
  setup(s0, a_r0, a_c, b_n4, b_kq, apb0, apb1, apb2, apb3, bp);

  u32x4 pa0, pa1, pa2, pa3;
  f32x4 pb[8];

#define G_LOAD(KT)                                                                       \
  {                                                                                      \
    const int k0_ = (KT) * 64;                                                           \
    pa0 = *(const u32x4*)(apb0 + k0_);                                                   \
    pa1 = *(const u32x4*)(apb1 + k0_);                                                   \
    pa2 = *(const u32x4*)(apb2 + k0_);                                                   \
    pa3 = *(const u32x4*)(apb3 + k0_);                                                   \
    _Pragma("unroll") for (int i_ = 0; i_ < 8; ++i_) pb[i_] = *(const f32x4*)(bp + (size_t)(k0_ + i_) * ldb); \
  }
#define G_STAGE(SA, SBB)                                                                 \
  {                                                                                      \
    *(u32x4*)&SA[(a_r0)*LDT + a_c] = pa0;                                                \
    *(u32x4*)&SA[(a_r0 + 32) * LDT + a_c] = pa1;                                         \
    *(u32x4*)&SA[(a_r0 + 64) * LDT + a_c] = pa2;                                         \
    *(u32x4*)&SA[(a_r0 + 96) * LDT + a_c] = pa3;                                         \
    _Pragma("unroll") for (int j_ = 0; j_ < 4; ++j_) {                                   \
      u32x4 pk_;                                                                         \
      pk_.x = pack2(pb[0][j_], pb[1][j_]);                                               \
      pk_.y = pack2(pb[2][j_], pb[3][j_]);                                               \
      pk_.z = pack2(pb[4][j_], pb[5][j_]);                                               \
      pk_.w = pack2(pb[6][j_], pb[7][j_]);                                               \
      *(u32x4*)&SBB[(j_ * 32 + b_n4) * LDT + b_kq * 8] = pk_;                            \
    }                                                                                    \
  }
  const int aoff = (w * 32 + r) * LDT + 8 * h, boff = r * LDT + 8 * h;
#define G_FRAG(BUF, SA, SBB, KS)                                                         \
  {                                                                                      \
    fa[BUF] = *(const bf16x8*)(SA + aoff + (KS) * 16);                                   \
    fb[BUF][0] = *(const bf16x8*)(SBB + boff + (KS) * 16);                               \
    fb[BUF][1] = *(const bf16x8*)(SBB + boff + 32 * LDT + (KS) * 16);                    \
    fb[BUF][2] = *(const bf16x8*)(SBB + boff + 64 * LDT + (KS) * 16);                    \
    fb[BUF][3] = *(const bf16x8*)(SBB + boff + 96 * LDT + (KS) * 16);                    \
  }
#define G_MFMA(BUF)                                                                      \
  {                                                                                      \
    acc[0] = MFMA(fa[BUF], fb[BUF][0], acc[0]);                                          \
    acc[1] = MFMA(fa[BUF], fb[BUF][1], acc[1]);                                          \
    acc[2] = MFMA(fa[BUF], fb[BUF][2], acc[2]);                                          \
    acc[3] = MFMA(fa[BUF], fb[BUF][3], acc[3]);                                          \
  }
#define SB() __builtin_amdgcn_sched_barrier(0)
#define G_COMPUTE(SA, SBB)                                                               \
  {                                                                                      \
    bf16x8 fa[2], fb[2][4];                                                              \
    G_FRAG(0, SA, SBB, 0);                                                               \
    G_FRAG(1, SA, SBB, 1);                                                               \
    SB();                                                                                \
    G_MFMA(0);                                                                           \
    SB();                                                                                \
    G_FRAG(0, SA, SBB, 2);                                                               \
    SB();                                                                                \
    G_MFMA(1);                                                                           \
    SB();                                                                                \
    G_FRAG(1, SA, SBB, 3);                                                               \
    SB();                                                                                \
    G_MFMA(0);                                                                           \
    SB();                                                                                \
    G_MFMA(1);                                                                           \
    SB();                                                                                \
  }

  G_LOAD(0);
  __syncthreads();
#pragma unroll 1
  for (int s = s0; s < s_end; s += s_step) {
    f32x16 acc[4];
#pragma unroll
    for (int a = 0; a < 4; ++a)
#pragma unroll
      for (int i = 0; i < 16; ++i) acc[a][i] = 0.f;
    const int sn = s + s_step;
    const bool has_next = sn < s_end;
    const u16 *n0 = apb0, *n1 = apb1, *n2 = apb2, *n3 = apb3;
    const float* nbp = bp;
    if (has_next) setup(sn, a_r0, a_c, b_n4, b_kq, n0, n1, n2, n3, nbp);
#pragma unroll 1
    for (int kt = 0; kt < 16; kt += 2) {
      G_STAGE(sA0, sB0);
      __syncthreads();
      G_LOAD(kt + 1);
      G_COMPUTE(sA0, sB0);
      G_STAGE(sA1, sB1);
      __syncthreads();
      {
        int kn = kt + 2;
        if (kt == 14) { apb0 = n0; apb1 = n1; apb2 = n2; apb3 = n3; bp = nbp; kn = 0; }
        G_LOAD(kn);
      }
      G_COMPUTE(sA1, sB1);
    }
    epi(s, acc, w, r, h);
  }
  __syncthreads();
#undef G_LOAD
#undef G_STAGE
#undef G_COMPUTE
#undef G_FRAG
#undef G_MFMA
}
#undef SB

template <bool CONTIG, class Setup, class Epi, class Pre>
DI void gemm_phase(char* smem, int s0, int s_end, int s_step, Setup setup, int ldb, Epi epi, Pre pre) {
  asm volatile("" : "+s"(s_end));
  if (s0 >= s_end) return;
  constexpr int LDK = 40;
  u16* sA0 = (u16*)smem;
  u16* sB0 = sA0 + 256 * LDK;
  u16* sA1 = sB0 + 128 * LDK;
  u16* sB1 = sA1 + 256 * LDK;
  const int tid = otid(), lane = tid & 63, w = tid >> 6, r = lane & 31, h = lane >> 5;
  const int a_r0 = tid >> 2, a_c = (tid & 3) * 8;
  const int b_n4 = tid & 31, b_kq = tid >> 5;
  const u16* abase;
  const float* bbase;
  unsigned ao0, ao1, ao2, ao3, bo;
  setup(s0, a_r0, a_c, b_n4, b_kq, abase, ao0, ao1, ao2, ao3, bbase, bo);

  u32x4 pa0, pa1, pa2, pa3;
  f32x4 pbA[4], pbB[4];

#define G_LOADA(KT)                                                                      \
  {                                                                                      \
    const int k0_ = (((KT) + rot) & 31) * 32;               \
    pa0 = *(const u32x4*)(abase + k0_ + (size_t)ao0);                                    \
    pa1 = *(const u32x4*)(abase + k0_ + (size_t)(CONTIG ? ao0 + 64u * DM : ao1));        \
    pa2 = *(const u32x4*)(abase + k0_ + (size_t)(CONTIG ? ao0 + 128u * DM : ao2));       \
    pa3 = *(const u32x4*)(abase + k0_ + (size_t)(CONTIG ? ao0 + 192u * DM : ao3));       \
  }
#define G_LOADB(PB, BP, KT, ROT)                                                         \
  {                                                                                      \
    const int k0_ = (((KT) + (ROT)) & 31) * 32;                                          \
    _Pragma("unroll") for (int i_ = 0; i_ < 4; ++i_) PB[i_] = *(const f32x4*)((BP) + (size_t)(k0_ + i_) * ldb + (size_t)bo); \
  }
#define G_STAGE(SA, SBB, PB)                                                               \
  {                                                                                      \
    *(u32x4*)&SA[(a_r0)*LDK + a_c] = pa0;                                                \
    *(u32x4*)&SA[(a_r0 + 64) * LDK + a_c] = pa1;                                         \
    *(u32x4*)&SA[(a_r0 + 128) * LDK + a_c] = pa2;                                        \
    *(u32x4*)&SA[(a_r0 + 192) * LDK + a_c] = pa3;                                        \
    _Pragma("unroll") for (int j_ = 0; j_ < 4; ++j_) {                                   \
      uint2 pk_;                                                                         \
      pk_.x = pack2(PB[0][j_], PB[1][j_]);                                               \
      pk_.y = pack2(PB[2][j_], PB[3][j_]);                                               \
      *(uint2*)&SBB[(j_ * 32 + b_n4) * LDK + b_kq * 4] = pk_;                            \
    }                                                                                    \
  }
  const int aoff = (w * 64 + r) * LDK + 8 * h, boff = r * LDK + 8 * h;
#define G_FRAG(FA, FB, SA, SBB, KS)                                                      \
  {                                                                                      \
    FA[0] = *(const bf16x8*)(SA + aoff + (KS) * 16);                                     \
    FA[1] = *(const bf16x8*)(SA + aoff + 32 * LDK + (KS) * 16);                          \
    FB[0] = *(const bf16x8*)(SBB + boff + (KS) * 16);                                    \
    FB[1] = *(const bf16x8*)(SBB + boff + 32 * LDK + (KS) * 16);                         \
    FB[2] = *(const bf16x8*)(SBB + boff + 64 * LDK + (KS) * 16);                         \
    FB[3] = *(const bf16x8*)(SBB + boff + 96 * LDK + (KS) * 16);                         \
  }
#define G_MFMA(FA, FB)                                                                   \
  {                                                                                      \
    _Pragma("unroll") for (int mt_ = 0; mt_ < 2; ++mt_)                                  \
    _Pragma("unroll") for (int nt_ = 0; nt_ < 4; ++nt_) acc[mt_][nt_] = MFMA(FA[mt_], FB[nt_], acc[mt_][nt_]); \
  }
#define SB() __builtin_amdgcn_sched_barrier(0)
#define G_COMPUTE(SA, SBB)                                                               \
  {                                                                                      \
    bf16x8 fa0[2], fb0[4];                                                               \
    G_FRAG(fa0, fb0, SA, SBB, 0);                                                        \
    SB();                                                                                \
    G_MFMA(fa0, fb0);                                                                    \
    SB();                                                                                \
    G_FRAG(fa0, fb0, SA, SBB, 1);                                                        \
    SB();                                                                                \
    G_MFMA(fa0, fb0);                                                                    \
    SB();                                                                                \
  }

  int rot = (s0 % 6);
  G_LOADA(0);
  G_LOADB(pbA, bbase, 0, rot);
  G_LOADB(pbB, bbase, 1, rot);
  __syncthreads();
#pragma unroll 1
  for (int s = s0; s < s_end; s += s_step) {
    f32x16 acc[2][4];
#pragma unroll
    for (int a = 0; a < 2; ++a)
#pragma unroll
      for (int b = 0; b < 4; ++b)
#pragma unroll
        for (int i = 0; i < 16; ++i) acc[a][b][i] = 0.f;
    pre(s, tid);
    const int sn = s + s_step;
    const bool has_next = sn < s_end;
    const u16* nabase = abase;
    const float* nbbase = bbase;
    unsigned n0 = ao0, n1 = ao1, n2 = ao2, n3 = ao3, nbo = bo;
    if (has_next) setup(sn, a_r0, a_c, b_n4, b_kq, nabase, n0, n1, n2, n3, nbbase, nbo);
    const int nrot = has_next ? (sn % 6) : rot;
#pragma unroll 1
    for (int kt = 0; kt < 32; kt += 2) {
      G_STAGE(sA0, sB0, pbA);
      G_LOADA(kt + 1);
      __syncthreads();
      {
        const bool last = (kt == 30);
        const float* bq = last ? nbbase : bbase;
        const int kb = last ? 0 : kt + 2;
        G_LOADB(pbA, bq, kb, last ? nrot : rot);
      }
      G_COMPUTE(sA0, sB0);
      G_STAGE(sA1, sB1, pbB);
      {
        int ka = kt + 2, kb = kt + 3;
        if (kt == 30) { abase = nabase; ao0 = n0; ao1 = n1; ao2 = n2; ao3 = n3; bbase = nbbase; rot = nrot; ka = 0; kb = 1; }
        G_LOADA(ka);
        G_LOADB(pbB, bbase, kb, rot);
      }
      __syncthreads();
      G_COMPUTE(sA1, sB1);
    }
    epi(s, acc, w, r, h);
  }
  __syncthreads();
#undef G_LOADA
#undef G_LOADB
#undef G_STAGE
#undef G_COMPUTE
#undef G_FRAG
#undef G_MFMA
}

DI void load4x4(const void* base, int stride, bool isf32, int rq, int c4, float v[4][4]) {
  if (isf32) {
#pragma unroll
    for (int i = 0; i < 4; ++i) {
      const float4 x = *(const float4*)((const float*)base + (size_t)(4 * rq + i) * stride + 4 * c4);
      v[i][0] = x.x; v[i][1] = x.y; v[i][2] = x.z; v[i][3] = x.w;
    }
  } else {
#pragma unroll
    for (int i = 0; i < 4; ++i) {
      const uint2 x = *(const uint2*)((const u16*)base + (size_t)(4 * rq + i) * stride + 4 * c4);
      v[i][0] = bflo(x.x); v[i][1] = bfhi(x.x); v[i][2] = bflo(x.y); v[i][3] = bfhi(x.y);
    }
  }
}
DI void store_n(u16* dst, int ld, int row0, int rq, int c4, const float v[4][4]) {
#pragma unroll
  for (int i = 0; i < 4; ++i) {
    uint2 pk = {pack2(v[i][0], v[i][1]), pack2(v[i][2], v[i][3])};
    *(uint2*)&dst[(row0 + 4 * rq + i) * ld + 4 * c4] = pk;
  }
}
DI void store_t(u16* dst, int ld, int col0, int rq, int c4, const float v[4][4], const float s[4]) {
#pragma unroll
  for (int j = 0; j < 4; ++j) {
    uint2 pk = {pack2(v[0][j] * s[0], v[1][j] * s[1]), pack2(v[2][j] * s[2], v[3][j] * s[3])};
    *(uint2*)&dst[(4 * c4 + j) * ld + col0 + 4 * rq] = pk;
  }
}

DI void attn_load(const u16* kp, const u16* vp, int stride, int rq, int c4, uint2 (&k)[4], uint2 (&v)[4]) {
#pragma unroll
  for (int i = 0; i < 4; ++i) {
    k[i] = *(const uint2*)(kp + (size_t)(4 * rq + i) * stride + 4 * c4);
    v[i] = *(const uint2*)(vp + (size_t)(4 * rq + i) * stride + 4 * c4);
  }
}
DI void attn_stage(u16* sK, u16* sVT, int rq, int c4, const uint2 (&k)[4], const uint2 (&v)[4]) {
#pragma unroll
  for (int i = 0; i < 4; ++i) *(uint2*)&sK[(4 * rq + i) * LDT + 4 * c4] = k[i];
  uint2 t0, t1, t2, t3;
  t0.x = (v[0].x & 0xffffu) | (v[1].x << 16);          t0.y = (v[2].x & 0xffffu) | (v[3].x << 16);
  t1.x = (v[0].x >> 16) | (v[1].x & 0xffff0000u);      t1.y = (v[2].x >> 16) | (v[3].x & 0xffff0000u);
  t2.x = (v[0].y & 0xffffu) | (v[1].y << 16);          t2.y = (v[2].y & 0xffffu) | (v[3].y << 16);
  t3.x = (v[0].y >> 16) | (v[1].y & 0xffff0000u);      t3.y = (v[2].y >> 16) | (v[3].y & 0xffff0000u);
  const int qs = 4 * (rq ^ ((c4 >> 1) & 7));
  *(uint2*)&sVT[(4 * c4 + 0) * LDT + qs] = t0;
  *(uint2*)&sVT[(4 * c4 + 1) * LDT + qs] = t1;
  *(uint2*)&sVT[(4 * c4 + 2) * LDT + qs] = t2;
  *(uint2*)&sVT[(4 * c4 + 3) * LDT + qs] = t3;
}

template <class TileSrc, class BiasF, class TMode>
DI void attn_core(char* smem, const u16* qbase, int ntiles, TileSrc src, BiasF biasf, TMode tmode, float m_init, bool has_sink, u16* obase) {
  u16* sK0 = (u16*)smem;
  u16* sVT0 = sK0 + 64 * LDT;
  u16* sK1 = sVT0 + 64 * LDT;
  u16* sVT1 = sK1 + 64 * LDT;
  const int tid = otid(), lane = tid & 63, w = tid >> 6, r = lane & 31, h = lane >> 5;
  const int rq = tid >> 4, c4 = tid & 15;
  const int ql = w * 32 + r;
  bf16x8 qf[4];
#pragma unroll
  for (int ks = 0; ks < 4; ++ks) qf[ks] = *(const bf16x8*)(qbase + (size_t)ql * DIN + ks * 16 + 8 * h);
  f32x16 O[2];
#pragma unroll
  for (int d = 0; d < 2; ++d)
#pragma unroll
    for (int i = 0; i < 16; ++i) O[d][i] = 0.f;
  float m = m_init, lsum = (has_sink && h == 0) ? 1.f : 0.f;

  auto nextv = [&](int j, const u16*& kp, const u16*& vp, int& stride) -> int {
    while (j < ntiles && !src(j, kp, vp, stride)) ++j;
    return j;
  };
  auto compute = [&](int jc, const u16* sK, const u16* sVT) {
    const int mode = tmode(jc, w);
    if (mode != 2) {
      f32x16 S[2];
#pragma unroll
      for (int mt = 0; mt < 2; ++mt)
#pragma unroll
        for (int i = 0; i < 16; ++i) S[mt][i] = 0.f;
#pragma unroll
      for (int ks = 0; ks < 4; ++ks)
#pragma unroll
        for (int mt = 0; mt < 2; ++mt) {
          const bf16x8 kf = *(const bf16x8*)&sK[(mt * 32 + r) * LDT + ks * 16 + 8 * h];
          S[mt] = MFMA(kf, qf[ks], S[mt]);
        }
      const float C2 = 0.125f * 1.44269504f;
      float mx = NEG;
      if (mode == 1) {
#pragma unroll
        for (int mt = 0; mt < 2; ++mt)
#pragma unroll
          for (int i = 0; i < 16; ++i) {
            const float s = S[mt][i] * C2 + biasf(jc, mt * 32 + crow(i, h), ql);
            S[mt][i] = s;
            mx = fmaxf(mx, s);
          }
      } else {
#pragma unroll
        for (int mt = 0; mt < 2; ++mt)
#pragma unroll
          for (int i = 0; i < 16; ++i) {
            const float s = S[mt][i] * C2;
            S[mt][i] = s;
            mx = fmaxf(mx, s);
          }
      }
      mx = fmaxf(mx, __shfl_xor(mx, 32));
      const float mn = fmaxf(m, mx);
      if (__any(mn > m)) {
        const float alpha = __builtin_amdgcn_exp2f(m - mn);
        m = mn;
        lsum *= alpha;
#pragma unroll
        for (int d = 0; d < 2; ++d)
#pragma unroll
          for (int i = 0; i < 16; ++i) O[d][i] *= alpha;
      }
      float ps = 0.f;
#pragma unroll
      for (int mt = 0; mt < 2; ++mt)
#pragma unroll
        for (int i = 0; i < 16; ++i) {
          const float pv = __builtin_amdgcn_exp2f(S[mt][i] - m);
          S[mt][i] = pv;
          ps += pv;
        }
      lsum += ps;
#pragma unroll
      for (int mt = 0; mt < 2; ++mt)
#pragma unroll
        for (int s = 0; s < 2; ++s) {
          const bf16x8 pf = mk8(pack2(S[mt][8 * s + 0], S[mt][8 * s + 1]), pack2(S[mt][8 * s + 2], S[mt][8 * s + 3]),
                                pack2(S[mt][8 * s + 4], S[mt][8 * s + 5]), pack2(S[mt][8 * s + 6], S[mt][8 * s + 7]));
#pragma unroll
          for (int d = 0; d < 2; ++d) {
            const int sw = (d * 4 + (r >> 3)) & 7, q = mt * 8 + 4 * s + h;
            const u16* vrow = &sVT[(d * 32 + r) * LDT];
            const uint2 lo = *(const uint2*)(vrow + 4 * (q ^ sw));
            const uint2 hi = *(const uint2*)(vrow + 4 * ((q + 2) ^ sw));
            O[d] = MFMA(mk8(lo.x, lo.y, hi.x, hi.y), pf, O[d]);
          }
        }
    }
  };

  uint2 kA[4], vA[4], kB[4], vB[4];
#pragma unroll
  for (int i = 0; i < 4; ++i) { kA[i] = make_uint2(0u, 0u); vA[i] = kA[i]; kB[i] = kA[i]; vB[i] = kA[i]; }
  const u16 *kp = nullptr, *vp = nullptr;
  int stride = 0;
  int jA = nextv(0, kp, vp, stride);
  if (jA < ntiles) attn_load(kp, vp, stride, rq, c4, kA, vA);
  int jB = nextv(jA + 1, kp, vp, stride);
  if (jB < ntiles) attn_load(kp, vp, stride, rq, c4, kB, vB);
  __syncthreads();
#pragma unroll 1
  for (;;) {
    if (jA >= ntiles) break;
    attn_stage(sK0, sVT0, rq, c4, kA, vA);
    {
      const int jc = jA;
      jA = nextv(jB + 1, kp, vp, stride);
      if (jA < ntiles) attn_load(kp, vp, stride, rq, c4, kA, vA);
      __syncthreads();
      compute(jc, sK0, sVT0);
    }
    if (jB >= ntiles) break;
    attn_stage(sK1, sVT1, rq, c4, kB, vB);
    {
      const int jc = jB;
      jB = nextv(jA + 1, kp, vp, stride);
      if (jB < ntiles) attn_load(kp, vp, stride, rq, c4, kB, vB);
      __syncthreads();
      compute(jc, sK1, sVT1);
    }
  }
  const float l = lsum + __shfl_xor(lsum, 32);
  const float inv = 1.f / l;
#pragma unroll
  for (int d = 0; d < 2; ++d)
#pragma unroll
    for (int g = 0; g < 4; ++g) {
      uint2 pk = {pack2(O[d][4 * g + 0] * inv, O[d][4 * g + 1] * inv), pack2(O[d][4 * g + 2] * inv, O[d][4 * g + 3] * inv)};
      *(uint2*)(obase + (size_t)ql * DM + d * 32 + 8 * g + 4 * h) = pk;
    }
}

DI void phase0(const Params& p, char* smem) {
  const int tid = otid();
  if (blockIdx.x == 0) {
    for (int idx = tid; idx < 1024; idx += 256) {
      const int pos = idx >> 4, j = idx & 15;
      const double inv = 1.0 / pow(10000.0, (double)j / 16.0);
      const float ang = (float)((double)pos * inv);
      p.ROPE[idx] = cosf(ang);
      p.ROPE[1024 + idx] = sinf(ang);
    }
  }
  float* scond = (float*)smem;
  for (int item = blockIdx.x; item < 768; item += gridDim.x) {
    const int l = item / 384, ks = (item / 24) % 16, jb = item % 24;
    __syncthreads();
    for (int idx = tid; idx < 320; idx += 256) {
      const int c = idx / 64, k = ks * 64 + (idx & 63);
      const float v = (c == 0) ? p.c_ctx[k] : p.c[(c - 1) * DM + k];
      scond[idx] = silu(v);
    }
    __syncthreads();
    const int j = jb * 256 + tid;
    const float* wp = p.w_ada + ((size_t)l * DM + ks * 64) * 6144 + j;
    float a[5] = {0.f, 0.f, 0.f, 0.f, 0.f};
#pragma unroll 8
    for (int k = 0; k < 64; ++k) {
      const float wv = wp[(size_t)k * 6144];
#pragma unroll
      for (int c = 0; c < 5; ++c) a[c] += scond[c * 64 + k] * wv;
    }
    const float bias = (ks == 0) ? p.b_ada[l * 6144 + j] : 0.f;
#pragma unroll
    for (int c = 0; c < 5; ++c) unsafeAtomicAdd(&p.MOD[(l * 5 + c) * 6144 + j], a[c] + bias);
  }
}

DI int cond_of(int T) { return T < NCTX ? 0 : 1 + ((T - NCTX) >> 11); }

DI void cvt_f32_bf16(const float* s, u16* d, int n4, int gtid, int gsz) {
  for (int i = gtid; i < n4; i += gsz) {
    const float4 x = *(const float4*)(s + (size_t)i * 4);
    uint2 pk = {pack2(x.x, x.y), pack2(x.z, x.w)};
    *(uint2*)(d + (size_t)i * 4) = pk;
  }
}
DI void phase0b(const Params& p) {
  const int tid = otid(), lane = tid & 63, w = tid >> 6;
  {
    const int gtid = blockIdx.x * 256 + tid, gsz = gridDim.x * 256;
    cvt_f32_bf16(p.cak, p.CAK, 4 * 2 * 512 * 128 / 4, gtid, gsz);
    cvt_f32_bf16(p.cav, p.CAV, 4 * 2 * 512 * 128 / 4, gtid, gsz);
    cvt_f32_bf16(p.cbk, p.CBK, 4 * 2 * 512 * 256 / 4, gtid, gsz);
    cvt_f32_bf16(p.cbv, p.CBV, 4 * 2 * 512 * 256 / 4, gtid, gsz);
  }
  for (int T = blockIdx.x * 4 + w; T < NTOK; T += gridDim.x * 4) {
    const float* mod = p.MOD + (size_t)cond_of(T) * 6144;
    const float* xr = (T < NCTX) ? (p.x_prompt + (size_t)T * DM) : (p.x_sample + (size_t)(T - NCTX) * DM);
#pragma unroll
    for (int i = 0; i < 4; ++i) {
      const int k = 256 * i + 4 * lane;
      const float4 x = *(const float4*)(xr + k);
      const float4 sc = *(const float4*)(mod + 1024 + k), sh = *(const float4*)(mod + k);
      uint2 pk = {pack2(x.x * (1.f + sc.x) + sh.x, x.y * (1.f + sc.y) + sh.y), pack2(x.z * (1.f + sc.z) + sh.z, x.w * (1.f + sc.w) + sh.w)};
      *(uint2*)(p.H2 + (size_t)T * DM + k) = pk;
    }
  }
}

DI void phase1(const Params& p, char* smem, int l) {
  const float* W = p.w_in + (size_t)l * DM * DIN;
  const int xcd = blockIdx.x & 7, nloc = gridDim.x >> 3;
  float* sR = (float*)(smem + 61440);
  for (int idx = otid(); idx < 2048; idx += 256) sR[idx] = p.ROPE[idx];
  auto setup = [&](int s, int ar0, int ac, int n4, int kq, const u16*& ab, unsigned& o0, unsigned& o1, unsigned& o2, unsigned& o3, const float*& bb, unsigned& bo) {
    const int tm = 6 * xcd + s % 6, tn = s / 6;
    ab = p.H2 + (size_t)tm * 256 * DM;
    o0 = (unsigned)(ar0 * DM + ac); o1 = o0 + 64u * DM; o2 = o0 + 128u * DM; o3 = o0 + 192u * DM;
    bb = W + tn * 128;
    bo = (unsigned)(4 * n4 + kq * 4 * DIN);
  };
  auto epi = [&](int s, f32x16(&acc)[2][4], int w, int r, int h) {
    int hq = h;
    asm volatile("" : "+v"(hq));
    const int tm = 6 * xcd + s % 6, tn = s / 6;
    const int m0 = tm * 256, n0 = tn * 128;
    const bool lat = m0 >= NCTX;
    const bool rope = lat && (n0 < 640);
    const int n = n0 + 4 * r;
    const int q = (r >> 2) & 3;
#pragma unroll
    for (int mt = 0; mt < 2; ++mt)
#pragma unroll
    for (int i = 0; i < 16; ++i) {
      const int T = m0 + w * 64 + mt * 32 + crow(i, hq);
      float v0 = acc[mt][0][i], v1 = acc[mt][1][i], v2 = acc[mt][2][i], v3 = acc[mt][3][i];
      if (rope) {
        const int t = (T - NCTX) & 2047;
        const int pos = (q < 2) ? (t >> 6) : (t & 63);
        const int jf = 4 * (r & 3);
        const float4 cs = *(const float4*)(sR + pos * 16 + jf), sn = *(const float4*)(sR + 1024 + pos * 16 + jf);
        const float o0 = __shfl_xor(v0, 4), o1 = __shfl_xor(v1, 4), o2 = __shfl_xor(v2, 4), o3 = __shfl_xor(v3, 4);
        if (q & 1) { v0 = o0 * sn.x + v0 * cs.x; v1 = o1 * sn.y + v1 * cs.y; v2 = o2 * sn.z + v2 * cs.z; v3 = o3 * sn.w + v3 * cs.w; }
        else { v0 = v0 * cs.x - o0 * sn.x; v1 = v1 * cs.y - o1 * sn.y; v2 = v2 * cs.z - o2 * sn.z; v3 = v3 * cs.w - o3 * sn.w; }
      }
      uint2 pk = {pack2(v0, v1), pack2(v2, v3)};
      *(uint2*)(p.QKV + (size_t)T * DIN + n) = pk;
      if (!lat) {
        const int b = T >> 8, t = T & 255;
        const float4 vv = {v0, v1, v2, v3};
        if (n0 == 512) *(float4*)(p.out + OFF_AK + ((size_t)(b * 2 + l) * 256 + t) * 128 + (n - 512)) = vv;
        else if (n0 == 640) *(float4*)(p.out + OFF_AV + ((size_t)(b * 2 + l) * 256 + t) * 128 + (n - 640)) = vv;
        else if (n0 == 1024 || n0 == 1152) *(float4*)(p.out + OFF_BK + ((size_t)(b * 2 + l) * 256 + t) * 256 + (n - 1024)) = vv;
        else if (n0 == 1280 || n0 == 1408) *(float4*)(p.out + OFF_BV + ((size_t)(b * 2 + l) * 256 + t) * 256 + (n - 1280)) = vv;
      }
      if ((i & 3) == 3) __builtin_amdgcn_sched_barrier(0);
    }
  };
  gemm_phase<true>(smem, blockIdx.x >> 3, 120, nloc, setup, DIN, epi, [](int, int) {});
}

DI float ret_lg(const Params& p, int l, int dir, int head) { return -__expf(p.decay[(l * 2 + dir) * 4 + head]); }

DI size_t kvs_slot(int req, int head, int dir, int c) { return ((size_t)((req * 4 + head) * 2 + dir) * 16 + c) * 4096; }

DI void retkv_item(const Params& p, char* smem, int l, int req, int head, int c) {
  u16* sKTf = (u16*)smem;
  u16* sKTb = sKTf + 64 * LDT2;
  u16* sVT = sKTb + 64 * LDT2;
  const int tid = otid(), lane = tid & 63, w = tid >> 6, r = lane & 31, h = lane >> 5;
  const int rq = tid >> 4, c4 = tid & 15;
  const int T0 = (req < 16 ? req * 256 : NCTX + (req - 16) * 2048) + c * 128;
  const float lgf = ret_lg(p, l, 0, head), lgb = ret_lg(p, l, 1, head);
  const float one4[4] = {1.f, 1.f, 1.f, 1.f};
  __syncthreads();
#pragma unroll
  for (int half = 0; half < 2; ++half) {
    float v[4][4];
    float sf[4], sb[4];
#pragma unroll
    for (int i = 0; i < 4; ++i) {
      const int j = half * 64 + 4 * rq + i;
      sf[i] = 0.125f * __expf(lgf * (float)(127 - j));
      sb[i] = 0.125f * __expf(lgb * (float)j);
    }
    load4x4(p.QKV + (size_t)(T0 + half * 64) * DIN + 1792 + head * 64, DIN, false, rq, c4, v);
    store_t(sKTf, LDT2, half * 64, rq, c4, v, sf);
    store_t(sKTb, LDT2, half * 64, rq, c4, v, sb);
    load4x4(p.QKV + (size_t)(T0 + half * 64) * DIN + 2048 + head * 64, DIN, false, rq, c4, v);
    store_t(sVT, LDT2, half * 64, rq, c4, v, one4);
  }
  __syncthreads();
  const int dir = w >> 1, mt = w & 1;
  const u16* sKT = dir ? sKTb : sKTf;
  f32x16 acc[2];
#pragma unroll
  for (int nt = 0; nt < 2; ++nt)
#pragma unroll
    for (int i = 0; i < 16; ++i) acc[nt][i] = 0.f;
#pragma unroll
  for (int ks = 0; ks < 8; ++ks) {
    const bf16x8 fa = *(const bf16x8*)&sKT[(mt * 32 + r) * LDT2 + ks * 16 + 8 * h];
#pragma unroll
    for (int nt = 0; nt < 2; ++nt) {
      const bf16x8 fb = *(const bf16x8*)&sVT[(nt * 32 + r) * LDT2 + ks * 16 + 8 * h];
      acc[nt] = MFMA(fa, fb, acc[nt]);
    }
  }
  float* dst = p.KVS + kvs_slot(req, head, dir, c);
#pragma unroll
  for (int nt = 0; nt < 2; ++nt)
#pragma unroll
    for (int i = 0; i < 16; ++i) dst[(mt * 32 + crow(i, h)) * 64 + nt * 32 + r] = acc[nt][i];
}

DI void phase2(const Params& p, char* smem, int l) {
  const int tid = otid();
  for (int item = blockIdx.x; item < 1536; item += gridDim.x) {
    if (item < 512) {
      const int b = item >> 7, head = (item >> 4) & 7, qb = item & 15, kvh = head >> 2;
      const int T0 = NCTX + b * 2048 + qb * 128;
      const u16* ck = p.CAK + ((size_t)(b * 2 + l) * 512) * 128 + kvh * 64;
      const u16* cv = p.CAV + ((size_t)(b * 2 + l) * 512) * 128 + kvh * 64;
      auto src = [&](int j, const u16*& kp, const u16*& vp, int& stride) -> bool {
        if (j < 8) {
          kp = ck + (size_t)j * 64 * 128; vp = cv + (size_t)j * 64 * 128; stride = 128;
          return true;
        }
        const int jj = j - 8, kb = qb - 1 + (jj >> 1);
        if (kb < 0 || kb >= 16) return false;
        const int Tk = NCTX + b * 2048 + kb * 128 + (jj & 1) * 64;
        kp = p.QKV + (size_t)Tk * DIN + 512 + kvh * 64; vp = p.QKV + (size_t)Tk * DIN + 640 + kvh * 64; stride = DIN;
        return true;
      };
      auto biasf = [&](int j, int key, int ql) -> float {
        if (j < 8) return 0.f;
        const int jj = j - 8;
        const int kj = (qb - 1 + (jj >> 1)) * 128 + (jj & 1) * 64 + key;
        const int qi = qb * 128 + ql;
        const int d = qi - kj;
        return (d <= 128 && d >= -128) ? 0.f : NEG;
      };
      auto tmode = [&](int j, int w) -> int {
        if (j < 8) return 0;
        const int jj = j - 8;
        const int k0 = (qb - 1 + (jj >> 1)) * 128 + (jj & 1) * 64, q0w = qb * 128 + w * 32;
        if (k0 - (q0w + 31) > 128 || q0w - (k0 + 63) > 128) return 2;
        if ((q0w + 31) - k0 <= 128 && (k0 + 63) - q0w <= 128) return 0;
        return 1;
      };
      attn_core(smem, p.QKV + (size_t)T0 * DIN + head * 64, 14, src, biasf, tmode, p.sink[l * 8 + head] * 1.44269504f, true,
                p.CAT + (size_t)T0 * DM + head * 64);
    } else if (item < 768) {
      const int it = item - 512;
      const int b = it >> 6, head = (it >> 4) & 3, qb = it & 15;
      const int T0 = NCTX + b * 2048 + qb * 128;
      float* srpb = (float*)(smem + 4 * 64 * LDT * 2);
      __syncthreads();
      for (int idx = tid; idx < 465; idx += 256) srpb[idx] = p.rpb[(size_t)(l * 4 + head) * 465 + idx] * 1.44269504f;
      const int r0 = 2 * qb;
      const int rmin = min(max(r0 - 4, 0), 24), rmax = min(max(r0 + 1 - 4, 0), 24) + 7;
      const u16* ck = p.CBK + ((size_t)(b * 2 + l) * 512) * 256 + head * 64;
      const u16* cv = p.CBV + ((size_t)(b * 2 + l) * 512) * 256 + head * 64;
      auto src = [&](int j, const u16*& kp, const u16*& vp, int& stride) -> bool {
        if (j < 8) {
          kp = ck + (size_t)j * 64 * 256; vp = cv + (size_t)j * 64 * 256; stride = 256;
          return true;
        }
        const int Tk = NCTX + b * 2048 + (rmin + j - 8) * 64;
        kp = p.QKV + (size_t)Tk * DIN + 1024 + head * 64; vp = p.QKV + (size_t)Tk * DIN + 1280 + head * 64; stride = DIN;
        return true;
      };
      auto biasf = [&](int j, int key, int ql) -> float {
        if (j < 8) return 0.f;
        const int kr = rmin + j - 8, kc = key;
        const int qr = r0 + (ql >> 6), qc = ql & 63;
        const int rs = min(max(qr - 4, 0), 24), cs = min(max(qc - 8, 0), 48);
        const bool ok = (kr >= rs) && (kr < rs + 8) && (kc >= cs) && (kc < cs + 16);
        const int bi = ok ? ((kr - qr + 7) * 31 + (kc - qc + 15)) : 0;
        const float bv = srpb[bi];
        return ok ? bv : NEG;
      };
      auto tmode = [&](int j, int w) -> int {
        if (j < 8) return 0;
        const int kr = rmin + j - 8, qr = r0 + (w >> 1);
        const int rs = min(max(qr - 4, 0), 24);
        return (kr >= rs && kr < rs + 8) ? 1 : 2;
      };
      attn_core(smem, p.QKV + (size_t)T0 * DIN + 768 + head * 64, 8 + (rmax - rmin + 1), src, biasf, tmode, NEG, false,
                p.CAT + (size_t)T0 * DM + 512 + head * 64);
    } else if (item < 1152) {
      const int it = item - 768;
      if (it < 256) retkv_item(p, smem, l, 16 + (it >> 6), (it >> 4) & 3, it & 15);
      else { const int i2 = it - 256; retkv_item(p, smem, l, i2 >> 3, (i2 >> 1) & 3, i2 & 1); }
    } else if (item < 1408) {
      const int it = item - 1152;
      const int b = it >> 4, head = (it >> 1) & 7, qh = it & 1, kvh = head >> 2;
      const int T0 = b * 256 + qh * 128;
      auto src = [&](int j, const u16*& kp, const u16*& vp, int& stride) -> bool {
        const int Tk = b * 256 + j * 64;
        kp = p.QKV + (size_t)Tk * DIN + 512 + kvh * 64; vp = p.QKV + (size_t)Tk * DIN + 640 + kvh * 64; stride = DIN;
        return true;
      };
      auto biasf = [&](int, int, int) -> float { return 0.f; };
      auto tmode = [&](int, int) -> int { return 0; };
      attn_core(smem, p.QKV + (size_t)T0 * DIN + head * 64, 4, src, biasf, tmode, p.sink[l * 8 + head] * 1.44269504f, true,
                p.CAT + (size_t)T0 * DM + head * 64);
    } else {
      const int it = item - 1408;
      const int b = it >> 3, head = (it >> 1) & 3, qh = it & 1;
      const int T0 = b * 256 + qh * 128;
      auto src = [&](int j, const u16*& kp, const u16*& vp, int& stride) -> bool {
        const int Tk = b * 256 + j * 64;
        kp = p.QKV + (size_t)Tk * DIN + 1024 + head * 64; vp = p.QKV + (size_t)Tk * DIN + 1280 + head * 64; stride = DIN;
        return true;
      };
      auto biasf = [&](int, int, int) -> float { return 0.f; };
      auto tmode = [&](int, int) -> int { return 0; };
      attn_core(smem, p.QKV + (size_t)T0 * DIN + 768 + head * 64, 4, src, biasf, tmode, NEG, false,
                p.CAT + (size_t)T0 * DM + 512 + head * 64);
    }
  }
}

DI void phase2c(const Params& p, char* smem, int l) {
  u16* sK = (u16*)smem;
  u16* sVT = sK + 128 * LDT;
  u16* sSTf = sVT + 64 * LDT2;
  u16* sSTb = sSTf + 64 * LDT;
  const int tid = otid(), lane = tid & 63, w = tid >> 6, r = lane & 31, h = lane >> 5;
  const int rq = tid >> 4, c4 = tid & 15;
  const float one4[4] = {1.f, 1.f, 1.f, 1.f};
  for (int item = blockIdx.x; item < 384; item += gridDim.x) {
    int req, head, c, nc;
    if (item < 256) { req = 16 + (item >> 6); head = (item >> 4) & 3; c = item & 15; nc = 16; }
    else { const int i2 = item - 256; req = i2 >> 3; head = (i2 >> 1) & 3; c = i2 & 1; nc = 2; }
    const bool lat = req >= 16;
    const int T0 = (lat ? NCTX + (req - 16) * 2048 : req * 256) + c * 128;
    const float lgf = ret_lg(p, l, 0, head), lgb = ret_lg(p, l, 1, head);
    const float gf = __expf(lgf * 128.f), gb = __expf(lgb * 128.f);
    __syncthreads();
    {
      const int d = tid >> 2, e0 = (tid & 3) * 16;
#pragma unroll
      for (int dir = 0; dir < 2; ++dir) {
        float s[16];
#pragma unroll
        for (int q = 0; q < 16; ++q) s[q] = 0.f;
        const float g = dir ? gb : gf;
        if (lat) {
          const float* s0 = p.state + ((size_t)(((req - 16) * 2 + l) * 2 + dir) * 4 + head) * 4096 + d * 64 + e0;
#pragma unroll
          for (int q = 0; q < 16; q += 4) {
            const float4 x = *(const float4*)(s0 + q);
            s[q] = x.x; s[q + 1] = x.y; s[q + 2] = x.z; s[q + 3] = x.w;
          }
        }
        const int nsteps = dir ? (nc - 1 - c) : c;
        for (int st = 0; st < nsteps; ++st) {
          const int cc = dir ? (nc - 1 - st) : st;
          const float* kv = p.KVS + kvs_slot(req, head, dir, cc) + d * 64 + e0;
#pragma unroll
          for (int q = 0; q < 16; q += 4) {
            const float4 x = *(const float4*)(kv + q);
            s[q] = s[q] * g + x.x; s[q + 1] = s[q + 1] * g + x.y; s[q + 2] = s[q + 2] * g + x.z; s[q + 3] = s[q + 3] * g + x.w;
          }
        }
        u16* sST = dir ? sSTb : sSTf;
#pragma unroll
        for (int q = 0; q < 16; ++q) sST[(e0 + q) * LDT + d] = (u16)(pack2(s[q], 0.f) & 0xffffu);
        if (!lat && c == 0) {
          const float* k0 = p.KVS + kvs_slot(req, head, dir, 0) + d * 64 + e0;
          const float* k1 = p.KVS + kvs_slot(req, head, dir, 1) + d * 64 + e0;
          float* o = p.out + OFF_ST + ((size_t)((req * 2 + l) * 2 + dir) * 4 + head) * 4096 + d * 64 + e0;
#pragma unroll
          for (int q = 0; q < 16; ++q) o[q] = dir ? (gb * k1[q] + k0[q]) : (gf * k0[q] + k1[q]);
        }
      }
    }
#pragma unroll
    for (int half = 0; half < 2; ++half) {
      float v[4][4];
      load4x4(p.QKV + (size_t)(T0 + half * 64) * DIN + 1792 + head * 64, DIN, false, rq, c4, v);
      store_n(sK, LDT, half * 64, rq, c4, v);
      load4x4(p.QKV + (size_t)(T0 + half * 64) * DIN + 2048 + head * 64, DIN, false, rq, c4, v);
      store_t(sVT, LDT2, half * 64, rq, c4, v, one4);
    }
    __syncthreads();
    const int qi = w * 32 + r;
    const u16* qrow = p.QKV + (size_t)(T0 + qi) * DIN + 1536 + head * 64;
    uint4 qraw[4];
#pragma unroll
    for (int ks = 0; ks < 4; ++ks) qraw[ks] = *(const uint4*)(qrow + ks * 16 + 8 * h);
    f32x16 O[2];
#pragma unroll
    for (int d = 0; d < 2; ++d)
#pragma unroll
      for (int i = 0; i < 16; ++i) O[d][i] = 0.f;
#pragma unroll 1
    for (int jt = 0; jt < 4; ++jt) {
      f32x16 S;
#pragma unroll
      for (int i = 0; i < 16; ++i) S[i] = 0.f;
#pragma unroll
      for (int ks = 0; ks < 4; ++ks) {
        const bf16x8 kf = *(const bf16x8*)&sK[(jt * 32 + r) * LDT + ks * 16 + 8 * h];
        S = MFMA(kf, __builtin_bit_cast(bf16x8, qraw[ks]), S);
      }
#pragma unroll
      for (int i = 0; i < 16; ++i) {
        const int j = jt * 32 + crow(i, h);
        const int dlt = qi - j;
        const float wgt = (dlt > 0) ? __expf(lgf * (float)dlt) : ((dlt < 0) ? __expf(lgb * (float)(-dlt)) : 2.f);
        S[i] = S[i] * 0.125f * wgt;
      }
#pragma unroll
      for (int s = 0; s < 2; ++s) {
        const bf16x8 pf = mk8(pack2(S[8 * s + 0], S[8 * s + 1]), pack2(S[8 * s + 2], S[8 * s + 3]),
                              pack2(S[8 * s + 4], S[8 * s + 5]), pack2(S[8 * s + 6], S[8 * s + 7]));
#pragma unroll
        for (int d = 0; d < 2; ++d) {
          const u16* vrow = &sVT[(d * 32 + r) * LDT2 + jt * 32 + 16 * s + 4 * h];
          const uint2 lo = *(const uint2*)vrow;
          const uint2 hi = *(const uint2*)(vrow + 8);
          O[d] = MFMA(mk8(lo.x, lo.y, hi.x, hi.y), pf, O[d]);
        }
      }
    }
    {
      const float xf = __expf(lgf * (float)(qi + 1)), xb = __expf(lgb * (float)(128 - qi));
#pragma unroll
      for (int ks = 0; ks < 4; ++ks) {
        const uint4 q = qraw[ks];
        const bf16x8 qsf = mk8(pack2(bflo(q.x) * xf, bfhi(q.x) * xf), pack2(bflo(q.y) * xf, bfhi(q.y) * xf),
                               pack2(bflo(q.z) * xf, bfhi(q.z) * xf), pack2(bflo(q.w) * xf, bfhi(q.w) * xf));
        const bf16x8 qsb = mk8(pack2(bflo(q.x) * xb, bfhi(q.x) * xb), pack2(bflo(q.y) * xb, bfhi(q.y) * xb),
                               pack2(bflo(q.z) * xb, bfhi(q.z) * xb), pack2(bflo(q.w) * xb, bfhi(q.w) * xb));
#pragma unroll
        for (int d = 0; d < 2; ++d) {
          const bf16x8 sf = *(const bf16x8*)&sSTf[(d * 32 + r) * LDT + ks * 16 + 8 * h];
          const bf16x8 sb = *(const bf16x8*)&sSTb[(d * 32 + r) * LDT + ks * 16 + 8 * h];
          O[d] = MFMA(sf, qsf, O[d]);
          O[d] = MFMA(sb, qsb, O[d]);
        }
      }
    }
    float sum = 0.f;
#pragma unroll
    for (int d = 0; d < 2; ++d)
#pragma unroll
      for (int i = 0; i < 16; ++i) sum += O[d][i];
    sum += __shfl_xor(sum, 32);
    const float mu = sum * (1.f / 64.f);
    float vs = 0.f;
#pragma unroll
    for (int d = 0; d < 2; ++d)
#pragma unroll
      for (int i = 0; i < 16; ++i) { const float t = O[d][i] - mu; vs += t * t; }
    vs += __shfl_xor(vs, 32);
    const float rstd = rsqrtf(vs * (1.f / 64.f) + 1e-6f);
    const u16* grow = p.QKV + (size_t)(T0 + qi) * DIN + 2304 + head * 64;
    const float* gnw = p.gn + l * 256 + head * 64;
    u16* orow = p.CAT + (size_t)(T0 + qi) * DM + 768 + head * 64;
#pragma unroll
    for (int d = 0; d < 2; ++d)
#pragma unroll
      for (int g = 0; g < 4; ++g) {
        const int e = d * 32 + 8 * g + 4 * h;
        const uint2 gr = *(const uint2*)(grow + e);
        const float4 gw = *(const float4*)(gnw + e);
        const float o0 = silu(bflo(gr.x)) * (O[d][4 * g + 0] - mu) * rstd * gw.x;
        const float o1 = silu(bfhi(gr.x)) * (O[d][4 * g + 1] - mu) * rstd * gw.y;
        const float o2 = silu(bflo(gr.y)) * (O[d][4 * g + 2] - mu) * rstd * gw.z;
        const float o3 = silu(bfhi(gr.y)) * (O[d][4 * g + 3] - mu) * rstd * gw.w;
        uint2 pk = {pack2(o0, o1), pack2(o2, o3)};
        *(uint2*)(orow + e) = pk;
      }
  }
}

DI void phase3(const Params& p, char* smem, int l, const float* xc, const float* xl) {
  const float* W = p.w_out + (size_t)l * DM * DM;
  u16* PREB = (u16*)p.PRE;
  const int xcd = blockIdx.x & 7, nloc = gridDim.x >> 3;
  auto setup = [&](int s, int ar0, int ac, int n4, int kq, const u16*& ab, unsigned& o0, unsigned& o1, unsigned& o2, unsigned& o3, const float*& bb, unsigned& bo) {
    const int tm = 6 * xcd + s % 6, tn = s / 6;
    ab = p.CAT + (size_t)tm * 256 * DM;
    o0 = (unsigned)(ar0 * DM + ac); o1 = o0 + 64u * DM; o2 = o0 + 128u * DM; o3 = o0 + 192u * DM;
    bb = W + tn * 128;
    bo = (unsigned)(4 * n4 + kq * 4 * DM);
  };
  auto epi = [&](int s, f32x16(&acc)[2][4], int w, int r, int h) {
    int hq = h;
    asm volatile("" : "+v"(hq));
    const int tm = 6 * xcd + s % 6, tn = s / 6;
    const int m0 = tm * 256, n0 = tn * 128;
    const float* g1 = p.MOD + (size_t)(l * 5 + cond_of(m0)) * 6144 + 2048 + n0 + 4 * r;
    const float g0 = g1[0], g1v = g1[1], g2 = g1[2], g3 = g1[3];
#pragma unroll
    for (int mt = 0; mt < 2; ++mt)
#pragma unroll
    for (int i = 0; i < 16; ++i) {
      const int ml = w * 64 + mt * 32 + crow(i, hq);
      uint2 pk = {pack2(g0 * acc[mt][0][i], g1v * acc[mt][1][i]), pack2(g2 * acc[mt][2][i], g3 * acc[mt][3][i])};
      *(uint2*)(PREB + (size_t)(m0 + ml) * DM + n0 + 4 * r) = pk;
      if ((i & 3) == 3) __builtin_amdgcn_sched_barrier(0);
    }
  };
  gemm_phase<true>(smem, blockIdx.x >> 3, 48, nloc, setup, DM, epi, [](int, int) {});
}

DI void phase4(const Params& p, char* smem, int l, const float* xc, const float* xl) {
  float* swr = (float*)smem;
  const int tid = otid(), lane = tid & 63, w = tid >> 6;
  __syncthreads();
  for (int idx = tid; idx < 4096; idx += 256) {
    const float4 x = *(const float4*)(p.w_router + (size_t)l * DM * 16 + idx * 4);
    const int k = idx >> 2, e = (idx & 3) * 4;
    swr[(e + 0) * DM + k] = x.x; swr[(e + 1) * DM + k] = x.y; swr[(e + 2) * DM + k] = x.z; swr[(e + 3) * DM + k] = x.w;
  }
  __syncthreads();
  const float* lg = p.ln1g + l * DM;
  const float* lb = p.ln1b + l * DM;
  const int rstride = gridDim.x * 4;
  uint2 nprb[4];
  float4 nxi[4];
  {
    const int T0 = blockIdx.x * 4 + w;
    if (T0 < NTOK) {
      const float* xr0 = (T0 < NCTX) ? (xc + (size_t)T0 * DM) : (xl + (size_t)(T0 - NCTX) * DM);
#pragma unroll
      for (int i = 0; i < 4; ++i) {
        nprb[i] = *(const uint2*)((const u16*)p.PRE + (size_t)T0 * DM + 256 * i + 4 * lane);
        nxi[i] = *(const float4*)(xr0 + 256 * i + 4 * lane);
      }
    }
  }
  for (int T = blockIdx.x * 4 + w; T < NTOK; T += rstride) {
    const float* mod = p.MOD + (size_t)(l * 5 + cond_of(T)) * 6144;
    float4 x[4];
    float s = 0.f;
#pragma unroll
    for (int i = 0; i < 4; ++i) {
      const uint2 prb = nprb[i];
      const float4 xi = nxi[i];
      const float4 pr = {bflo(prb.x), bfhi(prb.x), bflo(prb.y), bfhi(prb.y)};
      x[i].x = ALPHA * xi.x + pr.x; x[i].y = ALPHA * xi.y + pr.y; x[i].z = ALPHA * xi.z + pr.z; x[i].w = ALPHA * xi.w + pr.w;
      s += x[i].x + x[i].y + x[i].z + x[i].w;
    }
    {
      const int Tn = T + rstride;
      if (Tn < NTOK) {
        const float* xrn = (Tn < NCTX) ? (xc + (size_t)Tn * DM) : (xl + (size_t)(Tn - NCTX) * DM);
#pragma unroll
        for (int i = 0; i < 4; ++i) {
          nprb[i] = *(const uint2*)((const u16*)p.PRE + (size_t)Tn * DM + 256 * i + 4 * lane);
          nxi[i] = *(const float4*)(xrn + 256 * i + 4 * lane);
        }
      }
    }
    const float mu = wave_sum(s) * (1.f / 1024.f);
    float vs = 0.f;
#pragma unroll
    for (int i = 0; i < 4; ++i) {
      x[i].x -= mu; x[i].y -= mu; x[i].z -= mu; x[i].w -= mu;
      vs += x[i].x * x[i].x + x[i].y * x[i].y + x[i].z * x[i].z + x[i].w * x[i].w;
    }
    const float rstd = rsqrtf(wave_sum(vs) * (1.f / 1024.f) + 1e-6f);
#pragma unroll
    for (int i = 0; i < 4; ++i) {
      const int k = 256 * i + 4 * lane;
      const float4 g = *(const float4*)(lg + k), bb = *(const float4*)(lb + k);
      float4 y;
      y.x = x[i].x * rstd * g.x + bb.x; y.y = x[i].y * rstd * g.y + bb.y; y.z = x[i].z * rstd * g.z + bb.z; y.w = x[i].w * rstd * g.w + bb.w;
      *(float4*)(p.X + (size_t)T * DM + k) = y;
      const float4 sc = *(const float4*)(mod + 4096 + k), sh = *(const float4*)(mod + 3072 + k);
      float4 hh;
      hh.x = y.x * (1.f + sc.x) + sh.x; hh.y = y.y * (1.f + sc.y) + sh.y; hh.z = y.z * (1.f + sc.z) + sh.z; hh.w = y.w * (1.f + sc.w) + sh.w;
      uint2 pk = {pack2(hh.x, hh.y), pack2(hh.z, hh.w)};
      *(uint2*)(p.H2 + (size_t)T * DM + k) = pk;
      x[i] = hh;
    }
    float a16[16];
#pragma unroll
    for (int e = 0; e < 16; ++e) {
      float a = 0.f;
#pragma unroll
      for (int i = 0; i < 4; ++i) {
        const float4 wv = *(const float4*)(swr + e * DM + 256 * i + 4 * lane);
        a += x[i].x * wv.x + x[i].y * wv.y + x[i].z * wv.z + x[i].w * wv.w;
      }
      a16[e] = a;
      if ((e & 3) == 3) __builtin_amdgcn_sched_barrier(0);
    }
    float a8[8], a4[4], a2[2], a1;
    {
      const bool hi = (lane & 32) != 0;
#pragma unroll
      for (int j = 0; j < 8; ++j) {
        const float snd = hi ? a16[j] : a16[8 + j];
        const float kp = hi ? a16[8 + j] : a16[j];
        a8[j] = kp + __shfl_xor(snd, 32);
      }
    }
    {
      const bool hi = (lane & 16) != 0;
#pragma unroll
      for (int j = 0; j < 4; ++j) {
        const float snd = hi ? a8[j] : a8[4 + j];
        const float kp = hi ? a8[4 + j] : a8[j];
        a4[j] = kp + __shfl_xor(snd, 16);
      }
    }
    {
      const bool hi = (lane & 8) != 0;
#pragma unroll
      for (int j = 0; j < 2; ++j) {
        const float snd = hi ? a4[j] : a4[2 + j];
        const float kp = hi ? a4[2 + j] : a4[j];
        a2[j] = kp + __shfl_xor(snd, 8);
      }
    }
    {
      const bool hi = (lane & 4) != 0;
      const float snd = hi ? a2[0] : a2[1];
      const float kp = hi ? a2[1] : a2[0];
      a1 = kp + __shfl_xor(snd, 4);
    }
    a1 += __shfl_xor(a1, 2);
    a1 += __shfl_xor(a1, 1);
    const int myexp = ((lane >> 5) & 1) * 8 + ((lane >> 4) & 1) * 4 + ((lane >> 3) & 1) * 2 + ((lane >> 2) & 1);
    float mx = a1;
#pragma unroll
    for (int o = 32; o >= 4; o >>= 1) mx = fmaxf(mx, __shfl_xor(mx, o));
    const float ex = __expf(a1 - mx);
    float den = ex;
#pragma unroll
    for (int o = 32; o >= 4; o >>= 1) den += __shfl_xor(den, o);
    if ((lane & 3) == 0) { p.AFF[(size_t)T * 16 + myexp] = ex / den; p.INV[(size_t)T * 16 + myexp] = -1; }
  }
}

DI unsigned block_incl_scan(unsigned v, unsigned* wsum, int lane, int w, unsigned& total) {
#pragma unroll
  for (int o = 1; o < 64; o <<= 1) {
    const unsigned t = __shfl_up(v, o);
    if (lane >= o) v += t;
  }
  __syncthreads();
  if (lane == 63) wsum[w] = v;
  __syncthreads();
  unsigned off = 0;
  total = 0;
#pragma unroll
  for (int i = 0; i < 4; ++i) {
    const unsigned s = wsum[i];
    if (i < w) off += s;
    total += s;
  }
  return v + off;
}

DI void phase5(const Params& p, char* smem) {
  unsigned* hist = (unsigned*)smem;
  unsigned* wsum = hist + 256;
  unsigned* bc = wsum + 4;
  const int tid = otid(), lane = tid & 63, w = tid >> 6;
  for (int item = blockIdx.x; item < 320; item += gridDim.x) {
    int n, base, e, cap, rowbase;
    if (item < 64) {
      const int b = item >> 4; e = item & 15;
      n = 2048; base = NCTX + b * 2048; cap = 256; rowbase = 512 + b * 256;
    } else {
      const int it = item - 64; const int rq = it >> 4; e = it & 15;
      n = 256; base = rq * 256; cap = 32; rowbase = rq * 32;
    }
    const int per = n >> 8;
    unsigned key[8];
#pragma unroll
    for (int q = 0; q < 8; ++q) key[q] = (q < per) ? __float_as_uint(p.AFF[(size_t)(base + tid * per + q) * 16 + e]) : 0u;
    unsigned prefix = 0u, mask = 0u;
    unsigned remaining = (unsigned)cap;
#pragma unroll 1
    for (int pass = 3; pass >= 0; --pass) {
      const int shift = pass * 8;
      __syncthreads();
      hist[tid] = 0u;
      __syncthreads();
#pragma unroll
      for (int q = 0; q < 8; ++q)
        if (q < per && (key[q] & mask) == prefix) atomicAdd(&hist[(key[q] >> shift) & 255u], 1u);
      __syncthreads();
      const unsigned hv = hist[tid];
      unsigned total;
      const unsigned incl = block_incl_scan(hv, wsum, lane, w, total);
      const unsigned above = total - incl;
      if (above < remaining && remaining <= above + hv) { bc[0] = (unsigned)tid; bc[1] = remaining - above; }
      __syncthreads();
      const unsigned bsel = bc[0];
      remaining = bc[1];
      prefix |= bsel << shift;
      mask |= 0xFFu << shift;
    }
    const unsigned thr = prefix;
    unsigned ceq = 0u;
#pragma unroll
    for (int q = 0; q < 8; ++q) ceq += (q < per && key[q] == thr) ? 1u : 0u;
    unsigned tot;
    unsigned eq_before = block_incl_scan(ceq, wsum, lane, w, tot) - ceq;
    unsigned selmask = 0u, nsel = 0u;
#pragma unroll
    for (int q = 0; q < 8; ++q) {
      if (q < per) {
        const bool eq = key[q] == thr;
        const bool sel = (key[q] > thr) || (eq && eq_before < remaining);
        eq_before += eq ? 1u : 0u;
        selmask |= sel ? (1u << q) : 0u;
        nsel += sel ? 1u : 0u;
      }
    }
    unsigned row = block_incl_scan(nsel, wsum, lane, w, tot) - nsel;
#pragma unroll
    for (int q = 0; q < 8; ++q) {
      if (q < per && ((selmask >> q) & 1u)) {
        const int tok = base + tid * per + q;
        const int rr = e * NROWS_E + rowbase + (int)row;
        p.SELTOK[rr] = tok;
        p.SELGATE[rr] = __uint_as_float(key[q]);
        p.INV[(size_t)tok * 16 + e] = rr;
        ++row;
      }
    }
  }
}

DI void phase6(const Params& p, char* smem, int l) {
  const int xcd = blockIdx.x & 7, nloc = gridDim.x >> 3;
  auto setup = [&](int s, int ar0, int ac, int n4, int kq, const u16*& ab, unsigned& o0, unsigned& o1, unsigned& o2, unsigned& o3, const float*& bb, unsigned& bo) {
    const int e = 2 * xcd + s / 96, rem = s % 96, tn = rem / 6, tm = rem % 6;
    const int* tok = p.SELTOK + e * NROWS_E + tm * 256 + ar0;
    ab = p.H2;
    o0 = (unsigned)(tok[0] * DM + ac); o1 = (unsigned)(tok[64] * DM + ac);
    o2 = (unsigned)(tok[128] * DM + ac); o3 = (unsigned)(tok[192] * DM + ac);
    bb = p.w_gu + ((size_t)l * 16 + e) * DM * 2048 + tn * 64;
    bo = (unsigned)(((n4 >> 4) & 1) * 1024 + 4 * (n4 & 15) + kq * 4 * 2048);
  };
  auto epi = [&](int s, f32x16(&acc)[2][4], int w, int r, int h) {
    int hq = h;
    asm volatile("" : "+v"(hq));
    const int e = 2 * xcd + s / 96, rem = s % 96, tn = rem / 6, tm = rem % 6;
    const int m0 = tm * 256, f0 = tn * 64;
    u16* act = p.ACT + ((size_t)e * NROWS_E + m0) * DM;
#pragma unroll
    for (int mt = 0; mt < 2; ++mt)
#pragma unroll
    for (int i = 0; i < 16; ++i) {
      const int ml = w * 64 + mt * 32 + crow(i, hq);
      const float a0 = acc[mt][0][i], a1 = acc[mt][1][i], a2 = acc[mt][2][i], a3 = acc[mt][3][i];
      const bool lo = r < 16;
      const float s0 = lo ? a2 : a0, s1 = lo ? a3 : a1;
      const float r0 = __shfl_xor(s0, 16), r1 = __shfl_xor(s1, 16);
      const float g0 = lo ? a0 : r0, g1 = lo ? a1 : r1;
      const float v0 = lo ? r0 : a2, v1 = lo ? r1 : a3;
      *(unsigned*)(act + (size_t)ml * DM + f0 + 4 * (r & 15) + (lo ? 0 : 2)) = pack2(silu(g0) * v0, silu(g1) * v1);
      if ((i & 3) == 3) __builtin_amdgcn_sched_barrier(0);
    }
  };
  gemm_phase<false>(smem, blockIdx.x >> 3, 192, nloc, setup, 2048, epi, [](int, int) {});
}

DI void phase7(const Params& p, char* smem, int l, u16* FF) {
  const int xcd = blockIdx.x & 7, nloc = gridDim.x >> 3;
  auto setup = [&](int s, int ar0, int ac, int n4, int kq, const u16*& ab, unsigned& o0, unsigned& o1, unsigned& o2, unsigned& o3, const float*& bb, unsigned& bo) {
    const int e = 2 * xcd + s / 48, rem = s % 48, tn = rem / 6, tm = rem % 6;
    ab = p.ACT + ((size_t)e * NROWS_E + tm * 256) * DM;
    o0 = (unsigned)(ar0 * DM + ac); o1 = o0 + 64u * DM; o2 = o0 + 128u * DM; o3 = o0 + 192u * DM;
    bb = p.w_down + ((size_t)l * 16 + e) * DM * DM + tn * 128;
    bo = (unsigned)(4 * n4 + kq * 4 * DM);
  };
  float* sG = (float*)(smem + 61440);
  int par = 1;
  auto pre = [&](int s, int tid) {
    par ^= 1;
    const int e = 2 * xcd + s / 48, rem = s % 48, tm = rem % 6;
    sG[par * 256 + tid] = p.SELGATE[e * NROWS_E + tm * 256 + tid];
  };
  auto epi = [&](int s, f32x16(&acc)[2][4], int w, int r, int h) {
    int hq = h;
    asm volatile("" : "+v"(hq));
    const int e = 2 * xcd + s / 48, rem = s % 48, tn = rem / 6, tm = rem % 6;
    const int m0 = tm * 256, n0 = tn * 128;
#pragma unroll
    for (int mt = 0; mt < 2; ++mt)
#pragma unroll
    for (int i = 0; i < 16; ++i) {
      const int ml = w * 64 + mt * 32 + crow(i, hq);
      const float g = sG[par * 256 + ml];
      uint2 pk = {pack2(g * acc[mt][0][i], g * acc[mt][1][i]), pack2(g * acc[mt][2][i], g * acc[mt][3][i])};
      *(uint2*)(FF + ((size_t)e * NROWS_E + m0 + ml) * DM + n0 + 4 * r) = pk;
      if ((i & 3) == 3) __builtin_amdgcn_sched_barrier(0);
    }
  };
  gemm_phase<true>(smem, blockIdx.x >> 3, 96, nloc, setup, DM, epi, pre);
}

DI void phase8(const Params& p, int l, float* dst, bool write_h) {
  const int tid = otid(), lane = tid & 63, w = tid >> 6;
  const float* lg = p.ln2g + l * DM;
  const float* lb = p.ln2b + l * DM;
  const int rstride = gridDim.x * 4;
  float4 nxa[4];
  int ninv = -1;
  {
    const int T0 = blockIdx.x * 4 + w;
    if (T0 < NTOK) {
#pragma unroll
      for (int i = 0; i < 4; ++i) nxa[i] = *(const float4*)(p.X + (size_t)T0 * DM + 256 * i + 4 * lane);
      ninv = (lane < 16) ? p.INV[(size_t)T0 * 16 + lane] : -1;
    }
  }
  for (int T = blockIdx.x * 4 + w; T < NTOK; T += rstride) {
    const float* g2 = p.MOD + (size_t)(l * 5 + cond_of(T)) * 6144 + 5120;
    const float* modn = p.MOD + (size_t)(5 + cond_of(T)) * 6144;
    float4 x[4], ff[4], xa[4];
#pragma unroll
    for (int i = 0; i < 4; ++i) { ff[i] = make_float4(0.f, 0.f, 0.f, 0.f); xa[i] = nxa[i]; }
    const int myinv = ninv;
    {
      const int Tn = T + rstride;
      if (Tn < NTOK) {
#pragma unroll
        for (int i = 0; i < 4; ++i) nxa[i] = *(const float4*)(p.X + (size_t)Tn * DM + 256 * i + 4 * lane);
        ninv = (lane < 16) ? p.INV[(size_t)Tn * 16 + lane] : -1;
      }
    }
    unsigned long long sel = __ballot(myinv >= 0);
#pragma unroll 1
    while (sel) {
      int rows[4];
#pragma unroll
      for (int q = 0; q < 4; ++q) {
        if (sel) {
          const int e = __ffsll((long long)sel) - 1;
          sel &= sel - 1;
          rows[q] = __shfl(myinv, e);
        } else {
          rows[q] = -1;
        }
      }
      uint2 y[4][4];
#pragma unroll
      for (int q = 0; q < 4; ++q) {
        const u16* yr = p.YE + (size_t)(rows[q] >= 0 ? rows[q] : 0) * DM + 4 * lane;
#pragma unroll
        for (int i = 0; i < 4; ++i) y[q][i] = *(const uint2*)(yr + 256 * i);
      }
#pragma unroll
      for (int q = 0; q < 4; ++q) {
        const float wq = rows[q] >= 0 ? 1.f : 0.f;
#pragma unroll
        for (int i = 0; i < 4; ++i) {
          ff[i].x += wq * bflo(y[q][i].x); ff[i].y += wq * bfhi(y[q][i].x); ff[i].z += wq * bflo(y[q][i].y); ff[i].w += wq * bfhi(y[q][i].y);
        }
      }
    }
    float s = 0.f;
#pragma unroll
    for (int i = 0; i < 4; ++i) {
      const int k = 256 * i + 4 * lane;
      const float4 a = xa[i];
      const float4 f = ff[i];
      const float4 g = *(const float4*)(g2 + k);
      x[i].x = ALPHA * a.x + g.x * f.x; x[i].y = ALPHA * a.y + g.y * f.y; x[i].z = ALPHA * a.z + g.z * f.z; x[i].w = ALPHA * a.w + g.w * f.w;
      s += x[i].x + x[i].y + x[i].z + x[i].w;
    }
    const float mu = wave_sum(s) * (1.f / 1024.f);
    float vs = 0.f;
#pragma unroll
    for (int i = 0; i < 4; ++i) {
      x[i].x -= mu; x[i].y -= mu; x[i].z -= mu; x[i].w -= mu;
      vs += x[i].x * x[i].x + x[i].y * x[i].y + x[i].z * x[i].z + x[i].w * x[i].w;
    }
    const float rstd = rsqrtf(wave_sum(vs) * (1.f / 1024.f) + 1e-6f);
#pragma unroll
    for (int i = 0; i < 4; ++i) {
      const int k = 256 * i + 4 * lane;
      const float4 g = *(const float4*)(lg + k), bb = *(const float4*)(lb + k);
      float4 y;
      y.x = x[i].x * rstd * g.x + bb.x; y.y = x[i].y * rstd * g.y + bb.y; y.z = x[i].z * rstd * g.z + bb.z; y.w = x[i].w * rstd * g.w + bb.w;
      *(float4*)(dst + (size_t)T * DM + k) = y;
      if (write_h) {
        const float4 sc = *(const float4*)(modn + 1024 + k), sh = *(const float4*)(modn + k);
        uint2 pk = {pack2(y.x * (1.f + sc.x) + sh.x, y.y * (1.f + sc.y) + sh.y), pack2(y.z * (1.f + sc.z) + sh.z, y.w * (1.f + sc.w) + sh.w)};
        *(uint2*)(p.H2 + (size_t)T * DM + k) = pk;
      }
    }
  }
}

constexpr int kDynLds = 73728;
__global__ void __launch_bounds__(256, 2) mega(Params p) {
  extern __shared__ __attribute__((aligned(16))) char smem[];
  cg::grid_group grid = cg::this_grid();
  if (p.never) grid.sync();
  GBar gb;
  gb.bar = p.BAR; gb.x = xb_xcc_id(); gb.nloc = 0u; gb.nx = 0u;
  if (threadIdx.x == 0) (void)xb_add(&p.BAR[XB_XCNT(gb.x)], 1u);
  phase0(p, smem);
  gbar(gb);
  phase0b(p);
  gbar(gb);
#pragma unroll 1
  for (int l = 0; l < 2; ++l) {
    const float* xc = (l == 0) ? p.x_prompt : p.X;
    const float* xl = (l == 0) ? p.x_sample : (p.X + (size_t)NCTX * DM);
    phase1(p, smem, l);
    gbar(gb);
    if (PROBE == 1) { phase1(p, smem, l); gbar(gb); }
    phase2(p, smem, l);
    gbar(gb);
    if (PROBE == 3) { phase2(p, smem, l); gbar(gb); }
    phase2c(p, smem, l);
    gbar(gb);
    if (PROBE == 3) { phase2c(p, smem, l); gbar(gb); }
    phase3(p, smem, l, xc, xl);
    gbar(gb);
    if (PROBE == 1) { phase3(p, smem, l, xc, xl); gbar(gb); }
    phase4(p, smem, l, xc, xl);
    gbar(gb);
    phase5(p, smem);
    gbar(gb);
    phase6(p, smem, l);
    gbar(gb);
    if (PROBE == 1) { phase6(p, smem, l); gbar(gb); }
    phase7(p, smem, l, p.YE);
    gbar(gb);
    phase8(p, l, (l == 1) ? p.out : p.X, l == 0);
    if (l == 0) gbar(gb);
  }
}

extern "C" void kernel_launch(void* const* d_in, const int* in_sizes, int n_in, void* d_out, int out_size, void* d_ws,
                              size_t ws_size, hipStream_t stream) {
  static int grid_blocks = 0;
  if (!grid_blocks) {
    int dev = 0, cus = 0, per_cu = 0;
    hipGetDevice(&dev);
    hipDeviceGetAttribute(&cus, hipDeviceAttributeMultiprocessorCount, dev);
    hipFuncSetAttribute((const void*)mega, hipFuncAttributeMaxDynamicSharedMemorySize, kDynLds);
    hipOccupancyMaxActiveBlocksPerMultiprocessor(&per_cu, mega, 256, kDynLds);
    if (per_cu > 2) per_cu = 2;
    if (per_cu < 1) per_cu = 1;
    grid_blocks = cus * per_cu;
  }
  Params p{};
  const float** pf = (const float**)&p;
  for (int i = 0; i < 24; ++i) pf[i] = (const float*)d_in[i];
  p.out = (float*)d_out;
  char* ws = (char*)d_ws;
  size_t off = 0;
  auto take = [&](size_t bytes) { char* q = ws + off; off += (bytes + 255) & ~(size_t)255; return q; };
  p.MOD = (float*)take(2 * 5 * 6144 * 4);
  p.BAR = (unsigned*)take(XCD_BAR_WORDS * 4);
  p.ROPE = (float*)take(2048 * 4);
  p.X = (float*)take((size_t)NTOK * DM * 4);
  p.PRE = (float*)take((size_t)NTOK * DM * 4);
  p.KVS = (float*)take((size_t)20 * 4 * 2 * 16 * 4096 * 4);
  p.AFF = (float*)take((size_t)NTOK * 16 * 4);
  p.SELGATE = (float*)take((size_t)16 * NROWS_E * 4);
  p.SELTOK = (int*)take((size_t)16 * NROWS_E * 4);
  p.QKV = (u16*)take((size_t)NTOK * DIN * 2);
  p.CAT = (u16*)take((size_t)NTOK * DM * 2);
  p.H2 = (u16*)take((size_t)NTOK * DM * 2);
  p.ACT = (u16*)take((size_t)16 * NROWS_E * DM * 2);
  p.YE = (u16*)take((size_t)16 * NROWS_E * DM * 2);
  p.INV = (int*)take((size_t)NTOK * 16 * 4);
  p.CAK = (u16*)take((size_t)4 * 2 * 512 * 128 * 2);
  p.CAV = (u16*)take((size_t)4 * 2 * 512 * 128 * 2);
  p.CBK = (u16*)take((size_t)4 * 2 * 512 * 256 * 2);
  p.CBV = (u16*)take((size_t)4 * 2 * 512 * 256 * 2);
  p.never = 0;
  hipMemsetAsync(p.MOD, 0, (size_t)((char*)p.BAR - (char*)p.MOD) + XCD_BAR_WORDS * 4, stream);
  void* args[] = {&p};
  hipError_t e = hipLaunchCooperativeKernel((void*)mega, dim3(grid_blocks), dim3(256), args, kDynLds, stream);
  if (e != hipSuccess) fprintf(stderr, "cooperative launch failed: %s (grid %d)\n", hipGetErrorString(e), grid_blocks);
}
```

```cpp
#include <hip/hip_runtime.h>
#include <hip/hip_cooperative_groups.h>
#include <cstdio>
namespace cg = cooperative_groups;

#define DI __device__ __forceinline__
typedef short bf16x8 __attribute__((ext_vector_type(8)));
typedef float f32x16 __attribute__((ext_vector_type(16)));
typedef __bf16 bf2_t __attribute__((ext_vector_type(2)));
typedef float f2_t __attribute__((ext_vector_type(2)));
typedef unsigned short u16;
typedef unsigned u32x4 __attribute__((ext_vector_type(4)));
typedef float f32x4 __attribute__((ext_vector_type(4)));
typedef float f32x2 __attribute__((ext_vector_type(2)));

#define MFMA(a, b, c) __builtin_amdgcn_mfma_f32_32x32x16_bf16((a), (b), (c), 0, 0, 0)

#define PROBE 0
constexpr int NTOK = 12288;
constexpr int NCTX = 4096;
constexpr int DM = 1024;
constexpr int DIN = 2560;
constexpr int LDT = 72;
constexpr int LDT2 = 136;
constexpr int NROWS_E = 1536;
constexpr float NEG = -1e30f;
constexpr float ALPHA = 1.41421356237f;

constexpr size_t OFF_AK = 12582912, OFF_AV = 13631488, OFF_BK = 14680064, OFF_BV = 16777216, OFF_ST = 18874368;

struct Params {
  const float *x_prompt, *x_sample, *cak, *cav, *cbk, *cbv, *state, *c, *c_ctx, *w_ada, *b_ada, *w_in, *w_out, *sink, *rpb,
      *decay, *gn, *ln1g, *ln1b, *ln2g, *ln2b, *w_router, *w_gu, *w_down;
  float* out;
  float *MOD, *ROPE, *X, *PRE, *KVS, *AFF, *SELGATE;
  int* SELTOK;
  u16 *QKV, *CAT, *H2, *ACT, *CAK, *CAV, *CBK, *CBV;
  u16* YE;
  int* INV;
  unsigned* BAR;
  long never;
};

DI unsigned pack2(float a, float b) {
  f2_t v = {a, b};
  bf2_t r = __builtin_convertvector(v, bf2_t);
  return __builtin_bit_cast(unsigned, r);
}
DI int otid() { int x = threadIdx.x; asm volatile("" : "+v"(x)); return x; }
DI float bflo(unsigned u) { return __uint_as_float(u << 16); }
DI float bfhi(unsigned u) { return __uint_as_float(u & 0xffff0000u); }
DI int crow(int i, int h) { return (i & 3) + 8 * (i >> 2) + 4 * h; }
DI float silu(float x) { return x * __builtin_amdgcn_rcpf(1.f + __expf(-x)); }
DI float wave_sum(float v) {
#pragma unroll
  for (int o = 32; o >= 1; o >>= 1) v += __shfl_xor(v, o);
  return v;
}
DI bf16x8 mk8(unsigned a, unsigned b, unsigned c, unsigned d) {
  uint4 u = {a, b, c, d};
  return __builtin_bit_cast(bf16x8, u);
}


#define XB_TMO 128
#define XB_XCNT(j) (256 + 64 * (j))
#define XB_XSUB(j) (1280 + 64 * (j))
#define XB_XGEN(j) (2304 + 64 * (j))
#define XB_TOP 3328
#define XB_TOPGEN 3392
#define XCD_BAR_WORDS 3456
#define XB_SPIN_CAP (1u << 20)
DI unsigned xb_ld(unsigned* p) { return __hip_atomic_load(p, __ATOMIC_RELAXED, __HIP_MEMORY_SCOPE_AGENT); }
DI unsigned xb_add(unsigned* p, unsigned v) { return __hip_atomic_fetch_add(p, v, __ATOMIC_RELAXED, __HIP_MEMORY_SCOPE_AGENT); }
DI unsigned xb_xcc_id() { return (unsigned)__builtin_amdgcn_s_getreg((3 << 11) | 20) & 0xFu; }
#define XB_SPIN(cond, bar)                                                            \
  do {                                                                                \
    unsigned _sp = 0;                                                                 \
    while (cond) {                                                                    \
      __builtin_amdgcn_s_sleep(1);                                                    \
      if ((++_sp & 255u) == 0u) {                                                     \
        if (xb_ld(&(bar)[XB_TMO])) break;                                             \
        if (_sp > XB_SPIN_CAP) { atomicAdd(&(bar)[XB_TMO], 1u); break; }              \
      }                                                                               \
    }                                                                                 \
  } while (0)
struct GBar { unsigned* bar; unsigned x, nloc, nx; };
DI void gbar_complete(unsigned* bar, unsigned x, unsigned& nloc, unsigned& nx) {
  const unsigned G = gridDim.x;
  unsigned sum, cnt, mine, sp = 0u;
  for (;;) {
    sum = 0u; cnt = 0u; mine = 0u;
#pragma unroll
    for (unsigned j = 0; j < 16; ++j) {
      const unsigned c = xb_ld(&bar[XB_XCNT(j)]);
      sum += c; cnt += (c > 0u) ? 1u : 0u; mine = (j == x) ? c : mine;
    }
    if (sum == G) break;
    __builtin_amdgcn_s_sleep(1);
    if ((++sp & 255u) == 0u) {
      if (xb_ld(&bar[XB_TMO])) break;
      if (sp > XB_SPIN_CAP) { atomicAdd(&bar[XB_TMO], 1u); break; }
    }
  }
  nloc = mine > 0u ? mine : 1u;
  nx = cnt > 0u ? cnt : 1u;
}
DI void gbar(GBar& b) {
  asm volatile("s_waitcnt vmcnt(0)" ::: "memory");
  __syncthreads();
  if (threadIdx.x == 0) {
    unsigned* bar = b.bar;
    __builtin_amdgcn_s_waitcnt(0);
    if (b.nloc == 0u) gbar_complete(bar, b.x, b.nloc, b.nx);
    const unsigned nloc = b.nloc, nx = b.nx;
    const unsigned old = xb_add(&bar[XB_XSUB(b.x)], 1u);
    const unsigned gen = old / nloc;
    if (old + 1u == (gen + 1u) * nloc) {
      __builtin_amdgcn_fence(__ATOMIC_RELEASE, "agent");
      asm volatile("s_waitcnt vmcnt(0)" ::: "memory");
      const unsigned og = xb_add(&bar[XB_TOP], 1u);
      const unsigned tg = og / nx;
      if (og + 1u == (tg + 1u) * nx) xb_add(&bar[XB_TOPGEN], 1u);
      else XB_SPIN(xb_ld(&bar[XB_TOPGEN]) == tg, bar);
      __builtin_amdgcn_fence(__ATOMIC_ACQUIRE, "agent");
      xb_add(&bar[XB_XGEN(b.x)], 1u);
      asm volatile("s_waitcnt vmcnt(0)" ::: "memory");
    } else {
      XB_SPIN(xb_ld(&bar[XB_XGEN(b.x)]) == gen, bar);
      __builtin_amdgcn_fence(__ATOMIC_ACQUIRE, "agent");
      asm volatile("s_waitcnt vmcnt(0)" ::: "memory");
    }
  }
  __syncthreads();
}

template <class Setup, class Epi>
DI void gemm_phase128(char* smem, int s0, int s_end, int s_step, Setup setup, int ldb, Epi epi) {
  if (s0 >= s_end) return;
  u16* sA0 = (u16*)smem;
  u16* sB0 = sA0 + 128 * LDT;
  u16* sA1 = sB0 + 128 * LDT;
  u16* sB1 = sA1 + 128 * LDT;
  const int tid = otid(), lane = tid & 63, w = tid >> 6, r = lane & 31, h = lane >> 5;
  const int a_r0 = tid >> 3, a_c = (tid & 7) * 8;
  const int b_n4 = tid & 31, b_kq = tid >> 5;
  const u16 *apb0, *apb1, *apb2, *apb3;
  const float* bp;
  setup(s0, a_r0, a_c, b_n4, b_kq, apb0, apb1, apb2, apb3, bp);

  u32x4 pa0, pa1, pa2, pa3;
  f32x4 pb[8];

#define G_LOAD(KT)                                                                       \
  {                                                                                      \
    const int k0_ = (KT) * 64;                                                           \
    pa0 = *(const u32x4*)(apb0 + k0_);                                                   \
    pa1 = *(const u32x4*)(apb1 + k0_);                                                   \
    pa2 = *(const u32x4*)(apb2 + k0_);                                                   \
    pa3 = *(const u32x4*)(apb3 + k0_);                                                   \
    _Pragma("unroll") for (int i_ = 0; i_ < 8; ++i_) pb[i_] = *(const f32x4*)(bp + (size_t)(k0_ + i_) * ldb); \
  }
#define G_STAGE(SA, SBB)                                                                 \
  {                                                                                      \
    *(u32x4*)&SA[(a_r0)*LDT + a_c] = pa0;                                                \
    *(u32x4*)&SA[(a_r0 + 32) * LDT + a_c] = pa1;                                         \
    *(u32x4*)&SA[(a_r0 + 64) * LDT + a_c] = pa2;                                         \
    *(u32x4*)&SA[(a_r0 + 96) * LDT + a_c] = pa3;                                         \
    _Pragma("unroll") for (int j_ = 0; j_ < 4; ++j_) {                                   \
      u32x4 pk_;                                                                         \
      pk_.x = pack2(pb[0][j_], pb[1][j_]);                                               \
      pk_.y = pack2(pb[2][j_], pb[3][j_]);                                               \
      pk_.z = pack2(pb[4][j_], pb[5][j_]);                                               \
      pk_.w = pack2(pb[6][j_], pb[7][j_]);                                               \
      *(u32x4*)&SBB[(j_ * 32 + b_n4) * LDT + b_kq * 8] = pk_;                            \
    }                                                                                    \
  }
  const int aoff = (w * 32 + r) * LDT + 8 * h, boff = r * LDT + 8 * h;
#define G_FRAG(BUF, SA, SBB, KS)                                                         \
  {                                                                                      \
    fa[BUF] = *(const bf16x8*)(SA + aoff + (KS) * 16);                                   \
    fb[BUF][0] = *(const bf16x8*)(SBB + boff + (KS) * 16);                               \
    fb[BUF][1] = *(const bf16x8*)(SBB + boff + 32 * LDT + (KS) * 16);                    \
    fb[BUF][2] = *(const bf16x8*)(SBB + boff + 64 * LDT + (KS) * 16);                    \
    fb[BUF][3] = *(const bf16x8*)(SBB + boff + 96 * LDT + (KS) * 16);                    \
  }
#define G_MFMA(BUF)                                                                      \
  {                                                                                      \
    acc[0] = MFMA(fa[BUF], fb[BUF][0], acc[0]);                                          \
    acc[1] = MFMA(fa[BUF], fb[BUF][1], acc[1]);                                          \
    acc[2] = MFMA(fa[BUF], fb[BUF][2], acc[2]);                                          \
    acc[3] = MFMA(fa[BUF], fb[BUF][3], acc[3]);                                          \
  }
#define SB() __builtin_amdgcn_sched_barrier(0)
#define G_COMPUTE(SA, SBB)                                                               \
  {                                                                                      \
    bf16x8 fa[2], fb[2][4];                                                              \
    G_FRAG(0, SA, SBB, 0);                                                               \
    G_FRAG(1, SA, SBB, 1);                                                               \
    SB();                                                                                \
    G_MFMA(0);                                                                           \
    SB();                                                                                \
    G_FRAG(0, SA, SBB, 2);                                                               \
    SB();                                                                                \
    G_MFMA(1);                                                                           \
    SB();                                                                                \
    G_FRAG(1, SA, SBB, 3);                                                               \
    SB();                                                                                \
    G_MFMA(0);                                                                           \
    SB();                                                                                \
    G_MFMA(1);                                                                           \
    SB();                                                                                \
  }

  G_LOAD(0);
  __syncthreads();
#pragma unroll 1
  for (int s = s0; s < s_end; s += s_step) {
    f32x16 acc[4];
#pragma unroll
    for (int a = 0; a < 4; ++a)
#pragma unroll
      for (int i = 0; i < 16; ++i) acc[a][i] = 0.f;
    const int sn = s + s_step;
    const bool has_next = sn < s_end;
    const u16 *n0 = apb0, *n1 = apb1, *n2 = apb2, *n3 = apb3;
    const float* nbp = bp;
    if (has_next) setup(sn, a_r0, a_c, b_n4, b_kq, n0, n1, n2, n3, nbp);
#pragma unroll 1
    for (int kt = 0; kt < 16; kt += 2) {
      G_STAGE(sA0, sB0);
      __syncthreads();
      G_LOAD(kt + 1);
      G_COMPUTE(sA0, sB0);
      G_STAGE(sA1, sB1);
      __syncthreads();
      {
        int kn = kt + 2;
        if (kt == 14) { apb0 = n0; apb1 = n1; apb2 = n2; apb3 = n3; bp = nbp; kn = 0; }
        G_LOAD(kn);
      }
      G_COMPUTE(sA1, sB1);
    }
    epi(s, acc, w, r, h);
  }
  __syncthreads();
#undef G_LOAD
#undef G_STAGE
#undef G_COMPUTE
#undef G_FRAG
#undef G_MFMA
}
#undef SB

template <bool CONTIG, class Setup, class Epi, class Pre>
DI void gemm_phase(char* smem, int s0, int s_end, int s_step, Setup setup, int ldb, Epi epi, Pre pre) {
  asm volatile("" : "+s"(s_end));
  if (s0 >= s_end) return;
  constexpr int LDK = 40;
  u16* sA0 = (u16*)smem;
  u16* sB0 = sA0 + 256 * LDK;
  u16* sA1 = sB0 + 128 * LDK;
  u16* sB1 = sA1 + 256 * LDK;
  const int tid = otid(), lane = tid & 63, w = tid >> 6, r = lane & 31, h = lane >> 5;
  const int a_r0 = tid >> 2, a_c = (tid & 3) * 8;
  const int b_n4 = tid & 31, b_kq = tid >> 5;
  const u16* abase;
  const float* bbase;
  unsigned ao0, ao1, ao2, ao3, bo;
  setup(s0, a_r0, a_c, b_n4, b_kq, abase, ao0, ao1, ao2, ao3, bbase, bo);

  u32x4 pa0, pa1, pa2, pa3;
  f32x4 pbA[4], pbB[4];

#define G_LOADA(KT)                                                                      \
  {                                                                                      \
    const int k0_ = (((KT) + rot) & 31) * 32;               \
    pa0 = *(const u32x4*)(abase + k0_ + (size_t)ao0);                                    \
    pa1 = *(const u32x4*)(abase + k0_ + (size_t)(CONTIG ? ao0 + 64u * DM : ao1));        \
    pa2 = *(const u32x4*)(abase + k0_ + (size_t)(CONTIG ? ao0 + 128u * DM : ao2));       \
    pa3 = *(const u32x4*)(abase + k0_ + (size_t)(CONTIG ? ao0 + 192u * DM : ao3));       \
  }
#define G_LOADB(PB, BP, KT, ROT)                                                         \
  {                                                                                      \
    const int k0_ = (((KT) + (ROT)) & 31) * 32;                                          \
    _Pragma("unroll") for (int i_ = 0; i_ < 4; ++i_) PB[i_] = *(const f32x4*)((BP) + (size_t)(k0_ + i_) * ldb + (size_t)bo); \
  }
#define G_STAGE(SA, SBB, PB)                                                               \
  {                                                                                      \
    *(u32x4*)&SA[(a_r0)*LDK + a_c] = pa0;                                                \
    *(u32x4*)&SA[(a_r0 + 64) * LDK + a_c] = pa1;                                         \
    *(u32x4*)&SA[(a_r0 + 128) * LDK + a_c] = pa2;                                        \
    *(u32x4*)&SA[(a_r0 + 192) * LDK + a_c] = pa3;                                        \
    _Pragma("unroll") for (int j_ = 0; j_ < 4; ++j_) {                                   \
      uint2 pk_;                                                                         \
      pk_.x = pack2(PB[0][j_], PB[1][j_]);                                               \
      pk_.y = pack2(PB[2][j_], PB[3][j_]);                                               \
      *(uint2*)&SBB[(j_ * 32 + b_n4) * LDK + b_kq * 4] = pk_;                            \
    }                                                                                    \
  }
  const int aoff = (w * 64 + r) * LDK + 8 * h, boff = r * LDK + 8 * h;
#define G_FRAG(FA, FB, SA, SBB, KS)                                                      \
  {                                                                                      \
    FA[0] = *(const bf16x8*)(SA + aoff + (KS) * 16);                                     \
    FA[1] = *(const bf16x8*)(SA + aoff + 32 * LDK + (KS) * 16);                          \
    FB[0] = *(const bf16x8*)(SBB + boff + (KS) * 16);                                    \
    FB[1] = *(const bf16x8*)(SBB + boff + 32 * LDK + (KS) * 16);                         \
    FB[2] = *(const bf16x8*)(SBB + boff + 64 * LDK + (KS) * 16);                         \
    FB[3] = *(const bf16x8*)(SBB + boff + 96 * LDK + (KS) * 16);                         \
  }
#define G_MFMA(FA, FB)                                                                   \
  {                                                                                      \
    _Pragma("unroll") for (int mt_ = 0; mt_ < 2; ++mt_)                                  \
    _Pragma("unroll") for (int nt_ = 0; nt_ < 4; ++nt_) acc[mt_][nt_] = MFMA(FA[mt_], FB[nt_], acc[mt_][nt_]); \
  }
#define SB() __builtin_amdgcn_sched_barrier(0)
#define G_COMPUTE(SA, SBB)                                                               \
  {                                                                                      \
    bf16x8 fa0[2], fb0[4];                                                               \
    G_FRAG(fa0, fb0, SA, SBB, 0);                                                        \
    SB();                                                                                \
    G_MFMA(fa0, fb0);                                                                    \
    SB();                                                                                \
    G_FRAG(fa0, fb0, SA, SBB, 1);                                                        \
    SB();                                                                                \
    G_MFMA(fa0, fb0);                                                                    \
    SB();                                                                                \
  }

  int rot = (s0 % 6) + ((s0 / 6) & 1);
  G_LOADA(0);
  G_LOADB(pbA, bbase, 0, rot);
  G_LOADB(pbB, bbase, 1, rot);
  __syncthreads();
#pragma unroll 1
  for (int s = s0; s < s_end; s += s_step) {
    f32x16 acc[2][4];
#pragma unroll
    for (int a = 0; a < 2; ++a)
#pragma unroll
      for (int b = 0; b < 4; ++b)
#pragma unroll
        for (int i = 0; i < 16; ++i) acc[a][b][i] = 0.f;
    pre(s, tid);
    const int sn = s + s_step;
    const bool has_next = sn < s_end;
    const u16* nabase = abase;
    const float* nbbase = bbase;
    unsigned n0 = ao0, n1 = ao1, n2 = ao2, n3 = ao3, nbo = bo;
    if (has_next) setup(sn, a_r0, a_c, b_n4, b_kq, nabase, n0, n1, n2, n3, nbbase, nbo);
    const int nrot = has_next ? ((sn % 6) + ((sn / 6) & 1)) : rot;
#pragma unroll 1
    for (int kt = 0; kt < 32; kt += 2) {
      G_STAGE(sA0, sB0, pbA);
      G_LOADA(kt + 1);
      __syncthreads();
      {
        const bool last = (kt == 30);
        const float* bq = last ? nbbase : bbase;
        const int kb = last ? 0 : kt + 2;
        G_LOADB(pbA, bq, kb, last ? nrot : rot);
      }
      G_COMPUTE(sA0, sB0);
      G_STAGE(sA1, sB1, pbB);
      {
        int ka = kt + 2, kb = kt + 3;
        if (kt == 30) { abase = nabase; ao0 = n0; ao1 = n1; ao2 = n2; ao3 = n3; bbase = nbbase; rot = nrot; ka = 0; kb = 1; }
        G_LOADA(ka);
        G_LOADB(pbB, bbase, kb, rot);
      }
      __syncthreads();
      G_COMPUTE(sA1, sB1);
    }
    epi(s, acc, w, r, h);
  }
  __syncthreads();
#undef G_LOADA
#undef G_LOADB
#undef G_STAGE
#undef G_COMPUTE
#undef G_FRAG
#undef G_MFMA
}

DI void load4x4(const void* base, int stride, bool isf32, int rq, int c4, float v[4][4]) {
  if (isf32) {
#pragma unroll
    for (int i = 0; i < 4; ++i) {
      const float4 x = *(const float4*)((const float*)base + (size_t)(4 * rq + i) * stride + 4 * c4);
      v[i][0] = x.x; v[i][1] = x.y; v[i][2] = x.z; v[i][3] = x.w;
    }
  } else {
#pragma unroll
    for (int i = 0; i < 4; ++i) {
      const uint2 x = *(const uint2*)((const u16*)base + (size_t)(4 * rq + i) * stride + 4 * c4);
      v[i][0] = bflo(x.x); v[i][1] = bfhi(x.x); v[i][2] = bflo(x.y); v[i][3] = bfhi(x.y);
    }
  }
}
DI void store_n(u16* dst, int ld, int row0, int rq, int c4, const float v[4][4]) {
#pragma unroll
  for (int i = 0; i < 4; ++i) {
    uint2 pk = {pack2(v[i][0], v[i][1]), pack2(v[i][2], v[i][3])};
    *(uint2*)&dst[(row0 + 4 * rq + i) * ld + 4 * c4] = pk;
  }
}
DI void store_t(u16* dst, int ld, int col0, int rq, int c4, const float v[4][4], const float s[4]) {
#pragma unroll
  for (int j = 0; j < 4; ++j) {
    uint2 pk = {pack2(v[0][j] * s[0], v[1][j] * s[1]), pack2(v[2][j] * s[2], v[3][j] * s[3])};
    *(uint2*)&dst[(4 * c4 + j) * ld + col0 + 4 * rq] = pk;
  }
}

DI void attn_load(const u16* kp, const u16* vp, int stride, int rq, int c4, uint2 (&k)[4], uint2 (&v)[4]) {
#pragma unroll
  for (int i = 0; i < 4; ++i) {
    k[i] = *(const uint2*)(kp + (size_t)(4 * rq + i) * stride + 4 * c4);
    v[i] = *(const uint2*)(vp + (size_t)(4 * rq + i) * stride + 4 * c4);
  }
}
DI void attn_stage(u16* sK, u16* sVT, int rq, int c4, const uint2 (&k)[4], const uint2 (&v)[4]) {
#pragma unroll
  for (int i = 0; i < 4; ++i) *(uint2*)&sK[(4 * rq + i) * LDT + 4 * c4] = k[i];
  uint2 t0, t1, t2, t3;
  t0.x = (v[0].x & 0xffffu) | (v[1].x << 16);          t0.y = (v[2].x & 0xffffu) | (v[3].x << 16);
  t1.x = (v[0].x >> 16) | (v[1].x & 0xffff0000u);      t1.y = (v[2].x >> 16) | (v[3].x & 0xffff0000u);
  t2.x = (v[0].y & 0xffffu) | (v[1].y << 16);          t2.y = (v[2].y & 0xffffu) | (v[3].y << 16);
  t3.x = (v[0].y >> 16) | (v[1].y & 0xffff0000u);      t3.y = (v[2].y >> 16) | (v[3].y & 0xffff0000u);
  const int qs = 4 * (rq ^ ((c4 >> 1) & 7));
  *(uint2*)&sVT[(4 * c4 + 0) * LDT + qs] = t0;
  *(uint2*)&sVT[(4 * c4 + 1) * LDT + qs] = t1;
  *(uint2*)&sVT[(4 * c4 + 2) * LDT + qs] = t2;
  *(uint2*)&sVT[(4 * c4 + 3) * LDT + qs] = t3;
}

template <class TileSrc, class BiasF, class TMode>
DI void attn_core(char* smem, const u16* qbase, int ntiles, TileSrc src, BiasF biasf, TMode tmode, float m_init, bool has_sink, u16* obase) {
  u16* sK0 = (u16*)smem;
  u16* sVT0 = sK0 + 64 * LDT;
  u16* sK1 = sVT0 + 64 * LDT;
  u16* sVT1 = sK1 + 64 * LDT;
  const int tid = otid(), lane = tid & 63, w = tid >> 6, r = lane & 31, h = lane >> 5;
  const int rq = tid >> 4, c4 = tid & 15;
  const int ql = w * 32 + r;
  bf16x8 qf[4];
#pragma unroll
  for (int ks = 0; ks < 4; ++ks) qf[ks] = *(const bf16x8*)(qbase + (size_t)ql * DIN + ks * 16 + 8 * h);
  f32x16 O[2];
#pragma unroll
  for (int d = 0; d < 2; ++d)
#pragma unroll
    for (int i = 0; i < 16; ++i) O[d][i] = 0.f;
  float m = m_init, lsum = (has_sink && h == 0) ? 1.f : 0.f;

  auto nextv = [&](int j, const u16*& kp, const u16*& vp, int& stride) -> int {
    while (j < ntiles && !src(j, kp, vp, stride)) ++j;
    return j;
  };
  auto compute = [&](int jc, const u16* sK, const u16* sVT) {
    const int mode = tmode(jc, w);
    if (mode != 2) {
      f32x16 S[2];
#pragma unroll
      for (int mt = 0; mt < 2; ++mt)
#pragma unroll
        for (int i = 0; i < 16; ++i) S[mt][i] = 0.f;
#pragma unroll
      for (int ks = 0; ks < 4; ++ks)
#pragma unroll
        for (int mt = 0; mt < 2; ++mt) {
          const bf16x8 kf = *(const bf16x8*)&sK[(mt * 32 + r) * LDT + ks * 16 + 8 * h];
          S[mt] = MFMA(kf, qf[ks], S[mt]);
        }
      const float C2 = 0.125f * 1.44269504f;
      float mx = NEG;
      if (mode == 1) {
#pragma unroll
        for (int mt = 0; mt < 2; ++mt)
#pragma unroll
          for (int i = 0; i < 16; ++i) {
            const float s = S[mt][i] * C2 + biasf(jc, mt * 32 + crow(i, h), ql);
            S[mt][i] = s;
            mx = fmaxf(mx, s);
          }
      } else {
#pragma unroll
        for (int mt = 0; mt < 2; ++mt)
#pragma unroll
          for (int i = 0; i < 16; ++i) {
            const float s = S[mt][i] * C2;
            S[mt][i] = s;
            mx = fmaxf(mx, s);
          }
      }
      mx = fmaxf(mx, __shfl_xor(mx, 32));
      const float mn = fmaxf(m, mx);
      if (__any(mn > m)) {
        const float alpha = __builtin_amdgcn_exp2f(m - mn);
        m = mn;
        lsum *= alpha;
#pragma unroll
        for (int d = 0; d < 2; ++d)
#pragma unroll
          for (int i = 0; i < 16; ++i) O[d][i] *= alpha;
      }
      float ps = 0.f;
#pragma unroll
      for (int mt = 0; mt < 2; ++mt)
#pragma unroll
        for (int i = 0; i < 16; ++i) {
          const float pv = __builtin_amdgcn_exp2f(S[mt][i] - m);
          S[mt][i] = pv;
          ps += pv;
        }
      lsum += ps;
#pragma unroll
      for (int mt = 0; mt < 2; ++mt)
#pragma unroll
        for (int s = 0; s < 2; ++s) {
          const bf16x8 pf = mk8(pack2(S[mt][8 * s + 0], S[mt][8 * s + 1]), pack2(S[mt][8 * s + 2], S[mt][8 * s + 3]),
                                pack2(S[mt][8 * s + 4], S[mt][8 * s + 5]), pack2(S[mt][8 * s + 6], S[mt][8 * s + 7]));
#pragma unroll
          for (int d = 0; d < 2; ++d) {
            const int sw = (d * 4 + (r >> 3)) & 7, q = mt * 8 + 4 * s + h;
            const u16* vrow = &sVT[(d * 32 + r) * LDT];
            const uint2 lo = *(const uint2*)(vrow + 4 * (q ^ sw));
            const uint2 hi = *(const uint2*)(vrow + 4 * ((q + 2) ^ sw));
            O[d] = MFMA(mk8(lo.x, lo.y, hi.x, hi.y), pf, O[d]);
          }
        }
    }
  };

  uint2 kA[4], vA[4], kB[4], vB[4];
#pragma unroll
  for (int i = 0; i < 4; ++i) { kA[i] = make_uint2(0u, 0u); vA[i] = kA[i]; kB[i] = kA[i]; vB[i] = kA[i]; }
  const u16 *kp = nullptr, *vp = nullptr;
  int stride = 0;
  int jA = nextv(0, kp, vp, stride);
  if (jA < ntiles) attn_load(kp, vp, stride, rq, c4, kA, vA);
  int jB = nextv(jA + 1, kp, vp, stride);
  if (jB < ntiles) attn_load(kp, vp, stride, rq, c4, kB, vB);
  __syncthreads();
#pragma unroll 1
  for (;;) {
    if (jA >= ntiles) break;
    attn_stage(sK0, sVT0, rq, c4, kA, vA);
    {
      const int jc = jA;
      jA = nextv(jB + 1, kp, vp, stride);
      if (jA < ntiles) attn_load(kp, vp, stride, rq, c4, kA, vA);
      __syncthreads();
      compute(jc, sK0, sVT0);
    }
    if (jB >= ntiles) break;
    attn_stage(sK1, sVT1, rq, c4, kB, vB);
    {
      const int jc = jB;
      jB = nextv(jA + 1, kp, vp, stride);
      if (jB < ntiles) attn_load(kp, vp, stride, rq, c4, kB, vB);
      __syncthreads();
      compute(jc, sK1, sVT1);
    }
  }
  const float l = lsum + __shfl_xor(lsum, 32);
  const float inv = 1.f / l;
#pragma unroll
  for (int d = 0; d < 2; ++d)
#pragma unroll
    for (int g = 0; g < 4; ++g) {
      uint2 pk = {pack2(O[d][4 * g + 0] * inv, O[d][4 * g + 1] * inv), pack2(O[d][4 * g + 2] * inv, O[d][4 * g + 3] * inv)};
      *(uint2*)(obase + (size_t)ql * DM + d * 32 + 8 * g + 4 * h) = pk;
    }
}

DI void phase0(const Params& p, char* smem) {
  const int tid = otid();
  if (blockIdx.x == 0) {
    for (int idx = tid; idx < 1024; idx += 256) {
      const int pos = idx >> 4, j = idx & 15;
      const double inv = 1.0 / pow(10000.0, (double)j / 16.0);
      const float ang = (float)((double)pos * inv);
      p.ROPE[idx] = cosf(ang);
      p.ROPE[1024 + idx] = sinf(ang);
    }
  }
  float* scond = (float*)smem;
  for (int item = blockIdx.x; item < 768; item += gridDim.x) {
    const int l = item / 384, ks = (item / 24) % 16, jb = item % 24;
    __syncthreads();
    for (int idx = tid; idx < 320; idx += 256) {
      const int c = idx / 64, k = ks * 64 + (idx & 63);
      const float v = (c == 0) ? p.c_ctx[k] : p.c[(c - 1) * DM + k];
      scond[idx] = silu(v);
    }
    __syncthreads();
    const int j = jb * 256 + tid;
    const float* wp = p.w_ada + ((size_t)l * DM + ks * 64) * 6144 + j;
    float a[5] = {0.f, 0.f, 0.f, 0.f, 0.f};
#pragma unroll 8
    for (int k = 0; k < 64; ++k) {
      const float wv = wp[(size_t)k * 6144];
#pragma unroll
      for (int c = 0; c < 5; ++c) a[c] += scond[c * 64 + k] * wv;
    }
    const float bias = (ks == 0) ? p.b_ada[l * 6144 + j] : 0.f;
#pragma unroll
    for (int c = 0; c < 5; ++c) unsafeAtomicAdd(&p.MOD[(l * 5 + c) * 6144 + j], a[c] + bias);
  }
}

DI int cond_of(int T) { return T < NCTX ? 0 : 1 + ((T - NCTX) >> 11); }

DI void cvt_f32_bf16(const float* s, u16* d, int n4, int gtid, int gsz) {
  for (int i = gtid; i < n4; i += gsz) {
    const float4 x = *(const float4*)(s + (size_t)i * 4);
    uint2 pk = {pack2(x.x, x.y), pack2(x.z, x.w)};
    *(uint2*)(d + (size_t)i * 4) = pk;
  }
}
DI void phase0b(const Params& p) {
  const int tid = otid(), lane = tid & 63, w = tid >> 6;
  {
    const int gtid = blockIdx.x * 256 + tid, gsz = gridDim.x * 256;
    cvt_f32_bf16(p.cak, p.CAK, 4 * 2 * 512 * 128 / 4, gtid, gsz);
    cvt_f32_bf16(p.cav, p.CAV, 4 * 2 * 512 * 128 / 4, gtid, gsz);
    cvt_f32_bf16(p.cbk, p.CBK, 4 * 2 * 512 * 256 / 4, gtid, gsz);
    cvt_f32_bf16(p.cbv, p.CBV, 4 * 2 * 512 * 256 / 4, gtid, gsz);
  }
  for (int T = blockIdx.x * 4 + w; T < NTOK; T += gridDim.x * 4) {
    const float* mod = p.MOD + (size_t)cond_of(T) * 6144;
    const float* xr = (T < NCTX) ? (p.x_prompt + (size_t)T * DM) : (p.x_sample + (size_t)(T - NCTX) * DM);
#pragma unroll
    for (int i = 0; i < 4; ++i) {
      const int k = 256 * i + 4 * lane;
      const float4 x = *(const float4*)(xr + k);
      const float4 sc = *(const float4*)(mod + 1024 + k), sh = *(const float4*)(mod + k);
      uint2 pk = {pack2(x.x * (1.f + sc.x) + sh.x, x.y * (1.f + sc.y) + sh.y), pack2(x.z * (1.f + sc.z) + sh.z, x.w * (1.f + sc.w) + sh.w)};
      *(uint2*)(p.H2 + (size_t)T * DM + k) = pk;
    }
  }
}

DI void phase1(const Params& p, char* smem, int l) {
  const float* W = p.w_in + (size_t)l * DM * DIN;
  const int xcd = blockIdx.x & 7, nloc = gridDim.x >> 3;
  float* sR = (float*)(smem + 61440);
  for (int idx = otid(); idx < 2048; idx += 256) sR[idx] = p.ROPE[idx];
  auto setup = [&](int s, int ar0, int ac, int n4, int kq, const u16*& ab, unsigned& o0, unsigned& o1, unsigned& o2, unsigned& o3, const float*& bb, unsigned& bo) {
    const int tm = 6 * xcd + s % 6, tn = s / 6;
    ab = p.H2 + (size_t)tm * 256 * DM;
    o0 = (unsigned)(ar0 * DM + ac); o1 = o0 + 64u * DM; o2 = o0 + 128u * DM; o3 = o0 + 192u * DM;
    bb = W + tn * 128;
    bo = (unsigned)(4 * n4 + kq * 4 * DIN);
  };
  auto epi = [&](int s, f32x16(&acc)[2][4], int w, int r, int h) {
    int hq = h;
    asm volatile("" : "+v"(hq));
    const int tm = 6 * xcd + s % 6, tn = s / 6;
    const int m0 = tm * 256, n0 = tn * 128;
    const bool lat = m0 >= NCTX;
    const bool rope = lat && (n0 < 640);
    const int n = n0 + 4 * r;
    const int q = (r >> 2) & 3;
#pragma unroll
    for (int mt = 0; mt < 2; ++mt)
#pragma unroll
    for (int i = 0; i < 16; ++i) {
      const int T = m0 + w * 64 + mt * 32 + crow(i, hq);
      float v0 = acc[mt][0][i], v1 = acc[mt][1][i], v2 = acc[mt][2][i], v3 = acc[mt][3][i];
      if (rope) {
        const int t = (T - NCTX) & 2047;
        const int pos = (q < 2) ? (t >> 6) : (t & 63);
        const int jf = 4 * (r & 3);
        const float4 cs = *(const float4*)(sR + pos * 16 + jf), sn = *(const float4*)(sR + 1024 + pos * 16 + jf);
        const float o0 = __shfl_xor(v0, 4), o1 = __shfl_xor(v1, 4), o2 = __shfl_xor(v2, 4), o3 = __shfl_xor(v3, 4);
        if (q & 1) { v0 = o0 * sn.x + v0 * cs.x; v1 = o1 * sn.y + v1 * cs.y; v2 = o2 * sn.z + v2 * cs.z; v3 = o3 * sn.w + v3 * cs.w; }
        else { v0 = v0 * cs.x - o0 * sn.x; v1 = v1 * cs.y - o1 * sn.y; v2 = v2 * cs.z - o2 * sn.z; v3 = v3 * cs.w - o3 * sn.w; }
      }
      uint2 pk = {pack2(v0, v1), pack2(v2, v3)};
      *(uint2*)(p.QKV + (size_t)T * DIN + n) = pk;
      if (!lat) {
        const int b = T >> 8, t = T & 255;
        const float4 vv = {v0, v1, v2, v3};
        if (n0 == 512) *(float4*)(p.out + OFF_AK + ((size_t)(b * 2 + l) * 256 + t) * 128 + (n - 512)) = vv;
        else if (n0 == 640) *(float4*)(p.out + OFF_AV + ((size_t)(b * 2 + l) * 256 + t) * 128 + (n - 640)) = vv;
        else if (n0 == 1024 || n0 == 1152) *(float4*)(p.out + OFF_BK + ((size_t)(b * 2 + l) * 256 + t) * 256 + (n - 1024)) = vv;
        else if (n0 == 1280 || n0 == 1408) *(float4*)(p.out + OFF_BV + ((size_t)(b * 2 + l) * 256 + t) * 256 + (n - 1280)) = vv;
      }
      if ((i & 3) == 3) __builtin_amdgcn_sched_barrier(0);
    }
  };
  gemm_phase<true>(smem, blockIdx.x >> 3, 120, nloc, setup, DIN, epi, [](int, int) {});
}

DI float ret_lg(const Params& p, int l, int dir, int head) { return -__expf(p.decay[(l * 2 + dir) * 4 + head]); }

DI size_t kvs_slot(int req, int head, int dir, int c) { return ((size_t)((req * 4 + head) * 2 + dir) * 16 + c) * 4096; }

DI void retkv_item(const Params& p, char* smem, int l, int req, int head, int c) {
  u16* sKTf = (u16*)smem;
  u16* sKTb = sKTf + 64 * LDT2;
  u16* sVT = sKTb + 64 * LDT2;
  const int tid = otid(), lane = tid & 63, w = tid >> 6, r = lane & 31, h = lane >> 5;
  const int rq = tid >> 4, c4 = tid & 15;
  const int T0 = (req < 16 ? req * 256 : NCTX + (req - 16) * 2048) + c * 128;
  const float lgf = ret_lg(p, l, 0, head), lgb = ret_lg(p, l, 1, head);
  const float one4[4] = {1.f, 1.f, 1.f, 1.f};
  __syncthreads();
#pragma unroll
  for (int half = 0; half < 2; ++half) {
    float v[4][4];
    float sf[4], sb[4];
#pragma unroll
    for (int i = 0; i < 4; ++i) {
      const int j = half * 64 + 4 * rq + i;
      sf[i] = 0.125f * __expf(lgf * (float)(127 - j));
      sb[i] = 0.125f * __expf(lgb * (float)j);
    }
    load4x4(p.QKV + (size_t)(T0 + half * 64) * DIN + 1792 + head * 64, DIN, false, rq, c4, v);
    store_t(sKTf, LDT2, half * 64, rq, c4, v, sf);
    store_t(sKTb, LDT2, half * 64, rq, c4, v, sb);
    load4x4(p.QKV + (size_t)(T0 + half * 64) * DIN + 2048 + head * 64, DIN, false, rq, c4, v);
    store_t(sVT, LDT2, half * 64, rq, c4, v, one4);
  }
  __syncthreads();
  const int dir = w >> 1, mt = w & 1;
  const u16* sKT = dir ? sKTb : sKTf;
  f32x16 acc[2];
#pragma unroll
  for (int nt = 0; nt < 2; ++nt)
#pragma unroll
    for (int i = 0; i < 16; ++i) acc[nt][i] = 0.f;
#pragma unroll
  for (int ks = 0; ks < 8; ++ks) {
    const bf16x8 fa = *(const bf16x8*)&sKT[(mt * 32 + r) * LDT2 + ks * 16 + 8 * h];
#pragma unroll
    for (int nt = 0; nt < 2; ++nt) {
      const bf16x8 fb = *(const bf16x8*)&sVT[(nt * 32 + r) * LDT2 + ks * 16 + 8 * h];
      acc[nt] = MFMA(fa, fb, acc[nt]);
    }
  }
  float* dst = p.KVS + kvs_slot(req, head, dir, c);
#pragma unroll
  for (int nt = 0; nt < 2; ++nt)
#pragma unroll
    for (int i = 0; i < 16; ++i) dst[(mt * 32 + crow(i, h)) * 64 + nt * 32 + r] = acc[nt][i];
}

DI void phase2(const Params& p, char* smem, int l) {
  const int tid = otid();
  for (int item = blockIdx.x; item < 1536; item += gridDim.x) {
    if (item < 512) {
      const int b = item >> 7, head = (item >> 4) & 7, qb = item & 15, kvh = head >> 2;
      const int T0 = NCTX + b * 2048 + qb * 128;
      const u16* ck = p.CAK + ((size_t)(b * 2 + l) * 512) * 128 + kvh * 64;
      const u16* cv = p.CAV + ((size_t)(b * 2 + l) * 512) * 128 + kvh * 64;
      auto src = [&](int j, const u16*& kp, const u16*& vp, int& stride) -> bool {
        if (j < 8) {
          kp = ck + (size_t)j * 64 * 128; vp = cv + (size_t)j * 64 * 128; stride = 128;
          return true;
        }
        const int jj = j - 8, kb = qb - 1 + (jj >> 1);
        if (kb < 0 || kb >= 16) return false;
        const int Tk = NCTX + b * 2048 + kb * 128 + (jj & 1) * 64;
        kp = p.QKV + (size_t)Tk * DIN + 512 + kvh * 64; vp = p.QKV + (size_t)Tk * DIN + 640 + kvh * 64; stride = DIN;
        return true;
      };
      auto biasf = [&](int j, int key, int ql) -> float {
        if (j < 8) return 0.f;
        const int jj = j - 8;
        const int kj = (qb - 1 + (jj >> 1)) * 128 + (jj & 1) * 64 + key;
        const int qi = qb * 128 + ql;
        const int d = qi - kj;
        return (d <= 128 && d >= -128) ? 0.f : NEG;
      };
      auto tmode = [&](int j, int w) -> int {
        if (j < 8) return 0;
        const int jj = j - 8;
        const int k0 = (qb - 1 + (jj >> 1)) * 128 + (jj & 1) * 64, q0w = qb * 128 + w * 32;
        if (k0 - (q0w + 31) > 128 || q0w - (k0 + 63) > 128) return 2;
        if ((q0w + 31) - k0 <= 128 && (k0 + 63) - q0w <= 128) return 0;
        return 1;
      };
      attn_core(smem, p.QKV + (size_t)T0 * DIN + head * 64, 14, src, biasf, tmode, p.sink[l * 8 + head] * 1.44269504f, true,
                p.CAT + (size_t)T0 * DM + head * 64);
    } else if (item < 768) {
      const int it = item - 512;
      const int b = it >> 6, head = (it >> 4) & 3, qb = it & 15;
      const int T0 = NCTX + b * 2048 + qb * 128;
      float* srpb = (float*)(smem + 4 * 64 * LDT * 2);
      __syncthreads();
      for (int idx = tid; idx < 465; idx += 256) srpb[idx] = p.rpb[(size_t)(l * 4 + head) * 465 + idx] * 1.44269504f;
      const int r0 = 2 * qb;
      const int rmin = min(max(r0 - 4, 0), 24), rmax = min(max(r0 + 1 - 4, 0), 24) + 7;
      const u16* ck = p.CBK + ((size_t)(b * 2 + l) * 512) * 256 + head * 64;
      const u16* cv = p.CBV + ((size_t)(b * 2 + l) * 512) * 256 + head * 64;
      auto src = [&](int j, const u16*& kp, const u16*& vp, int& stride) -> bool {
        if (j < 8) {
          kp = ck + (size_t)j * 64 * 256; vp = cv + (size_t)j * 64 * 256; stride = 256;
          return true;
        }
        const int Tk = NCTX + b * 2048 + (rmin + j - 8) * 64;
        kp = p.QKV + (size_t)Tk * DIN + 1024 + head * 64; vp = p.QKV + (size_t)Tk * DIN + 1280 + head * 64; stride = DIN;
        return true;
      };
      auto biasf = [&](int j, int key, int ql) -> float {
        if (j < 8) return 0.f;
        const int kr = rmin + j - 8, kc = key;
        const int qr = r0 + (ql >> 6), qc = ql & 63;
        const int rs = min(max(qr - 4, 0), 24), cs = min(max(qc - 8, 0), 48);
        const bool ok = (kr >= rs) && (kr < rs + 8) && (kc >= cs) && (kc < cs + 16);
        const int bi = ok ? ((kr - qr + 7) * 31 + (kc - qc + 15)) : 0;
        const float bv = srpb[bi];
        return ok ? bv : NEG;
      };
      auto tmode = [&](int j, int w) -> int {
        if (j < 8) return 0;
        const int kr = rmin + j - 8, qr = r0 + (w >> 1);
        const int rs = min(max(qr - 4, 0), 24);
        return (kr >= rs && kr < rs + 8) ? 1 : 2;
      };
      attn_core(smem, p.QKV + (size_t)T0 * DIN + 768 + head * 64, 8 + (rmax - rmin + 1), src, biasf, tmode, NEG, false,
                p.CAT + (size_t)T0 * DM + 512 + head * 64);
    } else if (item < 1152) {
      const int it = item - 768;
      if (it < 256) retkv_item(p, smem, l, 16 + (it >> 6), (it >> 4) & 3, it & 15);
      else { const int i2 = it - 256; retkv_item(p, smem, l, i2 >> 3, (i2 >> 1) & 3, i2 & 1); }
    } else if (item < 1408) {
      const int it = item - 1152;
      const int b = it >> 4, head = (it >> 1) & 7, qh = it & 1, kvh = head >> 2;
      const int T0 = b * 256 + qh * 128;
      auto src = [&](int j, const u16*& kp, const u16*& vp, int& stride) -> bool {
        const int Tk = b * 256 + j * 64;
        kp = p.QKV + (size_t)Tk * DIN + 512 + kvh * 64; vp = p.QKV + (size_t)Tk * DIN + 640 + kvh * 64; stride = DIN;
        return true;
      };
      auto biasf = [&](int, int, int) -> float { return 0.f; };
      auto tmode = [&](int, int) -> int { return 0; };
      attn_core(smem, p.QKV + (size_t)T0 * DIN + head * 64, 4, src, biasf, tmode, p.sink[l * 8 + head] * 1.44269504f, true,
                p.CAT + (size_t)T0 * DM + head * 64);
    } else {
      const int it = item - 1408;
      const int b = it >> 3, head = (it >> 1) & 3, qh = it & 1;
      const int T0 = b * 256 + qh * 128;
      auto src = [&](int j, const u16*& kp, const u16*& vp, int& stride) -> bool {
        const int Tk = b * 256 + j * 64;
        kp = p.QKV + (size_t)Tk * DIN + 1024 + head * 64; vp = p.QKV + (size_t)Tk * DIN + 1280 + head * 64; stride = DIN;
        return true;
      };
      auto biasf = [&](int, int, int) -> float { return 0.f; };
      auto tmode = [&](int, int) -> int { return 0; };
      attn_core(smem, p.QKV + (size_t)T0 * DIN + 768 + head * 64, 4, src, biasf, tmode, NEG, false,
                p.CAT + (size_t)T0 * DM + 512 + head * 64);
    }
  }
}

DI void phase2c(const Params& p, char* smem, int l) {
  u16* sK = (u16*)smem;
  u16* sVT = sK + 128 * LDT;
  u16* sSTf = sVT + 64 * LDT2;
  u16* sSTb = sSTf + 64 * LDT;
  const int tid = otid(), lane = tid & 63, w = tid >> 6, r = lane & 31, h = lane >> 5;
  const int rq = tid >> 4, c4 = tid & 15;
  const float one4[4] = {1.f, 1.f, 1.f, 1.f};
  for (int item = blockIdx.x; item < 384; item += gridDim.x) {
    int req, head, c, nc;
    if (item < 256) { req = 16 + (item >> 6); head = (item >> 4) & 3; c = item & 15; nc = 16; }
    else { const int i2 = item - 256; req = i2 >> 3; head = (i2 >> 1) & 3; c = i2 & 1; nc = 2; }
    const bool lat = req >= 16;
    const int T0 = (lat ? NCTX + (req - 16) * 2048 : req * 256) + c * 128;
    const float lgf = ret_lg(p, l, 0, head), lgb = ret_lg(p, l, 1, head);
    const float gf = __expf(lgf * 128.f), gb = __expf(lgb * 128.f);
    __syncthreads();
    {
      const int d = tid >> 2, e0 = (tid & 3) * 16;
#pragma unroll
      for (int dir = 0; dir < 2; ++dir) {
        float s[16];
#pragma unroll
        for (int q = 0; q < 16; ++q) s[q] = 0.f;
        const float g = dir ? gb : gf;
        if (lat) {
          const float* s0 = p.state + ((size_t)(((req - 16) * 2 + l) * 2 + dir) * 4 + head) * 4096 + d * 64 + e0;
#pragma unroll
          for (int q = 0; q < 16; q += 4) {
            const float4 x = *(const float4*)(s0 + q);
            s[q] = x.x; s[q + 1] = x.y; s[q + 2] = x.z; s[q + 3] = x.w;
          }
        }
        const int nsteps = dir ? (nc - 1 - c) : c;
        for (int st = 0; st < nsteps; ++st) {
          const int cc = dir ? (nc - 1 - st) : st;
          const float* kv = p.KVS + kvs_slot(req, head, dir, cc) + d * 64 + e0;
#pragma unroll
          for (int q = 0; q < 16; q += 4) {
            const float4 x = *(const float4*)(kv + q);
            s[q] = s[q] * g + x.x; s[q + 1] = s[q + 1] * g + x.y; s[q + 2] = s[q + 2] * g + x.z; s[q + 3] = s[q + 3] * g + x.w;
          }
        }
        u16* sST = dir ? sSTb : sSTf;
#pragma unroll
        for (int q = 0; q < 16; ++q) sST[(e0 + q) * LDT + d] = (u16)(pack2(s[q], 0.f) & 0xffffu);
        if (!lat && c == 0) {
          const float* k0 = p.KVS + kvs_slot(req, head, dir, 0) + d * 64 + e0;
          const float* k1 = p.KVS + kvs_slot(req, head, dir, 1) + d * 64 + e0;
          float* o = p.out + OFF_ST + ((size_t)((req * 2 + l) * 2 + dir) * 4 + head) * 4096 + d * 64 + e0;
#pragma unroll
          for (int q = 0; q < 16; ++q) o[q] = dir ? (gb * k1[q] + k0[q]) : (gf * k0[q] + k1[q]);
        }
      }
    }
#pragma unroll
    for (int half = 0; half < 2; ++half) {
      float v[4][4];
      load4x4(p.QKV + (size_t)(T0 + half * 64) * DIN + 1792 + head * 64, DIN, false, rq, c4, v);
      store_n(sK, LDT, half * 64, rq, c4, v);
      load4x4(p.QKV + (size_t)(T0 + half * 64) * DIN + 2048 + head * 64, DIN, false, rq, c4, v);
      store_t(sVT, LDT2, half * 64, rq, c4, v, one4);
    }
    __syncthreads();
    const int qi = w * 32 + r;
    const u16* qrow = p.QKV + (size_t)(T0 + qi) * DIN + 1536 + head * 64;
    uint4 qraw[4];
#pragma unroll
    for (int ks = 0; ks < 4; ++ks) qraw[ks] = *(const uint4*)(qrow + ks * 16 + 8 * h);
    f32x16 O[2];
#pragma unroll
    for (int d = 0; d < 2; ++d)
#pragma unroll
      for (int i = 0; i < 16; ++i) O[d][i] = 0.f;
#pragma unroll 1
    for (int jt = 0; jt < 4; ++jt) {
      f32x16 S;
#pragma unroll
      for (int i = 0; i < 16; ++i) S[i] = 0.f;
#pragma unroll
      for (int ks = 0; ks < 4; ++ks) {
        const bf16x8 kf = *(const bf16x8*)&sK[(jt * 32 + r) * LDT + ks * 16 + 8 * h];
        S = MFMA(kf, __builtin_bit_cast(bf16x8, qraw[ks]), S);
      }
#pragma unroll
      for (int i = 0; i < 16; ++i) {
        const int j = jt * 32 + crow(i, h);
        const int dlt = qi - j;
        const float wgt = (dlt > 0) ? __expf(lgf * (float)dlt) : ((dlt < 0) ? __expf(lgb * (float)(-dlt)) : 2.f);
        S[i] = S[i] * 0.125f * wgt;
      }
#pragma unroll
      for (int s = 0; s < 2; ++s) {
        const bf16x8 pf = mk8(pack2(S[8 * s + 0], S[8 * s + 1]), pack2(S[8 * s + 2], S[8 * s + 3]),
                              pack2(S[8 * s + 4], S[8 * s + 5]), pack2(S[8 * s + 6], S[8 * s + 7]));
#pragma unroll
        for (int d = 0; d < 2; ++d) {
          const u16* vrow = &sVT[(d * 32 + r) * LDT2 + jt * 32 + 16 * s + 4 * h];
          const uint2 lo = *(const uint2*)vrow;
          const uint2 hi = *(const uint2*)(vrow + 8);
          O[d] = MFMA(mk8(lo.x, lo.y, hi.x, hi.y), pf, O[d]);
        }
      }
    }
    {
      const float xf = __expf(lgf * (float)(qi + 1)), xb = __expf(lgb * (float)(128 - qi));
#pragma unroll
      for (int ks = 0; ks < 4; ++ks) {
        const uint4 q = qraw[ks];
        const bf16x8 qsf = mk8(pack2(bflo(q.x) * xf, bfhi(q.x) * xf), pack2(bflo(q.y) * xf, bfhi(q.y) * xf),
                               pack2(bflo(q.z) * xf, bfhi(q.z) * xf), pack2(bflo(q.w) * xf, bfhi(q.w) * xf));
        const bf16x8 qsb = mk8(pack2(bflo(q.x) * xb, bfhi(q.x) * xb), pack2(bflo(q.y) * xb, bfhi(q.y) * xb),
                               pack2(bflo(q.z) * xb, bfhi(q.z) * xb), pack2(bflo(q.w) * xb, bfhi(q.w) * xb));
#pragma unroll
        for (int d = 0; d < 2; ++d) {
          const bf16x8 sf = *(const bf16x8*)&sSTf[(d * 32 + r) * LDT + ks * 16 + 8 * h];
          const bf16x8 sb = *(const bf16x8*)&sSTb[(d * 32 + r) * LDT + ks * 16 + 8 * h];
          O[d] = MFMA(sf, qsf, O[d]);
          O[d] = MFMA(sb, qsb, O[d]);
        }
      }
    }
    float sum = 0.f;
#pragma unroll
    for (int d = 0; d < 2; ++d)
#pragma unroll
      for (int i = 0; i < 16; ++i) sum += O[d][i];
    sum += __shfl_xor(sum, 32);
    const float mu = sum * (1.f / 64.f);
    float vs = 0.f;
#pragma unroll
    for (int d = 0; d < 2; ++d)
#pragma unroll
      for (int i = 0; i < 16; ++i) { const float t = O[d][i] - mu; vs += t * t; }
    vs += __shfl_xor(vs, 32);
    const float rstd = rsqrtf(vs * (1.f / 64.f) + 1e-6f);
    const u16* grow = p.QKV + (size_t)(T0 + qi) * DIN + 2304 + head * 64;
    const float* gnw = p.gn + l * 256 + head * 64;
    u16* orow = p.CAT + (size_t)(T0 + qi) * DM + 768 + head * 64;
#pragma unroll
    for (int d = 0; d < 2; ++d)
#pragma unroll
      for (int g = 0; g < 4; ++g) {
        const int e = d * 32 + 8 * g + 4 * h;
        const uint2 gr = *(const uint2*)(grow + e);
        const float4 gw = *(const float4*)(gnw + e);
        const float o0 = silu(bflo(gr.x)) * (O[d][4 * g + 0] - mu) * rstd * gw.x;
        const float o1 = silu(bfhi(gr.x)) * (O[d][4 * g + 1] - mu) * rstd * gw.y;
        const float o2 = silu(bflo(gr.y)) * (O[d][4 * g + 2] - mu) * rstd * gw.z;
        const float o3 = silu(bfhi(gr.y)) * (O[d][4 * g + 3] - mu) * rstd * gw.w;
        uint2 pk = {pack2(o0, o1), pack2(o2, o3)};
        *(uint2*)(orow + e) = pk;
      }
  }
}

DI void phase3(const Params& p, char* smem, int l, const float* xc, const float* xl) {
  const float* W = p.w_out + (size_t)l * DM * DM;
  u16* PREB = (u16*)p.PRE;
  const int xcd = blockIdx.x & 7, nloc = gridDim.x >> 3;
  auto setup = [&](int s, int ar0, int ac, int n4, int kq, const u16*& ab, unsigned& o0, unsigned& o1, unsigned& o2, unsigned& o3, const float*& bb, unsigned& bo) {
    const int tm = 6 * xcd + s % 6, tn = s / 6;
    ab = p.CAT + (size_t)tm * 256 * DM;
    o0 = (unsigned)(ar0 * DM + ac); o1 = o0 + 64u * DM; o2 = o0 + 128u * DM; o3 = o0 + 192u * DM;
    bb = W + tn * 128;
    bo = (unsigned)(4 * n4 + kq * 4 * DM);
  };
  auto epi = [&](int s, f32x16(&acc)[2][4], int w, int r, int h) {
    int hq = h;
    asm volatile("" : "+v"(hq));
    const int tm = 6 * xcd + s % 6, tn = s / 6;
    const int m0 = tm * 256, n0 = tn * 128;
    const float* g1 = p.MOD + (size_t)(l * 5 + cond_of(m0)) * 6144 + 2048 + n0 + 4 * r;
    const float g0 = g1[0], g1v = g1[1], g2 = g1[2], g3 = g1[3];
#pragma unroll
    for (int mt = 0; mt < 2; ++mt)
#pragma unroll
    for (int i = 0; i < 16; ++i) {
      const int ml = w * 64 + mt * 32 + crow(i, hq);
      uint2 pk = {pack2(g0 * acc[mt][0][i], g1v * acc[mt][1][i]), pack2(g2 * acc[mt][2][i], g3 * acc[mt][3][i])};
      *(uint2*)(PREB + (size_t)(m0 + ml) * DM + n0 + 4 * r) = pk;
      if ((i & 3) == 3) __builtin_amdgcn_sched_barrier(0);
    }
  };
  gemm_phase<true>(smem, blockIdx.x >> 3, 48, nloc, setup, DM, epi, [](int, int) {});
}

DI void phase4(const Params& p, char* smem, int l, const float* xc, const float* xl) {
  float* swr = (float*)smem;
  const int tid = otid(), lane = tid & 63, w = tid >> 6;
  __syncthreads();
  for (int idx = tid; idx < 4096; idx += 256) {
    const float4 x = *(const float4*)(p.w_router + (size_t)l * DM * 16 + idx * 4);
    const int k = idx >> 2, e = (idx & 3) * 4;
    swr[(e + 0) * DM + k] = x.x; swr[(e + 1) * DM + k] = x.y; swr[(e + 2) * DM + k] = x.z; swr[(e + 3) * DM + k] = x.w;
  }
  __syncthreads();
  const float* lg = p.ln1g + l * DM;
  const float* lb = p.ln1b + l * DM;
  const int rstride = gridDim.x * 4;
  uint2 nprb[4];
  float4 nxi[4];
  {
    const int T0 = blockIdx.x * 4 + w;
    if (T0 < NTOK) {
      const float* xr0 = (T0 < NCTX) ? (xc + (size_t)T0 * DM) : (xl + (size_t)(T0 - NCTX) * DM);
#pragma unroll
      for (int i = 0; i < 4; ++i) {
        nprb[i] = *(const uint2*)((const u16*)p.PRE + (size_t)T0 * DM + 256 * i + 4 * lane);
        nxi[i] = *(const float4*)(xr0 + 256 * i + 4 * lane);
      }
    }
  }
  for (int T = blockIdx.x * 4 + w; T < NTOK; T += rstride) {
    const float* mod = p.MOD + (size_t)(l * 5 + cond_of(T)) * 6144;
    float4 x[4];
    float s = 0.f;
#pragma unroll
    for (int i = 0; i < 4; ++i) {
      const uint2 prb = nprb[i];
      const float4 xi = nxi[i];
      const float4 pr = {bflo(prb.x), bfhi(prb.x), bflo(prb.y), bfhi(prb.y)};
      x[i].x = ALPHA * xi.x + pr.x; x[i].y = ALPHA * xi.y + pr.y; x[i].z = ALPHA * xi.z + pr.z; x[i].w = ALPHA * xi.w + pr.w;
      s += x[i].x + x[i].y + x[i].z + x[i].w;
    }
    {
      const int Tn = T + rstride;
      if (Tn < NTOK) {
        const float* xrn = (Tn < NCTX) ? (xc + (size_t)Tn * DM) : (xl + (size_t)(Tn - NCTX) * DM);
#pragma unroll
        for (int i = 0; i < 4; ++i) {
          nprb[i] = *(const uint2*)((const u16*)p.PRE + (size_t)Tn * DM + 256 * i + 4 * lane);
          nxi[i] = *(const float4*)(xrn + 256 * i + 4 * lane);
        }
      }
    }
    const float mu = wave_sum(s) * (1.f / 1024.f);
    float vs = 0.f;
#pragma unroll
    for (int i = 0; i < 4; ++i) {
      x[i].x -= mu; x[i].y -= mu; x[i].z -= mu; x[i].w -= mu;
      vs += x[i].x * x[i].x + x[i].y * x[i].y + x[i].z * x[i].z + x[i].w * x[i].w;
    }
    const float rstd = rsqrtf(wave_sum(vs) * (1.f / 1024.f) + 1e-6f);
#pragma unroll
    for (int i = 0; i < 4; ++i) {
      const int k = 256 * i + 4 * lane;
      const float4 g = *(const float4*)(lg + k), bb = *(const float4*)(lb + k);
      float4 y;
      y.x = x[i].x * rstd * g.x + bb.x; y.y = x[i].y * rstd * g.y + bb.y; y.z = x[i].z * rstd * g.z + bb.z; y.w = x[i].w * rstd * g.w + bb.w;
      *(float4*)(p.X + (size_t)T * DM + k) = y;
      const float4 sc = *(const float4*)(mod + 4096 + k), sh = *(const float4*)(mod + 3072 + k);
      float4 hh;
      hh.x = y.x * (1.f + sc.x) + sh.x; hh.y = y.y * (1.f + sc.y) + sh.y; hh.z = y.z * (1.f + sc.z) + sh.z; hh.w = y.w * (1.f + sc.w) + sh.w;
      uint2 pk = {pack2(hh.x, hh.y), pack2(hh.z, hh.w)};
      *(uint2*)(p.H2 + (size_t)T * DM + k) = pk;
      x[i] = hh;
    }
    float a16[16];
#pragma unroll
    for (int e = 0; e < 16; ++e) {
      float a = 0.f;
#pragma unroll
      for (int i = 0; i < 4; ++i) {
        const float4 wv = *(const float4*)(swr + e * DM + 256 * i + 4 * lane);
        a += x[i].x * wv.x + x[i].y * wv.y + x[i].z * wv.z + x[i].w * wv.w;
      }
      a16[e] = a;
      if ((e & 3) == 3) __builtin_amdgcn_sched_barrier(0);
    }
    float a8[8], a4[4], a2[2], a1;
    {
      const bool hi = (lane & 32) != 0;
#pragma unroll
      for (int j = 0; j < 8; ++j) {
        const float snd = hi ? a16[j] : a16[8 + j];
        const float kp = hi ? a16[8 + j] : a16[j];
        a8[j] = kp + __shfl_xor(snd, 32);
      }
    }
    {
      const bool hi = (lane & 16) != 0;
#pragma unroll
      for (int j = 0; j < 4; ++j) {
        const float snd = hi ? a8[j] : a8[4 + j];
        const float kp = hi ? a8[4 + j] : a8[j];
        a4[j] = kp + __shfl_xor(snd, 16);
      }
    }
    {
      const bool hi = (lane & 8) != 0;
#pragma unroll
      for (int j = 0; j < 2; ++j) {
        const float snd = hi ? a4[j] : a4[2 + j];
        const float kp = hi ? a4[2 + j] : a4[j];
        a2[j] = kp + __shfl_xor(snd, 8);
      }
    }
    {
      const bool hi = (lane & 4) != 0;
      const float snd = hi ? a2[0] : a2[1];
      const float kp = hi ? a2[1] : a2[0];
      a1 = kp + __shfl_xor(snd, 4);
    }
    a1 += __shfl_xor(a1, 2);
    a1 += __shfl_xor(a1, 1);
    const int myexp = ((lane >> 5) & 1) * 8 + ((lane >> 4) & 1) * 4 + ((lane >> 3) & 1) * 2 + ((lane >> 2) & 1);
    float mx = a1;
#pragma unroll
    for (int o = 32; o >= 4; o >>= 1) mx = fmaxf(mx, __shfl_xor(mx, o));
    const float ex = __expf(a1 - mx);
    float den = ex;
#pragma unroll
    for (int o = 32; o >= 4; o >>= 1) den += __shfl_xor(den, o);
    if ((lane & 3) == 0) { p.AFF[(size_t)T * 16 + myexp] = ex / den; p.INV[(size_t)T * 16 + myexp] = -1; }
  }
}

DI unsigned block_incl_scan(unsigned v, unsigned* wsum, int lane, int w, unsigned& total) {
#pragma unroll
  for (int o = 1; o < 64; o <<= 1) {
    const unsigned t = __shfl_up(v, o);
    if (lane >= o) v += t;
  }
  __syncthreads();
  if (lane == 63) wsum[w] = v;
  __syncthreads();
  unsigned off = 0;
  total = 0;
#pragma unroll
  for (int i = 0; i < 4; ++i) {
    const unsigned s = wsum[i];
    if (i < w) off += s;
    total += s;
  }
  return v + off;
}

DI void phase5(const Params& p, char* smem) {
  unsigned* hist = (unsigned*)smem;
  unsigned* wsum = hist + 256;
  unsigned* bc = wsum + 4;
  const int tid = otid(), lane = tid & 63, w = tid >> 6;
  for (int item = blockIdx.x; item < 320; item += gridDim.x) {
    int n, base, e, cap, rowbase;
    if (item < 64) {
      const int b = item >> 4; e = item & 15;
      n = 2048; base = NCTX + b * 2048; cap = 256; rowbase = 512 + b * 256;
    } else {
      const int it = item - 64; const int rq = it >> 4; e = it & 15;
      n = 256; base = rq * 256; cap = 32; rowbase = rq * 32;
    }
    const int per = n >> 8;
    unsigned key[8];
#pragma unroll
    for (int q = 0; q < 8; ++q) key[q] = (q < per) ? __float_as_uint(p.AFF[(size_t)(base + tid * per + q) * 16 + e]) : 0u;
    unsigned prefix = 0u, mask = 0u;
    unsigned remaining = (unsigned)cap;
#pragma unroll 1
    for (int pass = 3; pass >= 0; --pass) {
      const int shift = pass * 8;
      __syncthreads();
      hist[tid] = 0u;
      __syncthreads();
#pragma unroll
      for (int q = 0; q < 8; ++q)
        if (q < per && (key[q] & mask) == prefix) atomicAdd(&hist[(key[q] >> shift) & 255u], 1u);
      __syncthreads();
      const unsigned hv = hist[tid];
      unsigned total;
      const unsigned incl = block_incl_scan(hv, wsum, lane, w, total);
      const unsigned above = total - incl;
      if (above < remaining && remaining <= above + hv) { bc[0] = (unsigned)tid; bc[1] = remaining - above; }
      __syncthreads();
      const unsigned bsel = bc[0];
      remaining = bc[1];
      prefix |= bsel << shift;
      mask |= 0xFFu << shift;
    }
    const unsigned thr = prefix;
    unsigned ceq = 0u;
#pragma unroll
    for (int q = 0; q < 8; ++q) ceq += (q < per && key[q] == thr) ? 1u : 0u;
    unsigned tot;
    unsigned eq_before = block_incl_scan(ceq, wsum, lane, w, tot) - ceq;
    unsigned selmask = 0u, nsel = 0u;
#pragma unroll
    for (int q = 0; q < 8; ++q) {
      if (q < per) {
        const bool eq = key[q] == thr;
        const bool sel = (key[q] > thr) || (eq && eq_before < remaining);
        eq_before += eq ? 1u : 0u;
        selmask |= sel ? (1u << q) : 0u;
        nsel += sel ? 1u : 0u;
      }
    }
    unsigned row = block_incl_scan(nsel, wsum, lane, w, tot) - nsel;
#pragma unroll
    for (int q = 0; q < 8; ++q) {
      if (q < per && ((selmask >> q) & 1u)) {
        const int tok = base + tid * per + q;
        const int rr = e * NROWS_E + rowbase + (int)row;
        p.SELTOK[rr] = tok;
        p.SELGATE[rr] = __uint_as_float(key[q]);
        p.INV[(size_t)tok * 16 + e] = rr;
        ++row;
      }
    }
  }
}

DI void phase6(const Params& p, char* smem, int l) {
  const int xcd = blockIdx.x & 7, nloc = gridDim.x >> 3;
  auto setup = [&](int s, int ar0, int ac, int n4, int kq, const u16*& ab, unsigned& o0, unsigned& o1, unsigned& o2, unsigned& o3, const float*& bb, unsigned& bo) {
    const int e = 2 * xcd + s / 96, rem = s % 96, tn = rem / 6, tm = rem % 6;
    const int* tok = p.SELTOK + e * NROWS_E + tm * 256 + ar0;
    ab = p.H2;
    o0 = (unsigned)(tok[0] * DM + ac); o1 = (unsigned)(tok[64] * DM + ac);
    o2 = (unsigned)(tok[128] * DM + ac); o3 = (unsigned)(tok[192] * DM + ac);
    bb = p.w_gu + ((size_t)l * 16 + e) * DM * 2048 + tn * 64;
    bo = (unsigned)(((n4 >> 4) & 1) * 1024 + 4 * (n4 & 15) + kq * 4 * 2048);
  };
  auto epi = [&](int s, f32x16(&acc)[2][4], int w, int r, int h) {
    int hq = h;
    asm volatile("" : "+v"(hq));
    const int e = 2 * xcd + s / 96, rem = s % 96, tn = rem / 6, tm = rem % 6;
    const int m0 = tm * 256, f0 = tn * 64;
    u16* act = p.ACT + ((size_t)e * NROWS_E + m0) * DM;
#pragma unroll
    for (int mt = 0; mt < 2; ++mt)
#pragma unroll
    for (int i = 0; i < 16; ++i) {
      const int ml = w * 64 + mt * 32 + crow(i, hq);
      const float a0 = acc[mt][0][i], a1 = acc[mt][1][i], a2 = acc[mt][2][i], a3 = acc[mt][3][i];
      const bool lo = r < 16;
      const float s0 = lo ? a2 : a0, s1 = lo ? a3 : a1;
      const float r0 = __shfl_xor(s0, 16), r1 = __shfl_xor(s1, 16);
      const float g0 = lo ? a0 : r0, g1 = lo ? a1 : r1;
      const float v0 = lo ? r0 : a2, v1 = lo ? r1 : a3;
      *(unsigned*)(act + (size_t)ml * DM + f0 + 4 * (r & 15) + (lo ? 0 : 2)) = pack2(silu(g0) * v0, silu(g1) * v1);
      if ((i & 3) == 3) __builtin_amdgcn_sched_barrier(0);
    }
  };
  gemm_phase<false>(smem, blockIdx.x >> 3, 192, nloc, setup, 2048, epi, [](int, int) {});
}

DI void phase7(const Params& p, char* smem, int l, u16* FF) {
  const int xcd = blockIdx.x & 7, nloc = gridDim.x >> 3;
  auto setup = [&](int s, int ar0, int ac, int n4, int kq, const u16*& ab, unsigned& o0, unsigned& o1, unsigned& o2, unsigned& o3, const float*& bb, unsigned& bo) {
    const int e = 2 * xcd + s / 48, rem = s % 48, tn = rem / 6, tm = rem % 6;
    ab = p.ACT + ((size_t)e * NROWS_E + tm * 256) * DM;
    o0 = (unsigned)(ar0 * DM + ac); o1 = o0 + 64u * DM; o2 = o0 + 128u * DM; o3 = o0 + 192u * DM;
    bb = p.w_down + ((size_t)l * 16 + e) * DM * DM + tn * 128;
    bo = (unsigned)(4 * n4 + kq * 4 * DM);
  };
  float* sG = (float*)(smem + 61440);
  int par = 1;
  auto pre = [&](int s, int tid) {
    par ^= 1;
    const int e = 2 * xcd + s / 48, rem = s % 48, tm = rem % 6;
    sG[par * 256 + tid] = p.SELGATE[e * NROWS_E + tm * 256 + tid];
  };
  auto epi = [&](int s, f32x16(&acc)[2][4], int w, int r, int h) {
    int hq = h;
    asm volatile("" : "+v"(hq));
    const int e = 2 * xcd + s / 48, rem = s % 48, tn = rem / 6, tm = rem % 6;
    const int m0 = tm * 256, n0 = tn * 128;
#pragma unroll
    for (int mt = 0; mt < 2; ++mt)
#pragma unroll
    for (int i = 0; i < 16; ++i) {
      const int ml = w * 64 + mt * 32 + crow(i, hq);
      const float g = sG[par * 256 + ml];
      uint2 pk = {pack2(g * acc[mt][0][i], g * acc[mt][1][i]), pack2(g * acc[mt][2][i], g * acc[mt][3][i])};
      *(uint2*)(FF + ((size_t)e * NROWS_E + m0 + ml) * DM + n0 + 4 * r) = pk;
      if ((i & 3) == 3) __builtin_amdgcn_sched_barrier(0);
    }
  };
  gemm_phase<true>(smem, blockIdx.x >> 3, 96, nloc, setup, DM, epi, pre);
}

DI void phase8(const Params& p, int l, float* dst, bool write_h) {
  const int tid = otid(), lane = tid & 63, w = tid >> 6;
  const float* lg = p.ln2g + l * DM;
  const float* lb = p.ln2b + l * DM;
  const int rstride = gridDim.x * 4;
  float4 nxa[4];
  int ninv = -1;
  {
    const int T0 = blockIdx.x * 4 + w;
    if (T0 < NTOK) {
#pragma unroll
      for (int i = 0; i < 4; ++i) nxa[i] = *(const float4*)(p.X + (size_t)T0 * DM + 256 * i + 4 * lane);
      ninv = (lane < 16) ? p.INV[(size_t)T0 * 16 + lane] : -1;
    }
  }
  for (int T = blockIdx.x * 4 + w; T < NTOK; T += rstride) {
    const float* g2 = p.MOD + (size_t)(l * 5 + cond_of(T)) * 6144 + 5120;
    const float* modn = p.MOD + (size_t)(5 + cond_of(T)) * 6144;
    float4 x[4], ff[4], xa[4];
#pragma unroll
    for (int i = 0; i < 4; ++i) { ff[i] = make_float4(0.f, 0.f, 0.f, 0.f); xa[i] = nxa[i]; }
    const int myinv = ninv;
    {
      const int Tn = T + rstride;
      if (Tn < NTOK) {
#pragma unroll
        for (int i = 0; i < 4; ++i) nxa[i] = *(const float4*)(p.X + (size_t)Tn * DM + 256 * i + 4 * lane);
        ninv = (lane < 16) ? p.INV[(size_t)Tn * 16 + lane] : -1;
      }
    }
    unsigned long long sel = __ballot(myinv >= 0);
#pragma unroll 1
    while (sel) {
      int rows[4];
#pragma unroll
      for (int q = 0; q < 4; ++q) {
        if (sel) {
          const int e = __ffsll((long long)sel) - 1;
          sel &= sel - 1;
          rows[q] = __shfl(myinv, e);
        } else {
          rows[q] = -1;
        }
      }
      uint2 y[4][4];
#pragma unroll
      for (int q = 0; q < 4; ++q) {
        const u16* yr = p.YE + (size_t)(rows[q] >= 0 ? rows[q] : 0) * DM + 4 * lane;
#pragma unroll
        for (int i = 0; i < 4; ++i) y[q][i] = *(const uint2*)(yr + 256 * i);
      }
#pragma unroll
      for (int q = 0; q < 4; ++q) {
        const float wq = rows[q] >= 0 ? 1.f : 0.f;
#pragma unroll
        for (int i = 0; i < 4; ++i) {
          ff[i].x += wq * bflo(y[q][i].x); ff[i].y += wq * bfhi(y[q][i].x); ff[i].z += wq * bflo(y[q][i].y); ff[i].w += wq * bfhi(y[q][i].y);
        }
      }
    }
    float s = 0.f;
#pragma unroll
    for (int i = 0; i < 4; ++i) {
      const int k = 256 * i + 4 * lane;
      const float4 a = xa[i];
      const float4 f = ff[i];
      const float4 g = *(const float4*)(g2 + k);
      x[i].x = ALPHA * a.x + g.x * f.x; x[i].y = ALPHA * a.y + g.y * f.y; x[i].z = ALPHA * a.z + g.z * f.z; x[i].w = ALPHA * a.w + g.w * f.w;
      s += x[i].x + x[i].y + x[i].z + x[i].w;
    }
    const float mu = wave_sum(s) * (1.f / 1024.f);
    float vs = 0.f;
#pragma unroll
    for (int i = 0; i < 4; ++i) {
      x[i].x -= mu; x[i].y -= mu; x[i].z -= mu; x[i].w -= mu;
      vs += x[i].x * x[i].x + x[i].y * x[i].y + x[i].z * x[i].z + x[i].w * x[i].w;
    }
    const float rstd = rsqrtf(wave_sum(vs) * (1.f / 1024.f) + 1e-6f);
#pragma unroll
    for (int i = 0; i < 4; ++i) {
      const int k = 256 * i + 4 * lane;
      const float4 g = *(const float4*)(lg + k), bb = *(const float4*)(lb + k);
      float4 y;
      y.x = x[i].x * rstd * g.x + bb.x; y.y = x[i].y * rstd * g.y + bb.y; y.z = x[i].z * rstd * g.z + bb.z; y.w = x[i].w * rstd * g.w + bb.w;
      *(float4*)(dst + (size_t)T * DM + k) = y;
      if (write_h) {
        const float4 sc = *(const float4*)(modn + 1024 + k), sh = *(const float4*)(modn + k);
        uint2 pk = {pack2(y.x * (1.f + sc.x) + sh.x, y.y * (1.f + sc.y) + sh.y), pack2(y.z * (1.f + sc.z) + sh.z, y.w * (1.f + sc.w) + sh.w)};
        *(uint2*)(p.H2 + (size_t)T * DM + k) = pk;
      }
    }
  }
}

constexpr int kDynLds = 73728;
__global__ void __launch_bounds__(256, 2) mega(Params p) {
  extern __shared__ __attribute__((aligned(16))) char smem[];
  cg::grid_group grid = cg::this_grid();
  if (p.never) grid.sync();
  GBar gb;
  gb.bar = p.BAR; gb.x = xb_xcc_id(); gb.nloc = 0u; gb.nx = 0u;
  if (threadIdx.x == 0) (void)xb_add(&p.BAR[XB_XCNT(gb.x)], 1u);
  phase0(p, smem);
  gbar(gb);
  phase0b(p);
  gbar(gb);
#pragma unroll 1
  for (int l = 0; l < 2; ++l) {
    const float* xc = (l == 0) ? p.x_prompt : p.X;
    const float* xl = (l == 0) ? p.x_sample : (p.X + (size_t)NCTX * DM);
    phase1(p, smem, l);
    gbar(gb);
    if (PROBE == 1) { phase1(p, smem, l); gbar(gb); }
    phase2(p, smem, l);
    gbar(gb);
    if (PROBE == 3) { phase2(p, smem, l); gbar(gb); }
    phase2c(p, smem, l);
    gbar(gb);
    if (PROBE == 3) { phase2c(p, smem, l); gbar(gb); }
    phase3(p, smem, l, xc, xl);
    gbar(gb);
    if (PROBE == 1) { phase3(p, smem, l, xc, xl); gbar(gb); }
    phase4(p, smem, l, xc, xl);
    gbar(gb);
    phase5(p, smem);
    gbar(gb);
    phase6(p, smem, l);
    gbar(gb);
    if (PROBE == 1) { phase6(p, smem, l); gbar(gb); }
    phase7(p, smem, l, p.YE);
    gbar(gb);
    phase8(p, l, (l == 1) ? p.out : p.X, l == 0);
    if (l == 0) gbar(gb);
  }
}

extern "C" void kernel_launch(void* const* d_in, const int* in_sizes, int n_in, void* d_out, int out_size, void* d_ws,
                              size_t ws_size, hipStream_t stream) {
  static int grid_blocks = 0;
  if (!grid_blocks) {
    int dev = 0, cus = 0, per_cu = 0;
    hipGetDevice(&dev);
    hipDeviceGetAttribute(&cus, hipDeviceAttributeMultiprocessorCount, dev);
    hipFuncSetAttribute((const void*)mega, hipFuncAttributeMaxDynamicSharedMemorySize, kDynLds);
    hipOccupancyMaxActiveBlocksPerMultiprocessor(&per_cu, mega, 256, kDynLds);
    if (per_cu > 2) per_cu = 2;
    if (per_cu < 1) per_cu = 1;
    grid_blocks = cus * per_cu;
  }
  Params p{};
  const float** pf = (const float**)&p;
  for (int i = 0; i < 24; ++i) pf[i] = (const float*)d_in[i];
  p.out = (float*)d_out;
  char* ws = (char*)d_ws;
  size_t off = 0;
  auto take = [&](size_t bytes) { char* q = ws + off; off += (bytes + 255) & ~(size_t)255; return q; };
  p.MOD = (float*)take(2 * 5 * 6144 * 4);
  p.BAR = (unsigned*)take(XCD_BAR_WORDS * 4);
  p.ROPE = (float*)take(2048 * 4);
  p.X = (float*)take((size_t)NTOK * DM * 4);
  p.PRE = (float*)take((size_t)NTOK * DM * 4);
  p.KVS = (float*)take((size_t)20 * 4 * 2 * 16 * 4096 * 4);
  p.AFF = (float*)take((size_t)NTOK * 16 * 4);
  p.SELGATE = (float*)take((size_t)16 * NROWS_E * 4);
  p.SELTOK = (int*)take((size_t)16 * NROWS_E * 4);
  p.QKV = (u16*)take((size_t)NTOK * DIN * 2);
  p.CAT = (u16*)take((size_t)NTOK * DM * 2);
  p.H2 = (u16*)take((size_t)NTOK * DM * 2);
  p.ACT = (u16*)take((size_t)16 * NROWS_E * DM * 2);
  p.YE = (u16*)take((size_t)16 * NROWS_E * DM * 2);
  p.INV = (int*)take((size_t)NTOK * 16 * 4);
  p.CAK = (u16*)take((size_t)4 * 2 * 512 * 128 * 2);
  p.CAV = (u16*)take((size_t)4 * 2 * 512 * 128 * 2);
  p.CBK = (u16*)take((size_t)4 * 2 * 512 * 256 * 2);
  p.CBV = (u16*)take((size_t)4 * 2 * 512 * 256 * 2);
  p.never = 0;
  hipMemsetAsync(p.MOD, 0, (size_t)((char*)p.BAR - (char*)p.MOD) + XCD_BAR_WORDS * 4, stream);
  void* args[] = {&p};
  hipError_t e = hipLaunchCooperativeKernel((void*)mega, dim3(grid_blocks), dim3(256), args, kDynLds, stream);
  if (e != hipSuccess) fprintf(stderr, "cooperative launch failed: %s (grid %d)\n", hipGetErrorString(e), grid_blocks);
}
```
